# Optimizing an MI355X kernel written in HIP

```python
import math
import jax
import jax.numpy as jnp
from jax import lax
import numpy as np

D_MODEL = 1024
BATCH = 1
SEQ = 16384
DEPTH = 1

N_MEM = 256
NORM_EPS = 1e-6
NEG_INF = -1e30

RWKV_HEADS = 8
RWKV_HEAD_DIM = 64
RWKV_WIDTH = RWKV_HEADS * RWKV_HEAD_DIM
DECAY_LORA = 64
ICLR_LORA = 64
GATE_LORA = 128
RWKV_COLS = 3 * RWKV_WIDTH + DECAY_LORA + ICLR_LORA + GATE_LORA
RWKV_SPLITS = [RWKV_WIDTH, 2 * RWKV_WIDTH, 3 * RWKV_WIDTH, 3 * RWKV_WIDTH + DECAY_LORA, 3 * RWKV_WIDTH + DECAY_LORA + ICLR_LORA]
LN_X_EPS = 64e-5
KK_EPS = 1e-12

MOBA_HEADS = 8
MOBA_HEAD_DIM = 64
MOBA_WIDTH = MOBA_HEADS * MOBA_HEAD_DIM
MOBA_BLOCK = 256
MOBA_TOP_BLOCKS = 3
Q_CHUNK = 64

REL_BUCKETS = 32
REL_MAX_DISTANCE = 4096

N_BRANCHES = 2
IN_COLS = RWKV_COLS + 3 * MOBA_WIDTH + N_BRANCHES * D_MODEL

XATTN_HEADS = 4
XATTN_HEAD_DIM = 128
XATTN_WIDTH = XATTN_HEADS * XATTN_HEAD_DIM

N_GROUPS = 4
EXPERTS_PER_GROUP = 8
N_EXPERTS = N_GROUPS * EXPERTS_PER_GROUP
TOP_K_EXPERTS = 2
D_EXPERT = 512
MOE_BLOCK = 128

kernel_name = 'hybrid_rwkv7_moba_hmoe_layer'


def rmsnorm(x, g):
    xf = x.astype(jnp.float32)
    y = xf * lax.rsqrt(jnp.mean(xf * xf, axis=-1, keepdims=True) + NORM_EPS)
    return (y * g.astype(jnp.float32)).astype(x.dtype)


def t5_bucket(dist):
    n = jnp.maximum(dist, 0)
    max_exact = REL_BUCKETS // 2
    nf = jnp.maximum(n, max_exact).astype(jnp.float32)
    large = max_exact + (jnp.log(nf / max_exact) / math.log(REL_MAX_DISTANCE / max_exact)
                         * (REL_BUCKETS - max_exact)).astype(jnp.int32)
    large = jnp.minimum(large, REL_BUCKETS - 1)
    return jnp.where(n < max_exact, n, large)


def wkv7_scan(r, w, k, v, a, b):
    B, T, H, N = r.shape

    def step(S, inp):
        r_t, w_t, k_t, v_t, a_t, b_t = inp
        sa = jnp.einsum('bhvk,bhk->bhv', S, a_t)
        S = S * w_t[:, :, None, :] + sa[..., None] * b_t[:, :, None, :] + v_t[..., None] * k_t[:, :, None, :]
        return S, jnp.einsum('bhvk,bhk->bhv', S, r_t)

    xs = tuple(jnp.moveaxis(t.astype(jnp.float32), 1, 0) for t in (r, w, k, v, a, b))
    S0 = jnp.zeros((B, H, N, N), jnp.float32)
    _, y = lax.scan(step, S0, xs)
    return jnp.moveaxis(y, 0, 1)


def rwkv7_mixer(u, mu, w0, decay_up, iclr_a0, iclr_up, gate_up, k_k, k_a, r_k, ln_w, ln_b):
    B, T, _ = u.shape
    H, N = RWKV_HEADS, RWKV_HEAD_DIM
    u_prev = jnp.pad(u[:, :-1], ((0, 0), (1, 0), (0, 0)))
    u = u + mu * (u_prev - u)
    r, k, v, wd, ad, gd = jnp.split(u, RWKV_SPLITS, axis=-1)
    w_log = -jax.nn.softplus(-(w0 + jnp.tanh(wd) @ decay_up)) - 0.5
    decay = jnp.exp(-jnp.exp(w_log.astype(jnp.float32)))
    a = jax.nn.sigmoid(iclr_a0 + ad @ iclr_up)
    g = jax.nn.sigmoid(gd) @ gate_up
    kk = (k * k_k).reshape(B, T, H, N).astype(jnp.float32)
    kk = kk * lax.rsqrt(jnp.sum(kk * kk, axis=-1, keepdims=True) + KK_EPS)
    k = k * (1.0 + (a - 1.0) * k_a)
    r_h = r.reshape(B, T, H, N)
    k_h = k.reshape(B, T, H, N)
    v_h = v.reshape(B, T, H, N)
    a_h = a.reshape(B, T, H, N).astype(jnp.float32)
    y = wkv7_scan(r_h, decay.reshape(B, T, H, N), k_h, v_h, -kk, kk * a_h)
    mean = jnp.mean(y, axis=-1, keepdims=True)
    var = jnp.mean(jnp.square(y - mean), axis=-1, keepdims=True)
    y = ((y - mean) * lax.rsqrt(var + LN_X_EPS)).reshape(B, T, RWKV_WIDTH)
    y = y * ln_w.astype(jnp.float32) + ln_b.astype(jnp.float32)
    bonus = jnp.sum((r_h * k_h * r_k).astype(jnp.float32), axis=-1, keepdims=True) * v_h.astype(jnp.float32)
    y = y + bonus.reshape(B, T, RWKV_WIDTH)
    return (y * g.astype(jnp.float32)).astype(u.dtype)


def moba_attention(q, k, v, rel_bias):
    B, T, H, Dh = q.shape
    nb = -(-T // MOBA_BLOCK)
    pad = nb * MOBA_BLOCK - T
    q = q.transpose(0, 2, 1, 3)
    kb = jnp.pad(k.transpose(0, 2, 1, 3), ((0, 0), (0, 0), (0, pad), (0, 0))).reshape(B, H, nb, MOBA_BLOCK, Dh)
    vb = jnp.pad(v.transpose(0, 2, 1, 3), ((0, 0), (0, 0), (0, pad), (0, 0))).reshape(B, H, nb, MOBA_BLOCK, Dh)
    k_mean = jnp.mean(kb.astype(jnp.float32), axis=3)
    n_sel = min(MOBA_TOP_BLOCKS, nb)
    scale = Dh ** -0.5
    bias_hb = rel_bias.T.astype(jnp.float32)
    b_idx = jnp.arange(B)[:, None, None, None]
    h_idx = jnp.arange(H)[None, :, None, None]
    blk_ids = jnp.arange(nb)
    offs = jnp.arange(MOBA_BLOCK)

    def one_chunk(c):
        start = c * Q_CHUNK
        qc = lax.dynamic_slice_in_dim(q, start, Q_CHUNK, axis=2).astype(jnp.float32)
        q_pos = start + jnp.arange(Q_CHUNK)
        q_blk = start // MOBA_BLOCK
        blk_score = jnp.einsum('bhqd,bhnd->bhqn', qc, k_mean)
        blk_score = jnp.where(blk_ids < q_blk, blk_score, NEG_INF)
        _, sel = lax.top_k(blk_score, n_sel)
        sel_ok = sel < q_blk
        k_sel = kb[b_idx, h_idx, sel].astype(jnp.float32)
        v_sel = vb[b_idx, h_idx, sel].astype(jnp.float32)
        k_pos_sel = sel[..., None] * MOBA_BLOCK + offs
        bias_sel = bias_hb[h_idx[..., None], t5_bucket(q_pos[:, None, None] - k_pos_sel)]
        logit_sel = jnp.einsum('bhqd,bhqskd->bhqsk', qc, k_sel) * scale + bias_sel
        logit_sel = jnp.where(sel_ok[..., None], logit_sel, NEG_INF)
        k_own = lax.dynamic_index_in_dim(kb, q_blk, axis=2, keepdims=False).astype(jnp.float32)
        v_own = lax.dynamic_index_in_dim(vb, q_blk, axis=2, keepdims=False).astype(jnp.float32)
        rel_own = q_pos[:, None] - (q_blk * MOBA_BLOCK + offs)[None, :]
        logit_own = jnp.einsum('bhqd,bhkd->bhqk', qc, k_own) * scale + bias_hb[:, t5_bucket(rel_own)]
        logit_own = jnp.where(rel_own >= 0, logit_own, NEG_INF)
        logits = jnp.concatenate([logit_sel.reshape(B, H, Q_CHUNK, n_sel * MOBA_BLOCK), logit_own], axis=-1)
        p = jax.nn.softmax(logits, axis=-1)
        p_sel = p[..., :n_sel * MOBA_BLOCK].reshape(B, H, Q_CHUNK, n_sel, MOBA_BLOCK)
        p_own = p[..., n_sel * MOBA_BLOCK:]
        out = (jnp.einsum('bhqsk,bhqskd->bhqd', p_sel, v_sel)
               + jnp.einsum('bhqk,bhkd->bhqd', p_own, v_own))
        return out.astype(q.dtype)

    out = lax.map(one_chunk, jnp.arange(T // Q_CHUNK))
    return out.transpose(1, 0, 3, 2, 4).reshape(B, T, H * Dh)


def memory_cross_attention(h, mem_n, w_q, w_kv, w_o):
    B, T, _ = h.shape
    M = mem_n.shape[1]
    q = (h @ w_q).reshape(B, T, XATTN_HEADS, XATTN_HEAD_DIM)
    k, v = jnp.split(mem_n @ w_kv, 2, axis=-1)
    k = k.reshape(B, M, XATTN_HEADS, XATTN_HEAD_DIM)
    v = v.reshape(B, M, XATTN_HEADS, XATTN_HEAD_DIM)
    logits = jnp.einsum('bthd,bmhd->bhtm', q, k).astype(jnp.float32) * (XATTN_HEAD_DIM ** -0.5)
    p = jax.nn.softmax(logits, axis=-1).astype(v.dtype)
    o = jnp.einsum('bhtm,bmhd->bthd', p, v).reshape(B, T, XATTN_WIDTH)
    return o @ w_o


def hierarchical_moe(h, w_router_group, w_router_expert, w_exp_gate, w_exp_up, w_exp_down):
    B, T, D = h.shape
    n_tok = B * T
    xf = h.reshape(n_tok, D)
    g_prob = jax.nn.softmax((xf @ w_router_group).astype(jnp.float32), axis=-1)
    g_top_p, g_sel = lax.top_k(g_prob, 1)
    e_logits = (xf @ w_router_expert).astype(jnp.float32).reshape(n_tok, N_GROUPS, EXPERTS_PER_GROUP)
    e_in_group = e_logits[jnp.arange(n_tok), g_sel[:, 0]]
    top_v, top_i = lax.top_k(e_in_group, TOP_K_EXPERTS)
    gate = jax.nn.softmax(top_v, axis=-1) * g_top_p
    expert = g_sel * EXPERTS_PER_GROUP + top_i
    n_assign = n_tok * TOP_K_EXPERTS
    e_flat = expert.reshape(n_assign)
    tok_flat = jnp.repeat(jnp.arange(n_tok, dtype=jnp.int32), TOP_K_EXPERTS)
    w_flat = gate.reshape(n_assign)
    order = jnp.argsort(e_flat)
    e_s, tok_s, w_s = e_flat[order], tok_flat[order], w_flat[order]
    counts = jnp.bincount(e_flat, length=N_EXPERTS)
    start = jnp.cumsum(counts) - counts
    padded = (counts + MOE_BLOCK - 1) // MOE_BLOCK * MOE_BLOCK
    p_end = jnp.cumsum(padded)
    p_start = p_end - padded
    dest = p_start[e_s] + jnp.arange(n_assign) - start[e_s]
    n_blocks = (n_assign + N_EXPERTS * (MOE_BLOCK - 1) + MOE_BLOCK - 1) // MOE_BLOCK
    cap = n_blocks * MOE_BLOCK
    buf_tok = jnp.zeros((cap,), jnp.int32).at[dest].set(tok_s)
    buf_w = jnp.zeros((cap,), jnp.float32).at[dest].set(w_s)
    block_expert = jnp.minimum(jnp.searchsorted(p_end, jnp.arange(n_blocks) * MOE_BLOCK, side='right'), N_EXPERTS - 1)

    def expert_block(args):
        toks, e = args
        xb = xf[toks]
        hid = jax.nn.silu(xb @ w_exp_gate[e]) * (xb @ w_exp_up[e])
        return hid @ w_exp_down[e]

    y_blocks = lax.map(expert_block, (buf_tok.reshape(n_blocks, MOE_BLOCK), block_expert))
    y = y_blocks.reshape(cap, D) * buf_w[:, None].astype(h.dtype)
    return jax.ops.segment_sum(y, buf_tok, num_segments=n_tok).reshape(B, T, D)


def setup_inputs(seed: int = 0) -> dict:
    key = jax.random.key(seed)
    ks = jax.random.split(key, 32)
    f32 = jnp.float32

    def nrm(k, shape, scale):
        return jax.random.normal(k, shape, f32) * scale

    def gain(k, shape, base=1.0):
        return base + 0.02 * jax.random.normal(k, shape, f32)

    L, D = DEPTH, D_MODEL
    return {
        'x': nrm(ks[0], (BATCH, SEQ, D), 1.0),
        'mem': nrm(ks[1], (BATCH, N_MEM, D), 1.0),
        'rel_bias': nrm(ks[2], (REL_BUCKETS, MOBA_HEADS), 0.5),
        'mem_norm': gain(ks[3], (D,)),
        'norm_mix': gain(ks[4], (L, D)),
        'w_in': nrm(ks[5], (L, D, IN_COLS), D ** -0.5),
        'tshift_mu': jax.random.uniform(ks[6], (L, RWKV_COLS), f32),
        'decay_w0': jax.random.uniform(ks[7], (L, RWKV_WIDTH), f32, minval=-6.0, maxval=1.0),
        'decay_up': nrm(ks[8], (L, DECAY_LORA, RWKV_WIDTH), 0.5 * DECAY_LORA ** -0.5),
        'iclr_a0': nrm(ks[9], (L, RWKV_WIDTH), 0.1),
        'iclr_up': nrm(ks[10], (L, ICLR_LORA, RWKV_WIDTH), ICLR_LORA ** -0.5),
        'gate_up': nrm(ks[11], (L, GATE_LORA, RWKV_WIDTH), GATE_LORA ** -0.5),
        'k_k': gain(ks[12], (L, RWKV_WIDTH), 0.85),
        'k_a': gain(ks[13], (L, RWKV_WIDTH)),
        'r_k': nrm(ks[14], (L, RWKV_HEADS, RWKV_HEAD_DIM), 0.1),
        'ln_x_w': gain(ks[15], (L, RWKV_WIDTH)),
        'ln_x_b': nrm(ks[16], (L, RWKV_WIDTH), 0.02),
        'w_o_rwkv': nrm(ks[17], (L, RWKV_WIDTH, D), RWKV_WIDTH ** -0.5),
        'w_o_moba': nrm(ks[18], (L, MOBA_WIDTH, D), MOBA_WIDTH ** -0.5),
        'w_out': nrm(ks[19], (L, D, D), D ** -0.5),
        'norm_xattn': gain(ks[20], (L, D)),
        'w_q_x': nrm(ks[21], (L, D, XATTN_WIDTH), D ** -0.5),
        'w_kv_x': nrm(ks[22], (L, D, 2 * XATTN_WIDTH), D ** -0.5),
        'w_o_x': nrm(ks[23], (L, XATTN_WIDTH, D), XATTN_WIDTH ** -0.5),
        'norm_ffn': gain(ks[24], (L, D)),
        'w_router_group': nrm(ks[25], (L, D, N_GROUPS), D ** -0.5),
        'w_router_expert': nrm(ks[26], (L, D, N_EXPERTS), D ** -0.5),
        'w_exp_gate': nrm(ks[27], (L, N_EXPERTS, D, D_EXPERT), D ** -0.5),
        'w_exp_up': nrm(ks[28], (L, N_EXPERTS, D, D_EXPERT), D ** -0.5),
        'w_exp_down': nrm(ks[29], (L, N_EXPERTS, D_EXPERT, D), D_EXPERT ** -0.5),
        'norm_final': gain(ks[30], (D,)),
    }


def reference(x, mem, rel_bias, mem_norm, norm_mix, w_in, tshift_mu, decay_w0, decay_up, iclr_a0,
              iclr_up, gate_up, k_k, k_a, r_k, ln_x_w, ln_x_b, w_o_rwkv, w_o_moba, w_out,
              norm_xattn, w_q_x, w_kv_x, w_o_x, norm_ffn, w_router_group, w_router_expert,
              w_exp_gate, w_exp_up, w_exp_down, norm_final):
    B, T, _ = x.shape
    mem_n = rmsnorm(mem, mem_norm)
    for l in range(DEPTH):
        h = rmsnorm(x, norm_mix[l])
        u = h @ w_in[l]
        u_rwkv, u_moba, u_gate = jnp.split(u, [RWKV_COLS, RWKV_COLS + 3 * MOBA_WIDTH], axis=-1)
        o_a = rwkv7_mixer(u_rwkv, tshift_mu[l], decay_w0[l], decay_up[l], iclr_a0[l], iclr_up[l],
                          gate_up[l], k_k[l], k_a[l], r_k[l], ln_x_w[l], ln_x_b[l])
        q, k, v = jnp.split(u_moba, 3, axis=-1)
        o_b = moba_attention(q.reshape(B, T, MOBA_HEADS, MOBA_HEAD_DIM),
                             k.reshape(B, T, MOBA_HEADS, MOBA_HEAD_DIM),
                             v.reshape(B, T, MOBA_HEADS, MOBA_HEAD_DIM), rel_bias)
        gate_a, gate_b = jnp.split(u_gate, N_BRANCHES, axis=-1)
        merged = jax.nn.sigmoid(gate_a) * (o_a @ w_o_rwkv[l]) + jax.nn.sigmoid(gate_b) * (o_b @ w_o_moba[l])
        x = x + merged @ w_out[l]
        x = x + memory_cross_attention(rmsnorm(x, norm_xattn[l]), mem_n, w_q_x[l], w_kv_x[l], w_o_x[l])
        x = x + hierarchical_moe(rmsnorm(x, norm_ffn[l]), w_router_group[l], w_router_expert[l],
                                 w_exp_gate[l], w_exp_up[l], w_exp_down[l])
    return rmsnorm(x, norm_final)
```

```cpp
#include <hip/hip_runtime.h>
#include <hip/hip_cooperative_groups.h>
#include <cstdio>
#include <cstdint>
namespace cg = cooperative_groups;

typedef unsigned short bf16_t;
typedef short bf16x8 __attribute__((ext_vector_type(8)));
typedef float f32x4 __attribute__((ext_vector_type(4)));
typedef unsigned u32x4 __attribute__((ext_vector_type(4)));
typedef unsigned u32x2 __attribute__((ext_vector_type(2)));

constexpr int T = 16384, D = 1024, NMEM = 256;
constexpr int RW = 512, RCOLS = 1792, MW = 512, MCOLS = 1536, GCOLS = 2048, INCOLS = 5376;
constexpr int NEXP = 32, DEXP = 512, CAP = 36864, NBLK = 288;
constexpr size_t MiB = 1u << 20;
constexpr size_t OFF_CTL = 0;
constexpr size_t OFF_WIN = 1 * MiB;
constexpr size_t OFF_WORW = OFF_WIN + (size_t)INCOLS * D * 2;
constexpr size_t OFF_WOMB = OFF_WORW + 1 * MiB;
constexpr size_t OFF_WOUT = OFF_WOMB + 1 * MiB;
constexpr size_t OFF_WQ = OFF_WOUT + 2 * MiB;
constexpr size_t OFF_WKV = OFF_WQ + 1 * MiB;
constexpr size_t OFF_WOX = OFF_WKV + 2 * MiB;
constexpr size_t OFF_MEMN = OFF_WOX + 1 * MiB;
constexpr size_t OFF_KVX = OFF_MEMN + MiB / 2;
constexpr size_t OFF_ROUT = OFF_KVX + MiB / 2;
constexpr size_t OFF_XN = 21 * MiB;
constexpr size_t OFF_UG = 53 * MiB;
constexpr size_t OFF_UR = 117 * MiB;
constexpr size_t OFF_UM = 173 * MiB;
constexpr size_t OFF_OA = 221 * MiB;
constexpr size_t OFF_OB = 237 * MiB;
constexpr size_t OFF_MRG = 253 * MiB;
constexpr size_t OFF_EXPGU = 117 * MiB;
constexpr size_t OFF_EXPD = 181 * MiB;
constexpr size_t OFF_YMOE = 21 * MiB;
constexpr size_t WS_NEED = 289 * MiB;
static_assert(OFF_ROUT + MiB / 2 == OFF_XN, "ws map");
constexpr size_t CTL_CNT = 0;
constexpr size_t CTL_BLKE = 4096;
constexpr size_t CTL_KMEAN = 64 * 1024;
constexpr size_t CTL_TOKE = 192 * 1024;
constexpr size_t CTL_TOKG = 320 * 1024;
constexpr size_t CTL_TOKS = 448 * 1024;
constexpr size_t CTL_ROWTOK = 576 * 1024;

struct P {
    const float *x, *mem, *rel_bias, *mem_norm, *norm_mix, *w_in, *tshift_mu, *decay_w0, *decay_up, *iclr_a0, *iclr_up, *gate_up,
        *k_k, *k_a, *r_k, *ln_x_w, *ln_x_b, *w_o_rwkv, *w_o_moba, *w_out, *norm_xattn, *w_q_x, *w_kv_x, *w_o_x, *norm_ffn,
        *w_router_group, *w_router_expert, *w_exp_gate, *w_exp_up, *w_exp_down, *norm_final;
    float* out;
    char* ws;
};

__device__ __forceinline__ float bf2f(bf16_t b) { return __uint_as_float((unsigned)b << 16); }
__device__ __forceinline__ unsigned f2bf(float f) { unsigned u = __float_as_uint(f); return (u + 0x7fffu + ((u >> 16) & 1u)) >> 16; }
__device__ __forceinline__ unsigned pk2(float lo, float hi) { return f2bf(lo) | (f2bf(hi) << 16); }
__device__ __forceinline__ float wave_sum(float v) {
#pragma unroll
    for (int o = 32; o >= 1; o >>= 1) v += __shfl_xor(v, o);
    return v;
}
__device__ __forceinline__ float wave_max(float v) {
#pragma unroll
    for (int o = 32; o >= 1; o >>= 1) v = fmaxf(v, __shfl_xor(v, o));
    return v;
}
__device__ __forceinline__ float sigm(float x) { return 1.f / (1.f + __expf(-x)); }
__device__ __forceinline__ void wave_lds_fence() { asm volatile("s_waitcnt lgkmcnt(0)" ::: "memory"); __builtin_amdgcn_wave_barrier(); }
__device__ __forceinline__ int t5_bucket(int n) {
    if (n < 16) return n;
    int v = 8 + (31 - __clz(n * n));
    return v > 31 ? 31 : v;
}
__device__ __forceinline__ void unpack8(u32x4 w, float* f) {
    f[0] = __uint_as_float(w.x << 16); f[1] = __uint_as_float(w.x & 0xffff0000u);
    f[2] = __uint_as_float(w.y << 16); f[3] = __uint_as_float(w.y & 0xffff0000u);
    f[4] = __uint_as_float(w.z << 16); f[5] = __uint_as_float(w.z & 0xffff0000u);
    f[6] = __uint_as_float(w.w << 16); f[7] = __uint_as_float(w.w & 0xffff0000u);
}

template <bool GATHER>
__device__ __forceinline__ void gemm_k_loop(f32x4 (&acc)[4][4], const bf16_t* A, int lda, const int* rows, int brow,
                                            const bf16_t* Bt, int ldb, int bcol, int K, char* smem) {
    const int tid = threadIdx.x, lane = tid & 63, wid = tid >> 6, wr = wid >> 1, wc = wid & 1, fr = lane & 15, fq = lane >> 4;
    char* SA = smem; char* SB = smem + 8192;
    const int r0 = tid >> 2, c0 = (tid & 3) * 8;
    long ra0, ra1;
    if (GATHER) { ra0 = rows[r0]; ra1 = rows[r0 + 64]; } else { ra0 = brow + r0; ra1 = brow + r0 + 64; }
    const bf16_t* pa0 = A + ra0 * lda + c0; const bf16_t* pa1 = A + ra1 * lda + c0;
    const bf16_t* pb0 = Bt + (long)(bcol + r0) * ldb + c0; const bf16_t* pb1 = pb0 + (long)64 * ldb;
    const int nk = K / 32;
    for (int kt = 0; kt < nk; ++kt) {
        __builtin_amdgcn_global_load_lds((const unsigned*)(pa0 + kt * 32), (unsigned*)(SA + tid * 16), 16, 0, 0);
        __builtin_amdgcn_global_load_lds((const unsigned*)(pa1 + kt * 32), (unsigned*)(SA + tid * 16 + 4096), 16, 0, 0);
        __builtin_amdgcn_global_load_lds((const unsigned*)(pb0 + kt * 32), (unsigned*)(SB + tid * 16), 16, 0, 0);
        __builtin_amdgcn_global_load_lds((const unsigned*)(pb1 + kt * 32), (unsigned*)(SB + tid * 16 + 4096), 16, 0, 0);
        asm volatile("s_waitcnt vmcnt(0)" ::: "memory");
        __syncthreads();
        bf16x8 At[4], Bf[4];
#pragma unroll
        for (int m = 0; m < 4; ++m) At[m] = *(const bf16x8*)(SA + (wr * 64 + m * 16 + fr) * 64 + fq * 16);
#pragma unroll
        for (int n = 0; n < 4; ++n) Bf[n] = *(const bf16x8*)(SB + (wc * 64 + n * 16 + fr) * 64 + fq * 16);
#pragma unroll
        for (int m = 0; m < 4; ++m)
#pragma unroll
            for (int n = 0; n < 4; ++n) acc[m][n] = __builtin_amdgcn_mfma_f32_16x16x32_bf16(Bf[n], At[m], acc[m][n], 0, 0, 0);
        __syncthreads();
    }
}
__device__ __forceinline__ void zero_acc(f32x4 (&acc)[4][4]) {
#pragma unroll
    for (int m = 0; m < 4; ++m)
#pragma unroll
        for (int n = 0; n < 4; ++n) acc[m][n] = (f32x4){0.f, 0.f, 0.f, 0.f};
}
#define TILE_COORDS const int tid = threadIdx.x, lane = tid & 63, wid = tid >> 6, wr = wid >> 1, wc = wid & 1, fr = lane & 15, fq = lane >> 4; (void)wr; (void)wc; (void)fr; (void)fq; (void)lane;

__device__ __forceinline__ void transpose_tile(const float* W, int K, int N, bf16_t* Wt, int rs, int roff, int tile, float* scr  ) {
    const int tid = threadIdx.x;
    const int nnb = N / 64, kb = tile / nnb, nb = tile % nnb, k0 = kb * 64, n0 = nb * 64;
#pragma unroll 4
    for (int i = 0; i < 16; ++i) { const int k = i * 4 + (tid >> 6), n = tid & 63; scr[k * 65 + n] = W[(size_t)(k0 + k) * N + n0 + n]; }
    __syncthreads();
#pragma unroll
    for (int i = 0; i < 2; ++i) {
        const int c = tid + i * 256, n = c >> 3, kc = c & 7;
        const float* s = scr + (kc * 8) * 65 + n;
        u32x4 o; o.x = pk2(s[0], s[65]); o.y = pk2(s[2 * 65], s[3 * 65]); o.z = pk2(s[4 * 65], s[5 * 65]); o.w = pk2(s[6 * 65], s[7 * 65]);
        const int nn = n0 + n, drow = (nn >> 4) * rs + (nn & 15) + roff;
        *(u32x4*)(Wt + (size_t)drow * K + k0 + kc * 8) = o;
    }
    __syncthreads();
}
__device__ __forceinline__ void rms_row_bf16(const float* xrow, const float* g, bf16_t* orow, int lane) {
    const f32x4* xr = (const f32x4*)xrow + lane; const f32x4* gr = (const f32x4*)g + lane;
    f32x4 v[4]; float s = 0.f;
#pragma unroll
    for (int j = 0; j < 4; ++j) { v[j] = xr[64 * j]; s += v[j].x * v[j].x + v[j].y * v[j].y + v[j].z * v[j].z + v[j].w * v[j].w; }
    const float rstd = rsqrtf(wave_sum(s) * (1.f / 1024.f) + 1e-6f);
    u32x2* o8 = (u32x2*)orow + lane;
#pragma unroll
    for (int j = 0; j < 4; ++j) { const f32x4 gg = gr[64 * j]; u32x2 o; o.x = pk2(v[j].x * rstd * gg.x, v[j].y * rstd * gg.y); o.y = pk2(v[j].z * rstd * gg.z, v[j].w * rstd * gg.w); o8[64 * j] = o; }
}

constexpr int P0_T_IN = 16 * 84, P0_T_A = 128, P0_T_B = 256;
constexpr int P0_TR = P0_T_IN + 4 * P0_T_A + 2 * P0_T_B;
constexpr int P0_ROUT = 144, P0_NORM = T / 4, P0_MEM = NMEM / 4;
constexpr int P0_ITEMS = P0_TR + P0_ROUT + P0_NORM + P0_MEM + 1;

__device__ __forceinline__ void phase0(const P& p, int bid, int nb, char* smem) {
    const int tid = threadIdx.x, lane = tid & 63, wid = tid >> 6;
    char* ws = p.ws;
    for (int it = bid; it < P0_ITEMS; it += nb) {
        int r = it;
        if (r < P0_TR) {
            float* scr = (float*)smem;
            if (r < P0_T_IN) { transpose_tile(p.w_in, D, INCOLS, (bf16_t*)(ws + OFF_WIN), 16, 0, r, scr); continue; } r -= P0_T_IN;
            if (r < P0_T_A) { transpose_tile(p.w_o_rwkv, RW, D, (bf16_t*)(ws + OFF_WORW), 16, 0, r, scr); continue; } r -= P0_T_A;
            if (r < P0_T_A) { transpose_tile(p.w_o_moba, MW, D, (bf16_t*)(ws + OFF_WOMB), 16, 0, r, scr); continue; } r -= P0_T_A;
            if (r < P0_T_B) { transpose_tile(p.w_out, D, D, (bf16_t*)(ws + OFF_WOUT), 16, 0, r, scr); continue; } r -= P0_T_B;
            if (r < P0_T_A) { transpose_tile(p.w_q_x, D, 512, (bf16_t*)(ws + OFF_WQ), 16, 0, r, scr); continue; } r -= P0_T_A;
            if (r < P0_T_B) { transpose_tile(p.w_kv_x, D, D, (bf16_t*)(ws + OFF_WKV), 16, 0, r, scr); continue; } r -= P0_T_B;
            transpose_tile(p.w_o_x, 512, D, (bf16_t*)(ws + OFF_WOX), 16, 0, r, scr); continue;
        }
        r -= P0_TR;
        if (r < P0_ROUT) {
            const int e = r * 256 + tid, o = e >> 10, k = e & 1023;
            float* rt = (float*)(ws + OFF_ROUT);
            rt[e] = (o < 32) ? p.w_router_expert[k * 32 + o] : p.w_router_group[k * 4 + (o - 32)];
            continue;
        }
        r -= P0_ROUT;
        if (r < P0_NORM) { const int row = r * 4 + wid; rms_row_bf16(p.x + (size_t)row * D, p.norm_mix, (bf16_t*)(ws + OFF_XN) + (size_t)row * D, lane); continue; }
        r -= P0_NORM;
        if (r < P0_MEM) { const int row = r * 4 + wid; rms_row_bf16(p.mem + (size_t)row * D, p.mem_norm, (bf16_t*)(ws + OFF_MEMN) + (size_t)row * D, lane); continue; }
        if (tid < 64) ((int*)(ws + OFF_CTL + CTL_CNT))[tid] = 0;
    }
}

__device__ __forceinline__ void phase1(const P& p, int bid, int nb, char* smem) {
    TILE_COORDS
    char* ws = p.ws;
    constexpr int NT_U = (T / 128) * 42;
    for (int it = bid; it < NT_U + 16; it += nb) {
        f32x4 acc[4][4]; zero_acc(acc);
        if (it < NT_U) {
            const int pm = it / 42, pn = it % 42;
            gemm_k_loop<false>(acc, (const bf16_t*)(ws + OFF_XN), D, nullptr, pm * 128, (const bf16_t*)(ws + OFF_WIN), D, pn * 128, D, smem);
            const int colt = pn * 128;
            bf16_t* dst; int ld, cb; bool sg = false;
            if (colt < RCOLS) { dst = (bf16_t*)(ws + OFF_UR); ld = RCOLS; cb = colt; }
            else if (colt < RCOLS + MCOLS) { dst = (bf16_t*)(ws + OFF_UM); ld = MCOLS; cb = colt - RCOLS; }
            else { dst = (bf16_t*)(ws + OFF_UG); ld = GCOLS; cb = colt - RCOLS - MCOLS; sg = true; }
#pragma unroll
            for (int m = 0; m < 4; ++m) {
                const int row = pm * 128 + wr * 64 + m * 16 + fr;
#pragma unroll
                for (int n = 0; n < 4; ++n) {
                    f32x4 v = acc[m][n];
                    if (sg) { v.x = sigm(v.x); v.y = sigm(v.y); v.z = sigm(v.z); v.w = sigm(v.w); }
                    u32x2 o; o.x = pk2(v.x, v.y); o.y = pk2(v.z, v.w);
                    *(u32x2*)(dst + (size_t)row * ld + cb + wc * 64 + n * 16 + fq * 4) = o;
                }
            }
        } else {
            const int t2 = it - NT_U, pm = t2 >> 3, pn = t2 & 7;
            gemm_k_loop<false>(acc, (const bf16_t*)(ws + OFF_MEMN), D, nullptr, pm * 128, (const bf16_t*)(ws + OFF_WKV), D, pn * 128, D, smem);
            bf16_t* dst = (bf16_t*)(ws + OFF_KVX);
#pragma unroll
            for (int m = 0; m < 4; ++m) {
                const int row = pm * 128 + wr * 64 + m * 16 + fr;
#pragma unroll
                for (int n = 0; n < 4; ++n) {
                    const f32x4 v = acc[m][n]; u32x2 o; o.x = pk2(v.x, v.y); o.y = pk2(v.z, v.w);
                    *(u32x2*)(dst + (size_t)row * D + pn * 128 + wc * 64 + n * 16 + fq * 4) = o;
                }
            }
        }
    }
}

__device__ __forceinline__ void phase_kmean(const P& p, int bid, int nb, char* smem) {
    const int tid = threadIdx.x;
    const bf16_t* um = (const bf16_t*)(p.ws + OFF_UM);
    float* km = (float*)(p.ws + OFF_CTL + CTL_KMEAN);
    float* red = (float*)smem;
    for (int it = bid; it < 64 * 8; it += nb) {
        const int blk = it >> 3, h = it & 7, q = tid >> 6, d = tid & 63;
        float s = 0.f;
        for (int k = 0; k < 64; ++k) s += bf2f(um[(size_t)(blk * 256 + q * 64 + k) * MCOLS + 512 + h * 64 + d]);
        red[tid] = s;
        __syncthreads();
        if (tid < 64) km[(blk * 8 + h) * 64 + tid] = (red[tid] + red[tid + 64] + red[tid + 128] + red[tid + 192]) * (1.f / 256.f);
        __syncthreads();
    }
}

__device__ __forceinline__ void moba_naive(const P& p, int wave_id, int nwaves, float* ps  ) {
    const int lane = threadIdx.x & 63;
    const bf16_t* um = (const bf16_t*)(p.ws + OFF_UM);
    const float* km = (const float*)(p.ws + OFF_CTL + CTL_KMEAN);
    bf16_t* ob = (bf16_t*)(p.ws + OFF_OB);
    for (int it = wave_id; it < T * 8; it += nwaves) {
        const int t = it >> 3, h = it & 7, qb = t >> 8;
        float q[64];
        {
            const u32x4* qp = (const u32x4*)(um + (size_t)t * MCOLS + h * 64);
#pragma unroll
            for (int c = 0; c < 8; ++c) unpack8(qp[c], q + c * 8);
        }
        float sc = -3.0e38f;
        if (lane < qb) {
            const f32x4* kp = (const f32x4*)(km + (lane * 8 + h) * 64);
            float s = 0.f;
#pragma unroll
            for (int c = 0; c < 16; ++c) { const f32x4 kv = kp[c]; s += q[c * 4] * kv.x + q[c * 4 + 1] * kv.y + q[c * 4 + 2] * kv.z + q[c * 4 + 3] * kv.w; }
            sc = s;
        }
        int sel[4];
#pragma unroll
        for (int s = 0; s < 3; ++s) {
            const float m = wave_max(sc);
            const unsigned long long bal = __ballot(sc == m && m > -1.0e38f);
            const int idx = bal ? (int)__builtin_ctzll(bal) : -1;
            sel[s] = idx;
            if (lane == idx) sc = -3.0e38f;
        }
        sel[3] = qb;
        float lg[4][4];
        float mx = -3.0e38f;
#pragma unroll
        for (int s = 0; s < 4; ++s) {
            const int blk = sel[s];
#pragma unroll
            for (int kk = 0; kk < 4; ++kk) {
                float l = -3.0e38f;
                if (blk >= 0) {
                    const int key = blk * 256 + kk * 64 + lane;
                    const u32x4* kp = (const u32x4*)(um + (size_t)key * MCOLS + 512 + h * 64);
                    float dsum = 0.f;
#pragma unroll
                    for (int c = 0; c < 8; ++c) { float kf[8]; unpack8(kp[c], kf);
#pragma unroll
                        for (int e = 0; e < 8; ++e) dsum += q[c * 8 + e] * kf[e]; }
                    const int rel = t - key;
                    if (rel >= 0) l = dsum * 0.125f + p.rel_bias[t5_bucket(rel) * 8 + h];
                }
                lg[s][kk] = l; mx = fmaxf(mx, l);
            }
        }
        mx = wave_max(mx);
        float sum = 0.f;
#pragma unroll
        for (int s = 0; s < 4; ++s)
#pragma unroll
            for (int kk = 0; kk < 4; ++kk) { const float e = (lg[s][kk] > -1.0e38f) ? __expf(lg[s][kk] - mx) : 0.f; lg[s][kk] = e; sum += e; }
        sum = wave_sum(sum);
        const float inv = 1.f / sum;
#pragma unroll
        for (int s = 0; s < 4; ++s)
#pragma unroll
            for (int kk = 0; kk < 4; ++kk) ps[s * 256 + kk * 64 + lane] = lg[s][kk] * inv;
        wave_lds_fence();
        float o = 0.f;
#pragma unroll
        for (int s = 0; s < 4; ++s) {
            const int blk = sel[s];
            if (blk >= 0) {
                const bf16_t* vp = um + (size_t)(blk * 256) * MCOLS + 1024 + h * 64 + lane;
#pragma unroll 8
                for (int k = 0; k < 256; ++k) o += ps[s * 256 + k] * bf2f(vp[(size_t)k * MCOLS]);
            }
        }
        ob[(size_t)t * 512 + h * 64 + lane] = (bf16_t)f2bf(o);
        wave_lds_fence();
    }
}

__device__ __forceinline__ void rwkv_naive(const P& p, int h, char* smem) {
    const int tid = threadIdx.x, lane = tid & 63, q4 = tid >> 6;
    float* dU = (float*)smem;
    float* iU = dU + 4096;
    float* L = iU + 4096;
    float* RKV = L + 256;
    float* PART = RKV + 192;
    float* VR = PART + 768;
    const bf16_t* ur = (const bf16_t*)(p.ws + OFF_UR);
    bf16_t* oa = (bf16_t*)(p.ws + OFF_OA);
    for (int i = tid; i < 4096; i += 256) { const int r = i >> 6, c = i & 63; dU[i] = p.decay_up[r * 512 + h * 64 + c]; iU[i] = p.iclr_up[r * 512 + h * 64 + c]; }
    const int hj = h * 64 + lane;
    const float w0 = p.decay_w0[hj], a0 = p.iclr_a0[hj], kk_w = p.k_k[hj], ka_w = p.k_a[hj], rk_w = p.r_k[hj], lnw = p.ln_x_w[hj], lnb = p.ln_x_b[hj];
    float S[16];
#pragma unroll
    for (int i = 0; i < 16; ++i) S[i] = 0.f;
    const int vi = tid >> 2, kq = tid & 3;
    __syncthreads();
    for (int t = 0; t < T; ++t) {
        {
            const int col = 1536 + tid;
            const float cur = bf2f(ur[(size_t)t * RCOLS + col]);
            const float prv = t ? bf2f(ur[(size_t)(t - 1) * RCOLS + col]) : 0.f;
            const float xs = cur + p.tshift_mu[col] * (prv - cur);
            L[tid] = tid < 64 ? tanhf(xs) : (tid < 128 ? xs : sigm(xs));
            if (tid < 192) {
                const int c2 = q4 * 512 + h * 64 + lane;
                const float cu = bf2f(ur[(size_t)t * RCOLS + c2]);
                const float pv = t ? bf2f(ur[(size_t)(t - 1) * RCOLS + c2]) : 0.f;
                RKV[tid] = cu + p.tshift_mu[c2] * (pv - cu);
            }
        }
        __syncthreads();
        {
            float pd = 0.f, pa = 0.f, pg = 0.f;
#pragma unroll
            for (int i = 0; i < 16; ++i) { pd += L[q4 * 16 + i] * dU[(q4 * 16 + i) * 64 + lane]; pa += L[64 + q4 * 16 + i] * iU[(q4 * 16 + i) * 64 + lane]; }
#pragma unroll 8
            for (int i = 0; i < 32; ++i) pg += L[128 + q4 * 32 + i] * p.gate_up[(q4 * 32 + i) * 512 + hj];
            PART[q4 * 64 + lane] = pd; PART[256 + q4 * 64 + lane] = pa; PART[512 + q4 * 64 + lane] = pg;
        }
        __syncthreads();
        if (tid < 64) {
            const float wv = w0 + PART[lane] + PART[64 + lane] + PART[128 + lane] + PART[192 + lane];
            const float av = sigm(a0 + PART[256 + lane] + PART[320 + lane] + PART[384 + lane] + PART[448 + lane]);
            const float gv = PART[512 + lane] + PART[576 + lane] + PART[640 + lane] + PART[704 + lane];
            const float wlog = -log1pf(__expf(-wv)) - 0.5f;
            const float dec = __expf(-__expf(wlog));
            const float r = RKV[lane], k = RKV[64 + lane], v = RKV[128 + lane];
            float kk = k * kk_w;
            const float ss = wave_sum(kk * kk);
            kk *= rsqrtf(ss + 1e-12f);
            const float k2 = k * (1.f + (av - 1.f) * ka_w);
            const float rk = wave_sum(r * k2 * rk_w);
            VR[lane] = r; VR[64 + lane] = dec; VR[128 + lane] = k2; VR[192 + lane] = v; VR[256 + lane] = -kk; VR[320 + lane] = kk * av;
            VR[384 + lane] = gv; VR[448 + lane] = rk * v;
        }
        __syncthreads();
        {
            float sa = 0.f;
#pragma unroll
            for (int i = 0; i < 16; ++i) sa += S[i] * VR[256 + kq * 16 + i];
            sa += __shfl_xor(sa, 1); sa += __shfl_xor(sa, 2);
            const float vv = VR[192 + vi];
            float y = 0.f;
#pragma unroll
            for (int i = 0; i < 16; ++i) { const int k = kq * 16 + i; S[i] = S[i] * VR[64 + k] + sa * VR[320 + k] + vv * VR[128 + k]; y += S[i] * VR[k]; }
            y += __shfl_xor(y, 1); y += __shfl_xor(y, 2);
            if (kq == 0) VR[512 + vi] = y;
        }
        __syncthreads();
        if (tid < 64) {
            const float y = VR[512 + lane];
            const float mean = wave_sum(y) * (1.f / 64.f);
            const float d = y - mean;
            const float var = wave_sum(d * d) * (1.f / 64.f);
            const float yn = d * rsqrtf(var + 64e-5f) * lnw + lnb;
            oa[(size_t)t * 512 + hj] = (bf16_t)f2bf((yn + VR[448 + lane]) * VR[384 + lane]);
        }
    }
}

__device__ __forceinline__ void phase_merge(const P& p, int bid, int nb, char* smem) {
    TILE_COORDS
    char* ws = p.ws;
    const bf16_t* ug = (const bf16_t*)(ws + OFF_UG);
    bf16_t* mg = (bf16_t*)(ws + OFF_MRG);
    for (int it = bid; it < 128 * 8; it += nb) {
        const int pm = it >> 3, pn = it & 7;
        f32x4 acc[4][4], acc2[4][4]; zero_acc(acc); zero_acc(acc2);
        gemm_k_loop<false>(acc, (const bf16_t*)(ws + OFF_OA), 512, nullptr, pm * 128, (const bf16_t*)(ws + OFF_WORW), 512, pn * 128, 512, smem);
        gemm_k_loop<false>(acc2, (const bf16_t*)(ws + OFF_OB), 512, nullptr, pm * 128, (const bf16_t*)(ws + OFF_WOMB), 512, pn * 128, 512, smem);
#pragma unroll
        for (int m = 0; m < 4; ++m) {
            const int row = pm * 128 + wr * 64 + m * 16 + fr;
#pragma unroll
            for (int n = 0; n < 4; ++n) {
                const int col = pn * 128 + wc * 64 + n * 16 + fq * 4;
                const u32x2 ga = *(const u32x2*)(ug + (size_t)row * GCOLS + col);
                const u32x2 gb = *(const u32x2*)(ug + (size_t)row * GCOLS + 1024 + col);
                const f32x4 a = acc[m][n], b = acc2[m][n];
                const float r0 = __uint_as_float(ga.x << 16) * a.x + __uint_as_float(gb.x << 16) * b.x;
                const float r1 = __uint_as_float(ga.x & 0xffff0000u) * a.y + __uint_as_float(gb.x & 0xffff0000u) * b.y;
                const float r2 = __uint_as_float(ga.y << 16) * a.z + __uint_as_float(gb.y << 16) * b.z;
                const float r3 = __uint_as_float(ga.y & 0xffff0000u) * a.w + __uint_as_float(gb.y & 0xffff0000u) * b.w;
                u32x2 o; o.x = pk2(r0, r1); o.y = pk2(r2, r3);
                *(u32x2*)(mg + (size_t)row * D + col) = o;
            }
        }
    }
}

__device__ __forceinline__ void phase_resid_gemm(const bf16_t* A, int K, const bf16_t* Bt, const float* res, float* dst, int bid, int nb, char* smem) {
    TILE_COORDS
    for (int it = bid; it < 128 * 8; it += nb) {
        const int pm = it >> 3, pn = it & 7;
        f32x4 acc[4][4]; zero_acc(acc);
        gemm_k_loop<false>(acc, A, K, nullptr, pm * 128, Bt, K, pn * 128, K, smem);
#pragma unroll
        for (int m = 0; m < 4; ++m) {
            const int row = pm * 128 + wr * 64 + m * 16 + fr;
#pragma unroll
            for (int n = 0; n < 4; ++n) {
                const size_t off = (size_t)row * D + pn * 128 + wc * 64 + n * 16 + fq * 4;
                const f32x4 r = *(const f32x4*)(res + off);
                *(f32x4*)(dst + off) = r + acc[m][n];
            }
        }
    }
}

__device__ __forceinline__ void phase_norm(const float* src, const float* g, bf16_t* dst, int bid, int nb) {
    const int lane = threadIdx.x & 63, wid = threadIdx.x >> 6;
    for (int it = bid; it < T / 4; it += nb) { const int row = it * 4 + wid; rms_row_bf16(src + (size_t)row * D, g, dst + (size_t)row * D, lane); }
}

__device__ __forceinline__ void phase_expconv(const P& p, int bid, int nb, char* smem) {
    float* scr = (float*)smem;
    bf16_t* gu = (bf16_t*)(p.ws + OFF_EXPGU); bf16_t* dn = (bf16_t*)(p.ws + OFF_EXPD);
    for (int it = bid; it < 3 * 32 * 128; it += nb) {
        const int which = it / 4096, r = it % 4096, e = r >> 7, tile = r & 127;
        if (which == 0) transpose_tile(p.w_exp_gate + (size_t)e * D * DEXP, D, DEXP, gu + (size_t)e * D * D, 32, 0, tile, scr);
        else if (which == 1) transpose_tile(p.w_exp_up + (size_t)e * D * DEXP, D, DEXP, gu + (size_t)e * D * D, 32, 16, tile, scr);
        else transpose_tile(p.w_exp_down + (size_t)e * DEXP * D, DEXP, D, dn + (size_t)e * D * DEXP, 16, 0, tile, scr);
    }
}

__device__ __forceinline__ void phase_qx(const P& p, int bid, int nb, char* smem) {
    TILE_COORDS
    char* ws = p.ws;
    bf16_t* qx = (bf16_t*)(ws + OFF_OA);
    const float sc = 0.08838834764831845f;
    for (int it = bid; it < 128 * 4; it += nb) {
        const int pm = it >> 2, pn = it & 3;
        f32x4 acc[4][4]; zero_acc(acc);
        gemm_k_loop<false>(acc, (const bf16_t*)(ws + OFF_XN), D, nullptr, pm * 128, (const bf16_t*)(ws + OFF_WQ), D, pn * 128, D, smem);
#pragma unroll
        for (int m = 0; m < 4; ++m) {
            const int row = pm * 128 + wr * 64 + m * 16 + fr;
#pragma unroll
            for (int n = 0; n < 4; ++n) {
                const f32x4 v = acc[m][n] * sc; u32x2 o; o.x = pk2(v.x, v.y); o.y = pk2(v.z, v.w);
                *(u32x2*)(qx + (size_t)row * 512 + pn * 128 + wc * 64 + n * 16 + fq * 4) = o;
            }
        }
    }
}

__device__ __forceinline__ void xattn_naive(const P& p, int wave_id, int nwaves, float* wl  ) {
    const int lane = threadIdx.x & 63;
    const bf16_t* qx = (const bf16_t*)(p.ws + OFF_OA);
    const bf16_t* kv = (const bf16_t*)(p.ws + OFF_KVX);
    bf16_t* ox = (bf16_t*)(p.ws + OFF_OB);
    float* qs = wl; float* ps = wl + 128;
    for (int it = wave_id; it < T * 4; it += nwaves) {
        const int t = it >> 2, h = it & 3;
        {
            const unsigned w = *(const unsigned*)(qx + (size_t)t * 512 + h * 128 + lane * 2);
            qs[lane * 2] = __uint_as_float(w << 16); qs[lane * 2 + 1] = __uint_as_float(w & 0xffff0000u);
        }
        wave_lds_fence();
        float lg[4]; float mx = -3.0e38f;
#pragma unroll
        for (int kk = 0; kk < 4; ++kk) {
            const int key = kk * 64 + lane;
            const u32x4* kp = (const u32x4*)(kv + (size_t)key * D + h * 128);
            float dsum = 0.f;
#pragma unroll
            for (int c = 0; c < 16; ++c) { float kf[8]; unpack8(kp[c], kf);
#pragma unroll
                for (int e = 0; e < 8; ++e) dsum += qs[c * 8 + e] * kf[e]; }
            lg[kk] = dsum; mx = fmaxf(mx, dsum);
        }
        mx = wave_max(mx);
        float sum = 0.f;
#pragma unroll
        for (int kk = 0; kk < 4; ++kk) { lg[kk] = __expf(lg[kk] - mx); sum += lg[kk]; }
        sum = wave_sum(sum);
        const float inv = 1.f / sum;
#pragma unroll
        for (int kk = 0; kk < 4; ++kk) ps[kk * 64 + lane] = lg[kk] * inv;
        wave_lds_fence();
        float o0 = 0.f, o1 = 0.f;
        const bf16_t* vp = kv + 512 + h * 128 + lane * 2;
#pragma unroll 8
        for (int k = 0; k < 256; ++k) { const unsigned w = *(const unsigned*)(vp + (size_t)k * D); const float pp = ps[k]; o0 += pp * __uint_as_float(w << 16); o1 += pp * __uint_as_float(w & 0xffff0000u); }
        *(unsigned*)(ox + (size_t)t * 512 + h * 128 + lane * 2) = pk2(o0, o1);
        wave_lds_fence();
    }
}

__device__ __forceinline__ void phase_router(const P& p, int bid, int nb, char* smem) {
    const int tid = threadIdx.x, lane = tid & 63, wid = tid >> 6;
    char* ws = p.ws;
    int* hist = (int*)smem;
    if (tid < 32) hist[tid] = 0;
    __syncthreads();
    const float* x2 = p.out;
    const float* rt = (const float*)(ws + OFF_ROUT);
    bf16_t* xn = (bf16_t*)(ws + OFF_XN);
    int* toke = (int*)(ws + OFF_CTL + CTL_TOKE); float* tokg = (float*)(ws + OFF_CTL + CTL_TOKG);
    int* rowtok = (int*)(ws + OFF_CTL + CTL_ROWTOK);
    for (int i = bid * 256 + tid; i < CAP; i += nb * 256) rowtok[i] = 0;
    for (int it = bid; it < T / 16; it += nb) {
        const int rbase = it * 16 + wid * 4;
        f32x4 hv[4][4];
#pragma unroll
        for (int rr = 0; rr < 4; ++rr) {
            const f32x4* xr = (const f32x4*)(x2 + (size_t)(rbase + rr) * D) + lane; const f32x4* gr = (const f32x4*)p.norm_ffn + lane;
            float s = 0.f;
#pragma unroll
            for (int j = 0; j < 4; ++j) { hv[rr][j] = xr[64 * j]; s += hv[rr][j].x * hv[rr][j].x + hv[rr][j].y * hv[rr][j].y + hv[rr][j].z * hv[rr][j].z + hv[rr][j].w * hv[rr][j].w; }
            const float rstd = rsqrtf(wave_sum(s) * (1.f / 1024.f) + 1e-6f);
            u32x2* o8 = (u32x2*)(xn + (size_t)(rbase + rr) * D) + lane;
#pragma unroll
            for (int j = 0; j < 4; ++j) { const f32x4 gg = gr[64 * j]; hv[rr][j] = hv[rr][j] * rstd * gg; u32x2 o; o.x = pk2(hv[rr][j].x, hv[rr][j].y); o.y = pk2(hv[rr][j].z, hv[rr][j].w); o8[64 * j] = o; }
        }
        float mine[4] = {0.f, 0.f, 0.f, 0.f};
#pragma unroll 4
        for (int o = 0; o < 36; ++o) {
            const f32x4* wr_ = (const f32x4*)(rt + o * 1024) + lane;
            f32x4 w[4];
#pragma unroll
            for (int j = 0; j < 4; ++j) w[j] = wr_[64 * j];
#pragma unroll
            for (int rr = 0; rr < 4; ++rr) {
                float s = 0.f;
#pragma unroll
                for (int j = 0; j < 4; ++j) s += hv[rr][j].x * w[j].x + hv[rr][j].y * w[j].y + hv[rr][j].z * w[j].z + hv[rr][j].w * w[j].w;
                s = wave_sum(s);
                if (lane == o) mine[rr] = s;
            }
        }
#pragma unroll
        for (int rr = 0; rr < 4; ++rr) {
            const float g0 = __shfl(mine[rr], 32), g1 = __shfl(mine[rr], 33), g2 = __shfl(mine[rr], 34), g3 = __shfl(mine[rr], 35);
            int gs = 0; float gm = g0;
            if (g1 > gm) { gm = g1; gs = 1; }
            if (g2 > gm) { gm = g2; gs = 2; }
            if (g3 > gm) { gm = g3; gs = 3; }
            const float gp = 1.f / (__expf(g0 - gm) + __expf(g1 - gm) + __expf(g2 - gm) + __expf(g3 - gm));
            float e[8];
#pragma unroll
            for (int i = 0; i < 8; ++i) e[i] = __shfl(mine[rr], gs * 8 + i);
            int i1 = 0; float v1 = e[0];
#pragma unroll
            for (int i = 1; i < 8; ++i) if (e[i] > v1) { v1 = e[i]; i1 = i; }
            int i2 = -1; float v2 = -3.0e38f;
#pragma unroll
            for (int i = 0; i < 8; ++i) if (i != i1 && e[i] > v2) { v2 = e[i]; i2 = i; }
            const float e2 = __expf(v2 - v1), den = 1.f / (1.f + e2);
            if (lane == 0) {
                const int tok = rbase + rr;
                toke[tok * 2] = gs * 8 + i1; toke[tok * 2 + 1] = gs * 8 + i2;
                tokg[tok * 2] = gp * den; tokg[tok * 2 + 1] = gp * e2 * den;
                atomicAdd(&hist[gs * 8 + i1], 1); atomicAdd(&hist[gs * 8 + i2], 1);
            }
        }
    }
    __syncthreads();
    if (tid < 32 && hist[tid]) atomicAdd((int*)(ws + OFF_CTL + CTL_CNT) + tid, hist[tid]);
}

__device__ __forceinline__ void phase_dispatch(const P& p, int bid, int nb, char* smem) {
    const int tid = threadIdx.x;
    char* ws = p.ws;
    int* pstart = (int*)smem;
    const int* counts = (const int*)(ws + OFF_CTL + CTL_CNT);
    int* cursor = (int*)(ws + OFF_CTL + CTL_CNT) + 32;
    if (tid == 0) { int a = 0; for (int e = 0; e < 32; ++e) { pstart[e] = a; a += (counts[e] + 127) / 128 * 128; } pstart[32] = a; }
    __syncthreads();
    const int* toke = (const int*)(ws + OFF_CTL + CTL_TOKE);
    int* toks = (int*)(ws + OFF_CTL + CTL_TOKS); int* rowtok = (int*)(ws + OFF_CTL + CTL_ROWTOK);
    for (int i = bid * 256 + tid; i < T * 2; i += nb * 256) {
        const int e = toke[i];
        const int pos = pstart[e] + atomicAdd(&cursor[e], 1);
        rowtok[pos] = i >> 1; toks[i] = pos;
    }
    if (bid == 0) {
        int* blke = (int*)(ws + OFF_CTL + CTL_BLKE);
        for (int b = tid; b < NBLK; b += 256) {
            const int r = b * 128; int e = -1;
            if (r < pstart[32]) { e = 0; while (pstart[e + 1] <= r) ++e; }
            blke[b] = e;
        }
    }
}

__device__ __forceinline__ void phase_exp1(const P& p, int bid, int nb, char* smem) {
    TILE_COORDS
    char* ws = p.ws;
    const int* blke = (const int*)(ws + OFF_CTL + CTL_BLKE); const int* rowtok = (const int*)(ws + OFF_CTL + CTL_ROWTOK);
    bf16_t* hid = (bf16_t*)(ws + OFF_MRG);
    for (int it = bid; it < NBLK * 8; it += nb) {
        const int b = it >> 3, pn = it & 7, e = blke[b];
        if (e < 0) continue;
        f32x4 acc[4][4]; zero_acc(acc);
        gemm_k_loop<true>(acc, (const bf16_t*)(ws + OFF_XN), D, rowtok + b * 128, 0, (const bf16_t*)(ws + OFF_EXPGU) + (size_t)e * D * D, D, pn * 128, D, smem);
#pragma unroll
        for (int m = 0; m < 4; ++m) {
            const int row = b * 128 + wr * 64 + m * 16 + fr;
#pragma unroll
            for (int n2 = 0; n2 < 2; ++n2) {
                const f32x4 g = acc[m][n2 * 2], u = acc[m][n2 * 2 + 1];
                const float h0 = g.x * sigm(g.x) * u.x, h1 = g.y * sigm(g.y) * u.y, h2 = g.z * sigm(g.z) * u.z, h3 = g.w * sigm(g.w) * u.w;
                u32x2 o; o.x = pk2(h0, h1); o.y = pk2(h2, h3);
                *(u32x2*)(hid + (size_t)row * DEXP + pn * 64 + wc * 32 + n2 * 16 + fq * 4) = o;
            }
        }
    }
}
__device__ __forceinline__ void phase_exp2(const P& p, int bid, int nb, char* smem) {
    TILE_COORDS
    char* ws = p.ws;
    const int* blke = (const int*)(ws + OFF_CTL + CTL_BLKE);
    bf16_t* ym = (bf16_t*)(ws + OFF_YMOE);
    for (int it = bid; it < NBLK * 8; it += nb) {
        const int b = it >> 3, pn = it & 7, e = blke[b];
        if (e < 0) continue;
        f32x4 acc[4][4]; zero_acc(acc);
        gemm_k_loop<false>(acc, (const bf16_t*)(ws + OFF_MRG), DEXP, nullptr, b * 128, (const bf16_t*)(ws + OFF_EXPD) + (size_t)e * D * DEXP, DEXP, pn * 128, DEXP, smem);
#pragma unroll
        for (int m = 0; m < 4; ++m) {
            const int row = b * 128 + wr * 64 + m * 16 + fr;
#pragma unroll
            for (int n = 0; n < 4; ++n) {
                const f32x4 v = acc[m][n]; u32x2 o; o.x = pk2(v.x, v.y); o.y = pk2(v.z, v.w);
                *(u32x2*)(ym + (size_t)row * D + pn * 128 + wc * 64 + n * 16 + fq * 4) = o;
            }
        }
    }
}
__device__ __forceinline__ void phase_final(const P& p, int bid, int nb) {
    const int lane = threadIdx.x & 63, wid = threadIdx.x >> 6;
    char* ws = p.ws;
    const int* toks = (const int*)(ws + OFF_CTL + CTL_TOKS); const float* tokg = (const float*)(ws + OFF_CTL + CTL_TOKG);
    const bf16_t* ym = (const bf16_t*)(ws + OFF_YMOE);
    for (int it = bid; it < T / 4; it += nb) {
        const int row = it * 4 + wid;
        const int s1 = toks[row * 2], s2 = toks[row * 2 + 1]; const float g1 = tokg[row * 2], g2 = tokg[row * 2 + 1];
        f32x4* xr = (f32x4*)(p.out + (size_t)row * D) + lane; const f32x4* gr = (const f32x4*)p.norm_final + lane;
        const u32x2* y1 = (const u32x2*)(ym + (size_t)s1 * D) + lane; const u32x2* y2 = (const u32x2*)(ym + (size_t)s2 * D) + lane;
        f32x4 v[4]; float s = 0.f;
#pragma unroll
        for (int j = 0; j < 4; ++j) {
            v[j] = xr[64 * j]; const u32x2 a = y1[64 * j], b = y2[64 * j];
            v[j].x += g1 * __uint_as_float(a.x << 16) + g2 * __uint_as_float(b.x << 16);
            v[j].y += g1 * __uint_as_float(a.x & 0xffff0000u) + g2 * __uint_as_float(b.x & 0xffff0000u);
            v[j].z += g1 * __uint_as_float(a.y << 16) + g2 * __uint_as_float(b.y << 16);
            v[j].w += g1 * __uint_as_float(a.y & 0xffff0000u) + g2 * __uint_as_float(b.y & 0xffff0000u);
            s += v[j].x * v[j].x + v[j].y * v[j].y + v[j].z * v[j].z + v[j].w * v[j].w;
        }
        const float rstd = rsqrtf(wave_sum(s) * (1.f / 1024.f) + 1e-6f);
#pragma unroll
        for (int j = 0; j < 4; ++j) xr[64 * j] = v[j] * rstd * gr[64 * j];
    }
}

constexpr int NPHASE = 15;
template <int PH>
__device__ __forceinline__ void run_phase(const P& p, int bid, int nb, char* smem) {
    char* ws = p.ws;
    if (PH == 0) phase0(p, bid, nb, smem);
    else if (PH == 1) phase1(p, bid, nb, smem);
    else if (PH == 2) phase_kmean(p, bid, nb, smem);
    else if (PH == 3) {
        if (bid < 8) rwkv_naive(p, bid, smem);
        else moba_naive(p, (bid - 8) * 4 + (threadIdx.x >> 6), (nb - 8) * 4, (float*)smem + (threadIdx.x >> 6) * 1024);
    }
    else if (PH == 4) phase_merge(p, bid, nb, smem);
    else if (PH == 5) phase_resid_gemm((const bf16_t*)(ws + OFF_MRG), D, (const bf16_t*)(ws + OFF_WOUT), p.x, p.out, bid, nb, smem);
    else if (PH == 6) { phase_norm(p.out, p.norm_xattn, (bf16_t*)(ws + OFF_XN), bid, nb); phase_expconv(p, bid, nb, smem); }
    else if (PH == 7) phase_qx(p, bid, nb, smem);
    else if (PH == 8) xattn_naive(p, bid * 4 + (threadIdx.x >> 6), nb * 4, (float*)smem + (threadIdx.x >> 6) * 384);
    else if (PH == 9) phase_resid_gemm((const bf16_t*)(ws + OFF_OB), 512, (const bf16_t*)(ws + OFF_WOX), p.out, p.out, bid, nb, smem);
    else if (PH == 10) phase_router(p, bid, nb, smem);
    else if (PH == 11) phase_dispatch(p, bid, nb, smem);
    else if (PH == 12) phase_exp1(p, bid, nb, smem);
    else if (PH == 13) phase_exp2(p, bid, nb, smem);
    else if (PH == 14) phase_final(p, bid, nb);
}

constexpr int LDS_BYTES = 49152;
template <int PH>
__global__ void __launch_bounds__(256, 2) phase_kernel(P p) {
    extern __shared__ __attribute__((aligned(16))) char smem[];
    run_phase<PH>(p, blockIdx.x, gridDim.x, smem);
}

__global__ void __launch_bounds__(256, 2) mega_kernel(P p) {
    extern __shared__ __attribute__((aligned(16))) char smem[];
    cg::grid_group grid = cg::this_grid();
    const int bid = blockIdx.x, nb = gridDim.x;
    run_phase<0>(p, bid, nb, smem); grid.sync();
    run_phase<1>(p, bid, nb, smem); grid.sync();
    run_phase<2>(p, bid, nb, smem); grid.sync();
    run_phase<3>(p, bid, nb, smem); grid.sync();
    run_phase<4>(p, bid, nb, smem); grid.sync();
    run_phase<5>(p, bid, nb, smem); grid.sync();
    run_phase<6>(p, bid, nb, smem); grid.sync();
    run_phase<7>(p, bid, nb, smem); grid.sync();
    run_phase<8>(p, bid, nb, smem); grid.sync();
    run_phase<9>(p, bid, nb, smem); grid.sync();
    run_phase<10>(p, bid, nb, smem); grid.sync();
    run_phase<11>(p, bid, nb, smem); grid.sync();
    run_phase<12>(p, bid, nb, smem); grid.sync();
    run_phase<13>(p, bid, nb, smem); grid.sync();
    run_phase<14>(p, bid, nb, smem);
}

extern "C" void kernel_launch(void* const* d_in, const int* in_sizes, int n_in, void* d_out, int out_size, void* d_ws, size_t ws_size, hipStream_t stream) {
    if (n_in != 31 || ws_size < WS_NEED || out_size != T * D) { fprintf(stderr, "kernel_launch: unexpected n_in %d / ws_size %zu / out_size %d\n", n_in, ws_size, out_size); return; }
    static int grid_blocks = 0;
    if (!grid_blocks) {
        int dev = 0, cus = 0, per_cu = 0;
        hipGetDevice(&dev);
        hipDeviceGetAttribute(&cus, hipDeviceAttributeMultiprocessorCount, dev);
        hipOccupancyMaxActiveBlocksPerMultiprocessor(&per_cu, (const void*)mega_kernel, 256, LDS_BYTES);
        if (per_cu > 2) per_cu = 2;
        if (per_cu < 1) { fprintf(stderr, "kernel_launch: occupancy query returned %d\n", per_cu); per_cu = 1; }
        grid_blocks = cus * per_cu;
        fprintf(stderr, "kernel_launch: cus %d per_cu %d grid %d\n", cus, per_cu, grid_blocks);
    }
    P p{};
    const float** f = (const float**)&p;
    for (int i = 0; i < 31; ++i) f[i] = (const float*)d_in[i];
    p.out = (float*)d_out; p.ws = (char*)d_ws;
    void* args[] = {&p};
    hipError_t e = hipLaunchCooperativeKernel((const void*)mega_kernel, dim3(grid_blocks), dim3(256), args, LDS_BYTES, stream);
    if (e != hipSuccess) fprintf(stderr, "cooperative launch failed: %s (grid %d)\n", hipGetErrorString(e), grid_blocks);
}
```

```cpp
#include <hip/hip_runtime.h>
#include <hip/hip_cooperative_groups.h>
#include <cstdio>
#include <cstdint>
namespace cg = cooperative_groups;

typedef unsigned short bf16_t;
typedef short bf16x8 __attribute__((ext_vector_type(8)));
typedef float f32x4 __attribute__((ext_vector_type(4)));
typedef unsigned u32x4 __attribute__((ext_vector_type(4)));
typedef unsigned u32x2 __attribute__((ext_vector_type(2)));

constexpr int T = 16384, D = 1024, NMEM = 256;
constexpr int RW = 512, RCOLS = 1792, MW = 512, MCOLS = 1536, GCOLS = 2048, INCOLS = 5376;
constexpr int NEXP = 32, DEXP = 512, CAP = 36864, NBLK = 288;
constexpr size_t MiB = 1u << 20;
constexpr size_t OFF_CTL = 0;
constexpr size_t OFF_WIN = 1 * MiB;
constexpr size_t OFF_WORW = OFF_WIN + (size_t)INCOLS * D * 2;
constexpr size_t OFF_WOMB = OFF_WORW + 1 * MiB;
constexpr size_t OFF_WOUT = OFF_WOMB + 1 * MiB;
constexpr size_t OFF_WQ = OFF_WOUT + 2 * MiB;
constexpr size_t OFF_WKV = OFF_WQ + 1 * MiB;
constexpr size_t OFF_WOX = OFF_WKV + 2 * MiB;
constexpr size_t OFF_MEMN = OFF_WOX + 1 * MiB;
constexpr size_t OFF_KVX = OFF_MEMN + MiB / 2;
constexpr size_t OFF_ROUT = OFF_KVX + MiB / 2;
constexpr size_t OFF_XN = 21 * MiB;
constexpr size_t OFF_UG = 53 * MiB;
constexpr size_t OFF_UR = 117 * MiB;
constexpr size_t OFF_UM = 173 * MiB;
constexpr size_t OFF_OA = 221 * MiB;
constexpr size_t OFF_OB = 237 * MiB;
constexpr size_t OFF_MRG = 253 * MiB;
constexpr size_t OFF_EXPGU = 117 * MiB;
constexpr size_t OFF_EXPD = 181 * MiB;
constexpr size_t OFF_YMOE = 21 * MiB;
constexpr size_t OFF_LORA_D = OFF_ROUT + 160 * 1024;
constexpr size_t OFF_LORA_I = OFF_LORA_D + 64 * 1024;
constexpr size_t OFF_LORA_G = OFF_LORA_I + 64 * 1024;
constexpr size_t OFF_BON = 21 * MiB;
constexpr size_t OFF_RH = 37 * MiB;
constexpr size_t OFF_MF = 253 * MiB;
constexpr size_t OFF_SF = 269 * MiB;
constexpr size_t WS_NEED = 289 * MiB;
static_assert(OFF_ROUT + MiB / 2 == OFF_XN, "ws map");
constexpr size_t CTL_CNT = 0;
constexpr size_t CTL_BLKE = 4096;
constexpr size_t CTL_KMEAN = 64 * 1024;
constexpr size_t CTL_TOKE = 192 * 1024;
constexpr size_t CTL_TOKG = 320 * 1024;
constexpr size_t CTL_TOKS = 448 * 1024;
constexpr size_t CTL_ROWTOK = 576 * 1024;

struct P {
    const float *x, *mem, *rel_bias, *mem_norm, *norm_mix, *w_in, *tshift_mu, *decay_w0, *decay_up, *iclr_a0, *iclr_up, *gate_up,
        *k_k, *k_a, *r_k, *ln_x_w, *ln_x_b, *w_o_rwkv, *w_o_moba, *w_out, *norm_xattn, *w_q_x, *w_kv_x, *w_o_x, *norm_ffn,
        *w_router_group, *w_router_expert, *w_exp_gate, *w_exp_up, *w_exp_down, *norm_final;
    float* out;
    char* ws;
};

__device__ __forceinline__ int otid() { int t = threadIdx.x; asm volatile("" : "+v"(t)); return t; }
__device__ __forceinline__ float bf2f(bf16_t b) { return __uint_as_float((unsigned)b << 16); }
__device__ __forceinline__ unsigned f2bf(float f) { unsigned u = __float_as_uint(f); return (u + 0x7fffu + ((u >> 16) & 1u)) >> 16; }
__device__ __forceinline__ unsigned pk2(float lo, float hi) { return f2bf(lo) | (f2bf(hi) << 16); }
__device__ __forceinline__ float wave_sum(float v) {
#pragma unroll
    for (int o = 32; o >= 1; o >>= 1) v += __shfl_xor(v, o);
    return v;
}
__device__ __forceinline__ float wave_max(float v) {
#pragma unroll
    for (int o = 32; o >= 1; o >>= 1) v = fmaxf(v, __shfl_xor(v, o));
    return v;
}
__device__ __forceinline__ float sigm(float x) { return 1.f / (1.f + __expf(-x)); }
__device__ __forceinline__ void wave_lds_fence() { asm volatile("s_waitcnt lgkmcnt(0)" ::: "memory"); __builtin_amdgcn_wave_barrier(); }
__device__ __forceinline__ int t5_bucket(int n) {
    if (n < 16) return n;
    int v = 8 + (31 - __clz(n * n));
    return v > 31 ? 31 : v;
}
__device__ __forceinline__ void unpack8(u32x4 w, float* f) {
    f[0] = __uint_as_float(w.x << 16); f[1] = __uint_as_float(w.x & 0xffff0000u);
    f[2] = __uint_as_float(w.y << 16); f[3] = __uint_as_float(w.y & 0xffff0000u);
    f[4] = __uint_as_float(w.z << 16); f[5] = __uint_as_float(w.z & 0xffff0000u);
    f[6] = __uint_as_float(w.w << 16); f[7] = __uint_as_float(w.w & 0xffff0000u);
}

template <bool GATHER>
__device__ __forceinline__ void gemm_k_loop(f32x4 (&acc)[4][4], const bf16_t* A, int lda, const int* rows, int brow,
                                            const bf16_t* Bt, int ldb, int bcol, int K, char* smem) {
    const int tid = otid(), lane = tid & 63, wid = tid >> 6, wr = wid >> 1, wc = wid & 1, fr = lane & 15, fq = lane >> 4;
    char* SA = smem; char* SB = smem + 8192;
    const int r0 = tid >> 2, c0 = (tid & 3) * 8;
    long ra0, ra1;
    if (GATHER) { ra0 = rows[r0]; ra1 = rows[r0 + 64]; } else { ra0 = brow + r0; ra1 = brow + r0 + 64; }
    const bf16_t* pa0 = A + ra0 * lda + c0; const bf16_t* pa1 = A + ra1 * lda + c0;
    const bf16_t* pb0 = Bt + (long)(bcol + r0) * ldb + c0; const bf16_t* pb1 = pb0 + (long)64 * ldb;
    const int nk = K / 32;
    for (int kt = 0; kt < nk; ++kt) {
        __builtin_amdgcn_global_load_lds((const unsigned*)(pa0 + kt * 32), (unsigned*)(SA + tid * 16), 16, 0, 0);
        __builtin_amdgcn_global_load_lds((const unsigned*)(pa1 + kt * 32), (unsigned*)(SA + tid * 16 + 4096), 16, 0, 0);
        __builtin_amdgcn_global_load_lds((const unsigned*)(pb0 + kt * 32), (unsigned*)(SB + tid * 16), 16, 0, 0);
        __builtin_amdgcn_global_load_lds((const unsigned*)(pb1 + kt * 32), (unsigned*)(SB + tid * 16 + 4096), 16, 0, 0);
        asm volatile("s_waitcnt vmcnt(0)" ::: "memory");
        __syncthreads();
        bf16x8 At[4], Bf[4];
#pragma unroll
        for (int m = 0; m < 4; ++m) At[m] = *(const bf16x8*)(SA + (wr * 64 + m * 16 + fr) * 64 + fq * 16);
#pragma unroll
        for (int n = 0; n < 4; ++n) Bf[n] = *(const bf16x8*)(SB + (wc * 64 + n * 16 + fr) * 64 + fq * 16);
#pragma unroll
        for (int m = 0; m < 4; ++m)
#pragma unroll
            for (int n = 0; n < 4; ++n) acc[m][n] = __builtin_amdgcn_mfma_f32_16x16x32_bf16(Bf[n], At[m], acc[m][n], 0, 0, 0);
        __syncthreads();
    }
}
__device__ __forceinline__ void zero_acc(f32x4 (&acc)[4][4]) {
#pragma unroll
    for (int m = 0; m < 4; ++m)
#pragma unroll
        for (int n = 0; n < 4; ++n) acc[m][n] = (f32x4){0.f, 0.f, 0.f, 0.f};
}
#define TILE_COORDS const int tid = otid(), lane = tid & 63, wid = tid >> 6, wr = wid >> 1, wc = wid & 1, fr = lane & 15, fq = lane >> 4; (void)wr; (void)wc; (void)fr; (void)fq; (void)lane;

__device__ __forceinline__ void transpose_tile(const float* W, int K, int N, bf16_t* Wt, int rs, int roff, int tile, float* scr  ) {
    const int tid = otid();
    const int nnb = N / 64, kb = tile / nnb, nb = tile % nnb, k0 = kb * 64, n0 = nb * 64;
#pragma unroll 4
    for (int i = 0; i < 16; ++i) { const int k = i * 4 + (tid >> 6), n = tid & 63; scr[k * 65 + n] = W[(size_t)(k0 + k) * N + n0 + n]; }
    __syncthreads();
#pragma unroll
    for (int i = 0; i < 2; ++i) {
        const int c = tid + i * 256, n = c >> 3, kc = c & 7;
        const float* s = scr + (kc * 8) * 65 + n;
        u32x4 o; o.x = pk2(s[0], s[65]); o.y = pk2(s[2 * 65], s[3 * 65]); o.z = pk2(s[4 * 65], s[5 * 65]); o.w = pk2(s[6 * 65], s[7 * 65]);
        const int nn = n0 + n, drow = (nn >> 4) * rs + (nn & 15) + roff;
        *(u32x4*)(Wt + (size_t)drow * K + k0 + kc * 8) = o;
    }
    __syncthreads();
}
__device__ __forceinline__ void rms_row_bf16(const float* xrow, const float* g, bf16_t* orow, int lane) {
    const f32x4* xr = (const f32x4*)xrow + lane; const f32x4* gr = (const f32x4*)g + lane;
    f32x4 v[4]; float s = 0.f;
#pragma unroll
    for (int j = 0; j < 4; ++j) { v[j] = xr[64 * j]; s += v[j].x * v[j].x + v[j].y * v[j].y + v[j].z * v[j].z + v[j].w * v[j].w; }
    const float rstd = rsqrtf(wave_sum(s) * (1.f / 1024.f) + 1e-6f);
    u32x2* o8 = (u32x2*)orow + lane;
#pragma unroll
    for (int j = 0; j < 4; ++j) { const f32x4 gg = gr[64 * j]; u32x2 o; o.x = pk2(v[j].x * rstd * gg.x, v[j].y * rstd * gg.y); o.y = pk2(v[j].z * rstd * gg.z, v[j].w * rstd * gg.w); o8[64 * j] = o; }
}

constexpr int P0_T_IN = 16 * 84, P0_T_A = 128, P0_T_B = 256;
constexpr int P0_T_L = 8 + 8 + 16;
constexpr int P0_TR = P0_T_IN + 4 * P0_T_A + 2 * P0_T_B + P0_T_L;
constexpr int P0_ROUT = 144, P0_NORM = T / 4, P0_MEM = NMEM / 4;
constexpr int P0_ITEMS = P0_TR + P0_ROUT + P0_NORM + P0_MEM + 1;

__device__ __forceinline__ void phase0(const P& p, int bid, int nb, char* smem) {
    const int tid = otid(), lane = tid & 63, wid = tid >> 6;
    char* ws = p.ws;
    for (int it = bid; it < P0_ITEMS; it += nb) {
        int r = it;
        if (r < P0_TR) {
            float* scr = (float*)smem;
            if (r < P0_T_IN) { transpose_tile(p.w_in, D, INCOLS, (bf16_t*)(ws + OFF_WIN), 16, 0, r, scr); continue; } r -= P0_T_IN;
            if (r < P0_T_A) { transpose_tile(p.w_o_rwkv, RW, D, (bf16_t*)(ws + OFF_WORW), 16, 0, r, scr); continue; } r -= P0_T_A;
            if (r < P0_T_A) { transpose_tile(p.w_o_moba, MW, D, (bf16_t*)(ws + OFF_WOMB), 16, 0, r, scr); continue; } r -= P0_T_A;
            if (r < P0_T_B) { transpose_tile(p.w_out, D, D, (bf16_t*)(ws + OFF_WOUT), 16, 0, r, scr); continue; } r -= P0_T_B;
            if (r < P0_T_A) { transpose_tile(p.w_q_x, D, 512, (bf16_t*)(ws + OFF_WQ), 16, 0, r, scr); continue; } r -= P0_T_A;
            if (r < P0_T_B) { transpose_tile(p.w_kv_x, D, D, (bf16_t*)(ws + OFF_WKV), 16, 0, r, scr); continue; } r -= P0_T_B;
            if (r < P0_T_A) { transpose_tile(p.w_o_x, 512, D, (bf16_t*)(ws + OFF_WOX), 16, 0, r, scr); continue; } r -= P0_T_A;
            if (r < 8) { transpose_tile(p.decay_up, 64, 512, (bf16_t*)(ws + OFF_LORA_D), 16, 0, r, scr); continue; } r -= 8;
            if (r < 8) { transpose_tile(p.iclr_up, 64, 512, (bf16_t*)(ws + OFF_LORA_I), 16, 0, r, scr); continue; } r -= 8;
            transpose_tile(p.gate_up, 128, 512, (bf16_t*)(ws + OFF_LORA_G), 16, 0, r, scr); continue;
        }
        r -= P0_TR;
        if (r < P0_ROUT) {
            const int e = r * 256 + tid, o = e >> 10, k = e & 1023;
            float* rt = (float*)(ws + OFF_ROUT);
            rt[e] = (o < 32) ? p.w_router_expert[k * 32 + o] : p.w_router_group[k * 4 + (o - 32)];
            continue;
        }
        r -= P0_ROUT;
        if (r < P0_NORM) { const int row = r * 4 + wid; rms_row_bf16(p.x + (size_t)row * D, p.norm_mix, (bf16_t*)(ws + OFF_XN) + (size_t)row * D, lane); continue; }
        r -= P0_NORM;
        if (r < P0_MEM) { const int row = r * 4 + wid; rms_row_bf16(p.mem + (size_t)row * D, p.mem_norm, (bf16_t*)(ws + OFF_MEMN) + (size_t)row * D, lane); continue; }
        if (tid < 64) ((int*)(ws + OFF_CTL + CTL_CNT))[tid] = 0;
    }
}

__device__ __forceinline__ void phase1(const P& p, int bid, int nb, char* smem) {
    TILE_COORDS
    char* ws = p.ws;
    constexpr int NT_U = (T / 128) * 42;
    for (int it = bid; it < NT_U + 16; it += nb) {
        f32x4 acc[4][4]; zero_acc(acc);
        if (it < NT_U) {
            const int pm = it / 42, pn = it % 42;
            gemm_k_loop<false>(acc, (const bf16_t*)(ws + OFF_XN), D, nullptr, pm * 128, (const bf16_t*)(ws + OFF_WIN), D, pn * 128, D, smem);
            const int colt = pn * 128;
            bf16_t* dst; int ld, cb; bool sg = false;
            if (colt < RCOLS) { dst = (bf16_t*)(ws + OFF_UR); ld = RCOLS; cb = colt; }
            else if (colt < RCOLS + MCOLS) { dst = (bf16_t*)(ws + OFF_UM); ld = MCOLS; cb = colt - RCOLS; }
            else { dst = (bf16_t*)(ws + OFF_UG); ld = GCOLS; cb = colt - RCOLS - MCOLS; sg = true; }
#pragma unroll
            for (int m = 0; m < 4; ++m) {
                const int row = pm * 128 + wr * 64 + m * 16 + fr;
#pragma unroll
                for (int n = 0; n < 4; ++n) {
                    f32x4 v = acc[m][n];
                    if (sg) { v.x = sigm(v.x); v.y = sigm(v.y); v.z = sigm(v.z); v.w = sigm(v.w); }
                    u32x2 o; o.x = pk2(v.x, v.y); o.y = pk2(v.z, v.w);
                    *(u32x2*)(dst + (size_t)row * ld + cb + wc * 64 + n * 16 + fq * 4) = o;
                }
            }
        } else {
            const int t2 = it - NT_U, pm = t2 >> 3, pn = t2 & 7;
            gemm_k_loop<false>(acc, (const bf16_t*)(ws + OFF_MEMN), D, nullptr, pm * 128, (const bf16_t*)(ws + OFF_WKV), D, pn * 128, D, smem);
            bf16_t* dst = (bf16_t*)(ws + OFF_KVX);
#pragma unroll
            for (int m = 0; m < 4; ++m) {
                const int row = pm * 128 + wr * 64 + m * 16 + fr;
#pragma unroll
                for (int n = 0; n < 4; ++n) {
                    const f32x4 v = acc[m][n]; u32x2 o; o.x = pk2(v.x, v.y); o.y = pk2(v.z, v.w);
                    *(u32x2*)(dst + (size_t)row * D + pn * 128 + wc * 64 + n * 16 + fq * 4) = o;
                }
            }
        }
    }
}

__device__ __forceinline__ void phase_kmean(const P& p, int bid, int nb, char* smem) {
    const int tid = otid();
    const bf16_t* um = (const bf16_t*)(p.ws + OFF_UM);
    float* km = (float*)(p.ws + OFF_CTL + CTL_KMEAN);
    float* red = (float*)smem;
    for (int it = bid; it < 64 * 8; it += nb) {
        const int blk = it >> 3, h = it & 7, q = tid >> 6, d = tid & 63;
        float s = 0.f;
        for (int k = 0; k < 64; ++k) s += bf2f(um[(size_t)(blk * 256 + q * 64 + k) * MCOLS + 512 + h * 64 + d]);
        red[tid] = s;
        __syncthreads();
        if (tid < 64) km[(blk * 8 + h) * 64 + tid] = (red[tid] + red[tid + 64] + red[tid + 128] + red[tid + 192]) * (1.f / 256.f);
        __syncthreads();
    }
}

__device__ __forceinline__ void moba_naive(const P& p, int wave_id, int nwaves, float* ps  ) {
    const int lane = otid() & 63;
    const bf16_t* um = (const bf16_t*)(p.ws + OFF_UM);
    const float* km = (const float*)(p.ws + OFF_CTL + CTL_KMEAN);
    bf16_t* ob = (bf16_t*)(p.ws + OFF_OB);
    for (int it = wave_id; it < T * 8; it += nwaves) {
        const int t = it >> 3, h = it & 7, qb = t >> 8;
        float q[64];
        {
            const u32x4* qp = (const u32x4*)(um + (size_t)t * MCOLS + h * 64);
#pragma unroll
            for (int c = 0; c < 8; ++c) unpack8(qp[c], q + c * 8);
        }
        float sc = -3.0e38f;
        if (lane < qb) {
            const f32x4* kp = (const f32x4*)(km + (lane * 8 + h) * 64);
            float s = 0.f;
#pragma unroll
            for (int c = 0; c < 16; ++c) { const f32x4 kv = kp[c]; s += q[c * 4] * kv.x + q[c * 4 + 1] * kv.y + q[c * 4 + 2] * kv.z + q[c * 4 + 3] * kv.w; }
            sc = s;
        }
        int sel[4];
#pragma unroll
        for (int s = 0; s < 3; ++s) {
            const float m = wave_max(sc);
            const unsigned long long bal = __ballot(sc == m && m > -1.0e38f);
            const int idx = bal ? (int)__builtin_ctzll(bal) : -1;
            sel[s] = idx;
            if (lane == idx) sc = -3.0e38f;
        }
        sel[3] = qb;
        float lg[4][4];
        float mx = -3.0e38f;
#pragma unroll
        for (int s = 0; s < 4; ++s) {
            const int blk = sel[s];
#pragma unroll
            for (int kk = 0; kk < 4; ++kk) {
                float l = -3.0e38f;
                if (blk >= 0) {
                    const int key = blk * 256 + kk * 64 + lane;
                    const u32x4* kp = (const u32x4*)(um + (size_t)key * MCOLS + 512 + h * 64);
                    float dsum = 0.f;
#pragma unroll
                    for (int c = 0; c < 8; ++c) { float kf[8]; unpack8(kp[c], kf);
#pragma unroll
                        for (int e = 0; e < 8; ++e) dsum += q[c * 8 + e] * kf[e]; }
                    const int rel = t - key;
                    if (rel >= 0) l = dsum * 0.125f + p.rel_bias[t5_bucket(rel) * 8 + h];
                }
                lg[s][kk] = l; mx = fmaxf(mx, l);
            }
        }
        mx = wave_max(mx);
        float sum = 0.f;
#pragma unroll
        for (int s = 0; s < 4; ++s)
#pragma unroll
            for (int kk = 0; kk < 4; ++kk) { const float e = (lg[s][kk] > -1.0e38f) ? __expf(lg[s][kk] - mx) : 0.f; lg[s][kk] = e; sum += e; }
        sum = wave_sum(sum);
        const float inv = 1.f / sum;
#pragma unroll
        for (int s = 0; s < 4; ++s)
#pragma unroll
            for (int kk = 0; kk < 4; ++kk) ps[s * 256 + kk * 64 + lane] = lg[s][kk] * inv;
        wave_lds_fence();
        float o = 0.f;
#pragma unroll
        for (int s = 0; s < 4; ++s) {
            const int blk = sel[s];
            if (blk >= 0) {
                const bf16_t* vp = um + (size_t)(blk * 256) * MCOLS + 1024 + h * 64 + lane;
#pragma unroll 8
                for (int k = 0; k < 256; ++k) o += ps[s * 256 + k] * bf2f(vp[(size_t)k * MCOLS]);
            }
        }
        ob[(size_t)t * 512 + h * 64 + lane] = (bf16_t)f2bf(o);
        wave_lds_fence();
    }
}

__device__ __forceinline__ void rwkv_naive(const P& p, int h, char* smem) {
    const int tid = otid(), lane = tid & 63, q4 = tid >> 6;
    float* dU = (float*)smem;
    float* iU = dU + 4096;
    float* L = iU + 4096;
    float* RKV = L + 256;
    float* PART = RKV + 192;
    float* VR = PART + 768;
    const bf16_t* ur = (const bf16_t*)(p.ws + OFF_UR);
    bf16_t* oa = (bf16_t*)(p.ws + OFF_OA);
    for (int i = tid; i < 4096; i += 256) { const int r = i >> 6, c = i & 63; dU[i] = p.decay_up[r * 512 + h * 64 + c]; iU[i] = p.iclr_up[r * 512 + h * 64 + c]; }
    const int hj = h * 64 + lane;
    const float w0 = p.decay_w0[hj], a0 = p.iclr_a0[hj], kk_w = p.k_k[hj], ka_w = p.k_a[hj], rk_w = p.r_k[hj], lnw = p.ln_x_w[hj], lnb = p.ln_x_b[hj];
    float S[16];
#pragma unroll
    for (int i = 0; i < 16; ++i) S[i] = 0.f;
    const int vi = tid >> 2, kq = tid & 3;
    __syncthreads();
    for (int t = 0; t < T; ++t) {
        {
            const int col = 1536 + tid;
            const float cur = bf2f(ur[(size_t)t * RCOLS + col]);
            const float prv = t ? bf2f(ur[(size_t)(t - 1) * RCOLS + col]) : 0.f;
            const float xs = cur + p.tshift_mu[col] * (prv - cur);
            L[tid] = tid < 64 ? tanhf(xs) : (tid < 128 ? xs : sigm(xs));
            if (tid < 192) {
                const int c2 = q4 * 512 + h * 64 + lane;
                const float cu = bf2f(ur[(size_t)t * RCOLS + c2]);
                const float pv = t ? bf2f(ur[(size_t)(t - 1) * RCOLS + c2]) : 0.f;
                RKV[tid] = cu + p.tshift_mu[c2] * (pv - cu);
            }
        }
        __syncthreads();
        {
            float pd = 0.f, pa = 0.f, pg = 0.f;
#pragma unroll
            for (int i = 0; i < 16; ++i) { pd += L[q4 * 16 + i] * dU[(q4 * 16 + i) * 64 + lane]; pa += L[64 + q4 * 16 + i] * iU[(q4 * 16 + i) * 64 + lane]; }
#pragma unroll 8
            for (int i = 0; i < 32; ++i) pg += L[128 + q4 * 32 + i] * p.gate_up[(q4 * 32 + i) * 512 + hj];
            PART[q4 * 64 + lane] = pd; PART[256 + q4 * 64 + lane] = pa; PART[512 + q4 * 64 + lane] = pg;
        }
        __syncthreads();
        if (tid < 64) {
            const float wv = w0 + PART[lane] + PART[64 + lane] + PART[128 + lane] + PART[192 + lane];
            const float av = sigm(a0 + PART[256 + lane] + PART[320 + lane] + PART[384 + lane] + PART[448 + lane]);
            const float gv = PART[512 + lane] + PART[576 + lane] + PART[640 + lane] + PART[704 + lane];
            const float wlog = -log1pf(__expf(-wv)) - 0.5f;
            const float dec = __expf(-__expf(wlog));
            const float r = RKV[lane], k = RKV[64 + lane], v = RKV[128 + lane];
            float kk = k * kk_w;
            const float ss = wave_sum(kk * kk);
            kk *= rsqrtf(ss + 1e-12f);
            const float k2 = k * (1.f + (av - 1.f) * ka_w);
            const float rk = wave_sum(r * k2 * rk_w);
            VR[lane] = r; VR[64 + lane] = dec; VR[128 + lane] = k2; VR[192 + lane] = v; VR[256 + lane] = -kk; VR[320 + lane] = kk * av;
            VR[384 + lane] = gv; VR[448 + lane] = rk * v;
        }
        __syncthreads();
        {
            float sa = 0.f;
#pragma unroll
            for (int i = 0; i < 16; ++i) sa += S[i] * VR[256 + kq * 16 + i];
            sa += __shfl_xor(sa, 1); sa += __shfl_xor(sa, 2);
            const float vv = VR[192 + vi];
            float y = 0.f;
#pragma unroll
            for (int i = 0; i < 16; ++i) { const int k = kq * 16 + i; S[i] = S[i] * VR[64 + k] + sa * VR[320 + k] + vv * VR[128 + k]; y += S[i] * VR[k]; }
            y += __shfl_xor(y, 1); y += __shfl_xor(y, 2);
            if (kq == 0) VR[512 + vi] = y;
        }
        __syncthreads();
        if (tid < 64) {
            const float y = VR[512 + lane];
            const float mean = wave_sum(y) * (1.f / 64.f);
            const float d = y - mean;
            const float var = wave_sum(d * d) * (1.f / 64.f);
            const float yn = d * rsqrtf(var + 64e-5f) * lnw + lnb;
            oa[(size_t)t * 512 + hj] = (bf16_t)f2bf((yn + VR[448 + lane]) * VR[384 + lane]);
        }
    }
}

typedef __bf16 bf16x2_t __attribute__((ext_vector_type(2)));
__device__ __forceinline__ unsigned cvt_pk(float lo, float hi) { typedef float f2_t __attribute__((ext_vector_type(2))); const f2_t v = {lo, hi}; return __builtin_bit_cast(unsigned, __builtin_convertvector(v, bf16x2_t)); }
__device__ __forceinline__ u32x2 pack4(f32x4 v) { u32x2 o; o.x = cvt_pk(v.x, v.y); o.y = cvt_pk(v.z, v.w); return o; }
__device__ __forceinline__ bf16x8 pack8(f32x4 a, f32x4 b) { u32x4 o; o.x = cvt_pk(a.x, a.y); o.y = cvt_pk(a.z, a.w); o.z = cvt_pk(b.x, b.y); o.w = cvt_pk(b.z, b.w); return __builtin_bit_cast(bf16x8, o); }
__device__ __forceinline__ bf16x8 ldperm(const char* rowbase, int ks, int fq) {
    const u32x2 a = *(const u32x2*)(rowbase + (32 * ks + fq * 4) * 2), b = *(const u32x2*)(rowbase + (32 * ks + 16 + fq * 4) * 2);
    u32x4 o; o.x = a.x; o.y = a.y; o.z = b.x; o.w = b.y; return __builtin_bit_cast(bf16x8, o);
}
#define MFMA16(a, b, c) __builtin_amdgcn_mfma_f32_16x16x32_bf16((a), (b), (c), 0, 0, 0)
constexpr int SLOT = 9216, ROWB = 144, LIN_ROWB = 528;
constexpr int L_WL = 0 * SLOT, L_AL = 1 * SLOT, L_LIN = 2 * SLOT, L_AT = 2 * SLOT, L_BT = 3 * SLOT, L_KT = 4 * SLOT, L_RT = 5 * SLOT, L_VT = 6 * SLOT, L_ATT = 7 * SLOT;
constexpr int L_AAB = L_AT, L_AKV = L_BT, L_BBT = L_WL, L_KBT = L_AL;
constexpr int L_WTOT = 8 * SLOT, L_WC = L_WTOT + 1024, RW_LDS = L_WC + 256;

typedef float f32x2 __attribute__((ext_vector_type(2)));
template <int TT> struct SolveRow {
    static __device__ __forceinline__ void run(f32x2 (&x)[32], const char* Lb) {
        f32x2 a0 = {0.f, 0.f}, a1 = {0.f, 0.f};
#pragma unroll
        for (int c8 = 0; c8 <= (TT - 1) / 8; ++c8) {
            const u32x4 lv = *(const u32x4*)(Lb + TT * 144 + c8 * 16);
            f32x2 l0, l1, l2, l3;
            l0.x = __uint_as_float(lv.x << 16); l0.y = __uint_as_float(lv.x & 0xffff0000u);
            l1.x = __uint_as_float(lv.y << 16); l1.y = __uint_as_float(lv.y & 0xffff0000u);
            l2.x = __uint_as_float(lv.z << 16); l2.y = __uint_as_float(lv.z & 0xffff0000u);
            l3.x = __uint_as_float(lv.w << 16); l3.y = __uint_as_float(lv.w & 0xffff0000u);
            a0 = l0 * x[c8 * 4 + 0] + a0; a1 = l1 * x[c8 * 4 + 1] + a1; a0 = l2 * x[c8 * 4 + 2] + a0; a1 = l3 * x[c8 * 4 + 3] + a1;
        }
        a0 = a0 + a1;
        const float r = a0.x + a0.y;
        if (TT & 1) x[TT / 2].y += r; else x[TT / 2].x += r;
        asm volatile("" : "+v"(x[TT / 2]) :: "memory");
        SolveRow<TT + 1>::run(x, Lb);
    }
};
template <> struct SolveRow<64> { static __device__ __forceinline__ void run(f32x2 (&)[32], const char*) {} };

__device__ __forceinline__ void load_shift16(const bf16_t* ur, int row, int col, const float* mu, float* out) {
    const u32x4* cp = (const u32x4*)(ur + (size_t)row * RCOLS + col);
    const u32x4 c0 = cp[0], c1 = cp[1];
    u32x4 p0 = {0u, 0u, 0u, 0u}, p1 = {0u, 0u, 0u, 0u};
    if (row > 0) { const u32x4* pp = (const u32x4*)(ur + (size_t)(row - 1) * RCOLS + col); p0 = pp[0]; p1 = pp[1]; }
    float cf[16], pf[16];
    unpack8(c0, cf); unpack8(c1, cf + 8); unpack8(p0, pf); unpack8(p1, pf + 8);
#pragma unroll
    for (int e = 0; e < 16; ++e) out[e] = cf[e] + mu[col + e] * (pf[e] - cf[e]);
}

__device__ __forceinline__ void phase_rw_chunk(const P& p, int bid, int nb, char* smem) {
    char* ws = p.ws;
    const bf16_t* ur = (const bf16_t*)(ws + OFF_UR);
    bf16_t* G = (bf16_t*)(ws + OFF_OA); bf16_t* BON = (bf16_t*)(ws + OFF_BON); bf16_t* RH = (bf16_t*)(ws + OFF_RH);
    float* YL = p.out; f32x4* NF = (f32x4*)(p.out + (size_t)T * 512);
    u32x4* MF = (u32x4*)(ws + OFF_MF);
    float* wtot = (float*)(smem + L_WTOT); float* WCs = (float*)(smem + L_WC);
    for (int it = bid; it < 2048; it += nb) {
        const int c = it >> 3, h = it & 7;
        const int tid = otid();
        const int lane = tid & 63, w = __builtin_amdgcn_readfirstlane(tid >> 6), fr = lane & 15, fq = lane >> 4;
#pragma unroll 1
        for (int hf = 0; hf < 2; ++hf) {
            u32x4 cur[4], prv[4];
#pragma unroll
            for (int i = 0; i < 4; ++i) {
                const int q = tid + (hf * 4 + i) * 256, t = q >> 5, cc = q & 31, row = c * 64 + t, col = 1536 + cc * 8;
                cur[i] = *(const u32x4*)(ur + (size_t)row * RCOLS + col);
                prv[i] = (u32x4){0u, 0u, 0u, 0u};
                if (row > 0) prv[i] = *(const u32x4*)(ur + (size_t)(row - 1) * RCOLS + col);
            }
#pragma unroll
            for (int i = 0; i < 4; ++i) {
                const int q = tid + (hf * 4 + i) * 256, t = q >> 5, cc = q & 31, col = 1536 + cc * 8;
                float cf[8], pf[8], xs[8];
                unpack8(cur[i], cf); unpack8(prv[i], pf);
#pragma unroll
                for (int e = 0; e < 8; ++e) {
                    const float x = cf[e] + p.tshift_mu[col + e] * (pf[e] - cf[e]);
                    xs[e] = (cc < 8) ? (1.f - 2.f / (1.f + __expf(2.f * x))) : ((cc < 16) ? x : sigm(x));
                }
                u32x4 o; o.x = cvt_pk(xs[0], xs[1]); o.y = cvt_pk(xs[2], xs[3]); o.z = cvt_pk(xs[4], xs[5]); o.w = cvt_pk(xs[6], xs[7]);
                *(u32x4*)(smem + L_LIN + t * LIN_ROWB + cc * 16) = o;
                asm volatile("" ::: "memory");
            }
        }
        __syncthreads();
        {
            const char* lrow = smem + L_LIN + (w * 16 + fr) * LIN_ROWB;
            const bf16_t* dT = (const bf16_t*)(ws + OFF_LORA_D) + (size_t)(h * 64) * 64;
            const bf16_t* iT = (const bf16_t*)(ws + OFF_LORA_I) + (size_t)(h * 64) * 64;
            const bf16_t* gT = (const bf16_t*)(ws + OFF_LORA_G) + (size_t)(h * 64) * 128;
            bf16x8 lb[8];
#pragma unroll
            for (int ks = 0; ks < 8; ++ks) lb[ks] = *(const bf16x8*)(lrow + (ks * 32 + fq * 8) * 2);
#pragma unroll
            for (int jt = 0; jt < 4; ++jt) {
                f32x4 aw = {0.f, 0.f, 0.f, 0.f}, aa = aw, ag = aw;
#pragma unroll
                for (int ks = 0; ks < 2; ++ks) {
                    aw = MFMA16(*(const bf16x8*)(dT + (jt * 16 + fr) * 64 + ks * 32 + fq * 8), lb[ks], aw);
                    aa = MFMA16(*(const bf16x8*)(iT + (jt * 16 + fr) * 64 + ks * 32 + fq * 8), lb[2 + ks], aa);
                }
#pragma unroll
                for (int ks = 0; ks < 4; ++ks) ag = MFMA16(*(const bf16x8*)(gT + (jt * 16 + fr) * 128 + ks * 32 + fq * 8), lb[4 + ks], ag);
                *(u32x2*)(smem + L_WL + (w * 16 + fr) * ROWB + (jt * 16 + fq * 4) * 2) = pack4(aw);
                *(u32x2*)(smem + L_AL + (w * 16 + fr) * ROWB + (jt * 16 + fq * 4) * 2) = pack4(aa);
                *(u32x2*)(G + (size_t)(c * 64 + w * 16 + fr) * 512 + h * 64 + jt * 16 + fq * 4) = pack4(ag);
            }
        }
        __syncthreads();
        {
            const int t = tid >> 2, jq = tid & 3, j0 = jq * 16, hj0 = h * 64 + j0, row = c * 64 + t;
            float ai[16], kk[16], k2[16], rr[16];
            {
                float al[16];
                const u32x4* ap = (const u32x4*)(smem + L_AL + t * ROWB + j0 * 2);
                unpack8(ap[0], al); unpack8(ap[1], al + 8);
#pragma unroll
                for (int e = 0; e < 16; ++e) ai[e] = sigm(p.iclr_a0[hj0 + e] + al[e]);
            }
            float ss = 0.f, rk = 0.f;
            {
                float k[16];
                load_shift16(ur, row, 512 + hj0, p.tshift_mu, k);
#pragma unroll
                for (int e = 0; e < 16; ++e) { kk[e] = k[e] * p.k_k[hj0 + e]; ss += kk[e] * kk[e]; k2[e] = k[e] * (1.f + (ai[e] - 1.f) * p.k_a[hj0 + e]); }
            }
            ss += __shfl_xor(ss, 1); ss += __shfl_xor(ss, 2);
            const float inv = rsqrtf(ss + 1e-12f);
            asm volatile("" ::: "memory");
            load_shift16(ur, row, hj0, p.tshift_mu, rr);
#pragma unroll
            for (int e = 0; e < 16; ++e) rk += rr[e] * k2[e] * p.r_k[hj0 + e];
            rk += __shfl_xor(rk, 1); rk += __shfl_xor(rk, 2);
            asm volatile("" ::: "memory");
            {
                float v[16];
                load_shift16(ur, row, 1024 + hj0, p.tshift_mu, v);
#pragma unroll
                for (int e = 0; e < 16; ++e) *(bf16_t*)(smem + L_VT + (j0 + e) * ROWB + t * 2) = (bf16_t)f2bf(v[e]);
#pragma unroll
                for (int hh = 0; hh < 2; ++hh) {
                    u32x4 o; o.x = cvt_pk(rk * v[hh * 8], rk * v[hh * 8 + 1]); o.y = cvt_pk(rk * v[hh * 8 + 2], rk * v[hh * 8 + 3]); o.z = cvt_pk(rk * v[hh * 8 + 4], rk * v[hh * 8 + 5]); o.w = cvt_pk(rk * v[hh * 8 + 6], rk * v[hh * 8 + 7]);
                    *(u32x4*)(BON + (size_t)row * 512 + hj0 + hh * 8) = o;
                }
            }
            asm volatile("" ::: "memory");
            float lw[16], cum[16];
            {
                float wl[16];
                const u32x4* wp = (const u32x4*)(smem + L_WL + t * ROWB + j0 * 2);
                unpack8(wp[0], wl); unpack8(wp[1], wl + 8);
#pragma unroll
                for (int e = 0; e < 16; ++e) { const float wv = p.decay_w0[hj0 + e] + wl[e]; lw[e] = -__expf(-log1pf(__expf(-wv)) - 0.5f); }
            }
#pragma unroll
            for (int e = 0; e < 16; ++e) {
                float x = lw[e];
#pragma unroll
                for (int d = 4; d < 64; d <<= 1) { const float y = __shfl_up(x, d); if (lane >= d) x += y; }
                cum[e] = x;
            }
            if ((lane >> 2) == 15) {
#pragma unroll
                for (int e = 0; e < 16; ++e) wtot[w * 64 + j0 + e] = cum[e];
            }
            __syncthreads();
#pragma unroll
            for (int hh = 0; hh < 2; ++hh) {
                float at[8], bt[8], kt[8], rt[8];
#pragma unroll
                for (int e8 = 0; e8 < 8; ++e8) {
                    const int e = hh * 8 + e8;
                    const float t0 = wtot[j0 + e], t1 = wtot[64 + j0 + e], t2 = wtot[128 + j0 + e], t3 = wtot[192 + j0 + e];
                    const float cm = cum[e] + ((w > 0 ? t0 : 0.f) + (w > 1 ? t1 : 0.f) + (w > 2 ? t2 : 0.f));
                    const float tt = (t0 + t1) + (t2 + t3);
                    if (t == 63) WCs[j0 + e] = __expf(tt);
                    const float kn = kk[e] * inv;
                    const float E = __expf(cm), Ei = 1.f / E, Ex = __expf(cm - lw[e]), Ec = __expf(tt - cm);
                    const float b = kn * ai[e];
                    at[e8] = -kn * Ex; bt[e8] = b * Ei; kt[e8] = k2[e] * Ei; rt[e8] = rr[e] * E;
                    *(bf16_t*)(smem + L_BBT + (j0 + e) * ROWB + t * 2) = (bf16_t)f2bf(b * Ec);
                    *(bf16_t*)(smem + L_KBT + (j0 + e) * ROWB + t * 2) = (bf16_t)f2bf(k2[e] * Ec);
                    *(bf16_t*)(smem + L_ATT + (j0 + e) * ROWB + t * 2) = (bf16_t)f2bf(at[e8]);
                }
                u32x4 o;
                o.x = cvt_pk(at[0], at[1]); o.y = cvt_pk(at[2], at[3]); o.z = cvt_pk(at[4], at[5]); o.w = cvt_pk(at[6], at[7]);
                *(u32x4*)(smem + L_AT + t * ROWB + (j0 + hh * 8) * 2) = o;
                o.x = cvt_pk(bt[0], bt[1]); o.y = cvt_pk(bt[2], bt[3]); o.z = cvt_pk(bt[4], bt[5]); o.w = cvt_pk(bt[6], bt[7]);
                *(u32x4*)(smem + L_BT + t * ROWB + (j0 + hh * 8) * 2) = o;
                o.x = cvt_pk(kt[0], kt[1]); o.y = cvt_pk(kt[2], kt[3]); o.z = cvt_pk(kt[4], kt[5]); o.w = cvt_pk(kt[6], kt[7]);
                *(u32x4*)(smem + L_KT + t * ROWB + (j0 + hh * 8) * 2) = o;
                o.x = cvt_pk(rt[0], rt[1]); o.y = cvt_pk(rt[2], rt[3]); o.z = cvt_pk(rt[4], rt[5]); o.w = cvt_pk(rt[6], rt[7]);
                *(u32x4*)(smem + L_RT + t * ROWB + (j0 + hh * 8) * 2) = o;
            }
        }
        __syncthreads();
        bf16x8 frb[2], frk[2];
        {
            const int tid2 = otid(), lane = tid2 & 63, fr = lane & 15, fq = lane >> 4;
            bf16x8 xa[2], xr[2];
#pragma unroll
            for (int ks = 0; ks < 2; ++ks) {
                xa[ks] = *(const bf16x8*)(smem + L_AT + (w * 16 + fr) * ROWB + (ks * 32 + fq * 8) * 2);
                xr[ks] = *(const bf16x8*)(smem + L_RT + (w * 16 + fr) * ROWB + (ks * 32 + fq * 8) * 2);
            }
            f32x4 aab[4], aak[4], arb[4], ark[4];
            const int tq = w * 16 + fr;
#pragma unroll
            for (int n = 0; n < 4; ++n) {
                f32x4 dab = {0.f, 0.f, 0.f, 0.f}, dak = dab, drb = dab, drk = dab;
                if (n <= w) {
#pragma unroll
                    for (int ks = 0; ks < 2; ++ks) {
                        const bf16x8 yb = *(const bf16x8*)(smem + L_BT + (n * 16 + fr) * ROWB + (ks * 32 + fq * 8) * 2);
                        const bf16x8 yk = *(const bf16x8*)(smem + L_KT + (n * 16 + fr) * ROWB + (ks * 32 + fq * 8) * 2);
                        dab = MFMA16(yb, xa[ks], dab); dak = MFMA16(yk, xa[ks], dak); drb = MFMA16(yb, xr[ks], drb); drk = MFMA16(yk, xr[ks], drk);
                    }
#pragma unroll
                    for (int jj = 0; jj < 4; ++jj) {
                        const int sq = n * 16 + fq * 4 + jj;
                        if (!(sq < tq)) { dab[jj] = 0.f; dak[jj] = 0.f; }
                        if (!(sq <= tq)) { drb[jj] = 0.f; drk[jj] = 0.f; }
                    }
                }
                aab[n] = dab; aak[n] = dak; arb[n] = drb; ark[n] = drk;
            }
            __syncthreads();
#pragma unroll
            for (int n = 0; n < 4; ++n) *(u32x2*)(smem + L_AAB + (w * 16 + fr) * ROWB + (n * 16 + fq * 4) * 2) = pack4(aab[n]);
            bf16x8 fak[2];
#pragma unroll
            for (int ks = 0; ks < 2; ++ks) { fak[ks] = pack8(aak[2 * ks], aak[2 * ks + 1]); frb[ks] = pack8(arb[2 * ks], arb[2 * ks + 1]); frk[ks] = pack8(ark[2 * ks], ark[2 * ks + 1]); }
#pragma unroll
            for (int vt = 0; vt < 4; ++vt) {
                f32x4 acc = {0.f, 0.f, 0.f, 0.f};
#pragma unroll
                for (int ks = 0; ks < 2; ++ks) acc = MFMA16(fak[ks], ldperm(smem + L_VT + (vt * 16 + fr) * ROWB, ks, fq), acc);
                *(u32x2*)(smem + L_AKV + (vt * 16 + fr) * ROWB + (w * 16 + fq * 4) * 2) = pack4(acc);
            }
        }
        __syncthreads();
        if (w < 2) {
            char* rowp = smem + (w == 0 ? L_ATT : L_AKV) + (otid() & 63) * ROWB;
            f32x2 x[32];
#pragma unroll
            for (int c8 = 0; c8 < 8; ++c8) {
                const u32x4 xv = *(const u32x4*)(rowp + c8 * 16);
                x[c8 * 4 + 0].x = __uint_as_float(xv.x << 16); x[c8 * 4 + 0].y = __uint_as_float(xv.x & 0xffff0000u);
                x[c8 * 4 + 1].x = __uint_as_float(xv.y << 16); x[c8 * 4 + 1].y = __uint_as_float(xv.y & 0xffff0000u);
                x[c8 * 4 + 2].x = __uint_as_float(xv.z << 16); x[c8 * 4 + 2].y = __uint_as_float(xv.z & 0xffff0000u);
                x[c8 * 4 + 3].x = __uint_as_float(xv.w << 16); x[c8 * 4 + 3].y = __uint_as_float(xv.w & 0xffff0000u);
            }
            SolveRow<1>::run(x, smem + L_AAB);
#pragma unroll
            for (int c8 = 0; c8 < 8; ++c8) {
                u32x4 o; o.x = cvt_pk(x[c8 * 4].x, x[c8 * 4].y); o.y = cvt_pk(x[c8 * 4 + 1].x, x[c8 * 4 + 1].y); o.z = cvt_pk(x[c8 * 4 + 2].x, x[c8 * 4 + 2].y); o.w = cvt_pk(x[c8 * 4 + 3].x, x[c8 * 4 + 3].y);
                *(u32x4*)(rowp + c8 * 16) = o;
            }
        }
        __syncthreads();
        {
            const int tid4 = otid(), lane = tid4 & 63, fr = lane & 15, fq = lane >> 4;
            const int trow = c * 64 + w * 16 + fr;
#pragma unroll
            for (int kt = 0; kt < 4; ++kt) {
                f32x4 acc = {0.f, 0.f, 0.f, 0.f};
#pragma unroll
                for (int ks = 0; ks < 2; ++ks) acc = MFMA16(ldperm(smem + L_ATT + (kt * 16 + fr) * ROWB, ks, fq), frb[ks], acc);
                const u32x2 rr = *(const u32x2*)(smem + L_RT + (w * 16 + fr) * ROWB + (kt * 16 + fq * 4) * 2);
                acc.x += __uint_as_float(rr.x << 16); acc.y += __uint_as_float(rr.x & 0xffff0000u); acc.z += __uint_as_float(rr.y << 16); acc.w += __uint_as_float(rr.y & 0xffff0000u);
                *(u32x2*)(RH + (size_t)trow * 512 + h * 64 + kt * 16 + fq * 4) = pack4(acc);
            }
#pragma unroll
            for (int vt = 0; vt < 4; ++vt) {
                f32x4 acc = {0.f, 0.f, 0.f, 0.f};
#pragma unroll
                for (int ks = 0; ks < 2; ++ks) {
                    acc = MFMA16(ldperm(smem + L_AKV + (vt * 16 + fr) * ROWB, ks, fq), frb[ks], acc);
                    acc = MFMA16(ldperm(smem + L_VT + (vt * 16 + fr) * ROWB, ks, fq), frk[ks], acc);
                }
                *(f32x4*)(YL + (size_t)trow * 512 + h * 64 + vt * 16 + fq * 4) = acc;
            }
            bf16x8 xb[2], xk[2];
#pragma unroll
            for (int ks = 0; ks < 2; ++ks) {
                xb[ks] = *(const bf16x8*)(smem + L_BBT + (w * 16 + fr) * ROWB + (ks * 32 + fq * 8) * 2);
                xk[ks] = *(const bf16x8*)(smem + L_KBT + (w * 16 + fr) * ROWB + (ks * 32 + fq * 8) * 2);
            }
            f32x4 mt[4];
            const float wc = WCs[w * 16 + fr];
#pragma unroll
            for (int n = 0; n < 4; ++n) {
                f32x4 acc = {0.f, 0.f, 0.f, 0.f};
#pragma unroll
                for (int ks = 0; ks < 2; ++ks) acc = MFMA16(*(const bf16x8*)(smem + L_ATT + (n * 16 + fr) * ROWB + (ks * 32 + fq * 8) * 2), xb[ks], acc);
#pragma unroll
                for (int jj = 0; jj < 4; ++jj) if (n * 16 + fq * 4 + jj == w * 16 + fr) acc[jj] += wc;
                mt[n] = acc;
            }
#pragma unroll
            for (int ks = 0; ks < 2; ++ks) MF[((size_t)((c * 8 + h) * 4 + w) * 2 + ks) * 64 + lane] = __builtin_bit_cast(u32x4, pack8(mt[2 * ks], mt[2 * ks + 1]));
#pragma unroll
            for (int vs = 0; vs < 4; ++vs) {
                f32x4 acc = {0.f, 0.f, 0.f, 0.f};
#pragma unroll
                for (int ks = 0; ks < 2; ++ks) {
                    acc = MFMA16(xb[ks], *(const bf16x8*)(smem + L_AKV + (vs * 16 + fr) * ROWB + (ks * 32 + fq * 8) * 2), acc);
                    acc = MFMA16(xk[ks], *(const bf16x8*)(smem + L_VT + (vs * 16 + fr) * ROWB + (ks * 32 + fq * 8) * 2), acc);
                }
                NF[((size_t)((c * 8 + h) * 4 + w) * 4 + vs) * 64 + lane] = acc;
            }
        }
        __syncthreads();
    }
}

__device__ __forceinline__ void rw_scan(const P& p, int h) {
    const int lane = otid() & 63, vs = otid() >> 6;
    const u32x4* MF = (const u32x4*)(p.ws + OFF_MF); const f32x4* NF = (const f32x4*)(p.out + (size_t)T * 512);
    u32x4* SF = (u32x4*)(p.ws + OFF_SF);
    u32x4 st0 = {0u, 0u, 0u, 0u}, st1 = st0;
    u32x4 m[8]; f32x4 n[4];
#pragma unroll
    for (int i = 0; i < 8; ++i) m[i] = MF[((size_t)(h * 4 + (i >> 1)) * 2 + (i & 1)) * 64 + lane];
#pragma unroll
    for (int i = 0; i < 4; ++i) n[i] = NF[((size_t)(h * 4 + i) * 4 + vs) * 64 + lane];
    for (int c = 0; c < 256; ++c) {
        SF[((size_t)((c * 8 + h) * 4 + vs) * 2 + 0) * 64 + lane] = st0;
        SF[((size_t)((c * 8 + h) * 4 + vs) * 2 + 1) * 64 + lane] = st1;
        if (c == 255) break;
        u32x4 m2[8]; f32x4 n2[4];
        const int cn = (c + 1 < 255) ? c + 1 : c;
#pragma unroll
        for (int i = 0; i < 8; ++i) m2[i] = MF[((size_t)((cn * 8 + h) * 4 + (i >> 1)) * 2 + (i & 1)) * 64 + lane];
#pragma unroll
        for (int i = 0; i < 4; ++i) n2[i] = NF[((size_t)((cn * 8 + h) * 4 + i) * 4 + vs) * 64 + lane];
        f32x4 acc[4];
#pragma unroll
        for (int i = 0; i < 4; ++i) {
            acc[i] = MFMA16(__builtin_bit_cast(bf16x8, m[2 * i]), __builtin_bit_cast(bf16x8, st0), n[i]);
            acc[i] = MFMA16(__builtin_bit_cast(bf16x8, m[2 * i + 1]), __builtin_bit_cast(bf16x8, st1), acc[i]);
        }
        st0 = __builtin_bit_cast(u32x4, pack8(acc[0], acc[1])); st1 = __builtin_bit_cast(u32x4, pack8(acc[2], acc[3]));
#pragma unroll
        for (int i = 0; i < 8; ++i) m[i] = m2[i];
#pragma unroll
        for (int i = 0; i < 4; ++i) n[i] = n2[i];
    }
}

__device__ __forceinline__ void phase_rw_out(const P& p, int bid, int nb) {
    const int tid = otid(), lane = tid & 63, w = tid >> 6, fr = lane & 15, fq = lane >> 4;
    char* ws = p.ws;
    bf16_t* OA = (bf16_t*)(ws + OFF_OA); const bf16_t* BON = (const bf16_t*)(ws + OFF_BON); const bf16_t* RH = (const bf16_t*)(ws + OFF_RH);
    const float* YL = p.out; const u32x4* SF = (const u32x4*)(ws + OFF_SF);
    for (int it = bid; it < 2048; it += nb) {
        const int c = it >> 3, h = it & 7, trow = c * 64 + w * 16 + fr;
        const char* rrow = (const char*)(RH + (size_t)trow * 512 + h * 64);
        bf16x8 rf[2]; rf[0] = ldperm(rrow, 0, fq); rf[1] = ldperm(rrow, 1, fq);
        f32x4 acc[4];
#pragma unroll
        for (int vs = 0; vs < 4; ++vs) {
            acc[vs] = *(const f32x4*)(YL + (size_t)trow * 512 + h * 64 + vs * 16 + fq * 4);
#pragma unroll
            for (int ks = 0; ks < 2; ++ks) acc[vs] = MFMA16(__builtin_bit_cast(bf16x8, SF[((size_t)((c * 8 + h) * 4 + vs) * 2 + ks) * 64 + lane]), rf[ks], acc[vs]);
        }
        float s = 0.f;
#pragma unroll
        for (int vs = 0; vs < 4; ++vs) s += (acc[vs].x + acc[vs].y) + (acc[vs].z + acc[vs].w);
        s += __shfl_xor(s, 16); s += __shfl_xor(s, 32);
        const float mean = s * (1.f / 64.f);
        float q = 0.f;
#pragma unroll
        for (int vs = 0; vs < 4; ++vs) { acc[vs] = acc[vs] - mean; q += (acc[vs].x * acc[vs].x + acc[vs].y * acc[vs].y) + (acc[vs].z * acc[vs].z + acc[vs].w * acc[vs].w); }
        q += __shfl_xor(q, 16); q += __shfl_xor(q, 32);
        const float rstd = rsqrtf(q * (1.f / 64.f) + 64e-5f);
#pragma unroll
        for (int vs = 0; vs < 4; ++vs) {
            const int hv = h * 64 + vs * 16 + fq * 4;
            const f32x4 lw = *(const f32x4*)(p.ln_x_w + hv), lb = *(const f32x4*)(p.ln_x_b + hv);
            const u32x2 bo = *(const u32x2*)(BON + (size_t)trow * 512 + hv), gg = *(const u32x2*)(OA + (size_t)trow * 512 + hv);
            f32x4 o = acc[vs] * rstd * lw + lb;
            o.x = (o.x + __uint_as_float(bo.x << 16)) * __uint_as_float(gg.x << 16);
            o.y = (o.y + __uint_as_float(bo.x & 0xffff0000u)) * __uint_as_float(gg.x & 0xffff0000u);
            o.z = (o.z + __uint_as_float(bo.y << 16)) * __uint_as_float(gg.y << 16);
            o.w = (o.w + __uint_as_float(bo.y & 0xffff0000u)) * __uint_as_float(gg.y & 0xffff0000u);
            *(u32x2*)(OA + (size_t)trow * 512 + hv) = pack4(o);
        }
    }
}

__device__ __forceinline__ void phase_merge(const P& p, int bid, int nb, char* smem) {
    TILE_COORDS
    char* ws = p.ws;
    const bf16_t* ug = (const bf16_t*)(ws + OFF_UG);
    bf16_t* mg = (bf16_t*)(ws + OFF_MRG);
    for (int it = bid; it < 128 * 8; it += nb) {
        const int pm = it >> 3, pn = it & 7;
        f32x4 acc[4][4], acc2[4][4]; zero_acc(acc); zero_acc(acc2);
        gemm_k_loop<false>(acc, (const bf16_t*)(ws + OFF_OA), 512, nullptr, pm * 128, (const bf16_t*)(ws + OFF_WORW), 512, pn * 128, 512, smem);
        gemm_k_loop<false>(acc2, (const bf16_t*)(ws + OFF_OB), 512, nullptr, pm * 128, (const bf16_t*)(ws + OFF_WOMB), 512, pn * 128, 512, smem);
#pragma unroll
        for (int m = 0; m < 4; ++m) {
            const int row = pm * 128 + wr * 64 + m * 16 + fr;
#pragma unroll
            for (int n = 0; n < 4; ++n) {
                const int col = pn * 128 + wc * 64 + n * 16 + fq * 4;
                const u32x2 ga = *(const u32x2*)(ug + (size_t)row * GCOLS + col);
                const u32x2 gb = *(const u32x2*)(ug + (size_t)row * GCOLS + 1024 + col);
                const f32x4 a = acc[m][n], b = acc2[m][n];
                const float r0 = __uint_as_float(ga.x << 16) * a.x + __uint_as_float(gb.x << 16) * b.x;
                const float r1 = __uint_as_float(ga.x & 0xffff0000u) * a.y + __uint_as_float(gb.x & 0xffff0000u) * b.y;
                const float r2 = __uint_as_float(ga.y << 16) * a.z + __uint_as_float(gb.y << 16) * b.z;
                const float r3 = __uint_as_float(ga.y & 0xffff0000u) * a.w + __uint_as_float(gb.y & 0xffff0000u) * b.w;
                u32x2 o; o.x = pk2(r0, r1); o.y = pk2(r2, r3);
                *(u32x2*)(mg + (size_t)row * D + col) = o;
            }
        }
    }
}

__device__ __forceinline__ void phase_resid_gemm(const bf16_t* A, int K, const bf16_t* Bt, const float* res, float* dst, int bid, int nb, char* smem) {
    TILE_COORDS
    for (int it = bid; it < 128 * 8; it += nb) {
        const int pm = it >> 3, pn = it & 7;
        f32x4 acc[4][4]; zero_acc(acc);
        gemm_k_loop<false>(acc, A, K, nullptr, pm * 128, Bt, K, pn * 128, K, smem);
#pragma unroll
        for (int m = 0; m < 4; ++m) {
            const int row = pm * 128 + wr * 64 + m * 16 + fr;
#pragma unroll
            for (int n = 0; n < 4; ++n) {
                const size_t off = (size_t)row * D + pn * 128 + wc * 64 + n * 16 + fq * 4;
                const f32x4 r = *(const f32x4*)(res + off);
                *(f32x4*)(dst + off) = r + acc[m][n];
            }
        }
    }
}

__device__ __forceinline__ void phase_norm(const float* src, const float* g, bf16_t* dst, int bid, int nb) {
    const int lane = otid() & 63, wid = otid() >> 6;
    for (int it = bid; it < T / 4; it += nb) { const int row = it * 4 + wid; rms_row_bf16(src + (size_t)row * D, g, dst + (size_t)row * D, lane); }
}

__device__ __forceinline__ void phase_expconv(const P& p, int bid, int nb, char* smem) {
    float* scr = (float*)smem;
    bf16_t* gu = (bf16_t*)(p.ws + OFF_EXPGU); bf16_t* dn = (bf16_t*)(p.ws + OFF_EXPD);
    for (int it = bid; it < 3 * 32 * 128; it += nb) {
        const int which = it / 4096, r = it % 4096, e = r >> 7, tile = r & 127;
        if (which == 0) transpose_tile(p.w_exp_gate + (size_t)e * D * DEXP, D, DEXP, gu + (size_t)e * D * D, 32, 0, tile, scr);
        else if (which == 1) transpose_tile(p.w_exp_up + (size_t)e * D * DEXP, D, DEXP, gu + (size_t)e * D * D, 32, 16, tile, scr);
        else transpose_tile(p.w_exp_down + (size_t)e * DEXP * D, DEXP, D, dn + (size_t)e * D * DEXP, 16, 0, tile, scr);
    }
}

__device__ __forceinline__ void phase_qx(const P& p, int bid, int nb, char* smem) {
    TILE_COORDS
    char* ws = p.ws;
    bf16_t* qx = (bf16_t*)(ws + OFF_OA);
    const float sc = 0.08838834764831845f;
    for (int it = bid; it < 128 * 4; it += nb) {
        const int pm = it >> 2, pn = it & 3;
        f32x4 acc[4][4]; zero_acc(acc);
        gemm_k_loop<false>(acc, (const bf16_t*)(ws + OFF_XN), D, nullptr, pm * 128, (const bf16_t*)(ws + OFF_WQ), D, pn * 128, D, smem);
#pragma unroll
        for (int m = 0; m < 4; ++m) {
            const int row = pm * 128 + wr * 64 + m * 16 + fr;
#pragma unroll
            for (int n = 0; n < 4; ++n) {
                const f32x4 v = acc[m][n] * sc; u32x2 o; o.x = pk2(v.x, v.y); o.y = pk2(v.z, v.w);
                *(u32x2*)(qx + (size_t)row * 512 + pn * 128 + wc * 64 + n * 16 + fq * 4) = o;
            }
        }
    }
}

__device__ __forceinline__ void xattn_naive(const P& p, int wave_id, int nwaves, float* wl  ) {
    const int lane = otid() & 63;
    const bf16_t* qx = (const bf16_t*)(p.ws + OFF_OA);
    const bf16_t* kv = (const bf16_t*)(p.ws + OFF_KVX);
    bf16_t* ox = (bf16_t*)(p.ws + OFF_OB);
    float* qs = wl; float* ps = wl + 128;
    for (int it = wave_id; it < T * 4; it += nwaves) {
        const int t = it >> 2, h = it & 3;
        {
            const unsigned w = *(const unsigned*)(qx + (size_t)t * 512 + h * 128 + lane * 2);
            qs[lane * 2] = __uint_as_float(w << 16); qs[lane * 2 + 1] = __uint_as_float(w & 0xffff0000u);
        }
        wave_lds_fence();
        float lg[4] = {0.f, 0.f, 0.f, 0.f}; float mx = -3.0e38f;
#pragma unroll 1
        for (int c4 = 0; c4 < 4; ++c4) {
            float qv[32];
#pragma unroll
            for (int e = 0; e < 32; ++e) qv[e] = qs[c4 * 32 + e];
#pragma unroll
            for (int kk = 0; kk < 4; ++kk) {
                const int key = kk * 64 + lane;
                const u32x4* kp = (const u32x4*)(kv + (size_t)key * D + h * 128 + c4 * 32);
                float dsum = 0.f;
#pragma unroll
                for (int c = 0; c < 4; ++c) { float kf[8]; unpack8(kp[c], kf);
#pragma unroll
                    for (int e = 0; e < 8; ++e) dsum += qv[c * 8 + e] * kf[e]; }
                lg[kk] += dsum;
            }
            asm volatile("" ::: "memory");
        }
#pragma unroll
        for (int kk = 0; kk < 4; ++kk) mx = fmaxf(mx, lg[kk]);
        mx = wave_max(mx);
        float sum = 0.f;
#pragma unroll
        for (int kk = 0; kk < 4; ++kk) { lg[kk] = __expf(lg[kk] - mx); sum += lg[kk]; }
        sum = wave_sum(sum);
        const float inv = 1.f / sum;
#pragma unroll
        for (int kk = 0; kk < 4; ++kk) ps[kk * 64 + lane] = lg[kk] * inv;
        wave_lds_fence();
        float o0 = 0.f, o1 = 0.f;
        const bf16_t* vp = kv + 512 + h * 128 + lane * 2;
#pragma unroll 8
        for (int k = 0; k < 256; ++k) { const unsigned w = *(const unsigned*)(vp + (size_t)k * D); const float pp = ps[k]; o0 += pp * __uint_as_float(w << 16); o1 += pp * __uint_as_float(w & 0xffff0000u); }
        *(unsigned*)(ox + (size_t)t * 512 + h * 128 + lane * 2) = pk2(o0, o1);
        wave_lds_fence();
    }
}

__device__ __forceinline__ void phase_router(const P& p, int bid, int nb, char* smem) {
    const int tid = otid(), lane = tid & 63, wid = tid >> 6;
    char* ws = p.ws;
    int* hist = (int*)smem;
    if (tid < 32) hist[tid] = 0;
    __syncthreads();
    const float* x2 = p.out;
    const float* rt = (const float*)(ws + OFF_ROUT);
    bf16_t* xn = (bf16_t*)(ws + OFF_XN);
    int* toke = (int*)(ws + OFF_CTL + CTL_TOKE); float* tokg = (float*)(ws + OFF_CTL + CTL_TOKG);
    int* rowtok = (int*)(ws + OFF_CTL + CTL_ROWTOK);
    for (int i = bid * 256 + tid; i < CAP; i += nb * 256) rowtok[i] = 0;
    for (int it = bid; it < T / 16; it += nb) {
        const int rbase = it * 16 + wid * 4;
        f32x4 hv[4][4];
#pragma unroll
        for (int rr = 0; rr < 4; ++rr) {
            const f32x4* xr = (const f32x4*)(x2 + (size_t)(rbase + rr) * D) + lane; const f32x4* gr = (const f32x4*)p.norm_ffn + lane;
            float s = 0.f;
#pragma unroll
            for (int j = 0; j < 4; ++j) { hv[rr][j] = xr[64 * j]; s += hv[rr][j].x * hv[rr][j].x + hv[rr][j].y * hv[rr][j].y + hv[rr][j].z * hv[rr][j].z + hv[rr][j].w * hv[rr][j].w; }
            const float rstd = rsqrtf(wave_sum(s) * (1.f / 1024.f) + 1e-6f);
            u32x2* o8 = (u32x2*)(xn + (size_t)(rbase + rr) * D) + lane;
#pragma unroll
            for (int j = 0; j < 4; ++j) { const f32x4 gg = gr[64 * j]; hv[rr][j] = hv[rr][j] * rstd * gg; u32x2 o; o.x = pk2(hv[rr][j].x, hv[rr][j].y); o.y = pk2(hv[rr][j].z, hv[rr][j].w); o8[64 * j] = o; }
        }
        float mine[4] = {0.f, 0.f, 0.f, 0.f};
#pragma unroll 4
        for (int o = 0; o < 36; ++o) {
            const f32x4* wr_ = (const f32x4*)(rt + o * 1024) + lane;
            f32x4 w[4];
#pragma unroll
            for (int j = 0; j < 4; ++j) w[j] = wr_[64 * j];
#pragma unroll
            for (int rr = 0; rr < 4; ++rr) {
                float s = 0.f;
#pragma unroll
                for (int j = 0; j < 4; ++j) s += hv[rr][j].x * w[j].x + hv[rr][j].y * w[j].y + hv[rr][j].z * w[j].z + hv[rr][j].w * w[j].w;
                s = wave_sum(s);
                if (lane == o) mine[rr] = s;
            }
            asm volatile("" ::: "memory");
        }
#pragma unroll
        for (int rr = 0; rr < 4; ++rr) {
            const float g0 = __shfl(mine[rr], 32), g1 = __shfl(mine[rr], 33), g2 = __shfl(mine[rr], 34), g3 = __shfl(mine[rr], 35);
            int gs = 0; float gm = g0;
            if (g1 > gm) { gm = g1; gs = 1; }
            if (g2 > gm) { gm = g2; gs = 2; }
            if (g3 > gm) { gm = g3; gs = 3; }
            const float gp = 1.f / (__expf(g0 - gm) + __expf(g1 - gm) + __expf(g2 - gm) + __expf(g3 - gm));
            float e[8];
#pragma unroll
            for (int i = 0; i < 8; ++i) e[i] = __shfl(mine[rr], gs * 8 + i);
            int i1 = 0; float v1 = e[0];
#pragma unroll
            for (int i = 1; i < 8; ++i) if (e[i] > v1) { v1 = e[i]; i1 = i; }
            int i2 = -1; float v2 = -3.0e38f;
#pragma unroll
            for (int i = 0; i < 8; ++i) if (i != i1 && e[i] > v2) { v2 = e[i]; i2 = i; }
            const float e2 = __expf(v2 - v1), den = 1.f / (1.f + e2);
            if (lane == 0) {
                const int tok = rbase + rr;
                toke[tok * 2] = gs * 8 + i1; toke[tok * 2 + 1] = gs * 8 + i2;
                tokg[tok * 2] = gp * den; tokg[tok * 2 + 1] = gp * e2 * den;
                atomicAdd(&hist[gs * 8 + i1], 1); atomicAdd(&hist[gs * 8 + i2], 1);
            }
        }
    }
    __syncthreads();
    if (tid < 32 && hist[tid]) atomicAdd((int*)(ws + OFF_CTL + CTL_CNT) + tid, hist[tid]);
}

__device__ __forceinline__ void phase_dispatch(const P& p, int bid, int nb, char* smem) {
    const int tid = otid();
    char* ws = p.ws;
    int* pstart = (int*)smem;
    const int* counts = (const int*)(ws + OFF_CTL + CTL_CNT);
    int* cursor = (int*)(ws + OFF_CTL + CTL_CNT) + 32;
    if (tid == 0) { int a = 0; for (int e = 0; e < 32; ++e) { pstart[e] = a; a += (counts[e] + 127) / 128 * 128; } pstart[32] = a; }
    __syncthreads();
    const int* toke = (const int*)(ws + OFF_CTL + CTL_TOKE);
    int* toks = (int*)(ws + OFF_CTL + CTL_TOKS); int* rowtok = (int*)(ws + OFF_CTL + CTL_ROWTOK);
    for (int i = bid * 256 + tid; i < T * 2; i += nb * 256) {
        const int e = toke[i];
        const int pos = pstart[e] + atomicAdd(&cursor[e], 1);
        rowtok[pos] = i >> 1; toks[i] = pos;
    }
    if (bid == 0) {
        int* blke = (int*)(ws + OFF_CTL + CTL_BLKE);
        for (int b = tid; b < NBLK; b += 256) {
            const int r = b * 128; int e = -1;
            if (r < pstart[32]) { e = 0; while (pstart[e + 1] <= r) ++e; }
            blke[b] = e;
        }
    }
}

__device__ __forceinline__ void phase_exp1(const P& p, int bid, int nb, char* smem) {
    TILE_COORDS
    char* ws = p.ws;
    const int* blke = (const int*)(ws + OFF_CTL + CTL_BLKE); const int* rowtok = (const int*)(ws + OFF_CTL + CTL_ROWTOK);
    bf16_t* hid = (bf16_t*)(ws + OFF_MRG);
    for (int it = bid; it < NBLK * 8; it += nb) {
        const int b = it >> 3, pn = it & 7, e = blke[b];
        if (e < 0) continue;
        f32x4 acc[4][4]; zero_acc(acc);
        gemm_k_loop<true>(acc, (const bf16_t*)(ws + OFF_XN), D, rowtok + b * 128, 0, (const bf16_t*)(ws + OFF_EXPGU) + (size_t)e * D * D, D, pn * 128, D, smem);
#pragma unroll
        for (int m = 0; m < 4; ++m) {
            const int row = b * 128 + wr * 64 + m * 16 + fr;
#pragma unroll
            for (int n2 = 0; n2 < 2; ++n2) {
                const f32x4 g = acc[m][n2 * 2], u = acc[m][n2 * 2 + 1];
                const float h0 = g.x * sigm(g.x) * u.x, h1 = g.y * sigm(g.y) * u.y, h2 = g.z * sigm(g.z) * u.z, h3 = g.w * sigm(g.w) * u.w;
                u32x2 o; o.x = pk2(h0, h1); o.y = pk2(h2, h3);
                *(u32x2*)(hid + (size_t)row * DEXP + pn * 64 + wc * 32 + n2 * 16 + fq * 4) = o;
            }
        }
    }
}
__device__ __forceinline__ void phase_exp2(const P& p, int bid, int nb, char* smem) {
    TILE_COORDS
    char* ws = p.ws;
    const int* blke = (const int*)(ws + OFF_CTL + CTL_BLKE);
    bf16_t* ym = (bf16_t*)(ws + OFF_YMOE);
    for (int it = bid; it < NBLK * 8; it += nb) {
        const int b = it >> 3, pn = it & 7, e = blke[b];
        if (e < 0) continue;
        f32x4 acc[4][4]; zero_acc(acc);
        gemm_k_loop<false>(acc, (const bf16_t*)(ws + OFF_MRG), DEXP, nullptr, b * 128, (const bf16_t*)(ws + OFF_EXPD) + (size_t)e * D * DEXP, DEXP, pn * 128, DEXP, smem);
#pragma unroll
        for (int m = 0; m < 4; ++m) {
            const int row = b * 128 + wr * 64 + m * 16 + fr;
#pragma unroll
            for (int n = 0; n < 4; ++n) {
                const f32x4 v = acc[m][n]; u32x2 o; o.x = pk2(v.x, v.y); o.y = pk2(v.z, v.w);
                *(u32x2*)(ym + (size_t)row * D + pn * 128 + wc * 64 + n * 16 + fq * 4) = o;
            }
        }
    }
}
__device__ __forceinline__ void phase_final(const P& p, int bid, int nb) {
    const int lane = otid() & 63, wid = otid() >> 6;
    char* ws = p.ws;
    const int* toks = (const int*)(ws + OFF_CTL + CTL_TOKS); const float* tokg = (const float*)(ws + OFF_CTL + CTL_TOKG);
    const bf16_t* ym = (const bf16_t*)(ws + OFF_YMOE);
    for (int it = bid; it < T / 4; it += nb) {
        const int row = it * 4 + wid;
        const int s1 = toks[row * 2], s2 = toks[row * 2 + 1]; const float g1 = tokg[row * 2], g2 = tokg[row * 2 + 1];
        f32x4* xr = (f32x4*)(p.out + (size_t)row * D) + lane; const f32x4* gr = (const f32x4*)p.norm_final + lane;
        const u32x2* y1 = (const u32x2*)(ym + (size_t)s1 * D) + lane; const u32x2* y2 = (const u32x2*)(ym + (size_t)s2 * D) + lane;
        f32x4 v[4]; float s = 0.f;
#pragma unroll
        for (int j = 0; j < 4; ++j) {
            v[j] = xr[64 * j]; const u32x2 a = y1[64 * j], b = y2[64 * j];
            v[j].x += g1 * __uint_as_float(a.x << 16) + g2 * __uint_as_float(b.x << 16);
            v[j].y += g1 * __uint_as_float(a.x & 0xffff0000u) + g2 * __uint_as_float(b.x & 0xffff0000u);
            v[j].z += g1 * __uint_as_float(a.y << 16) + g2 * __uint_as_float(b.y << 16);
            v[j].w += g1 * __uint_as_float(a.y & 0xffff0000u) + g2 * __uint_as_float(b.y & 0xffff0000u);
            s += v[j].x * v[j].x + v[j].y * v[j].y + v[j].z * v[j].z + v[j].w * v[j].w;
        }
        const float rstd = rsqrtf(wave_sum(s) * (1.f / 1024.f) + 1e-6f);
#pragma unroll
        for (int j = 0; j < 4; ++j) xr[64 * j] = v[j] * rstd * gr[64 * j];
    }
}

constexpr int NPHASE = 16;
template <int PH>
__device__ __forceinline__ void run_phase(const P& p, int bid, int nb, char* smem) {
    char* ws = p.ws;
    if (PH == 0) phase0(p, bid, nb, smem);
    else if (PH == 1) phase1(p, bid, nb, smem);
    else if (PH == 2) { phase_kmean(p, bid, nb, smem); phase_rw_chunk(p, bid, nb, smem); }
    else if (PH == 3) {
        if (bid < 8) rw_scan(p, bid);
        else moba_naive(p, (bid - 8) * 4 + (otid() >> 6), (nb - 8) * 4, (float*)smem + (otid() >> 6) * 1024);
    }
    else if (PH == 4) phase_rw_out(p, bid, nb);
    else if (PH == 5) phase_merge(p, bid, nb, smem);
    else if (PH == 6) phase_resid_gemm((const bf16_t*)(ws + OFF_MRG), D, (const bf16_t*)(ws + OFF_WOUT), p.x, p.out, bid, nb, smem);
    else if (PH == 7) { phase_norm(p.out, p.norm_xattn, (bf16_t*)(ws + OFF_XN), bid, nb); phase_expconv(p, bid, nb, smem); }
    else if (PH == 8) phase_qx(p, bid, nb, smem);
    else if (PH == 9) xattn_naive(p, bid * 4 + (otid() >> 6), nb * 4, (float*)smem + (otid() >> 6) * 384);
    else if (PH == 10) phase_resid_gemm((const bf16_t*)(ws + OFF_OB), 512, (const bf16_t*)(ws + OFF_WOX), p.out, p.out, bid, nb, smem);
    else if (PH == 11) phase_router(p, bid, nb, smem);
    else if (PH == 12) phase_dispatch(p, bid, nb, smem);
    else if (PH == 13) phase_exp1(p, bid, nb, smem);
    else if (PH == 14) phase_exp2(p, bid, nb, smem);
    else if (PH == 15) phase_final(p, bid, nb);
}

constexpr int LDS_BYTES = 75264;
static_assert(RW_LDS <= LDS_BYTES, "lds");
template <int PH>
__global__ void __launch_bounds__(256, 2) phase_kernel(P p) {
    extern __shared__ __attribute__((aligned(16))) char smem[];
    run_phase<PH>(p, blockIdx.x, gridDim.x, smem);
}

#ifndef NO_MEGA
__global__ void __launch_bounds__(256, 2) mega_kernel(P p) {
    extern __shared__ __attribute__((aligned(16))) char smem[];
    cg::grid_group grid = cg::this_grid();
    const int bid = blockIdx.x, nb = gridDim.x;
    run_phase<0>(p, bid, nb, smem); grid.sync();
    run_phase<1>(p, bid, nb, smem); grid.sync();
    run_phase<2>(p, bid, nb, smem); grid.sync();
    run_phase<3>(p, bid, nb, smem); grid.sync();
    run_phase<4>(p, bid, nb, smem); grid.sync();
    run_phase<5>(p, bid, nb, smem); grid.sync();
    run_phase<6>(p, bid, nb, smem); grid.sync();
    run_phase<7>(p, bid, nb, smem); grid.sync();
    run_phase<8>(p, bid, nb, smem); grid.sync();
    run_phase<9>(p, bid, nb, smem); grid.sync();
    run_phase<10>(p, bid, nb, smem); grid.sync();
    run_phase<11>(p, bid, nb, smem); grid.sync();
    run_phase<12>(p, bid, nb, smem); grid.sync();
    run_phase<13>(p, bid, nb, smem); grid.sync();
    run_phase<14>(p, bid, nb, smem); grid.sync();
    run_phase<15>(p, bid, nb, smem);
}

extern "C" void kernel_launch(void* const* d_in, const int* in_sizes, int n_in, void* d_out, int out_size, void* d_ws, size_t ws_size, hipStream_t stream) {
    if (n_in != 31 || ws_size < WS_NEED || out_size != T * D) { fprintf(stderr, "kernel_launch: unexpected n_in %d / ws_size %zu / out_size %d\n", n_in, ws_size, out_size); return; }
    static int grid_blocks = 0;
    if (!grid_blocks) {
        int dev = 0, cus = 0, per_cu = 0;
        hipGetDevice(&dev);
        hipDeviceGetAttribute(&cus, hipDeviceAttributeMultiprocessorCount, dev);
        if (hipFuncSetAttribute((const void*)mega_kernel, hipFuncAttributeMaxDynamicSharedMemorySize, LDS_BYTES) != hipSuccess) fprintf(stderr, "kernel_launch: hipFuncSetAttribute failed\n");
        hipOccupancyMaxActiveBlocksPerMultiprocessor(&per_cu, (const void*)mega_kernel, 256, LDS_BYTES);
        if (per_cu > 2) per_cu = 2;
        if (per_cu < 1) { fprintf(stderr, "kernel_launch: occupancy query returned %d\n", per_cu); per_cu = 1; }
        grid_blocks = cus * per_cu;
        fprintf(stderr, "kernel_launch: cus %d per_cu %d grid %d\n", cus, per_cu, grid_blocks);
    }
    P p{};
    const float** f = (const float**)&p;
    for (int i = 0; i < 31; ++i) f[i] = (const float*)d_in[i];
    p.out = (float*)d_out; p.ws = (char*)d_ws;
    void* args[] = {&p};
    hipError_t e = hipLaunchCooperativeKernel((const void*)mega_kernel, dim3(grid_blocks), dim3(256), args, LDS_BYTES, stream);
    if (e != hipSuccess) fprintf(stderr, "cooperative launch failed: %s (grid %d)\n", hipGetErrorString(e), grid_blocks);
}
#endif
```

```cpp
#include <hip/hip_runtime.h>
#include <hip/hip_cooperative_groups.h>
#include <cstdio>
#include <cstdint>
namespace cg = cooperative_groups;

typedef unsigned short bf16_t;
typedef short bf16x8 __attribute__((ext_vector_type(8)));
typedef float f32x4 __attribute__((ext_vector_type(4)));
typedef unsigned u32x4 __attribute__((ext_vector_type(4)));
typedef unsigned u32x2 __attribute__((ext_vector_type(2)));

constexpr int T = 16384, D = 1024, NMEM = 256;
constexpr int RW = 512, RCOLS = 1792, MW = 512, MCOLS = 1536, GCOLS = 2048, INCOLS = 5376;
constexpr int NEXP = 32, DEXP = 512, CAP = 36864, NBLK = 288;
constexpr size_t MiB = 1u << 20;
constexpr size_t OFF_CTL = 0;
constexpr size_t OFF_WIN = 1 * MiB;
constexpr size_t OFF_WORW = OFF_WIN + (size_t)INCOLS * D * 2;
constexpr size_t OFF_WOMB = OFF_WORW + 1 * MiB;
constexpr size_t OFF_WOUT = OFF_WOMB + 1 * MiB;
constexpr size_t OFF_WQ = OFF_WOUT + 2 * MiB;
constexpr size_t OFF_WKV = OFF_WQ + 1 * MiB;
constexpr size_t OFF_WOX = OFF_WKV + 2 * MiB;
constexpr size_t OFF_MEMN = OFF_WOX + 1 * MiB;
constexpr size_t OFF_KVX = OFF_MEMN + MiB / 2;
constexpr size_t OFF_ROUT = OFF_KVX + MiB / 2;
constexpr size_t OFF_XN = 21 * MiB;
constexpr size_t OFF_UG = 53 * MiB;
constexpr size_t OFF_UR = 117 * MiB;
constexpr size_t OFF_UM = 173 * MiB;
constexpr size_t OFF_OA = 221 * MiB;
constexpr size_t OFF_OB = 237 * MiB;
constexpr size_t OFF_MRG = 253 * MiB;
constexpr size_t OFF_EXPGU = 117 * MiB;
constexpr size_t OFF_EXPD = 181 * MiB;
constexpr size_t OFF_YMOE = 21 * MiB;
constexpr size_t OFF_LORA_D = OFF_ROUT + 160 * 1024;
constexpr size_t OFF_LORA_I = OFF_LORA_D + 64 * 1024;
constexpr size_t OFF_LORA_G = OFF_LORA_I + 64 * 1024;
constexpr size_t OFF_BON = 21 * MiB;
constexpr size_t OFF_RH = 37 * MiB;
constexpr size_t OFF_MF = 253 * MiB;
constexpr size_t OFF_SF = 269 * MiB;
constexpr size_t WS_NEED = 289 * MiB;
static_assert(OFF_ROUT + MiB / 2 == OFF_XN, "ws map");
constexpr size_t CTL_CNT = 0;
constexpr size_t CTL_BLKE = 4096;
constexpr size_t CTL_KMEAN = 64 * 1024;
constexpr size_t CTL_TOKE = 192 * 1024;
constexpr size_t CTL_TOKG = 320 * 1024;
constexpr size_t CTL_TOKS = 448 * 1024;
constexpr size_t CTL_ROWTOK = 576 * 1024;

struct P {
    const float *x, *mem, *rel_bias, *mem_norm, *norm_mix, *w_in, *tshift_mu, *decay_w0, *decay_up, *iclr_a0, *iclr_up, *gate_up,
        *k_k, *k_a, *r_k, *ln_x_w, *ln_x_b, *w_o_rwkv, *w_o_moba, *w_out, *norm_xattn, *w_q_x, *w_kv_x, *w_o_x, *norm_ffn,
        *w_router_group, *w_router_expert, *w_exp_gate, *w_exp_up, *w_exp_down, *norm_final;
    float* out;
    char* ws;
};

__device__ __forceinline__ int otid() { int t = threadIdx.x; asm volatile("" : "+v"(t)); return t; }
__device__ __forceinline__ float bf2f(bf16_t b) { return __uint_as_float((unsigned)b << 16); }
__device__ __forceinline__ unsigned f2bf(float f) { unsigned u = __float_as_uint(f); return (u + 0x7fffu + ((u >> 16) & 1u)) >> 16; }
__device__ __forceinline__ unsigned pk2(float lo, float hi) { return f2bf(lo) | (f2bf(hi) << 16); }
__device__ __forceinline__ float wave_sum(float v) {
#pragma unroll
    for (int o = 32; o >= 1; o >>= 1) v += __shfl_xor(v, o);
    return v;
}
__device__ __forceinline__ float wave_max(float v) {
#pragma unroll
    for (int o = 32; o >= 1; o >>= 1) v = fmaxf(v, __shfl_xor(v, o));
    return v;
}
__device__ __forceinline__ float sigm(float x) { return 1.f / (1.f + __expf(-x)); }
__device__ __forceinline__ void wave_lds_fence() { asm volatile("s_waitcnt lgkmcnt(0)" ::: "memory"); __builtin_amdgcn_wave_barrier(); }
__device__ __forceinline__ int t5_bucket(int n) {
    if (n < 16) return n;
    int v = 8 + (31 - __clz(n * n));
    return v > 31 ? 31 : v;
}
__device__ __forceinline__ void unpack8(u32x4 w, float* f) {
    f[0] = __uint_as_float(w.x << 16); f[1] = __uint_as_float(w.x & 0xffff0000u);
    f[2] = __uint_as_float(w.y << 16); f[3] = __uint_as_float(w.y & 0xffff0000u);
    f[4] = __uint_as_float(w.z << 16); f[5] = __uint_as_float(w.z & 0xffff0000u);
    f[6] = __uint_as_float(w.w << 16); f[7] = __uint_as_float(w.w & 0xffff0000u);
}

template <bool GATHER>
__device__ __forceinline__ void gemm_k_loop(f32x4 (&acc)[4][4], const bf16_t* A, int lda, const int* rows, int brow,
                                            const bf16_t* Bt, int ldb, int bcol, int K, char* smem) {
    const int tid = otid(), lane = tid & 63, wid = tid >> 6, wr = wid >> 1, wc = wid & 1, fr = lane & 15, fq = lane >> 4;
    char* SA = smem; char* SB = smem + 8192;
    const int r0 = tid >> 2, c0 = (tid & 3) * 8;
    long ra0, ra1;
    if (GATHER) { ra0 = rows[r0]; ra1 = rows[r0 + 64]; } else { ra0 = brow + r0; ra1 = brow + r0 + 64; }
    const bf16_t* pa0 = A + ra0 * lda + c0; const bf16_t* pa1 = A + ra1 * lda + c0;
    const bf16_t* pb0 = Bt + (long)(bcol + r0) * ldb + c0; const bf16_t* pb1 = pb0 + (long)64 * ldb;
    const int nk = K / 32;
    for (int kt = 0; kt < nk; ++kt) {
        __builtin_amdgcn_global_load_lds((const unsigned*)(pa0 + kt * 32), (unsigned*)(SA + tid * 16), 16, 0, 0);
        __builtin_amdgcn_global_load_lds((const unsigned*)(pa1 + kt * 32), (unsigned*)(SA + tid * 16 + 4096), 16, 0, 0);
        __builtin_amdgcn_global_load_lds((const unsigned*)(pb0 + kt * 32), (unsigned*)(SB + tid * 16), 16, 0, 0);
        __builtin_amdgcn_global_load_lds((const unsigned*)(pb1 + kt * 32), (unsigned*)(SB + tid * 16 + 4096), 16, 0, 0);
        asm volatile("s_waitcnt vmcnt(0)" ::: "memory");
        __syncthreads();
        bf16x8 At[4], Bf[4];
#pragma unroll
        for (int m = 0; m < 4; ++m) At[m] = *(const bf16x8*)(SA + (wr * 64 + m * 16 + fr) * 64 + fq * 16);
#pragma unroll
        for (int n = 0; n < 4; ++n) Bf[n] = *(const bf16x8*)(SB + (wc * 64 + n * 16 + fr) * 64 + fq * 16);
#pragma unroll
        for (int m = 0; m < 4; ++m)
#pragma unroll
            for (int n = 0; n < 4; ++n) acc[m][n] = __builtin_amdgcn_mfma_f32_16x16x32_bf16(Bf[n], At[m], acc[m][n], 0, 0, 0);
        __syncthreads();
    }
}
__device__ __forceinline__ void zero_acc(f32x4 (&acc)[4][4]) {
#pragma unroll
    for (int m = 0; m < 4; ++m)
#pragma unroll
        for (int n = 0; n < 4; ++n) acc[m][n] = (f32x4){0.f, 0.f, 0.f, 0.f};
}
#define TILE_COORDS const int tid = otid(), lane = tid & 63, wid = tid >> 6, wr = wid >> 1, wc = wid & 1, fr = lane & 15, fq = lane >> 4; (void)wr; (void)wc; (void)fr; (void)fq; (void)lane;

__device__ __forceinline__ void transpose_tile(const float* W, int K, int N, bf16_t* Wt, int rs, int roff, int tile, float* scr  ) {
    const int tid = otid();
    const int nnb = N / 64, kb = tile / nnb, nb = tile % nnb, k0 = kb * 64, n0 = nb * 64;
#pragma unroll 4
    for (int i = 0; i < 16; ++i) { const int k = i * 4 + (tid >> 6), n = tid & 63; scr[k * 65 + n] = W[(size_t)(k0 + k) * N + n0 + n]; }
    __syncthreads();
#pragma unroll
    for (int i = 0; i < 2; ++i) {
        const int c = tid + i * 256, n = c >> 3, kc = c & 7;
        const float* s = scr + (kc * 8) * 65 + n;
        u32x4 o; o.x = pk2(s[0], s[65]); o.y = pk2(s[2 * 65], s[3 * 65]); o.z = pk2(s[4 * 65], s[5 * 65]); o.w = pk2(s[6 * 65], s[7 * 65]);
        const int nn = n0 + n, drow = (nn >> 4) * rs + (nn & 15) + roff;
        *(u32x4*)(Wt + (size_t)drow * K + k0 + kc * 8) = o;
    }
    __syncthreads();
}
__device__ __forceinline__ void rms_row_bf16(const float* xrow, const float* g, bf16_t* orow, int lane) {
    const f32x4* xr = (const f32x4*)xrow + lane; const f32x4* gr = (const f32x4*)g + lane;
    f32x4 v[4]; float s = 0.f;
#pragma unroll
    for (int j = 0; j < 4; ++j) { v[j] = xr[64 * j]; s += v[j].x * v[j].x + v[j].y * v[j].y + v[j].z * v[j].z + v[j].w * v[j].w; }
    const float rstd = rsqrtf(wave_sum(s) * (1.f / 1024.f) + 1e-6f);
    u32x2* o8 = (u32x2*)orow + lane;
#pragma unroll
    for (int j = 0; j < 4; ++j) { const f32x4 gg = gr[64 * j]; u32x2 o; o.x = pk2(v[j].x * rstd * gg.x, v[j].y * rstd * gg.y); o.y = pk2(v[j].z * rstd * gg.z, v[j].w * rstd * gg.w); o8[64 * j] = o; }
}

constexpr int P0_T_IN = 16 * 84, P0_T_A = 128, P0_T_B = 256;
constexpr int P0_T_L = 8 + 8 + 16;
constexpr int P0_TR = P0_T_IN + 4 * P0_T_A + 2 * P0_T_B + P0_T_L;
constexpr int P0_ROUT = 144, P0_NORM = T / 4, P0_MEM = NMEM / 4;
constexpr int P0_ITEMS = P0_TR + P0_ROUT + P0_NORM + P0_MEM + 1;

__device__ __forceinline__ void phase0(const P& p, int bid, int nb, char* smem) {
    const int tid = otid(), lane = tid & 63, wid = tid >> 6;
    char* ws = p.ws;
    for (int it = bid; it < P0_ITEMS; it += nb) {
        int r = it;
        if (r < P0_TR) {
            float* scr = (float*)smem;
            if (r < P0_T_IN) { transpose_tile(p.w_in, D, INCOLS, (bf16_t*)(ws + OFF_WIN), 16, 0, r, scr); continue; } r -= P0_T_IN;
            if (r < P0_T_A) { transpose_tile(p.w_o_rwkv, RW, D, (bf16_t*)(ws + OFF_WORW), 16, 0, r, scr); continue; } r -= P0_T_A;
            if (r < P0_T_A) { transpose_tile(p.w_o_moba, MW, D, (bf16_t*)(ws + OFF_WOMB), 16, 0, r, scr); continue; } r -= P0_T_A;
            if (r < P0_T_B) { transpose_tile(p.w_out, D, D, (bf16_t*)(ws + OFF_WOUT), 16, 0, r, scr); continue; } r -= P0_T_B;
            if (r < P0_T_A) { transpose_tile(p.w_q_x, D, 512, (bf16_t*)(ws + OFF_WQ), 16, 0, r, scr); continue; } r -= P0_T_A;
            if (r < P0_T_B) { transpose_tile(p.w_kv_x, D, D, (bf16_t*)(ws + OFF_WKV), 16, 0, r, scr); continue; } r -= P0_T_B;
            if (r < P0_T_A) { transpose_tile(p.w_o_x, 512, D, (bf16_t*)(ws + OFF_WOX), 16, 0, r, scr); continue; } r -= P0_T_A;
            if (r < 8) { transpose_tile(p.decay_up, 64, 512, (bf16_t*)(ws + OFF_LORA_D), 16, 0, r, scr); continue; } r -= 8;
            if (r < 8) { transpose_tile(p.iclr_up, 64, 512, (bf16_t*)(ws + OFF_LORA_I), 16, 0, r, scr); continue; } r -= 8;
            transpose_tile(p.gate_up, 128, 512, (bf16_t*)(ws + OFF_LORA_G), 16, 0, r, scr); continue;
        }
        r -= P0_TR;
        if (r < P0_ROUT) {
            const int e = r * 256 + tid, o = e >> 10, k = e & 1023;
            float* rt = (float*)(ws + OFF_ROUT);
            rt[e] = (o < 32) ? p.w_router_expert[k * 32 + o] : p.w_router_group[k * 4 + (o - 32)];
            continue;
        }
        r -= P0_ROUT;
        if (r < P0_NORM) { const int row = r * 4 + wid; rms_row_bf16(p.x + (size_t)row * D, p.norm_mix, (bf16_t*)(ws + OFF_XN) + (size_t)row * D, lane); continue; }
        r -= P0_NORM;
        if (r < P0_MEM) { const int row = r * 4 + wid; rms_row_bf16(p.mem + (size_t)row * D, p.mem_norm, (bf16_t*)(ws + OFF_MEMN) + (size_t)row * D, lane); continue; }
        if (tid < 64) ((int*)(ws + OFF_CTL + CTL_CNT))[tid] = 0;
    }
}

__device__ __forceinline__ void phase1(const P& p, int bid, int nb, char* smem) {
    TILE_COORDS
    char* ws = p.ws;
    constexpr int NT_U = (T / 128) * 42;
    for (int it = bid; it < NT_U + 16; it += nb) {
        f32x4 acc[4][4]; zero_acc(acc);
        if (it < NT_U) {
            const int pm = it / 42, pn = it % 42;
            gemm_k_loop<false>(acc, (const bf16_t*)(ws + OFF_XN), D, nullptr, pm * 128, (const bf16_t*)(ws + OFF_WIN), D, pn * 128, D, smem);
            const int colt = pn * 128;
            bf16_t* dst; int ld, cb; bool sg = false;
            if (colt < RCOLS) { dst = (bf16_t*)(ws + OFF_UR); ld = RCOLS; cb = colt; }
            else if (colt < RCOLS + MCOLS) { dst = (bf16_t*)(ws + OFF_UM); ld = MCOLS; cb = colt - RCOLS; }
            else { dst = (bf16_t*)(ws + OFF_UG); ld = GCOLS; cb = colt - RCOLS - MCOLS; sg = true; }
#pragma unroll
            for (int m = 0; m < 4; ++m) {
                const int row = pm * 128 + wr * 64 + m * 16 + fr;
#pragma unroll
                for (int n = 0; n < 4; ++n) {
                    f32x4 v = acc[m][n];
                    if (sg) { v.x = sigm(v.x); v.y = sigm(v.y); v.z = sigm(v.z); v.w = sigm(v.w); }
                    u32x2 o; o.x = pk2(v.x, v.y); o.y = pk2(v.z, v.w);
                    *(u32x2*)(dst + (size_t)row * ld + cb + wc * 64 + n * 16 + fq * 4) = o;
                }
            }
        } else {
            const int t2 = it - NT_U, pm = t2 >> 3, pn = t2 & 7;
            gemm_k_loop<false>(acc, (const bf16_t*)(ws + OFF_MEMN), D, nullptr, pm * 128, (const bf16_t*)(ws + OFF_WKV), D, pn * 128, D, smem);
            bf16_t* dst = (bf16_t*)(ws + OFF_KVX);
#pragma unroll
            for (int m = 0; m < 4; ++m) {
                const int row = pm * 128 + wr * 64 + m * 16 + fr;
#pragma unroll
                for (int n = 0; n < 4; ++n) {
                    const f32x4 v = acc[m][n]; u32x2 o; o.x = pk2(v.x, v.y); o.y = pk2(v.z, v.w);
                    *(u32x2*)(dst + (size_t)row * D + pn * 128 + wc * 64 + n * 16 + fq * 4) = o;
                }
            }
        }
    }
}

__device__ __forceinline__ void phase_kmean(const P& p, int bid, int nb, char* smem) {
    const int tid = otid();
    const bf16_t* um = (const bf16_t*)(p.ws + OFF_UM);
    float* km = (float*)(p.ws + OFF_CTL + CTL_KMEAN);
    float* red = (float*)smem;
    for (int it = bid; it < 64 * 8; it += nb) {
        const int blk = it >> 3, h = it & 7, q = tid >> 6, d = tid & 63;
        float s = 0.f;
        for (int k = 0; k < 64; ++k) s += bf2f(um[(size_t)(blk * 256 + q * 64 + k) * MCOLS + 512 + h * 64 + d]);
        red[tid] = s;
        __syncthreads();
        if (tid < 64) km[(blk * 8 + h) * 64 + tid] = (red[tid] + red[tid + 64] + red[tid + 128] + red[tid + 192]) * (1.f / 256.f);
        __syncthreads();
    }
}

__device__ __forceinline__ void moba_naive(const P& p, int wave_id, int nwaves, float* ps  ) {
    const int lane = otid() & 63;
    const bf16_t* um = (const bf16_t*)(p.ws + OFF_UM);
    const float* km = (const float*)(p.ws + OFF_CTL + CTL_KMEAN);
    bf16_t* ob = (bf16_t*)(p.ws + OFF_OB);
    for (int it = wave_id; it < T * 8; it += nwaves) {
        const int t = it >> 3, h = it & 7, qb = t >> 8;
        float q[64];
        {
            const u32x4* qp = (const u32x4*)(um + (size_t)t * MCOLS + h * 64);
#pragma unroll
            for (int c = 0; c < 8; ++c) unpack8(qp[c], q + c * 8);
        }
        float sc = -3.0e38f;
        if (lane < qb) {
            const f32x4* kp = (const f32x4*)(km + (lane * 8 + h) * 64);
            float s = 0.f;
#pragma unroll
            for (int c = 0; c < 16; ++c) { const f32x4 kv = kp[c]; s += q[c * 4] * kv.x + q[c * 4 + 1] * kv.y + q[c * 4 + 2] * kv.z + q[c * 4 + 3] * kv.w; }
            sc = s;
        }
        int sel[4];
#pragma unroll
        for (int s = 0; s < 3; ++s) {
            const float m = wave_max(sc);
            const unsigned long long bal = __ballot(sc == m && m > -1.0e38f);
            const int idx = bal ? (int)__builtin_ctzll(bal) : -1;
            sel[s] = idx;
            if (lane == idx) sc = -3.0e38f;
        }
        sel[3] = qb;
        float lg[4][4];
        float mx = -3.0e38f;
#pragma unroll
        for (int s = 0; s < 4; ++s) {
            const int blk = sel[s];
#pragma unroll
            for (int kk = 0; kk < 4; ++kk) {
                float l = -3.0e38f;
                if (blk >= 0) {
                    const int key = blk * 256 + kk * 64 + lane;
                    const u32x4* kp = (const u32x4*)(um + (size_t)key * MCOLS + 512 + h * 64);
                    float dsum = 0.f;
#pragma unroll
                    for (int c = 0; c < 8; ++c) { float kf[8]; unpack8(kp[c], kf);
#pragma unroll
                        for (int e = 0; e < 8; ++e) dsum += q[c * 8 + e] * kf[e]; }
                    const int rel = t - key;
                    if (rel >= 0) l = dsum * 0.125f + p.rel_bias[t5_bucket(rel) * 8 + h];
                }
                lg[s][kk] = l; mx = fmaxf(mx, l);
            }
        }
        mx = wave_max(mx);
        float sum = 0.f;
#pragma unroll
        for (int s = 0; s < 4; ++s)
#pragma unroll
            for (int kk = 0; kk < 4; ++kk) { const float e = (lg[s][kk] > -1.0e38f) ? __expf(lg[s][kk] - mx) : 0.f; lg[s][kk] = e; sum += e; }
        sum = wave_sum(sum);
        const float inv = 1.f / sum;
#pragma unroll
        for (int s = 0; s < 4; ++s)
#pragma unroll
            for (int kk = 0; kk < 4; ++kk) ps[s * 256 + kk * 64 + lane] = lg[s][kk] * inv;
        wave_lds_fence();
        float o = 0.f;
#pragma unroll
        for (int s = 0; s < 4; ++s) {
            const int blk = sel[s];
            if (blk >= 0) {
                const bf16_t* vp = um + (size_t)(blk * 256) * MCOLS + 1024 + h * 64 + lane;
#pragma unroll 8
                for (int k = 0; k < 256; ++k) o += ps[s * 256 + k] * bf2f(vp[(size_t)k * MCOLS]);
            }
        }
        ob[(size_t)t * 512 + h * 64 + lane] = (bf16_t)f2bf(o);
        wave_lds_fence();
    }
}

__device__ __forceinline__ void rwkv_naive(const P& p, int h, char* smem) {
    const int tid = otid(), lane = tid & 63, q4 = tid >> 6;
    float* dU = (float*)smem;
    float* iU = dU + 4096;
    float* L = iU + 4096;
    float* RKV = L + 256;
    float* PART = RKV + 192;
    float* VR = PART + 768;
    const bf16_t* ur = (const bf16_t*)(p.ws + OFF_UR);
    bf16_t* oa = (bf16_t*)(p.ws + OFF_OA);
    for (int i = tid; i < 4096; i += 256) { const int r = i >> 6, c = i & 63; dU[i] = p.decay_up[r * 512 + h * 64 + c]; iU[i] = p.iclr_up[r * 512 + h * 64 + c]; }
    const int hj = h * 64 + lane;
    const float w0 = p.decay_w0[hj], a0 = p.iclr_a0[hj], kk_w = p.k_k[hj], ka_w = p.k_a[hj], rk_w = p.r_k[hj], lnw = p.ln_x_w[hj], lnb = p.ln_x_b[hj];
    float S[16];
#pragma unroll
    for (int i = 0; i < 16; ++i) S[i] = 0.f;
    const int vi = tid >> 2, kq = tid & 3;
    __syncthreads();
    for (int t = 0; t < T; ++t) {
        {
            const int col = 1536 + tid;
            const float cur = bf2f(ur[(size_t)t * RCOLS + col]);
            const float prv = t ? bf2f(ur[(size_t)(t - 1) * RCOLS + col]) : 0.f;
            const float xs = cur + p.tshift_mu[col] * (prv - cur);
            L[tid] = tid < 64 ? tanhf(xs) : (tid < 128 ? xs : sigm(xs));
            if (tid < 192) {
                const int c2 = q4 * 512 + h * 64 + lane;
                const float cu = bf2f(ur[(size_t)t * RCOLS + c2]);
                const float pv = t ? bf2f(ur[(size_t)(t - 1) * RCOLS + c2]) : 0.f;
                RKV[tid] = cu + p.tshift_mu[c2] * (pv - cu);
            }
        }
        __syncthreads();
        {
            float pd = 0.f, pa = 0.f, pg = 0.f;
#pragma unroll
            for (int i = 0; i < 16; ++i) { pd += L[q4 * 16 + i] * dU[(q4 * 16 + i) * 64 + lane]; pa += L[64 + q4 * 16 + i] * iU[(q4 * 16 + i) * 64 + lane]; }
#pragma unroll 8
            for (int i = 0; i < 32; ++i) pg += L[128 + q4 * 32 + i] * p.gate_up[(q4 * 32 + i) * 512 + hj];
            PART[q4 * 64 + lane] = pd; PART[256 + q4 * 64 + lane] = pa; PART[512 + q4 * 64 + lane] = pg;
        }
        __syncthreads();
        if (tid < 64) {
            const float wv = w0 + PART[lane] + PART[64 + lane] + PART[128 + lane] + PART[192 + lane];
            const float av = sigm(a0 + PART[256 + lane] + PART[320 + lane] + PART[384 + lane] + PART[448 + lane]);
            const float gv = PART[512 + lane] + PART[576 + lane] + PART[640 + lane] + PART[704 + lane];
            const float wlog = -log1pf(__expf(-wv)) - 0.5f;
            const float dec = __expf(-__expf(wlog));
            const float r = RKV[lane], k = RKV[64 + lane], v = RKV[128 + lane];
            float kk = k * kk_w;
            const float ss = wave_sum(kk * kk);
            kk *= rsqrtf(ss + 1e-12f);
            const float k2 = k * (1.f + (av - 1.f) * ka_w);
            const float rk = wave_sum(r * k2 * rk_w);
            VR[lane] = r; VR[64 + lane] = dec; VR[128 + lane] = k2; VR[192 + lane] = v; VR[256 + lane] = -kk; VR[320 + lane] = kk * av;
            VR[384 + lane] = gv; VR[448 + lane] = rk * v;
        }
        __syncthreads();
        {
            float sa = 0.f;
#pragma unroll
            for (int i = 0; i < 16; ++i) sa += S[i] * VR[256 + kq * 16 + i];
            sa += __shfl_xor(sa, 1); sa += __shfl_xor(sa, 2);
            const float vv = VR[192 + vi];
            float y = 0.f;
#pragma unroll
            for (int i = 0; i < 16; ++i) { const int k = kq * 16 + i; S[i] = S[i] * VR[64 + k] + sa * VR[320 + k] + vv * VR[128 + k]; y += S[i] * VR[k]; }
            y += __shfl_xor(y, 1); y += __shfl_xor(y, 2);
            if (kq == 0) VR[512 + vi] = y;
        }
        __syncthreads();
        if (tid < 64) {
            const float y = VR[512 + lane];
            const float mean = wave_sum(y) * (1.f / 64.f);
            const float d = y - mean;
            const float var = wave_sum(d * d) * (1.f / 64.f);
            const float yn = d * rsqrtf(var + 64e-5f) * lnw + lnb;
            oa[(size_t)t * 512 + hj] = (bf16_t)f2bf((yn + VR[448 + lane]) * VR[384 + lane]);
        }
    }
}

typedef __bf16 bf16x2_t __attribute__((ext_vector_type(2)));
__device__ __forceinline__ unsigned cvt_pk(float lo, float hi) { typedef float f2_t __attribute__((ext_vector_type(2))); const f2_t v = {lo, hi}; return __builtin_bit_cast(unsigned, __builtin_convertvector(v, bf16x2_t)); }
__device__ __forceinline__ u32x2 pack4(f32x4 v) { u32x2 o; o.x = cvt_pk(v.x, v.y); o.y = cvt_pk(v.z, v.w); return o; }
__device__ __forceinline__ bf16x8 pack8(f32x4 a, f32x4 b) { u32x4 o; o.x = cvt_pk(a.x, a.y); o.y = cvt_pk(a.z, a.w); o.z = cvt_pk(b.x, b.y); o.w = cvt_pk(b.z, b.w); return __builtin_bit_cast(bf16x8, o); }
__device__ __forceinline__ bf16x8 ldperm(const char* rowbase, int ks, int fq) {
    const u32x2 a = *(const u32x2*)(rowbase + (32 * ks + fq * 4) * 2), b = *(const u32x2*)(rowbase + (32 * ks + 16 + fq * 4) * 2);
    u32x4 o; o.x = a.x; o.y = a.y; o.z = b.x; o.w = b.y; return __builtin_bit_cast(bf16x8, o);
}
#define MFMA16(a, b, c) __builtin_amdgcn_mfma_f32_16x16x32_bf16((a), (b), (c), 0, 0, 0)
constexpr int SLOT = 9216, ROWB = 144, LIN_ROWB = 528;
constexpr int L_WL = 0 * SLOT, L_AL = 1 * SLOT, L_LIN = 2 * SLOT, L_AT = 2 * SLOT, L_BT = 3 * SLOT, L_KT = 4 * SLOT, L_RT = 5 * SLOT, L_VT = 6 * SLOT, L_ATT = 7 * SLOT;
constexpr int L_AAB = L_AT, L_AKV = L_BT, L_BBT = L_WL, L_KBT = L_AL;
constexpr int L_WTOT = 8 * SLOT, L_WC = L_WTOT + 1024, RW_LDS = L_WC + 256;

typedef float f32x2 __attribute__((ext_vector_type(2)));
template <int TT> struct SolveRow {
    static __device__ __forceinline__ void run(f32x2 (&x)[32], const char* Lb) {
        f32x2 a0 = {0.f, 0.f}, a1 = {0.f, 0.f};
#pragma unroll
        for (int c8 = 0; c8 <= (TT - 1) / 8; ++c8) {
            const u32x4 lv = *(const u32x4*)(Lb + TT * 144 + c8 * 16);
            f32x2 l0, l1, l2, l3;
            l0.x = __uint_as_float(lv.x << 16); l0.y = __uint_as_float(lv.x & 0xffff0000u);
            l1.x = __uint_as_float(lv.y << 16); l1.y = __uint_as_float(lv.y & 0xffff0000u);
            l2.x = __uint_as_float(lv.z << 16); l2.y = __uint_as_float(lv.z & 0xffff0000u);
            l3.x = __uint_as_float(lv.w << 16); l3.y = __uint_as_float(lv.w & 0xffff0000u);
            a0 = l0 * x[c8 * 4 + 0] + a0; a1 = l1 * x[c8 * 4 + 1] + a1; a0 = l2 * x[c8 * 4 + 2] + a0; a1 = l3 * x[c8 * 4 + 3] + a1;
        }
        a0 = a0 + a1;
        const float r = a0.x + a0.y;
        if (TT & 1) x[TT / 2].y += r; else x[TT / 2].x += r;
        asm volatile("" : "+v"(x[TT / 2]) :: "memory");
        SolveRow<TT + 1>::run(x, Lb);
    }
};
template <> struct SolveRow<64> { static __device__ __forceinline__ void run(f32x2 (&)[32], const char*) {} };

__device__ __forceinline__ void load_shift16(const bf16_t* ur, int row, int col, const float* mu, float* out) {
    const u32x4* cp = (const u32x4*)(ur + (size_t)row * RCOLS + col);
    const u32x4 c0 = cp[0], c1 = cp[1];
    u32x4 p0 = {0u, 0u, 0u, 0u}, p1 = {0u, 0u, 0u, 0u};
    if (row > 0) { const u32x4* pp = (const u32x4*)(ur + (size_t)(row - 1) * RCOLS + col); p0 = pp[0]; p1 = pp[1]; }
    float cf[16], pf[16];
    unpack8(c0, cf); unpack8(c1, cf + 8); unpack8(p0, pf); unpack8(p1, pf + 8);
#pragma unroll
    for (int e = 0; e < 16; ++e) out[e] = cf[e] + mu[col + e] * (pf[e] - cf[e]);
}

__device__ __forceinline__ void phase_rw_chunk(const P& p, int bid, int nb, char* smem) {
    char* ws = p.ws;
    const bf16_t* ur = (const bf16_t*)(ws + OFF_UR);
    bf16_t* G = (bf16_t*)(ws + OFF_OA); bf16_t* BON = (bf16_t*)(ws + OFF_BON); bf16_t* RH = (bf16_t*)(ws + OFF_RH);
    float* YL = p.out; f32x4* NF = (f32x4*)(p.out + (size_t)T * 512);
    u32x4* MF = (u32x4*)(ws + OFF_MF);
    float* wtot = (float*)(smem + L_WTOT); float* WCs = (float*)(smem + L_WC);
    for (int it = bid; it < 2048; it += nb) {
        const int c = it >> 3, h = it & 7;
        const int tid = otid();
        const int lane = tid & 63, w = __builtin_amdgcn_readfirstlane(tid >> 6), fr = lane & 15, fq = lane >> 4;
#pragma unroll 1
        for (int hf = 0; hf < 2; ++hf) {
            u32x4 cur[4], prv[4];
#pragma unroll
            for (int i = 0; i < 4; ++i) {
                const int q = tid + (hf * 4 + i) * 256, t = q >> 5, cc = q & 31, row = c * 64 + t, col = 1536 + cc * 8;
                cur[i] = *(const u32x4*)(ur + (size_t)row * RCOLS + col);
                prv[i] = (u32x4){0u, 0u, 0u, 0u};
                if (row > 0) prv[i] = *(const u32x4*)(ur + (size_t)(row - 1) * RCOLS + col);
            }
#pragma unroll
            for (int i = 0; i < 4; ++i) {
                const int q = tid + (hf * 4 + i) * 256, t = q >> 5, cc = q & 31, col = 1536 + cc * 8;
                float cf[8], pf[8], xs[8];
                unpack8(cur[i], cf); unpack8(prv[i], pf);
#pragma unroll
                for (int e = 0; e < 8; ++e) {
                    const float x = cf[e] + p.tshift_mu[col + e] * (pf[e] - cf[e]);
                    xs[e] = (cc < 8) ? (1.f - 2.f / (1.f + __expf(2.f * x))) : ((cc < 16) ? x : sigm(x));
                }
                u32x4 o; o.x = cvt_pk(xs[0], xs[1]); o.y = cvt_pk(xs[2], xs[3]); o.z = cvt_pk(xs[4], xs[5]); o.w = cvt_pk(xs[6], xs[7]);
                *(u32x4*)(smem + L_LIN + t * LIN_ROWB + cc * 16) = o;
                asm volatile("" ::: "memory");
            }
        }
        __syncthreads();
        {
            const char* lrow = smem + L_LIN + (w * 16 + fr) * LIN_ROWB;
            const bf16_t* dT = (const bf16_t*)(ws + OFF_LORA_D) + (size_t)(h * 64) * 64;
            const bf16_t* iT = (const bf16_t*)(ws + OFF_LORA_I) + (size_t)(h * 64) * 64;
            const bf16_t* gT = (const bf16_t*)(ws + OFF_LORA_G) + (size_t)(h * 64) * 128;
            bf16x8 lb[8];
#pragma unroll
            for (int ks = 0; ks < 8; ++ks) lb[ks] = *(const bf16x8*)(lrow + (ks * 32 + fq * 8) * 2);
#pragma unroll
            for (int jt = 0; jt < 4; ++jt) {
                f32x4 aw = {0.f, 0.f, 0.f, 0.f}, aa = aw, ag = aw;
#pragma unroll
                for (int ks = 0; ks < 2; ++ks) {
                    aw = MFMA16(*(const bf16x8*)(dT + (jt * 16 + fr) * 64 + ks * 32 + fq * 8), lb[ks], aw);
                    aa = MFMA16(*(const bf16x8*)(iT + (jt * 16 + fr) * 64 + ks * 32 + fq * 8), lb[2 + ks], aa);
                }
#pragma unroll
                for (int ks = 0; ks < 4; ++ks) ag = MFMA16(*(const bf16x8*)(gT + (jt * 16 + fr) * 128 + ks * 32 + fq * 8), lb[4 + ks], ag);
                *(u32x2*)(smem + L_WL + (w * 16 + fr) * ROWB + (jt * 16 + fq * 4) * 2) = pack4(aw);
                *(u32x2*)(smem + L_AL + (w * 16 + fr) * ROWB + (jt * 16 + fq * 4) * 2) = pack4(aa);
                *(u32x2*)(G + (size_t)(c * 64 + w * 16 + fr) * 512 + h * 64 + jt * 16 + fq * 4) = pack4(ag);
            }
        }
        __syncthreads();
        {
            const int t = tid >> 2, jq = tid & 3, j0 = jq * 16, hj0 = h * 64 + j0, row = c * 64 + t;
            float ai[16], kk[16], k2[16], rr[16];
            {
                float al[16];
                const u32x4* ap = (const u32x4*)(smem + L_AL + t * ROWB + j0 * 2);
                unpack8(ap[0], al); unpack8(ap[1], al + 8);
#pragma unroll
                for (int e = 0; e < 16; ++e) ai[e] = sigm(p.iclr_a0[hj0 + e] + al[e]);
            }
            float ss = 0.f, rk = 0.f;
            {
                float k[16];
                load_shift16(ur, row, 512 + hj0, p.tshift_mu, k);
#pragma unroll
                for (int e = 0; e < 16; ++e) { kk[e] = k[e] * p.k_k[hj0 + e]; ss += kk[e] * kk[e]; k2[e] = k[e] * (1.f + (ai[e] - 1.f) * p.k_a[hj0 + e]); }
            }
            ss += __shfl_xor(ss, 1); ss += __shfl_xor(ss, 2);
            const float inv = rsqrtf(ss + 1e-12f);
            asm volatile("" ::: "memory");
            load_shift16(ur, row, hj0, p.tshift_mu, rr);
#pragma unroll
            for (int e = 0; e < 16; ++e) rk += rr[e] * k2[e] * p.r_k[hj0 + e];
            rk += __shfl_xor(rk, 1); rk += __shfl_xor(rk, 2);
            asm volatile("" ::: "memory");
            {
                float v[16];
                load_shift16(ur, row, 1024 + hj0, p.tshift_mu, v);
#pragma unroll
                for (int e = 0; e < 16; ++e) *(bf16_t*)(smem + L_VT + (j0 + e) * ROWB + t * 2) = (bf16_t)f2bf(v[e]);
#pragma unroll
                for (int hh = 0; hh < 2; ++hh) {
                    u32x4 o; o.x = cvt_pk(rk * v[hh * 8], rk * v[hh * 8 + 1]); o.y = cvt_pk(rk * v[hh * 8 + 2], rk * v[hh * 8 + 3]); o.z = cvt_pk(rk * v[hh * 8 + 4], rk * v[hh * 8 + 5]); o.w = cvt_pk(rk * v[hh * 8 + 6], rk * v[hh * 8 + 7]);
                    *(u32x4*)(BON + (size_t)row * 512 + hj0 + hh * 8) = o;
                }
            }
            asm volatile("" ::: "memory");
            float lw[16], cum[16];
            {
                float wl[16];
                const u32x4* wp = (const u32x4*)(smem + L_WL + t * ROWB + j0 * 2);
                unpack8(wp[0], wl); unpack8(wp[1], wl + 8);
#pragma unroll
                for (int e = 0; e < 16; ++e) { const float wv = p.decay_w0[hj0 + e] + wl[e]; lw[e] = -__expf(-log1pf(__expf(-wv)) - 0.5f); }
            }
#pragma unroll
            for (int e = 0; e < 16; ++e) {
                float x = lw[e];
#pragma unroll
                for (int d = 4; d < 64; d <<= 1) { const float y = __shfl_up(x, d); if (lane >= d) x += y; }
                cum[e] = x;
            }
            if ((lane >> 2) == 15) {
#pragma unroll
                for (int e = 0; e < 16; ++e) wtot[w * 64 + j0 + e] = cum[e];
            }
            __syncthreads();
#pragma unroll
            for (int hh = 0; hh < 2; ++hh) {
                float at[8], bt[8], kt[8], rt[8];
#pragma unroll
                for (int e8 = 0; e8 < 8; ++e8) {
                    const int e = hh * 8 + e8;
                    const float t0 = wtot[j0 + e], t1 = wtot[64 + j0 + e], t2 = wtot[128 + j0 + e], t3 = wtot[192 + j0 + e];
                    const float cm = cum[e] + ((w > 0 ? t0 : 0.f) + (w > 1 ? t1 : 0.f) + (w > 2 ? t2 : 0.f));
                    const float tt = (t0 + t1) + (t2 + t3);
                    if (t == 63) WCs[j0 + e] = __expf(tt);
                    const float kn = kk[e] * inv;
                    const float E = __expf(cm), Ei = 1.f / E, Ex = __expf(cm - lw[e]), Ec = __expf(tt - cm);
                    const float b = kn * ai[e];
                    at[e8] = -kn * Ex; bt[e8] = b * Ei; kt[e8] = k2[e] * Ei; rt[e8] = rr[e] * E;
                    *(bf16_t*)(smem + L_BBT + (j0 + e) * ROWB + t * 2) = (bf16_t)f2bf(b * Ec);
                    *(bf16_t*)(smem + L_KBT + (j0 + e) * ROWB + t * 2) = (bf16_t)f2bf(k2[e] * Ec);
                    *(bf16_t*)(smem + L_ATT + (j0 + e) * ROWB + t * 2) = (bf16_t)f2bf(at[e8]);
                }
                u32x4 o;
                o.x = cvt_pk(at[0], at[1]); o.y = cvt_pk(at[2], at[3]); o.z = cvt_pk(at[4], at[5]); o.w = cvt_pk(at[6], at[7]);
                *(u32x4*)(smem + L_AT + t * ROWB + (j0 + hh * 8) * 2) = o;
                o.x = cvt_pk(bt[0], bt[1]); o.y = cvt_pk(bt[2], bt[3]); o.z = cvt_pk(bt[4], bt[5]); o.w = cvt_pk(bt[6], bt[7]);
                *(u32x4*)(smem + L_BT + t * ROWB + (j0 + hh * 8) * 2) = o;
                o.x = cvt_pk(kt[0], kt[1]); o.y = cvt_pk(kt[2], kt[3]); o.z = cvt_pk(kt[4], kt[5]); o.w = cvt_pk(kt[6], kt[7]);
                *(u32x4*)(smem + L_KT + t * ROWB + (j0 + hh * 8) * 2) = o;
                o.x = cvt_pk(rt[0], rt[1]); o.y = cvt_pk(rt[2], rt[3]); o.z = cvt_pk(rt[4], rt[5]); o.w = cvt_pk(rt[6], rt[7]);
                *(u32x4*)(smem + L_RT + t * ROWB + (j0 + hh * 8) * 2) = o;
            }
        }
        __syncthreads();
        bf16x8 frb[2], frk[2];
        {
            const int tid2 = otid(), lane = tid2 & 63, fr = lane & 15, fq = lane >> 4;
            bf16x8 xa[2], xr[2];
#pragma unroll
            for (int ks = 0; ks < 2; ++ks) {
                xa[ks] = *(const bf16x8*)(smem + L_AT + (w * 16 + fr) * ROWB + (ks * 32 + fq * 8) * 2);
                xr[ks] = *(const bf16x8*)(smem + L_RT + (w * 16 + fr) * ROWB + (ks * 32 + fq * 8) * 2);
            }
            f32x4 aab[4], aak[4], arb[4], ark[4];
            const int tq = w * 16 + fr;
#pragma unroll
            for (int n = 0; n < 4; ++n) {
                f32x4 dab = {0.f, 0.f, 0.f, 0.f}, dak = dab, drb = dab, drk = dab;
                if (n <= w) {
#pragma unroll
                    for (int ks = 0; ks < 2; ++ks) {
                        const bf16x8 yb = *(const bf16x8*)(smem + L_BT + (n * 16 + fr) * ROWB + (ks * 32 + fq * 8) * 2);
                        const bf16x8 yk = *(const bf16x8*)(smem + L_KT + (n * 16 + fr) * ROWB + (ks * 32 + fq * 8) * 2);
                        dab = MFMA16(yb, xa[ks], dab); dak = MFMA16(yk, xa[ks], dak); drb = MFMA16(yb, xr[ks], drb); drk = MFMA16(yk, xr[ks], drk);
                    }
#pragma unroll
                    for (int jj = 0; jj < 4; ++jj) {
                        const int sq = n * 16 + fq * 4 + jj;
                        if (!(sq < tq)) { dab[jj] = 0.f; dak[jj] = 0.f; }
                        if (!(sq <= tq)) { drb[jj] = 0.f; drk[jj] = 0.f; }
                    }
                }
                aab[n] = dab; aak[n] = dak; arb[n] = drb; ark[n] = drk;
            }
            __syncthreads();
#pragma unroll
            for (int n = 0; n < 4; ++n) *(u32x2*)(smem + L_AAB + (w * 16 + fr) * ROWB + (n * 16 + fq * 4) * 2) = pack4(aab[n]);
            bf16x8 fak[2];
#pragma unroll
            for (int ks = 0; ks < 2; ++ks) { fak[ks] = pack8(aak[2 * ks], aak[2 * ks + 1]); frb[ks] = pack8(arb[2 * ks], arb[2 * ks + 1]); frk[ks] = pack8(ark[2 * ks], ark[2 * ks + 1]); }
#pragma unroll
            for (int vt = 0; vt < 4; ++vt) {
                f32x4 acc = {0.f, 0.f, 0.f, 0.f};
#pragma unroll
                for (int ks = 0; ks < 2; ++ks) acc = MFMA16(fak[ks], ldperm(smem + L_VT + (vt * 16 + fr) * ROWB, ks, fq), acc);
                *(u32x2*)(smem + L_AKV + (vt * 16 + fr) * ROWB + (w * 16 + fq * 4) * 2) = pack4(acc);
            }
        }
        __syncthreads();
        if (w < 2) {
            char* rowp = smem + (w == 0 ? L_ATT : L_AKV) + (otid() & 63) * ROWB;
            f32x2 x[32];
#pragma unroll
            for (int c8 = 0; c8 < 8; ++c8) {
                const u32x4 xv = *(const u32x4*)(rowp + c8 * 16);
                x[c8 * 4 + 0].x = __uint_as_float(xv.x << 16); x[c8 * 4 + 0].y = __uint_as_float(xv.x & 0xffff0000u);
                x[c8 * 4 + 1].x = __uint_as_float(xv.y << 16); x[c8 * 4 + 1].y = __uint_as_float(xv.y & 0xffff0000u);
                x[c8 * 4 + 2].x = __uint_as_float(xv.z << 16); x[c8 * 4 + 2].y = __uint_as_float(xv.z & 0xffff0000u);
                x[c8 * 4 + 3].x = __uint_as_float(xv.w << 16); x[c8 * 4 + 3].y = __uint_as_float(xv.w & 0xffff0000u);
            }
            SolveRow<1>::run(x, smem + L_AAB);
#pragma unroll
            for (int c8 = 0; c8 < 8; ++c8) {
                u32x4 o; o.x = cvt_pk(x[c8 * 4].x, x[c8 * 4].y); o.y = cvt_pk(x[c8 * 4 + 1].x, x[c8 * 4 + 1].y); o.z = cvt_pk(x[c8 * 4 + 2].x, x[c8 * 4 + 2].y); o.w = cvt_pk(x[c8 * 4 + 3].x, x[c8 * 4 + 3].y);
                *(u32x4*)(rowp + c8 * 16) = o;
            }
        }
        __syncthreads();
        {
            const int tid4 = otid(), lane = tid4 & 63, fr = lane & 15, fq = lane >> 4;
            const int trow = c * 64 + w * 16 + fr;
#pragma unroll
            for (int kt = 0; kt < 4; ++kt) {
                f32x4 acc = {0.f, 0.f, 0.f, 0.f};
#pragma unroll
                for (int ks = 0; ks < 2; ++ks) acc = MFMA16(ldperm(smem + L_ATT + (kt * 16 + fr) * ROWB, ks, fq), frb[ks], acc);
                const u32x2 rr = *(const u32x2*)(smem + L_RT + (w * 16 + fr) * ROWB + (kt * 16 + fq * 4) * 2);
                acc.x += __uint_as_float(rr.x << 16); acc.y += __uint_as_float(rr.x & 0xffff0000u); acc.z += __uint_as_float(rr.y << 16); acc.w += __uint_as_float(rr.y & 0xffff0000u);
                *(u32x2*)(RH + (size_t)trow * 512 + h * 64 + kt * 16 + fq * 4) = pack4(acc);
            }
#pragma unroll
            for (int vt = 0; vt < 4; ++vt) {
                f32x4 acc = {0.f, 0.f, 0.f, 0.f};
#pragma unroll
                for (int ks = 0; ks < 2; ++ks) {
                    acc = MFMA16(ldperm(smem + L_AKV + (vt * 16 + fr) * ROWB, ks, fq), frb[ks], acc);
                    acc = MFMA16(ldperm(smem + L_VT + (vt * 16 + fr) * ROWB, ks, fq), frk[ks], acc);
                }
                *(f32x4*)(YL + (size_t)trow * 512 + h * 64 + vt * 16 + fq * 4) = acc;
            }
            bf16x8 xb[2], xk[2];
#pragma unroll
            for (int ks = 0; ks < 2; ++ks) {
                xb[ks] = *(const bf16x8*)(smem + L_BBT + (w * 16 + fr) * ROWB + (ks * 32 + fq * 8) * 2);
                xk[ks] = *(const bf16x8*)(smem + L_KBT + (w * 16 + fr) * ROWB + (ks * 32 + fq * 8) * 2);
            }
            f32x4 mt[4];
            const float wc = WCs[w * 16 + fr];
#pragma unroll
            for (int n = 0; n < 4; ++n) {
                f32x4 acc = {0.f, 0.f, 0.f, 0.f};
#pragma unroll
                for (int ks = 0; ks < 2; ++ks) acc = MFMA16(*(const bf16x8*)(smem + L_ATT + (n * 16 + fr) * ROWB + (ks * 32 + fq * 8) * 2), xb[ks], acc);
#pragma unroll
                for (int jj = 0; jj < 4; ++jj) if (n * 16 + fq * 4 + jj == w * 16 + fr) acc[jj] += wc;
                mt[n] = acc;
            }
#pragma unroll
            for (int ks = 0; ks < 2; ++ks) MF[((size_t)((c * 8 + h) * 4 + w) * 2 + ks) * 64 + lane] = __builtin_bit_cast(u32x4, pack8(mt[2 * ks], mt[2 * ks + 1]));
#pragma unroll
            for (int vs = 0; vs < 4; ++vs) {
                f32x4 acc = {0.f, 0.f, 0.f, 0.f};
#pragma unroll
                for (int ks = 0; ks < 2; ++ks) {
                    acc = MFMA16(xb[ks], *(const bf16x8*)(smem + L_AKV + (vs * 16 + fr) * ROWB + (ks * 32 + fq * 8) * 2), acc);
                    acc = MFMA16(xk[ks], *(const bf16x8*)(smem + L_VT + (vs * 16 + fr) * ROWB + (ks * 32 + fq * 8) * 2), acc);
                }
                NF[((size_t)((c * 8 + h) * 4 + w) * 4 + vs) * 64 + lane] = acc;
            }
        }
        __syncthreads();
    }
}

__device__ __forceinline__ void rw_scan(const P& p, int h) {
    const int lane = otid() & 63, vs = otid() >> 6;
    const u32x4* MF = (const u32x4*)(p.ws + OFF_MF); const f32x4* NF = (const f32x4*)(p.out + (size_t)T * 512);
    u32x4* SF = (u32x4*)(p.ws + OFF_SF);
    u32x4 st0 = {0u, 0u, 0u, 0u}, st1 = st0;
    u32x4 m[8]; f32x4 n[4];
#pragma unroll
    for (int i = 0; i < 8; ++i) m[i] = MF[((size_t)(h * 4 + (i >> 1)) * 2 + (i & 1)) * 64 + lane];
#pragma unroll
    for (int i = 0; i < 4; ++i) n[i] = NF[((size_t)(h * 4 + i) * 4 + vs) * 64 + lane];
    for (int c = 0; c < 256; ++c) {
        SF[((size_t)((c * 8 + h) * 4 + vs) * 2 + 0) * 64 + lane] = st0;
        SF[((size_t)((c * 8 + h) * 4 + vs) * 2 + 1) * 64 + lane] = st1;
        if (c == 255) break;
        u32x4 m2[8]; f32x4 n2[4];
        const int cn = (c + 1 < 255) ? c + 1 : c;
#pragma unroll
        for (int i = 0; i < 8; ++i) m2[i] = MF[((size_t)((cn * 8 + h) * 4 + (i >> 1)) * 2 + (i & 1)) * 64 + lane];
#pragma unroll
        for (int i = 0; i < 4; ++i) n2[i] = NF[((size_t)((cn * 8 + h) * 4 + i) * 4 + vs) * 64 + lane];
        f32x4 acc[4];
#pragma unroll
        for (int i = 0; i < 4; ++i) {
            acc[i] = MFMA16(__builtin_bit_cast(bf16x8, m[2 * i]), __builtin_bit_cast(bf16x8, st0), n[i]);
            acc[i] = MFMA16(__builtin_bit_cast(bf16x8, m[2 * i + 1]), __builtin_bit_cast(bf16x8, st1), acc[i]);
        }
        st0 = __builtin_bit_cast(u32x4, pack8(acc[0], acc[1])); st1 = __builtin_bit_cast(u32x4, pack8(acc[2], acc[3]));
#pragma unroll
        for (int i = 0; i < 8; ++i) m[i] = m2[i];
#pragma unroll
        for (int i = 0; i < 4; ++i) n[i] = n2[i];
    }
}

__device__ __forceinline__ void phase_rw_out(const P& p, int bid, int nb) {
    const int tid = otid(), lane = tid & 63, w = tid >> 6, fr = lane & 15, fq = lane >> 4;
    char* ws = p.ws;
    bf16_t* OA = (bf16_t*)(ws + OFF_OA); const bf16_t* BON = (const bf16_t*)(ws + OFF_BON); const bf16_t* RH = (const bf16_t*)(ws + OFF_RH);
    const float* YL = p.out; const u32x4* SF = (const u32x4*)(ws + OFF_SF);
    for (int it = bid; it < 2048; it += nb) {
        const int c = it >> 3, h = it & 7, trow = c * 64 + w * 16 + fr;
        const char* rrow = (const char*)(RH + (size_t)trow * 512 + h * 64);
        bf16x8 rf[2]; rf[0] = ldperm(rrow, 0, fq); rf[1] = ldperm(rrow, 1, fq);
        f32x4 acc[4];
#pragma unroll
        for (int vs = 0; vs < 4; ++vs) {
            acc[vs] = *(const f32x4*)(YL + (size_t)trow * 512 + h * 64 + vs * 16 + fq * 4);
#pragma unroll
            for (int ks = 0; ks < 2; ++ks) acc[vs] = MFMA16(__builtin_bit_cast(bf16x8, SF[((size_t)((c * 8 + h) * 4 + vs) * 2 + ks) * 64 + lane]), rf[ks], acc[vs]);
        }
        float s = 0.f;
#pragma unroll
        for (int vs = 0; vs < 4; ++vs) s += (acc[vs].x + acc[vs].y) + (acc[vs].z + acc[vs].w);
        s += __shfl_xor(s, 16); s += __shfl_xor(s, 32);
        const float mean = s * (1.f / 64.f);
        float q = 0.f;
#pragma unroll
        for (int vs = 0; vs < 4; ++vs) { acc[vs] = acc[vs] - mean; q += (acc[vs].x * acc[vs].x + acc[vs].y * acc[vs].y) + (acc[vs].z * acc[vs].z + acc[vs].w * acc[vs].w); }
        q += __shfl_xor(q, 16); q += __shfl_xor(q, 32);
        const float rstd = rsqrtf(q * (1.f / 64.f) + 64e-5f);
#pragma unroll
        for (int vs = 0; vs < 4; ++vs) {
            const int hv = h * 64 + vs * 16 + fq * 4;
            const f32x4 lw = *(const f32x4*)(p.ln_x_w + hv), lb = *(const f32x4*)(p.ln_x_b + hv);
            const u32x2 bo = *(const u32x2*)(BON + (size_t)trow * 512 + hv), gg = *(const u32x2*)(OA + (size_t)trow * 512 + hv);
            f32x4 o = acc[vs] * rstd * lw + lb;
            o.x = (o.x + __uint_as_float(bo.x << 16)) * __uint_as_float(gg.x << 16);
            o.y = (o.y + __uint_as_float(bo.x & 0xffff0000u)) * __uint_as_float(gg.x & 0xffff0000u);
            o.z = (o.z + __uint_as_float(bo.y << 16)) * __uint_as_float(gg.y << 16);
            o.w = (o.w + __uint_as_float(bo.y & 0xffff0000u)) * __uint_as_float(gg.y & 0xffff0000u);
            *(u32x2*)(OA + (size_t)trow * 512 + hv) = pack4(o);
        }
    }
}

__device__ __forceinline__ void phase_merge(const P& p, int bid, int nb, char* smem) {
    TILE_COORDS
    char* ws = p.ws;
    const bf16_t* ug = (const bf16_t*)(ws + OFF_UG);
    bf16_t* mg = (bf16_t*)(ws + OFF_MRG);
    for (int it = bid; it < 128 * 8; it += nb) {
        const int pm = it >> 3, pn = it & 7;
        f32x4 acc[4][4], acc2[4][4]; zero_acc(acc); zero_acc(acc2);
        gemm_k_loop<false>(acc, (const bf16_t*)(ws + OFF_OA), 512, nullptr, pm * 128, (const bf16_t*)(ws + OFF_WORW), 512, pn * 128, 512, smem);
        gemm_k_loop<false>(acc2, (const bf16_t*)(ws + OFF_OB), 512, nullptr, pm * 128, (const bf16_t*)(ws + OFF_WOMB), 512, pn * 128, 512, smem);
#pragma unroll
        for (int m = 0; m < 4; ++m) {
            const int row = pm * 128 + wr * 64 + m * 16 + fr;
#pragma unroll
            for (int n = 0; n < 4; ++n) {
                const int col = pn * 128 + wc * 64 + n * 16 + fq * 4;
                const u32x2 ga = *(const u32x2*)(ug + (size_t)row * GCOLS + col);
                const u32x2 gb = *(const u32x2*)(ug + (size_t)row * GCOLS + 1024 + col);
                const f32x4 a = acc[m][n], b = acc2[m][n];
                const float r0 = __uint_as_float(ga.x << 16) * a.x + __uint_as_float(gb.x << 16) * b.x;
                const float r1 = __uint_as_float(ga.x & 0xffff0000u) * a.y + __uint_as_float(gb.x & 0xffff0000u) * b.y;
                const float r2 = __uint_as_float(ga.y << 16) * a.z + __uint_as_float(gb.y << 16) * b.z;
                const float r3 = __uint_as_float(ga.y & 0xffff0000u) * a.w + __uint_as_float(gb.y & 0xffff0000u) * b.w;
                u32x2 o; o.x = pk2(r0, r1); o.y = pk2(r2, r3);
                *(u32x2*)(mg + (size_t)row * D + col) = o;
            }
        }
    }
}

__device__ __forceinline__ void phase_resid_gemm(const bf16_t* A, int K, const bf16_t* Bt, const float* res, float* dst, int bid, int nb, char* smem) {
    TILE_COORDS
    for (int it = bid; it < 128 * 8; it += nb) {
        const int pm = it >> 3, pn = it & 7;
        f32x4 acc[4][4]; zero_acc(acc);
        gemm_k_loop<false>(acc, A, K, nullptr, pm * 128, Bt, K, pn * 128, K, smem);
#pragma unroll
        for (int m = 0; m < 4; ++m) {
            const int row = pm * 128 + wr * 64 + m * 16 + fr;
#pragma unroll
            for (int n = 0; n < 4; ++n) {
                const size_t off = (size_t)row * D + pn * 128 + wc * 64 + n * 16 + fq * 4;
                const f32x4 r = *(const f32x4*)(res + off);
                *(f32x4*)(dst + off) = r + acc[m][n];
            }
        }
    }
}

__device__ __forceinline__ void phase_norm(const float* src, const float* g, bf16_t* dst, int bid, int nb) {
    const int lane = otid() & 63, wid = otid() >> 6;
    for (int it = bid; it < T / 4; it += nb) { const int row = it * 4 + wid; rms_row_bf16(src + (size_t)row * D, g, dst + (size_t)row * D, lane); }
}

__device__ __forceinline__ void phase_expconv(const P& p, int bid, int nb, char* smem) {
    float* scr = (float*)smem;
    bf16_t* gu = (bf16_t*)(p.ws + OFF_EXPGU); bf16_t* dn = (bf16_t*)(p.ws + OFF_EXPD);
    for (int it = bid; it < 3 * 32 * 128; it += nb) {
        const int which = it / 4096, r = it % 4096, e = r >> 7, tile = r & 127;
        if (which == 0) transpose_tile(p.w_exp_gate + (size_t)e * D * DEXP, D, DEXP, gu + (size_t)e * D * D, 32, 0, tile, scr);
        else if (which == 1) transpose_tile(p.w_exp_up + (size_t)e * D * DEXP, D, DEXP, gu + (size_t)e * D * D, 32, 16, tile, scr);
        else transpose_tile(p.w_exp_down + (size_t)e * DEXP * D, DEXP, D, dn + (size_t)e * D * DEXP, 16, 0, tile, scr);
    }
}

__device__ __forceinline__ void phase_qx(const P& p, int bid, int nb, char* smem) {
    TILE_COORDS
    char* ws = p.ws;
    bf16_t* qx = (bf16_t*)(ws + OFF_OA);
    const float sc = 0.08838834764831845f;
    for (int it = bid; it < 128 * 4; it += nb) {
        const int pm = it >> 2, pn = it & 3;
        f32x4 acc[4][4]; zero_acc(acc);
        gemm_k_loop<false>(acc, (const bf16_t*)(ws + OFF_XN), D, nullptr, pm * 128, (const bf16_t*)(ws + OFF_WQ), D, pn * 128, D, smem);
#pragma unroll
        for (int m = 0; m < 4; ++m) {
            const int row = pm * 128 + wr * 64 + m * 16 + fr;
#pragma unroll
            for (int n = 0; n < 4; ++n) {
                const f32x4 v = acc[m][n] * sc; u32x2 o; o.x = pk2(v.x, v.y); o.y = pk2(v.z, v.w);
                *(u32x2*)(qx + (size_t)row * 512 + pn * 128 + wc * 64 + n * 16 + fq * 4) = o;
            }
        }
    }
}

__device__ __forceinline__ void xattn_naive(const P& p, int wave_id, int nwaves, float* wl  ) {
    const int lane = otid() & 63;
    const bf16_t* qx = (const bf16_t*)(p.ws + OFF_OA);
    const bf16_t* kv = (const bf16_t*)(p.ws + OFF_KVX);
    bf16_t* ox = (bf16_t*)(p.ws + OFF_OB);
    float* qs = wl; float* ps = wl + 128;
    for (int it = wave_id; it < T * 4; it += nwaves) {
        const int t = it >> 2, h = it & 3;
        {
            const unsigned w = *(const unsigned*)(qx + (size_t)t * 512 + h * 128 + lane * 2);
            qs[lane * 2] = __uint_as_float(w << 16); qs[lane * 2 + 1] = __uint_as_float(w & 0xffff0000u);
        }
        wave_lds_fence();
        float lg[4] = {0.f, 0.f, 0.f, 0.f}; float mx = -3.0e38f;
#pragma unroll 1
        for (int c4 = 0; c4 < 4; ++c4) {
            float qv[32];
#pragma unroll
            for (int e = 0; e < 32; ++e) qv[e] = qs[c4 * 32 + e];
#pragma unroll
            for (int kk = 0; kk < 4; ++kk) {
                const int key = kk * 64 + lane;
                const u32x4* kp = (const u32x4*)(kv + (size_t)key * D + h * 128 + c4 * 32);
                float dsum = 0.f;
#pragma unroll
                for (int c = 0; c < 4; ++c) { float kf[8]; unpack8(kp[c], kf);
#pragma unroll
                    for (int e = 0; e < 8; ++e) dsum += qv[c * 8 + e] * kf[e]; }
                lg[kk] += dsum;
            }
            asm volatile("" ::: "memory");
        }
#pragma unroll
        for (int kk = 0; kk < 4; ++kk) mx = fmaxf(mx, lg[kk]);
        mx = wave_max(mx);
        float sum = 0.f;
#pragma unroll
        for (int kk = 0; kk < 4; ++kk) { lg[kk] = __expf(lg[kk] - mx); sum += lg[kk]; }
        sum = wave_sum(sum);
        const float inv = 1.f / sum;
#pragma unroll
        for (int kk = 0; kk < 4; ++kk) ps[kk * 64 + lane] = lg[kk] * inv;
        wave_lds_fence();
        float o0 = 0.f, o1 = 0.f;
        const bf16_t* vp = kv + 512 + h * 128 + lane * 2;
#pragma unroll 8
        for (int k = 0; k < 256; ++k) { const unsigned w = *(const unsigned*)(vp + (size_t)k * D); const float pp = ps[k]; o0 += pp * __uint_as_float(w << 16); o1 += pp * __uint_as_float(w & 0xffff0000u); }
        *(unsigned*)(ox + (size_t)t * 512 + h * 128 + lane * 2) = pk2(o0, o1);
        wave_lds_fence();
    }
}

__device__ __forceinline__ void phase_router(const P& p, int bid, int nb, char* smem) {
    const int tid = otid(), lane = tid & 63, wid = tid >> 6;
    char* ws = p.ws;
    int* hist = (int*)smem;
    if (tid < 32) hist[tid] = 0;
    __syncthreads();
    const float* x2 = p.out;
    const float* rt = (const float*)(ws + OFF_ROUT);
    bf16_t* xn = (bf16_t*)(ws + OFF_XN);
    int* toke = (int*)(ws + OFF_CTL + CTL_TOKE); float* tokg = (float*)(ws + OFF_CTL + CTL_TOKG);
    int* rowtok = (int*)(ws + OFF_CTL + CTL_ROWTOK);
    for (int i = bid * 256 + tid; i < CAP; i += nb * 256) rowtok[i] = 0;
    for (int it = bid; it < T / 16; it += nb) {
        const int rbase = it * 16 + wid * 4;
        f32x4 hv[4][4];
#pragma unroll
        for (int rr = 0; rr < 4; ++rr) {
            const f32x4* xr = (const f32x4*)(x2 + (size_t)(rbase + rr) * D) + lane; const f32x4* gr = (const f32x4*)p.norm_ffn + lane;
            float s = 0.f;
#pragma unroll
            for (int j = 0; j < 4; ++j) { hv[rr][j] = xr[64 * j]; s += hv[rr][j].x * hv[rr][j].x + hv[rr][j].y * hv[rr][j].y + hv[rr][j].z * hv[rr][j].z + hv[rr][j].w * hv[rr][j].w; }
            const float rstd = rsqrtf(wave_sum(s) * (1.f / 1024.f) + 1e-6f);
            u32x2* o8 = (u32x2*)(xn + (size_t)(rbase + rr) * D) + lane;
#pragma unroll
            for (int j = 0; j < 4; ++j) { const f32x4 gg = gr[64 * j]; hv[rr][j] = hv[rr][j] * rstd * gg; u32x2 o; o.x = pk2(hv[rr][j].x, hv[rr][j].y); o.y = pk2(hv[rr][j].z, hv[rr][j].w); o8[64 * j] = o; }
        }
        float mine[4] = {0.f, 0.f, 0.f, 0.f};
#pragma unroll 4
        for (int o = 0; o < 36; ++o) {
            const f32x4* wr_ = (const f32x4*)(rt + o * 1024) + lane;
            f32x4 w[4];
#pragma unroll
            for (int j = 0; j < 4; ++j) w[j] = wr_[64 * j];
#pragma unroll
            for (int rr = 0; rr < 4; ++rr) {
                float s = 0.f;
#pragma unroll
                for (int j = 0; j < 4; ++j) s += hv[rr][j].x * w[j].x + hv[rr][j].y * w[j].y + hv[rr][j].z * w[j].z + hv[rr][j].w * w[j].w;
                s = wave_sum(s);
                if (lane == o) mine[rr] = s;
            }
            asm volatile("" ::: "memory");
        }
#pragma unroll
        for (int rr = 0; rr < 4; ++rr) {
            const float g0 = __shfl(mine[rr], 32), g1 = __shfl(mine[rr], 33), g2 = __shfl(mine[rr], 34), g3 = __shfl(mine[rr], 35);
            int gs = 0; float gm = g0;
            if (g1 > gm) { gm = g1; gs = 1; }
            if (g2 > gm) { gm = g2; gs = 2; }
            if (g3 > gm) { gm = g3; gs = 3; }
            const float gp = 1.f / (__expf(g0 - gm) + __expf(g1 - gm) + __expf(g2 - gm) + __expf(g3 - gm));
            float e[8];
#pragma unroll
            for (int i = 0; i < 8; ++i) e[i] = __shfl(mine[rr], gs * 8 + i);
            int i1 = 0; float v1 = e[0];
#pragma unroll
            for (int i = 1; i < 8; ++i) if (e[i] > v1) { v1 = e[i]; i1 = i; }
            int i2 = -1; float v2 = -3.0e38f;
#pragma unroll
            for (int i = 0; i < 8; ++i) if (i != i1 && e[i] > v2) { v2 = e[i]; i2 = i; }
            const float e2 = __expf(v2 - v1), den = 1.f / (1.f + e2);
            if (lane == 0) {
                const int tok = rbase + rr;
                toke[tok * 2] = gs * 8 + i1; toke[tok * 2 + 1] = gs * 8 + i2;
                tokg[tok * 2] = gp * den; tokg[tok * 2 + 1] = gp * e2 * den;
                atomicAdd(&hist[gs * 8 + i1], 1); atomicAdd(&hist[gs * 8 + i2], 1);
            }
        }
    }
    __syncthreads();
    if (tid < 32 && hist[tid]) atomicAdd((int*)(ws + OFF_CTL + CTL_CNT) + tid, hist[tid]);
}

__device__ __forceinline__ void phase_dispatch(const P& p, int bid, int nb, char* smem) {
    const int tid = otid();
    char* ws = p.ws;
    int* pstart = (int*)smem;
    const int* counts = (const int*)(ws + OFF_CTL + CTL_CNT);
    int* cursor = (int*)(ws + OFF_CTL + CTL_CNT) + 32;
    if (tid == 0) { int a = 0; for (int e = 0; e < 32; ++e) { pstart[e] = a; a += (counts[e] + 127) / 128 * 128; } pstart[32] = a; }
    __syncthreads();
    const int* toke = (const int*)(ws + OFF_CTL + CTL_TOKE);
    int* toks = (int*)(ws + OFF_CTL + CTL_TOKS); int* rowtok = (int*)(ws + OFF_CTL + CTL_ROWTOK);
    for (int i = bid * 256 + tid; i < T * 2; i += nb * 256) {
        const int e = toke[i];
        const int pos = pstart[e] + atomicAdd(&cursor[e], 1);
        rowtok[pos] = i >> 1; toks[i] = pos;
    }
    if (bid == 0) {
        int* blke = (int*)(ws + OFF_CTL + CTL_BLKE);
        for (int b = tid; b < NBLK; b += 256) {
            const int r = b * 128; int e = -1;
            if (r < pstart[32]) { e = 0; while (pstart[e + 1] <= r) ++e; }
            blke[b] = e;
        }
    }
}

__device__ __forceinline__ void phase_exp1(const P& p, int bid, int nb, char* smem) {
    TILE_COORDS
    char* ws = p.ws;
    const int* blke = (const int*)(ws + OFF_CTL + CTL_BLKE); const int* rowtok = (const int*)(ws + OFF_CTL + CTL_ROWTOK);
    bf16_t* hid = (bf16_t*)(ws + OFF_MRG);
    for (int it = bid; it < NBLK * 8; it += nb) {
        const int b = it >> 3, pn = it & 7, e = blke[b];
        if (e < 0) continue;
        f32x4 acc[4][4]; zero_acc(acc);
        gemm_k_loop<true>(acc, (const bf16_t*)(ws + OFF_XN), D, rowtok + b * 128, 0, (const bf16_t*)(ws + OFF_EXPGU) + (size_t)e * D * D, D, pn * 128, D, smem);
#pragma unroll
        for (int m = 0; m < 4; ++m) {
            const int row = b * 128 + wr * 64 + m * 16 + fr;
#pragma unroll
            for (int n2 = 0; n2 < 2; ++n2) {
                const f32x4 g = acc[m][n2 * 2], u = acc[m][n2 * 2 + 1];
                const float h0 = g.x * sigm(g.x) * u.x, h1 = g.y * sigm(g.y) * u.y, h2 = g.z * sigm(g.z) * u.z, h3 = g.w * sigm(g.w) * u.w;
                u32x2 o; o.x = pk2(h0, h1); o.y = pk2(h2, h3);
                *(u32x2*)(hid + (size_t)row * DEXP + pn * 64 + wc * 32 + n2 * 16 + fq * 4) = o;
            }
        }
    }
}
__device__ __forceinline__ void phase_exp2(const P& p, int bid, int nb, char* smem) {
    TILE_COORDS
    char* ws = p.ws;
    const int* blke = (const int*)(ws + OFF_CTL + CTL_BLKE);
    bf16_t* ym = (bf16_t*)(ws + OFF_YMOE);
    for (int it = bid; it < NBLK * 8; it += nb) {
        const int b = it >> 3, pn = it & 7, e = blke[b];
        if (e < 0) continue;
        f32x4 acc[4][4]; zero_acc(acc);
        gemm_k_loop<false>(acc, (const bf16_t*)(ws + OFF_MRG), DEXP, nullptr, b * 128, (const bf16_t*)(ws + OFF_EXPD) + (size_t)e * D * DEXP, DEXP, pn * 128, DEXP, smem);
#pragma unroll
        for (int m = 0; m < 4; ++m) {
            const int row = b * 128 + wr * 64 + m * 16 + fr;
#pragma unroll
            for (int n = 0; n < 4; ++n) {
                const f32x4 v = acc[m][n]; u32x2 o; o.x = pk2(v.x, v.y); o.y = pk2(v.z, v.w);
                *(u32x2*)(ym + (size_t)row * D + pn * 128 + wc * 64 + n * 16 + fq * 4) = o;
            }
        }
    }
}
__device__ __forceinline__ void phase_final(const P& p, int bid, int nb) {
    const int lane = otid() & 63, wid = otid() >> 6;
    char* ws = p.ws;
    const int* toks = (const int*)(ws + OFF_CTL + CTL_TOKS); const float* tokg = (const float*)(ws + OFF_CTL + CTL_TOKG);
    const bf16_t* ym = (const bf16_t*)(ws + OFF_YMOE);
    for (int it = bid; it < T / 4; it += nb) {
        const int row = it * 4 + wid;
        const int s1 = toks[row * 2], s2 = toks[row * 2 + 1]; const float g1 = tokg[row * 2], g2 = tokg[row * 2 + 1];
        f32x4* xr = (f32x4*)(p.out + (size_t)row * D) + lane; const f32x4* gr = (const f32x4*)p.norm_final + lane;
        const u32x2* y1 = (const u32x2*)(ym + (size_t)s1 * D) + lane; const u32x2* y2 = (const u32x2*)(ym + (size_t)s2 * D) + lane;
        f32x4 v[4]; float s = 0.f;
#pragma unroll
        for (int j = 0; j < 4; ++j) {
            v[j] = xr[64 * j]; const u32x2 a = y1[64 * j], b = y2[64 * j];
            v[j].x += g1 * __uint_as_float(a.x << 16) + g2 * __uint_as_float(b.x << 16);
            v[j].y += g1 * __uint_as_float(a.x & 0xffff0000u) + g2 * __uint_as_float(b.x & 0xffff0000u);
            v[j].z += g1 * __uint_as_float(a.y << 16) + g2 * __uint_as_float(b.y << 16);
            v[j].w += g1 * __uint_as_float(a.y & 0xffff0000u) + g2 * __uint_as_float(b.y & 0xffff0000u);
            s += v[j].x * v[j].x + v[j].y * v[j].y + v[j].z * v[j].z + v[j].w * v[j].w;
        }
        const float rstd = rsqrtf(wave_sum(s) * (1.f / 1024.f) + 1e-6f);
#pragma unroll
        for (int j = 0; j < 4; ++j) xr[64 * j] = v[j] * rstd * gr[64 * j];
    }
}

constexpr int NPHASE = 16;
template <int PH>
__device__ __forceinline__ void run_phase(const P& p, int bid, int nb, char* smem) {
    char* ws = p.ws;
    if (PH == 0) phase0(p, bid, nb, smem);
    else if (PH == 1) phase1(p, bid, nb, smem);
    else if (PH == 2) { phase_kmean(p, bid, nb, smem); phase_rw_chunk(p, bid, nb, smem); }
    else if (PH == 3) {
        if (bid < 8) rw_scan(p, bid);
        else moba_naive(p, (bid - 8) * 4 + (otid() >> 6), (nb - 8) * 4, (float*)smem + (otid() >> 6) * 1024);
    }
    else if (PH == 4) phase_rw_out(p, bid, nb);
    else if (PH == 5) phase_merge(p, bid, nb, smem);
    else if (PH == 6) phase_resid_gemm((const bf16_t*)(ws + OFF_MRG), D, (const bf16_t*)(ws + OFF_WOUT), p.x, p.out, bid, nb, smem);
    else if (PH == 7) { phase_norm(p.out, p.norm_xattn, (bf16_t*)(ws + OFF_XN), bid, nb); phase_expconv(p, bid, nb, smem); }
    else if (PH == 8) phase_qx(p, bid, nb, smem);
    else if (PH == 9) xattn_naive(p, bid * 4 + (otid() >> 6), nb * 4, (float*)smem + (otid() >> 6) * 384);
    else if (PH == 10) phase_resid_gemm((const bf16_t*)(ws + OFF_OB), 512, (const bf16_t*)(ws + OFF_WOX), p.out, p.out, bid, nb, smem);
    else if (PH == 11) phase_router(p, bid, nb, smem);
    else if (PH == 12) phase_dispatch(p, bid, nb, smem);
    else if (PH == 13) phase_exp1(p, bid, nb, smem);
    else if (PH == 14) phase_exp2(p, bid, nb, smem);
    else if (PH == 15) phase_final(p, bid, nb);
}


#define XB_TMO      128
#define XB_XCNT(j)  (256  + 64 * (j))
#define XB_XSUB(j)  (1280 + 64 * (j))
#define XB_XGEN(j)  (2304 + 64 * (j))
#define XB_TOP      3328
#define XB_TOPGEN   3392
#define XCD_BAR_WORDS 3456
#define XB_SPIN_CAP (1u << 18)
#define LAS __attribute__((address_space(3)))
__device__ __forceinline__ unsigned xb_ld(unsigned* p)              { return __hip_atomic_load(p, __ATOMIC_RELAXED, __HIP_MEMORY_SCOPE_AGENT); }
__device__ __forceinline__ unsigned xb_add(unsigned* p, unsigned v) { return __hip_atomic_fetch_add(p, v, __ATOMIC_RELAXED, __HIP_MEMORY_SCOPE_AGENT); }
__device__ __forceinline__ unsigned xb_xcc_id() { return (unsigned)__builtin_amdgcn_s_getreg((3 << 11) | 20) & 0xFu; }
#define XB_SPIN(cond, bar) do { unsigned _sp = 0; while (cond) { __builtin_amdgcn_s_sleep(1); \
    if ((++_sp & 255u) == 0u) { if (xb_ld(&(bar)[XB_TMO])) break; if (_sp > XB_SPIN_CAP) { atomicAdd(&(bar)[XB_TMO], 1u); break; } } } } while (0)
struct XcdBarrier { unsigned* bar; unsigned x; volatile LAS unsigned* st; };
__device__ __forceinline__ XcdBarrier xcd_barrier_post(unsigned* bar, volatile LAS unsigned* st) {
    XcdBarrier b; b.bar = bar; b.x = xb_xcc_id(); b.st = st;
    if (threadIdx.x == 0) (void)xb_add(&bar[XB_XCNT(b.x)], 1u);
    return b;
}
__device__ __forceinline__ void xcd_barrier_complete(unsigned* bar, unsigned x, unsigned& nloc, unsigned& nx) {
    const unsigned G = gridDim.x * gridDim.y * gridDim.z;
    unsigned sum, cnt, mine, sp = 0u;
    for (;;) {
        sum = 0u; cnt = 0u; mine = 0u;
#pragma unroll
        for (unsigned j = 0; j < 16; ++j) { const unsigned c = xb_ld(&bar[XB_XCNT(j)]); sum += c; cnt += (c > 0u) ? 1u : 0u; mine = (j == x) ? c : mine; }
        if (sum == G) break;
        __builtin_amdgcn_s_sleep(1);
        if ((++sp & 255u) == 0u) { if (xb_ld(&bar[XB_TMO])) break; if (sp > XB_SPIN_CAP) { atomicAdd(&bar[XB_TMO], 1u); break; } }
    }
    nloc = mine > 0u ? mine : 1u; nx = cnt > 0u ? cnt : 1u;
}
__device__ __forceinline__ void xcd_barrier(const XcdBarrier& b) {
    asm volatile("s_waitcnt vmcnt(0)" ::: "memory");
    __syncthreads();
    if (threadIdx.x == 0) {
        unsigned* bar = b.bar;
        __builtin_amdgcn_s_waitcnt(0);
        unsigned nloc = b.st[0], nx = b.st[1];
        if (nloc == 0u) { xcd_barrier_complete(bar, b.x, nloc, nx); b.st[0] = nloc; b.st[1] = nx; }
        const unsigned old = xb_add(&bar[XB_XSUB(b.x)], 1u);
        const unsigned gen = old / nloc;
        if (old + 1u == (gen + 1u) * nloc) {
            __builtin_amdgcn_fence(__ATOMIC_RELEASE, "agent");
            asm volatile("s_waitcnt vmcnt(0)" ::: "memory");
            const unsigned og = xb_add(&bar[XB_TOP], 1u);
            const unsigned tg = og / nx;
            if (og + 1u == (tg + 1u) * nx) xb_add(&bar[XB_TOPGEN], 1u);
            else XB_SPIN(xb_ld(&bar[XB_TOPGEN]) == tg, bar);
            __builtin_amdgcn_fence(__ATOMIC_ACQUIRE, "agent");
            xb_add(&bar[XB_XGEN(b.x)], 1u);
            asm volatile("s_waitcnt vmcnt(0)" ::: "memory");
        } else {
            XB_SPIN(xb_ld(&bar[XB_XGEN(b.x)]) == gen, bar);
            __builtin_amdgcn_fence(__ATOMIC_ACQUIRE, "agent");
            asm volatile("s_waitcnt vmcnt(0)" ::: "memory");
        }
    }
    __syncthreads();
}
constexpr size_t CTL_BAR = 736 * 1024;
constexpr int L_BARST = 75200;

constexpr int LDS_BYTES = 75264;
static_assert(RW_LDS <= LDS_BYTES, "lds");
template <int PH>
__global__ void __launch_bounds__(256, 2) phase_kernel(P p) {
    extern __shared__ __attribute__((aligned(16))) char smem[];
    run_phase<PH>(p, blockIdx.x, gridDim.x, smem);
}

#ifndef NO_MEGA
__global__ void __launch_bounds__(256, 2) mega_kernel(P p) {
    extern __shared__ __attribute__((aligned(16))) char smem[];
    cg::grid_group grid = cg::this_grid();
    const int bid = blockIdx.x, nb = gridDim.x;
    volatile LAS unsigned* bst = (volatile LAS unsigned*)(LAS char*)(smem + L_BARST);
    if (threadIdx.x < 2) bst[threadIdx.x] = 0u;
    __syncthreads();
    const XcdBarrier xb = xcd_barrier_post((unsigned*)(p.ws + OFF_CTL + CTL_BAR), bst);
#define GSYNC() xcd_barrier(xb)
    run_phase<0>(p, bid, nb, smem); grid.sync();
    run_phase<1>(p, bid, nb, smem); GSYNC();
    run_phase<2>(p, bid, nb, smem); GSYNC();
    run_phase<3>(p, bid, nb, smem); GSYNC();
    run_phase<4>(p, bid, nb, smem); GSYNC();
    run_phase<5>(p, bid, nb, smem); GSYNC();
    run_phase<6>(p, bid, nb, smem); GSYNC();
    run_phase<7>(p, bid, nb, smem); GSYNC();
    run_phase<8>(p, bid, nb, smem); GSYNC();
    run_phase<9>(p, bid, nb, smem); GSYNC();
    run_phase<10>(p, bid, nb, smem); GSYNC();
    run_phase<11>(p, bid, nb, smem); GSYNC();
    run_phase<12>(p, bid, nb, smem); GSYNC();
    run_phase<13>(p, bid, nb, smem); GSYNC();
    run_phase<14>(p, bid, nb, smem); GSYNC();
    run_phase<15>(p, bid, nb, smem);
}

extern "C" void kernel_launch(void* const* d_in, const int* in_sizes, int n_in, void* d_out, int out_size, void* d_ws, size_t ws_size, hipStream_t stream) {
    if (n_in != 31 || ws_size < WS_NEED || out_size != T * D) { fprintf(stderr, "kernel_launch: unexpected n_in %d / ws_size %zu / out_size %d\n", n_in, ws_size, out_size); return; }
    static int grid_blocks = 0;
    if (!grid_blocks) {
        int dev = 0, cus = 0, per_cu = 0;
        hipGetDevice(&dev);
        hipDeviceGetAttribute(&cus, hipDeviceAttributeMultiprocessorCount, dev);
        if (hipFuncSetAttribute((const void*)mega_kernel, hipFuncAttributeMaxDynamicSharedMemorySize, LDS_BYTES) != hipSuccess) fprintf(stderr, "kernel_launch: hipFuncSetAttribute failed\n");
        hipOccupancyMaxActiveBlocksPerMultiprocessor(&per_cu, (const void*)mega_kernel, 256, LDS_BYTES);
        if (per_cu > 2) per_cu = 2;
        if (per_cu < 1) { fprintf(stderr, "kernel_launch: occupancy query returned %d\n", per_cu); per_cu = 1; }
        grid_blocks = cus * per_cu;
        fprintf(stderr, "kernel_launch: cus %d per_cu %d grid %d\n", cus, per_cu, grid_blocks);
    }
    P p{};
    const float** f = (const float**)&p;
    for (int i = 0; i < 31; ++i) f[i] = (const float*)d_in[i];
    p.out = (float*)d_out; p.ws = (char*)d_ws;
    if (hipMemsetAsync((char*)d_ws + OFF_CTL + CTL_BAR, 0, XCD_BAR_WORDS * 4, stream) != hipSuccess) fprintf(stderr, "kernel_launch: memset failed\n");
    void* args[] = {&p};
    hipError_t e = hipLaunchCooperativeKernel((const void*)mega_kernel, dim3(grid_blocks), dim3(256), args, LDS_BYTES, stream);
    if (e != hipSuccess) fprintf(stderr, "cooperative launch failed: %s (grid %d)\n", hipGetErrorString(e), grid_blocks);
}
#endif
```

```cpp
#include <hip/hip_runtime.h>
#include <hip/hip_cooperative_groups.h>
#include <cstdio>
#include <cstdint>
namespace cg = cooperative_groups;

typedef unsigned short bf16_t;
typedef short bf16x8 __attribute__((ext_vector_type(8)));
typedef float f32x4 __attribute__((ext_vector_type(4)));
typedef unsigned u32x4 __attribute__((ext_vector_type(4)));
typedef unsigned u32x2 __attribute__((ext_vector_type(2)));

constexpr int T = 16384, D = 1024, NMEM = 256;
constexpr int UMC = 1024;
constexpr int RW = 512, RCOLS = 1792, MW = 512, MCOLS = 1536, GCOLS = 2048, INCOLS = 5376;
constexpr int NEXP = 32, DEXP = 512, CAP = 36864, NBLK = 288;
constexpr size_t MiB = 1u << 20;
constexpr size_t OFF_CTL = 0;
constexpr size_t OFF_WIN = 1 * MiB;
constexpr size_t OFF_WORW = OFF_WIN + (size_t)INCOLS * D * 2;
constexpr size_t OFF_WOMB = OFF_WORW + 1 * MiB;
constexpr size_t OFF_WOUT = OFF_WOMB + 1 * MiB;
constexpr size_t OFF_WQ = OFF_WOUT + 2 * MiB;
constexpr size_t OFF_WKV = OFF_WQ + 1 * MiB;
constexpr size_t OFF_WOX = OFF_WKV + 2 * MiB;
constexpr size_t OFF_MEMN = OFF_WOX + 1 * MiB;
constexpr size_t OFF_KVX = OFF_MEMN + MiB / 2;
constexpr size_t OFF_ROUT = OFF_KVX + MiB / 2;
constexpr size_t OFF_XN = 21 * MiB;
constexpr size_t OFF_UG = 53 * MiB;
constexpr size_t OFF_UR = 117 * MiB;
constexpr size_t OFF_UM = 173 * MiB;
constexpr size_t OFF_VT = 205 * MiB;
constexpr size_t OFF_MSEL = 285 * MiB;
constexpr size_t OFF_MQL = OFF_MSEL + MiB / 2;
constexpr size_t OFF_MSP = OFF_MQL + 3 * MiB / 2;
constexpr size_t OFF_OA = 221 * MiB;
constexpr size_t OFF_OB = 237 * MiB;
constexpr size_t OFF_MRG = 253 * MiB;
constexpr size_t OFF_EXPGU = 117 * MiB;
constexpr size_t OFF_EXPD = 181 * MiB;
constexpr size_t OFF_YMOE = 21 * MiB;
constexpr size_t OFF_LORA_D = OFF_ROUT + 160 * 1024;
constexpr size_t OFF_LORA_I = OFF_LORA_D + 64 * 1024;
constexpr size_t OFF_LORA_G = OFF_LORA_I + 64 * 1024;
constexpr size_t OFF_BON = 21 * MiB;
constexpr size_t OFF_RH = 37 * MiB;
constexpr size_t OFF_MF = 253 * MiB;
constexpr size_t OFF_SF = 269 * MiB;
constexpr size_t WS_NEED = 289 * MiB;
static_assert(OFF_ROUT + MiB / 2 == OFF_XN, "ws map");
constexpr size_t CTL_CNT = 0;
constexpr size_t CTL_BLKE = 4096;
constexpr size_t CTL_MCNT = 8192, CTL_MCUR = 10240, CTL_MLST = 12288, CTL_MTST = 14592;
constexpr size_t CTL_KMB = 768 * 1024;
constexpr size_t CTL_TOKE = 192 * 1024;
constexpr size_t CTL_TOKG = 320 * 1024;
constexpr size_t CTL_TOKS = 448 * 1024;
constexpr size_t CTL_ROWTOK = 576 * 1024;

struct P {
    const float *x, *mem, *rel_bias, *mem_norm, *norm_mix, *w_in, *tshift_mu, *decay_w0, *decay_up, *iclr_a0, *iclr_up, *gate_up,
        *k_k, *k_a, *r_k, *ln_x_w, *ln_x_b, *w_o_rwkv, *w_o_moba, *w_out, *norm_xattn, *w_q_x, *w_kv_x, *w_o_x, *norm_ffn,
        *w_router_group, *w_router_expert, *w_exp_gate, *w_exp_up, *w_exp_down, *norm_final;
    float* out;
    char* ws;
};

__device__ __forceinline__ int otid() { int t = threadIdx.x; asm volatile("" : "+v"(t)); return t; }
__device__ __forceinline__ float bf2f(bf16_t b) { return __uint_as_float((unsigned)b << 16); }
__device__ __forceinline__ unsigned f2bf(float f) { unsigned u = __float_as_uint(f); return (u + 0x7fffu + ((u >> 16) & 1u)) >> 16; }
__device__ __forceinline__ unsigned pk2(float lo, float hi) { return f2bf(lo) | (f2bf(hi) << 16); }
__device__ __forceinline__ float wave_sum(float v) {
#pragma unroll
    for (int o = 32; o >= 1; o >>= 1) v += __shfl_xor(v, o);
    return v;
}
__device__ __forceinline__ float wave_max(float v) {
#pragma unroll
    for (int o = 32; o >= 1; o >>= 1) v = fmaxf(v, __shfl_xor(v, o));
    return v;
}
__device__ __forceinline__ float sigm(float x) { return 1.f / (1.f + __expf(-x)); }
__device__ __forceinline__ void wave_lds_fence() { asm volatile("s_waitcnt lgkmcnt(0)" ::: "memory"); __builtin_amdgcn_wave_barrier(); }
__device__ __forceinline__ int t5_bucket(int n) {
    if (n < 16) return n;
    int v = 8 + (31 - __clz(n * n));
    return v > 31 ? 31 : v;
}
__device__ __forceinline__ void unpack8(u32x4 w, float* f) {
    f[0] = __uint_as_float(w.x << 16); f[1] = __uint_as_float(w.x & 0xffff0000u);
    f[2] = __uint_as_float(w.y << 16); f[3] = __uint_as_float(w.y & 0xffff0000u);
    f[4] = __uint_as_float(w.z << 16); f[5] = __uint_as_float(w.z & 0xffff0000u);
    f[6] = __uint_as_float(w.w << 16); f[7] = __uint_as_float(w.w & 0xffff0000u);
}

template <bool GATHER, bool SWAP = false>
__device__ __forceinline__ void gemm_k_loop(f32x4 (&acc)[4][4], const bf16_t* A, int lda, const int* rows, int brow,
                                            const bf16_t* Bt, int ldb, int bcol, int K, char* smem) {
    const int tid = otid(), lane = tid & 63, wid = tid >> 6, wr = wid >> 1, wc = wid & 1, fr = lane & 15, fq = lane >> 4;
    char* SA = smem; char* SB = smem + 8192;
    const int r0 = tid >> 2, c0 = (tid & 3) * 8;
    long ra0, ra1;
    if (GATHER) { ra0 = rows[r0]; ra1 = rows[r0 + 64]; } else { ra0 = brow + r0; ra1 = brow + r0 + 64; }
    const bf16_t* pa0 = A + ra0 * lda + c0; const bf16_t* pa1 = A + ra1 * lda + c0;
    const bf16_t* pb0 = Bt + (long)(bcol + r0) * ldb + c0; const bf16_t* pb1 = pb0 + (long)64 * ldb;
    const int nk = K / 32;
    for (int kt = 0; kt < nk; ++kt) {
        __builtin_amdgcn_global_load_lds((const unsigned*)(pa0 + kt * 32), (unsigned*)(SA + tid * 16), 16, 0, 0);
        __builtin_amdgcn_global_load_lds((const unsigned*)(pa1 + kt * 32), (unsigned*)(SA + tid * 16 + 4096), 16, 0, 0);
        __builtin_amdgcn_global_load_lds((const unsigned*)(pb0 + kt * 32), (unsigned*)(SB + tid * 16), 16, 0, 0);
        __builtin_amdgcn_global_load_lds((const unsigned*)(pb1 + kt * 32), (unsigned*)(SB + tid * 16 + 4096), 16, 0, 0);
        asm volatile("s_waitcnt vmcnt(0)" ::: "memory");
        __syncthreads();
        bf16x8 At[4], Bf[4];
#pragma unroll
        for (int m = 0; m < 4; ++m) At[m] = *(const bf16x8*)(SA + (wr * 64 + m * 16 + fr) * 64 + fq * 16);
#pragma unroll
        for (int n = 0; n < 4; ++n) Bf[n] = *(const bf16x8*)(SB + (wc * 64 + n * 16 + fr) * 64 + fq * 16);
#pragma unroll
        for (int m = 0; m < 4; ++m)
#pragma unroll
            for (int n = 0; n < 4; ++n) acc[m][n] = SWAP ? __builtin_amdgcn_mfma_f32_16x16x32_bf16(At[m], Bf[n], acc[m][n], 0, 0, 0) : __builtin_amdgcn_mfma_f32_16x16x32_bf16(Bf[n], At[m], acc[m][n], 0, 0, 0);
        __syncthreads();
    }
}
__device__ __forceinline__ void zero_acc(f32x4 (&acc)[4][4]) {
#pragma unroll
    for (int m = 0; m < 4; ++m)
#pragma unroll
        for (int n = 0; n < 4; ++n) acc[m][n] = (f32x4){0.f, 0.f, 0.f, 0.f};
}
#define TILE_COORDS const int tid = otid(), lane = tid & 63, wid = tid >> 6, wr = wid >> 1, wc = wid & 1, fr = lane & 15, fq = lane >> 4; (void)wr; (void)wc; (void)fr; (void)fq; (void)lane;

__device__ __forceinline__ void transpose_tile(const float* W, int K, int N, bf16_t* Wt, int rs, int roff, int tile, float* scr  ) {
    const int tid = otid();
    const int nnb = N / 64, kb = tile / nnb, nb = tile % nnb, k0 = kb * 64, n0 = nb * 64;
#pragma unroll 4
    for (int i = 0; i < 16; ++i) { const int k = i * 4 + (tid >> 6), n = tid & 63; scr[k * 65 + n] = W[(size_t)(k0 + k) * N + n0 + n]; }
    __syncthreads();
#pragma unroll
    for (int i = 0; i < 2; ++i) {
        const int c = tid + i * 256, n = c >> 3, kc = c & 7;
        const float* s = scr + (kc * 8) * 65 + n;
        u32x4 o; o.x = pk2(s[0], s[65]); o.y = pk2(s[2 * 65], s[3 * 65]); o.z = pk2(s[4 * 65], s[5 * 65]); o.w = pk2(s[6 * 65], s[7 * 65]);
        const int nn = n0 + n, drow = (nn >> 4) * rs + (nn & 15) + roff;
        *(u32x4*)(Wt + (size_t)drow * K + k0 + kc * 8) = o;
    }
    __syncthreads();
}
__device__ __forceinline__ void rms_row_bf16(const float* xrow, const float* g, bf16_t* orow, int lane) {
    const f32x4* xr = (const f32x4*)xrow + lane; const f32x4* gr = (const f32x4*)g + lane;
    f32x4 v[4]; float s = 0.f;
#pragma unroll
    for (int j = 0; j < 4; ++j) { v[j] = xr[64 * j]; s += v[j].x * v[j].x + v[j].y * v[j].y + v[j].z * v[j].z + v[j].w * v[j].w; }
    const float rstd = rsqrtf(wave_sum(s) * (1.f / 1024.f) + 1e-6f);
    u32x2* o8 = (u32x2*)orow + lane;
#pragma unroll
    for (int j = 0; j < 4; ++j) { const f32x4 gg = gr[64 * j]; u32x2 o; o.x = pk2(v[j].x * rstd * gg.x, v[j].y * rstd * gg.y); o.y = pk2(v[j].z * rstd * gg.z, v[j].w * rstd * gg.w); o8[64 * j] = o; }
}

constexpr int P0_T_IN = 16 * 84, P0_T_A = 128, P0_T_B = 256;
constexpr int P0_T_L = 8 + 8 + 16;
constexpr int P0_TR = P0_T_IN + 4 * P0_T_A + 2 * P0_T_B + P0_T_L;
constexpr int P0_ROUT = 144, P0_NORM = T / 4, P0_MEM = NMEM / 4;
constexpr int P0_ITEMS = P0_TR + P0_ROUT + P0_NORM + P0_MEM + 1;

__device__ __forceinline__ void phase0(const P& p, int bid, int nb, char* smem) {
    const int tid = otid(), lane = tid & 63, wid = tid >> 6;
    char* ws = p.ws;
    for (int it = bid; it < P0_ITEMS; it += nb) {
        int r = it;
        if (r < P0_TR) {
            float* scr = (float*)smem;
            if (r < P0_T_IN) { transpose_tile(p.w_in, D, INCOLS, (bf16_t*)(ws + OFF_WIN), 16, 0, r, scr); continue; } r -= P0_T_IN;
            if (r < P0_T_A) { transpose_tile(p.w_o_rwkv, RW, D, (bf16_t*)(ws + OFF_WORW), 16, 0, r, scr); continue; } r -= P0_T_A;
            if (r < P0_T_A) { transpose_tile(p.w_o_moba, MW, D, (bf16_t*)(ws + OFF_WOMB), 16, 0, r, scr); continue; } r -= P0_T_A;
            if (r < P0_T_B) { transpose_tile(p.w_out, D, D, (bf16_t*)(ws + OFF_WOUT), 16, 0, r, scr); continue; } r -= P0_T_B;
            if (r < P0_T_A) { transpose_tile(p.w_q_x, D, 512, (bf16_t*)(ws + OFF_WQ), 16, 0, r, scr); continue; } r -= P0_T_A;
            if (r < P0_T_B) { transpose_tile(p.w_kv_x, D, D, (bf16_t*)(ws + OFF_WKV), 16, 0, r, scr); continue; } r -= P0_T_B;
            if (r < P0_T_A) { transpose_tile(p.w_o_x, 512, D, (bf16_t*)(ws + OFF_WOX), 16, 0, r, scr); continue; } r -= P0_T_A;
            if (r < 8) { transpose_tile(p.decay_up, 64, 512, (bf16_t*)(ws + OFF_LORA_D), 16, 0, r, scr); continue; } r -= 8;
            if (r < 8) { transpose_tile(p.iclr_up, 64, 512, (bf16_t*)(ws + OFF_LORA_I), 16, 0, r, scr); continue; } r -= 8;
            transpose_tile(p.gate_up, 128, 512, (bf16_t*)(ws + OFF_LORA_G), 16, 0, r, scr); continue;
        }
        r -= P0_TR;
        if (r < P0_ROUT) {
            const int e = r * 256 + tid, o = e >> 10, k = e & 1023;
            float* rt = (float*)(ws + OFF_ROUT);
            rt[e] = (o < 32) ? p.w_router_expert[k * 32 + o] : p.w_router_group[k * 4 + (o - 32)];
            continue;
        }
        r -= P0_ROUT;
        if (r < P0_NORM) { const int row = r * 4 + wid; rms_row_bf16(p.x + (size_t)row * D, p.norm_mix, (bf16_t*)(ws + OFF_XN) + (size_t)row * D, lane); continue; }
        r -= P0_NORM;
        if (r < P0_MEM) { const int row = r * 4 + wid; rms_row_bf16(p.mem + (size_t)row * D, p.mem_norm, (bf16_t*)(ws + OFF_MEMN) + (size_t)row * D, lane); continue; }
        if (tid < 64) ((int*)(ws + OFF_CTL + CTL_CNT))[tid] = 0;
        for (int i = tid; i < 1024; i += 256) ((int*)(ws + OFF_CTL + CTL_MCNT))[i] = 0;
    }
}

__device__ __forceinline__ void phase1(const P& p, int bid, int nb, char* smem) {
    TILE_COORDS
    char* ws = p.ws;
    constexpr int NT_U = (T / 128) * 42;
    for (int it = bid; it < NT_U + 16; it += nb) {
        f32x4 acc[4][4]; zero_acc(acc);
        if (it < NT_U) {
            const int pm = it / 42, pn = it % 42;
            const int colt = pn * 128;
            if (colt >= RCOLS + 1024 && colt < RCOLS + MCOLS) {
                gemm_k_loop<false, true>(acc, (const bf16_t*)(ws + OFF_XN), D, nullptr, pm * 128, (const bf16_t*)(ws + OFF_WIN), D, pn * 128, D, smem);
                bf16_t* vt = (bf16_t*)(ws + OFF_VT);
#pragma unroll
                for (int m = 0; m < 4; ++m)
#pragma unroll
                    for (int n = 0; n < 4; ++n) {
                        const int col = colt - (RCOLS + 1024) + wc * 64 + n * 16 + fr, row = pm * 128 + wr * 64 + m * 16 + fq * 4;
                        const f32x4 v = acc[m][n]; u32x2 o; o.x = pk2(v.x, v.y); o.y = pk2(v.z, v.w);
                        *(u32x2*)(vt + (size_t)col * T + row) = o;
                    }
                continue;
            }
            gemm_k_loop<false>(acc, (const bf16_t*)(ws + OFF_XN), D, nullptr, pm * 128, (const bf16_t*)(ws + OFF_WIN), D, pn * 128, D, smem);
            bf16_t* dst; int ld, cb; bool sg = false;
            if (colt < RCOLS) { dst = (bf16_t*)(ws + OFF_UR); ld = RCOLS; cb = colt; }
            else if (colt < RCOLS + MCOLS) { dst = (bf16_t*)(ws + OFF_UM); ld = UMC; cb = colt - RCOLS; }
            else { dst = (bf16_t*)(ws + OFF_UG); ld = GCOLS; cb = colt - RCOLS - MCOLS; sg = true; }
#pragma unroll
            for (int m = 0; m < 4; ++m) {
                const int row = pm * 128 + wr * 64 + m * 16 + fr;
#pragma unroll
                for (int n = 0; n < 4; ++n) {
                    f32x4 v = acc[m][n];
                    if (sg) { v.x = sigm(v.x); v.y = sigm(v.y); v.z = sigm(v.z); v.w = sigm(v.w); }
                    u32x2 o; o.x = pk2(v.x, v.y); o.y = pk2(v.z, v.w);
                    *(u32x2*)(dst + (size_t)row * ld + cb + wc * 64 + n * 16 + fq * 4) = o;
                }
            }
        } else {
            const int t2 = it - NT_U, pm = t2 >> 3, pn = t2 & 7;
            gemm_k_loop<false>(acc, (const bf16_t*)(ws + OFF_MEMN), D, nullptr, pm * 128, (const bf16_t*)(ws + OFF_WKV), D, pn * 128, D, smem);
            bf16_t* dst = (bf16_t*)(ws + OFF_KVX);
#pragma unroll
            for (int m = 0; m < 4; ++m) {
                const int row = pm * 128 + wr * 64 + m * 16 + fr;
#pragma unroll
                for (int n = 0; n < 4; ++n) {
                    const f32x4 v = acc[m][n]; u32x2 o; o.x = pk2(v.x, v.y); o.y = pk2(v.z, v.w);
                    *(u32x2*)(dst + (size_t)row * D + pn * 128 + wc * 64 + n * 16 + fq * 4) = o;
                }
            }
        }
    }
}

__device__ __forceinline__ void phase_kmean(const P& p, int bid, int nb, char* smem) {
    const int tid = otid();
    const bf16_t* um = (const bf16_t*)(p.ws + OFF_UM);
    bf16_t* kmb = (bf16_t*)(p.ws + OFF_CTL + CTL_KMB);
    float* red = (float*)smem;
    for (int it = bid; it < 64 * 8; it += nb) {
        const int blk = it >> 3, h = it & 7, q = tid >> 6, d = tid & 63;
        float s = 0.f;
        for (int k = 0; k < 64; ++k) s += bf2f(um[(size_t)(blk * 256 + q * 64 + k) * UMC + 512 + h * 64 + d]);
        red[tid] = s;
        __syncthreads();
        if (tid < 64) kmb[(blk * 8 + h) * 64 + tid] = (bf16_t)f2bf((red[tid] + red[tid + 64] + red[tid + 128] + red[tid + 192]) * (1.f / 256.f));
        __syncthreads();
    }
}

__device__ __forceinline__ void rwkv_naive(const P& p, int h, char* smem) {
    const int tid = otid(), lane = tid & 63, q4 = tid >> 6;
    float* dU = (float*)smem;
    float* iU = dU + 4096;
    float* L = iU + 4096;
    float* RKV = L + 256;
    float* PART = RKV + 192;
    float* VR = PART + 768;
    const bf16_t* ur = (const bf16_t*)(p.ws + OFF_UR);
    bf16_t* oa = (bf16_t*)(p.ws + OFF_OA);
    for (int i = tid; i < 4096; i += 256) { const int r = i >> 6, c = i & 63; dU[i] = p.decay_up[r * 512 + h * 64 + c]; iU[i] = p.iclr_up[r * 512 + h * 64 + c]; }
    const int hj = h * 64 + lane;
    const float w0 = p.decay_w0[hj], a0 = p.iclr_a0[hj], kk_w = p.k_k[hj], ka_w = p.k_a[hj], rk_w = p.r_k[hj], lnw = p.ln_x_w[hj], lnb = p.ln_x_b[hj];
    float S[16];
#pragma unroll
    for (int i = 0; i < 16; ++i) S[i] = 0.f;
    const int vi = tid >> 2, kq = tid & 3;
    __syncthreads();
    for (int t = 0; t < T; ++t) {
        {
            const int col = 1536 + tid;
            const float cur = bf2f(ur[(size_t)t * RCOLS + col]);
            const float prv = t ? bf2f(ur[(size_t)(t - 1) * RCOLS + col]) : 0.f;
            const float xs = cur + p.tshift_mu[col] * (prv - cur);
            L[tid] = tid < 64 ? tanhf(xs) : (tid < 128 ? xs : sigm(xs));
            if (tid < 192) {
                const int c2 = q4 * 512 + h * 64 + lane;
                const float cu = bf2f(ur[(size_t)t * RCOLS + c2]);
                const float pv = t ? bf2f(ur[(size_t)(t - 1) * RCOLS + c2]) : 0.f;
                RKV[tid] = cu + p.tshift_mu[c2] * (pv - cu);
            }
        }
        __syncthreads();
        {
            float pd = 0.f, pa = 0.f, pg = 0.f;
#pragma unroll
            for (int i = 0; i < 16; ++i) { pd += L[q4 * 16 + i] * dU[(q4 * 16 + i) * 64 + lane]; pa += L[64 + q4 * 16 + i] * iU[(q4 * 16 + i) * 64 + lane]; }
#pragma unroll 8
            for (int i = 0; i < 32; ++i) pg += L[128 + q4 * 32 + i] * p.gate_up[(q4 * 32 + i) * 512 + hj];
            PART[q4 * 64 + lane] = pd; PART[256 + q4 * 64 + lane] = pa; PART[512 + q4 * 64 + lane] = pg;
        }
        __syncthreads();
        if (tid < 64) {
            const float wv = w0 + PART[lane] + PART[64 + lane] + PART[128 + lane] + PART[192 + lane];
            const float av = sigm(a0 + PART[256 + lane] + PART[320 + lane] + PART[384 + lane] + PART[448 + lane]);
            const float gv = PART[512 + lane] + PART[576 + lane] + PART[640 + lane] + PART[704 + lane];
            const float wlog = -log1pf(__expf(-wv)) - 0.5f;
            const float dec = __expf(-__expf(wlog));
            const float r = RKV[lane], k = RKV[64 + lane], v = RKV[128 + lane];
            float kk = k * kk_w;
            const float ss = wave_sum(kk * kk);
            kk *= rsqrtf(ss + 1e-12f);
            const float k2 = k * (1.f + (av - 1.f) * ka_w);
            const float rk = wave_sum(r * k2 * rk_w);
            VR[lane] = r; VR[64 + lane] = dec; VR[128 + lane] = k2; VR[192 + lane] = v; VR[256 + lane] = -kk; VR[320 + lane] = kk * av;
            VR[384 + lane] = gv; VR[448 + lane] = rk * v;
        }
        __syncthreads();
        {
            float sa = 0.f;
#pragma unroll
            for (int i = 0; i < 16; ++i) sa += S[i] * VR[256 + kq * 16 + i];
            sa += __shfl_xor(sa, 1); sa += __shfl_xor(sa, 2);
            const float vv = VR[192 + vi];
            float y = 0.f;
#pragma unroll
            for (int i = 0; i < 16; ++i) { const int k = kq * 16 + i; S[i] = S[i] * VR[64 + k] + sa * VR[320 + k] + vv * VR[128 + k]; y += S[i] * VR[k]; }
            y += __shfl_xor(y, 1); y += __shfl_xor(y, 2);
            if (kq == 0) VR[512 + vi] = y;
        }
        __syncthreads();
        if (tid < 64) {
            const float y = VR[512 + lane];
            const float mean = wave_sum(y) * (1.f / 64.f);
            const float d = y - mean;
            const float var = wave_sum(d * d) * (1.f / 64.f);
            const float yn = d * rsqrtf(var + 64e-5f) * lnw + lnb;
            oa[(size_t)t * 512 + hj] = (bf16_t)f2bf((yn + VR[448 + lane]) * VR[384 + lane]);
        }
    }
}

typedef __bf16 bf16x2_t __attribute__((ext_vector_type(2)));
__device__ __forceinline__ unsigned cvt_pk(float lo, float hi) { typedef float f2_t __attribute__((ext_vector_type(2))); const f2_t v = {lo, hi}; return __builtin_bit_cast(unsigned, __builtin_convertvector(v, bf16x2_t)); }
__device__ __forceinline__ u32x2 pack4(f32x4 v) { u32x2 o; o.x = cvt_pk(v.x, v.y); o.y = cvt_pk(v.z, v.w); return o; }
__device__ __forceinline__ bf16x8 pack8(f32x4 a, f32x4 b) { u32x4 o; o.x = cvt_pk(a.x, a.y); o.y = cvt_pk(a.z, a.w); o.z = cvt_pk(b.x, b.y); o.w = cvt_pk(b.z, b.w); return __builtin_bit_cast(bf16x8, o); }
__device__ __forceinline__ bf16x8 ldperm(const char* rowbase, int ks, int fq) {
    const u32x2 a = *(const u32x2*)(rowbase + (32 * ks + fq * 4) * 2), b = *(const u32x2*)(rowbase + (32 * ks + 16 + fq * 4) * 2);
    u32x4 o; o.x = a.x; o.y = a.y; o.z = b.x; o.w = b.y; return __builtin_bit_cast(bf16x8, o);
}
#define MFMA16(a, b, c) __builtin_amdgcn_mfma_f32_16x16x32_bf16((a), (b), (c), 0, 0, 0)
constexpr int SLOT = 9216, ROWB = 144, LIN_ROWB = 528;
constexpr int L_WL = 0 * SLOT, L_AL = 1 * SLOT, L_LIN = 2 * SLOT, L_AT = 2 * SLOT, L_BT = 3 * SLOT, L_KT = 4 * SLOT, L_RT = 5 * SLOT, L_VT = 6 * SLOT, L_ATT = 7 * SLOT;
constexpr int L_AAB = L_AT, L_AKV = L_BT, L_BBT = L_WL, L_KBT = L_AL;
constexpr int L_WTOT = 8 * SLOT, L_WC = L_WTOT + 1024, RW_LDS = L_WC + 256;

typedef float f32x2 __attribute__((ext_vector_type(2)));
template <int TT> struct SolveRow {
    static __device__ __forceinline__ void run(f32x2 (&x)[32], const char* Lb) {
        f32x2 a0 = {0.f, 0.f}, a1 = {0.f, 0.f};
#pragma unroll
        for (int c8 = 0; c8 <= (TT - 1) / 8; ++c8) {
            const u32x4 lv = *(const u32x4*)(Lb + TT * 144 + c8 * 16);
            f32x2 l0, l1, l2, l3;
            l0.x = __uint_as_float(lv.x << 16); l0.y = __uint_as_float(lv.x & 0xffff0000u);
            l1.x = __uint_as_float(lv.y << 16); l1.y = __uint_as_float(lv.y & 0xffff0000u);
            l2.x = __uint_as_float(lv.z << 16); l2.y = __uint_as_float(lv.z & 0xffff0000u);
            l3.x = __uint_as_float(lv.w << 16); l3.y = __uint_as_float(lv.w & 0xffff0000u);
            a0 = l0 * x[c8 * 4 + 0] + a0; a1 = l1 * x[c8 * 4 + 1] + a1; a0 = l2 * x[c8 * 4 + 2] + a0; a1 = l3 * x[c8 * 4 + 3] + a1;
        }
        a0 = a0 + a1;
        const float r = a0.x + a0.y;
        if (TT & 1) x[TT / 2].y += r; else x[TT / 2].x += r;
        asm volatile("" : "+v"(x[TT / 2]) :: "memory");
        SolveRow<TT + 1>::run(x, Lb);
    }
};
template <> struct SolveRow<64> { static __device__ __forceinline__ void run(f32x2 (&)[32], const char*) {} };

__device__ __forceinline__ void load_shift16(const bf16_t* ur, int row, int col, const float* mu, float* out) {
    const u32x4* cp = (const u32x4*)(ur + (size_t)row * RCOLS + col);
    const u32x4 c0 = cp[0], c1 = cp[1];
    u32x4 p0 = {0u, 0u, 0u, 0u}, p1 = {0u, 0u, 0u, 0u};
    if (row > 0) { const u32x4* pp = (const u32x4*)(ur + (size_t)(row - 1) * RCOLS + col); p0 = pp[0]; p1 = pp[1]; }
    float cf[16], pf[16];
    unpack8(c0, cf); unpack8(c1, cf + 8); unpack8(p0, pf); unpack8(p1, pf + 8);
#pragma unroll
    for (int e = 0; e < 16; ++e) out[e] = cf[e] + mu[col + e] * (pf[e] - cf[e]);
}

__device__ __forceinline__ void phase_rw_chunk(const P& p, int bid, int nb, char* smem) {
    char* ws = p.ws;
    const bf16_t* ur = (const bf16_t*)(ws + OFF_UR);
    bf16_t* G = (bf16_t*)(ws + OFF_OA); bf16_t* BON = (bf16_t*)(ws + OFF_BON); bf16_t* RH = (bf16_t*)(ws + OFF_RH);
    float* YL = p.out; f32x4* NF = (f32x4*)(p.out + (size_t)T * 512);
    u32x4* MF = (u32x4*)(ws + OFF_MF);
    float* wtot = (float*)(smem + L_WTOT); float* WCs = (float*)(smem + L_WC);
    for (int it = bid; it < 2048; it += nb) {
        const int c = it >> 3, h = it & 7;
        const int tid = otid();
        const int lane = tid & 63, w = __builtin_amdgcn_readfirstlane(tid >> 6), fr = lane & 15, fq = lane >> 4;
#pragma unroll 1
        for (int hf = 0; hf < 2; ++hf) {
            u32x4 cur[4], prv[4];
#pragma unroll
            for (int i = 0; i < 4; ++i) {
                const int q = tid + (hf * 4 + i) * 256, t = q >> 5, cc = q & 31, row = c * 64 + t, col = 1536 + cc * 8;
                cur[i] = *(const u32x4*)(ur + (size_t)row * RCOLS + col);
                prv[i] = (u32x4){0u, 0u, 0u, 0u};
                if (row > 0) prv[i] = *(const u32x4*)(ur + (size_t)(row - 1) * RCOLS + col);
            }
#pragma unroll
            for (int i = 0; i < 4; ++i) {
                const int q = tid + (hf * 4 + i) * 256, t = q >> 5, cc = q & 31, col = 1536 + cc * 8;
                float cf[8], pf[8], xs[8];
                unpack8(cur[i], cf); unpack8(prv[i], pf);
#pragma unroll
                for (int e = 0; e < 8; ++e) {
                    const float x = cf[e] + p.tshift_mu[col + e] * (pf[e] - cf[e]);
                    xs[e] = (cc < 8) ? (1.f - 2.f / (1.f + __expf(2.f * x))) : ((cc < 16) ? x : sigm(x));
                }
                u32x4 o; o.x = cvt_pk(xs[0], xs[1]); o.y = cvt_pk(xs[2], xs[3]); o.z = cvt_pk(xs[4], xs[5]); o.w = cvt_pk(xs[6], xs[7]);
                *(u32x4*)(smem + L_LIN + t * LIN_ROWB + cc * 16) = o;
                asm volatile("" ::: "memory");
            }
        }
        __syncthreads();
        {
            const char* lrow = smem + L_LIN + (w * 16 + fr) * LIN_ROWB;
            const bf16_t* dT = (const bf16_t*)(ws + OFF_LORA_D) + (size_t)(h * 64) * 64;
            const bf16_t* iT = (const bf16_t*)(ws + OFF_LORA_I) + (size_t)(h * 64) * 64;
            const bf16_t* gT = (const bf16_t*)(ws + OFF_LORA_G) + (size_t)(h * 64) * 128;
            bf16x8 lb[8];
#pragma unroll
            for (int ks = 0; ks < 8; ++ks) lb[ks] = *(const bf16x8*)(lrow + (ks * 32 + fq * 8) * 2);
#pragma unroll
            for (int jt = 0; jt < 4; ++jt) {
                f32x4 aw = {0.f, 0.f, 0.f, 0.f}, aa = aw, ag = aw;
#pragma unroll
                for (int ks = 0; ks < 2; ++ks) {
                    aw = MFMA16(*(const bf16x8*)(dT + (jt * 16 + fr) * 64 + ks * 32 + fq * 8), lb[ks], aw);
                    aa = MFMA16(*(const bf16x8*)(iT + (jt * 16 + fr) * 64 + ks * 32 + fq * 8), lb[2 + ks], aa);
                }
#pragma unroll
                for (int ks = 0; ks < 4; ++ks) ag = MFMA16(*(const bf16x8*)(gT + (jt * 16 + fr) * 128 + ks * 32 + fq * 8), lb[4 + ks], ag);
                *(u32x2*)(smem + L_WL + (w * 16 + fr) * ROWB + (jt * 16 + fq * 4) * 2) = pack4(aw);
                *(u32x2*)(smem + L_AL + (w * 16 + fr) * ROWB + (jt * 16 + fq * 4) * 2) = pack4(aa);
                *(u32x2*)(G + (size_t)(c * 64 + w * 16 + fr) * 512 + h * 64 + jt * 16 + fq * 4) = pack4(ag);
            }
        }
        __syncthreads();
        {
            const int t = tid >> 2, jq = tid & 3, j0 = jq * 16, hj0 = h * 64 + j0, row = c * 64 + t;
            float ai[16], kk[16], k2[16], rr[16];
            {
                float al[16];
                const u32x4* ap = (const u32x4*)(smem + L_AL + t * ROWB + j0 * 2);
                unpack8(ap[0], al); unpack8(ap[1], al + 8);
#pragma unroll
                for (int e = 0; e < 16; ++e) ai[e] = sigm(p.iclr_a0[hj0 + e] + al[e]);
            }
            float ss = 0.f, rk = 0.f;
            {
                float k[16];
                load_shift16(ur, row, 512 + hj0, p.tshift_mu, k);
#pragma unroll
                for (int e = 0; e < 16; ++e) { kk[e] = k[e] * p.k_k[hj0 + e]; ss += kk[e] * kk[e]; k2[e] = k[e] * (1.f + (ai[e] - 1.f) * p.k_a[hj0 + e]); }
            }
            ss += __shfl_xor(ss, 1); ss += __shfl_xor(ss, 2);
            const float inv = rsqrtf(ss + 1e-12f);
            asm volatile("" ::: "memory");
            load_shift16(ur, row, hj0, p.tshift_mu, rr);
#pragma unroll
            for (int e = 0; e < 16; ++e) rk += rr[e] * k2[e] * p.r_k[hj0 + e];
            rk += __shfl_xor(rk, 1); rk += __shfl_xor(rk, 2);
            asm volatile("" ::: "memory");
            {
                float v[16];
                load_shift16(ur, row, 1024 + hj0, p.tshift_mu, v);
#pragma unroll
                for (int e = 0; e < 16; ++e) *(bf16_t*)(smem + L_VT + (j0 + e) * ROWB + t * 2) = (bf16_t)f2bf(v[e]);
#pragma unroll
                for (int hh = 0; hh < 2; ++hh) {
                    u32x4 o; o.x = cvt_pk(rk * v[hh * 8], rk * v[hh * 8 + 1]); o.y = cvt_pk(rk * v[hh * 8 + 2], rk * v[hh * 8 + 3]); o.z = cvt_pk(rk * v[hh * 8 + 4], rk * v[hh * 8 + 5]); o.w = cvt_pk(rk * v[hh * 8 + 6], rk * v[hh * 8 + 7]);
                    *(u32x4*)(BON + (size_t)row * 512 + hj0 + hh * 8) = o;
                }
            }
            asm volatile("" ::: "memory");
            float lw[16], cum[16];
            {
                float wl[16];
                const u32x4* wp = (const u32x4*)(smem + L_WL + t * ROWB + j0 * 2);
                unpack8(wp[0], wl); unpack8(wp[1], wl + 8);
#pragma unroll
                for (int e = 0; e < 16; ++e) { const float wv = p.decay_w0[hj0 + e] + wl[e]; lw[e] = -__expf(-log1pf(__expf(-wv)) - 0.5f); }
            }
#pragma unroll
            for (int e = 0; e < 16; ++e) {
                float x = lw[e];
#pragma unroll
                for (int d = 4; d < 64; d <<= 1) { const float y = __shfl_up(x, d); if (lane >= d) x += y; }
                cum[e] = x;
            }
            if ((lane >> 2) == 15) {
#pragma unroll
                for (int e = 0; e < 16; ++e) wtot[w * 64 + j0 + e] = cum[e];
            }
            __syncthreads();
#pragma unroll
            for (int hh = 0; hh < 2; ++hh) {
                float at[8], bt[8], kt[8], rt[8];
#pragma unroll
                for (int e8 = 0; e8 < 8; ++e8) {
                    const int e = hh * 8 + e8;
                    const float t0 = wtot[j0 + e], t1 = wtot[64 + j0 + e], t2 = wtot[128 + j0 + e], t3 = wtot[192 + j0 + e];
                    const float cm = cum[e] + ((w > 0 ? t0 : 0.f) + (w > 1 ? t1 : 0.f) + (w > 2 ? t2 : 0.f));
                    const float tt = (t0 + t1) + (t2 + t3);
                    if (t == 63) WCs[j0 + e] = __expf(tt);
                    const float kn = kk[e] * inv;
                    const float E = __expf(cm), Ei = 1.f / E, Ex = __expf(cm - lw[e]), Ec = __expf(tt - cm);
                    const float b = kn * ai[e];
                    at[e8] = -kn * Ex; bt[e8] = b * Ei; kt[e8] = k2[e] * Ei; rt[e8] = rr[e] * E;
                    *(bf16_t*)(smem + L_BBT + (j0 + e) * ROWB + t * 2) = (bf16_t)f2bf(b * Ec);
                    *(bf16_t*)(smem + L_KBT + (j0 + e) * ROWB + t * 2) = (bf16_t)f2bf(k2[e] * Ec);
                    *(bf16_t*)(smem + L_ATT + (j0 + e) * ROWB + t * 2) = (bf16_t)f2bf(at[e8]);
                }
                u32x4 o;
                o.x = cvt_pk(at[0], at[1]); o.y = cvt_pk(at[2], at[3]); o.z = cvt_pk(at[4], at[5]); o.w = cvt_pk(at[6], at[7]);
                *(u32x4*)(smem + L_AT + t * ROWB + (j0 + hh * 8) * 2) = o;
                o.x = cvt_pk(bt[0], bt[1]); o.y = cvt_pk(bt[2], bt[3]); o.z = cvt_pk(bt[4], bt[5]); o.w = cvt_pk(bt[6], bt[7]);
                *(u32x4*)(smem + L_BT + t * ROWB + (j0 + hh * 8) * 2) = o;
                o.x = cvt_pk(kt[0], kt[1]); o.y = cvt_pk(kt[2], kt[3]); o.z = cvt_pk(kt[4], kt[5]); o.w = cvt_pk(kt[6], kt[7]);
                *(u32x4*)(smem + L_KT + t * ROWB + (j0 + hh * 8) * 2) = o;
                o.x = cvt_pk(rt[0], rt[1]); o.y = cvt_pk(rt[2], rt[3]); o.z = cvt_pk(rt[4], rt[5]); o.w = cvt_pk(rt[6], rt[7]);
                *(u32x4*)(smem + L_RT + t * ROWB + (j0 + hh * 8) * 2) = o;
            }
        }
        __syncthreads();
        bf16x8 frb[2], frk[2];
        {
            const int tid2 = otid(), lane = tid2 & 63, fr = lane & 15, fq = lane >> 4;
            bf16x8 xa[2], xr[2];
#pragma unroll
            for (int ks = 0; ks < 2; ++ks) {
                xa[ks] = *(const bf16x8*)(smem + L_AT + (w * 16 + fr) * ROWB + (ks * 32 + fq * 8) * 2);
                xr[ks] = *(const bf16x8*)(smem + L_RT + (w * 16 + fr) * ROWB + (ks * 32 + fq * 8) * 2);
            }
            f32x4 aab[4], aak[4], arb[4], ark[4];
            const int tq = w * 16 + fr;
#pragma unroll
            for (int n = 0; n < 4; ++n) {
                f32x4 dab = {0.f, 0.f, 0.f, 0.f}, dak = dab, drb = dab, drk = dab;
                if (n <= w) {
#pragma unroll
                    for (int ks = 0; ks < 2; ++ks) {
                        const bf16x8 yb = *(const bf16x8*)(smem + L_BT + (n * 16 + fr) * ROWB + (ks * 32 + fq * 8) * 2);
                        const bf16x8 yk = *(const bf16x8*)(smem + L_KT + (n * 16 + fr) * ROWB + (ks * 32 + fq * 8) * 2);
                        dab = MFMA16(yb, xa[ks], dab); dak = MFMA16(yk, xa[ks], dak); drb = MFMA16(yb, xr[ks], drb); drk = MFMA16(yk, xr[ks], drk);
                    }
#pragma unroll
                    for (int jj = 0; jj < 4; ++jj) {
                        const int sq = n * 16 + fq * 4 + jj;
                        if (!(sq < tq)) { dab[jj] = 0.f; dak[jj] = 0.f; }
                        if (!(sq <= tq)) { drb[jj] = 0.f; drk[jj] = 0.f; }
                    }
                }
                aab[n] = dab; aak[n] = dak; arb[n] = drb; ark[n] = drk;
            }
            __syncthreads();
#pragma unroll
            for (int n = 0; n < 4; ++n) *(u32x2*)(smem + L_AAB + (w * 16 + fr) * ROWB + (n * 16 + fq * 4) * 2) = pack4(aab[n]);
            bf16x8 fak[2];
#pragma unroll
            for (int ks = 0; ks < 2; ++ks) { fak[ks] = pack8(aak[2 * ks], aak[2 * ks + 1]); frb[ks] = pack8(arb[2 * ks], arb[2 * ks + 1]); frk[ks] = pack8(ark[2 * ks], ark[2 * ks + 1]); }
#pragma unroll
            for (int vt = 0; vt < 4; ++vt) {
                f32x4 acc = {0.f, 0.f, 0.f, 0.f};
#pragma unroll
                for (int ks = 0; ks < 2; ++ks) acc = MFMA16(fak[ks], ldperm(smem + L_VT + (vt * 16 + fr) * ROWB, ks, fq), acc);
                *(u32x2*)(smem + L_AKV + (vt * 16 + fr) * ROWB + (w * 16 + fq * 4) * 2) = pack4(acc);
            }
        }
        __syncthreads();
        if (w < 2) {
            char* rowp = smem + (w == 0 ? L_ATT : L_AKV) + (otid() & 63) * ROWB;
            f32x2 x[32];
#pragma unroll
            for (int c8 = 0; c8 < 8; ++c8) {
                const u32x4 xv = *(const u32x4*)(rowp + c8 * 16);
                x[c8 * 4 + 0].x = __uint_as_float(xv.x << 16); x[c8 * 4 + 0].y = __uint_as_float(xv.x & 0xffff0000u);
                x[c8 * 4 + 1].x = __uint_as_float(xv.y << 16); x[c8 * 4 + 1].y = __uint_as_float(xv.y & 0xffff0000u);
                x[c8 * 4 + 2].x = __uint_as_float(xv.z << 16); x[c8 * 4 + 2].y = __uint_as_float(xv.z & 0xffff0000u);
                x[c8 * 4 + 3].x = __uint_as_float(xv.w << 16); x[c8 * 4 + 3].y = __uint_as_float(xv.w & 0xffff0000u);
            }
            SolveRow<1>::run(x, smem + L_AAB);
#pragma unroll
            for (int c8 = 0; c8 < 8; ++c8) {
                u32x4 o; o.x = cvt_pk(x[c8 * 4].x, x[c8 * 4].y); o.y = cvt_pk(x[c8 * 4 + 1].x, x[c8 * 4 + 1].y); o.z = cvt_pk(x[c8 * 4 + 2].x, x[c8 * 4 + 2].y); o.w = cvt_pk(x[c8 * 4 + 3].x, x[c8 * 4 + 3].y);
                *(u32x4*)(rowp + c8 * 16) = o;
            }
        }
        __syncthreads();
        {
            const int tid4 = otid(), lane = tid4 & 63, fr = lane & 15, fq = lane >> 4;
            const int trow = c * 64 + w * 16 + fr;
#pragma unroll
            for (int kt = 0; kt < 4; ++kt) {
                f32x4 acc = {0.f, 0.f, 0.f, 0.f};
#pragma unroll
                for (int ks = 0; ks < 2; ++ks) acc = MFMA16(ldperm(smem + L_ATT + (kt * 16 + fr) * ROWB, ks, fq), frb[ks], acc);
                const u32x2 rr = *(const u32x2*)(smem + L_RT + (w * 16 + fr) * ROWB + (kt * 16 + fq * 4) * 2);
                acc.x += __uint_as_float(rr.x << 16); acc.y += __uint_as_float(rr.x & 0xffff0000u); acc.z += __uint_as_float(rr.y << 16); acc.w += __uint_as_float(rr.y & 0xffff0000u);
                *(u32x2*)(RH + (size_t)trow * 512 + h * 64 + kt * 16 + fq * 4) = pack4(acc);
            }
#pragma unroll
            for (int vt = 0; vt < 4; ++vt) {
                f32x4 acc = {0.f, 0.f, 0.f, 0.f};
#pragma unroll
                for (int ks = 0; ks < 2; ++ks) {
                    acc = MFMA16(ldperm(smem + L_AKV + (vt * 16 + fr) * ROWB, ks, fq), frb[ks], acc);
                    acc = MFMA16(ldperm(smem + L_VT + (vt * 16 + fr) * ROWB, ks, fq), frk[ks], acc);
                }
                *(f32x4*)(YL + (size_t)trow * 512 + h * 64 + vt * 16 + fq * 4) = acc;
            }
            bf16x8 xb[2], xk[2];
#pragma unroll
            for (int ks = 0; ks < 2; ++ks) {
                xb[ks] = *(const bf16x8*)(smem + L_BBT + (w * 16 + fr) * ROWB + (ks * 32 + fq * 8) * 2);
                xk[ks] = *(const bf16x8*)(smem + L_KBT + (w * 16 + fr) * ROWB + (ks * 32 + fq * 8) * 2);
            }
            f32x4 mt[4];
            const float wc = WCs[w * 16 + fr];
#pragma unroll
            for (int n = 0; n < 4; ++n) {
                f32x4 acc = {0.f, 0.f, 0.f, 0.f};
#pragma unroll
                for (int ks = 0; ks < 2; ++ks) acc = MFMA16(*(const bf16x8*)(smem + L_ATT + (n * 16 + fr) * ROWB + (ks * 32 + fq * 8) * 2), xb[ks], acc);
#pragma unroll
                for (int jj = 0; jj < 4; ++jj) if (n * 16 + fq * 4 + jj == w * 16 + fr) acc[jj] += wc;
                mt[n] = acc;
            }
#pragma unroll
            for (int ks = 0; ks < 2; ++ks) MF[((size_t)((c * 8 + h) * 4 + w) * 2 + ks) * 64 + lane] = __builtin_bit_cast(u32x4, pack8(mt[2 * ks], mt[2 * ks + 1]));
#pragma unroll
            for (int vs = 0; vs < 4; ++vs) {
                f32x4 acc = {0.f, 0.f, 0.f, 0.f};
#pragma unroll
                for (int ks = 0; ks < 2; ++ks) {
                    acc = MFMA16(xb[ks], *(const bf16x8*)(smem + L_AKV + (vs * 16 + fr) * ROWB + (ks * 32 + fq * 8) * 2), acc);
                    acc = MFMA16(xk[ks], *(const bf16x8*)(smem + L_VT + (vs * 16 + fr) * ROWB + (ks * 32 + fq * 8) * 2), acc);
                }
                NF[((size_t)((c * 8 + h) * 4 + w) * 4 + vs) * 64 + lane] = acc;
            }
        }
        __syncthreads();
    }
}

__device__ __forceinline__ void rw_scan(const P& p, int h) {
    const int lane = otid() & 63, vs = otid() >> 6;
    const u32x4* MF = (const u32x4*)(p.ws + OFF_MF); const f32x4* NF = (const f32x4*)(p.out + (size_t)T * 512);
    u32x4* SF = (u32x4*)(p.ws + OFF_SF);
    u32x4 st0 = {0u, 0u, 0u, 0u}, st1 = st0;
    u32x4 m[8]; f32x4 n[4];
#pragma unroll
    for (int i = 0; i < 8; ++i) m[i] = MF[((size_t)(h * 4 + (i >> 1)) * 2 + (i & 1)) * 64 + lane];
#pragma unroll
    for (int i = 0; i < 4; ++i) n[i] = NF[((size_t)(h * 4 + i) * 4 + vs) * 64 + lane];
    for (int c = 0; c < 256; ++c) {
        SF[((size_t)((c * 8 + h) * 4 + vs) * 2 + 0) * 64 + lane] = st0;
        SF[((size_t)((c * 8 + h) * 4 + vs) * 2 + 1) * 64 + lane] = st1;
        if (c == 255) break;
        u32x4 m2[8]; f32x4 n2[4];
        const int cn = (c + 1 < 255) ? c + 1 : c;
#pragma unroll
        for (int i = 0; i < 8; ++i) m2[i] = MF[((size_t)((cn * 8 + h) * 4 + (i >> 1)) * 2 + (i & 1)) * 64 + lane];
#pragma unroll
        for (int i = 0; i < 4; ++i) n2[i] = NF[((size_t)((cn * 8 + h) * 4 + i) * 4 + vs) * 64 + lane];
        f32x4 acc[4];
#pragma unroll
        for (int i = 0; i < 4; ++i) {
            acc[i] = MFMA16(__builtin_bit_cast(bf16x8, m[2 * i]), __builtin_bit_cast(bf16x8, st0), n[i]);
            acc[i] = MFMA16(__builtin_bit_cast(bf16x8, m[2 * i + 1]), __builtin_bit_cast(bf16x8, st1), acc[i]);
        }
        st0 = __builtin_bit_cast(u32x4, pack8(acc[0], acc[1])); st1 = __builtin_bit_cast(u32x4, pack8(acc[2], acc[3]));
#pragma unroll
        for (int i = 0; i < 8; ++i) m[i] = m2[i];
#pragma unroll
        for (int i = 0; i < 4; ++i) n[i] = n2[i];
    }
}

__device__ __forceinline__ void phase_rw_out(const P& p, int bid, int nb) {
    const int tid = otid(), lane = tid & 63, w = tid >> 6, fr = lane & 15, fq = lane >> 4;
    char* ws = p.ws;
    bf16_t* OA = (bf16_t*)(ws + OFF_OA); const bf16_t* BON = (const bf16_t*)(ws + OFF_BON); const bf16_t* RH = (const bf16_t*)(ws + OFF_RH);
    const float* YL = p.out; const u32x4* SF = (const u32x4*)(ws + OFF_SF);
    for (int it = bid; it < 2048; it += nb) {
        const int c = it >> 3, h = it & 7, trow = c * 64 + w * 16 + fr;
        const char* rrow = (const char*)(RH + (size_t)trow * 512 + h * 64);
        bf16x8 rf[2]; rf[0] = ldperm(rrow, 0, fq); rf[1] = ldperm(rrow, 1, fq);
        f32x4 acc[4];
#pragma unroll
        for (int vs = 0; vs < 4; ++vs) {
            acc[vs] = *(const f32x4*)(YL + (size_t)trow * 512 + h * 64 + vs * 16 + fq * 4);
#pragma unroll
            for (int ks = 0; ks < 2; ++ks) acc[vs] = MFMA16(__builtin_bit_cast(bf16x8, SF[((size_t)((c * 8 + h) * 4 + vs) * 2 + ks) * 64 + lane]), rf[ks], acc[vs]);
        }
        float s = 0.f;
#pragma unroll
        for (int vs = 0; vs < 4; ++vs) s += (acc[vs].x + acc[vs].y) + (acc[vs].z + acc[vs].w);
        s += __shfl_xor(s, 16); s += __shfl_xor(s, 32);
        const float mean = s * (1.f / 64.f);
        float q = 0.f;
#pragma unroll
        for (int vs = 0; vs < 4; ++vs) { acc[vs] = acc[vs] - mean; q += (acc[vs].x * acc[vs].x + acc[vs].y * acc[vs].y) + (acc[vs].z * acc[vs].z + acc[vs].w * acc[vs].w); }
        q += __shfl_xor(q, 16); q += __shfl_xor(q, 32);
        const float rstd = rsqrtf(q * (1.f / 64.f) + 64e-5f);
#pragma unroll
        for (int vs = 0; vs < 4; ++vs) {
            const int hv = h * 64 + vs * 16 + fq * 4;
            const f32x4 lw = *(const f32x4*)(p.ln_x_w + hv), lb = *(const f32x4*)(p.ln_x_b + hv);
            const u32x2 bo = *(const u32x2*)(BON + (size_t)trow * 512 + hv), gg = *(const u32x2*)(OA + (size_t)trow * 512 + hv);
            f32x4 o = acc[vs] * rstd * lw + lb;
            o.x = (o.x + __uint_as_float(bo.x << 16)) * __uint_as_float(gg.x << 16);
            o.y = (o.y + __uint_as_float(bo.x & 0xffff0000u)) * __uint_as_float(gg.x & 0xffff0000u);
            o.z = (o.z + __uint_as_float(bo.y << 16)) * __uint_as_float(gg.y << 16);
            o.w = (o.w + __uint_as_float(bo.y & 0xffff0000u)) * __uint_as_float(gg.y & 0xffff0000u);
            *(u32x2*)(OA + (size_t)trow * 512 + hv) = pack4(o);
        }
    }
}

constexpr int A_LK = 0, A_LV = 36864, A_BIAS = 70656, A_TST = 70784;
constexpr int MAXTILES = 6656;

__device__ __forceinline__ void moba_select(const P& p, int bid0, int nb0, char* smem) {
    const int tid = otid(), lane = tid & 63, w = tid >> 6, fr = lane & 15, fq = lane >> 4;
    char* ws = p.ws;
    const bf16_t* um = (const bf16_t*)(ws + OFF_UM); const bf16_t* kmb = (const bf16_t*)(ws + OFF_CTL + CTL_KMB);
    unsigned* SEL = (unsigned*)(ws + OFF_MSEL);
    int* hist = (int*)smem;
    for (int i = tid; i < 512; i += 256) hist[i] = 0;
    __syncthreads();
    for (int it = bid0; it < 2048; it += nb0) {
        const int tile = it >> 3, h = it & 7, qb = tile >> 2, t = tile * 64 + w * 16 + fr;
        bf16x8 qf[2];
#pragma unroll
        for (int ks = 0; ks < 2; ++ks) qf[ks] = *(const bf16x8*)(um + (size_t)t * UMC + h * 64 + ks * 32 + fq * 8);
        float sc[4][4];
#pragma unroll
        for (int nt = 0; nt < 4; ++nt) {
            f32x4 acc = {0.f, 0.f, 0.f, 0.f};
            if (nt * 16 < qb) {
#pragma unroll
                for (int ks = 0; ks < 2; ++ks) acc = MFMA16(*(const bf16x8*)(kmb + (size_t)((nt * 16 + fr) * 8 + h) * 64 + ks * 32 + fq * 8), qf[ks], acc);
            }
#pragma unroll
            for (int j = 0; j < 4; ++j) sc[nt][j] = (nt * 16 + fq * 4 + j < qb) ? acc[j] : -3.0e38f;
        }
        unsigned selw = 0u;
#pragma unroll
        for (int s = 0; s < 3; ++s) {
            float bv = -3.0e38f; int bi = 255;
#pragma unroll
            for (int nt = 0; nt < 4; ++nt)
#pragma unroll
                for (int j = 0; j < 4; ++j) if (sc[nt][j] > bv) { bv = sc[nt][j]; bi = nt * 16 + fq * 4 + j; }
#pragma unroll
            for (int o = 16; o <= 32; o <<= 1) {
                const float v2 = __shfl_xor(bv, o); const int i2 = __shfl_xor(bi, o);
                if (v2 > bv || (v2 == bv && i2 < bi)) { bv = v2; bi = i2; }
            }
            if (!(bv > -1.0e38f)) bi = 255;
            selw |= (unsigned)bi << (8 * s);
#pragma unroll
            for (int nt = 0; nt < 4; ++nt)
#pragma unroll
                for (int j = 0; j < 4; ++j) if (nt * 16 + fq * 4 + j == bi) sc[nt][j] = -3.0e38f;
            if (fq == 0 && bi != 255) atomicAdd(&hist[h * 64 + bi], 1);
        }
        if (fq == 0) SEL[t * 8 + h] = selw | 0xff000000u;
    }
    __syncthreads();
    int* gcnt = (int*)(ws + OFF_CTL + CTL_MCNT);
    for (int i = tid; i < 512; i += 256) if (hist[i]) atomicAdd(&gcnt[i], hist[i]);
}

__device__ __forceinline__ void moba_fill(const P& p, int bid, int nb, char* smem) {
    const int tid = otid();
    char* ws = p.ws;
    const int* gcnt = (const int*)(ws + OFF_CTL + CTL_MCNT); int* gcur = (int*)(ws + OFF_CTL + CTL_MCUR);
    int* lst = (int*)smem;
    int* tst = lst + 520;
    int* lh = tst + 520;
    int* lc = lh + 512;
    for (int i = tid; i < 512; i += 256) lc[i] = gcnt[i];
    __syncthreads();
    if (tid == 0) {
        int a = 0, b = 0;
        for (int i = 0; i < 512; ++i) { const int c = lc[i]; lst[i] = a; tst[i] = b; a += c; b += (c + 63) >> 6; }
        lst[512] = a; tst[512] = b;
    }
    __syncthreads();
    for (int i = tid; i < 512; i += 256) { lh[i] = 0; lc[i] = 0; }
    __syncthreads();
    if (bid == 0) {
        int* glst = (int*)(ws + OFF_CTL + CTL_MLST); int* gtst = (int*)(ws + OFF_CTL + CTL_MTST);
        for (int i = tid; i < 513; i += 256) { glst[i] = lst[i]; gtst[i] = tst[i]; }
    }
    const unsigned* SEL = (const unsigned*)(ws + OFF_MSEL);
    int* QL = (int*)(ws + OFF_MQL); int* SP = (int*)(ws + OFF_MSP);
    const int per = (T * 8 + nb - 1) / nb, i0 = bid * per, i1 = min(T * 8, i0 + per);
    for (int i = i0 + tid; i < i1; i += 256) {
        const unsigned sw = SEL[i]; const int h = i & 7;
#pragma unroll
        for (int s = 0; s < 3; ++s) { const int j = (sw >> (8 * s)) & 255; if (j != 255) atomicAdd(&lh[h * 64 + j], 1); }
    }
    __syncthreads();
    for (int i = tid; i < 512; i += 256) { const int c = lh[i]; lh[i] = c ? atomicAdd(&gcur[i], c) : 0; }
    __syncthreads();
    for (int i = i0 + tid; i < i1; i += 256) {
        const unsigned sw = SEL[i]; const int h = i & 7;
#pragma unroll
        for (int s = 0; s < 3; ++s) {
            const int j = (sw >> (8 * s)) & 255; int pos = -1;
            if (j != 255) { const int li = h * 64 + j; pos = lst[li] + lh[li] + atomicAdd(&lc[li], 1); QL[pos] = i >> 3; }
            SP[i * 3 + s] = pos;
        }
    }
}

__device__ __forceinline__ int t5b(int n) {
    const int v = (int)(__float_as_uint((float)(n * n)) >> 23) - 119;
    return n < 16 ? n : (v > 31 ? 31 : v);
}

__device__ __forceinline__ void attn_stage(const P& p, int j, int h, int nkeys, char* smem, int tid) {
    const bf16_t* um = (const bf16_t*)(p.ws + OFF_UM); const bf16_t* vt = (const bf16_t*)(p.ws + OFF_VT);
    for (int idx = tid; idx < nkeys * 8; idx += 256) {
        const int key = idx >> 3, ch = idx & 7;
        *(u32x4*)(smem + A_LK + key * 144 + ch * 16) = *(const u32x4*)(um + (size_t)(j * 256 + key) * UMC + 512 + h * 64 + ch * 8);
    }
    const int cpr = nkeys >> 3;
    for (int idx = tid; idx < 64 * cpr; idx += 256) {
        const int d = idx / cpr, ch = idx - d * cpr;
        *(u32x4*)(smem + A_LV + d * 528 + ch * 16) = *(const u32x4*)(vt + (size_t)(h * 64 + d) * T + j * 256 + ch * 8);
    }
    if (tid < 32) ((float*)(smem + A_BIAS))[tid] = p.rel_bias[tid * 8 + h];
}
template <bool CAUSAL>
__device__ __forceinline__ void attn_core(const char* smem, const bf16_t* qrow, int qt, int kbase, int nkeys, int fr, int fq, float& m_out, float& l_out, f32x4 (&o)[4]) {
    bf16x8 qf[2];
#pragma unroll
    for (int ks = 0; ks < 2; ++ks) qf[ks] = *(const bf16x8*)(qrow + ks * 32 + fq * 8);
    const float* lb = (const float*)(smem + A_BIAS);
    const int nkt = nkeys >> 4;
    f32x4 sc[16];
    float mx = -3.0e38f;
#pragma unroll
    for (int kt = 0; kt < 16; ++kt) {
        f32x4 acc = {0.f, 0.f, 0.f, 0.f};
        if (kt < nkt) {
#pragma unroll
            for (int ks = 0; ks < 2; ++ks) acc = MFMA16(*(const bf16x8*)(smem + A_LK + (kt * 16 + fr) * 144 + (ks * 32 + fq * 8) * 2), qf[ks], acc);
#pragma unroll
            for (int jj = 0; jj < 4; ++jj) {
                const int rel = qt - (kbase + kt * 16 + fq * 4 + jj);
                float l = acc[jj] * 0.125f + lb[t5b(rel < 0 ? 0 : rel)];
                if (CAUSAL && rel < 0) l = -3.0e38f;
                acc[jj] = l; mx = fmaxf(mx, l);
            }
        } else { acc = (f32x4){-3.0e38f, -3.0e38f, -3.0e38f, -3.0e38f}; }
        sc[kt] = acc;
    }
    mx = fmaxf(mx, __shfl_xor(mx, 16)); mx = fmaxf(mx, __shfl_xor(mx, 32));
    float ls = 0.f;
#pragma unroll
    for (int kt = 0; kt < 16; ++kt)
#pragma unroll
        for (int jj = 0; jj < 4; ++jj) { const float e = (sc[kt][jj] > -1.0e38f) ? __expf(sc[kt][jj] - mx) : 0.f; sc[kt][jj] = e; ls += e; }
    ls += __shfl_xor(ls, 16); ls += __shfl_xor(ls, 32);
#pragma unroll
    for (int dt = 0; dt < 4; ++dt) o[dt] = (f32x4){0.f, 0.f, 0.f, 0.f};
#pragma unroll
    for (int s = 0; s < 8; ++s) {
        if (s * 2 < nkt) {
            const bf16x8 pf = pack8(sc[2 * s], sc[2 * s + 1]);
#pragma unroll
            for (int dt = 0; dt < 4; ++dt) o[dt] = MFMA16(ldperm(smem + A_LV + (dt * 16 + fr) * 528, s, fq), pf, o[dt]);
        }
    }
    m_out = mx; l_out = ls;
}

__device__ __forceinline__ void moba_partial(const P& p, int bid, int nb, char* smem) {
    const int tid = otid(), lane = tid & 63, w = tid >> 6, fr = lane & 15, fq = lane >> 4;
    char* ws = p.ws;
    const bf16_t* um = (const bf16_t*)(ws + OFF_UM);
    const int* glst = (const int*)(ws + OFF_CTL + CTL_MLST); const int* gtst = (const int*)(ws + OFF_CTL + CTL_MTST);
    const int* QL = (const int*)(ws + OFF_MQL);
    bf16_t* PO = (bf16_t*)p.out; float* PM = (float*)((char*)p.out + 52 * MiB); float* PL = PM + 400000;
    int* tst = (int*)(smem + A_TST);
    for (int i = tid; i < 513; i += 256) tst[i] = gtst[i];
    __syncthreads();
    const int ntiles = tst[512];
    for (int it = bid; it < ntiles; it += nb) {
        int lo = 0, hi = 512;
        while (hi - lo > 1) { const int mid = (lo + hi) >> 1; if (tst[mid] <= it) lo = mid; else hi = mid; }
        const int li = lo, h = li >> 6, j = li & 63, r = it - tst[li];
        const int l0 = glst[li], l1 = glst[li + 1], base = l0 + r * 64;
        attn_stage(p, j, h, 256, smem, tid);
        __syncthreads();
        const int idx = w * 16 + fr; const bool valid = base + idx < l1;
        const int pos = valid ? base + idx : base;
        const int qt = QL[pos];
        float m, l; f32x4 o[4];
        attn_core<false>(smem, um + (size_t)qt * UMC + h * 64, qt, j * 256, 256, fr, fq, m, l, o);
        if (valid) {
#pragma unroll
            for (int dt = 0; dt < 4; ++dt) *(u32x2*)(PO + (size_t)pos * 64 + dt * 16 + fq * 4) = pack4(o[dt]);
            if (fq == 0) { PM[pos] = m; PL[pos] = l; }
        }
        __syncthreads();
    }
}

__device__ __forceinline__ void moba_own(const P& p, int bid, int nb, char* smem) {
    const int tid = otid(), lane = tid & 63, w = tid >> 6, fr = lane & 15, fq = lane >> 4;
    char* ws = p.ws;
    const bf16_t* um = (const bf16_t*)(ws + OFF_UM);
    const int* SP = (const int*)(ws + OFF_MSP);
    const bf16_t* PO = (const bf16_t*)p.out; const float* PM = (const float*)((const char*)p.out + 52 * MiB); const float* PL = PM + 400000;
    bf16_t* ob = (bf16_t*)(ws + OFF_OB);
    for (int it = bid; it < 2048; it += nb) {
        const int tile = it >> 3, h = it & 7, b = tile >> 2, tb = tile & 3, nkeys = (tb + 1) * 64;
        attn_stage(p, b, h, nkeys, smem, tid);
        __syncthreads();
        const int qt = tile * 64 + w * 16 + fr;
        float m, l; f32x4 o[4];
        attn_core<true>(smem, um + (size_t)qt * UMC + h * 64, qt, b * 256, nkeys, fr, fq, m, l, o);
        int pos[3]; float pm[3]; float M = m;
#pragma unroll
        for (int s = 0; s < 3; ++s) { pos[s] = SP[(qt * 8 + h) * 3 + s]; pm[s] = (pos[s] >= 0) ? PM[pos[s]] : -3.0e38f; M = fmaxf(M, pm[s]); }
        const float so = __expf(m - M);
        float den = l * so;
#pragma unroll
        for (int dt = 0; dt < 4; ++dt) o[dt] = o[dt] * so;
#pragma unroll
        for (int s = 0; s < 3; ++s) {
            if (pos[s] >= 0) {
                const float e = __expf(pm[s] - M);
                den += PL[pos[s]] * e;
#pragma unroll
                for (int dt = 0; dt < 4; ++dt) {
                    const u32x2 pv = *(const u32x2*)(PO + (size_t)pos[s] * 64 + dt * 16 + fq * 4);
                    o[dt].x += e * __uint_as_float(pv.x << 16); o[dt].y += e * __uint_as_float(pv.x & 0xffff0000u);
                    o[dt].z += e * __uint_as_float(pv.y << 16); o[dt].w += e * __uint_as_float(pv.y & 0xffff0000u);
                }
            }
        }
        const float inv = 1.f / den;
#pragma unroll
        for (int dt = 0; dt < 4; ++dt) *(u32x2*)(ob + (size_t)qt * 512 + h * 64 + dt * 16 + fq * 4) = pack4(o[dt] * inv);
        __syncthreads();
    }
}

__device__ __forceinline__ void phase_merge(const P& p, int bid, int nb, char* smem) {
    TILE_COORDS
    char* ws = p.ws;
    const bf16_t* ug = (const bf16_t*)(ws + OFF_UG);
    bf16_t* mg = (bf16_t*)(ws + OFF_MRG);
    for (int it = bid; it < 128 * 8; it += nb) {
        const int pm = it >> 3, pn = it & 7;
        f32x4 acc[4][4], acc2[4][4]; zero_acc(acc); zero_acc(acc2);
        gemm_k_loop<false>(acc, (const bf16_t*)(ws + OFF_OA), 512, nullptr, pm * 128, (const bf16_t*)(ws + OFF_WORW), 512, pn * 128, 512, smem);
        gemm_k_loop<false>(acc2, (const bf16_t*)(ws + OFF_OB), 512, nullptr, pm * 128, (const bf16_t*)(ws + OFF_WOMB), 512, pn * 128, 512, smem);
#pragma unroll
        for (int m = 0; m < 4; ++m) {
            const int row = pm * 128 + wr * 64 + m * 16 + fr;
#pragma unroll
            for (int n = 0; n < 4; ++n) {
                const int col = pn * 128 + wc * 64 + n * 16 + fq * 4;
                const u32x2 ga = *(const u32x2*)(ug + (size_t)row * GCOLS + col);
                const u32x2 gb = *(const u32x2*)(ug + (size_t)row * GCOLS + 1024 + col);
                const f32x4 a = acc[m][n], b = acc2[m][n];
                const float r0 = __uint_as_float(ga.x << 16) * a.x + __uint_as_float(gb.x << 16) * b.x;
                const float r1 = __uint_as_float(ga.x & 0xffff0000u) * a.y + __uint_as_float(gb.x & 0xffff0000u) * b.y;
                const float r2 = __uint_as_float(ga.y << 16) * a.z + __uint_as_float(gb.y << 16) * b.z;
                const float r3 = __uint_as_float(ga.y & 0xffff0000u) * a.w + __uint_as_float(gb.y & 0xffff0000u) * b.w;
                u32x2 o; o.x = pk2(r0, r1); o.y = pk2(r2, r3);
                *(u32x2*)(mg + (size_t)row * D + col) = o;
            }
        }
    }
}

__device__ __forceinline__ void phase_resid_gemm(const bf16_t* A, int K, const bf16_t* Bt, const float* res, float* dst, int bid, int nb, char* smem) {
    TILE_COORDS
    for (int it = bid; it < 128 * 8; it += nb) {
        const int pm = it >> 3, pn = it & 7;
        f32x4 acc[4][4]; zero_acc(acc);
        gemm_k_loop<false>(acc, A, K, nullptr, pm * 128, Bt, K, pn * 128, K, smem);
#pragma unroll
        for (int m = 0; m < 4; ++m) {
            const int row = pm * 128 + wr * 64 + m * 16 + fr;
#pragma unroll
            for (int n = 0; n < 4; ++n) {
                const size_t off = (size_t)row * D + pn * 128 + wc * 64 + n * 16 + fq * 4;
                const f32x4 r = *(const f32x4*)(res + off);
                *(f32x4*)(dst + off) = r + acc[m][n];
            }
        }
    }
}

__device__ __forceinline__ void phase_norm(const float* src, const float* g, bf16_t* dst, int bid, int nb) {
    const int lane = otid() & 63, wid = otid() >> 6;
    for (int it = bid; it < T / 4; it += nb) { const int row = it * 4 + wid; rms_row_bf16(src + (size_t)row * D, g, dst + (size_t)row * D, lane); }
}

__device__ __forceinline__ void phase_expconv(const P& p, int bid, int nb, char* smem) {
    float* scr = (float*)smem;
    bf16_t* gu = (bf16_t*)(p.ws + OFF_EXPGU); bf16_t* dn = (bf16_t*)(p.ws + OFF_EXPD);
    for (int it = bid; it < 3 * 32 * 128; it += nb) {
        const int which = it / 4096, r = it % 4096, e = r >> 7, tile = r & 127;
        if (which == 0) transpose_tile(p.w_exp_gate + (size_t)e * D * DEXP, D, DEXP, gu + (size_t)e * D * D, 32, 0, tile, scr);
        else if (which == 1) transpose_tile(p.w_exp_up + (size_t)e * D * DEXP, D, DEXP, gu + (size_t)e * D * D, 32, 16, tile, scr);
        else transpose_tile(p.w_exp_down + (size_t)e * DEXP * D, DEXP, D, dn + (size_t)e * D * DEXP, 16, 0, tile, scr);
    }
}

__device__ __forceinline__ void phase_qx(const P& p, int bid, int nb, char* smem) {
    TILE_COORDS
    char* ws = p.ws;
    bf16_t* qx = (bf16_t*)(ws + OFF_OA);
    const float sc = 0.08838834764831845f;
    for (int it = bid; it < 128 * 4; it += nb) {
        const int pm = it >> 2, pn = it & 3;
        f32x4 acc[4][4]; zero_acc(acc);
        gemm_k_loop<false>(acc, (const bf16_t*)(ws + OFF_XN), D, nullptr, pm * 128, (const bf16_t*)(ws + OFF_WQ), D, pn * 128, D, smem);
#pragma unroll
        for (int m = 0; m < 4; ++m) {
            const int row = pm * 128 + wr * 64 + m * 16 + fr;
#pragma unroll
            for (int n = 0; n < 4; ++n) {
                const f32x4 v = acc[m][n] * sc; u32x2 o; o.x = pk2(v.x, v.y); o.y = pk2(v.z, v.w);
                *(u32x2*)(qx + (size_t)row * 512 + pn * 128 + wc * 64 + n * 16 + fq * 4) = o;
            }
        }
    }
}

__device__ __forceinline__ void xattn_naive(const P& p, int wave_id, int nwaves, float* wl  ) {
    const int lane = otid() & 63;
    const bf16_t* qx = (const bf16_t*)(p.ws + OFF_OA);
    const bf16_t* kv = (const bf16_t*)(p.ws + OFF_KVX);
    bf16_t* ox = (bf16_t*)(p.ws + OFF_OB);
    float* qs = wl; float* ps = wl + 128;
    for (int it = wave_id; it < T * 4; it += nwaves) {
        const int t = it >> 2, h = it & 3;
        {
            const unsigned w = *(const unsigned*)(qx + (size_t)t * 512 + h * 128 + lane * 2);
            qs[lane * 2] = __uint_as_float(w << 16); qs[lane * 2 + 1] = __uint_as_float(w & 0xffff0000u);
        }
        wave_lds_fence();
        float lg[4] = {0.f, 0.f, 0.f, 0.f}; float mx = -3.0e38f;
#pragma unroll 1
        for (int c4 = 0; c4 < 4; ++c4) {
            float qv[32];
#pragma unroll
            for (int e = 0; e < 32; ++e) qv[e] = qs[c4 * 32 + e];
#pragma unroll
            for (int kk = 0; kk < 4; ++kk) {
                const int key = kk * 64 + lane;
                const u32x4* kp = (const u32x4*)(kv + (size_t)key * D + h * 128 + c4 * 32);
                float dsum = 0.f;
#pragma unroll
                for (int c = 0; c < 4; ++c) { float kf[8]; unpack8(kp[c], kf);
#pragma unroll
                    for (int e = 0; e < 8; ++e) dsum += qv[c * 8 + e] * kf[e]; }
                lg[kk] += dsum;
            }
            asm volatile("" ::: "memory");
        }
#pragma unroll
        for (int kk = 0; kk < 4; ++kk) mx = fmaxf(mx, lg[kk]);
        mx = wave_max(mx);
        float sum = 0.f;
#pragma unroll
        for (int kk = 0; kk < 4; ++kk) { lg[kk] = __expf(lg[kk] - mx); sum += lg[kk]; }
        sum = wave_sum(sum);
        const float inv = 1.f / sum;
#pragma unroll
        for (int kk = 0; kk < 4; ++kk) ps[kk * 64 + lane] = lg[kk] * inv;
        wave_lds_fence();
        float o0 = 0.f, o1 = 0.f;
        const bf16_t* vp = kv + 512 + h * 128 + lane * 2;
#pragma unroll 8
        for (int k = 0; k < 256; ++k) { const unsigned w = *(const unsigned*)(vp + (size_t)k * D); const float pp = ps[k]; o0 += pp * __uint_as_float(w << 16); o1 += pp * __uint_as_float(w & 0xffff0000u); }
        *(unsigned*)(ox + (size_t)t * 512 + h * 128 + lane * 2) = pk2(o0, o1);
        wave_lds_fence();
    }
}

__device__ __forceinline__ void phase_router(const P& p, int bid, int nb, char* smem) {
    const int tid = otid(), lane = tid & 63, wid = tid >> 6;
    char* ws = p.ws;
    int* hist = (int*)smem;
    if (tid < 32) hist[tid] = 0;
    __syncthreads();
    const float* x2 = p.out;
    const float* rt = (const float*)(ws + OFF_ROUT);
    bf16_t* xn = (bf16_t*)(ws + OFF_XN);
    int* toke = (int*)(ws + OFF_CTL + CTL_TOKE); float* tokg = (float*)(ws + OFF_CTL + CTL_TOKG);
    int* rowtok = (int*)(ws + OFF_CTL + CTL_ROWTOK);
    for (int i = bid * 256 + tid; i < CAP; i += nb * 256) rowtok[i] = 0;
    for (int it = bid; it < T / 16; it += nb) {
        const int rbase = it * 16 + wid * 4;
        f32x4 hv[4][4];
#pragma unroll
        for (int rr = 0; rr < 4; ++rr) {
            const f32x4* xr = (const f32x4*)(x2 + (size_t)(rbase + rr) * D) + lane; const f32x4* gr = (const f32x4*)p.norm_ffn + lane;
            float s = 0.f;
#pragma unroll
            for (int j = 0; j < 4; ++j) { hv[rr][j] = xr[64 * j]; s += hv[rr][j].x * hv[rr][j].x + hv[rr][j].y * hv[rr][j].y + hv[rr][j].z * hv[rr][j].z + hv[rr][j].w * hv[rr][j].w; }
            const float rstd = rsqrtf(wave_sum(s) * (1.f / 1024.f) + 1e-6f);
            u32x2* o8 = (u32x2*)(xn + (size_t)(rbase + rr) * D) + lane;
#pragma unroll
            for (int j = 0; j < 4; ++j) { const f32x4 gg = gr[64 * j]; hv[rr][j] = hv[rr][j] * rstd * gg; u32x2 o; o.x = pk2(hv[rr][j].x, hv[rr][j].y); o.y = pk2(hv[rr][j].z, hv[rr][j].w); o8[64 * j] = o; }
        }
        float mine[4] = {0.f, 0.f, 0.f, 0.f};
#pragma unroll 4
        for (int o = 0; o < 36; ++o) {
            const f32x4* wr_ = (const f32x4*)(rt + o * 1024) + lane;
            f32x4 w[4];
#pragma unroll
            for (int j = 0; j < 4; ++j) w[j] = wr_[64 * j];
#pragma unroll
            for (int rr = 0; rr < 4; ++rr) {
                float s = 0.f;
#pragma unroll
                for (int j = 0; j < 4; ++j) s += hv[rr][j].x * w[j].x + hv[rr][j].y * w[j].y + hv[rr][j].z * w[j].z + hv[rr][j].w * w[j].w;
                s = wave_sum(s);
                if (lane == o) mine[rr] = s;
            }
            asm volatile("" ::: "memory");
        }
#pragma unroll
        for (int rr = 0; rr < 4; ++rr) {
            const float g0 = __shfl(mine[rr], 32), g1 = __shfl(mine[rr], 33), g2 = __shfl(mine[rr], 34), g3 = __shfl(mine[rr], 35);
            int gs = 0; float gm = g0;
            if (g1 > gm) { gm = g1; gs = 1; }
            if (g2 > gm) { gm = g2; gs = 2; }
            if (g3 > gm) { gm = g3; gs = 3; }
            const float gp = 1.f / (__expf(g0 - gm) + __expf(g1 - gm) + __expf(g2 - gm) + __expf(g3 - gm));
            float e[8];
#pragma unroll
            for (int i = 0; i < 8; ++i) e[i] = __shfl(mine[rr], gs * 8 + i);
            int i1 = 0; float v1 = e[0];
#pragma unroll
            for (int i = 1; i < 8; ++i) if (e[i] > v1) { v1 = e[i]; i1 = i; }
            int i2 = -1; float v2 = -3.0e38f;
#pragma unroll
            for (int i = 0; i < 8; ++i) if (i != i1 && e[i] > v2) { v2 = e[i]; i2 = i; }
            const float e2 = __expf(v2 - v1), den = 1.f / (1.f + e2);
            if (lane == 0) {
                const int tok = rbase + rr;
                toke[tok * 2] = gs * 8 + i1; toke[tok * 2 + 1] = gs * 8 + i2;
                tokg[tok * 2] = gp * den; tokg[tok * 2 + 1] = gp * e2 * den;
                atomicAdd(&hist[gs * 8 + i1], 1); atomicAdd(&hist[gs * 8 + i2], 1);
            }
        }
    }
    __syncthreads();
    if (tid < 32 && hist[tid]) atomicAdd((int*)(ws + OFF_CTL + CTL_CNT) + tid, hist[tid]);
}

__device__ __forceinline__ void phase_dispatch(const P& p, int bid, int nb, char* smem) {
    const int tid = otid();
    char* ws = p.ws;
    int* pstart = (int*)smem;
    const int* counts = (const int*)(ws + OFF_CTL + CTL_CNT);
    int* cursor = (int*)(ws + OFF_CTL + CTL_CNT) + 32;
    if (tid == 0) { int a = 0; for (int e = 0; e < 32; ++e) { pstart[e] = a; a += (counts[e] + 127) / 128 * 128; } pstart[32] = a; }
    __syncthreads();
    const int* toke = (const int*)(ws + OFF_CTL + CTL_TOKE);
    int* toks = (int*)(ws + OFF_CTL + CTL_TOKS); int* rowtok = (int*)(ws + OFF_CTL + CTL_ROWTOK);
    for (int i = bid * 256 + tid; i < T * 2; i += nb * 256) {
        const int e = toke[i];
        const int pos = pstart[e] + atomicAdd(&cursor[e], 1);
        rowtok[pos] = i >> 1; toks[i] = pos;
    }
    if (bid == 0) {
        int* blke = (int*)(ws + OFF_CTL + CTL_BLKE);
        for (int b = tid; b < NBLK; b += 256) {
            const int r = b * 128; int e = -1;
            if (r < pstart[32]) { e = 0; while (pstart[e + 1] <= r) ++e; }
            blke[b] = e;
        }
    }
}

__device__ __forceinline__ void phase_exp1(const P& p, int bid, int nb, char* smem) {
    TILE_COORDS
    char* ws = p.ws;
    const int* blke = (const int*)(ws + OFF_CTL + CTL_BLKE); const int* rowtok = (const int*)(ws + OFF_CTL + CTL_ROWTOK);
    bf16_t* hid = (bf16_t*)(ws + OFF_MRG);
    for (int it = bid; it < NBLK * 8; it += nb) {
        const int b = it >> 3, pn = it & 7, e = blke[b];
        if (e < 0) continue;
        f32x4 acc[4][4]; zero_acc(acc);
        gemm_k_loop<true>(acc, (const bf16_t*)(ws + OFF_XN), D, rowtok + b * 128, 0, (const bf16_t*)(ws + OFF_EXPGU) + (size_t)e * D * D, D, pn * 128, D, smem);
#pragma unroll
        for (int m = 0; m < 4; ++m) {
            const int row = b * 128 + wr * 64 + m * 16 + fr;
#pragma unroll
            for (int n2 = 0; n2 < 2; ++n2) {
                const f32x4 g = acc[m][n2 * 2], u = acc[m][n2 * 2 + 1];
                const float h0 = g.x * sigm(g.x) * u.x, h1 = g.y * sigm(g.y) * u.y, h2 = g.z * sigm(g.z) * u.z, h3 = g.w * sigm(g.w) * u.w;
                u32x2 o; o.x = pk2(h0, h1); o.y = pk2(h2, h3);
                *(u32x2*)(hid + (size_t)row * DEXP + pn * 64 + wc * 32 + n2 * 16 + fq * 4) = o;
            }
        }
    }
}
__device__ __forceinline__ void phase_exp2(const P& p, int bid, int nb, char* smem) {
    TILE_COORDS
    char* ws = p.ws;
    const int* blke = (const int*)(ws + OFF_CTL + CTL_BLKE);
    bf16_t* ym = (bf16_t*)(ws + OFF_YMOE);
    for (int it = bid; it < NBLK * 8; it += nb) {
        const int b = it >> 3, pn = it & 7, e = blke[b];
        if (e < 0) continue;
        f32x4 acc[4][4]; zero_acc(acc);
        gemm_k_loop<false>(acc, (const bf16_t*)(ws + OFF_MRG), DEXP, nullptr, b * 128, (const bf16_t*)(ws + OFF_EXPD) + (size_t)e * D * DEXP, DEXP, pn * 128, DEXP, smem);
#pragma unroll
        for (int m = 0; m < 4; ++m) {
            const int row = b * 128 + wr * 64 + m * 16 + fr;
#pragma unroll
            for (int n = 0; n < 4; ++n) {
                const f32x4 v = acc[m][n]; u32x2 o; o.x = pk2(v.x, v.y); o.y = pk2(v.z, v.w);
                *(u32x2*)(ym + (size_t)row * D + pn * 128 + wc * 64 + n * 16 + fq * 4) = o;
            }
        }
    }
}
__device__ __forceinline__ void phase_final(const P& p, int bid, int nb) {
    const int lane = otid() & 63, wid = otid() >> 6;
    char* ws = p.ws;
    const int* toks = (const int*)(ws + OFF_CTL + CTL_TOKS); const float* tokg = (const float*)(ws + OFF_CTL + CTL_TOKG);
    const bf16_t* ym = (const bf16_t*)(ws + OFF_YMOE);
    for (int it = bid; it < T / 4; it += nb) {
        const int row = it * 4 + wid;
        const int s1 = toks[row * 2], s2 = toks[row * 2 + 1]; const float g1 = tokg[row * 2], g2 = tokg[row * 2 + 1];
        f32x4* xr = (f32x4*)(p.out + (size_t)row * D) + lane; const f32x4* gr = (const f32x4*)p.norm_final + lane;
        const u32x2* y1 = (const u32x2*)(ym + (size_t)s1 * D) + lane; const u32x2* y2 = (const u32x2*)(ym + (size_t)s2 * D) + lane;
        f32x4 v[4]; float s = 0.f;
#pragma unroll
        for (int j = 0; j < 4; ++j) {
            v[j] = xr[64 * j]; const u32x2 a = y1[64 * j], b = y2[64 * j];
            v[j].x += g1 * __uint_as_float(a.x << 16) + g2 * __uint_as_float(b.x << 16);
            v[j].y += g1 * __uint_as_float(a.x & 0xffff0000u) + g2 * __uint_as_float(b.x & 0xffff0000u);
            v[j].z += g1 * __uint_as_float(a.y << 16) + g2 * __uint_as_float(b.y << 16);
            v[j].w += g1 * __uint_as_float(a.y & 0xffff0000u) + g2 * __uint_as_float(b.y & 0xffff0000u);
            s += v[j].x * v[j].x + v[j].y * v[j].y + v[j].z * v[j].z + v[j].w * v[j].w;
        }
        const float rstd = rsqrtf(wave_sum(s) * (1.f / 1024.f) + 1e-6f);
#pragma unroll
        for (int j = 0; j < 4; ++j) xr[64 * j] = v[j] * rstd * gr[64 * j];
    }
}

constexpr int NPHASE = 18;
template <int PH>
__device__ __forceinline__ void run_phase(const P& p, int bid, int nb, char* smem) {
    char* ws = p.ws;
    if (PH == 0) phase0(p, bid, nb, smem);
    else if (PH == 1) phase1(p, bid, nb, smem);
    else if (PH == 2) { phase_kmean(p, bid, nb, smem); phase_rw_chunk(p, bid, nb, smem); }
    else if (PH == 3) { if (bid < 8) rw_scan(p, bid); else moba_select(p, bid - 8, nb - 8, smem); }
    else if (PH == 4) { phase_rw_out(p, bid, nb); moba_fill(p, bid, nb, smem); }
    else if (PH == 5) moba_partial(p, bid, nb, smem);
    else if (PH == 6) moba_own(p, bid, nb, smem);
    else if (PH == 7) phase_merge(p, bid, nb, smem);
    else if (PH == 8) phase_resid_gemm((const bf16_t*)(ws + OFF_MRG), D, (const bf16_t*)(ws + OFF_WOUT), p.x, p.out, bid, nb, smem);
    else if (PH == 9) { phase_norm(p.out, p.norm_xattn, (bf16_t*)(ws + OFF_XN), bid, nb); phase_expconv(p, bid, nb, smem); }
    else if (PH == 10) phase_qx(p, bid, nb, smem);
    else if (PH == 11) xattn_naive(p, bid * 4 + (otid() >> 6), nb * 4, (float*)smem + (otid() >> 6) * 384);
    else if (PH == 12) phase_resid_gemm((const bf16_t*)(ws + OFF_OB), 512, (const bf16_t*)(ws + OFF_WOX), p.out, p.out, bid, nb, smem);
    else if (PH == 13) phase_router(p, bid, nb, smem);
    else if (PH == 14) phase_dispatch(p, bid, nb, smem);
    else if (PH == 15) phase_exp1(p, bid, nb, smem);
    else if (PH == 16) phase_exp2(p, bid, nb, smem);
    else if (PH == 17) phase_final(p, bid, nb);
}

#define XB_TMO      128
#define XB_XCNT(j)  (256  + 64 * (j))
#define XB_XSUB(j)  (1280 + 64 * (j))
#define XB_XGEN(j)  (2304 + 64 * (j))
#define XB_TOP      3328
#define XB_TOPGEN   3392
#define XCD_BAR_WORDS 3456
#define XB_SPIN_CAP (1u << 18)
#define LAS __attribute__((address_space(3)))
__device__ __forceinline__ unsigned xb_ld(unsigned* p)              { return __hip_atomic_load(p, __ATOMIC_RELAXED, __HIP_MEMORY_SCOPE_AGENT); }
__device__ __forceinline__ unsigned xb_add(unsigned* p, unsigned v) { return __hip_atomic_fetch_add(p, v, __ATOMIC_RELAXED, __HIP_MEMORY_SCOPE_AGENT); }
__device__ __forceinline__ unsigned xb_xcc_id() { return (unsigned)__builtin_amdgcn_s_getreg((3 << 11) | 20) & 0xFu; }
#define XB_SPIN(cond, bar) do { unsigned _sp = 0; while (cond) { __builtin_amdgcn_s_sleep(1); \
    if ((++_sp & 255u) == 0u) { if (xb_ld(&(bar)[XB_TMO])) break; if (_sp > XB_SPIN_CAP) { atomicAdd(&(bar)[XB_TMO], 1u); break; } } } } while (0)
struct XcdBarrier { unsigned* bar; unsigned x; volatile LAS unsigned* st; };
__device__ __forceinline__ XcdBarrier xcd_barrier_post(unsigned* bar, volatile LAS unsigned* st) {
    XcdBarrier b; b.bar = bar; b.x = xb_xcc_id(); b.st = st;
    if (threadIdx.x == 0) (void)xb_add(&bar[XB_XCNT(b.x)], 1u);
    return b;
}
__device__ __forceinline__ void xcd_barrier_complete(unsigned* bar, unsigned x, unsigned& nloc, unsigned& nx) {
    const unsigned G = gridDim.x * gridDim.y * gridDim.z;
    unsigned sum, cnt, mine, sp = 0u;
    for (;;) {
        sum = 0u; cnt = 0u; mine = 0u;
#pragma unroll
        for (unsigned j = 0; j < 16; ++j) { const unsigned c = xb_ld(&bar[XB_XCNT(j)]); sum += c; cnt += (c > 0u) ? 1u : 0u; mine = (j == x) ? c : mine; }
        if (sum == G) break;
        __builtin_amdgcn_s_sleep(1);
        if ((++sp & 255u) == 0u) { if (xb_ld(&bar[XB_TMO])) break; if (sp > XB_SPIN_CAP) { atomicAdd(&bar[XB_TMO], 1u); break; } }
    }
    nloc = mine > 0u ? mine : 1u; nx = cnt > 0u ? cnt : 1u;
}
__device__ __forceinline__ void xcd_barrier(const XcdBarrier& b) {
    asm volatile("s_waitcnt vmcnt(0)" ::: "memory");
    __syncthreads();
    if (threadIdx.x == 0) {
        unsigned* bar = b.bar;
        __builtin_amdgcn_s_waitcnt(0);
        unsigned nloc = b.st[0], nx = b.st[1];
        if (nloc == 0u) { xcd_barrier_complete(bar, b.x, nloc, nx); b.st[0] = nloc; b.st[1] = nx; }
        const unsigned old = xb_add(&bar[XB_XSUB(b.x)], 1u);
        const unsigned gen = old / nloc;
        if (old + 1u == (gen + 1u) * nloc) {
            __builtin_amdgcn_fence(__ATOMIC_RELEASE, "agent");
            asm volatile("s_waitcnt vmcnt(0)" ::: "memory");
            const unsigned og = xb_add(&bar[XB_TOP], 1u);
            const unsigned tg = og / nx;
            if (og + 1u == (tg + 1u) * nx) xb_add(&bar[XB_TOPGEN], 1u);
            else XB_SPIN(xb_ld(&bar[XB_TOPGEN]) == tg, bar);
            __builtin_amdgcn_fence(__ATOMIC_ACQUIRE, "agent");
            xb_add(&bar[XB_XGEN(b.x)], 1u);
            asm volatile("s_waitcnt vmcnt(0)" ::: "memory");
        } else {
            XB_SPIN(xb_ld(&bar[XB_XGEN(b.x)]) == gen, bar);
            __builtin_amdgcn_fence(__ATOMIC_ACQUIRE, "agent");
            asm volatile("s_waitcnt vmcnt(0)" ::: "memory");
        }
    }
    __syncthreads();
}
constexpr size_t CTL_BAR = 736 * 1024;
constexpr int L_BARST = 75200;

constexpr int LDS_BYTES = 75264;
static_assert(RW_LDS <= LDS_BYTES, "lds");
template <int PH>
__global__ void __launch_bounds__(256, 2) phase_kernel(P p) {
    extern __shared__ __attribute__((aligned(16))) char smem[];
    run_phase<PH>(p, blockIdx.x, gridDim.x, smem);
}

#ifndef NO_MEGA
__global__ void __launch_bounds__(256, 2) mega_kernel(P p) {
    extern __shared__ __attribute__((aligned(16))) char smem[];
    cg::grid_group grid = cg::this_grid();
    const int bid = blockIdx.x, nb = gridDim.x;
    volatile LAS unsigned* bst = (volatile LAS unsigned*)(LAS char*)(smem + L_BARST);
    if (threadIdx.x < 2) bst[threadIdx.x] = 0u;
    __syncthreads();
    const XcdBarrier xb = xcd_barrier_post((unsigned*)(p.ws + OFF_CTL + CTL_BAR), bst);
#define GSYNC() xcd_barrier(xb)
    run_phase<0>(p, bid, nb, smem); grid.sync();
    run_phase<1>(p, bid, nb, smem); GSYNC();
    run_phase<2>(p, bid, nb, smem); GSYNC();
    run_phase<3>(p, bid, nb, smem); GSYNC();
    run_phase<4>(p, bid, nb, smem); GSYNC();
    run_phase<5>(p, bid, nb, smem); GSYNC();
    run_phase<6>(p, bid, nb, smem); GSYNC();
    run_phase<7>(p, bid, nb, smem); GSYNC();
    run_phase<8>(p, bid, nb, smem); GSYNC();
    run_phase<9>(p, bid, nb, smem); GSYNC();
    run_phase<10>(p, bid, nb, smem); GSYNC();
    run_phase<11>(p, bid, nb, smem); GSYNC();
    run_phase<12>(p, bid, nb, smem); GSYNC();
    run_phase<13>(p, bid, nb, smem); GSYNC();
    run_phase<14>(p, bid, nb, smem); GSYNC();
    run_phase<15>(p, bid, nb, smem); GSYNC();
    run_phase<16>(p, bid, nb, smem); GSYNC();
    run_phase<17>(p, bid, nb, smem);
}

extern "C" void kernel_launch(void* const* d_in, const int* in_sizes, int n_in, void* d_out, int out_size, void* d_ws, size_t ws_size, hipStream_t stream) {
    if (n_in != 31 || ws_size < WS_NEED || out_size != T * D) { fprintf(stderr, "kernel_launch: unexpected n_in %d / ws_size %zu / out_size %d\n", n_in, ws_size, out_size); return; }
    static int grid_blocks = 0;
    if (!grid_blocks) {
        int dev = 0, cus = 0, per_cu = 0;
        hipGetDevice(&dev);
        hipDeviceGetAttribute(&cus, hipDeviceAttributeMultiprocessorCount, dev);
        if (hipFuncSetAttribute((const void*)mega_kernel, hipFuncAttributeMaxDynamicSharedMemorySize, LDS_BYTES) != hipSuccess) fprintf(stderr, "kernel_launch: hipFuncSetAttribute failed\n");
        hipOccupancyMaxActiveBlocksPerMultiprocessor(&per_cu, (const void*)mega_kernel, 256, LDS_BYTES);
        if (per_cu > 2) per_cu = 2;
        if (per_cu < 1) { fprintf(stderr, "kernel_launch: occupancy query returned %d\n", per_cu); per_cu = 1; }
        grid_blocks = cus * per_cu;
        fprintf(stderr, "kernel_launch: cus %d per_cu %d grid %d\n", cus, per_cu, grid_blocks);
    }
    P p{};
    const float** f = (const float**)&p;
    for (int i = 0; i < 31; ++i) f[i] = (const float*)d_in[i];
    p.out = (float*)d_out; p.ws = (char*)d_ws;
    if (hipMemsetAsync((char*)d_ws + OFF_CTL + CTL_BAR, 0, XCD_BAR_WORDS * 4, stream) != hipSuccess) fprintf(stderr, "kernel_launch: memset failed\n");
    void* args[] = {&p};
    hipError_t e = hipLaunchCooperativeKernel((const void*)mega_kernel, dim3(grid_blocks), dim3(256), args, LDS_BYTES, stream);
    if (e != hipSuccess) fprintf(stderr, "cooperative launch failed: %s (grid %d)\n", hipGetErrorString(e), grid_blocks);
}
#endif
```

```cpp
#include <hip/hip_runtime.h>
#include <hip/hip_cooperative_groups.h>
#include <cstdio>
#include <cstdint>
namespace cg = cooperative_groups;

typedef unsigned short bf16_t;
typedef short bf16x8 __attribute__((ext_vector_type(8)));
typedef float f32x4 __attribute__((ext_vector_type(4)));
typedef unsigned u32x4 __attribute__((ext_vector_type(4)));
typedef unsigned u32x2 __attribute__((ext_vector_type(2)));

constexpr int T = 16384, D = 1024, NMEM = 256;
constexpr int UMC = 1024;
constexpr int RW = 512, RCOLS = 1792, MW = 512, MCOLS = 1536, GCOLS = 2048, INCOLS = 5376;
constexpr int NEXP = 32, DEXP = 512, CAP = 36864, NBLK = 288;
constexpr size_t MiB = 1u << 20;
constexpr size_t OFF_CTL = 0;
constexpr size_t OFF_WIN = 1 * MiB;
constexpr size_t OFF_WORW = OFF_WIN + (size_t)INCOLS * D * 2;
constexpr size_t OFF_WOMB = OFF_WORW + 1 * MiB;
constexpr size_t OFF_WOUT = OFF_WOMB + 1 * MiB;
constexpr size_t OFF_WQ = OFF_WOUT + 2 * MiB;
constexpr size_t OFF_WKV = OFF_WQ + 1 * MiB;
constexpr size_t OFF_WOX = OFF_WKV + 2 * MiB;
constexpr size_t OFF_MEMN = OFF_WOX + 1 * MiB;
constexpr size_t OFF_KVX = OFF_MEMN + MiB / 2;
constexpr size_t OFF_ROUT = OFF_KVX + MiB / 2;
constexpr size_t OFF_XN = 21 * MiB;
constexpr size_t OFF_UG = 53 * MiB;
constexpr size_t OFF_UR = 117 * MiB;
constexpr size_t OFF_UM = 173 * MiB;
constexpr size_t OFF_VT = 205 * MiB;
constexpr size_t OFF_MSEL = 285 * MiB;
constexpr size_t OFF_MQL = OFF_MSEL + MiB / 2;
constexpr size_t OFF_MSP = OFF_MQL + 3 * MiB / 2;
constexpr size_t OFF_OA = 221 * MiB;
constexpr size_t OFF_OB = 237 * MiB;
constexpr size_t OFF_MRG = 253 * MiB;
constexpr size_t OFF_EXPGU = 117 * MiB;
constexpr size_t OFF_EXPD = 181 * MiB;
constexpr size_t OFF_YMOE = 21 * MiB;
constexpr size_t OFF_LORA_D = OFF_ROUT + 160 * 1024;
constexpr size_t OFF_LORA_I = OFF_LORA_D + 64 * 1024;
constexpr size_t OFF_LORA_G = OFF_LORA_I + 64 * 1024;
constexpr size_t OFF_BON = 21 * MiB;
constexpr size_t OFF_RH = 37 * MiB;
constexpr size_t OFF_MF = 253 * MiB;
constexpr size_t OFF_SF = 269 * MiB;
constexpr size_t WS_NEED = 289 * MiB;
static_assert(OFF_ROUT + MiB / 2 == OFF_XN, "ws map");
constexpr size_t CTL_CNT = 0;
constexpr size_t CTL_BLKE = 4096;
constexpr size_t CTL_MCNT = 8192, CTL_MCUR = 10240, CTL_MLST = 12288, CTL_MTST = 14592;
constexpr size_t CTL_KMB = 768 * 1024;
constexpr size_t CTL_TOKE = 192 * 1024;
constexpr size_t CTL_TOKG = 320 * 1024;
constexpr size_t CTL_TOKS = 448 * 1024;
constexpr size_t CTL_ROWTOK = 576 * 1024;

struct P {
    const float *x, *mem, *rel_bias, *mem_norm, *norm_mix, *w_in, *tshift_mu, *decay_w0, *decay_up, *iclr_a0, *iclr_up, *gate_up,
        *k_k, *k_a, *r_k, *ln_x_w, *ln_x_b, *w_o_rwkv, *w_o_moba, *w_out, *norm_xattn, *w_q_x, *w_kv_x, *w_o_x, *norm_ffn,
        *w_router_group, *w_router_expert, *w_exp_gate, *w_exp_up, *w_exp_down, *norm_final;
    float* out;
    char* ws;
};

__device__ __forceinline__ int otid() { int t = threadIdx.x; asm volatile("" : "+v"(t)); return t; }
__device__ __forceinline__ float bf2f(bf16_t b) { return __uint_as_float((unsigned)b << 16); }
__device__ __forceinline__ unsigned f2bf(float f) { unsigned u = __float_as_uint(f); return (u + 0x7fffu + ((u >> 16) & 1u)) >> 16; }
__device__ __forceinline__ unsigned pk2(float lo, float hi) { return f2bf(lo) | (f2bf(hi) << 16); }
__device__ __forceinline__ float wave_sum(float v) {
#pragma unroll
    for (int o = 32; o >= 1; o >>= 1) v += __shfl_xor(v, o);
    return v;
}
__device__ __forceinline__ float wave_max(float v) {
#pragma unroll
    for (int o = 32; o >= 1; o >>= 1) v = fmaxf(v, __shfl_xor(v, o));
    return v;
}
__device__ __forceinline__ float sigm(float x) { return 1.f / (1.f + __expf(-x)); }
__device__ __forceinline__ void wave_lds_fence() { asm volatile("s_waitcnt lgkmcnt(0)" ::: "memory"); __builtin_amdgcn_wave_barrier(); }
__device__ __forceinline__ int t5_bucket(int n) {
    if (n < 16) return n;
    int v = 8 + (31 - __clz(n * n));
    return v > 31 ? 31 : v;
}
__device__ __forceinline__ void unpack8(u32x4 w, float* f) {
    f[0] = __uint_as_float(w.x << 16); f[1] = __uint_as_float(w.x & 0xffff0000u);
    f[2] = __uint_as_float(w.y << 16); f[3] = __uint_as_float(w.y & 0xffff0000u);
    f[4] = __uint_as_float(w.z << 16); f[5] = __uint_as_float(w.z & 0xffff0000u);
    f[6] = __uint_as_float(w.w << 16); f[7] = __uint_as_float(w.w & 0xffff0000u);
}

template <bool GATHER, bool SWAP, bool R32, int NM, int NN>
__device__ __forceinline__ void gemm_core(f32x4 (&acc)[NM][NN], const bf16_t* A, int lda, const int* rows, int brow,
                                          const bf16_t* Bt, int ldb, int bcol, int K, char* smem) {
    const int tid = otid(), lane = tid & 63, wid = tid >> 6, fr = lane & 15, fq = lane >> 4;
    const int arow0 = R32 ? wid * 32 : (wid >> 1) * 64, brow0 = R32 ? 0 : (wid & 1) * 64;
    const int r0 = tid >> 3, lch = (tid & 7) ^ ((tid >> 4) & 7);
    const bf16_t* pa[4]; const bf16_t* pb[4];
#pragma unroll
    for (int i = 0; i < 4; ++i) {
        const long ra = GATHER ? (long)rows[r0 + 32 * i] : (long)(brow + r0 + 32 * i);
        pa[i] = A + ra * lda + lch * 8;
        pb[i] = Bt + (long)(bcol + r0 + 32 * i) * ldb + lch * 8;
    }
    const int nk = K / 64;
#pragma unroll
    for (int i = 0; i < 4; ++i) {
        __builtin_amdgcn_global_load_lds((const unsigned*)pa[i], (unsigned*)(smem + tid * 16 + i * 4096), 16, 0, 0);
        __builtin_amdgcn_global_load_lds((const unsigned*)pb[i], (unsigned*)(smem + 16384 + tid * 16 + i * 4096), 16, 0, 0);
    }
    const int sw = fr >> 1;
    for (int kt = 0; kt < nk; ++kt) {
        asm volatile("s_waitcnt vmcnt(0)" ::: "memory");
        __syncthreads();
        char* cur = smem + (kt & 1) * 32768;
        if (kt + 1 < nk) {
            char* nxt = smem + ((kt + 1) & 1) * 32768;
#pragma unroll
            for (int i = 0; i < 4; ++i) {
                __builtin_amdgcn_global_load_lds((const unsigned*)(pa[i] + (kt + 1) * 64), (unsigned*)(nxt + tid * 16 + i * 4096), 16, 0, 0);
                __builtin_amdgcn_global_load_lds((const unsigned*)(pb[i] + (kt + 1) * 64), (unsigned*)(nxt + 16384 + tid * 16 + i * 4096), 16, 0, 0);
            }
        }
#pragma unroll
        for (int ks = 0; ks < 2; ++ks) {
            const int pc = ((ks * 4 + fq) ^ sw) * 16;
            bf16x8 At[NM], Bf[NN];
#pragma unroll
            for (int m = 0; m < NM; ++m) At[m] = *(const bf16x8*)(cur + (arow0 + m * 16 + fr) * 128 + pc);
#pragma unroll
            for (int n = 0; n < NN; ++n) Bf[n] = *(const bf16x8*)(cur + 16384 + (brow0 + n * 16 + fr) * 128 + pc);
#pragma unroll
            for (int m = 0; m < NM; ++m)
#pragma unroll
                for (int n = 0; n < NN; ++n) acc[m][n] = SWAP ? __builtin_amdgcn_mfma_f32_16x16x32_bf16(At[m], Bf[n], acc[m][n], 0, 0, 0) : __builtin_amdgcn_mfma_f32_16x16x32_bf16(Bf[n], At[m], acc[m][n], 0, 0, 0);
        }
    }
    __syncthreads();
}
template <bool GATHER, bool SWAP = false>
__device__ __forceinline__ void gemm_k_loop(f32x4 (&acc)[4][4], const bf16_t* A, int lda, const int* rows, int brow, const bf16_t* Bt, int ldb, int bcol, int K, char* smem) {
    gemm_core<GATHER, SWAP, false, 4, 4>(acc, A, lda, rows, brow, Bt, ldb, bcol, K, smem);
}
__device__ __forceinline__ void zero_acc(f32x4 (&acc)[4][4]) {
#pragma unroll
    for (int m = 0; m < 4; ++m)
#pragma unroll
        for (int n = 0; n < 4; ++n) acc[m][n] = (f32x4){0.f, 0.f, 0.f, 0.f};
}
#define TILE_COORDS const int tid = otid(), lane = tid & 63, wid = tid >> 6, wr = wid >> 1, wc = wid & 1, fr = lane & 15, fq = lane >> 4; (void)wr; (void)wc; (void)fr; (void)fq; (void)lane;

__device__ __forceinline__ void transpose_tile(const float* W, int K, int N, bf16_t* Wt, int rs, int roff, int tile, float* scr  ) {
    const int tid = otid();
    const int nnb = N / 64, kb = tile / nnb, nb = tile % nnb, k0 = kb * 64, n0 = nb * 64;
#pragma unroll 4
    for (int i = 0; i < 16; ++i) { const int k = i * 4 + (tid >> 6), n = tid & 63; scr[k * 65 + n] = W[(size_t)(k0 + k) * N + n0 + n]; }
    __syncthreads();
#pragma unroll
    for (int i = 0; i < 2; ++i) {
        const int c = tid + i * 256, n = c >> 3, kc = c & 7;
        const float* s = scr + (kc * 8) * 65 + n;
        u32x4 o; o.x = pk2(s[0], s[65]); o.y = pk2(s[2 * 65], s[3 * 65]); o.z = pk2(s[4 * 65], s[5 * 65]); o.w = pk2(s[6 * 65], s[7 * 65]);
        const int nn = n0 + n, drow = (nn >> 4) * rs + (nn & 15) + roff;
        *(u32x4*)(Wt + (size_t)drow * K + k0 + kc * 8) = o;
    }
    __syncthreads();
}
__device__ __forceinline__ void rms_row_bf16(const float* xrow, const float* g, bf16_t* orow, int lane) {
    const f32x4* xr = (const f32x4*)xrow + lane; const f32x4* gr = (const f32x4*)g + lane;
    f32x4 v[4]; float s = 0.f;
#pragma unroll
    for (int j = 0; j < 4; ++j) { v[j] = xr[64 * j]; s += v[j].x * v[j].x + v[j].y * v[j].y + v[j].z * v[j].z + v[j].w * v[j].w; }
    const float rstd = rsqrtf(wave_sum(s) * (1.f / 1024.f) + 1e-6f);
    u32x2* o8 = (u32x2*)orow + lane;
#pragma unroll
    for (int j = 0; j < 4; ++j) { const f32x4 gg = gr[64 * j]; u32x2 o; o.x = pk2(v[j].x * rstd * gg.x, v[j].y * rstd * gg.y); o.y = pk2(v[j].z * rstd * gg.z, v[j].w * rstd * gg.w); o8[64 * j] = o; }
}

constexpr int P0_T_IN = 16 * 84, P0_T_A = 128, P0_T_B = 256;
constexpr int P0_T_L = 8 + 8 + 16;
constexpr int P0_TR = P0_T_IN + 4 * P0_T_A + 2 * P0_T_B + P0_T_L;
constexpr int P0_ROUT = 144, P0_NORM = T / 4, P0_MEM = NMEM / 4;
constexpr int P0_ITEMS = P0_TR + P0_ROUT + P0_NORM + P0_MEM + 1;

__device__ __forceinline__ void phase0(const P& p, int bid, int nb, char* smem) {
    const int tid = otid(), lane = tid & 63, wid = tid >> 6;
    char* ws = p.ws;
    for (int it = bid; it < P0_ITEMS; it += nb) {
        int r = it;
        if (r < P0_TR) {
            float* scr = (float*)smem;
            if (r < P0_T_IN) { transpose_tile(p.w_in, D, INCOLS, (bf16_t*)(ws + OFF_WIN), 16, 0, r, scr); continue; } r -= P0_T_IN;
            if (r < P0_T_A) { transpose_tile(p.w_o_rwkv, RW, D, (bf16_t*)(ws + OFF_WORW), 16, 0, r, scr); continue; } r -= P0_T_A;
            if (r < P0_T_A) { transpose_tile(p.w_o_moba, MW, D, (bf16_t*)(ws + OFF_WOMB), 16, 0, r, scr); continue; } r -= P0_T_A;
            if (r < P0_T_B) { transpose_tile(p.w_out, D, D, (bf16_t*)(ws + OFF_WOUT), 16, 0, r, scr); continue; } r -= P0_T_B;
            if (r < P0_T_A) { transpose_tile(p.w_q_x, D, 512, (bf16_t*)(ws + OFF_WQ), 16, 0, r, scr); continue; } r -= P0_T_A;
            if (r < P0_T_B) { transpose_tile(p.w_kv_x, D, D, (bf16_t*)(ws + OFF_WKV), 16, 0, r, scr); continue; } r -= P0_T_B;
            if (r < P0_T_A) { transpose_tile(p.w_o_x, 512, D, (bf16_t*)(ws + OFF_WOX), 16, 0, r, scr); continue; } r -= P0_T_A;
            if (r < 8) { transpose_tile(p.decay_up, 64, 512, (bf16_t*)(ws + OFF_LORA_D), 16, 0, r, scr); continue; } r -= 8;
            if (r < 8) { transpose_tile(p.iclr_up, 64, 512, (bf16_t*)(ws + OFF_LORA_I), 16, 0, r, scr); continue; } r -= 8;
            transpose_tile(p.gate_up, 128, 512, (bf16_t*)(ws + OFF_LORA_G), 16, 0, r, scr); continue;
        }
        r -= P0_TR;
        if (r < P0_ROUT) {
            const int e = r * 256 + tid, o = e >> 10, k = e & 1023;
            float* rt = (float*)(ws + OFF_ROUT);
            rt[e] = (o < 32) ? p.w_router_expert[k * 32 + o] : p.w_router_group[k * 4 + (o - 32)];
            continue;
        }
        r -= P0_ROUT;
        if (r < P0_NORM) { const int row = r * 4 + wid; rms_row_bf16(p.x + (size_t)row * D, p.norm_mix, (bf16_t*)(ws + OFF_XN) + (size_t)row * D, lane); continue; }
        r -= P0_NORM;
        if (r < P0_MEM) { const int row = r * 4 + wid; rms_row_bf16(p.mem + (size_t)row * D, p.mem_norm, (bf16_t*)(ws + OFF_MEMN) + (size_t)row * D, lane); continue; }
        if (tid < 64) ((int*)(ws + OFF_CTL + CTL_CNT))[tid] = 0;
        for (int i = tid; i < 1024; i += 256) ((int*)(ws + OFF_CTL + CTL_MCNT))[i] = 0;
    }
}

__device__ __forceinline__ void phase1(const P& p, int bid, int nb, char* smem) {
    TILE_COORDS
    char* ws = p.ws;
    constexpr int NT_U = (T / 128) * 42;
    for (int it = bid; it < NT_U + 16; it += nb) {
        f32x4 acc[4][4]; zero_acc(acc);
        if (it < NT_U) {
            const int pm = it / 42, pn = it % 42;
            const int colt = pn * 128;
            if (colt >= RCOLS + 1024 && colt < RCOLS + MCOLS) {
                gemm_k_loop<false, true>(acc, (const bf16_t*)(ws + OFF_XN), D, nullptr, pm * 128, (const bf16_t*)(ws + OFF_WIN), D, pn * 128, D, smem);
                bf16_t* vt = (bf16_t*)(ws + OFF_VT);
#pragma unroll
                for (int m = 0; m < 4; ++m)
#pragma unroll
                    for (int n = 0; n < 4; ++n) {
                        const int col = colt - (RCOLS + 1024) + wc * 64 + n * 16 + fr, row = pm * 128 + wr * 64 + m * 16 + fq * 4;
                        const f32x4 v = acc[m][n]; u32x2 o; o.x = pk2(v.x, v.y); o.y = pk2(v.z, v.w);
                        *(u32x2*)(vt + (size_t)col * T + row) = o;
                    }
                continue;
            }
            gemm_k_loop<false>(acc, (const bf16_t*)(ws + OFF_XN), D, nullptr, pm * 128, (const bf16_t*)(ws + OFF_WIN), D, pn * 128, D, smem);
            bf16_t* dst; int ld, cb; bool sg = false;
            if (colt < RCOLS) { dst = (bf16_t*)(ws + OFF_UR); ld = RCOLS; cb = colt; }
            else if (colt < RCOLS + MCOLS) { dst = (bf16_t*)(ws + OFF_UM); ld = UMC; cb = colt - RCOLS; }
            else { dst = (bf16_t*)(ws + OFF_UG); ld = GCOLS; cb = colt - RCOLS - MCOLS; sg = true; }
#pragma unroll
            for (int m = 0; m < 4; ++m) {
                const int row = pm * 128 + wr * 64 + m * 16 + fr;
#pragma unroll
                for (int n = 0; n < 4; ++n) {
                    f32x4 v = acc[m][n];
                    if (sg) { v.x = sigm(v.x); v.y = sigm(v.y); v.z = sigm(v.z); v.w = sigm(v.w); }
                    u32x2 o; o.x = pk2(v.x, v.y); o.y = pk2(v.z, v.w);
                    *(u32x2*)(dst + (size_t)row * ld + cb + wc * 64 + n * 16 + fq * 4) = o;
                }
            }
        } else {
            const int t2 = it - NT_U, pm = t2 >> 3, pn = t2 & 7;
            if (pn < 4) {
                gemm_k_loop<false>(acc, (const bf16_t*)(ws + OFF_MEMN), D, nullptr, pm * 128, (const bf16_t*)(ws + OFF_WKV), D, pn * 128, D, smem);
                bf16_t* dst = (bf16_t*)(ws + OFF_KVX);
#pragma unroll
                for (int m = 0; m < 4; ++m) {
                    const int row = pm * 128 + wr * 64 + m * 16 + fr;
#pragma unroll
                    for (int n = 0; n < 4; ++n) {
                        const f32x4 v = acc[m][n]; u32x2 o; o.x = pk2(v.x, v.y); o.y = pk2(v.z, v.w);
                        *(u32x2*)(dst + (size_t)row * 512 + pn * 128 + wc * 64 + n * 16 + fq * 4) = o;
                    }
                }
            } else {
                gemm_k_loop<false, true>(acc, (const bf16_t*)(ws + OFF_MEMN), D, nullptr, pm * 128, (const bf16_t*)(ws + OFF_WKV), D, pn * 128, D, smem);
                bf16_t* dst = (bf16_t*)(ws + OFF_KVX) + 256 * 512;
#pragma unroll
                for (int m = 0; m < 4; ++m)
#pragma unroll
                    for (int n = 0; n < 4; ++n) {
                        const int col = (pn - 4) * 128 + wc * 64 + n * 16 + fr, row = pm * 128 + wr * 64 + m * 16 + fq * 4;
                        const f32x4 v = acc[m][n]; u32x2 o; o.x = pk2(v.x, v.y); o.y = pk2(v.z, v.w);
                        *(u32x2*)(dst + (size_t)col * 256 + row) = o;
                    }
            }
        }
    }
}

__device__ __forceinline__ void phase_kmean(const P& p, int bid, int nb, char* smem) {
    const int tid = otid();
    const bf16_t* um = (const bf16_t*)(p.ws + OFF_UM);
    bf16_t* kmb = (bf16_t*)(p.ws + OFF_CTL + CTL_KMB);
    float* red = (float*)smem;
    for (int it = bid; it < 64 * 8; it += nb) {
        const int blk = it >> 3, h = it & 7, q = tid >> 6, d = tid & 63;
        float s = 0.f;
        for (int k = 0; k < 64; ++k) s += bf2f(um[(size_t)(blk * 256 + q * 64 + k) * UMC + 512 + h * 64 + d]);
        red[tid] = s;
        __syncthreads();
        if (tid < 64) kmb[(blk * 8 + h) * 64 + tid] = (bf16_t)f2bf((red[tid] + red[tid + 64] + red[tid + 128] + red[tid + 192]) * (1.f / 256.f));
        __syncthreads();
    }
}

__device__ __forceinline__ void rwkv_naive(const P& p, int h, char* smem) {
    const int tid = otid(), lane = tid & 63, q4 = tid >> 6;
    float* dU = (float*)smem;
    float* iU = dU + 4096;
    float* L = iU + 4096;
    float* RKV = L + 256;
    float* PART = RKV + 192;
    float* VR = PART + 768;
    const bf16_t* ur = (const bf16_t*)(p.ws + OFF_UR);
    bf16_t* oa = (bf16_t*)(p.ws + OFF_OA);
    for (int i = tid; i < 4096; i += 256) { const int r = i >> 6, c = i & 63; dU[i] = p.decay_up[r * 512 + h * 64 + c]; iU[i] = p.iclr_up[r * 512 + h * 64 + c]; }
    const int hj = h * 64 + lane;
    const float w0 = p.decay_w0[hj], a0 = p.iclr_a0[hj], kk_w = p.k_k[hj], ka_w = p.k_a[hj], rk_w = p.r_k[hj], lnw = p.ln_x_w[hj], lnb = p.ln_x_b[hj];
    float S[16];
#pragma unroll
    for (int i = 0; i < 16; ++i) S[i] = 0.f;
    const int vi = tid >> 2, kq = tid & 3;
    __syncthreads();
    for (int t = 0; t < T; ++t) {
        {
            const int col = 1536 + tid;
            const float cur = bf2f(ur[(size_t)t * RCOLS + col]);
            const float prv = t ? bf2f(ur[(size_t)(t - 1) * RCOLS + col]) : 0.f;
            const float xs = cur + p.tshift_mu[col] * (prv - cur);
            L[tid] = tid < 64 ? tanhf(xs) : (tid < 128 ? xs : sigm(xs));
            if (tid < 192) {
                const int c2 = q4 * 512 + h * 64 + lane;
                const float cu = bf2f(ur[(size_t)t * RCOLS + c2]);
                const float pv = t ? bf2f(ur[(size_t)(t - 1) * RCOLS + c2]) : 0.f;
                RKV[tid] = cu + p.tshift_mu[c2] * (pv - cu);
            }
        }
        __syncthreads();
        {
            float pd = 0.f, pa = 0.f, pg = 0.f;
#pragma unroll
            for (int i = 0; i < 16; ++i) { pd += L[q4 * 16 + i] * dU[(q4 * 16 + i) * 64 + lane]; pa += L[64 + q4 * 16 + i] * iU[(q4 * 16 + i) * 64 + lane]; }
#pragma unroll 8
            for (int i = 0; i < 32; ++i) pg += L[128 + q4 * 32 + i] * p.gate_up[(q4 * 32 + i) * 512 + hj];
            PART[q4 * 64 + lane] = pd; PART[256 + q4 * 64 + lane] = pa; PART[512 + q4 * 64 + lane] = pg;
        }
        __syncthreads();
        if (tid < 64) {
            const float wv = w0 + PART[lane] + PART[64 + lane] + PART[128 + lane] + PART[192 + lane];
            const float av = sigm(a0 + PART[256 + lane] + PART[320 + lane] + PART[384 + lane] + PART[448 + lane]);
            const float gv = PART[512 + lane] + PART[576 + lane] + PART[640 + lane] + PART[704 + lane];
            const float wlog = -log1pf(__expf(-wv)) - 0.5f;
            const float dec = __expf(-__expf(wlog));
            const float r = RKV[lane], k = RKV[64 + lane], v = RKV[128 + lane];
            float kk = k * kk_w;
            const float ss = wave_sum(kk * kk);
            kk *= rsqrtf(ss + 1e-12f);
            const float k2 = k * (1.f + (av - 1.f) * ka_w);
            const float rk = wave_sum(r * k2 * rk_w);
            VR[lane] = r; VR[64 + lane] = dec; VR[128 + lane] = k2; VR[192 + lane] = v; VR[256 + lane] = -kk; VR[320 + lane] = kk * av;
            VR[384 + lane] = gv; VR[448 + lane] = rk * v;
        }
        __syncthreads();
        {
            float sa = 0.f;
#pragma unroll
            for (int i = 0; i < 16; ++i) sa += S[i] * VR[256 + kq * 16 + i];
            sa += __shfl_xor(sa, 1); sa += __shfl_xor(sa, 2);
            const float vv = VR[192 + vi];
            float y = 0.f;
#pragma unroll
            for (int i = 0; i < 16; ++i) { const int k = kq * 16 + i; S[i] = S[i] * VR[64 + k] + sa * VR[320 + k] + vv * VR[128 + k]; y += S[i] * VR[k]; }
            y += __shfl_xor(y, 1); y += __shfl_xor(y, 2);
            if (kq == 0) VR[512 + vi] = y;
        }
        __syncthreads();
        if (tid < 64) {
            const float y = VR[512 + lane];
            const float mean = wave_sum(y) * (1.f / 64.f);
            const float d = y - mean;
            const float var = wave_sum(d * d) * (1.f / 64.f);
            const float yn = d * rsqrtf(var + 64e-5f) * lnw + lnb;
            oa[(size_t)t * 512 + hj] = (bf16_t)f2bf((yn + VR[448 + lane]) * VR[384 + lane]);
        }
    }
}

typedef __bf16 bf16x2_t __attribute__((ext_vector_type(2)));
__device__ __forceinline__ unsigned cvt_pk(float lo, float hi) { typedef float f2_t __attribute__((ext_vector_type(2))); const f2_t v = {lo, hi}; return __builtin_bit_cast(unsigned, __builtin_convertvector(v, bf16x2_t)); }
__device__ __forceinline__ u32x2 pack4(f32x4 v) { u32x2 o; o.x = cvt_pk(v.x, v.y); o.y = cvt_pk(v.z, v.w); return o; }
__device__ __forceinline__ bf16x8 pack8(f32x4 a, f32x4 b) { u32x4 o; o.x = cvt_pk(a.x, a.y); o.y = cvt_pk(a.z, a.w); o.z = cvt_pk(b.x, b.y); o.w = cvt_pk(b.z, b.w); return __builtin_bit_cast(bf16x8, o); }
__device__ __forceinline__ bf16x8 ldperm(const char* rowbase, int ks, int fq) {
    const u32x2 a = *(const u32x2*)(rowbase + (32 * ks + fq * 4) * 2), b = *(const u32x2*)(rowbase + (32 * ks + 16 + fq * 4) * 2);
    u32x4 o; o.x = a.x; o.y = a.y; o.z = b.x; o.w = b.y; return __builtin_bit_cast(bf16x8, o);
}
#define MFMA16(a, b, c) __builtin_amdgcn_mfma_f32_16x16x32_bf16((a), (b), (c), 0, 0, 0)
constexpr int SLOT = 9216, ROWB = 144, LIN_ROWB = 528;
constexpr int L_WL = 0 * SLOT, L_AL = 1 * SLOT, L_LIN = 2 * SLOT, L_AT = 2 * SLOT, L_BT = 3 * SLOT, L_KT = 4 * SLOT, L_RT = 5 * SLOT, L_VT = 6 * SLOT, L_ATT = 7 * SLOT;
constexpr int L_AAB = L_AT, L_AKV = L_BT, L_BBT = L_WL, L_KBT = L_AL;
constexpr int L_WTOT = 8 * SLOT, L_WC = L_WTOT + 1024, RW_LDS = L_WC + 256;

typedef float f32x2 __attribute__((ext_vector_type(2)));
template <int TT> struct SolveRow {
    static __device__ __forceinline__ void run(f32x2 (&x)[32], const char* Lb) {
        f32x2 a0 = {0.f, 0.f}, a1 = {0.f, 0.f};
#pragma unroll
        for (int c8 = 0; c8 <= (TT - 1) / 8; ++c8) {
            const u32x4 lv = *(const u32x4*)(Lb + TT * 144 + c8 * 16);
            f32x2 l0, l1, l2, l3;
            l0.x = __uint_as_float(lv.x << 16); l0.y = __uint_as_float(lv.x & 0xffff0000u);
            l1.x = __uint_as_float(lv.y << 16); l1.y = __uint_as_float(lv.y & 0xffff0000u);
            l2.x = __uint_as_float(lv.z << 16); l2.y = __uint_as_float(lv.z & 0xffff0000u);
            l3.x = __uint_as_float(lv.w << 16); l3.y = __uint_as_float(lv.w & 0xffff0000u);
            a0 = l0 * x[c8 * 4 + 0] + a0; a1 = l1 * x[c8 * 4 + 1] + a1; a0 = l2 * x[c8 * 4 + 2] + a0; a1 = l3 * x[c8 * 4 + 3] + a1;
        }
        a0 = a0 + a1;
        const float r = a0.x + a0.y;
        if (TT & 1) x[TT / 2].y += r; else x[TT / 2].x += r;
        asm volatile("" : "+v"(x[TT / 2]) :: "memory");
        SolveRow<TT + 1>::run(x, Lb);
    }
};
template <> struct SolveRow<64> { static __device__ __forceinline__ void run(f32x2 (&)[32], const char*) {} };

__device__ __forceinline__ void load_shift16(const bf16_t* ur, int row, int col, const float* mu, float* out) {
    const u32x4* cp = (const u32x4*)(ur + (size_t)row * RCOLS + col);
    const u32x4 c0 = cp[0], c1 = cp[1];
    u32x4 p0 = {0u, 0u, 0u, 0u}, p1 = {0u, 0u, 0u, 0u};
    if (row > 0) { const u32x4* pp = (const u32x4*)(ur + (size_t)(row - 1) * RCOLS + col); p0 = pp[0]; p1 = pp[1]; }
    float cf[16], pf[16];
    unpack8(c0, cf); unpack8(c1, cf + 8); unpack8(p0, pf); unpack8(p1, pf + 8);
#pragma unroll
    for (int e = 0; e < 16; ++e) out[e] = cf[e] + mu[col + e] * (pf[e] - cf[e]);
}

__device__ __forceinline__ void phase_rw_chunk(const P& p, int bid, int nb, char* smem) {
    char* ws = p.ws;
    const bf16_t* ur = (const bf16_t*)(ws + OFF_UR);
    bf16_t* G = (bf16_t*)(ws + OFF_OA); bf16_t* BON = (bf16_t*)(ws + OFF_BON); bf16_t* RH = (bf16_t*)(ws + OFF_RH);
    float* YL = p.out; f32x4* NF = (f32x4*)(p.out + (size_t)T * 512);
    u32x4* MF = (u32x4*)(ws + OFF_MF);
    float* wtot = (float*)(smem + L_WTOT); float* WCs = (float*)(smem + L_WC);
    for (int it = bid; it < 2048; it += nb) {
        const int c = it >> 3, h = it & 7;
        const int tid = otid();
        const int lane = tid & 63, w = __builtin_amdgcn_readfirstlane(tid >> 6), fr = lane & 15, fq = lane >> 4;
#pragma unroll 1
        for (int hf = 0; hf < 2; ++hf) {
            u32x4 cur[4], prv[4];
#pragma unroll
            for (int i = 0; i < 4; ++i) {
                const int q = tid + (hf * 4 + i) * 256, t = q >> 5, cc = q & 31, row = c * 64 + t, col = 1536 + cc * 8;
                cur[i] = *(const u32x4*)(ur + (size_t)row * RCOLS + col);
                prv[i] = (u32x4){0u, 0u, 0u, 0u};
                if (row > 0) prv[i] = *(const u32x4*)(ur + (size_t)(row - 1) * RCOLS + col);
            }
#pragma unroll
            for (int i = 0; i < 4; ++i) {
                const int q = tid + (hf * 4 + i) * 256, t = q >> 5, cc = q & 31, col = 1536 + cc * 8;
                float cf[8], pf[8], xs[8];
                unpack8(cur[i], cf); unpack8(prv[i], pf);
#pragma unroll
                for (int e = 0; e < 8; ++e) {
                    const float x = cf[e] + p.tshift_mu[col + e] * (pf[e] - cf[e]);
                    xs[e] = (cc < 8) ? (1.f - 2.f / (1.f + __expf(2.f * x))) : ((cc < 16) ? x : sigm(x));
                }
                u32x4 o; o.x = cvt_pk(xs[0], xs[1]); o.y = cvt_pk(xs[2], xs[3]); o.z = cvt_pk(xs[4], xs[5]); o.w = cvt_pk(xs[6], xs[7]);
                *(u32x4*)(smem + L_LIN + t * LIN_ROWB + cc * 16) = o;
                asm volatile("" ::: "memory");
            }
        }
        __syncthreads();
        {
            const char* lrow = smem + L_LIN + (w * 16 + fr) * LIN_ROWB;
            const bf16_t* dT = (const bf16_t*)(ws + OFF_LORA_D) + (size_t)(h * 64) * 64;
            const bf16_t* iT = (const bf16_t*)(ws + OFF_LORA_I) + (size_t)(h * 64) * 64;
            const bf16_t* gT = (const bf16_t*)(ws + OFF_LORA_G) + (size_t)(h * 64) * 128;
            bf16x8 lb[8];
#pragma unroll
            for (int ks = 0; ks < 8; ++ks) lb[ks] = *(const bf16x8*)(lrow + (ks * 32 + fq * 8) * 2);
#pragma unroll
            for (int jt = 0; jt < 4; ++jt) {
                f32x4 aw = {0.f, 0.f, 0.f, 0.f}, aa = aw, ag = aw;
#pragma unroll
                for (int ks = 0; ks < 2; ++ks) {
                    aw = MFMA16(*(const bf16x8*)(dT + (jt * 16 + fr) * 64 + ks * 32 + fq * 8), lb[ks], aw);
                    aa = MFMA16(*(const bf16x8*)(iT + (jt * 16 + fr) * 64 + ks * 32 + fq * 8), lb[2 + ks], aa);
                }
#pragma unroll
                for (int ks = 0; ks < 4; ++ks) ag = MFMA16(*(const bf16x8*)(gT + (jt * 16 + fr) * 128 + ks * 32 + fq * 8), lb[4 + ks], ag);
                *(u32x2*)(smem + L_WL + (w * 16 + fr) * ROWB + (jt * 16 + fq * 4) * 2) = pack4(aw);
                *(u32x2*)(smem + L_AL + (w * 16 + fr) * ROWB + (jt * 16 + fq * 4) * 2) = pack4(aa);
                *(u32x2*)(G + (size_t)(c * 64 + w * 16 + fr) * 512 + h * 64 + jt * 16 + fq * 4) = pack4(ag);
            }
        }
        __syncthreads();
        {
            const int t = tid >> 2, jq = tid & 3, j0 = jq * 16, hj0 = h * 64 + j0, row = c * 64 + t;
            float ai[16], kk[16], k2[16], rr[16];
            {
                float al[16];
                const u32x4* ap = (const u32x4*)(smem + L_AL + t * ROWB + j0 * 2);
                unpack8(ap[0], al); unpack8(ap[1], al + 8);
#pragma unroll
                for (int e = 0; e < 16; ++e) ai[e] = sigm(p.iclr_a0[hj0 + e] + al[e]);
            }
            float ss = 0.f, rk = 0.f;
            {
                float k[16];
                load_shift16(ur, row, 512 + hj0, p.tshift_mu, k);
#pragma unroll
                for (int e = 0; e < 16; ++e) { kk[e] = k[e] * p.k_k[hj0 + e]; ss += kk[e] * kk[e]; k2[e] = k[e] * (1.f + (ai[e] - 1.f) * p.k_a[hj0 + e]); }
            }
            ss += __shfl_xor(ss, 1); ss += __shfl_xor(ss, 2);
            const float inv = rsqrtf(ss + 1e-12f);
            asm volatile("" ::: "memory");
            load_shift16(ur, row, hj0, p.tshift_mu, rr);
#pragma unroll
            for (int e = 0; e < 16; ++e) rk += rr[e] * k2[e] * p.r_k[hj0 + e];
            rk += __shfl_xor(rk, 1); rk += __shfl_xor(rk, 2);
            asm volatile("" ::: "memory");
            {
                float v[16];
                load_shift16(ur, row, 1024 + hj0, p.tshift_mu, v);
#pragma unroll
                for (int e = 0; e < 16; ++e) *(bf16_t*)(smem + L_VT + (j0 + e) * ROWB + t * 2) = (bf16_t)f2bf(v[e]);
#pragma unroll
                for (int hh = 0; hh < 2; ++hh) {
                    u32x4 o; o.x = cvt_pk(rk * v[hh * 8], rk * v[hh * 8 + 1]); o.y = cvt_pk(rk * v[hh * 8 + 2], rk * v[hh * 8 + 3]); o.z = cvt_pk(rk * v[hh * 8 + 4], rk * v[hh * 8 + 5]); o.w = cvt_pk(rk * v[hh * 8 + 6], rk * v[hh * 8 + 7]);
                    *(u32x4*)(BON + (size_t)row * 512 + hj0 + hh * 8) = o;
                }
            }
            asm volatile("" ::: "memory");
            float lw[16], cum[16];
            {
                float wl[16];
                const u32x4* wp = (const u32x4*)(smem + L_WL + t * ROWB + j0 * 2);
                unpack8(wp[0], wl); unpack8(wp[1], wl + 8);
#pragma unroll
                for (int e = 0; e < 16; ++e) { const float wv = p.decay_w0[hj0 + e] + wl[e]; lw[e] = -__expf(-log1pf(__expf(-wv)) - 0.5f); }
            }
#pragma unroll
            for (int e = 0; e < 16; ++e) {
                float x = lw[e];
#pragma unroll
                for (int d = 4; d < 64; d <<= 1) { const float y = __shfl_up(x, d); if (lane >= d) x += y; }
                cum[e] = x;
            }
            if ((lane >> 2) == 15) {
#pragma unroll
                for (int e = 0; e < 16; ++e) wtot[w * 64 + j0 + e] = cum[e];
            }
            __syncthreads();
#pragma unroll
            for (int hh = 0; hh < 2; ++hh) {
                float at[8], bt[8], kt[8], rt[8];
#pragma unroll
                for (int e8 = 0; e8 < 8; ++e8) {
                    const int e = hh * 8 + e8;
                    const float t0 = wtot[j0 + e], t1 = wtot[64 + j0 + e], t2 = wtot[128 + j0 + e], t3 = wtot[192 + j0 + e];
                    const float cm = cum[e] + ((w > 0 ? t0 : 0.f) + (w > 1 ? t1 : 0.f) + (w > 2 ? t2 : 0.f));
                    const float tt = (t0 + t1) + (t2 + t3);
                    if (t == 63) WCs[j0 + e] = __expf(tt);
                    const float kn = kk[e] * inv;
                    const float E = __expf(cm), Ei = 1.f / E, Ex = __expf(cm - lw[e]), Ec = __expf(tt - cm);
                    const float b = kn * ai[e];
                    at[e8] = -kn * Ex; bt[e8] = b * Ei; kt[e8] = k2[e] * Ei; rt[e8] = rr[e] * E;
                    *(bf16_t*)(smem + L_BBT + (j0 + e) * ROWB + t * 2) = (bf16_t)f2bf(b * Ec);
                    *(bf16_t*)(smem + L_KBT + (j0 + e) * ROWB + t * 2) = (bf16_t)f2bf(k2[e] * Ec);
                    *(bf16_t*)(smem + L_ATT + (j0 + e) * ROWB + t * 2) = (bf16_t)f2bf(at[e8]);
                }
                u32x4 o;
                o.x = cvt_pk(at[0], at[1]); o.y = cvt_pk(at[2], at[3]); o.z = cvt_pk(at[4], at[5]); o.w = cvt_pk(at[6], at[7]);
                *(u32x4*)(smem + L_AT + t * ROWB + (j0 + hh * 8) * 2) = o;
                o.x = cvt_pk(bt[0], bt[1]); o.y = cvt_pk(bt[2], bt[3]); o.z = cvt_pk(bt[4], bt[5]); o.w = cvt_pk(bt[6], bt[7]);
                *(u32x4*)(smem + L_BT + t * ROWB + (j0 + hh * 8) * 2) = o;
                o.x = cvt_pk(kt[0], kt[1]); o.y = cvt_pk(kt[2], kt[3]); o.z = cvt_pk(kt[4], kt[5]); o.w = cvt_pk(kt[6], kt[7]);
                *(u32x4*)(smem + L_KT + t * ROWB + (j0 + hh * 8) * 2) = o;
                o.x = cvt_pk(rt[0], rt[1]); o.y = cvt_pk(rt[2], rt[3]); o.z = cvt_pk(rt[4], rt[5]); o.w = cvt_pk(rt[6], rt[7]);
                *(u32x4*)(smem + L_RT + t * ROWB + (j0 + hh * 8) * 2) = o;
            }
        }
        __syncthreads();
        bf16x8 frb[2], frk[2];
        {
            const int tid2 = otid(), lane = tid2 & 63, fr = lane & 15, fq = lane >> 4;
            bf16x8 xa[2], xr[2];
#pragma unroll
            for (int ks = 0; ks < 2; ++ks) {
                xa[ks] = *(const bf16x8*)(smem + L_AT + (w * 16 + fr) * ROWB + (ks * 32 + fq * 8) * 2);
                xr[ks] = *(const bf16x8*)(smem + L_RT + (w * 16 + fr) * ROWB + (ks * 32 + fq * 8) * 2);
            }
            f32x4 aab[4], aak[4], arb[4], ark[4];
            const int tq = w * 16 + fr;
#pragma unroll
            for (int n = 0; n < 4; ++n) {
                f32x4 dab = {0.f, 0.f, 0.f, 0.f}, dak = dab, drb = dab, drk = dab;
                if (n <= w) {
#pragma unroll
                    for (int ks = 0; ks < 2; ++ks) {
                        const bf16x8 yb = *(const bf16x8*)(smem + L_BT + (n * 16 + fr) * ROWB + (ks * 32 + fq * 8) * 2);
                        const bf16x8 yk = *(const bf16x8*)(smem + L_KT + (n * 16 + fr) * ROWB + (ks * 32 + fq * 8) * 2);
                        dab = MFMA16(yb, xa[ks], dab); dak = MFMA16(yk, xa[ks], dak); drb = MFMA16(yb, xr[ks], drb); drk = MFMA16(yk, xr[ks], drk);
                    }
#pragma unroll
                    for (int jj = 0; jj < 4; ++jj) {
                        const int sq = n * 16 + fq * 4 + jj;
                        if (!(sq < tq)) { dab[jj] = 0.f; dak[jj] = 0.f; }
                        if (!(sq <= tq)) { drb[jj] = 0.f; drk[jj] = 0.f; }
                    }
                }
                aab[n] = dab; aak[n] = dak; arb[n] = drb; ark[n] = drk;
            }
            __syncthreads();
#pragma unroll
            for (int n = 0; n < 4; ++n) *(u32x2*)(smem + L_AAB + (w * 16 + fr) * ROWB + (n * 16 + fq * 4) * 2) = pack4(aab[n]);
            bf16x8 fak[2];
#pragma unroll
            for (int ks = 0; ks < 2; ++ks) { fak[ks] = pack8(aak[2 * ks], aak[2 * ks + 1]); frb[ks] = pack8(arb[2 * ks], arb[2 * ks + 1]); frk[ks] = pack8(ark[2 * ks], ark[2 * ks + 1]); }
#pragma unroll
            for (int vt = 0; vt < 4; ++vt) {
                f32x4 acc = {0.f, 0.f, 0.f, 0.f};
#pragma unroll
                for (int ks = 0; ks < 2; ++ks) acc = MFMA16(fak[ks], ldperm(smem + L_VT + (vt * 16 + fr) * ROWB, ks, fq), acc);
                *(u32x2*)(smem + L_AKV + (vt * 16 + fr) * ROWB + (w * 16 + fq * 4) * 2) = pack4(acc);
            }
        }
        __syncthreads();
        if (w < 2) {
            char* rowp = smem + (w == 0 ? L_ATT : L_AKV) + (otid() & 63) * ROWB;
            f32x2 x[32];
#pragma unroll
            for (int c8 = 0; c8 < 8; ++c8) {
                const u32x4 xv = *(const u32x4*)(rowp + c8 * 16);
                x[c8 * 4 + 0].x = __uint_as_float(xv.x << 16); x[c8 * 4 + 0].y = __uint_as_float(xv.x & 0xffff0000u);
                x[c8 * 4 + 1].x = __uint_as_float(xv.y << 16); x[c8 * 4 + 1].y = __uint_as_float(xv.y & 0xffff0000u);
                x[c8 * 4 + 2].x = __uint_as_float(xv.z << 16); x[c8 * 4 + 2].y = __uint_as_float(xv.z & 0xffff0000u);
                x[c8 * 4 + 3].x = __uint_as_float(xv.w << 16); x[c8 * 4 + 3].y = __uint_as_float(xv.w & 0xffff0000u);
            }
            SolveRow<1>::run(x, smem + L_AAB);
#pragma unroll
            for (int c8 = 0; c8 < 8; ++c8) {
                u32x4 o; o.x = cvt_pk(x[c8 * 4].x, x[c8 * 4].y); o.y = cvt_pk(x[c8 * 4 + 1].x, x[c8 * 4 + 1].y); o.z = cvt_pk(x[c8 * 4 + 2].x, x[c8 * 4 + 2].y); o.w = cvt_pk(x[c8 * 4 + 3].x, x[c8 * 4 + 3].y);
                *(u32x4*)(rowp + c8 * 16) = o;
            }
        }
        __syncthreads();
        {
            const int tid4 = otid(), lane = tid4 & 63, fr = lane & 15, fq = lane >> 4;
            const int trow = c * 64 + w * 16 + fr;
#pragma unroll
            for (int kt = 0; kt < 4; ++kt) {
                f32x4 acc = {0.f, 0.f, 0.f, 0.f};
#pragma unroll
                for (int ks = 0; ks < 2; ++ks) acc = MFMA16(ldperm(smem + L_ATT + (kt * 16 + fr) * ROWB, ks, fq), frb[ks], acc);
                const u32x2 rr = *(const u32x2*)(smem + L_RT + (w * 16 + fr) * ROWB + (kt * 16 + fq * 4) * 2);
                acc.x += __uint_as_float(rr.x << 16); acc.y += __uint_as_float(rr.x & 0xffff0000u); acc.z += __uint_as_float(rr.y << 16); acc.w += __uint_as_float(rr.y & 0xffff0000u);
                *(u32x2*)(RH + (size_t)trow * 512 + h * 64 + kt * 16 + fq * 4) = pack4(acc);
            }
#pragma unroll
            for (int vt = 0; vt < 4; ++vt) {
                f32x4 acc = {0.f, 0.f, 0.f, 0.f};
#pragma unroll
                for (int ks = 0; ks < 2; ++ks) {
                    acc = MFMA16(ldperm(smem + L_AKV + (vt * 16 + fr) * ROWB, ks, fq), frb[ks], acc);
                    acc = MFMA16(ldperm(smem + L_VT + (vt * 16 + fr) * ROWB, ks, fq), frk[ks], acc);
                }
                *(f32x4*)(YL + (size_t)trow * 512 + h * 64 + vt * 16 + fq * 4) = acc;
            }
            bf16x8 xb[2], xk[2];
#pragma unroll
            for (int ks = 0; ks < 2; ++ks) {
                xb[ks] = *(const bf16x8*)(smem + L_BBT + (w * 16 + fr) * ROWB + (ks * 32 + fq * 8) * 2);
                xk[ks] = *(const bf16x8*)(smem + L_KBT + (w * 16 + fr) * ROWB + (ks * 32 + fq * 8) * 2);
            }
            f32x4 mt[4];
            const float wc = WCs[w * 16 + fr];
#pragma unroll
            for (int n = 0; n < 4; ++n) {
                f32x4 acc = {0.f, 0.f, 0.f, 0.f};
#pragma unroll
                for (int ks = 0; ks < 2; ++ks) acc = MFMA16(*(const bf16x8*)(smem + L_ATT + (n * 16 + fr) * ROWB + (ks * 32 + fq * 8) * 2), xb[ks], acc);
#pragma unroll
                for (int jj = 0; jj < 4; ++jj) if (n * 16 + fq * 4 + jj == w * 16 + fr) acc[jj] += wc;
                mt[n] = acc;
            }
#pragma unroll
            for (int ks = 0; ks < 2; ++ks) MF[((size_t)((c * 8 + h) * 4 + w) * 2 + ks) * 64 + lane] = __builtin_bit_cast(u32x4, pack8(mt[2 * ks], mt[2 * ks + 1]));
#pragma unroll
            for (int vs = 0; vs < 4; ++vs) {
                f32x4 acc = {0.f, 0.f, 0.f, 0.f};
#pragma unroll
                for (int ks = 0; ks < 2; ++ks) {
                    acc = MFMA16(xb[ks], *(const bf16x8*)(smem + L_AKV + (vs * 16 + fr) * ROWB + (ks * 32 + fq * 8) * 2), acc);
                    acc = MFMA16(xk[ks], *(const bf16x8*)(smem + L_VT + (vs * 16 + fr) * ROWB + (ks * 32 + fq * 8) * 2), acc);
                }
                NF[((size_t)((c * 8 + h) * 4 + w) * 4 + vs) * 64 + lane] = acc;
            }
        }
        __syncthreads();
    }
}

__device__ __forceinline__ void rw_scan(const P& p, int h) {
    const int lane = otid() & 63, vs = otid() >> 6;
    const u32x4* MF = (const u32x4*)(p.ws + OFF_MF); const f32x4* NF = (const f32x4*)(p.out + (size_t)T * 512);
    u32x4* SF = (u32x4*)(p.ws + OFF_SF);
    u32x4 st0 = {0u, 0u, 0u, 0u}, st1 = st0;
    u32x4 m[8]; f32x4 n[4];
#pragma unroll
    for (int i = 0; i < 8; ++i) m[i] = MF[((size_t)(h * 4 + (i >> 1)) * 2 + (i & 1)) * 64 + lane];
#pragma unroll
    for (int i = 0; i < 4; ++i) n[i] = NF[((size_t)(h * 4 + i) * 4 + vs) * 64 + lane];
    for (int c = 0; c < 256; ++c) {
        SF[((size_t)((c * 8 + h) * 4 + vs) * 2 + 0) * 64 + lane] = st0;
        SF[((size_t)((c * 8 + h) * 4 + vs) * 2 + 1) * 64 + lane] = st1;
        if (c == 255) break;
        u32x4 m2[8]; f32x4 n2[4];
        const int cn = (c + 1 < 255) ? c + 1 : c;
#pragma unroll
        for (int i = 0; i < 8; ++i) m2[i] = MF[((size_t)((cn * 8 + h) * 4 + (i >> 1)) * 2 + (i & 1)) * 64 + lane];
#pragma unroll
        for (int i = 0; i < 4; ++i) n2[i] = NF[((size_t)((cn * 8 + h) * 4 + i) * 4 + vs) * 64 + lane];
        f32x4 acc[4];
#pragma unroll
        for (int i = 0; i < 4; ++i) {
            acc[i] = MFMA16(__builtin_bit_cast(bf16x8, m[2 * i]), __builtin_bit_cast(bf16x8, st0), n[i]);
            acc[i] = MFMA16(__builtin_bit_cast(bf16x8, m[2 * i + 1]), __builtin_bit_cast(bf16x8, st1), acc[i]);
        }
        st0 = __builtin_bit_cast(u32x4, pack8(acc[0], acc[1])); st1 = __builtin_bit_cast(u32x4, pack8(acc[2], acc[3]));
#pragma unroll
        for (int i = 0; i < 8; ++i) m[i] = m2[i];
#pragma unroll
        for (int i = 0; i < 4; ++i) n[i] = n2[i];
    }
}

__device__ __forceinline__ void phase_rw_out(const P& p, int bid, int nb) {
    const int tid = otid(), lane = tid & 63, w = tid >> 6, fr = lane & 15, fq = lane >> 4;
    char* ws = p.ws;
    bf16_t* OA = (bf16_t*)(ws + OFF_OA); const bf16_t* BON = (const bf16_t*)(ws + OFF_BON); const bf16_t* RH = (const bf16_t*)(ws + OFF_RH);
    const float* YL = p.out; const u32x4* SF = (const u32x4*)(ws + OFF_SF);
    for (int it = bid; it < 2048; it += nb) {
        const int c = it >> 3, h = it & 7, trow = c * 64 + w * 16 + fr;
        const char* rrow = (const char*)(RH + (size_t)trow * 512 + h * 64);
        bf16x8 rf[2]; rf[0] = ldperm(rrow, 0, fq); rf[1] = ldperm(rrow, 1, fq);
        f32x4 acc[4];
#pragma unroll
        for (int vs = 0; vs < 4; ++vs) {
            acc[vs] = *(const f32x4*)(YL + (size_t)trow * 512 + h * 64 + vs * 16 + fq * 4);
#pragma unroll
            for (int ks = 0; ks < 2; ++ks) acc[vs] = MFMA16(__builtin_bit_cast(bf16x8, SF[((size_t)((c * 8 + h) * 4 + vs) * 2 + ks) * 64 + lane]), rf[ks], acc[vs]);
        }
        float s = 0.f;
#pragma unroll
        for (int vs = 0; vs < 4; ++vs) s += (acc[vs].x + acc[vs].y) + (acc[vs].z + acc[vs].w);
        s += __shfl_xor(s, 16); s += __shfl_xor(s, 32);
        const float mean = s * (1.f / 64.f);
        float q = 0.f;
#pragma unroll
        for (int vs = 0; vs < 4; ++vs) { acc[vs] = acc[vs] - mean; q += (acc[vs].x * acc[vs].x + acc[vs].y * acc[vs].y) + (acc[vs].z * acc[vs].z + acc[vs].w * acc[vs].w); }
        q += __shfl_xor(q, 16); q += __shfl_xor(q, 32);
        const float rstd = rsqrtf(q * (1.f / 64.f) + 64e-5f);
#pragma unroll
        for (int vs = 0; vs < 4; ++vs) {
            const int hv = h * 64 + vs * 16 + fq * 4;
            const f32x4 lw = *(const f32x4*)(p.ln_x_w + hv), lb = *(const f32x4*)(p.ln_x_b + hv);
            const u32x2 bo = *(const u32x2*)(BON + (size_t)trow * 512 + hv), gg = *(const u32x2*)(OA + (size_t)trow * 512 + hv);
            f32x4 o = acc[vs] * rstd * lw + lb;
            o.x = (o.x + __uint_as_float(bo.x << 16)) * __uint_as_float(gg.x << 16);
            o.y = (o.y + __uint_as_float(bo.x & 0xffff0000u)) * __uint_as_float(gg.x & 0xffff0000u);
            o.z = (o.z + __uint_as_float(bo.y << 16)) * __uint_as_float(gg.y << 16);
            o.w = (o.w + __uint_as_float(bo.y & 0xffff0000u)) * __uint_as_float(gg.y & 0xffff0000u);
            *(u32x2*)(OA + (size_t)trow * 512 + hv) = pack4(o);
        }
    }
}

constexpr int A_LK = 0, A_LV = 36864, A_BIAS = 70656, A_TST = 70784;
constexpr int MAXTILES = 6656;

__device__ __forceinline__ void moba_select(const P& p, int bid0, int nb0, char* smem) {
    const int tid = otid(), lane = tid & 63, w = tid >> 6, fr = lane & 15, fq = lane >> 4;
    char* ws = p.ws;
    const bf16_t* um = (const bf16_t*)(ws + OFF_UM); const bf16_t* kmb = (const bf16_t*)(ws + OFF_CTL + CTL_KMB);
    unsigned* SEL = (unsigned*)(ws + OFF_MSEL);
    int* hist = (int*)smem;
    for (int i = tid; i < 512; i += 256) hist[i] = 0;
    __syncthreads();
    for (int it = bid0; it < 2048; it += nb0) {
        const int tile = it >> 3, h = it & 7, qb = tile >> 2, t = tile * 64 + w * 16 + fr;
        bf16x8 qf[2];
#pragma unroll
        for (int ks = 0; ks < 2; ++ks) qf[ks] = *(const bf16x8*)(um + (size_t)t * UMC + h * 64 + ks * 32 + fq * 8);
        float sc[4][4];
#pragma unroll
        for (int nt = 0; nt < 4; ++nt) {
            f32x4 acc = {0.f, 0.f, 0.f, 0.f};
            if (nt * 16 < qb) {
#pragma unroll
                for (int ks = 0; ks < 2; ++ks) acc = MFMA16(*(const bf16x8*)(kmb + (size_t)((nt * 16 + fr) * 8 + h) * 64 + ks * 32 + fq * 8), qf[ks], acc);
            }
#pragma unroll
            for (int j = 0; j < 4; ++j) sc[nt][j] = (nt * 16 + fq * 4 + j < qb) ? acc[j] : -3.0e38f;
        }
        unsigned selw = 0u;
#pragma unroll
        for (int s = 0; s < 3; ++s) {
            float bv = -3.0e38f; int bi = 255;
#pragma unroll
            for (int nt = 0; nt < 4; ++nt)
#pragma unroll
                for (int j = 0; j < 4; ++j) if (sc[nt][j] > bv) { bv = sc[nt][j]; bi = nt * 16 + fq * 4 + j; }
#pragma unroll
            for (int o = 16; o <= 32; o <<= 1) {
                const float v2 = __shfl_xor(bv, o); const int i2 = __shfl_xor(bi, o);
                if (v2 > bv || (v2 == bv && i2 < bi)) { bv = v2; bi = i2; }
            }
            if (!(bv > -1.0e38f)) bi = 255;
            selw |= (unsigned)bi << (8 * s);
#pragma unroll
            for (int nt = 0; nt < 4; ++nt)
#pragma unroll
                for (int j = 0; j < 4; ++j) if (nt * 16 + fq * 4 + j == bi) sc[nt][j] = -3.0e38f;
            if (fq == 0 && bi != 255) atomicAdd(&hist[h * 64 + bi], 1);
        }
        if (fq == 0) SEL[t * 8 + h] = selw | 0xff000000u;
    }
    __syncthreads();
    int* gcnt = (int*)(ws + OFF_CTL + CTL_MCNT);
    for (int i = tid; i < 512; i += 256) if (hist[i]) atomicAdd(&gcnt[i], hist[i]);
}

__device__ __forceinline__ void moba_fill(const P& p, int bid, int nb, char* smem) {
    const int tid = otid();
    char* ws = p.ws;
    const int* gcnt = (const int*)(ws + OFF_CTL + CTL_MCNT); int* gcur = (int*)(ws + OFF_CTL + CTL_MCUR);
    int* lst = (int*)smem;
    int* tst = lst + 520;
    int* lh = tst + 520;
    int* lc = lh + 512;
    for (int i = tid; i < 512; i += 256) lc[i] = gcnt[i];
    __syncthreads();
    if (tid == 0) {
        int a = 0, b = 0;
        for (int i = 0; i < 512; ++i) { const int c = lc[i]; lst[i] = a; tst[i] = b; a += c; b += (c + 63) >> 6; }
        lst[512] = a; tst[512] = b;
    }
    __syncthreads();
    for (int i = tid; i < 512; i += 256) { lh[i] = 0; lc[i] = 0; }
    __syncthreads();
    if (bid == 0) {
        int* glst = (int*)(ws + OFF_CTL + CTL_MLST); int* gtst = (int*)(ws + OFF_CTL + CTL_MTST);
        for (int i = tid; i < 513; i += 256) { glst[i] = lst[i]; gtst[i] = tst[i]; }
    }
    const unsigned* SEL = (const unsigned*)(ws + OFF_MSEL);
    int* QL = (int*)(ws + OFF_MQL); int* SP = (int*)(ws + OFF_MSP);
    const int per = (T * 8 + nb - 1) / nb, i0 = bid * per, i1 = min(T * 8, i0 + per);
    for (int i = i0 + tid; i < i1; i += 256) {
        const unsigned sw = SEL[i]; const int h = i & 7;
#pragma unroll
        for (int s = 0; s < 3; ++s) { const int j = (sw >> (8 * s)) & 255; if (j != 255) atomicAdd(&lh[h * 64 + j], 1); }
    }
    __syncthreads();
    for (int i = tid; i < 512; i += 256) { const int c = lh[i]; lh[i] = c ? atomicAdd(&gcur[i], c) : 0; }
    __syncthreads();
    for (int i = i0 + tid; i < i1; i += 256) {
        const unsigned sw = SEL[i]; const int h = i & 7;
#pragma unroll
        for (int s = 0; s < 3; ++s) {
            const int j = (sw >> (8 * s)) & 255; int pos = -1;
            if (j != 255) { const int li = h * 64 + j; pos = lst[li] + lh[li] + atomicAdd(&lc[li], 1); QL[pos] = i >> 3; }
            SP[i * 3 + s] = pos;
        }
    }
}

__device__ __forceinline__ int t5b(int n) {
    const int v = (int)(__float_as_uint((float)(n * n)) >> 23) - 119;
    return n < 16 ? n : (v > 31 ? 31 : v);
}

__device__ __forceinline__ void attn_stage(const P& p, int j, int h, int nkeys, char* smem, int tid) {
    const bf16_t* um = (const bf16_t*)(p.ws + OFF_UM); const bf16_t* vt = (const bf16_t*)(p.ws + OFF_VT);
    for (int idx = tid; idx < nkeys * 8; idx += 256) {
        const int key = idx >> 3, ch = idx & 7;
        *(u32x4*)(smem + A_LK + key * 144 + ch * 16) = *(const u32x4*)(um + (size_t)(j * 256 + key) * UMC + 512 + h * 64 + ch * 8);
    }
    const int cpr = nkeys >> 3;
    for (int idx = tid; idx < 64 * cpr; idx += 256) {
        const int d = idx / cpr, ch = idx - d * cpr;
        *(u32x4*)(smem + A_LV + d * 528 + ch * 16) = *(const u32x4*)(vt + (size_t)(h * 64 + d) * T + j * 256 + ch * 8);
    }
    if (tid < 32) ((float*)(smem + A_BIAS))[tid] = p.rel_bias[tid * 8 + h];
}
template <bool CAUSAL>
__device__ __forceinline__ void attn_core(const char* smem, const bf16_t* qrow, int qt, int kbase, int nkeys, int fr, int fq, float& m_out, float& l_out, f32x4 (&o)[4]) {
    bf16x8 qf[2];
#pragma unroll
    for (int ks = 0; ks < 2; ++ks) qf[ks] = *(const bf16x8*)(qrow + ks * 32 + fq * 8);
    const float* lb = (const float*)(smem + A_BIAS);
    const int nkt = nkeys >> 4;
    f32x4 sc[16];
    float mx = -3.0e38f;
#pragma unroll
    for (int kt = 0; kt < 16; ++kt) {
        f32x4 acc = {0.f, 0.f, 0.f, 0.f};
        if (kt < nkt) {
#pragma unroll
            for (int ks = 0; ks < 2; ++ks) acc = MFMA16(*(const bf16x8*)(smem + A_LK + (kt * 16 + fr) * 144 + (ks * 32 + fq * 8) * 2), qf[ks], acc);
#pragma unroll
            for (int jj = 0; jj < 4; ++jj) {
                const int rel = qt - (kbase + kt * 16 + fq * 4 + jj);
                float l = acc[jj] * 0.125f + lb[t5b(rel < 0 ? 0 : rel)];
                if (CAUSAL && rel < 0) l = -3.0e38f;
                acc[jj] = l; mx = fmaxf(mx, l);
            }
        } else { acc = (f32x4){-3.0e38f, -3.0e38f, -3.0e38f, -3.0e38f}; }
        sc[kt] = acc;
    }
    mx = fmaxf(mx, __shfl_xor(mx, 16)); mx = fmaxf(mx, __shfl_xor(mx, 32));
    float ls = 0.f;
#pragma unroll
    for (int kt = 0; kt < 16; ++kt)
#pragma unroll
        for (int jj = 0; jj < 4; ++jj) { const float e = (sc[kt][jj] > -1.0e38f) ? __expf(sc[kt][jj] - mx) : 0.f; sc[kt][jj] = e; ls += e; }
    ls += __shfl_xor(ls, 16); ls += __shfl_xor(ls, 32);
#pragma unroll
    for (int dt = 0; dt < 4; ++dt) o[dt] = (f32x4){0.f, 0.f, 0.f, 0.f};
#pragma unroll
    for (int s = 0; s < 8; ++s) {
        if (s * 2 < nkt) {
            const bf16x8 pf = pack8(sc[2 * s], sc[2 * s + 1]);
#pragma unroll
            for (int dt = 0; dt < 4; ++dt) o[dt] = MFMA16(ldperm(smem + A_LV + (dt * 16 + fr) * 528, s, fq), pf, o[dt]);
        }
    }
    m_out = mx; l_out = ls;
}

__device__ __forceinline__ void moba_partial(const P& p, int bid, int nb, char* smem) {
    const int tid = otid(), lane = tid & 63, w = tid >> 6, fr = lane & 15, fq = lane >> 4;
    char* ws = p.ws;
    const bf16_t* um = (const bf16_t*)(ws + OFF_UM);
    const int* glst = (const int*)(ws + OFF_CTL + CTL_MLST); const int* gtst = (const int*)(ws + OFF_CTL + CTL_MTST);
    const int* QL = (const int*)(ws + OFF_MQL);
    bf16_t* PO = (bf16_t*)p.out; float* PM = (float*)((char*)p.out + 52 * MiB); float* PL = PM + 400000;
    int* tst = (int*)(smem + A_TST);
    for (int i = tid; i < 513; i += 256) tst[i] = gtst[i];
    __syncthreads();
    const int ntiles = tst[512];
    for (int it = bid; it < ntiles; it += nb) {
        int lo = 0, hi = 512;
        while (hi - lo > 1) { const int mid = (lo + hi) >> 1; if (tst[mid] <= it) lo = mid; else hi = mid; }
        const int li = lo, h = li >> 6, j = li & 63, r = it - tst[li];
        const int l0 = glst[li], l1 = glst[li + 1], base = l0 + r * 64;
        attn_stage(p, j, h, 256, smem, tid);
        __syncthreads();
        const int idx = w * 16 + fr; const bool valid = base + idx < l1;
        const int pos = valid ? base + idx : base;
        const int qt = QL[pos];
        float m, l; f32x4 o[4];
        attn_core<false>(smem, um + (size_t)qt * UMC + h * 64, qt, j * 256, 256, fr, fq, m, l, o);
        if (valid) {
#pragma unroll
            for (int dt = 0; dt < 4; ++dt) *(u32x2*)(PO + (size_t)pos * 64 + dt * 16 + fq * 4) = pack4(o[dt]);
            if (fq == 0) { PM[pos] = m; PL[pos] = l; }
        }
        __syncthreads();
    }
}

__device__ __forceinline__ void moba_own(const P& p, int bid, int nb, char* smem) {
    const int tid = otid(), lane = tid & 63, w = tid >> 6, fr = lane & 15, fq = lane >> 4;
    char* ws = p.ws;
    const bf16_t* um = (const bf16_t*)(ws + OFF_UM);
    const int* SP = (const int*)(ws + OFF_MSP);
    const bf16_t* PO = (const bf16_t*)p.out; const float* PM = (const float*)((const char*)p.out + 52 * MiB); const float* PL = PM + 400000;
    bf16_t* ob = (bf16_t*)(ws + OFF_OB);
    for (int it = bid; it < 2048; it += nb) {
        const int tile = it >> 3, h = it & 7, b = tile >> 2, tb = tile & 3, nkeys = (tb + 1) * 64;
        attn_stage(p, b, h, nkeys, smem, tid);
        __syncthreads();
        const int qt = tile * 64 + w * 16 + fr;
        float m, l; f32x4 o[4];
        attn_core<true>(smem, um + (size_t)qt * UMC + h * 64, qt, b * 256, nkeys, fr, fq, m, l, o);
        int pos[3]; float pm[3]; float M = m;
#pragma unroll
        for (int s = 0; s < 3; ++s) { pos[s] = SP[(qt * 8 + h) * 3 + s]; pm[s] = (pos[s] >= 0) ? PM[pos[s]] : -3.0e38f; M = fmaxf(M, pm[s]); }
        const float so = __expf(m - M);
        float den = l * so;
#pragma unroll
        for (int dt = 0; dt < 4; ++dt) o[dt] = o[dt] * so;
#pragma unroll
        for (int s = 0; s < 3; ++s) {
            if (pos[s] >= 0) {
                const float e = __expf(pm[s] - M);
                den += PL[pos[s]] * e;
#pragma unroll
                for (int dt = 0; dt < 4; ++dt) {
                    const u32x2 pv = *(const u32x2*)(PO + (size_t)pos[s] * 64 + dt * 16 + fq * 4);
                    o[dt].x += e * __uint_as_float(pv.x << 16); o[dt].y += e * __uint_as_float(pv.x & 0xffff0000u);
                    o[dt].z += e * __uint_as_float(pv.y << 16); o[dt].w += e * __uint_as_float(pv.y & 0xffff0000u);
                }
            }
        }
        const float inv = 1.f / den;
#pragma unroll
        for (int dt = 0; dt < 4; ++dt) *(u32x2*)(ob + (size_t)qt * 512 + h * 64 + dt * 16 + fq * 4) = pack4(o[dt] * inv);
        __syncthreads();
    }
}

__device__ __forceinline__ void phase_qx_xattn(const P& p, int bid, int nb, char* smem) {
    char* ws = p.ws;
    const bf16_t* KX = (const bf16_t*)(ws + OFF_KVX); const bf16_t* VXT = KX + 256 * 512;
    bf16_t* ox = (bf16_t*)(ws + OFF_OB);
    for (int it = bid; it < 512; it += nb) {
        const int pm = it >> 2, h = it & 3;
        bf16x8 qf[2][4];
        {
            f32x4 acc[2][8];
#pragma unroll
            for (int m = 0; m < 2; ++m)
#pragma unroll
                for (int n = 0; n < 8; ++n) acc[m][n] = (f32x4){0.f, 0.f, 0.f, 0.f};
            gemm_core<false, false, true, 2, 8>(acc, (const bf16_t*)(ws + OFF_XN), D, nullptr, pm * 128, (const bf16_t*)(ws + OFF_WQ), D, h * 128, D, smem);
            const float sc = 0.08838834764831845f;
#pragma unroll
            for (int m = 0; m < 2; ++m)
#pragma unroll
                for (int s2 = 0; s2 < 4; ++s2) qf[m][s2] = pack8(acc[m][2 * s2] * sc, acc[m][2 * s2 + 1] * sc);
        }
        const int tid = otid(), lane = tid & 63, w = tid >> 6, fr = lane & 15, fq = lane >> 4;
        for (int idx = tid; idx < 4096; idx += 256) { const int key = idx >> 4, ch = idx & 15; *(u32x4*)(smem + key * 272 + ch * 16) = *(const u32x4*)(KX + (size_t)key * 512 + h * 128 + ch * 8); }
        __syncthreads();
        bf16x8 pf[2][8]; float inv[2];
#pragma unroll
        for (int m = 0; m < 2; ++m) {
            f32x4 sc[16]; float mx = -3.0e38f;
#pragma unroll
            for (int kt = 0; kt < 16; ++kt) {
                f32x4 a = {0.f, 0.f, 0.f, 0.f};
#pragma unroll
                for (int s2 = 0; s2 < 4; ++s2) a = MFMA16(ldperm(smem + (kt * 16 + fr) * 272, s2, fq), qf[m][s2], a);
                sc[kt] = a; mx = fmaxf(fmaxf(mx, fmaxf(a.x, a.y)), fmaxf(a.z, a.w));
            }
            mx = fmaxf(mx, __shfl_xor(mx, 16)); mx = fmaxf(mx, __shfl_xor(mx, 32));
            float ls = 0.f;
#pragma unroll
            for (int kt = 0; kt < 16; ++kt) { sc[kt].x = __expf(sc[kt].x - mx); sc[kt].y = __expf(sc[kt].y - mx); sc[kt].z = __expf(sc[kt].z - mx); sc[kt].w = __expf(sc[kt].w - mx); ls += (sc[kt].x + sc[kt].y) + (sc[kt].z + sc[kt].w); }
            ls += __shfl_xor(ls, 16); ls += __shfl_xor(ls, 32);
            inv[m] = 1.f / ls;
#pragma unroll
            for (int s2 = 0; s2 < 8; ++s2) { pf[m][s2] = pack8(sc[2 * s2], sc[2 * s2 + 1]); asm volatile("" : "+v"(pf[m][s2])); }
            asm volatile("" ::: "memory");
        }
        __syncthreads();
        for (int idx = tid; idx < 4096; idx += 256) { const int d = idx >> 5, ch = idx & 31; *(u32x4*)(smem + d * 528 + ch * 16) = *(const u32x4*)(VXT + (size_t)(h * 128 + d) * 256 + ch * 8); }
        __syncthreads();
#pragma unroll
        for (int m = 0; m < 2; ++m) {
            const int row = pm * 128 + w * 32 + m * 16 + fr;
#pragma unroll
            for (int dt = 0; dt < 8; ++dt) {
                f32x4 o = {0.f, 0.f, 0.f, 0.f};
#pragma unroll
                for (int s2 = 0; s2 < 8; ++s2) o = MFMA16(ldperm(smem + (dt * 16 + fr) * 528, s2, fq), pf[m][s2], o);
                *(u32x2*)(ox + (size_t)row * 512 + h * 128 + dt * 16 + fq * 4) = pack4(o * inv[m]);
                asm volatile("" ::: "memory");
            }
        }
        __syncthreads();
    }
}

__device__ __forceinline__ void phase_merge(const P& p, int bid, int nb, char* smem) {
    TILE_COORDS
    char* ws = p.ws;
    const bf16_t* ug = (const bf16_t*)(ws + OFF_UG);
    bf16_t* mg = (bf16_t*)(ws + OFF_MRG);
    for (int it = bid; it < 128 * 8; it += nb) {
        const int pm = it >> 3, pn = it & 7;
        f32x4 acc[4][4], acc2[4][4]; zero_acc(acc); zero_acc(acc2);
        gemm_k_loop<false>(acc, (const bf16_t*)(ws + OFF_OA), 512, nullptr, pm * 128, (const bf16_t*)(ws + OFF_WORW), 512, pn * 128, 512, smem);
        gemm_k_loop<false>(acc2, (const bf16_t*)(ws + OFF_OB), 512, nullptr, pm * 128, (const bf16_t*)(ws + OFF_WOMB), 512, pn * 128, 512, smem);
#pragma unroll
        for (int m = 0; m < 4; ++m) {
            const int row = pm * 128 + wr * 64 + m * 16 + fr;
#pragma unroll
            for (int n = 0; n < 4; ++n) {
                const int col = pn * 128 + wc * 64 + n * 16 + fq * 4;
                const u32x2 ga = *(const u32x2*)(ug + (size_t)row * GCOLS + col);
                const u32x2 gb = *(const u32x2*)(ug + (size_t)row * GCOLS + 1024 + col);
                const f32x4 a = acc[m][n], b = acc2[m][n];
                const float r0 = __uint_as_float(ga.x << 16) * a.x + __uint_as_float(gb.x << 16) * b.x;
                const float r1 = __uint_as_float(ga.x & 0xffff0000u) * a.y + __uint_as_float(gb.x & 0xffff0000u) * b.y;
                const float r2 = __uint_as_float(ga.y << 16) * a.z + __uint_as_float(gb.y << 16) * b.z;
                const float r3 = __uint_as_float(ga.y & 0xffff0000u) * a.w + __uint_as_float(gb.y & 0xffff0000u) * b.w;
                u32x2 o; o.x = pk2(r0, r1); o.y = pk2(r2, r3);
                *(u32x2*)(mg + (size_t)row * D + col) = o;
            }
        }
    }
}

__device__ __forceinline__ void phase_resid_gemm(const bf16_t* A, int K, const bf16_t* Bt, const float* res, float* dst, int bid, int nb, char* smem) {
    TILE_COORDS
    for (int it = bid; it < 128 * 8; it += nb) {
        const int pm = it >> 3, pn = it & 7;
        f32x4 acc[4][4]; zero_acc(acc);
        gemm_k_loop<false>(acc, A, K, nullptr, pm * 128, Bt, K, pn * 128, K, smem);
#pragma unroll
        for (int m = 0; m < 4; ++m) {
            const int row = pm * 128 + wr * 64 + m * 16 + fr;
#pragma unroll
            for (int n = 0; n < 4; ++n) {
                const size_t off = (size_t)row * D + pn * 128 + wc * 64 + n * 16 + fq * 4;
                const f32x4 r = *(const f32x4*)(res + off);
                *(f32x4*)(dst + off) = r + acc[m][n];
            }
        }
    }
}

__device__ __forceinline__ void phase_norm(const float* src, const float* g, bf16_t* dst, int bid, int nb) {
    const int lane = otid() & 63, wid = otid() >> 6;
    for (int it = bid; it < T / 4; it += nb) { const int row = it * 4 + wid; rms_row_bf16(src + (size_t)row * D, g, dst + (size_t)row * D, lane); }
}

__device__ __forceinline__ void phase_expconv(const P& p, int bid, int nb, char* smem) {
    float* scr = (float*)smem;
    bf16_t* gu = (bf16_t*)(p.ws + OFF_EXPGU); bf16_t* dn = (bf16_t*)(p.ws + OFF_EXPD);
    for (int it = bid; it < 3 * 32 * 128; it += nb) {
        const int which = it / 4096, r = it % 4096, e = r >> 7, tile = r & 127;
        if (which == 0) transpose_tile(p.w_exp_gate + (size_t)e * D * DEXP, D, DEXP, gu + (size_t)e * D * D, 32, 0, tile, scr);
        else if (which == 1) transpose_tile(p.w_exp_up + (size_t)e * D * DEXP, D, DEXP, gu + (size_t)e * D * D, 32, 16, tile, scr);
        else transpose_tile(p.w_exp_down + (size_t)e * DEXP * D, DEXP, D, dn + (size_t)e * D * DEXP, 16, 0, tile, scr);
    }
}

__device__ __forceinline__ void phase_router(const P& p, int bid, int nb, char* smem) {
    const int tid = otid(), lane = tid & 63, wid = tid >> 6;
    char* ws = p.ws;
    int* hist = (int*)smem;
    if (tid < 32) hist[tid] = 0;
    __syncthreads();
    const float* x2 = p.out;
    const float* rt = (const float*)(ws + OFF_ROUT);
    bf16_t* xn = (bf16_t*)(ws + OFF_XN);
    int* toke = (int*)(ws + OFF_CTL + CTL_TOKE); float* tokg = (float*)(ws + OFF_CTL + CTL_TOKG);
    int* rowtok = (int*)(ws + OFF_CTL + CTL_ROWTOK);
    for (int i = bid * 256 + tid; i < CAP; i += nb * 256) rowtok[i] = 0;
    for (int it = bid; it < T / 16; it += nb) {
        const int rbase = it * 16 + wid * 4;
        f32x4 hv[4][4];
#pragma unroll
        for (int rr = 0; rr < 4; ++rr) {
            const f32x4* xr = (const f32x4*)(x2 + (size_t)(rbase + rr) * D) + lane; const f32x4* gr = (const f32x4*)p.norm_ffn + lane;
            float s = 0.f;
#pragma unroll
            for (int j = 0; j < 4; ++j) { hv[rr][j] = xr[64 * j]; s += hv[rr][j].x * hv[rr][j].x + hv[rr][j].y * hv[rr][j].y + hv[rr][j].z * hv[rr][j].z + hv[rr][j].w * hv[rr][j].w; }
            const float rstd = rsqrtf(wave_sum(s) * (1.f / 1024.f) + 1e-6f);
            u32x2* o8 = (u32x2*)(xn + (size_t)(rbase + rr) * D) + lane;
#pragma unroll
            for (int j = 0; j < 4; ++j) { const f32x4 gg = gr[64 * j]; hv[rr][j] = hv[rr][j] * rstd * gg; u32x2 o; o.x = pk2(hv[rr][j].x, hv[rr][j].y); o.y = pk2(hv[rr][j].z, hv[rr][j].w); o8[64 * j] = o; }
        }
        float mine[4] = {0.f, 0.f, 0.f, 0.f};
#pragma unroll 4
        for (int o = 0; o < 36; ++o) {
            const f32x4* wr_ = (const f32x4*)(rt + o * 1024) + lane;
            f32x4 w[4];
#pragma unroll
            for (int j = 0; j < 4; ++j) w[j] = wr_[64 * j];
#pragma unroll
            for (int rr = 0; rr < 4; ++rr) {
                float s = 0.f;
#pragma unroll
                for (int j = 0; j < 4; ++j) s += hv[rr][j].x * w[j].x + hv[rr][j].y * w[j].y + hv[rr][j].z * w[j].z + hv[rr][j].w * w[j].w;
                s = wave_sum(s);
                if (lane == o) mine[rr] = s;
            }
            asm volatile("" ::: "memory");
        }
#pragma unroll
        for (int rr = 0; rr < 4; ++rr) {
            const float g0 = __shfl(mine[rr], 32), g1 = __shfl(mine[rr], 33), g2 = __shfl(mine[rr], 34), g3 = __shfl(mine[rr], 35);
            int gs = 0; float gm = g0;
            if (g1 > gm) { gm = g1; gs = 1; }
            if (g2 > gm) { gm = g2; gs = 2; }
            if (g3 > gm) { gm = g3; gs = 3; }
            const float gp = 1.f / (__expf(g0 - gm) + __expf(g1 - gm) + __expf(g2 - gm) + __expf(g3 - gm));
            float e[8];
#pragma unroll
            for (int i = 0; i < 8; ++i) e[i] = __shfl(mine[rr], gs * 8 + i);
            int i1 = 0; float v1 = e[0];
#pragma unroll
            for (int i = 1; i < 8; ++i) if (e[i] > v1) { v1 = e[i]; i1 = i; }
            int i2 = -1; float v2 = -3.0e38f;
#pragma unroll
            for (int i = 0; i < 8; ++i) if (i != i1 && e[i] > v2) { v2 = e[i]; i2 = i; }
            const float e2 = __expf(v2 - v1), den = 1.f / (1.f + e2);
            if (lane == 0) {
                const int tok = rbase + rr;
                toke[tok * 2] = gs * 8 + i1; toke[tok * 2 + 1] = gs * 8 + i2;
                tokg[tok * 2] = gp * den; tokg[tok * 2 + 1] = gp * e2 * den;
                atomicAdd(&hist[gs * 8 + i1], 1); atomicAdd(&hist[gs * 8 + i2], 1);
            }
        }
    }
    __syncthreads();
    if (tid < 32 && hist[tid]) atomicAdd((int*)(ws + OFF_CTL + CTL_CNT) + tid, hist[tid]);
}

__device__ __forceinline__ void phase_dispatch(const P& p, int bid, int nb, char* smem) {
    const int tid = otid();
    char* ws = p.ws;
    int* pstart = (int*)smem;
    const int* counts = (const int*)(ws + OFF_CTL + CTL_CNT);
    int* cursor = (int*)(ws + OFF_CTL + CTL_CNT) + 32;
    if (tid == 0) { int a = 0; for (int e = 0; e < 32; ++e) { pstart[e] = a; a += (counts[e] + 127) / 128 * 128; } pstart[32] = a; }
    __syncthreads();
    const int* toke = (const int*)(ws + OFF_CTL + CTL_TOKE);
    int* toks = (int*)(ws + OFF_CTL + CTL_TOKS); int* rowtok = (int*)(ws + OFF_CTL + CTL_ROWTOK);
    for (int i = bid * 256 + tid; i < T * 2; i += nb * 256) {
        const int e = toke[i];
        const int pos = pstart[e] + atomicAdd(&cursor[e], 1);
        rowtok[pos] = i >> 1; toks[i] = pos;
    }
    if (bid == 0) {
        int* blke = (int*)(ws + OFF_CTL + CTL_BLKE);
        for (int b = tid; b < NBLK; b += 256) {
            const int r = b * 128; int e = -1;
            if (r < pstart[32]) { e = 0; while (pstart[e + 1] <= r) ++e; }
            blke[b] = e;
        }
    }
}

__device__ __forceinline__ void phase_exp1(const P& p, int bid, int nb, char* smem) {
    TILE_COORDS
    char* ws = p.ws;
    const int* blke = (const int*)(ws + OFF_CTL + CTL_BLKE); const int* rowtok = (const int*)(ws + OFF_CTL + CTL_ROWTOK);
    bf16_t* hid = (bf16_t*)(ws + OFF_MRG);
    for (int it = bid; it < NBLK * 8; it += nb) {
        const int b = it >> 3, pn = it & 7, e = blke[b];
        if (e < 0) continue;
        f32x4 acc[4][4]; zero_acc(acc);
        gemm_k_loop<true>(acc, (const bf16_t*)(ws + OFF_XN), D, rowtok + b * 128, 0, (const bf16_t*)(ws + OFF_EXPGU) + (size_t)e * D * D, D, pn * 128, D, smem);
#pragma unroll
        for (int m = 0; m < 4; ++m) {
            const int row = b * 128 + wr * 64 + m * 16 + fr;
#pragma unroll
            for (int n2 = 0; n2 < 2; ++n2) {
                const f32x4 g = acc[m][n2 * 2], u = acc[m][n2 * 2 + 1];
                const float h0 = g.x * sigm(g.x) * u.x, h1 = g.y * sigm(g.y) * u.y, h2 = g.z * sigm(g.z) * u.z, h3 = g.w * sigm(g.w) * u.w;
                u32x2 o; o.x = pk2(h0, h1); o.y = pk2(h2, h3);
                *(u32x2*)(hid + (size_t)row * DEXP + pn * 64 + wc * 32 + n2 * 16 + fq * 4) = o;
            }
        }
    }
}
__device__ __forceinline__ void phase_exp2(const P& p, int bid, int nb, char* smem) {
    TILE_COORDS
    char* ws = p.ws;
    const int* blke = (const int*)(ws + OFF_CTL + CTL_BLKE);
    bf16_t* ym = (bf16_t*)(ws + OFF_YMOE);
    for (int it = bid; it < NBLK * 8; it += nb) {
        const int b = it >> 3, pn = it & 7, e = blke[b];
        if (e < 0) continue;
        f32x4 acc[4][4]; zero_acc(acc);
        gemm_k_loop<false>(acc, (const bf16_t*)(ws + OFF_MRG), DEXP, nullptr, b * 128, (const bf16_t*)(ws + OFF_EXPD) + (size_t)e * D * DEXP, DEXP, pn * 128, DEXP, smem);
#pragma unroll
        for (int m = 0; m < 4; ++m) {
            const int row = b * 128 + wr * 64 + m * 16 + fr;
#pragma unroll
            for (int n = 0; n < 4; ++n) {
                const f32x4 v = acc[m][n]; u32x2 o; o.x = pk2(v.x, v.y); o.y = pk2(v.z, v.w);
                *(u32x2*)(ym + (size_t)row * D + pn * 128 + wc * 64 + n * 16 + fq * 4) = o;
            }
        }
    }
}
__device__ __forceinline__ void phase_final(const P& p, int bid, int nb) {
    const int lane = otid() & 63, wid = otid() >> 6;
    char* ws = p.ws;
    const int* toks = (const int*)(ws + OFF_CTL + CTL_TOKS); const float* tokg = (const float*)(ws + OFF_CTL + CTL_TOKG);
    const bf16_t* ym = (const bf16_t*)(ws + OFF_YMOE);
    for (int it = bid; it < T / 4; it += nb) {
        const int row = it * 4 + wid;
        const int s1 = toks[row * 2], s2 = toks[row * 2 + 1]; const float g1 = tokg[row * 2], g2 = tokg[row * 2 + 1];
        f32x4* xr = (f32x4*)(p.out + (size_t)row * D) + lane; const f32x4* gr = (const f32x4*)p.norm_final + lane;
        const u32x2* y1 = (const u32x2*)(ym + (size_t)s1 * D) + lane; const u32x2* y2 = (const u32x2*)(ym + (size_t)s2 * D) + lane;
        f32x4 v[4]; float s = 0.f;
#pragma unroll
        for (int j = 0; j < 4; ++j) {
            v[j] = xr[64 * j]; const u32x2 a = y1[64 * j], b = y2[64 * j];
            v[j].x += g1 * __uint_as_float(a.x << 16) + g2 * __uint_as_float(b.x << 16);
            v[j].y += g1 * __uint_as_float(a.x & 0xffff0000u) + g2 * __uint_as_float(b.x & 0xffff0000u);
            v[j].z += g1 * __uint_as_float(a.y << 16) + g2 * __uint_as_float(b.y << 16);
            v[j].w += g1 * __uint_as_float(a.y & 0xffff0000u) + g2 * __uint_as_float(b.y & 0xffff0000u);
            s += v[j].x * v[j].x + v[j].y * v[j].y + v[j].z * v[j].z + v[j].w * v[j].w;
        }
        const float rstd = rsqrtf(wave_sum(s) * (1.f / 1024.f) + 1e-6f);
#pragma unroll
        for (int j = 0; j < 4; ++j) xr[64 * j] = v[j] * rstd * gr[64 * j];
    }
}

constexpr int NPHASE = 17;
template <int PH>
__device__ __forceinline__ void run_phase(const P& p, int bid, int nb, char* smem) {
    char* ws = p.ws;
    if (PH == 0) phase0(p, bid, nb, smem);
    else if (PH == 1) phase1(p, bid, nb, smem);
    else if (PH == 2) { phase_kmean(p, bid, nb, smem); phase_rw_chunk(p, bid, nb, smem); }
    else if (PH == 3) { if (bid < 8) rw_scan(p, bid); else moba_select(p, bid - 8, nb - 8, smem); }
    else if (PH == 4) { phase_rw_out(p, bid, nb); moba_fill(p, bid, nb, smem); }
    else if (PH == 5) moba_partial(p, bid, nb, smem);
    else if (PH == 6) moba_own(p, bid, nb, smem);
    else if (PH == 7) phase_merge(p, bid, nb, smem);
    else if (PH == 8) phase_resid_gemm((const bf16_t*)(ws + OFF_MRG), D, (const bf16_t*)(ws + OFF_WOUT), p.x, p.out, bid, nb, smem);
    else if (PH == 9) { phase_norm(p.out, p.norm_xattn, (bf16_t*)(ws + OFF_XN), bid, nb); phase_expconv(p, bid, nb, smem); }
    else if (PH == 10) phase_qx_xattn(p, bid, nb, smem);
    else if (PH == 11) phase_resid_gemm((const bf16_t*)(ws + OFF_OB), 512, (const bf16_t*)(ws + OFF_WOX), p.out, p.out, bid, nb, smem);
    else if (PH == 12) phase_router(p, bid, nb, smem);
    else if (PH == 13) phase_dispatch(p, bid, nb, smem);
    else if (PH == 14) phase_exp1(p, bid, nb, smem);
    else if (PH == 15) phase_exp2(p, bid, nb, smem);
    else if (PH == 16) phase_final(p, bid, nb);
}

#define XB_TMO      128
#define XB_XCNT(j)  (256  + 64 * (j))
#define XB_XSUB(j)  (1280 + 64 * (j))
#define XB_XGEN(j)  (2304 + 64 * (j))
#define XB_TOP      3328
#define XB_TOPGEN   3392
#define XCD_BAR_WORDS 3456
#define XB_SPIN_CAP (1u << 18)
#define LAS __attribute__((address_space(3)))
__device__ __forceinline__ unsigned xb_ld(unsigned* p)              { return __hip_atomic_load(p, __ATOMIC_RELAXED, __HIP_MEMORY_SCOPE_AGENT); }
__device__ __forceinline__ unsigned xb_add(unsigned* p, unsigned v) { return __hip_atomic_fetch_add(p, v, __ATOMIC_RELAXED, __HIP_MEMORY_SCOPE_AGENT); }
__device__ __forceinline__ unsigned xb_xcc_id() { return (unsigned)__builtin_amdgcn_s_getreg((3 << 11) | 20) & 0xFu; }
#define XB_SPIN(cond, bar) do { unsigned _sp = 0; while (cond) { __builtin_amdgcn_s_sleep(1); \
    if ((++_sp & 255u) == 0u) { if (xb_ld(&(bar)[XB_TMO])) break; if (_sp > XB_SPIN_CAP) { atomicAdd(&(bar)[XB_TMO], 1u); break; } } } } while (0)
struct XcdBarrier { unsigned* bar; unsigned x; volatile LAS unsigned* st; };
__device__ __forceinline__ XcdBarrier xcd_barrier_post(unsigned* bar, volatile LAS unsigned* st) {
    XcdBarrier b; b.bar = bar; b.x = xb_xcc_id(); b.st = st;
    if (threadIdx.x == 0) (void)xb_add(&bar[XB_XCNT(b.x)], 1u);
    return b;
}
__device__ __forceinline__ void xcd_barrier_complete(unsigned* bar, unsigned x, unsigned& nloc, unsigned& nx) {
    const unsigned G = gridDim.x * gridDim.y * gridDim.z;
    unsigned sum, cnt, mine, sp = 0u;
    for (;;) {
        sum = 0u; cnt = 0u; mine = 0u;
#pragma unroll
        for (unsigned j = 0; j < 16; ++j) { const unsigned c = xb_ld(&bar[XB_XCNT(j)]); sum += c; cnt += (c > 0u) ? 1u : 0u; mine = (j == x) ? c : mine; }
        if (sum == G) break;
        __builtin_amdgcn_s_sleep(1);
        if ((++sp & 255u) == 0u) { if (xb_ld(&bar[XB_TMO])) break; if (sp > XB_SPIN_CAP) { atomicAdd(&bar[XB_TMO], 1u); break; } }
    }
    nloc = mine > 0u ? mine : 1u; nx = cnt > 0u ? cnt : 1u;
}
__device__ __forceinline__ void xcd_barrier(const XcdBarrier& b) {
    asm volatile("s_waitcnt vmcnt(0)" ::: "memory");
    __syncthreads();
    if (threadIdx.x == 0) {
        unsigned* bar = b.bar;
        __builtin_amdgcn_s_waitcnt(0);
        unsigned nloc = b.st[0], nx = b.st[1];
        if (nloc == 0u) { xcd_barrier_complete(bar, b.x, nloc, nx); b.st[0] = nloc; b.st[1] = nx; }
        const unsigned old = xb_add(&bar[XB_XSUB(b.x)], 1u);
        const unsigned gen = old / nloc;
        if (old + 1u == (gen + 1u) * nloc) {
            __builtin_amdgcn_fence(__ATOMIC_RELEASE, "agent");
            asm volatile("s_waitcnt vmcnt(0)" ::: "memory");
            const unsigned og = xb_add(&bar[XB_TOP], 1u);
            const unsigned tg = og / nx;
            if (og + 1u == (tg + 1u) * nx) xb_add(&bar[XB_TOPGEN], 1u);
            else XB_SPIN(xb_ld(&bar[XB_TOPGEN]) == tg, bar);
            __builtin_amdgcn_fence(__ATOMIC_ACQUIRE, "agent");
            xb_add(&bar[XB_XGEN(b.x)], 1u);
            asm volatile("s_waitcnt vmcnt(0)" ::: "memory");
        } else {
            XB_SPIN(xb_ld(&bar[XB_XGEN(b.x)]) == gen, bar);
            __builtin_amdgcn_fence(__ATOMIC_ACQUIRE, "agent");
            asm volatile("s_waitcnt vmcnt(0)" ::: "memory");
        }
    }
    __syncthreads();
}
constexpr size_t CTL_BAR = 736 * 1024;
constexpr int L_BARST = 75200;

constexpr int LDS_BYTES = 75264;
static_assert(RW_LDS <= LDS_BYTES, "lds");
template <int PH>
__global__ void __launch_bounds__(256, 2) phase_kernel(P p) {
    extern __shared__ __attribute__((aligned(16))) char smem[];
    run_phase<PH>(p, blockIdx.x, gridDim.x, smem);
}

#ifndef NO_MEGA
__global__ void __launch_bounds__(256, 2) mega_kernel(P p) {
    extern __shared__ __attribute__((aligned(16))) char smem[];
    cg::grid_group grid = cg::this_grid();
    const int bid = blockIdx.x, nb = gridDim.x;
    volatile LAS unsigned* bst = (volatile LAS unsigned*)(LAS char*)(smem + L_BARST);
    if (threadIdx.x < 2) bst[threadIdx.x] = 0u;
    __syncthreads();
    const XcdBarrier xb = xcd_barrier_post((unsigned*)(p.ws + OFF_CTL + CTL_BAR), bst);
#define GSYNC() xcd_barrier(xb)
    run_phase<0>(p, bid, nb, smem); grid.sync();
    run_phase<1>(p, bid, nb, smem); GSYNC();
    run_phase<2>(p, bid, nb, smem); GSYNC();
    run_phase<3>(p, bid, nb, smem); GSYNC();
    run_phase<4>(p, bid, nb, smem); GSYNC();
    run_phase<5>(p, bid, nb, smem); GSYNC();
    run_phase<6>(p, bid, nb, smem); GSYNC();
    run_phase<7>(p, bid, nb, smem); GSYNC();
    run_phase<8>(p, bid, nb, smem); GSYNC();
    run_phase<9>(p, bid, nb, smem); GSYNC();
    run_phase<10>(p, bid, nb, smem); GSYNC();
    run_phase<11>(p, bid, nb, smem); GSYNC();
    run_phase<12>(p, bid, nb, smem); GSYNC();
    run_phase<13>(p, bid, nb, smem); GSYNC();
    run_phase<14>(p, bid, nb, smem); GSYNC();
    run_phase<15>(p, bid, nb, smem); GSYNC();
    run_phase<16>(p, bid, nb, smem);
}

extern "C" void kernel_launch(void* const* d_in, const int* in_sizes, int n_in, void* d_out, int out_size, void* d_ws, size_t ws_size, hipStream_t stream) {
    if (n_in != 31 || ws_size < WS_NEED || out_size != T * D) { fprintf(stderr, "kernel_launch: unexpected n_in %d / ws_size %zu / out_size %d\n", n_in, ws_size, out_size); return; }
    static int grid_blocks = 0;
    if (!grid_blocks) {
        int dev = 0, cus = 0, per_cu = 0;
        hipGetDevice(&dev);
        hipDeviceGetAttribute(&cus, hipDeviceAttributeMultiprocessorCount, dev);
        if (hipFuncSetAttribute((const void*)mega_kernel, hipFuncAttributeMaxDynamicSharedMemorySize, LDS_BYTES) != hipSuccess) fprintf(stderr, "kernel_launch: hipFuncSetAttribute failed\n");
        hipOccupancyMaxActiveBlocksPerMultiprocessor(&per_cu, (const void*)mega_kernel, 256, LDS_BYTES);
        if (per_cu > 2) per_cu = 2;
        if (per_cu < 1) { fprintf(stderr, "kernel_launch: occupancy query returned %d\n", per_cu); per_cu = 1; }
        grid_blocks = cus * per_cu;
        fprintf(stderr, "kernel_launch: cus %d per_cu %d grid %d\n", cus, per_cu, grid_blocks);
    }
    P p{};
    const float** f = (const float**)&p;
    for (int i = 0; i < 31; ++i) f[i] = (const float*)d_in[i];
    p.out = (float*)d_out; p.ws = (char*)d_ws;
    if (hipMemsetAsync((char*)d_ws + OFF_CTL + CTL_BAR, 0, XCD_BAR_WORDS * 4, stream) != hipSuccess) fprintf(stderr, "kernel_launch: memset failed\n");
    void* args[] = {&p};
    hipError_t e = hipLaunchCooperativeKernel((const void*)mega_kernel, dim3(grid_blocks), dim3(256), args, LDS_BYTES, stream);
    if (e != hipSuccess) fprintf(stderr, "cooperative launch failed: %s (grid %d)\n", hipGetErrorString(e), grid_blocks);
}
#endif
```

```cpp
#include <hip/hip_runtime.h>
#include <hip/hip_cooperative_groups.h>
#include <cstdio>
#include <cstdint>
namespace cg = cooperative_groups;

typedef unsigned short bf16_t;
typedef short bf16x8 __attribute__((ext_vector_type(8)));
typedef float f32x4 __attribute__((ext_vector_type(4)));
typedef unsigned u32x4 __attribute__((ext_vector_type(4)));
typedef unsigned u32x2 __attribute__((ext_vector_type(2)));

constexpr int T = 16384, D = 1024, NMEM = 256;
constexpr int UMC = 1024;
constexpr int RW = 512, RCOLS = 1792, MW = 512, MCOLS = 1536, GCOLS = 2048, INCOLS = 5376;
constexpr int NEXP = 32, DEXP = 512, CAP = 36864, NBLK = 288;
constexpr size_t MiB = 1u << 20;
constexpr size_t OFF_CTL = 0;
constexpr size_t OFF_WIN = 1 * MiB;
constexpr size_t OFF_WORW = OFF_WIN + (size_t)INCOLS * D * 2;
constexpr size_t OFF_WOMB = OFF_WORW + 1 * MiB;
constexpr size_t OFF_WOUT = OFF_WOMB + 1 * MiB;
constexpr size_t OFF_WQ = OFF_WOUT + 2 * MiB;
constexpr size_t OFF_WKV = OFF_WQ + 1 * MiB;
constexpr size_t OFF_WOX = OFF_WKV + 2 * MiB;
constexpr size_t OFF_MEMN = OFF_WOX + 1 * MiB;
constexpr size_t OFF_KVX = OFF_MEMN + MiB / 2;
constexpr size_t OFF_ROUT = OFF_KVX + MiB / 2;
constexpr size_t OFF_XN = 21 * MiB;
constexpr size_t OFF_UG = 53 * MiB;
constexpr size_t OFF_UR = 117 * MiB;
constexpr size_t OFF_UM = 173 * MiB;
constexpr size_t OFF_VT = 205 * MiB;
constexpr size_t OFF_MSEL = 285 * MiB;
constexpr size_t OFF_MQL = OFF_MSEL + MiB / 2;
constexpr size_t OFF_MSP = OFF_MQL + 3 * MiB / 2;
constexpr size_t OFF_OA = 221 * MiB;
constexpr size_t OFF_OB = 237 * MiB;
constexpr size_t OFF_MRG = 253 * MiB;
constexpr size_t OFF_EXPGU = 117 * MiB;
constexpr size_t OFF_EXPD = 181 * MiB;
constexpr size_t OFF_YMOE = 21 * MiB;
constexpr size_t OFF_LORA_D = OFF_ROUT + 160 * 1024;
constexpr size_t OFF_LORA_I = OFF_LORA_D + 64 * 1024;
constexpr size_t OFF_LORA_G = OFF_LORA_I + 64 * 1024;
constexpr size_t OFF_BON = 21 * MiB;
constexpr size_t OFF_RH = 37 * MiB;
constexpr size_t OFF_MF = 253 * MiB;
constexpr size_t OFF_SF = 269 * MiB;
constexpr size_t WS_NEED = 289 * MiB;
static_assert(OFF_ROUT + MiB / 2 == OFF_XN, "ws map");
constexpr size_t CTL_CNT = 0;
constexpr size_t CTL_BLKE = 4096;
constexpr size_t CTL_MCNT = 8192, CTL_MCUR = 10240, CTL_MLST = 12288, CTL_MTST = 14592;
constexpr size_t CTL_KMB = 768 * 1024;
constexpr size_t CTL_TOKE = 192 * 1024;
constexpr size_t CTL_TOKG = 320 * 1024;
constexpr size_t CTL_TOKS = 448 * 1024;
constexpr size_t CTL_ROWTOK = 576 * 1024;

struct P {
    const float *x, *mem, *rel_bias, *mem_norm, *norm_mix, *w_in, *tshift_mu, *decay_w0, *decay_up, *iclr_a0, *iclr_up, *gate_up,
        *k_k, *k_a, *r_k, *ln_x_w, *ln_x_b, *w_o_rwkv, *w_o_moba, *w_out, *norm_xattn, *w_q_x, *w_kv_x, *w_o_x, *norm_ffn,
        *w_router_group, *w_router_expert, *w_exp_gate, *w_exp_up, *w_exp_down, *norm_final;
    float* out;
    char* ws;
};

__device__ __forceinline__ int otid() { int t = threadIdx.x; asm volatile("" : "+v"(t)); return t; }
__device__ __forceinline__ float bf2f(bf16_t b) { return __uint_as_float((unsigned)b << 16); }
__device__ __forceinline__ unsigned f2bf(float f) { unsigned u = __float_as_uint(f); return (u + 0x7fffu + ((u >> 16) & 1u)) >> 16; }
__device__ __forceinline__ unsigned pk2(float lo, float hi) { return f2bf(lo) | (f2bf(hi) << 16); }
__device__ __forceinline__ float wave_sum(float v) {
#pragma unroll
    for (int o = 32; o >= 1; o >>= 1) v += __shfl_xor(v, o);
    return v;
}
__device__ __forceinline__ float wave_max(float v) {
#pragma unroll
    for (int o = 32; o >= 1; o >>= 1) v = fmaxf(v, __shfl_xor(v, o));
    return v;
}
__device__ __forceinline__ float sigm(float x) { return 1.f / (1.f + __expf(-x)); }
__device__ __forceinline__ void wave_lds_fence() { asm volatile("s_waitcnt lgkmcnt(0)" ::: "memory"); __builtin_amdgcn_wave_barrier(); }
__device__ __forceinline__ int t5_bucket(int n) {
    if (n < 16) return n;
    int v = 8 + (31 - __clz(n * n));
    return v > 31 ? 31 : v;
}
__device__ __forceinline__ void unpack8(u32x4 w, float* f) {
    f[0] = __uint_as_float(w.x << 16); f[1] = __uint_as_float(w.x & 0xffff0000u);
    f[2] = __uint_as_float(w.y << 16); f[3] = __uint_as_float(w.y & 0xffff0000u);
    f[4] = __uint_as_float(w.z << 16); f[5] = __uint_as_float(w.z & 0xffff0000u);
    f[6] = __uint_as_float(w.w << 16); f[7] = __uint_as_float(w.w & 0xffff0000u);
}

template <bool GATHER, bool SWAP, bool R32, int NM, int NN>
__device__ __forceinline__ void gemm_core(f32x4 (&acc)[NM][NN], const bf16_t* A, int lda, const int* rows, int brow,
                                          const bf16_t* Bt, int ldb, int bcol, int K, char* smem) {
    const int tid = otid(), lane = tid & 63, wid = tid >> 6, fr = lane & 15, fq = lane >> 4;
    const int arow0 = R32 ? wid * 32 : (wid >> 1) * 64, brow0 = R32 ? 0 : (wid & 1) * 64;
    const int r0 = tid >> 3, lch = (tid & 7) ^ ((tid >> 4) & 7);
    const bf16_t* pa[4]; const bf16_t* pb[4];
#pragma unroll
    for (int i = 0; i < 4; ++i) {
        const long ra = GATHER ? (long)rows[r0 + 32 * i] : (long)(brow + r0 + 32 * i);
        pa[i] = A + ra * lda + lch * 8;
        pb[i] = Bt + (long)(bcol + r0 + 32 * i) * ldb + lch * 8;
    }
    const int nk = K / 64;
#pragma unroll
    for (int i = 0; i < 4; ++i) {
        __builtin_amdgcn_global_load_lds((const unsigned*)pa[i], (unsigned*)(smem + tid * 16 + i * 4096), 16, 0, 0);
        __builtin_amdgcn_global_load_lds((const unsigned*)pb[i], (unsigned*)(smem + 16384 + tid * 16 + i * 4096), 16, 0, 0);
    }
    const int sw = fr >> 1;
    for (int kt = 0; kt < nk; ++kt) {
        asm volatile("s_waitcnt vmcnt(0)" ::: "memory");
        __syncthreads();
        char* cur = smem + (kt & 1) * 32768;
        if (kt + 1 < nk) {
            char* nxt = smem + ((kt + 1) & 1) * 32768;
#pragma unroll
            for (int i = 0; i < 4; ++i) {
                __builtin_amdgcn_global_load_lds((const unsigned*)(pa[i] + (kt + 1) * 64), (unsigned*)(nxt + tid * 16 + i * 4096), 16, 0, 0);
                __builtin_amdgcn_global_load_lds((const unsigned*)(pb[i] + (kt + 1) * 64), (unsigned*)(nxt + 16384 + tid * 16 + i * 4096), 16, 0, 0);
            }
        }
#pragma unroll
        for (int ks = 0; ks < 2; ++ks) {
            const int pc = ((ks * 4 + fq) ^ sw) * 16;
            bf16x8 At[NM], Bf[NN];
#pragma unroll
            for (int m = 0; m < NM; ++m) At[m] = *(const bf16x8*)(cur + (arow0 + m * 16 + fr) * 128 + pc);
#pragma unroll
            for (int n = 0; n < NN; ++n) Bf[n] = *(const bf16x8*)(cur + 16384 + (brow0 + n * 16 + fr) * 128 + pc);
#pragma unroll
            for (int m = 0; m < NM; ++m)
#pragma unroll
                for (int n = 0; n < NN; ++n) acc[m][n] = SWAP ? __builtin_amdgcn_mfma_f32_16x16x32_bf16(At[m], Bf[n], acc[m][n], 0, 0, 0) : __builtin_amdgcn_mfma_f32_16x16x32_bf16(Bf[n], At[m], acc[m][n], 0, 0, 0);
        }
    }
    __syncthreads();
}
template <bool GATHER, bool SWAP = false>
__device__ __forceinline__ void gemm_k_loop(f32x4 (&acc)[4][4], const bf16_t* A, int lda, const int* rows, int brow, const bf16_t* Bt, int ldb, int bcol, int K, char* smem) {
    gemm_core<GATHER, SWAP, false, 4, 4>(acc, A, lda, rows, brow, Bt, ldb, bcol, K, smem);
}
__device__ __forceinline__ void zero_acc(f32x4 (&acc)[4][4]) {
#pragma unroll
    for (int m = 0; m < 4; ++m)
#pragma unroll
        for (int n = 0; n < 4; ++n) acc[m][n] = (f32x4){0.f, 0.f, 0.f, 0.f};
}
#define TILE_COORDS const int tid = otid(), lane = tid & 63, wid = tid >> 6, wr = wid >> 1, wc = wid & 1, fr = lane & 15, fq = lane >> 4; (void)wr; (void)wc; (void)fr; (void)fq; (void)lane;

__device__ __forceinline__ void transpose_tile(const float* W, int K, int N, bf16_t* Wt, int rs, int roff, int tile, float* scr  ) {
    const int tid = otid();
    const int nnb = N / 64, kb = tile / nnb, nb = tile % nnb, k0 = kb * 64, n0 = nb * 64;
#pragma unroll 4
    for (int i = 0; i < 16; ++i) { const int k = i * 4 + (tid >> 6), n = tid & 63; scr[k * 65 + n] = W[(size_t)(k0 + k) * N + n0 + n]; }
    __syncthreads();
#pragma unroll
    for (int i = 0; i < 2; ++i) {
        const int c = tid + i * 256, n = c >> 3, kc = c & 7;
        const float* s = scr + (kc * 8) * 65 + n;
        u32x4 o; o.x = pk2(s[0], s[65]); o.y = pk2(s[2 * 65], s[3 * 65]); o.z = pk2(s[4 * 65], s[5 * 65]); o.w = pk2(s[6 * 65], s[7 * 65]);
        const int nn = n0 + n, drow = (nn >> 4) * rs + (nn & 15) + roff;
        *(u32x4*)(Wt + (size_t)drow * K + k0 + kc * 8) = o;
    }
    __syncthreads();
}
__device__ __forceinline__ void rms_row_bf16(const float* xrow, const float* g, bf16_t* orow, int lane) {
    const f32x4* xr = (const f32x4*)xrow + lane; const f32x4* gr = (const f32x4*)g + lane;
    f32x4 v[4]; float s = 0.f;
#pragma unroll
    for (int j = 0; j < 4; ++j) { v[j] = xr[64 * j]; s += v[j].x * v[j].x + v[j].y * v[j].y + v[j].z * v[j].z + v[j].w * v[j].w; }
    const float rstd = rsqrtf(wave_sum(s) * (1.f / 1024.f) + 1e-6f);
    u32x2* o8 = (u32x2*)orow + lane;
#pragma unroll
    for (int j = 0; j < 4; ++j) { const f32x4 gg = gr[64 * j]; u32x2 o; o.x = pk2(v[j].x * rstd * gg.x, v[j].y * rstd * gg.y); o.y = pk2(v[j].z * rstd * gg.z, v[j].w * rstd * gg.w); o8[64 * j] = o; }
}

constexpr int P0_T_IN = 16 * 84, P0_T_A = 128, P0_T_B = 256;
constexpr int P0_T_L = 8 + 8 + 16;
constexpr int P0_TR = P0_T_IN + 4 * P0_T_A + 2 * P0_T_B + P0_T_L;
constexpr int P0_ROUT = 144, P0_NORM = T / 4, P0_MEM = NMEM / 4;
constexpr int P0_ITEMS = P0_TR + P0_ROUT + P0_NORM + P0_MEM + 1;

__device__ __forceinline__ void phase0(const P& p, int bid, int nb, char* smem) {
    const int tid = otid(), lane = tid & 63, wid = tid >> 6;
    char* ws = p.ws;
    for (int it = bid; it < P0_ITEMS; it += nb) {
        int r = it;
        if (r < P0_TR) {
            float* scr = (float*)smem;
            if (r < P0_T_IN) { transpose_tile(p.w_in, D, INCOLS, (bf16_t*)(ws + OFF_WIN), 16, 0, r, scr); continue; } r -= P0_T_IN;
            if (r < P0_T_A) { transpose_tile(p.w_o_rwkv, RW, D, (bf16_t*)(ws + OFF_WORW), 16, 0, r, scr); continue; } r -= P0_T_A;
            if (r < P0_T_A) { transpose_tile(p.w_o_moba, MW, D, (bf16_t*)(ws + OFF_WOMB), 16, 0, r, scr); continue; } r -= P0_T_A;
            if (r < P0_T_B) { transpose_tile(p.w_out, D, D, (bf16_t*)(ws + OFF_WOUT), 16, 0, r, scr); continue; } r -= P0_T_B;
            if (r < P0_T_A) { transpose_tile(p.w_q_x, D, 512, (bf16_t*)(ws + OFF_WQ), 16, 0, r, scr); continue; } r -= P0_T_A;
            if (r < P0_T_B) { transpose_tile(p.w_kv_x, D, D, (bf16_t*)(ws + OFF_WKV), 16, 0, r, scr); continue; } r -= P0_T_B;
            if (r < P0_T_A) { transpose_tile(p.w_o_x, 512, D, (bf16_t*)(ws + OFF_WOX), 16, 0, r, scr); continue; } r -= P0_T_A;
            if (r < 8) { transpose_tile(p.decay_up, 64, 512, (bf16_t*)(ws + OFF_LORA_D), 16, 0, r, scr); continue; } r -= 8;
            if (r < 8) { transpose_tile(p.iclr_up, 64, 512, (bf16_t*)(ws + OFF_LORA_I), 16, 0, r, scr); continue; } r -= 8;
            transpose_tile(p.gate_up, 128, 512, (bf16_t*)(ws + OFF_LORA_G), 16, 0, r, scr); continue;
        }
        r -= P0_TR;
        if (r < P0_ROUT) {
            const int e = r * 256 + tid, o = e >> 10, k = e & 1023;
            float* rt = (float*)(ws + OFF_ROUT);
            rt[e] = (o < 32) ? p.w_router_expert[k * 32 + o] : p.w_router_group[k * 4 + (o - 32)];
            continue;
        }
        r -= P0_ROUT;
        if (r < P0_NORM) { const int row = r * 4 + wid; rms_row_bf16(p.x + (size_t)row * D, p.norm_mix, (bf16_t*)(ws + OFF_XN) + (size_t)row * D, lane); continue; }
        r -= P0_NORM;
        if (r < P0_MEM) { const int row = r * 4 + wid; rms_row_bf16(p.mem + (size_t)row * D, p.mem_norm, (bf16_t*)(ws + OFF_MEMN) + (size_t)row * D, lane); continue; }
        if (tid < 64) ((int*)(ws + OFF_CTL + CTL_CNT))[tid] = 0;
        for (int i = tid; i < 1024; i += 256) ((int*)(ws + OFF_CTL + CTL_MCNT))[i] = 0;
    }
}

__device__ __forceinline__ void phase1(const P& p, int bid, int nb, char* smem) {
    TILE_COORDS
    char* ws = p.ws;
    constexpr int NT_U = (T / 128) * 42;
    for (int it = bid; it < NT_U + 16; it += nb) {
        f32x4 acc[4][4]; zero_acc(acc);
        if (it < NT_U) {
            const int pm = it / 42, pn = it % 42;
            const int colt = pn * 128;
            if (colt >= RCOLS + 1024 && colt < RCOLS + MCOLS) {
                gemm_k_loop<false, true>(acc, (const bf16_t*)(ws + OFF_XN), D, nullptr, pm * 128, (const bf16_t*)(ws + OFF_WIN), D, pn * 128, D, smem);
                bf16_t* vt = (bf16_t*)(ws + OFF_VT);
#pragma unroll
                for (int m = 0; m < 4; ++m)
#pragma unroll
                    for (int n = 0; n < 4; ++n) {
                        const int col = colt - (RCOLS + 1024) + wc * 64 + n * 16 + fr, row = pm * 128 + wr * 64 + m * 16 + fq * 4;
                        const f32x4 v = acc[m][n]; u32x2 o; o.x = pk2(v.x, v.y); o.y = pk2(v.z, v.w);
                        *(u32x2*)(vt + (size_t)col * T + row) = o;
                    }
                continue;
            }
            gemm_k_loop<false>(acc, (const bf16_t*)(ws + OFF_XN), D, nullptr, pm * 128, (const bf16_t*)(ws + OFF_WIN), D, pn * 128, D, smem);
            bf16_t* dst; int ld, cb; bool sg = false;
            if (colt < RCOLS) { dst = (bf16_t*)(ws + OFF_UR); ld = RCOLS; cb = colt; }
            else if (colt < RCOLS + MCOLS) { dst = (bf16_t*)(ws + OFF_UM); ld = UMC; cb = colt - RCOLS; }
            else { dst = (bf16_t*)(ws + OFF_UG); ld = GCOLS; cb = colt - RCOLS - MCOLS; sg = true; }
#pragma unroll
            for (int m = 0; m < 4; ++m) {
                const int row = pm * 128 + wr * 64 + m * 16 + fr;
#pragma unroll
                for (int n = 0; n < 4; ++n) {
                    f32x4 v = acc[m][n];
                    if (sg) { v.x = sigm(v.x); v.y = sigm(v.y); v.z = sigm(v.z); v.w = sigm(v.w); }
                    u32x2 o; o.x = pk2(v.x, v.y); o.y = pk2(v.z, v.w);
                    *(u32x2*)(dst + (size_t)row * ld + cb + wc * 64 + n * 16 + fq * 4) = o;
                }
            }
        } else {
            const int t2 = it - NT_U, pm = t2 >> 3, pn = t2 & 7;
            if (pn < 4) {
                gemm_k_loop<false>(acc, (const bf16_t*)(ws + OFF_MEMN), D, nullptr, pm * 128, (const bf16_t*)(ws + OFF_WKV), D, pn * 128, D, smem);
                bf16_t* dst = (bf16_t*)(ws + OFF_KVX);
#pragma unroll
                for (int m = 0; m < 4; ++m) {
                    const int row = pm * 128 + wr * 64 + m * 16 + fr;
#pragma unroll
                    for (int n = 0; n < 4; ++n) {
                        const f32x4 v = acc[m][n]; u32x2 o; o.x = pk2(v.x, v.y); o.y = pk2(v.z, v.w);
                        *(u32x2*)(dst + (size_t)row * 512 + pn * 128 + wc * 64 + n * 16 + fq * 4) = o;
                    }
                }
            } else {
                gemm_k_loop<false, true>(acc, (const bf16_t*)(ws + OFF_MEMN), D, nullptr, pm * 128, (const bf16_t*)(ws + OFF_WKV), D, pn * 128, D, smem);
                bf16_t* dst = (bf16_t*)(ws + OFF_KVX) + 256 * 512;
#pragma unroll
                for (int m = 0; m < 4; ++m)
#pragma unroll
                    for (int n = 0; n < 4; ++n) {
                        const int col = (pn - 4) * 128 + wc * 64 + n * 16 + fr, row = pm * 128 + wr * 64 + m * 16 + fq * 4;
                        const f32x4 v = acc[m][n]; u32x2 o; o.x = pk2(v.x, v.y); o.y = pk2(v.z, v.w);
                        *(u32x2*)(dst + (size_t)col * 256 + row) = o;
                    }
            }
        }
    }
}

__device__ __forceinline__ void phase_kmean(const P& p, int bid, int nb, char* smem) {
    const int tid = otid();
    const bf16_t* um = (const bf16_t*)(p.ws + OFF_UM);
    bf16_t* kmb = (bf16_t*)(p.ws + OFF_CTL + CTL_KMB);
    float* red = (float*)smem;
    for (int it = bid; it < 64 * 8; it += nb) {
        const int blk = it >> 3, h = it & 7, q = tid >> 6, d = tid & 63;
        float s = 0.f;
        for (int k = 0; k < 64; ++k) s += bf2f(um[(size_t)(blk * 256 + q * 64 + k) * UMC + 512 + h * 64 + d]);
        red[tid] = s;
        __syncthreads();
        if (tid < 64) kmb[(blk * 8 + h) * 64 + tid] = (bf16_t)f2bf((red[tid] + red[tid + 64] + red[tid + 128] + red[tid + 192]) * (1.f / 256.f));
        __syncthreads();
    }
}

__device__ __forceinline__ void rwkv_naive(const P& p, int h, char* smem) {
    const int tid = otid(), lane = tid & 63, q4 = tid >> 6;
    float* dU = (float*)smem;
    float* iU = dU + 4096;
    float* L = iU + 4096;
    float* RKV = L + 256;
    float* PART = RKV + 192;
    float* VR = PART + 768;
    const bf16_t* ur = (const bf16_t*)(p.ws + OFF_UR);
    bf16_t* oa = (bf16_t*)(p.ws + OFF_OA);
    for (int i = tid; i < 4096; i += 256) { const int r = i >> 6, c = i & 63; dU[i] = p.decay_up[r * 512 + h * 64 + c]; iU[i] = p.iclr_up[r * 512 + h * 64 + c]; }
    const int hj = h * 64 + lane;
    const float w0 = p.decay_w0[hj], a0 = p.iclr_a0[hj], kk_w = p.k_k[hj], ka_w = p.k_a[hj], rk_w = p.r_k[hj], lnw = p.ln_x_w[hj], lnb = p.ln_x_b[hj];
    float S[16];
#pragma unroll
    for (int i = 0; i < 16; ++i) S[i] = 0.f;
    const int vi = tid >> 2, kq = tid & 3;
    __syncthreads();
    for (int t = 0; t < T; ++t) {
        {
            const int col = 1536 + tid;
            const float cur = bf2f(ur[(size_t)t * RCOLS + col]);
            const float prv = t ? bf2f(ur[(size_t)(t - 1) * RCOLS + col]) : 0.f;
            const float xs = cur + p.tshift_mu[col] * (prv - cur);
            L[tid] = tid < 64 ? tanhf(xs) : (tid < 128 ? xs : sigm(xs));
            if (tid < 192) {
                const int c2 = q4 * 512 + h * 64 + lane;
                const float cu = bf2f(ur[(size_t)t * RCOLS + c2]);
                const float pv = t ? bf2f(ur[(size_t)(t - 1) * RCOLS + c2]) : 0.f;
                RKV[tid] = cu + p.tshift_mu[c2] * (pv - cu);
            }
        }
        __syncthreads();
        {
            float pd = 0.f, pa = 0.f, pg = 0.f;
#pragma unroll
            for (int i = 0; i < 16; ++i) { pd += L[q4 * 16 + i] * dU[(q4 * 16 + i) * 64 + lane]; pa += L[64 + q4 * 16 + i] * iU[(q4 * 16 + i) * 64 + lane]; }
#pragma unroll 8
            for (int i = 0; i < 32; ++i) pg += L[128 + q4 * 32 + i] * p.gate_up[(q4 * 32 + i) * 512 + hj];
            PART[q4 * 64 + lane] = pd; PART[256 + q4 * 64 + lane] = pa; PART[512 + q4 * 64 + lane] = pg;
        }
        __syncthreads();
        if (tid < 64) {
            const float wv = w0 + PART[lane] + PART[64 + lane] + PART[128 + lane] + PART[192 + lane];
            const float av = sigm(a0 + PART[256 + lane] + PART[320 + lane] + PART[384 + lane] + PART[448 + lane]);
            const float gv = PART[512 + lane] + PART[576 + lane] + PART[640 + lane] + PART[704 + lane];
            const float wlog = -log1pf(__expf(-wv)) - 0.5f;
            const float dec = __expf(-__expf(wlog));
            const float r = RKV[lane], k = RKV[64 + lane], v = RKV[128 + lane];
            float kk = k * kk_w;
            const float ss = wave_sum(kk * kk);
            kk *= rsqrtf(ss + 1e-12f);
            const float k2 = k * (1.f + (av - 1.f) * ka_w);
            const float rk = wave_sum(r * k2 * rk_w);
            VR[lane] = r; VR[64 + lane] = dec; VR[128 + lane] = k2; VR[192 + lane] = v; VR[256 + lane] = -kk; VR[320 + lane] = kk * av;
            VR[384 + lane] = gv; VR[448 + lane] = rk * v;
        }
        __syncthreads();
        {
            float sa = 0.f;
#pragma unroll
            for (int i = 0; i < 16; ++i) sa += S[i] * VR[256 + kq * 16 + i];
            sa += __shfl_xor(sa, 1); sa += __shfl_xor(sa, 2);
            const float vv = VR[192 + vi];
            float y = 0.f;
#pragma unroll
            for (int i = 0; i < 16; ++i) { const int k = kq * 16 + i; S[i] = S[i] * VR[64 + k] + sa * VR[320 + k] + vv * VR[128 + k]; y += S[i] * VR[k]; }
            y += __shfl_xor(y, 1); y += __shfl_xor(y, 2);
            if (kq == 0) VR[512 + vi] = y;
        }
        __syncthreads();
        if (tid < 64) {
            const float y = VR[512 + lane];
            const float mean = wave_sum(y) * (1.f / 64.f);
            const float d = y - mean;
            const float var = wave_sum(d * d) * (1.f / 64.f);
            const float yn = d * rsqrtf(var + 64e-5f) * lnw + lnb;
            oa[(size_t)t * 512 + hj] = (bf16_t)f2bf((yn + VR[448 + lane]) * VR[384 + lane]);
        }
    }
}

typedef __bf16 bf16x2_t __attribute__((ext_vector_type(2)));
__device__ __forceinline__ unsigned cvt_pk(float lo, float hi) { typedef float f2_t __attribute__((ext_vector_type(2))); const f2_t v = {lo, hi}; return __builtin_bit_cast(unsigned, __builtin_convertvector(v, bf16x2_t)); }
__device__ __forceinline__ u32x2 pack4(f32x4 v) { u32x2 o; o.x = cvt_pk(v.x, v.y); o.y = cvt_pk(v.z, v.w); return o; }
__device__ __forceinline__ bf16x8 pack8(f32x4 a, f32x4 b) { u32x4 o; o.x = cvt_pk(a.x, a.y); o.y = cvt_pk(a.z, a.w); o.z = cvt_pk(b.x, b.y); o.w = cvt_pk(b.z, b.w); return __builtin_bit_cast(bf16x8, o); }
__device__ __forceinline__ bf16x8 ldperm(const char* rowbase, int ks, int fq) {
    const u32x2 a = *(const u32x2*)(rowbase + (32 * ks + fq * 4) * 2), b = *(const u32x2*)(rowbase + (32 * ks + 16 + fq * 4) * 2);
    u32x4 o; o.x = a.x; o.y = a.y; o.z = b.x; o.w = b.y; return __builtin_bit_cast(bf16x8, o);
}
#define MFMA16(a, b, c) __builtin_amdgcn_mfma_f32_16x16x32_bf16((a), (b), (c), 0, 0, 0)
constexpr int SLOT = 9216, ROWB = 144, LIN_ROWB = 528;
constexpr int L_WL = 0 * SLOT, L_AL = 1 * SLOT, L_LIN = 2 * SLOT, L_AT = 2 * SLOT, L_BT = 3 * SLOT, L_KT = 4 * SLOT, L_RT = 5 * SLOT, L_VT = 6 * SLOT, L_ATT = 7 * SLOT;
constexpr int L_AAB = L_AT, L_AKV = L_BT, L_BBT = L_WL, L_KBT = L_AL;
constexpr int L_WTOT = 8 * SLOT, L_WC = L_WTOT + 1024, RW_LDS = L_WC + 256;

typedef float f32x2 __attribute__((ext_vector_type(2)));
template <int TT> struct SolveRow {
    static __device__ __forceinline__ void run(f32x2 (&x)[32], const char* Lb) {
        f32x2 a0 = {0.f, 0.f}, a1 = {0.f, 0.f};
#pragma unroll
        for (int c8 = 0; c8 <= (TT - 1) / 8; ++c8) {
            const u32x4 lv = *(const u32x4*)(Lb + TT * 144 + c8 * 16);
            f32x2 l0, l1, l2, l3;
            l0.x = __uint_as_float(lv.x << 16); l0.y = __uint_as_float(lv.x & 0xffff0000u);
            l1.x = __uint_as_float(lv.y << 16); l1.y = __uint_as_float(lv.y & 0xffff0000u);
            l2.x = __uint_as_float(lv.z << 16); l2.y = __uint_as_float(lv.z & 0xffff0000u);
            l3.x = __uint_as_float(lv.w << 16); l3.y = __uint_as_float(lv.w & 0xffff0000u);
            a0 = l0 * x[c8 * 4 + 0] + a0; a1 = l1 * x[c8 * 4 + 1] + a1; a0 = l2 * x[c8 * 4 + 2] + a0; a1 = l3 * x[c8 * 4 + 3] + a1;
        }
        a0 = a0 + a1;
        const float r = a0.x + a0.y;
        if (TT & 1) x[TT / 2].y += r; else x[TT / 2].x += r;
        asm volatile("" : "+v"(x[TT / 2]) :: "memory");
        SolveRow<TT + 1>::run(x, Lb);
    }
};
template <> struct SolveRow<64> { static __device__ __forceinline__ void run(f32x2 (&)[32], const char*) {} };

__device__ __forceinline__ void load_shift16(const bf16_t* ur, int row, int col, const float* mu, float* out) {
    const u32x4* cp = (const u32x4*)(ur + (size_t)row * RCOLS + col);
    const u32x4 c0 = cp[0], c1 = cp[1];
    u32x4 p0 = {0u, 0u, 0u, 0u}, p1 = {0u, 0u, 0u, 0u};
    if (row > 0) { const u32x4* pp = (const u32x4*)(ur + (size_t)(row - 1) * RCOLS + col); p0 = pp[0]; p1 = pp[1]; }
    float cf[16], pf[16];
    unpack8(c0, cf); unpack8(c1, cf + 8); unpack8(p0, pf); unpack8(p1, pf + 8);
#pragma unroll
    for (int e = 0; e < 16; ++e) out[e] = cf[e] + mu[col + e] * (pf[e] - cf[e]);
}

__device__ __forceinline__ void phase_rw_chunk(const P& p, int bid, int nb, char* smem) {
    char* ws = p.ws;
    const bf16_t* ur = (const bf16_t*)(ws + OFF_UR);
    bf16_t* G = (bf16_t*)(ws + OFF_OA); bf16_t* BON = (bf16_t*)(ws + OFF_BON); bf16_t* RH = (bf16_t*)(ws + OFF_RH);
    float* YL = p.out; f32x4* NF = (f32x4*)(p.out + (size_t)T * 512);
    u32x4* MF = (u32x4*)(ws + OFF_MF);
    float* wtot = (float*)(smem + L_WTOT); float* WCs = (float*)(smem + L_WC);
    for (int it = bid; it < 2048; it += nb) {
        const int c = it >> 3, h = it & 7;
        const int tid = otid();
        const int lane = tid & 63, w = __builtin_amdgcn_readfirstlane(tid >> 6), fr = lane & 15, fq = lane >> 4;
#pragma unroll 1
        for (int hf = 0; hf < 2; ++hf) {
            u32x4 cur[4], prv[4];
#pragma unroll
            for (int i = 0; i < 4; ++i) {
                const int q = tid + (hf * 4 + i) * 256, t = q >> 5, cc = q & 31, row = c * 64 + t, col = 1536 + cc * 8;
                cur[i] = *(const u32x4*)(ur + (size_t)row * RCOLS + col);
                prv[i] = (u32x4){0u, 0u, 0u, 0u};
                if (row > 0) prv[i] = *(const u32x4*)(ur + (size_t)(row - 1) * RCOLS + col);
            }
#pragma unroll
            for (int i = 0; i < 4; ++i) {
                const int q = tid + (hf * 4 + i) * 256, t = q >> 5, cc = q & 31, col = 1536 + cc * 8;
                float cf[8], pf[8], xs[8];
                unpack8(cur[i], cf); unpack8(prv[i], pf);
#pragma unroll
                for (int e = 0; e < 8; ++e) {
                    const float x = cf[e] + p.tshift_mu[col + e] * (pf[e] - cf[e]);
                    xs[e] = (cc < 8) ? (1.f - 2.f / (1.f + __expf(2.f * x))) : ((cc < 16) ? x : sigm(x));
                }
                u32x4 o; o.x = cvt_pk(xs[0], xs[1]); o.y = cvt_pk(xs[2], xs[3]); o.z = cvt_pk(xs[4], xs[5]); o.w = cvt_pk(xs[6], xs[7]);
                *(u32x4*)(smem + L_LIN + t * LIN_ROWB + cc * 16) = o;
                asm volatile("" ::: "memory");
            }
        }
        __syncthreads();
        {
            const char* lrow = smem + L_LIN + (w * 16 + fr) * LIN_ROWB;
            const bf16_t* dT = (const bf16_t*)(ws + OFF_LORA_D) + (size_t)(h * 64) * 64;
            const bf16_t* iT = (const bf16_t*)(ws + OFF_LORA_I) + (size_t)(h * 64) * 64;
            const bf16_t* gT = (const bf16_t*)(ws + OFF_LORA_G) + (size_t)(h * 64) * 128;
            bf16x8 lb[8];
#pragma unroll
            for (int ks = 0; ks < 8; ++ks) lb[ks] = *(const bf16x8*)(lrow + (ks * 32 + fq * 8) * 2);
#pragma unroll
            for (int jt = 0; jt < 4; ++jt) {
                f32x4 aw = {0.f, 0.f, 0.f, 0.f}, aa = aw, ag = aw;
#pragma unroll
                for (int ks = 0; ks < 2; ++ks) {
                    aw = MFMA16(*(const bf16x8*)(dT + (jt * 16 + fr) * 64 + ks * 32 + fq * 8), lb[ks], aw);
                    aa = MFMA16(*(const bf16x8*)(iT + (jt * 16 + fr) * 64 + ks * 32 + fq * 8), lb[2 + ks], aa);
                }
#pragma unroll
                for (int ks = 0; ks < 4; ++ks) ag = MFMA16(*(const bf16x8*)(gT + (jt * 16 + fr) * 128 + ks * 32 + fq * 8), lb[4 + ks], ag);
                *(u32x2*)(smem + L_WL + (w * 16 + fr) * ROWB + (jt * 16 + fq * 4) * 2) = pack4(aw);
                *(u32x2*)(smem + L_AL + (w * 16 + fr) * ROWB + (jt * 16 + fq * 4) * 2) = pack4(aa);
                *(u32x2*)(G + (size_t)(c * 64 + w * 16 + fr) * 512 + h * 64 + jt * 16 + fq * 4) = pack4(ag);
            }
        }
        __syncthreads();
        {
            const int t = tid >> 2, jq = tid & 3, j0 = jq * 16, hj0 = h * 64 + j0, row = c * 64 + t;
            float ai[16], kk[16], k2[16], rr[16];
            {
                float al[16];
                const u32x4* ap = (const u32x4*)(smem + L_AL + t * ROWB + j0 * 2);
                unpack8(ap[0], al); unpack8(ap[1], al + 8);
#pragma unroll
                for (int e = 0; e < 16; ++e) ai[e] = sigm(p.iclr_a0[hj0 + e] + al[e]);
            }
            float ss = 0.f, rk = 0.f;
            {
                float k[16];
                load_shift16(ur, row, 512 + hj0, p.tshift_mu, k);
#pragma unroll
                for (int e = 0; e < 16; ++e) { kk[e] = k[e] * p.k_k[hj0 + e]; ss += kk[e] * kk[e]; k2[e] = k[e] * (1.f + (ai[e] - 1.f) * p.k_a[hj0 + e]); }
            }
            ss += __shfl_xor(ss, 1); ss += __shfl_xor(ss, 2);
            const float inv = rsqrtf(ss + 1e-12f);
            asm volatile("" ::: "memory");
            load_shift16(ur, row, hj0, p.tshift_mu, rr);
#pragma unroll
            for (int e = 0; e < 16; ++e) rk += rr[e] * k2[e] * p.r_k[hj0 + e];
            rk += __shfl_xor(rk, 1); rk += __shfl_xor(rk, 2);
            asm volatile("" ::: "memory");
            {
                float v[16];
                load_shift16(ur, row, 1024 + hj0, p.tshift_mu, v);
#pragma unroll
                for (int e = 0; e < 16; ++e) *(bf16_t*)(smem + L_VT + (j0 + e) * ROWB + t * 2) = (bf16_t)f2bf(v[e]);
#pragma unroll
                for (int hh = 0; hh < 2; ++hh) {
                    u32x4 o; o.x = cvt_pk(rk * v[hh * 8], rk * v[hh * 8 + 1]); o.y = cvt_pk(rk * v[hh * 8 + 2], rk * v[hh * 8 + 3]); o.z = cvt_pk(rk * v[hh * 8 + 4], rk * v[hh * 8 + 5]); o.w = cvt_pk(rk * v[hh * 8 + 6], rk * v[hh * 8 + 7]);
                    *(u32x4*)(BON + (size_t)row * 512 + hj0 + hh * 8) = o;
                }
            }
            asm volatile("" ::: "memory");
            float lw[16], cum[16];
            {
                float wl[16];
                const u32x4* wp = (const u32x4*)(smem + L_WL + t * ROWB + j0 * 2);
                unpack8(wp[0], wl); unpack8(wp[1], wl + 8);
#pragma unroll
                for (int e = 0; e < 16; ++e) { const float wv = p.decay_w0[hj0 + e] + wl[e]; lw[e] = -__expf(-log1pf(__expf(-wv)) - 0.5f); }
            }
#pragma unroll
            for (int e = 0; e < 16; ++e) {
                float x = lw[e];
#pragma unroll
                for (int d = 4; d < 64; d <<= 1) { const float y = __shfl_up(x, d); if (lane >= d) x += y; }
                cum[e] = x;
            }
            if ((lane >> 2) == 15) {
#pragma unroll
                for (int e = 0; e < 16; ++e) wtot[w * 64 + j0 + e] = cum[e];
            }
            __syncthreads();
#pragma unroll
            for (int hh = 0; hh < 2; ++hh) {
                float at[8], bt[8], kt[8], rt[8];
#pragma unroll
                for (int e8 = 0; e8 < 8; ++e8) {
                    const int e = hh * 8 + e8;
                    const float t0 = wtot[j0 + e], t1 = wtot[64 + j0 + e], t2 = wtot[128 + j0 + e], t3 = wtot[192 + j0 + e];
                    const float cm = cum[e] + ((w > 0 ? t0 : 0.f) + (w > 1 ? t1 : 0.f) + (w > 2 ? t2 : 0.f));
                    const float tt = (t0 + t1) + (t2 + t3);
                    if (t == 63) WCs[j0 + e] = __expf(tt);
                    const float kn = kk[e] * inv;
                    const float E = __expf(cm), Ei = 1.f / E, Ex = __expf(cm - lw[e]), Ec = __expf(tt - cm);
                    const float b = kn * ai[e];
                    at[e8] = -kn * Ex; bt[e8] = b * Ei; kt[e8] = k2[e] * Ei; rt[e8] = rr[e] * E;
                    *(bf16_t*)(smem + L_BBT + (j0 + e) * ROWB + t * 2) = (bf16_t)f2bf(b * Ec);
                    *(bf16_t*)(smem + L_KBT + (j0 + e) * ROWB + t * 2) = (bf16_t)f2bf(k2[e] * Ec);
                    *(bf16_t*)(smem + L_ATT + (j0 + e) * ROWB + t * 2) = (bf16_t)f2bf(at[e8]);
                }
                u32x4 o;
                o.x = cvt_pk(at[0], at[1]); o.y = cvt_pk(at[2], at[3]); o.z = cvt_pk(at[4], at[5]); o.w = cvt_pk(at[6], at[7]);
                *(u32x4*)(smem + L_AT + t * ROWB + (j0 + hh * 8) * 2) = o;
                o.x = cvt_pk(bt[0], bt[1]); o.y = cvt_pk(bt[2], bt[3]); o.z = cvt_pk(bt[4], bt[5]); o.w = cvt_pk(bt[6], bt[7]);
                *(u32x4*)(smem + L_BT + t * ROWB + (j0 + hh * 8) * 2) = o;
                o.x = cvt_pk(kt[0], kt[1]); o.y = cvt_pk(kt[2], kt[3]); o.z = cvt_pk(kt[4], kt[5]); o.w = cvt_pk(kt[6], kt[7]);
                *(u32x4*)(smem + L_KT + t * ROWB + (j0 + hh * 8) * 2) = o;
                o.x = cvt_pk(rt[0], rt[1]); o.y = cvt_pk(rt[2], rt[3]); o.z = cvt_pk(rt[4], rt[5]); o.w = cvt_pk(rt[6], rt[7]);
                *(u32x4*)(smem + L_RT + t * ROWB + (j0 + hh * 8) * 2) = o;
            }
        }
        __syncthreads();
        bf16x8 frb[2], frk[2];
        {
            const int tid2 = otid(), lane = tid2 & 63, fr = lane & 15, fq = lane >> 4;
            bf16x8 xa[2], xr[2];
#pragma unroll
            for (int ks = 0; ks < 2; ++ks) {
                xa[ks] = *(const bf16x8*)(smem + L_AT + (w * 16 + fr) * ROWB + (ks * 32 + fq * 8) * 2);
                xr[ks] = *(const bf16x8*)(smem + L_RT + (w * 16 + fr) * ROWB + (ks * 32 + fq * 8) * 2);
            }
            f32x4 aab[4], aak[4], arb[4], ark[4];
            const int tq = w * 16 + fr;
#pragma unroll
            for (int n = 0; n < 4; ++n) {
                f32x4 dab = {0.f, 0.f, 0.f, 0.f}, dak = dab, drb = dab, drk = dab;
                if (n <= w) {
#pragma unroll
                    for (int ks = 0; ks < 2; ++ks) {
                        const bf16x8 yb = *(const bf16x8*)(smem + L_BT + (n * 16 + fr) * ROWB + (ks * 32 + fq * 8) * 2);
                        const bf16x8 yk = *(const bf16x8*)(smem + L_KT + (n * 16 + fr) * ROWB + (ks * 32 + fq * 8) * 2);
                        dab = MFMA16(yb, xa[ks], dab); dak = MFMA16(yk, xa[ks], dak); drb = MFMA16(yb, xr[ks], drb); drk = MFMA16(yk, xr[ks], drk);
                    }
#pragma unroll
                    for (int jj = 0; jj < 4; ++jj) {
                        const int sq = n * 16 + fq * 4 + jj;
                        if (!(sq < tq)) { dab[jj] = 0.f; dak[jj] = 0.f; }
                        if (!(sq <= tq)) { drb[jj] = 0.f; drk[jj] = 0.f; }
                    }
                }
                aab[n] = dab; aak[n] = dak; arb[n] = drb; ark[n] = drk;
            }
            __syncthreads();
#pragma unroll
            for (int n = 0; n < 4; ++n) *(u32x2*)(smem + L_AAB + (w * 16 + fr) * ROWB + (n * 16 + fq * 4) * 2) = pack4(aab[n]);
            bf16x8 fak[2];
#pragma unroll
            for (int ks = 0; ks < 2; ++ks) { fak[ks] = pack8(aak[2 * ks], aak[2 * ks + 1]); frb[ks] = pack8(arb[2 * ks], arb[2 * ks + 1]); frk[ks] = pack8(ark[2 * ks], ark[2 * ks + 1]); }
#pragma unroll
            for (int vt = 0; vt < 4; ++vt) {
                f32x4 acc = {0.f, 0.f, 0.f, 0.f};
#pragma unroll
                for (int ks = 0; ks < 2; ++ks) acc = MFMA16(fak[ks], ldperm(smem + L_VT + (vt * 16 + fr) * ROWB, ks, fq), acc);
                *(u32x2*)(smem + L_AKV + (vt * 16 + fr) * ROWB + (w * 16 + fq * 4) * 2) = pack4(acc);
            }
        }
        __syncthreads();
        if (w < 2) {
            char* rowp = smem + (w == 0 ? L_ATT : L_AKV) + (otid() & 63) * ROWB;
            f32x2 x[32];
#pragma unroll
            for (int c8 = 0; c8 < 8; ++c8) {
                const u32x4 xv = *(const u32x4*)(rowp + c8 * 16);
                x[c8 * 4 + 0].x = __uint_as_float(xv.x << 16); x[c8 * 4 + 0].y = __uint_as_float(xv.x & 0xffff0000u);
                x[c8 * 4 + 1].x = __uint_as_float(xv.y << 16); x[c8 * 4 + 1].y = __uint_as_float(xv.y & 0xffff0000u);
                x[c8 * 4 + 2].x = __uint_as_float(xv.z << 16); x[c8 * 4 + 2].y = __uint_as_float(xv.z & 0xffff0000u);
                x[c8 * 4 + 3].x = __uint_as_float(xv.w << 16); x[c8 * 4 + 3].y = __uint_as_float(xv.w & 0xffff0000u);
            }
            SolveRow<1>::run(x, smem + L_AAB);
#pragma unroll
            for (int c8 = 0; c8 < 8; ++c8) {
                u32x4 o; o.x = cvt_pk(x[c8 * 4].x, x[c8 * 4].y); o.y = cvt_pk(x[c8 * 4 + 1].x, x[c8 * 4 + 1].y); o.z = cvt_pk(x[c8 * 4 + 2].x, x[c8 * 4 + 2].y); o.w = cvt_pk(x[c8 * 4 + 3].x, x[c8 * 4 + 3].y);
                *(u32x4*)(rowp + c8 * 16) = o;
            }
        }
        __syncthreads();
        {
            const int tid4 = otid(), lane = tid4 & 63, fr = lane & 15, fq = lane >> 4;
            const int trow = c * 64 + w * 16 + fr;
#pragma unroll
            for (int kt = 0; kt < 4; ++kt) {
                f32x4 acc = {0.f, 0.f, 0.f, 0.f};
#pragma unroll
                for (int ks = 0; ks < 2; ++ks) acc = MFMA16(ldperm(smem + L_ATT + (kt * 16 + fr) * ROWB, ks, fq), frb[ks], acc);
                const u32x2 rr = *(const u32x2*)(smem + L_RT + (w * 16 + fr) * ROWB + (kt * 16 + fq * 4) * 2);
                acc.x += __uint_as_float(rr.x << 16); acc.y += __uint_as_float(rr.x & 0xffff0000u); acc.z += __uint_as_float(rr.y << 16); acc.w += __uint_as_float(rr.y & 0xffff0000u);
                *(u32x2*)(RH + (size_t)trow * 512 + h * 64 + kt * 16 + fq * 4) = pack4(acc);
            }
#pragma unroll
            for (int vt = 0; vt < 4; ++vt) {
                f32x4 acc = {0.f, 0.f, 0.f, 0.f};
#pragma unroll
                for (int ks = 0; ks < 2; ++ks) {
                    acc = MFMA16(ldperm(smem + L_AKV + (vt * 16 + fr) * ROWB, ks, fq), frb[ks], acc);
                    acc = MFMA16(ldperm(smem + L_VT + (vt * 16 + fr) * ROWB, ks, fq), frk[ks], acc);
                }
                *(f32x4*)(YL + (size_t)trow * 512 + h * 64 + vt * 16 + fq * 4) = acc;
            }
            bf16x8 xb[2], xk[2];
#pragma unroll
            for (int ks = 0; ks < 2; ++ks) {
                xb[ks] = *(const bf16x8*)(smem + L_BBT + (w * 16 + fr) * ROWB + (ks * 32 + fq * 8) * 2);
                xk[ks] = *(const bf16x8*)(smem + L_KBT + (w * 16 + fr) * ROWB + (ks * 32 + fq * 8) * 2);
            }
            f32x4 mt[4];
            const float wc = WCs[w * 16 + fr];
#pragma unroll
            for (int n = 0; n < 4; ++n) {
                f32x4 acc = {0.f, 0.f, 0.f, 0.f};
#pragma unroll
                for (int ks = 0; ks < 2; ++ks) acc = MFMA16(*(const bf16x8*)(smem + L_ATT + (n * 16 + fr) * ROWB + (ks * 32 + fq * 8) * 2), xb[ks], acc);
#pragma unroll
                for (int jj = 0; jj < 4; ++jj) if (n * 16 + fq * 4 + jj == w * 16 + fr) acc[jj] += wc;
                mt[n] = acc;
            }
#pragma unroll
            for (int ks = 0; ks < 2; ++ks) MF[((size_t)((c * 8 + h) * 4 + w) * 2 + ks) * 64 + lane] = __builtin_bit_cast(u32x4, pack8(mt[2 * ks], mt[2 * ks + 1]));
#pragma unroll
            for (int vs = 0; vs < 4; ++vs) {
                f32x4 acc = {0.f, 0.f, 0.f, 0.f};
#pragma unroll
                for (int ks = 0; ks < 2; ++ks) {
                    acc = MFMA16(xb[ks], *(const bf16x8*)(smem + L_AKV + (vs * 16 + fr) * ROWB + (ks * 32 + fq * 8) * 2), acc);
                    acc = MFMA16(xk[ks], *(const bf16x8*)(smem + L_VT + (vs * 16 + fr) * ROWB + (ks * 32 + fq * 8) * 2), acc);
                }
                NF[((size_t)((c * 8 + h) * 4 + w) * 4 + vs) * 64 + lane] = acc;
            }
        }
        __syncthreads();
    }
}

__device__ __forceinline__ void rw_scan(const P& p, int h) {
    const int lane = otid() & 63, vs = otid() >> 6;
    const u32x4* MF = (const u32x4*)(p.ws + OFF_MF); const f32x4* NF = (const f32x4*)(p.out + (size_t)T * 512);
    u32x4* SF = (u32x4*)(p.ws + OFF_SF);
    u32x4 st0 = {0u, 0u, 0u, 0u}, st1 = st0;
    u32x4 m[8]; f32x4 n[4];
#pragma unroll
    for (int i = 0; i < 8; ++i) m[i] = MF[((size_t)(h * 4 + (i >> 1)) * 2 + (i & 1)) * 64 + lane];
#pragma unroll
    for (int i = 0; i < 4; ++i) n[i] = NF[((size_t)(h * 4 + i) * 4 + vs) * 64 + lane];
    for (int c = 0; c < 256; ++c) {
        SF[((size_t)((c * 8 + h) * 4 + vs) * 2 + 0) * 64 + lane] = st0;
        SF[((size_t)((c * 8 + h) * 4 + vs) * 2 + 1) * 64 + lane] = st1;
        if (c == 255) break;
        u32x4 m2[8]; f32x4 n2[4];
        const int cn = (c + 1 < 255) ? c + 1 : c;
#pragma unroll
        for (int i = 0; i < 8; ++i) m2[i] = MF[((size_t)((cn * 8 + h) * 4 + (i >> 1)) * 2 + (i & 1)) * 64 + lane];
#pragma unroll
        for (int i = 0; i < 4; ++i) n2[i] = NF[((size_t)((cn * 8 + h) * 4 + i) * 4 + vs) * 64 + lane];
        f32x4 acc[4];
#pragma unroll
        for (int i = 0; i < 4; ++i) {
            acc[i] = MFMA16(__builtin_bit_cast(bf16x8, m[2 * i]), __builtin_bit_cast(bf16x8, st0), n[i]);
            acc[i] = MFMA16(__builtin_bit_cast(bf16x8, m[2 * i + 1]), __builtin_bit_cast(bf16x8, st1), acc[i]);
        }
        st0 = __builtin_bit_cast(u32x4, pack8(acc[0], acc[1])); st1 = __builtin_bit_cast(u32x4, pack8(acc[2], acc[3]));
#pragma unroll
        for (int i = 0; i < 8; ++i) m[i] = m2[i];
#pragma unroll
        for (int i = 0; i < 4; ++i) n[i] = n2[i];
    }
}

__device__ __forceinline__ void phase_rw_out(const P& p, int bid, int nb) {
    const int tid = otid(), lane = tid & 63, w = tid >> 6, fr = lane & 15, fq = lane >> 4;
    char* ws = p.ws;
    bf16_t* OA = (bf16_t*)(ws + OFF_OA); const bf16_t* BON = (const bf16_t*)(ws + OFF_BON); const bf16_t* RH = (const bf16_t*)(ws + OFF_RH);
    const float* YL = p.out; const u32x4* SF = (const u32x4*)(ws + OFF_SF);
    for (int it = bid; it < 2048; it += nb) {
        const int c = it >> 3, h = it & 7, trow = c * 64 + w * 16 + fr;
        const char* rrow = (const char*)(RH + (size_t)trow * 512 + h * 64);
        bf16x8 rf[2]; rf[0] = ldperm(rrow, 0, fq); rf[1] = ldperm(rrow, 1, fq);
        f32x4 acc[4];
#pragma unroll
        for (int vs = 0; vs < 4; ++vs) {
            acc[vs] = *(const f32x4*)(YL + (size_t)trow * 512 + h * 64 + vs * 16 + fq * 4);
#pragma unroll
            for (int ks = 0; ks < 2; ++ks) acc[vs] = MFMA16(__builtin_bit_cast(bf16x8, SF[((size_t)((c * 8 + h) * 4 + vs) * 2 + ks) * 64 + lane]), rf[ks], acc[vs]);
        }
        float s = 0.f;
#pragma unroll
        for (int vs = 0; vs < 4; ++vs) s += (acc[vs].x + acc[vs].y) + (acc[vs].z + acc[vs].w);
        s += __shfl_xor(s, 16); s += __shfl_xor(s, 32);
        const float mean = s * (1.f / 64.f);
        float q = 0.f;
#pragma unroll
        for (int vs = 0; vs < 4; ++vs) { acc[vs] = acc[vs] - mean; q += (acc[vs].x * acc[vs].x + acc[vs].y * acc[vs].y) + (acc[vs].z * acc[vs].z + acc[vs].w * acc[vs].w); }
        q += __shfl_xor(q, 16); q += __shfl_xor(q, 32);
        const float rstd = rsqrtf(q * (1.f / 64.f) + 64e-5f);
#pragma unroll
        for (int vs = 0; vs < 4; ++vs) {
            const int hv = h * 64 + vs * 16 + fq * 4;
            const f32x4 lw = *(const f32x4*)(p.ln_x_w + hv), lb = *(const f32x4*)(p.ln_x_b + hv);
            const u32x2 bo = *(const u32x2*)(BON + (size_t)trow * 512 + hv), gg = *(const u32x2*)(OA + (size_t)trow * 512 + hv);
            f32x4 o = acc[vs] * rstd * lw + lb;
            o.x = (o.x + __uint_as_float(bo.x << 16)) * __uint_as_float(gg.x << 16);
            o.y = (o.y + __uint_as_float(bo.x & 0xffff0000u)) * __uint_as_float(gg.x & 0xffff0000u);
            o.z = (o.z + __uint_as_float(bo.y << 16)) * __uint_as_float(gg.y << 16);
            o.w = (o.w + __uint_as_float(bo.y & 0xffff0000u)) * __uint_as_float(gg.y & 0xffff0000u);
            *(u32x2*)(OA + (size_t)trow * 512 + hv) = pack4(o);
        }
    }
}

constexpr int A_LK = 0, A_LV = 36864, A_BIAS = 70656, A_TST = 70784;
constexpr int MAXTILES = 6656;

__device__ __forceinline__ void moba_select(const P& p, int bid0, int nb0, char* smem) {
    const int tid = otid(), lane = tid & 63, w = tid >> 6, fr = lane & 15, fq = lane >> 4;
    char* ws = p.ws;
    const bf16_t* um = (const bf16_t*)(ws + OFF_UM); const bf16_t* kmb = (const bf16_t*)(ws + OFF_CTL + CTL_KMB);
    unsigned* SEL = (unsigned*)(ws + OFF_MSEL);
    int* hist = (int*)smem;
    for (int i = tid; i < 512; i += 256) hist[i] = 0;
    __syncthreads();
    for (int it = bid0; it < 2048; it += nb0) {
        const int tile = it >> 3, h = it & 7, qb = tile >> 2, t = tile * 64 + w * 16 + fr;
        bf16x8 qf[2];
#pragma unroll
        for (int ks = 0; ks < 2; ++ks) qf[ks] = *(const bf16x8*)(um + (size_t)t * UMC + h * 64 + ks * 32 + fq * 8);
        float sc[4][4];
#pragma unroll
        for (int nt = 0; nt < 4; ++nt) {
            f32x4 acc = {0.f, 0.f, 0.f, 0.f};
            if (nt * 16 < qb) {
#pragma unroll
                for (int ks = 0; ks < 2; ++ks) acc = MFMA16(*(const bf16x8*)(kmb + (size_t)((nt * 16 + fr) * 8 + h) * 64 + ks * 32 + fq * 8), qf[ks], acc);
            }
#pragma unroll
            for (int j = 0; j < 4; ++j) sc[nt][j] = (nt * 16 + fq * 4 + j < qb) ? acc[j] : -3.0e38f;
        }
        unsigned selw = 0u;
#pragma unroll
        for (int s = 0; s < 3; ++s) {
            float bv = -3.0e38f; int bi = 255;
#pragma unroll
            for (int nt = 0; nt < 4; ++nt)
#pragma unroll
                for (int j = 0; j < 4; ++j) if (sc[nt][j] > bv) { bv = sc[nt][j]; bi = nt * 16 + fq * 4 + j; }
#pragma unroll
            for (int o = 16; o <= 32; o <<= 1) {
                const float v2 = __shfl_xor(bv, o); const int i2 = __shfl_xor(bi, o);
                if (v2 > bv || (v2 == bv && i2 < bi)) { bv = v2; bi = i2; }
            }
            if (!(bv > -1.0e38f)) bi = 255;
            selw |= (unsigned)bi << (8 * s);
#pragma unroll
            for (int nt = 0; nt < 4; ++nt)
#pragma unroll
                for (int j = 0; j < 4; ++j) if (nt * 16 + fq * 4 + j == bi) sc[nt][j] = -3.0e38f;
            if (fq == 0 && bi != 255) atomicAdd(&hist[h * 64 + bi], 1);
        }
        if (fq == 0) SEL[t * 8 + h] = selw | 0xff000000u;
    }
    __syncthreads();
    int* gcnt = (int*)(ws + OFF_CTL + CTL_MCNT);
    for (int i = tid; i < 512; i += 256) if (hist[i]) atomicAdd(&gcnt[i], hist[i]);
}

__device__ __forceinline__ void moba_fill(const P& p, int bid, int nb, char* smem) {
    const int tid = otid();
    char* ws = p.ws;
    const int* gcnt = (const int*)(ws + OFF_CTL + CTL_MCNT); int* gcur = (int*)(ws + OFF_CTL + CTL_MCUR);
    int* lst = (int*)smem;
    int* tst = lst + 520;
    int* lh = tst + 520;
    int* lc = lh + 512;
    for (int i = tid; i < 512; i += 256) lc[i] = gcnt[i];
    __syncthreads();
    if (tid == 0) {
        int a = 0, b = 0;
        for (int i = 0; i < 512; ++i) { const int c = lc[i]; lst[i] = a; tst[i] = b; a += c; b += (c + 63) >> 6; }
        lst[512] = a; tst[512] = b;
    }
    __syncthreads();
    for (int i = tid; i < 512; i += 256) { lh[i] = 0; lc[i] = 0; }
    __syncthreads();
    if (bid == 0) {
        int* glst = (int*)(ws + OFF_CTL + CTL_MLST); int* gtst = (int*)(ws + OFF_CTL + CTL_MTST);
        for (int i = tid; i < 513; i += 256) { glst[i] = lst[i]; gtst[i] = tst[i]; }
    }
    const unsigned* SEL = (const unsigned*)(ws + OFF_MSEL);
    int* QL = (int*)(ws + OFF_MQL); int* SP = (int*)(ws + OFF_MSP);
    const int per = (T * 8 + nb - 1) / nb, i0 = bid * per, i1 = min(T * 8, i0 + per);
    for (int i = i0 + tid; i < i1; i += 256) {
        const unsigned sw = SEL[i]; const int h = i & 7;
#pragma unroll
        for (int s = 0; s < 3; ++s) { const int j = (sw >> (8 * s)) & 255; if (j != 255) atomicAdd(&lh[h * 64 + j], 1); }
    }
    __syncthreads();
    for (int i = tid; i < 512; i += 256) { const int c = lh[i]; lh[i] = c ? atomicAdd(&gcur[i], c) : 0; }
    __syncthreads();
    for (int i = i0 + tid; i < i1; i += 256) {
        const unsigned sw = SEL[i]; const int h = i & 7;
#pragma unroll
        for (int s = 0; s < 3; ++s) {
            const int j = (sw >> (8 * s)) & 255; int pos = -1;
            if (j != 255) { const int li = h * 64 + j; pos = lst[li] + lh[li] + atomicAdd(&lc[li], 1); QL[pos] = i >> 3; }
            SP[i * 3 + s] = pos;
        }
    }
}

__device__ __forceinline__ int t5b(int n) {
    const int v = (int)(__float_as_uint((float)(n * n)) >> 23) - 119;
    return n < 16 ? n : (v > 31 ? 31 : v);
}

__device__ __forceinline__ void attn_stage(const P& p, int j, int h, int nkeys, char* smem, int tid) {
    const bf16_t* um = (const bf16_t*)(p.ws + OFF_UM); const bf16_t* vt = (const bf16_t*)(p.ws + OFF_VT);
    for (int idx = tid; idx < nkeys * 8; idx += 256) {
        const int key = idx >> 3, ch = idx & 7;
        *(u32x4*)(smem + A_LK + key * 144 + ch * 16) = *(const u32x4*)(um + (size_t)(j * 256 + key) * UMC + 512 + h * 64 + ch * 8);
    }
    const int cpr = nkeys >> 3;
    for (int idx = tid; idx < 64 * cpr; idx += 256) {
        const int d = idx / cpr, ch = idx - d * cpr;
        *(u32x4*)(smem + A_LV + d * 528 + ch * 16) = *(const u32x4*)(vt + (size_t)(h * 64 + d) * T + j * 256 + ch * 8);
    }
    if (tid < 32) ((float*)(smem + A_BIAS))[tid] = p.rel_bias[tid * 8 + h];
}
template <bool CAUSAL>
__device__ __forceinline__ void attn_core(const char* smem, const bf16_t* qrow, int qt, int kbase, int nkeys, int fr, int fq, float& m_out, float& l_out, f32x4 (&o)[4]) {
    bf16x8 qf[2];
#pragma unroll
    for (int ks = 0; ks < 2; ++ks) qf[ks] = *(const bf16x8*)(qrow + ks * 32 + fq * 8);
    const float* lb = (const float*)(smem + A_BIAS);
    const int nkt = nkeys >> 4;
    f32x4 sc[16];
    float mx = -3.0e38f;
#pragma unroll
    for (int kt = 0; kt < 16; ++kt) {
        f32x4 acc = {0.f, 0.f, 0.f, 0.f};
        if (kt < nkt) {
#pragma unroll
            for (int ks = 0; ks < 2; ++ks) acc = MFMA16(*(const bf16x8*)(smem + A_LK + (kt * 16 + fr) * 144 + (ks * 32 + fq * 8) * 2), qf[ks], acc);
#pragma unroll
            for (int jj = 0; jj < 4; ++jj) {
                const int rel = qt - (kbase + kt * 16 + fq * 4 + jj);
                float l = acc[jj] * 0.125f + lb[t5b(rel < 0 ? 0 : rel)];
                if (CAUSAL && rel < 0) l = -3.0e38f;
                acc[jj] = l; mx = fmaxf(mx, l);
            }
        } else { acc = (f32x4){-3.0e38f, -3.0e38f, -3.0e38f, -3.0e38f}; }
        sc[kt] = acc;
    }
    mx = fmaxf(mx, __shfl_xor(mx, 16)); mx = fmaxf(mx, __shfl_xor(mx, 32));
    float ls = 0.f;
#pragma unroll
    for (int kt = 0; kt < 16; ++kt)
#pragma unroll
        for (int jj = 0; jj < 4; ++jj) { const float e = (sc[kt][jj] > -1.0e38f) ? __expf(sc[kt][jj] - mx) : 0.f; sc[kt][jj] = e; ls += e; }
    ls += __shfl_xor(ls, 16); ls += __shfl_xor(ls, 32);
#pragma unroll
    for (int dt = 0; dt < 4; ++dt) o[dt] = (f32x4){0.f, 0.f, 0.f, 0.f};
#pragma unroll
    for (int s = 0; s < 8; ++s) {
        if (s * 2 < nkt) {
            const bf16x8 pf = pack8(sc[2 * s], sc[2 * s + 1]);
#pragma unroll
            for (int dt = 0; dt < 4; ++dt) o[dt] = MFMA16(ldperm(smem + A_LV + (dt * 16 + fr) * 528, s, fq), pf, o[dt]);
        }
    }
    m_out = mx; l_out = ls;
}

__device__ __forceinline__ void moba_partial(const P& p, int bid, int nb, char* smem) {
    const int tid = otid(), lane = tid & 63, w = tid >> 6, fr = lane & 15, fq = lane >> 4;
    char* ws = p.ws;
    const bf16_t* um = (const bf16_t*)(ws + OFF_UM);
    const int* glst = (const int*)(ws + OFF_CTL + CTL_MLST); const int* gtst = (const int*)(ws + OFF_CTL + CTL_MTST);
    const int* QL = (const int*)(ws + OFF_MQL);
    bf16_t* PO = (bf16_t*)p.out; float* PM = (float*)((char*)p.out + 52 * MiB); float* PL = PM + 400000;
    int* tst = (int*)(smem + A_TST);
    for (int i = tid; i < 513; i += 256) tst[i] = gtst[i];
    __syncthreads();
    const int ntiles = tst[512];
    for (int it = bid; it < ntiles; it += nb) {
        int lo = 0, hi = 512;
        while (hi - lo > 1) { const int mid = (lo + hi) >> 1; if (tst[mid] <= it) lo = mid; else hi = mid; }
        const int li = lo, h = li >> 6, j = li & 63, r = it - tst[li];
        const int l0 = glst[li], l1 = glst[li + 1], base = l0 + r * 64;
        attn_stage(p, j, h, 256, smem, tid);
        __syncthreads();
        const int idx = w * 16 + fr; const bool valid = base + idx < l1;
        const int pos = valid ? base + idx : base;
        const int qt = QL[pos];
        float m, l; f32x4 o[4];
        attn_core<false>(smem, um + (size_t)qt * UMC + h * 64, qt, j * 256, 256, fr, fq, m, l, o);
        if (valid) {
#pragma unroll
            for (int dt = 0; dt < 4; ++dt) *(u32x2*)(PO + (size_t)pos * 64 + dt * 16 + fq * 4) = pack4(o[dt]);
            if (fq == 0) { PM[pos] = m; PL[pos] = l; }
        }
        __syncthreads();
    }
}

__device__ __forceinline__ void moba_own(const P& p, int bid, int nb, char* smem) {
    const int tid = otid(), lane = tid & 63, w = tid >> 6, fr = lane & 15, fq = lane >> 4;
    char* ws = p.ws;
    const bf16_t* um = (const bf16_t*)(ws + OFF_UM);
    const int* SP = (const int*)(ws + OFF_MSP);
    const bf16_t* PO = (const bf16_t*)p.out; const float* PM = (const float*)((const char*)p.out + 52 * MiB); const float* PL = PM + 400000;
    bf16_t* ob = (bf16_t*)(ws + OFF_OB);
    for (int it = bid; it < 2048; it += nb) {
        const int tile = it >> 3, h = it & 7, b = tile >> 2, tb = tile & 3, nkeys = (tb + 1) * 64;
        attn_stage(p, b, h, nkeys, smem, tid);
        __syncthreads();
        const int qt = tile * 64 + w * 16 + fr;
        float m, l; f32x4 o[4];
        attn_core<true>(smem, um + (size_t)qt * UMC + h * 64, qt, b * 256, nkeys, fr, fq, m, l, o);
        int pos[3]; float pm[3]; float M = m;
#pragma unroll
        for (int s = 0; s < 3; ++s) { pos[s] = SP[(qt * 8 + h) * 3 + s]; pm[s] = (pos[s] >= 0) ? PM[pos[s]] : -3.0e38f; M = fmaxf(M, pm[s]); }
        const float so = __expf(m - M);
        float den = l * so;
#pragma unroll
        for (int dt = 0; dt < 4; ++dt) o[dt] = o[dt] * so;
#pragma unroll
        for (int s = 0; s < 3; ++s) {
            if (pos[s] >= 0) {
                const float e = __expf(pm[s] - M);
                den += PL[pos[s]] * e;
#pragma unroll
                for (int dt = 0; dt < 4; ++dt) {
                    const u32x2 pv = *(const u32x2*)(PO + (size_t)pos[s] * 64 + dt * 16 + fq * 4);
                    o[dt].x += e * __uint_as_float(pv.x << 16); o[dt].y += e * __uint_as_float(pv.x & 0xffff0000u);
                    o[dt].z += e * __uint_as_float(pv.y << 16); o[dt].w += e * __uint_as_float(pv.y & 0xffff0000u);
                }
            }
        }
        const float inv = 1.f / den;
#pragma unroll
        for (int dt = 0; dt < 4; ++dt) *(u32x2*)(ob + (size_t)qt * 512 + h * 64 + dt * 16 + fq * 4) = pack4(o[dt] * inv);
        __syncthreads();
    }
}

__device__ __forceinline__ void phase_qx_xattn(const P& p, int bid, int nb, char* smem) {
    char* ws = p.ws;
    const bf16_t* KX = (const bf16_t*)(ws + OFF_KVX); const bf16_t* VXT = KX + 256 * 512;
    bf16_t* ox = (bf16_t*)(ws + OFF_OB);
    for (int it = bid; it < 512; it += nb) {
        const int pm = it >> 2, h = it & 3;
        bf16x8 qf[2][4];
        {
            f32x4 acc[2][8];
#pragma unroll
            for (int m = 0; m < 2; ++m)
#pragma unroll
                for (int n = 0; n < 8; ++n) acc[m][n] = (f32x4){0.f, 0.f, 0.f, 0.f};
            gemm_core<false, false, true, 2, 8>(acc, (const bf16_t*)(ws + OFF_XN), D, nullptr, pm * 128, (const bf16_t*)(ws + OFF_WQ), D, h * 128, D, smem);
            const float sc = 0.08838834764831845f;
#pragma unroll
            for (int m = 0; m < 2; ++m)
#pragma unroll
                for (int s2 = 0; s2 < 4; ++s2) qf[m][s2] = pack8(acc[m][2 * s2] * sc, acc[m][2 * s2 + 1] * sc);
        }
        const int tid = otid(), lane = tid & 63, w = tid >> 6, fr = lane & 15, fq = lane >> 4;
        for (int idx = tid; idx < 4096; idx += 256) { const int key = idx >> 4, ch = idx & 15; *(u32x4*)(smem + key * 272 + ch * 16) = *(const u32x4*)(KX + (size_t)key * 512 + h * 128 + ch * 8); }
        __syncthreads();
        bf16x8 pf[2][8]; float inv[2];
#pragma unroll
        for (int m = 0; m < 2; ++m) {
            f32x4 sc[16]; float mx = -3.0e38f;
#pragma unroll
            for (int kt = 0; kt < 16; ++kt) {
                f32x4 a = {0.f, 0.f, 0.f, 0.f};
#pragma unroll
                for (int s2 = 0; s2 < 4; ++s2) a = MFMA16(ldperm(smem + (kt * 16 + fr) * 272, s2, fq), qf[m][s2], a);
                sc[kt] = a; mx = fmaxf(fmaxf(mx, fmaxf(a.x, a.y)), fmaxf(a.z, a.w));
            }
            mx = fmaxf(mx, __shfl_xor(mx, 16)); mx = fmaxf(mx, __shfl_xor(mx, 32));
            float ls = 0.f;
#pragma unroll
            for (int kt = 0; kt < 16; ++kt) { sc[kt].x = __expf(sc[kt].x - mx); sc[kt].y = __expf(sc[kt].y - mx); sc[kt].z = __expf(sc[kt].z - mx); sc[kt].w = __expf(sc[kt].w - mx); ls += (sc[kt].x + sc[kt].y) + (sc[kt].z + sc[kt].w); }
            ls += __shfl_xor(ls, 16); ls += __shfl_xor(ls, 32);
            inv[m] = 1.f / ls;
#pragma unroll
            for (int s2 = 0; s2 < 8; ++s2) { pf[m][s2] = pack8(sc[2 * s2], sc[2 * s2 + 1]); asm volatile("" : "+v"(pf[m][s2])); }
            asm volatile("" ::: "memory");
        }
        __syncthreads();
        for (int idx = tid; idx < 4096; idx += 256) { const int d = idx >> 5, ch = idx & 31; *(u32x4*)(smem + d * 528 + ch * 16) = *(const u32x4*)(VXT + (size_t)(h * 128 + d) * 256 + ch * 8); }
        __syncthreads();
#pragma unroll
        for (int m = 0; m < 2; ++m) {
            const int row = pm * 128 + w * 32 + m * 16 + fr;
#pragma unroll
            for (int dt = 0; dt < 8; ++dt) {
                f32x4 o = {0.f, 0.f, 0.f, 0.f};
#pragma unroll
                for (int s2 = 0; s2 < 8; ++s2) o = MFMA16(ldperm(smem + (dt * 16 + fr) * 528, s2, fq), pf[m][s2], o);
                *(u32x2*)(ox + (size_t)row * 512 + h * 128 + dt * 16 + fq * 4) = pack4(o * inv[m]);
                asm volatile("" ::: "memory");
            }
        }
        __syncthreads();
    }
}

__device__ __forceinline__ void phase_merge(const P& p, int bid, int nb, char* smem) {
    TILE_COORDS
    char* ws = p.ws;
    const bf16_t* ug = (const bf16_t*)(ws + OFF_UG);
    bf16_t* mg = (bf16_t*)(ws + OFF_MRG);
    for (int it = bid; it < 128 * 8; it += nb) {
        const int pm = it >> 3, pn = it & 7;
        f32x4 acc[4][4], acc2[4][4]; zero_acc(acc); zero_acc(acc2);
        gemm_k_loop<false>(acc, (const bf16_t*)(ws + OFF_OA), 512, nullptr, pm * 128, (const bf16_t*)(ws + OFF_WORW), 512, pn * 128, 512, smem);
        gemm_k_loop<false>(acc2, (const bf16_t*)(ws + OFF_OB), 512, nullptr, pm * 128, (const bf16_t*)(ws + OFF_WOMB), 512, pn * 128, 512, smem);
#pragma unroll
        for (int m = 0; m < 4; ++m) {
            const int row = pm * 128 + wr * 64 + m * 16 + fr;
#pragma unroll
            for (int n = 0; n < 4; ++n) {
                const int col = pn * 128 + wc * 64 + n * 16 + fq * 4;
                const u32x2 ga = *(const u32x2*)(ug + (size_t)row * GCOLS + col);
                const u32x2 gb = *(const u32x2*)(ug + (size_t)row * GCOLS + 1024 + col);
                const f32x4 a = acc[m][n], b = acc2[m][n];
                const float r0 = __uint_as_float(ga.x << 16) * a.x + __uint_as_float(gb.x << 16) * b.x;
                const float r1 = __uint_as_float(ga.x & 0xffff0000u) * a.y + __uint_as_float(gb.x & 0xffff0000u) * b.y;
                const float r2 = __uint_as_float(ga.y << 16) * a.z + __uint_as_float(gb.y << 16) * b.z;
                const float r3 = __uint_as_float(ga.y & 0xffff0000u) * a.w + __uint_as_float(gb.y & 0xffff0000u) * b.w;
                u32x2 o; o.x = pk2(r0, r1); o.y = pk2(r2, r3);
                *(u32x2*)(mg + (size_t)row * D + col) = o;
            }
        }
    }
}

__device__ __forceinline__ void phase_resid_gemm(const bf16_t* A, int K, const bf16_t* Bt, const float* res, float* dst, int bid, int nb, char* smem) {
    TILE_COORDS
    for (int it = bid; it < 128 * 8; it += nb) {
        const int pm = it >> 3, pn = it & 7;
        f32x4 acc[4][4]; zero_acc(acc);
        gemm_k_loop<false>(acc, A, K, nullptr, pm * 128, Bt, K, pn * 128, K, smem);
#pragma unroll
        for (int m = 0; m < 4; ++m) {
            const int row = pm * 128 + wr * 64 + m * 16 + fr;
#pragma unroll
            for (int n = 0; n < 4; ++n) {
                const size_t off = (size_t)row * D + pn * 128 + wc * 64 + n * 16 + fq * 4;
                const f32x4 r = *(const f32x4*)(res + off);
                *(f32x4*)(dst + off) = r + acc[m][n];
            }
        }
    }
}

__device__ __forceinline__ void phase_norm(const float* src, const float* g, bf16_t* dst, int bid, int nb) {
    const int lane = otid() & 63, wid = otid() >> 6;
    for (int it = bid; it < T / 4; it += nb) { const int row = it * 4 + wid; rms_row_bf16(src + (size_t)row * D, g, dst + (size_t)row * D, lane); }
}

__device__ __forceinline__ void phase_expconv(const P& p, int bid, int nb, char* smem) {
    float* scr = (float*)smem;
    bf16_t* gu = (bf16_t*)(p.ws + OFF_EXPGU); bf16_t* dn = (bf16_t*)(p.ws + OFF_EXPD);
    for (int it = bid; it < 3 * 32 * 128; it += nb) {
        const int which = it / 4096, r = it % 4096, e = r >> 7, tile = r & 127;
        if (which == 0) transpose_tile(p.w_exp_gate + (size_t)e * D * DEXP, D, DEXP, gu + (size_t)e * D * D, 32, 0, tile, scr);
        else if (which == 1) transpose_tile(p.w_exp_up + (size_t)e * D * DEXP, D, DEXP, gu + (size_t)e * D * D, 32, 16, tile, scr);
        else transpose_tile(p.w_exp_down + (size_t)e * DEXP * D, DEXP, D, dn + (size_t)e * D * DEXP, 16, 0, tile, scr);
    }
}

__device__ __forceinline__ void phase_router(const P& p, int bid, int nb, char* smem) {
    const int tid = otid(), lane = tid & 63, wid = tid >> 6;
    char* ws = p.ws;
    int* hist = (int*)smem;
    if (tid < 32) hist[tid] = 0;
    __syncthreads();
    const float* x2 = p.out;
    const float* rt = (const float*)(ws + OFF_ROUT);
    bf16_t* xn = (bf16_t*)(ws + OFF_XN);
    int* toke = (int*)(ws + OFF_CTL + CTL_TOKE); float* tokg = (float*)(ws + OFF_CTL + CTL_TOKG);
    int* rowtok = (int*)(ws + OFF_CTL + CTL_ROWTOK);
    for (int i = bid * 256 + tid; i < CAP; i += nb * 256) rowtok[i] = 0;
    for (int it = bid; it < T / 16; it += nb) {
        const int rbase = it * 16 + wid * 4;
        f32x4 hv[4][4];
#pragma unroll
        for (int rr = 0; rr < 4; ++rr) {
            const f32x4* xr = (const f32x4*)(x2 + (size_t)(rbase + rr) * D) + lane; const f32x4* gr = (const f32x4*)p.norm_ffn + lane;
            float s = 0.f;
#pragma unroll
            for (int j = 0; j < 4; ++j) { hv[rr][j] = xr[64 * j]; s += hv[rr][j].x * hv[rr][j].x + hv[rr][j].y * hv[rr][j].y + hv[rr][j].z * hv[rr][j].z + hv[rr][j].w * hv[rr][j].w; }
            const float rstd = rsqrtf(wave_sum(s) * (1.f / 1024.f) + 1e-6f);
            u32x2* o8 = (u32x2*)(xn + (size_t)(rbase + rr) * D) + lane;
#pragma unroll
            for (int j = 0; j < 4; ++j) { const f32x4 gg = gr[64 * j]; hv[rr][j] = hv[rr][j] * rstd * gg; u32x2 o; o.x = pk2(hv[rr][j].x, hv[rr][j].y); o.y = pk2(hv[rr][j].z, hv[rr][j].w); o8[64 * j] = o; }
        }
        float mine[4] = {0.f, 0.f, 0.f, 0.f};
#pragma unroll 4
        for (int o = 0; o < 36; ++o) {
            const f32x4* wr_ = (const f32x4*)(rt + o * 1024) + lane;
            f32x4 w[4];
#pragma unroll
            for (int j = 0; j < 4; ++j) w[j] = wr_[64 * j];
#pragma unroll
            for (int rr = 0; rr < 4; ++rr) {
                float s = 0.f;
#pragma unroll
                for (int j = 0; j < 4; ++j) s += hv[rr][j].x * w[j].x + hv[rr][j].y * w[j].y + hv[rr][j].z * w[j].z + hv[rr][j].w * w[j].w;
                s = wave_sum(s);
                if (lane == o) mine[rr] = s;
            }
            asm volatile("" ::: "memory");
        }
#pragma unroll
        for (int rr = 0; rr < 4; ++rr) {
            const float g0 = __shfl(mine[rr], 32), g1 = __shfl(mine[rr], 33), g2 = __shfl(mine[rr], 34), g3 = __shfl(mine[rr], 35);
            int gs = 0; float gm = g0;
            if (g1 > gm) { gm = g1; gs = 1; }
            if (g2 > gm) { gm = g2; gs = 2; }
            if (g3 > gm) { gm = g3; gs = 3; }
            const float gp = 1.f / (__expf(g0 - gm) + __expf(g1 - gm) + __expf(g2 - gm) + __expf(g3 - gm));
            float e[8];
#pragma unroll
            for (int i = 0; i < 8; ++i) e[i] = __shfl(mine[rr], gs * 8 + i);
            int i1 = 0; float v1 = e[0];
#pragma unroll
            for (int i = 1; i < 8; ++i) if (e[i] > v1) { v1 = e[i]; i1 = i; }
            int i2 = -1; float v2 = -3.0e38f;
#pragma unroll
            for (int i = 0; i < 8; ++i) if (i != i1 && e[i] > v2) { v2 = e[i]; i2 = i; }
            const float e2 = __expf(v2 - v1), den = 1.f / (1.f + e2);
            if (lane == 0) {
                const int tok = rbase + rr;
                toke[tok * 2] = gs * 8 + i1; toke[tok * 2 + 1] = gs * 8 + i2;
                tokg[tok * 2] = gp * den; tokg[tok * 2 + 1] = gp * e2 * den;
                atomicAdd(&hist[gs * 8 + i1], 1); atomicAdd(&hist[gs * 8 + i2], 1);
            }
        }
    }
    __syncthreads();
    if (tid < 32 && hist[tid]) atomicAdd((int*)(ws + OFF_CTL + CTL_CNT) + tid, hist[tid]);
}

__device__ __forceinline__ void phase_dispatch(const P& p, int bid, int nb, char* smem) {
    const int tid = otid();
    char* ws = p.ws;
    int* pstart = (int*)smem;
    const int* counts = (const int*)(ws + OFF_CTL + CTL_CNT);
    int* cursor = (int*)(ws + OFF_CTL + CTL_CNT) + 32;
    if (tid == 0) { int a = 0; for (int e = 0; e < 32; ++e) { pstart[e] = a; a += (counts[e] + 127) / 128 * 128; } pstart[32] = a; }
    __syncthreads();
    const int* toke = (const int*)(ws + OFF_CTL + CTL_TOKE);
    int* toks = (int*)(ws + OFF_CTL + CTL_TOKS); int* rowtok = (int*)(ws + OFF_CTL + CTL_ROWTOK);
    for (int i = bid * 256 + tid; i < T * 2; i += nb * 256) {
        const int e = toke[i];
        const int pos = pstart[e] + atomicAdd(&cursor[e], 1);
        rowtok[pos] = i >> 1; toks[i] = pos;
    }
    if (bid == 0) {
        int* blke = (int*)(ws + OFF_CTL + CTL_BLKE);
        for (int b = tid; b < NBLK; b += 256) {
            const int r = b * 128; int e = -1;
            if (r < pstart[32]) { e = 0; while (pstart[e + 1] <= r) ++e; }
            blke[b] = e;
        }
    }
}

__device__ __forceinline__ void phase_exp1(const P& p, int bid, int nb, char* smem) {
    TILE_COORDS
    char* ws = p.ws;
    const int* blke = (const int*)(ws + OFF_CTL + CTL_BLKE); const int* rowtok = (const int*)(ws + OFF_CTL + CTL_ROWTOK);
    bf16_t* hid = (bf16_t*)(ws + OFF_MRG);
    for (int it = bid; it < NBLK * 8; it += nb) {
        const int b = it >> 3, pn = it & 7, e = blke[b];
        if (e < 0) continue;
        f32x4 acc[4][4]; zero_acc(acc);
        gemm_k_loop<true>(acc, (const bf16_t*)(ws + OFF_XN), D, rowtok + b * 128, 0, (const bf16_t*)(ws + OFF_EXPGU) + (size_t)e * D * D, D, pn * 128, D, smem);
#pragma unroll
        for (int m = 0; m < 4; ++m) {
            const int row = b * 128 + wr * 64 + m * 16 + fr;
#pragma unroll
            for (int n2 = 0; n2 < 2; ++n2) {
                const f32x4 g = acc[m][n2 * 2], u = acc[m][n2 * 2 + 1];
                const float h0 = g.x * sigm(g.x) * u.x, h1 = g.y * sigm(g.y) * u.y, h2 = g.z * sigm(g.z) * u.z, h3 = g.w * sigm(g.w) * u.w;
                u32x2 o; o.x = pk2(h0, h1); o.y = pk2(h2, h3);
                *(u32x2*)(hid + (size_t)row * DEXP + pn * 64 + wc * 32 + n2 * 16 + fq * 4) = o;
            }
        }
    }
}
__device__ __forceinline__ void phase_exp2(const P& p, int bid, int nb, char* smem) {
    TILE_COORDS
    char* ws = p.ws;
    const int* blke = (const int*)(ws + OFF_CTL + CTL_BLKE);
    bf16_t* ym = (bf16_t*)(ws + OFF_YMOE);
    for (int it = bid; it < NBLK * 8; it += nb) {
        const int b = it >> 3, pn = it & 7, e = blke[b];
        if (e < 0) continue;
        f32x4 acc[4][4]; zero_acc(acc);
        gemm_k_loop<false>(acc, (const bf16_t*)(ws + OFF_MRG), DEXP, nullptr, b * 128, (const bf16_t*)(ws + OFF_EXPD) + (size_t)e * D * DEXP, DEXP, pn * 128, DEXP, smem);
#pragma unroll
        for (int m = 0; m < 4; ++m) {
            const int row = b * 128 + wr * 64 + m * 16 + fr;
#pragma unroll
            for (int n = 0; n < 4; ++n) {
                const f32x4 v = acc[m][n]; u32x2 o; o.x = pk2(v.x, v.y); o.y = pk2(v.z, v.w);
                *(u32x2*)(ym + (size_t)row * D + pn * 128 + wc * 64 + n * 16 + fq * 4) = o;
            }
        }
    }
}
__device__ __forceinline__ void phase_final(const P& p, int bid, int nb) {
    const int lane = otid() & 63, wid = otid() >> 6;
    char* ws = p.ws;
    const int* toks = (const int*)(ws + OFF_CTL + CTL_TOKS); const float* tokg = (const float*)(ws + OFF_CTL + CTL_TOKG);
    const bf16_t* ym = (const bf16_t*)(ws + OFF_YMOE);
    for (int it = bid; it < T / 4; it += nb) {
        const int row = it * 4 + wid;
        const int s1 = toks[row * 2], s2 = toks[row * 2 + 1]; const float g1 = tokg[row * 2], g2 = tokg[row * 2 + 1];
        f32x4* xr = (f32x4*)(p.out + (size_t)row * D) + lane; const f32x4* gr = (const f32x4*)p.norm_final + lane;
        const u32x2* y1 = (const u32x2*)(ym + (size_t)s1 * D) + lane; const u32x2* y2 = (const u32x2*)(ym + (size_t)s2 * D) + lane;
        f32x4 v[4]; float s = 0.f;
#pragma unroll
        for (int j = 0; j < 4; ++j) {
            v[j] = xr[64 * j]; const u32x2 a = y1[64 * j], b = y2[64 * j];
            v[j].x += g1 * __uint_as_float(a.x << 16) + g2 * __uint_as_float(b.x << 16);
            v[j].y += g1 * __uint_as_float(a.x & 0xffff0000u) + g2 * __uint_as_float(b.x & 0xffff0000u);
            v[j].z += g1 * __uint_as_float(a.y << 16) + g2 * __uint_as_float(b.y << 16);
            v[j].w += g1 * __uint_as_float(a.y & 0xffff0000u) + g2 * __uint_as_float(b.y & 0xffff0000u);
            s += v[j].x * v[j].x + v[j].y * v[j].y + v[j].z * v[j].z + v[j].w * v[j].w;
        }
        const float rstd = rsqrtf(wave_sum(s) * (1.f / 1024.f) + 1e-6f);
#pragma unroll
        for (int j = 0; j < 4; ++j) xr[64 * j] = v[j] * rstd * gr[64 * j];
    }
}

constexpr int NPHASE = 17;
template <int PH>
__device__ __forceinline__ void run_phase(const P& p, int bid, int nb, char* smem) {
    char* ws = p.ws;
    if (PH == 0) phase0(p, bid, nb, smem);
    else if (PH == 1) phase1(p, bid, nb, smem);
    else if (PH == 2) { phase_kmean(p, bid, nb, smem); phase_rw_chunk(p, bid, nb, smem); }
    else if (PH == 3) { if (bid < 8) rw_scan(p, bid); else moba_select(p, bid - 8, nb - 8, smem); }
    else if (PH == 4) { phase_rw_out(p, bid, nb); moba_fill(p, bid, nb, smem); }
    else if (PH == 5) moba_partial(p, bid, nb, smem);
    else if (PH == 6) moba_own(p, bid, nb, smem);
    else if (PH == 7) phase_merge(p, bid, nb, smem);
    else if (PH == 8) phase_resid_gemm((const bf16_t*)(ws + OFF_MRG), D, (const bf16_t*)(ws + OFF_WOUT), p.x, p.out, bid, nb, smem);
    else if (PH == 9) { phase_norm(p.out, p.norm_xattn, (bf16_t*)(ws + OFF_XN), bid, nb); phase_expconv(p, bid, nb, smem); }
    else if (PH == 10) phase_qx_xattn(p, bid, nb, smem);
    else if (PH == 11) phase_resid_gemm((const bf16_t*)(ws + OFF_OB), 512, (const bf16_t*)(ws + OFF_WOX), p.out, p.out, bid, nb, smem);
    else if (PH == 12) phase_router(p, bid, nb, smem);
    else if (PH == 13) phase_dispatch(p, bid, nb, smem);
    else if (PH == 14) phase_exp1(p, bid, nb, smem);
    else if (PH == 15) phase_exp2(p, bid, nb, smem);
    else if (PH == 16) phase_final(p, bid, nb);
}

#define XB_TMO      128
#define XB_XCNT(j)  (256  + 64 * (j))
#define XB_XSUB(j)  (1280 + 64 * (j))
#define XB_XGEN(j)  (2304 + 64 * (j))
#define XB_TOP      3328
#define XB_TOPGEN   3392
#define XCD_BAR_WORDS 3456
#define XB_SPIN_CAP (1u << 18)
#define LAS __attribute__((address_space(3)))
__device__ __forceinline__ unsigned xb_ld(unsigned* p)              { return __hip_atomic_load(p, __ATOMIC_RELAXED, __HIP_MEMORY_SCOPE_AGENT); }
__device__ __forceinline__ unsigned xb_add(unsigned* p, unsigned v) { return __hip_atomic_fetch_add(p, v, __ATOMIC_RELAXED, __HIP_MEMORY_SCOPE_AGENT); }
__device__ __forceinline__ unsigned xb_xcc_id() { return (unsigned)__builtin_amdgcn_s_getreg((3 << 11) | 20) & 0xFu; }
#define XB_SPIN(cond, bar) do { unsigned _sp = 0; while (cond) { __builtin_amdgcn_s_sleep(1); \
    if ((++_sp & 255u) == 0u) { if (xb_ld(&(bar)[XB_TMO])) break; if (_sp > XB_SPIN_CAP) { atomicAdd(&(bar)[XB_TMO], 1u); break; } } } } while (0)
struct XcdBarrier { unsigned* bar; unsigned x; volatile LAS unsigned* st; };
__device__ __forceinline__ XcdBarrier xcd_barrier_post(unsigned* bar, volatile LAS unsigned* st) {
    XcdBarrier b; b.bar = bar; b.x = xb_xcc_id(); b.st = st;
    if (threadIdx.x == 0) (void)xb_add(&bar[XB_XCNT(b.x)], 1u);
    return b;
}
__device__ __forceinline__ void xcd_barrier_complete(unsigned* bar, unsigned x, unsigned& nloc, unsigned& nx) {
    const unsigned G = gridDim.x * gridDim.y * gridDim.z;
    unsigned sum, cnt, mine, sp = 0u;
    for (;;) {
        sum = 0u; cnt = 0u; mine = 0u;
#pragma unroll
        for (unsigned j = 0; j < 16; ++j) { const unsigned c = xb_ld(&bar[XB_XCNT(j)]); sum += c; cnt += (c > 0u) ? 1u : 0u; mine = (j == x) ? c : mine; }
        if (sum == G) break;
        __builtin_amdgcn_s_sleep(1);
        if ((++sp & 255u) == 0u) { if (xb_ld(&bar[XB_TMO])) break; if (sp > XB_SPIN_CAP) { atomicAdd(&bar[XB_TMO], 1u); break; } }
    }
    nloc = mine > 0u ? mine : 1u; nx = cnt > 0u ? cnt : 1u;
}
__device__ __forceinline__ void xcd_barrier(const XcdBarrier& b) {
    asm volatile("s_waitcnt vmcnt(0)" ::: "memory");
    __syncthreads();
    if (threadIdx.x == 0) {
        unsigned* bar = b.bar;
        __builtin_amdgcn_s_waitcnt(0);
        unsigned nloc = b.st[0], nx = b.st[1];
        if (nloc == 0u) { xcd_barrier_complete(bar, b.x, nloc, nx); b.st[0] = nloc; b.st[1] = nx; }
        const unsigned old = xb_add(&bar[XB_XSUB(b.x)], 1u);
        const unsigned gen = old / nloc;
        if (old + 1u == (gen + 1u) * nloc) {
            __builtin_amdgcn_fence(__ATOMIC_RELEASE, "agent");
            asm volatile("s_waitcnt vmcnt(0)" ::: "memory");
            const unsigned og = xb_add(&bar[XB_TOP], 1u);
            const unsigned tg = og / nx;
            if (og + 1u == (tg + 1u) * nx) xb_add(&bar[XB_TOPGEN], 1u);
            else XB_SPIN(xb_ld(&bar[XB_TOPGEN]) == tg, bar);
            __builtin_amdgcn_fence(__ATOMIC_ACQUIRE, "agent");
            xb_add(&bar[XB_XGEN(b.x)], 1u);
            asm volatile("s_waitcnt vmcnt(0)" ::: "memory");
        } else {
            XB_SPIN(xb_ld(&bar[XB_XGEN(b.x)]) == gen, bar);
            __builtin_amdgcn_fence(__ATOMIC_ACQUIRE, "agent");
            asm volatile("s_waitcnt vmcnt(0)" ::: "memory");
        }
    }
    __syncthreads();
}
constexpr size_t CTL_BAR = 736 * 1024;
constexpr int L_BARST = 75200;

constexpr int LDS_BYTES = 75264;
static_assert(RW_LDS <= LDS_BYTES, "lds");
template <int PH>
__global__ void __launch_bounds__(256, 2) phase_kernel(P p) {
    extern __shared__ __attribute__((aligned(16))) char smem[];
    run_phase<PH>(p, blockIdx.x, gridDim.x, smem);
}

#ifndef NO_MEGA
__global__ void __launch_bounds__(256, 2) mega_kernel(P p) {
    extern __shared__ __attribute__((aligned(16))) char smem[];
    const int bid = blockIdx.x, nb = gridDim.x;
    volatile LAS unsigned* bst = (volatile LAS unsigned*)(LAS char*)(smem + L_BARST);
    if (threadIdx.x < 2) bst[threadIdx.x] = 0u;
    __syncthreads();
    const XcdBarrier xb = xcd_barrier_post((unsigned*)(p.ws + OFF_CTL + CTL_BAR), bst);
#define GSYNC() xcd_barrier(xb)
    run_phase<0>(p, bid, nb, smem); GSYNC();
    run_phase<1>(p, bid, nb, smem); GSYNC();
    run_phase<2>(p, bid, nb, smem); GSYNC();
    run_phase<3>(p, bid, nb, smem); GSYNC();
    run_phase<4>(p, bid, nb, smem); GSYNC();
    run_phase<5>(p, bid, nb, smem); GSYNC();
    run_phase<6>(p, bid, nb, smem); GSYNC();
    run_phase<7>(p, bid, nb, smem); GSYNC();
    run_phase<8>(p, bid, nb, smem); GSYNC();
    run_phase<9>(p, bid, nb, smem); GSYNC();
    run_phase<10>(p, bid, nb, smem); GSYNC();
    run_phase<11>(p, bid, nb, smem); GSYNC();
    run_phase<12>(p, bid, nb, smem); GSYNC();
    run_phase<13>(p, bid, nb, smem); GSYNC();
    run_phase<14>(p, bid, nb, smem); GSYNC();
    run_phase<15>(p, bid, nb, smem); GSYNC();
    run_phase<16>(p, bid, nb, smem);
}

extern "C" void kernel_launch(void* const* d_in, const int* in_sizes, int n_in, void* d_out, int out_size, void* d_ws, size_t ws_size, hipStream_t stream) {
    if (n_in != 31 || ws_size < WS_NEED || out_size != T * D) { fprintf(stderr, "kernel_launch: unexpected n_in %d / ws_size %zu / out_size %d\n", n_in, ws_size, out_size); return; }
    static int grid_blocks = 0;
    if (!grid_blocks) {
        int dev = 0, cus = 0, per_cu = 0;
        hipGetDevice(&dev);
        hipDeviceGetAttribute(&cus, hipDeviceAttributeMultiprocessorCount, dev);
        if (hipFuncSetAttribute((const void*)mega_kernel, hipFuncAttributeMaxDynamicSharedMemorySize, LDS_BYTES) != hipSuccess) fprintf(stderr, "kernel_launch: hipFuncSetAttribute failed\n");
        hipOccupancyMaxActiveBlocksPerMultiprocessor(&per_cu, (const void*)mega_kernel, 256, LDS_BYTES);
        if (per_cu > 2) per_cu = 2;
        if (per_cu < 1) { fprintf(stderr, "kernel_launch: occupancy query returned %d\n", per_cu); per_cu = 1; }
        grid_blocks = cus * per_cu;
        fprintf(stderr, "kernel_launch: cus %d per_cu %d grid %d\n", cus, per_cu, grid_blocks);
    }
    P p{};
    const float** f = (const float**)&p;
    for (int i = 0; i < 31; ++i) f[i] = (const float*)d_in[i];
    p.out = (float*)d_out; p.ws = (char*)d_ws;
    if (hipMemsetAsync((char*)d_ws + OFF_CTL + CTL_BAR, 0, XCD_BAR_WORDS * 4, stream) != hipSuccess) fprintf(stderr, "kernel_launch: memset failed\n");
    void* args[] = {&p};
    hipError_t e = hipLaunchCooperativeKernel((const void*)mega_kernel, dim3(grid_blocks), dim3(256), args, LDS_BYTES, stream);
    if (e != hipSuccess) fprintf(stderr, "cooperative launch failed: %s (grid %d)\n", hipGetErrorString(e), grid_blocks);
}
#endif
```

```cpp
#include <hip/hip_runtime.h>
#include <cstdio>
#include <cstdint>

typedef unsigned short bf16_t;
typedef short bf16x8 __attribute__((ext_vector_type(8)));
typedef float f32x4 __attribute__((ext_vector_type(4)));
typedef float f32x2 __attribute__((ext_vector_type(2)));
typedef unsigned u32x4 __attribute__((ext_vector_type(4)));
typedef unsigned u32x2 __attribute__((ext_vector_type(2)));
typedef __bf16 bf16x2_t __attribute__((ext_vector_type(2)));
#define LAS __attribute__((address_space(3)))
#define MFMA16(a, b, c) __builtin_amdgcn_mfma_f32_16x16x32_bf16((a), (b), (c), 0, 0, 0)

constexpr int NT = 512;
constexpr int T = 16384, D = 1024, NMEM = 256;
constexpr int UMC = 1536;
constexpr int RW = 512, RCOLS = 1792, MW = 512, MCOLS = 1536, GCOLS = 2048, INCOLS = 5376;
constexpr int NEXP = 32, DEXP = 512, MBLK = 256, NBLK = 160, CAP = NBLK * MBLK;
constexpr size_t MiB = 1u << 20;
constexpr size_t OFF_CTL = 0;
constexpr size_t OFF_WIN = 1 * MiB;
constexpr size_t OFF_WORW = OFF_WIN + (size_t)INCOLS * D * 2;
constexpr size_t OFF_WOMB = OFF_WORW + 1 * MiB;
constexpr size_t OFF_WOUT = OFF_WOMB + 1 * MiB;
constexpr size_t OFF_WQ = OFF_WOUT + 2 * MiB;
constexpr size_t OFF_WKV = OFF_WQ + 1 * MiB;
constexpr size_t OFF_WOX = OFF_WKV + 2 * MiB;
constexpr size_t OFF_MEMN = OFF_WOX + 1 * MiB;
constexpr size_t OFF_KVX = OFF_MEMN + MiB / 2;
constexpr size_t OFF_ROUT = OFF_KVX + MiB / 2;
constexpr size_t OFF_LORA_D = OFF_ROUT + 160 * 1024;
constexpr size_t OFF_LORA_I = OFF_LORA_D + 64 * 1024;
constexpr size_t OFF_LORA_G = OFF_LORA_I + 64 * 1024;
constexpr size_t OFF_XN = 21 * MiB;
constexpr size_t OFF_BON = 21 * MiB;
constexpr size_t OFF_RH = 37 * MiB;
constexpr size_t OFF_UG = 53 * MiB;
constexpr size_t OFF_UR = 117 * MiB;
constexpr size_t OFF_UM = 173 * MiB;
constexpr size_t OFF_OA = 221 * MiB;
constexpr size_t OFF_OB = 237 * MiB;
constexpr size_t OFF_MRG = 253 * MiB;
constexpr size_t OFF_MF = 253 * MiB;
constexpr size_t OFF_SF = 269 * MiB;
constexpr size_t OFF_VT = 253 * MiB;
constexpr size_t OFF_EXPGU = 117 * MiB;
constexpr size_t OFF_EXPD = 181 * MiB;
constexpr size_t OFF_YMOE = 21 * MiB;
constexpr size_t OFF_MSEL = 285 * MiB;
constexpr size_t OFF_MQL = OFF_MSEL + MiB / 2;
constexpr size_t OFF_MSP = OFF_MQL + 3 * MiB / 2;
constexpr size_t WS_NEED = 293 * MiB;
static_assert(OFF_LORA_G + 128 * 1024 <= OFF_XN, "ws map");
constexpr size_t CTL_CNT = 0;
constexpr size_t CTL_BLKE = 4096;
constexpr size_t CTL_MCNT = 8192, CTL_MCUR = 10240, CTL_MLST = 12288, CTL_MTST = 14592;
constexpr size_t CTL_TOKE = 192 * 1024;
constexpr size_t CTL_TOKG = 320 * 1024;
constexpr size_t CTL_TOKS = 448 * 1024;
constexpr size_t CTL_ROWTOK = 576 * 1024;
constexpr size_t CTL_BAR = 752 * 1024;
constexpr size_t CTL_KMB = 768 * 1024;

struct P {
    const float *x, *mem, *rel_bias, *mem_norm, *norm_mix, *w_in, *tshift_mu, *decay_w0, *decay_up, *iclr_a0, *iclr_up, *gate_up,
        *k_k, *k_a, *r_k, *ln_x_w, *ln_x_b, *w_o_rwkv, *w_o_moba, *w_out, *norm_xattn, *w_q_x, *w_kv_x, *w_o_x, *norm_ffn,
        *w_router_group, *w_router_expert, *w_exp_gate, *w_exp_up, *w_exp_down, *norm_final;
    float* out;
    char* ws;
};

__device__ __forceinline__ int otid() { int t = threadIdx.x; asm volatile("" : "+v"(t)); return t; }
__device__ __forceinline__ float bf2f(bf16_t b) { return __uint_as_float((unsigned)b << 16); }
__device__ __forceinline__ unsigned f2bf(float f) { unsigned u = __float_as_uint(f); return (u + 0x7fffu + ((u >> 16) & 1u)) >> 16; }
__device__ __forceinline__ unsigned cvt_pk(float lo, float hi) { const f32x2 v = {lo, hi}; return __builtin_bit_cast(unsigned, __builtin_convertvector(v, bf16x2_t)); }
__device__ __forceinline__ unsigned pk2(float lo, float hi) { return cvt_pk(lo, hi); }
__device__ __forceinline__ u32x2 pack4(f32x4 v) { u32x2 o; o.x = cvt_pk(v.x, v.y); o.y = cvt_pk(v.z, v.w); return o; }
__device__ __forceinline__ bf16x8 pack8(f32x4 a, f32x4 b) { u32x4 o; o.x = cvt_pk(a.x, a.y); o.y = cvt_pk(a.z, a.w); o.z = cvt_pk(b.x, b.y); o.w = cvt_pk(b.z, b.w); return __builtin_bit_cast(bf16x8, o); }
__device__ __forceinline__ bf16x8 ldperm(const char* rowbase, int ks, int fq) {
    const u32x2 a = *(const u32x2*)(rowbase + (32 * ks + fq * 4) * 2), b = *(const u32x2*)(rowbase + (32 * ks + 16 + fq * 4) * 2);
    u32x4 o; o.x = a.x; o.y = a.y; o.z = b.x; o.w = b.y; return __builtin_bit_cast(bf16x8, o);
}
__device__ __forceinline__ float wave_sum(float v) {
#pragma unroll
    for (int o = 32; o >= 1; o >>= 1) v += __shfl_xor(v, o);
    return v;
}
__device__ __forceinline__ float sigm(float x) { return 1.f / (1.f + __expf(-x)); }
__device__ __forceinline__ void unpack8(u32x4 w, float* f) {
    f[0] = __uint_as_float(w.x << 16); f[1] = __uint_as_float(w.x & 0xffff0000u);
    f[2] = __uint_as_float(w.y << 16); f[3] = __uint_as_float(w.y & 0xffff0000u);
    f[4] = __uint_as_float(w.z << 16); f[5] = __uint_as_float(w.z & 0xffff0000u);
    f[6] = __uint_as_float(w.w << 16); f[7] = __uint_as_float(w.w & 0xffff0000u);
}
__device__ __forceinline__ f32x4 unpack4(u32x2 w) { f32x4 r; r.x = __uint_as_float(w.x << 16); r.y = __uint_as_float(w.x & 0xffff0000u); r.z = __uint_as_float(w.y << 16); r.w = __uint_as_float(w.y & 0xffff0000u); return r; }

namespace pg8 {
constexpr int BM = 256, BK = 64, HALF = 128, HTB = HALF * BK * 2  , STAGE_BYTES = 8 * HTB, NXCD = 8, WGM = 8;
__device__ __forceinline__ int lds_byte(int r, int c) { const int st = (r >> 4) * 2 + (c >> 5), rr = r & 15, cc = c & 31, ob = rr * 64 + cc * 2; return st * 1024 + (ob ^ (((ob >> 9) & 1) << 5)); }
__device__ __forceinline__ void stage_rc(int b, int& R, int& C) { const int st = b / 1024, sb = b % 1024, swz = sb ^ (((sb >> 9) & 1) << 5); R = (st >> 1) * 16 + swz / 64; C = (st & 1) * 32 + (swz % 64) / 2; }
__device__ __forceinline__ int perm32(int rho) { const int n = rho >> 4, i = rho & 15; return 8 * (i >> 2) + 4 * n + (i & 3); }
struct Unit { int pm, pn, e; };

struct StaticOrder {
    int nM, nN, nwg, G, c;
    __device__ void init(int M, int N, int G_, int c_) { nM = M / BM; nN = N / BM; nwg = nM * nN; G = G_; c = c_; }
    __device__ bool next(int i, Unit& u) const {
        const long L = (long)i * G + c; if (L >= nwg) return false;
        int wgid = (int)L; { const int q = nwg / NXCD, r = nwg % NXCD, xcd = wgid % NXCD, off = wgid / NXCD; wgid = (xcd < r ? xcd * (q + 1) : r * (q + 1) + (xcd - r) * q) + off; }
        const int nig = WGM * nN, gid = wgid / nig, fm = gid * WGM, gsz = (nM - fm) < WGM ? (nM - fm) : WGM;
        u.pm = fm + ((wgid % nig) % gsz); u.pn = (wgid % nig) / gsz; u.e = 0; return true;
    }
    __device__ __forceinline__ unsigned rowA(const Unit& u, int r) const { return (unsigned)(u.pm * BM + r); }
    __device__ __forceinline__ unsigned rowB(const Unit& u, int r) const { return (unsigned)(u.pn * BM + r); }
};

template <class Epi, class Sched, bool ALIGN_EPI>
__device__ __forceinline__ void gemm_phase(LAS unsigned char* lds, const bf16_t* Ab, const bf16_t* Bb, const int K, const Sched& S, const Epi& E) {
    const int tid = otid(), wid = __builtin_amdgcn_readfirstlane(tid >> 6), lane = tid & 63, wr = wid >> 2, wc = wid & 3, fr = lane & 15, fq = lane >> 4;
    const int nt = K / BK;
    int sR[2], sC[2], sRb[2];
#pragma unroll
    for (int i = 0; i < 2; ++i) { int R, C; stage_rc(tid * 16 + i * 8192, R, C); sR[i] = R; sC[i] = C; sRb[i] = Epi::PERM ? ((R & ~31) + perm32(R & 31)) : R; }
    const unsigned kstep = (unsigned)(BK * 2);
    const unsigned ldsw = (unsigned)wid * 1024u;
    const int aoff = lds_byte(wr * 64 + fr, fq * 8), boff = lds_byte(wc * 32 + fr, fq * 8);
#define PG8_SA(b, h) (((b) * 2 + (h)) * HTB)
#define PG8_SB(b, h) ((4 + (b) * 2 + (h)) * HTB)
#define PG8_STAGE(bufoff, gbase, offs, kb) do { _Pragma("unroll") for (int _i = 0; _i < 2; ++_i) \
        __builtin_amdgcn_global_load_lds((const unsigned*)((const char*)(gbase) + (size_t)((offs)[_i] + (kb))), (LAS unsigned*)(lds + (bufoff) + ldsw + _i * 8192), 16, 0, 0); } while (0)
#define PG8_LDA(dst, b, h) do { _Pragma("unroll") for (int m = 0; m < 4; ++m) _Pragma("unroll") for (int k = 0; k < 2; ++k) dst[m][k] = *(const LAS bf16x8*)(lds + PG8_SA(b, h) + aoff + m * 2048 + k * 1024); } while (0)
#define PG8_LDB(dst, b, h) do { _Pragma("unroll") for (int n = 0; n < 2; ++n) _Pragma("unroll") for (int k = 0; k < 2; ++k) dst[n][k] = *(const LAS bf16x8*)(lds + PG8_SB(b, h) + boff + n * 2048 + k * 1024); } while (0)
#define PG8_MMA(ai, bj, At, Bt) do { __builtin_amdgcn_s_setprio(1); _Pragma("unroll") for (int m = 0; m < 4; ++m) _Pragma("unroll") for (int n = 0; n < 2; ++n) _Pragma("unroll") for (int k = 0; k < 2; ++k) \
        acc[ai][bj][m][n] = __builtin_amdgcn_mfma_f32_16x16x32_bf16(Bt[n][k], At[m][k], acc[ai][bj][m][n], 0, 0, 0); __builtin_amdgcn_s_setprio(0); } while (0)
#define PG8_WAIT_V(n) asm volatile("s_waitcnt vmcnt(" #n ")" ::: "memory")
#define PG8_WAIT_L(n) asm volatile("s_waitcnt lgkmcnt(" #n ")" ::: "memory")
#define PG8_BAR __builtin_amdgcn_s_barrier()
#define PG8_SCHED __builtin_amdgcn_sched_barrier(0)
#define PG8_OFFS(u, AO, BO) do { _Pragma("unroll") for (int _h = 0; _h < 2; ++_h) _Pragma("unroll") for (int _i = 0; _i < 2; ++_i) { \
        AO[_h][_i] = (S.rowA(u, _h * HALF + sR[_i]) * (unsigned)K + (unsigned)sC[_i]) * 2u; BO[_h][_i] = (S.rowB(u, _h * HALF + sRb[_i]) * (unsigned)K + (unsigned)sC[_i]) * 2u; } } while (0)
    Unit cur, nxt; int ui = 0;
    if (!S.next(0, cur)) return;
    f32x4 acc[2][2][4][2];
#pragma unroll
    for (int a = 0; a < 2; ++a)
#pragma unroll
        for (int b = 0; b < 2; ++b)
#pragma unroll
            for (int m = 0; m < 4; ++m)
#pragma unroll
                for (int n = 0; n < 2; ++n) acc[a][b][m][n] = (f32x4){0.f, 0.f, 0.f, 0.f};
    bf16x8 At[4][2], B0[2][2], B1[2][2];
    unsigned ao[2][2], bo[2][2], nao[2][2], nbo[2][2];
    PG8_OFFS(cur, ao, bo);
    PG8_STAGE(PG8_SB(0, 0), Bb, bo[0], 0u); PG8_STAGE(PG8_SB(0, 1), Bb, bo[1], 0u); PG8_STAGE(PG8_SA(0, 0), Ab, ao[0], 0u); PG8_STAGE(PG8_SA(0, 1), Ab, ao[1], 0u);
    if (wr == 1) PG8_BAR;
    PG8_WAIT_V(2); PG8_BAR;
    PG8_STAGE(PG8_SB(1, 0), Bb, bo[0], kstep); PG8_STAGE(PG8_SA(1, 0), Ab, ao[0], kstep); PG8_STAGE(PG8_SB(1, 1), Bb, bo[1], kstep);
    PG8_WAIT_V(6); PG8_BAR;
    for (;;) {
        const bool has_next = S.next(ui + 1, nxt);
        if (has_next) { PG8_OFFS(nxt, nao, nbo); }
        else {
#pragma unroll
            for (int h = 0; h < 2; ++h)
#pragma unroll
                for (int i = 0; i < 2; ++i) { nao[h][i] = ao[h][i]; nbo[h][i] = bo[h][i]; }
        }
        for (int t = 0; t < nt; t += 2) {
            const bool last = (t == nt - 2);
            const unsigned k1 = (unsigned)(t + 1) * kstep, k2 = last ? 0u : (unsigned)(t + 2) * kstep, k3 = k2 + kstep;
            unsigned a2[2][2], b2[2][2];
#pragma unroll
            for (int h = 0; h < 2; ++h)
#pragma unroll
                for (int i = 0; i < 2; ++i) { a2[h][i] = last ? nao[h][i] : ao[h][i]; b2[h][i] = last ? nbo[h][i] : bo[h][i]; }
            PG8_LDB(B0, 0, 0); PG8_LDB(B1, 0, 1); PG8_SCHED; PG8_LDA(At, 0, 0); PG8_STAGE(PG8_SA(1, 1), Ab, ao[1], k1);
            PG8_WAIT_V(8); PG8_WAIT_L(0); PG8_BAR; PG8_MMA(0, 0, At, B0); PG8_MMA(0, 1, At, B1); PG8_BAR; PG8_SCHED;
            PG8_LDA(At, 0, 1); PG8_STAGE(PG8_SB(0, 0), Bb, b2[0], k2); PG8_STAGE(PG8_SB(0, 1), Bb, b2[1], k2); PG8_STAGE(PG8_SA(0, 0), Ab, a2[0], k2);
            PG8_WAIT_V(8); PG8_WAIT_L(0); PG8_BAR; PG8_MMA(1, 0, At, B0); PG8_MMA(1, 1, At, B1); PG8_BAR; PG8_SCHED;
            PG8_LDB(B0, 1, 0); PG8_LDB(B1, 1, 1); PG8_SCHED; PG8_LDA(At, 1, 0); PG8_STAGE(PG8_SA(0, 1), Ab, a2[1], k2);
            PG8_WAIT_V(8); PG8_WAIT_L(0); PG8_BAR; PG8_MMA(0, 0, At, B0); PG8_MMA(0, 1, At, B1); PG8_BAR; PG8_SCHED;
            PG8_LDA(At, 1, 1); PG8_STAGE(PG8_SB(1, 0), Bb, b2[0], k3); PG8_STAGE(PG8_SB(1, 1), Bb, b2[1], k3); PG8_STAGE(PG8_SA(1, 0), Ab, a2[0], k3);
            PG8_WAIT_V(8); PG8_WAIT_L(0); PG8_BAR; PG8_MMA(1, 0, At, B0); PG8_MMA(1, 1, At, B1); PG8_BAR; PG8_SCHED;
        }
        if constexpr (ALIGN_EPI) { if (wr == 0) PG8_BAR; }
        E(acc, cur, wr, wc, fr, fq);
        if (!has_next) break;
#pragma unroll
        for (int a = 0; a < 2; ++a)
#pragma unroll
            for (int b = 0; b < 2; ++b)
#pragma unroll
                for (int m = 0; m < 4; ++m)
#pragma unroll
                    for (int n = 0; n < 2; ++n) acc[a][b][m][n] = (f32x4){0.f, 0.f, 0.f, 0.f};
        cur = nxt; ++ui;
#pragma unroll
        for (int h = 0; h < 2; ++h)
#pragma unroll
            for (int i = 0; i < 2; ++i) { ao[h][i] = nao[h][i]; bo[h][i] = nbo[h][i]; }
        if constexpr (ALIGN_EPI) { if (wr == 1) PG8_BAR; }
    }
    PG8_WAIT_V(0);
    if constexpr (!ALIGN_EPI) { if (wr == 0) PG8_BAR; }
    PG8_BAR;
#undef PG8_SA
#undef PG8_SB
#undef PG8_STAGE
#undef PG8_LDA
#undef PG8_LDB
#undef PG8_MMA
#undef PG8_WAIT_V
#undef PG8_WAIT_L
#undef PG8_BAR
#undef PG8_SCHED
#undef PG8_OFFS
}
}

__device__ __forceinline__ void gemm_r32(f32x4 (&acc)[2][8], const bf16_t* A, int lda, int brow, const bf16_t* Bt, int ldb, int bcol, int K, char* smem) {
    const int tid = otid(), lane = tid & 63, wid = tid >> 6, fr = lane & 15, fq = lane >> 4;
    const int r0 = tid >> 3, lch = (tid & 7) ^ ((tid >> 4) & 7);
    const bf16_t* pa[4]; const bf16_t* pb[2];
#pragma unroll
    for (int i = 0; i < 4; ++i) pa[i] = A + (long)(brow + r0 + 64 * i) * lda + lch * 8;
#pragma unroll
    for (int i = 0; i < 2; ++i) pb[i] = Bt + (long)(bcol + r0 + 64 * i) * ldb + lch * 8;
    const int nk = K / 64;
#pragma unroll
    for (int i = 0; i < 4; ++i) __builtin_amdgcn_global_load_lds((const unsigned*)pa[i], (unsigned*)(smem + tid * 16 + i * 8192), 16, 0, 0);
#pragma unroll
    for (int i = 0; i < 2; ++i) __builtin_amdgcn_global_load_lds((const unsigned*)pb[i], (unsigned*)(smem + 32768 + tid * 16 + i * 8192), 16, 0, 0);
    const int sw = fr >> 1;
    for (int kt = 0; kt < nk; ++kt) {
        asm volatile("s_waitcnt vmcnt(0)" ::: "memory");
        __syncthreads();
        char* cur = smem + (kt & 1) * 49152;
        if (kt + 1 < nk) {
            char* nx = smem + ((kt + 1) & 1) * 49152;
#pragma unroll
            for (int i = 0; i < 4; ++i) __builtin_amdgcn_global_load_lds((const unsigned*)(pa[i] + (kt + 1) * 64), (unsigned*)(nx + tid * 16 + i * 8192), 16, 0, 0);
#pragma unroll
            for (int i = 0; i < 2; ++i) __builtin_amdgcn_global_load_lds((const unsigned*)(pb[i] + (kt + 1) * 64), (unsigned*)(nx + 32768 + tid * 16 + i * 8192), 16, 0, 0);
        }
#pragma unroll
        for (int ks = 0; ks < 2; ++ks) {
            const int pc = ((ks * 4 + fq) ^ sw) * 16;
            bf16x8 At[2], Bf[8];
#pragma unroll
            for (int m = 0; m < 2; ++m) At[m] = *(const bf16x8*)(cur + (wid * 32 + m * 16 + fr) * 128 + pc);
#pragma unroll
            for (int n = 0; n < 8; ++n) Bf[n] = *(const bf16x8*)(cur + 32768 + (n * 16 + fr) * 128 + pc);
#pragma unroll
            for (int m = 0; m < 2; ++m)
#pragma unroll
                for (int n = 0; n < 8; ++n) acc[m][n] = MFMA16(Bf[n], At[m], acc[m][n]);
        }
    }
    __syncthreads();
}

__device__ __forceinline__ void transpose_tile(const float* W, int K, int N, bf16_t* Wt, int rs, int roff, int tile, float* scr  ) {
    const int tid = otid();
    const int nnb = N / 128, kb = tile / nnb, nb = tile % nnb, k0 = kb * 64, n0 = nb * 128;
#pragma unroll 4
    for (int i = 0; i < 16; ++i) { const int k = i * 4 + (tid >> 7), n = tid & 127; scr[k * 129 + n] = W[(size_t)(k0 + k) * N + n0 + n]; }
    __syncthreads();
#pragma unroll
    for (int i = 0; i < 2; ++i) {
        const int c = tid + i * 512, n = c >> 3, kc = c & 7;
        const float* s = scr + (kc * 8) * 129 + n;
        u32x4 o; o.x = pk2(s[0], s[129]); o.y = pk2(s[2 * 129], s[3 * 129]); o.z = pk2(s[4 * 129], s[5 * 129]); o.w = pk2(s[6 * 129], s[7 * 129]);
        const int nn = n0 + n, drow = (nn >> 4) * rs + (nn & 15) + roff;
        *(u32x4*)(Wt + (size_t)drow * K + k0 + kc * 8) = o;
    }
    __syncthreads();
}
__device__ __forceinline__ void rms_row_bf16(const float* xrow, const float* g, bf16_t* orow, int lane) {
    const f32x4* xr = (const f32x4*)xrow + lane; const f32x4* gr = (const f32x4*)g + lane;
    f32x4 v[4]; float s = 0.f;
#pragma unroll
    for (int j = 0; j < 4; ++j) { v[j] = xr[64 * j]; s += v[j].x * v[j].x + v[j].y * v[j].y + v[j].z * v[j].z + v[j].w * v[j].w; }
    const float rstd = rsqrtf(wave_sum(s) * (1.f / 1024.f) + 1e-6f);
    u32x2* o8 = (u32x2*)orow + lane;
#pragma unroll
    for (int j = 0; j < 4; ++j) { const f32x4 gg = gr[64 * j]; u32x2 o; o.x = pk2(v[j].x * rstd * gg.x, v[j].y * rstd * gg.y); o.y = pk2(v[j].z * rstd * gg.z, v[j].w * rstd * gg.w); o8[64 * j] = o; }
}
constexpr int P0_T_IN = 16 * 42, P0_T_A = 64, P0_T_B = 128, P0_T_L = 4 + 4 + 8;
constexpr int P0_TR = P0_T_IN + 4 * P0_T_A + 2 * P0_T_B + P0_T_L;
constexpr int P0_ROUT = 72, P0_NORM = T / 8, P0_MEM = NMEM / 8;
constexpr int P0_ITEMS = P0_TR + P0_ROUT + P0_NORM + P0_MEM + 1;
__device__ __forceinline__ void phase0(const P& p, int bid, int nb, char* smem) {
    const int tid = otid(), lane = tid & 63, wid = tid >> 6;
    char* ws = p.ws;
    for (int it = bid; it < P0_ITEMS; it += nb) {
        int r = it;
        if (r < P0_TR) {
            float* scr = (float*)smem;
            if (r < P0_T_IN) { transpose_tile(p.w_in, D, INCOLS, (bf16_t*)(ws + OFF_WIN), 16, 0, r, scr); continue; } r -= P0_T_IN;
            if (r < P0_T_A) { transpose_tile(p.w_o_rwkv, RW, D, (bf16_t*)(ws + OFF_WORW), 16, 0, r, scr); continue; } r -= P0_T_A;
            if (r < P0_T_A) { transpose_tile(p.w_o_moba, MW, D, (bf16_t*)(ws + OFF_WOMB), 16, 0, r, scr); continue; } r -= P0_T_A;
            if (r < P0_T_B) { transpose_tile(p.w_out, D, D, (bf16_t*)(ws + OFF_WOUT), 16, 0, r, scr); continue; } r -= P0_T_B;
            if (r < P0_T_A) { transpose_tile(p.w_q_x, D, 512, (bf16_t*)(ws + OFF_WQ), 16, 0, r, scr); continue; } r -= P0_T_A;
            if (r < P0_T_B) { transpose_tile(p.w_kv_x, D, D, (bf16_t*)(ws + OFF_WKV), 16, 0, r, scr); continue; } r -= P0_T_B;
            if (r < P0_T_A) { transpose_tile(p.w_o_x, 512, D, (bf16_t*)(ws + OFF_WOX), 16, 0, r, scr); continue; } r -= P0_T_A;
            if (r < 4) { transpose_tile(p.decay_up, 64, 512, (bf16_t*)(ws + OFF_LORA_D), 16, 0, r, scr); continue; } r -= 4;
            if (r < 4) { transpose_tile(p.iclr_up, 64, 512, (bf16_t*)(ws + OFF_LORA_I), 16, 0, r, scr); continue; } r -= 4;
            transpose_tile(p.gate_up, 128, 512, (bf16_t*)(ws + OFF_LORA_G), 16, 0, r, scr); continue;
        }
        r -= P0_TR;
        if (r < P0_ROUT) {
            const int e = r * 512 + tid, o = e >> 10, k = e & 1023;
            float* rt = (float*)(ws + OFF_ROUT);
            rt[e] = (o < 32) ? p.w_router_expert[k * 32 + o] : p.w_router_group[k * 4 + (o - 32)];
            continue;
        }
        r -= P0_ROUT;
        if (r < P0_NORM) { const int row = r * 8 + wid; rms_row_bf16(p.x + (size_t)row * D, p.norm_mix, (bf16_t*)(ws + OFF_XN) + (size_t)row * D, lane); continue; }
        r -= P0_NORM;
        if (r < P0_MEM) { const int row = r * 8 + wid; rms_row_bf16(p.mem + (size_t)row * D, p.mem_norm, (bf16_t*)(ws + OFF_MEMN) + (size_t)row * D, lane); continue; }
        if (tid < 64) ((int*)(ws + OFF_CTL + CTL_CNT))[tid] = 0;
        for (int i = tid; i < 1024; i += NT) ((int*)(ws + OFF_CTL + CTL_MCNT))[i] = 0;
    }
}

struct EpiU {
    static constexpr bool PERM = true;
    char* ws;
    __device__ __forceinline__ void operator()(const f32x4 (&acc)[2][2][4][2], const pg8::Unit& u, int wr, int wc, int fr, int fq) const {
        const int colt = u.pn * 256;
        bf16_t* dst; int ld, cb; bool sg = false;
        if (colt < RCOLS) { dst = (bf16_t*)(ws + OFF_UR); ld = RCOLS; cb = colt; }
        else if (colt < RCOLS + MCOLS) { dst = (bf16_t*)(ws + OFF_UM); ld = UMC; cb = colt - RCOLS; }
        else { dst = (bf16_t*)(ws + OFF_UG); ld = GCOLS; cb = colt - RCOLS - MCOLS; sg = true; }
        const int row0 = u.pm * 256 + wr * 64 + fr, col0 = cb + wc * 32 + 8 * fq;
#pragma unroll
        for (int ai = 0; ai < 2; ++ai)
#pragma unroll
            for (int m = 0; m < 4; ++m) {
                bf16_t* rowp = dst + (size_t)(row0 + ai * 128 + m * 16) * ld + col0;
#pragma unroll
                for (int bj = 0; bj < 2; ++bj) {
                    f32x4 v0 = acc[ai][bj][m][0], v1 = acc[ai][bj][m][1];
                    if (sg) { v0.x = sigm(v0.x); v0.y = sigm(v0.y); v0.z = sigm(v0.z); v0.w = sigm(v0.w); v1.x = sigm(v1.x); v1.y = sigm(v1.y); v1.z = sigm(v1.z); v1.w = sigm(v1.w); }
                    u32x4 w; w.x = cvt_pk(v0.x, v0.y); w.y = cvt_pk(v0.z, v0.w); w.z = cvt_pk(v1.x, v1.y); w.w = cvt_pk(v1.z, v1.w);
                    *(u32x4*)(rowp + bj * 128) = w;
                }
            }
    }
};
__device__ __forceinline__ void phase1(const P& p, int bid, int nb, char* smem) {
    pg8::StaticOrder S; S.init(T, INCOLS, nb, bid);
    EpiU E{p.ws};
    pg8::gemm_phase<EpiU, pg8::StaticOrder, true>((LAS unsigned char*)smem, (const bf16_t*)(p.ws + OFF_XN), (const bf16_t*)(p.ws + OFF_WIN), D, S, E);
}

__device__ __forceinline__ void phase_kmean(const P& p, int bid, int nb, char* smem) {
    const int tid = otid();
    const bf16_t* um = (const bf16_t*)(p.ws + OFF_UM);
    bf16_t* kmb = (bf16_t*)(p.ws + OFF_CTL + CTL_KMB);
    float* red = (float*)smem;
    for (int it = bid; it < 64 * 8; it += nb) {
        const int blk = it >> 3, h = it & 7, q = tid >> 6, d = tid & 63;
        float s = 0.f;
        for (int k = 0; k < 32; ++k) s += bf2f(um[(size_t)(blk * 256 + q * 32 + k) * UMC + 512 + h * 64 + d]);
        red[tid] = s;
        __syncthreads();
        if (tid < 64) { float a = 0.f;
#pragma unroll
            for (int j = 0; j < 8; ++j) a += red[tid + 64 * j];
            kmb[(blk * 8 + h) * 64 + tid] = (bf16_t)f2bf(a * (1.f / 256.f)); }
        __syncthreads();
    }
}
__device__ __forceinline__ void phase_vtrans(const P& p, int bid, int nb, char* smem) {
    const int tid = otid();
    const bf16_t* um = (const bf16_t*)(p.ws + OFF_UM); bf16_t* vt = (bf16_t*)(p.ws + OFF_VT);
    for (int it = bid; it < 256 * 4; it += nb) {
        const int tt = it >> 2, cq = it & 3, t0 = tt * 64, c0 = cq * 128;
#pragma unroll
        for (int i = 0; i < 2; ++i) { const int c = tid + i * 512, r = c >> 4, ch = c & 15; *(u32x4*)(smem + r * 272 + ch * 16) = *(const u32x4*)(um + (size_t)(t0 + r) * UMC + 1024 + c0 + ch * 8); }
        __syncthreads();
#pragma unroll
        for (int i = 0; i < 2; ++i) {
            const int c = tid + i * 512, col = c >> 3, tc = c & 7;
            unsigned short e[8];
#pragma unroll
            for (int j = 0; j < 8; ++j) e[j] = *(const unsigned short*)(smem + (tc * 8 + j) * 272 + col * 2);
            u32x4 o; o.x = e[0] | ((unsigned)e[1] << 16); o.y = e[2] | ((unsigned)e[3] << 16); o.z = e[4] | ((unsigned)e[5] << 16); o.w = e[6] | ((unsigned)e[7] << 16);
            *(u32x4*)(vt + (size_t)(c0 + col) * T + t0 + tc * 8) = o;
        }
        __syncthreads();
    }
}

constexpr int SLOT = 9216, ROWB = 144, LIN_ROWB = 528;
constexpr int L_WL = 0 * SLOT, L_AL = 1 * SLOT, L_LIN = 2 * SLOT, L_AT = 2 * SLOT, L_BT = 3 * SLOT, L_KT = 4 * SLOT, L_RT = 5 * SLOT, L_VT = 6 * SLOT, L_ATT = 7 * SLOT;
constexpr int L_AAB = L_AT, L_AKV = L_BT, L_BBT = L_WL, L_KBT = L_AL;
constexpr int L_WTOT = 8 * SLOT, L_WC = L_WTOT + 1024, RW_LDS = L_WC + 256;

typedef float f32x2 __attribute__((ext_vector_type(2)));
template <int TT> struct SolveRow {
    static __device__ __forceinline__ void run(f32x2 (&x)[32], const char* Lb) {
        f32x2 a0 = {0.f, 0.f}, a1 = {0.f, 0.f};
#pragma unroll
        for (int c8 = 0; c8 <= (TT - 1) / 8; ++c8) {
            const u32x4 lv = *(const u32x4*)(Lb + TT * 144 + c8 * 16);
            f32x2 l0, l1, l2, l3;
            l0.x = __uint_as_float(lv.x << 16); l0.y = __uint_as_float(lv.x & 0xffff0000u);
            l1.x = __uint_as_float(lv.y << 16); l1.y = __uint_as_float(lv.y & 0xffff0000u);
            l2.x = __uint_as_float(lv.z << 16); l2.y = __uint_as_float(lv.z & 0xffff0000u);
            l3.x = __uint_as_float(lv.w << 16); l3.y = __uint_as_float(lv.w & 0xffff0000u);
            a0 = l0 * x[c8 * 4 + 0] + a0; a1 = l1 * x[c8 * 4 + 1] + a1; a0 = l2 * x[c8 * 4 + 2] + a0; a1 = l3 * x[c8 * 4 + 3] + a1;
        }
        a0 = a0 + a1;
        const float r = a0.x + a0.y;
        if (TT & 1) x[TT / 2].y += r; else x[TT / 2].x += r;
        asm volatile("" : "+v"(x[TT / 2]) :: "memory");
        SolveRow<TT + 1>::run(x, Lb);
    }
};
template <> struct SolveRow<64> { static __device__ __forceinline__ void run(f32x2 (&)[32], const char*) {} };

__device__ __forceinline__ void load_shift16(const bf16_t* ur, int row, int col, const float* mu, float* out) {
    const u32x4* cp = (const u32x4*)(ur + (size_t)row * RCOLS + col);
    const u32x4 c0 = cp[0], c1 = cp[1];
    u32x4 p0 = {0u, 0u, 0u, 0u}, p1 = {0u, 0u, 0u, 0u};
    if (row > 0) { const u32x4* pp = (const u32x4*)(ur + (size_t)(row - 1) * RCOLS + col); p0 = pp[0]; p1 = pp[1]; }
    float cf[16], pf[16];
    unpack8(c0, cf); unpack8(c1, cf + 8); unpack8(p0, pf); unpack8(p1, pf + 8);
#pragma unroll
    for (int e = 0; e < 16; ++e) out[e] = cf[e] + mu[col + e] * (pf[e] - cf[e]);
}

__device__ __forceinline__ void phase_rw_chunk(const P& p, int bid, int nb, char* smem0) {
    char* ws = p.ws;
    const bf16_t* ur = (const bf16_t*)(ws + OFF_UR);
    bf16_t* G = (bf16_t*)(ws + OFF_OA); bf16_t* BON = (bf16_t*)(ws + OFF_BON); bf16_t* RH = (bf16_t*)(ws + OFF_RH);
    float* YL = p.out; f32x4* NF = (f32x4*)(p.out + (size_t)T * 512);
    u32x4* MF = (u32x4*)(ws + OFF_MF);
    for (int itb = bid * 2; itb < 2048; itb += nb * 2) {
        const int tid5 = otid();
        const int half = __builtin_amdgcn_readfirstlane(tid5 >> 8), tid = tid5 & 255;
        char* smem = smem0 + half * RW_LDS;
        float* wtot = (float*)(smem + L_WTOT); float* WCs = (float*)(smem + L_WC);
        const int it = itb + half, c = it >> 3, h = it & 7;
        const int lane = tid & 63, w = __builtin_amdgcn_readfirstlane(tid >> 6), fr = lane & 15, fq = lane >> 4;
#pragma unroll 1
        for (int hf = 0; hf < 2; ++hf) {
            u32x4 cur[4], prv[4];
#pragma unroll
            for (int i = 0; i < 4; ++i) {
                const int q = tid + (hf * 4 + i) * 256, t = q >> 5, cc = q & 31, row = c * 64 + t, col = 1536 + cc * 8;
                cur[i] = *(const u32x4*)(ur + (size_t)row * RCOLS + col);
                prv[i] = (u32x4){0u, 0u, 0u, 0u};
                if (row > 0) prv[i] = *(const u32x4*)(ur + (size_t)(row - 1) * RCOLS + col);
            }
#pragma unroll
            for (int i = 0; i < 4; ++i) {
                const int q = tid + (hf * 4 + i) * 256, t = q >> 5, cc = q & 31, col = 1536 + cc * 8;
                float cf[8], pf[8], xs[8];
                unpack8(cur[i], cf); unpack8(prv[i], pf);
#pragma unroll
                for (int e = 0; e < 8; ++e) {
                    const float x = cf[e] + p.tshift_mu[col + e] * (pf[e] - cf[e]);
                    xs[e] = (cc < 8) ? (1.f - 2.f / (1.f + __expf(2.f * x))) : ((cc < 16) ? x : sigm(x));
                }
                u32x4 o; o.x = cvt_pk(xs[0], xs[1]); o.y = cvt_pk(xs[2], xs[3]); o.z = cvt_pk(xs[4], xs[5]); o.w = cvt_pk(xs[6], xs[7]);
                *(u32x4*)(smem + L_LIN + t * LIN_ROWB + cc * 16) = o;
                asm volatile("" ::: "memory");
            }
        }
        __syncthreads();
        {
            const char* lrow = smem + L_LIN + (w * 16 + fr) * LIN_ROWB;
            const bf16_t* dT = (const bf16_t*)(ws + OFF_LORA_D) + (size_t)(h * 64) * 64;
            const bf16_t* iT = (const bf16_t*)(ws + OFF_LORA_I) + (size_t)(h * 64) * 64;
            const bf16_t* gT = (const bf16_t*)(ws + OFF_LORA_G) + (size_t)(h * 64) * 128;
            bf16x8 lb[8];
#pragma unroll
            for (int ks = 0; ks < 8; ++ks) lb[ks] = *(const bf16x8*)(lrow + (ks * 32 + fq * 8) * 2);
#pragma unroll
            for (int jt = 0; jt < 4; ++jt) {
                f32x4 aw = {0.f, 0.f, 0.f, 0.f}, aa = aw, ag = aw;
#pragma unroll
                for (int ks = 0; ks < 2; ++ks) {
                    aw = MFMA16(*(const bf16x8*)(dT + (jt * 16 + fr) * 64 + ks * 32 + fq * 8), lb[ks], aw);
                    aa = MFMA16(*(const bf16x8*)(iT + (jt * 16 + fr) * 64 + ks * 32 + fq * 8), lb[2 + ks], aa);
                }
#pragma unroll
                for (int ks = 0; ks < 4; ++ks) ag = MFMA16(*(const bf16x8*)(gT + (jt * 16 + fr) * 128 + ks * 32 + fq * 8), lb[4 + ks], ag);
                *(u32x2*)(smem + L_WL + (w * 16 + fr) * ROWB + (jt * 16 + fq * 4) * 2) = pack4(aw);
                *(u32x2*)(smem + L_AL + (w * 16 + fr) * ROWB + (jt * 16 + fq * 4) * 2) = pack4(aa);
                *(u32x2*)(G + (size_t)(c * 64 + w * 16 + fr) * 512 + h * 64 + jt * 16 + fq * 4) = pack4(ag);
            }
        }
        __syncthreads();
        {
            const int t = tid >> 2, jq = tid & 3, j0 = jq * 16, hj0 = h * 64 + j0, row = c * 64 + t;
            float ai[16], kk[16], k2[16], rr[16];
            {
                float al[16];
                const u32x4* ap = (const u32x4*)(smem + L_AL + t * ROWB + j0 * 2);
                unpack8(ap[0], al); unpack8(ap[1], al + 8);
#pragma unroll
                for (int e = 0; e < 16; ++e) ai[e] = sigm(p.iclr_a0[hj0 + e] + al[e]);
            }
            float ss = 0.f, rk = 0.f;
            {
                float k[16];
                load_shift16(ur, row, 512 + hj0, p.tshift_mu, k);
#pragma unroll
                for (int e = 0; e < 16; ++e) { kk[e] = k[e] * p.k_k[hj0 + e]; ss += kk[e] * kk[e]; k2[e] = k[e] * (1.f + (ai[e] - 1.f) * p.k_a[hj0 + e]); }
            }
            ss += __shfl_xor(ss, 1); ss += __shfl_xor(ss, 2);
            const float inv = rsqrtf(ss + 1e-12f);
            asm volatile("" ::: "memory");
            load_shift16(ur, row, hj0, p.tshift_mu, rr);
#pragma unroll
            for (int e = 0; e < 16; ++e) rk += rr[e] * k2[e] * p.r_k[hj0 + e];
            rk += __shfl_xor(rk, 1); rk += __shfl_xor(rk, 2);
            asm volatile("" ::: "memory");
            {
                float v[16];
                load_shift16(ur, row, 1024 + hj0, p.tshift_mu, v);
#pragma unroll
                for (int e = 0; e < 16; ++e) *(bf16_t*)(smem + L_VT + (j0 + e) * ROWB + t * 2) = (bf16_t)f2bf(v[e]);
#pragma unroll
                for (int hh = 0; hh < 2; ++hh) {
                    u32x4 o; o.x = cvt_pk(rk * v[hh * 8], rk * v[hh * 8 + 1]); o.y = cvt_pk(rk * v[hh * 8 + 2], rk * v[hh * 8 + 3]); o.z = cvt_pk(rk * v[hh * 8 + 4], rk * v[hh * 8 + 5]); o.w = cvt_pk(rk * v[hh * 8 + 6], rk * v[hh * 8 + 7]);
                    *(u32x4*)(BON + (size_t)row * 512 + hj0 + hh * 8) = o;
                }
            }
            asm volatile("" ::: "memory");
            float lw[16], cum[16];
            {
                float wl[16];
                const u32x4* wp = (const u32x4*)(smem + L_WL + t * ROWB + j0 * 2);
                unpack8(wp[0], wl); unpack8(wp[1], wl + 8);
#pragma unroll
                for (int e = 0; e < 16; ++e) { const float wv = p.decay_w0[hj0 + e] + wl[e]; lw[e] = -__expf(-log1pf(__expf(-wv)) - 0.5f); }
            }
#pragma unroll
            for (int e = 0; e < 16; ++e) {
                float x = lw[e];
#pragma unroll
                for (int d = 4; d < 64; d <<= 1) { const float y = __shfl_up(x, d); if (lane >= d) x += y; }
                cum[e] = x;
            }
            if ((lane >> 2) == 15) {
#pragma unroll
                for (int e = 0; e < 16; ++e) wtot[w * 64 + j0 + e] = cum[e];
            }
            __syncthreads();
#pragma unroll
            for (int hh = 0; hh < 2; ++hh) {
                float at[8], bt[8], kt[8], rt[8];
#pragma unroll
                for (int e8 = 0; e8 < 8; ++e8) {
                    const int e = hh * 8 + e8;
                    const float t0 = wtot[j0 + e], t1 = wtot[64 + j0 + e], t2 = wtot[128 + j0 + e], t3 = wtot[192 + j0 + e];
                    const float cm = cum[e] + ((w > 0 ? t0 : 0.f) + (w > 1 ? t1 : 0.f) + (w > 2 ? t2 : 0.f));
                    const float tt = (t0 + t1) + (t2 + t3);
                    if (t == 63) WCs[j0 + e] = __expf(tt);
                    const float kn = kk[e] * inv;
                    const float E = __expf(cm), Ei = 1.f / E, Ex = __expf(cm - lw[e]), Ec = __expf(tt - cm);
                    const float b = kn * ai[e];
                    at[e8] = -kn * Ex; bt[e8] = b * Ei; kt[e8] = k2[e] * Ei; rt[e8] = rr[e] * E;
                    *(bf16_t*)(smem + L_BBT + (j0 + e) * ROWB + t * 2) = (bf16_t)f2bf(b * Ec);
                    *(bf16_t*)(smem + L_KBT + (j0 + e) * ROWB + t * 2) = (bf16_t)f2bf(k2[e] * Ec);
                    *(bf16_t*)(smem + L_ATT + (j0 + e) * ROWB + t * 2) = (bf16_t)f2bf(at[e8]);
                }
                u32x4 o;
                o.x = cvt_pk(at[0], at[1]); o.y = cvt_pk(at[2], at[3]); o.z = cvt_pk(at[4], at[5]); o.w = cvt_pk(at[6], at[7]);
                *(u32x4*)(smem + L_AT + t * ROWB + (j0 + hh * 8) * 2) = o;
                o.x = cvt_pk(bt[0], bt[1]); o.y = cvt_pk(bt[2], bt[3]); o.z = cvt_pk(bt[4], bt[5]); o.w = cvt_pk(bt[6], bt[7]);
                *(u32x4*)(smem + L_BT + t * ROWB + (j0 + hh * 8) * 2) = o;
                o.x = cvt_pk(kt[0], kt[1]); o.y = cvt_pk(kt[2], kt[3]); o.z = cvt_pk(kt[4], kt[5]); o.w = cvt_pk(kt[6], kt[7]);
                *(u32x4*)(smem + L_KT + t * ROWB + (j0 + hh * 8) * 2) = o;
                o.x = cvt_pk(rt[0], rt[1]); o.y = cvt_pk(rt[2], rt[3]); o.z = cvt_pk(rt[4], rt[5]); o.w = cvt_pk(rt[6], rt[7]);
                *(u32x4*)(smem + L_RT + t * ROWB + (j0 + hh * 8) * 2) = o;
            }
        }
        __syncthreads();
        bf16x8 frb[2], frk[2];
        {
            const int tid2 = otid() & 255, lane = tid2 & 63, fr = lane & 15, fq = lane >> 4;
            bf16x8 xa[2], xr[2];
#pragma unroll
            for (int ks = 0; ks < 2; ++ks) {
                xa[ks] = *(const bf16x8*)(smem + L_AT + (w * 16 + fr) * ROWB + (ks * 32 + fq * 8) * 2);
                xr[ks] = *(const bf16x8*)(smem + L_RT + (w * 16 + fr) * ROWB + (ks * 32 + fq * 8) * 2);
            }
            f32x4 aab[4], aak[4], arb[4], ark[4];
            const int tq = w * 16 + fr;
#pragma unroll
            for (int n = 0; n < 4; ++n) {
                f32x4 dab = {0.f, 0.f, 0.f, 0.f}, dak = dab, drb = dab, drk = dab;
                if (n <= w) {
#pragma unroll
                    for (int ks = 0; ks < 2; ++ks) {
                        const bf16x8 yb = *(const bf16x8*)(smem + L_BT + (n * 16 + fr) * ROWB + (ks * 32 + fq * 8) * 2);
                        const bf16x8 yk = *(const bf16x8*)(smem + L_KT + (n * 16 + fr) * ROWB + (ks * 32 + fq * 8) * 2);
                        dab = MFMA16(yb, xa[ks], dab); dak = MFMA16(yk, xa[ks], dak); drb = MFMA16(yb, xr[ks], drb); drk = MFMA16(yk, xr[ks], drk);
                    }
#pragma unroll
                    for (int jj = 0; jj < 4; ++jj) {
                        const int sq = n * 16 + fq * 4 + jj;
                        if (!(sq < tq)) { dab[jj] = 0.f; dak[jj] = 0.f; }
                        if (!(sq <= tq)) { drb[jj] = 0.f; drk[jj] = 0.f; }
                    }
                }
                aab[n] = dab; aak[n] = dak; arb[n] = drb; ark[n] = drk;
            }
            __syncthreads();
#pragma unroll
            for (int n = 0; n < 4; ++n) *(u32x2*)(smem + L_AAB + (w * 16 + fr) * ROWB + (n * 16 + fq * 4) * 2) = pack4(aab[n]);
            bf16x8 fak[2];
#pragma unroll
            for (int ks = 0; ks < 2; ++ks) { fak[ks] = pack8(aak[2 * ks], aak[2 * ks + 1]); frb[ks] = pack8(arb[2 * ks], arb[2 * ks + 1]); frk[ks] = pack8(ark[2 * ks], ark[2 * ks + 1]); }
#pragma unroll
            for (int vt = 0; vt < 4; ++vt) {
                f32x4 acc = {0.f, 0.f, 0.f, 0.f};
#pragma unroll
                for (int ks = 0; ks < 2; ++ks) acc = MFMA16(fak[ks], ldperm(smem + L_VT + (vt * 16 + fr) * ROWB, ks, fq), acc);
                *(u32x2*)(smem + L_AKV + (vt * 16 + fr) * ROWB + (w * 16 + fq * 4) * 2) = pack4(acc);
            }
        }
        __syncthreads();
        if (w < 2) {
            char* rowp = smem + (w == 0 ? L_ATT : L_AKV) + (otid() & 63) * ROWB;
            f32x2 x[32];
#pragma unroll
            for (int c8 = 0; c8 < 8; ++c8) {
                const u32x4 xv = *(const u32x4*)(rowp + c8 * 16);
                x[c8 * 4 + 0].x = __uint_as_float(xv.x << 16); x[c8 * 4 + 0].y = __uint_as_float(xv.x & 0xffff0000u);
                x[c8 * 4 + 1].x = __uint_as_float(xv.y << 16); x[c8 * 4 + 1].y = __uint_as_float(xv.y & 0xffff0000u);
                x[c8 * 4 + 2].x = __uint_as_float(xv.z << 16); x[c8 * 4 + 2].y = __uint_as_float(xv.z & 0xffff0000u);
                x[c8 * 4 + 3].x = __uint_as_float(xv.w << 16); x[c8 * 4 + 3].y = __uint_as_float(xv.w & 0xffff0000u);
            }
            SolveRow<1>::run(x, smem + L_AAB);
#pragma unroll
            for (int c8 = 0; c8 < 8; ++c8) {
                u32x4 o; o.x = cvt_pk(x[c8 * 4].x, x[c8 * 4].y); o.y = cvt_pk(x[c8 * 4 + 1].x, x[c8 * 4 + 1].y); o.z = cvt_pk(x[c8 * 4 + 2].x, x[c8 * 4 + 2].y); o.w = cvt_pk(x[c8 * 4 + 3].x, x[c8 * 4 + 3].y);
                *(u32x4*)(rowp + c8 * 16) = o;
            }
        }
        __syncthreads();
        {
            const int tid4 = otid() & 255, lane = tid4 & 63, fr = lane & 15, fq = lane >> 4;
            const int trow = c * 64 + w * 16 + fr;
#pragma unroll
            for (int kt = 0; kt < 4; ++kt) {
                f32x4 acc = {0.f, 0.f, 0.f, 0.f};
#pragma unroll
                for (int ks = 0; ks < 2; ++ks) acc = MFMA16(ldperm(smem + L_ATT + (kt * 16 + fr) * ROWB, ks, fq), frb[ks], acc);
                const u32x2 rr = *(const u32x2*)(smem + L_RT + (w * 16 + fr) * ROWB + (kt * 16 + fq * 4) * 2);
                acc.x += __uint_as_float(rr.x << 16); acc.y += __uint_as_float(rr.x & 0xffff0000u); acc.z += __uint_as_float(rr.y << 16); acc.w += __uint_as_float(rr.y & 0xffff0000u);
                *(u32x2*)(RH + (size_t)trow * 512 + h * 64 + kt * 16 + fq * 4) = pack4(acc);
            }
#pragma unroll
            for (int vt = 0; vt < 4; ++vt) {
                f32x4 acc = {0.f, 0.f, 0.f, 0.f};
#pragma unroll
                for (int ks = 0; ks < 2; ++ks) {
                    acc = MFMA16(ldperm(smem + L_AKV + (vt * 16 + fr) * ROWB, ks, fq), frb[ks], acc);
                    acc = MFMA16(ldperm(smem + L_VT + (vt * 16 + fr) * ROWB, ks, fq), frk[ks], acc);
                }
                *(f32x4*)(YL + (size_t)trow * 512 + h * 64 + vt * 16 + fq * 4) = acc;
            }
            bf16x8 xb[2], xk[2];
#pragma unroll
            for (int ks = 0; ks < 2; ++ks) {
                xb[ks] = *(const bf16x8*)(smem + L_BBT + (w * 16 + fr) * ROWB + (ks * 32 + fq * 8) * 2);
                xk[ks] = *(const bf16x8*)(smem + L_KBT + (w * 16 + fr) * ROWB + (ks * 32 + fq * 8) * 2);
            }
            f32x4 mt[4];
            const float wc = WCs[w * 16 + fr];
#pragma unroll
            for (int n = 0; n < 4; ++n) {
                f32x4 acc = {0.f, 0.f, 0.f, 0.f};
#pragma unroll
                for (int ks = 0; ks < 2; ++ks) acc = MFMA16(*(const bf16x8*)(smem + L_ATT + (n * 16 + fr) * ROWB + (ks * 32 + fq * 8) * 2), xb[ks], acc);
#pragma unroll
                for (int jj = 0; jj < 4; ++jj) if (n * 16 + fq * 4 + jj == w * 16 + fr) acc[jj] += wc;
                mt[n] = acc;
            }
#pragma unroll
            for (int ks = 0; ks < 2; ++ks) MF[((size_t)((c * 8 + h) * 4 + w) * 2 + ks) * 64 + lane] = __builtin_bit_cast(u32x4, pack8(mt[2 * ks], mt[2 * ks + 1]));
#pragma unroll
            for (int vs = 0; vs < 4; ++vs) {
                f32x4 acc = {0.f, 0.f, 0.f, 0.f};
#pragma unroll
                for (int ks = 0; ks < 2; ++ks) {
                    acc = MFMA16(xb[ks], *(const bf16x8*)(smem + L_AKV + (vs * 16 + fr) * ROWB + (ks * 32 + fq * 8) * 2), acc);
                    acc = MFMA16(xk[ks], *(const bf16x8*)(smem + L_VT + (vs * 16 + fr) * ROWB + (ks * 32 + fq * 8) * 2), acc);
                }
                NF[((size_t)((c * 8 + h) * 4 + w) * 4 + vs) * 64 + lane] = acc;
            }
        }
        __syncthreads();
    }
}

__device__ __forceinline__ void rw_scan(const P& p, int chain) {
    const int lane = otid() & 63, h = chain >> 2, vs = chain & 3;
    const u32x4* MF = (const u32x4*)(p.ws + OFF_MF); const f32x4* NF = (const f32x4*)(p.out + (size_t)T * 512);
    u32x4* SF = (u32x4*)(p.ws + OFF_SF);
    u32x4 st0 = {0u, 0u, 0u, 0u}, st1 = st0;
    u32x4 m[8]; f32x4 n[4];
    u32x4 m2[8]; f32x4 n2[4];
#pragma unroll
    for (int i = 0; i < 8; ++i) { m[i] = MF[((size_t)(h * 4 + (i >> 1)) * 2 + (i & 1)) * 64 + lane]; m2[i] = MF[((size_t)((8 + h) * 4 + (i >> 1)) * 2 + (i & 1)) * 64 + lane]; }
#pragma unroll
    for (int i = 0; i < 4; ++i) { n[i] = NF[((size_t)(h * 4 + i) * 4 + vs) * 64 + lane]; n2[i] = NF[((size_t)((8 + h) * 4 + i) * 4 + vs) * 64 + lane]; }
    for (int c = 0; c < 256; ++c) {
        SF[((size_t)((c * 8 + h) * 4 + vs) * 2 + 0) * 64 + lane] = st0;
        SF[((size_t)((c * 8 + h) * 4 + vs) * 2 + 1) * 64 + lane] = st1;
        if (c == 255) break;
        u32x4 m3[8]; f32x4 n3[4];
        const int cn = (c + 2 < 255) ? c + 2 : 254;
#pragma unroll
        for (int i = 0; i < 8; ++i) m3[i] = MF[((size_t)((cn * 8 + h) * 4 + (i >> 1)) * 2 + (i & 1)) * 64 + lane];
#pragma unroll
        for (int i = 0; i < 4; ++i) n3[i] = NF[((size_t)((cn * 8 + h) * 4 + i) * 4 + vs) * 64 + lane];
        f32x4 acc[4];
#pragma unroll
        for (int i = 0; i < 4; ++i) {
            acc[i] = MFMA16(__builtin_bit_cast(bf16x8, m[2 * i]), __builtin_bit_cast(bf16x8, st0), n[i]);
            acc[i] = MFMA16(__builtin_bit_cast(bf16x8, m[2 * i + 1]), __builtin_bit_cast(bf16x8, st1), acc[i]);
        }
        st0 = __builtin_bit_cast(u32x4, pack8(acc[0], acc[1])); st1 = __builtin_bit_cast(u32x4, pack8(acc[2], acc[3]));
#pragma unroll
        for (int i = 0; i < 8; ++i) { m[i] = m2[i]; m2[i] = m3[i]; }
#pragma unroll
        for (int i = 0; i < 4; ++i) { n[i] = n2[i]; n2[i] = n3[i]; }
    }
}

__device__ __forceinline__ void phase_rw_out(const P& p, int bid, int nb) {
    const int tid = otid(), lane = tid & 63, w8 = tid >> 6, w = w8 & 3, fr = lane & 15, fq = lane >> 4;
    char* ws = p.ws;
    bf16_t* OA = (bf16_t*)(ws + OFF_OA); const bf16_t* BON = (const bf16_t*)(ws + OFF_BON); const bf16_t* RH = (const bf16_t*)(ws + OFF_RH);
    const float* YL = p.out; const u32x4* SF = (const u32x4*)(ws + OFF_SF);
    for (int itb = bid * 2; itb < 2048; itb += nb * 2) {
        const int it = itb + (w8 >> 2), c = it >> 3, h = it & 7, trow = c * 64 + w * 16 + fr;
        const char* rrow = (const char*)(RH + (size_t)trow * 512 + h * 64);
        bf16x8 rf[2]; rf[0] = ldperm(rrow, 0, fq); rf[1] = ldperm(rrow, 1, fq);
        f32x4 acc[4];
#pragma unroll
        for (int vs = 0; vs < 4; ++vs) {
            acc[vs] = *(const f32x4*)(YL + (size_t)trow * 512 + h * 64 + vs * 16 + fq * 4);
#pragma unroll
            for (int ks = 0; ks < 2; ++ks) acc[vs] = MFMA16(__builtin_bit_cast(bf16x8, SF[((size_t)((c * 8 + h) * 4 + vs) * 2 + ks) * 64 + lane]), rf[ks], acc[vs]);
        }
        float s = 0.f;
#pragma unroll
        for (int vs = 0; vs < 4; ++vs) s += (acc[vs].x + acc[vs].y) + (acc[vs].z + acc[vs].w);
        s += __shfl_xor(s, 16); s += __shfl_xor(s, 32);
        const float mean = s * (1.f / 64.f);
        float q = 0.f;
#pragma unroll
        for (int vs = 0; vs < 4; ++vs) { acc[vs] = acc[vs] - mean; q += (acc[vs].x * acc[vs].x + acc[vs].y * acc[vs].y) + (acc[vs].z * acc[vs].z + acc[vs].w * acc[vs].w); }
        q += __shfl_xor(q, 16); q += __shfl_xor(q, 32);
        const float rstd = rsqrtf(q * (1.f / 64.f) + 64e-5f);
#pragma unroll
        for (int vs = 0; vs < 4; ++vs) {
            const int hv = h * 64 + vs * 16 + fq * 4;
            const f32x4 lw = *(const f32x4*)(p.ln_x_w + hv), lb = *(const f32x4*)(p.ln_x_b + hv);
            const u32x2 bo = *(const u32x2*)(BON + (size_t)trow * 512 + hv), gg = *(const u32x2*)(OA + (size_t)trow * 512 + hv);
            f32x4 o = acc[vs] * rstd * lw + lb;
            o.x = (o.x + __uint_as_float(bo.x << 16)) * __uint_as_float(gg.x << 16);
            o.y = (o.y + __uint_as_float(bo.x & 0xffff0000u)) * __uint_as_float(gg.x & 0xffff0000u);
            o.z = (o.z + __uint_as_float(bo.y << 16)) * __uint_as_float(gg.y << 16);
            o.w = (o.w + __uint_as_float(bo.y & 0xffff0000u)) * __uint_as_float(gg.y & 0xffff0000u);
            *(u32x2*)(OA + (size_t)trow * 512 + hv) = pack4(o);
        }
    }
}


constexpr int A_LK = 0, A_LV = 36864, A_BIAS = 70656, A_TST = 70784;
constexpr int MAXTILES = 6656;

__device__ __forceinline__ void moba_select(const P& p, int bid0, int nb0, char* smem) {
    const int tid = otid(), lane = tid & 63, w = tid >> 6, fr = lane & 15, fq = lane >> 4;
    char* ws = p.ws;
    const bf16_t* um = (const bf16_t*)(ws + OFF_UM); const bf16_t* kmb = (const bf16_t*)(ws + OFF_CTL + CTL_KMB);
    unsigned* SEL = (unsigned*)(ws + OFF_MSEL);
    int* hist = (int*)smem;
    for (int i = tid; i < 512; i += NT) hist[i] = 0;
    __syncthreads();
    for (int it = bid0; it < 1024; it += nb0) {
        const int tile = it >> 3, h = it & 7, qb = tile >> 1, t = tile * 128 + w * 16 + fr;
        bf16x8 qf[2];
#pragma unroll
        for (int ks = 0; ks < 2; ++ks) qf[ks] = *(const bf16x8*)(um + (size_t)t * UMC + h * 64 + ks * 32 + fq * 8);
        float sc[4][4];
#pragma unroll
        for (int nt = 0; nt < 4; ++nt) {
            f32x4 acc = {0.f, 0.f, 0.f, 0.f};
            if (nt * 16 < qb) {
#pragma unroll
                for (int ks = 0; ks < 2; ++ks) acc = MFMA16(*(const bf16x8*)(kmb + (size_t)((nt * 16 + fr) * 8 + h) * 64 + ks * 32 + fq * 8), qf[ks], acc);
            }
#pragma unroll
            for (int j = 0; j < 4; ++j) sc[nt][j] = (nt * 16 + fq * 4 + j < qb) ? acc[j] : -3.0e38f;
        }
        unsigned selw = 0u;
#pragma unroll
        for (int s = 0; s < 3; ++s) {
            float bv = -3.0e38f; int bi = 255;
#pragma unroll
            for (int nt = 0; nt < 4; ++nt)
#pragma unroll
                for (int j = 0; j < 4; ++j) if (sc[nt][j] > bv) { bv = sc[nt][j]; bi = nt * 16 + fq * 4 + j; }
#pragma unroll
            for (int o = 16; o <= 32; o <<= 1) {
                const float v2 = __shfl_xor(bv, o); const int i2 = __shfl_xor(bi, o);
                if (v2 > bv || (v2 == bv && i2 < bi)) { bv = v2; bi = i2; }
            }
            if (!(bv > -1.0e38f)) bi = 255;
            selw |= (unsigned)bi << (8 * s);
#pragma unroll
            for (int nt = 0; nt < 4; ++nt)
#pragma unroll
                for (int j = 0; j < 4; ++j) if (nt * 16 + fq * 4 + j == bi) sc[nt][j] = -3.0e38f;
            if (fq == 0 && bi != 255) atomicAdd(&hist[h * 64 + bi], 1);
        }
        if (fq == 0) SEL[t * 8 + h] = selw | 0xff000000u;
    }
    __syncthreads();
    int* gcnt = (int*)(ws + OFF_CTL + CTL_MCNT);
    for (int i = tid; i < 512; i += NT) if (hist[i]) atomicAdd(&gcnt[i], hist[i]);
}

__device__ __forceinline__ void moba_fill(const P& p, int bid, int nb, char* smem) {
    const int tid = otid();
    char* ws = p.ws;
    const int* gcnt = (const int*)(ws + OFF_CTL + CTL_MCNT); int* gcur = (int*)(ws + OFF_CTL + CTL_MCUR);
    int* lst = (int*)smem;
    int* tst = lst + 520;
    int* lh = tst + 520;
    int* lc = lh + 512;
    for (int i = tid; i < 512; i += NT) lc[i] = gcnt[i];
    __syncthreads();
    if (tid == 0) {
        int a = 0, b = 0;
        for (int i = 0; i < 512; ++i) { const int c = lc[i]; lst[i] = a; tst[i] = b; a += c; b += (c + 127) >> 7; }
        lst[512] = a; tst[512] = b;
    }
    __syncthreads();
    for (int i = tid; i < 512; i += NT) { lh[i] = 0; lc[i] = 0; }
    __syncthreads();
    if (bid == 0) {
        int* glst = (int*)(ws + OFF_CTL + CTL_MLST); int* gtst = (int*)(ws + OFF_CTL + CTL_MTST);
        for (int i = tid; i < 513; i += NT) { glst[i] = lst[i]; gtst[i] = tst[i]; }
    }
    const unsigned* SEL = (const unsigned*)(ws + OFF_MSEL);
    int* QL = (int*)(ws + OFF_MQL); int* SP = (int*)(ws + OFF_MSP);
    const int per = (T * 8 + nb - 1) / nb, i0 = bid * per, i1 = min(T * 8, i0 + per);
    for (int i = i0 + tid; i < i1; i += NT) {
        const unsigned sw = SEL[i]; const int h = i & 7;
#pragma unroll
        for (int s = 0; s < 3; ++s) { const int j = (sw >> (8 * s)) & 255; if (j != 255) atomicAdd(&lh[h * 64 + j], 1); }
    }
    __syncthreads();
    for (int i = tid; i < 512; i += NT) { const int c = lh[i]; lh[i] = c ? atomicAdd(&gcur[i], c) : 0; }
    __syncthreads();
    for (int i = i0 + tid; i < i1; i += NT) {
        const unsigned sw = SEL[i]; const int h = i & 7;
#pragma unroll
        for (int s = 0; s < 3; ++s) {
            const int j = (sw >> (8 * s)) & 255; int pos = -1;
            if (j != 255) { const int li = h * 64 + j; pos = lst[li] + lh[li] + atomicAdd(&lc[li], 1); QL[pos] = i >> 3; }
            SP[i * 3 + s] = pos;
        }
    }
}

__device__ __forceinline__ int t5b(int n) {
    const int v = (int)(__float_as_uint((float)(n * n)) >> 23) - 119;
    return n < 16 ? n : (v > 31 ? 31 : v);
}

__device__ __forceinline__ void attn_stage(const P& p, int j, int h, int nkeys, char* smem, int tid) {
    const bf16_t* um = (const bf16_t*)(p.ws + OFF_UM); const bf16_t* vt = (const bf16_t*)(p.ws + OFF_VT);
    for (int idx = tid; idx < nkeys * 8; idx += NT) {
        const int key = idx >> 3, ch = idx & 7;
        *(u32x4*)(smem + A_LK + key * 144 + ch * 16) = *(const u32x4*)(um + (size_t)(j * 256 + key) * UMC + 512 + h * 64 + ch * 8);
    }
    const int cpr = nkeys >> 3;
    for (int idx = tid; idx < 64 * cpr; idx += NT) {
        const int d = idx / cpr, ch = idx - d * cpr;
        *(u32x4*)(smem + A_LV + d * 528 + ch * 16) = *(const u32x4*)(vt + (size_t)(h * 64 + d) * T + j * 256 + ch * 8);
    }
    if (tid < 32) ((float*)(smem + A_BIAS))[tid] = p.rel_bias[tid * 8 + h];
}
template <bool CAUSAL>
__device__ __forceinline__ void attn_core(const char* smem, const bf16_t* qrow, int qt, int kbase, int nkeys, int fr, int fq, float& m_out, float& l_out, f32x4 (&o)[4]) {
    bf16x8 qf[2];
#pragma unroll
    for (int ks = 0; ks < 2; ++ks) qf[ks] = *(const bf16x8*)(qrow + ks * 32 + fq * 8);
    const float* lb = (const float*)(smem + A_BIAS);
    const int nkt = nkeys >> 4;
    f32x4 sc[16];
    float mx = -3.0e38f;
#pragma unroll
    for (int kt = 0; kt < 16; ++kt) {
        f32x4 acc = {0.f, 0.f, 0.f, 0.f};
        if (kt < nkt) {
#pragma unroll
            for (int ks = 0; ks < 2; ++ks) acc = MFMA16(*(const bf16x8*)(smem + A_LK + (kt * 16 + fr) * 144 + (ks * 32 + fq * 8) * 2), qf[ks], acc);
#pragma unroll
            for (int jj = 0; jj < 4; ++jj) {
                const int rel = qt - (kbase + kt * 16 + fq * 4 + jj);
                float l = acc[jj] * 0.125f + lb[t5b(rel < 0 ? 0 : rel)];
                if (CAUSAL && rel < 0) l = -3.0e38f;
                acc[jj] = l; mx = fmaxf(mx, l);
            }
        } else { acc = (f32x4){-3.0e38f, -3.0e38f, -3.0e38f, -3.0e38f}; }
        sc[kt] = acc;
    }
    mx = fmaxf(mx, __shfl_xor(mx, 16)); mx = fmaxf(mx, __shfl_xor(mx, 32));
    float ls = 0.f;
#pragma unroll
    for (int kt = 0; kt < 16; ++kt)
#pragma unroll
        for (int jj = 0; jj < 4; ++jj) { const float e = (sc[kt][jj] > -1.0e38f) ? __expf(sc[kt][jj] - mx) : 0.f; sc[kt][jj] = e; ls += e; }
    ls += __shfl_xor(ls, 16); ls += __shfl_xor(ls, 32);
#pragma unroll
    for (int dt = 0; dt < 4; ++dt) o[dt] = (f32x4){0.f, 0.f, 0.f, 0.f};
#pragma unroll
    for (int s = 0; s < 8; ++s) {
        if (s * 2 < nkt) {
            const bf16x8 pf = pack8(sc[2 * s], sc[2 * s + 1]);
#pragma unroll
            for (int dt = 0; dt < 4; ++dt) o[dt] = MFMA16(ldperm(smem + A_LV + (dt * 16 + fr) * 528, s, fq), pf, o[dt]);
        }
    }
    m_out = mx; l_out = ls;
}

__device__ __forceinline__ void moba_partial(const P& p, int bid, int nb, char* smem) {
    const int tid = otid(), lane = tid & 63, w = tid >> 6, fr = lane & 15, fq = lane >> 4;
    char* ws = p.ws;
    const bf16_t* um = (const bf16_t*)(ws + OFF_UM);
    const int* glst = (const int*)(ws + OFF_CTL + CTL_MLST); const int* gtst = (const int*)(ws + OFF_CTL + CTL_MTST);
    const int* QL = (const int*)(ws + OFF_MQL);
    bf16_t* PO = (bf16_t*)p.out; float* PM = (float*)((char*)p.out + 52 * MiB); float* PL = PM + 400000;
    int* tst = (int*)(smem + A_TST);
    for (int i = tid; i < 513; i += NT) tst[i] = gtst[i];
    __syncthreads();
    const int ntiles = tst[512];
    for (int it = bid; it < ntiles; it += nb) {
        int lo = 0, hi = 512;
        while (hi - lo > 1) { const int mid = (lo + hi) >> 1; if (tst[mid] <= it) lo = mid; else hi = mid; }
        const int li = lo, h = li >> 6, j = li & 63, r = it - tst[li];
        const int l0 = glst[li], l1 = glst[li + 1], base = l0 + r * 128;
        attn_stage(p, j, h, 256, smem, tid);
        __syncthreads();
        const int idx = w * 16 + fr; const bool valid = base + idx < l1;
        const int pos = valid ? base + idx : base;
        const int qt = QL[pos];
        float m, l; f32x4 o[4];
        attn_core<false>(smem, um + (size_t)qt * UMC + h * 64, qt, j * 256, 256, fr, fq, m, l, o);
        if (valid) {
#pragma unroll
            for (int dt = 0; dt < 4; ++dt) *(u32x2*)(PO + (size_t)pos * 64 + dt * 16 + fq * 4) = pack4(o[dt]);
            if (fq == 0) { PM[pos] = m; PL[pos] = l; }
        }
        __syncthreads();
    }
}

__device__ __forceinline__ void moba_own(const P& p, int bid, int nb, char* smem) {
    const int tid = otid(), lane = tid & 63, w = tid >> 6, fr = lane & 15, fq = lane >> 4;
    char* ws = p.ws;
    const bf16_t* um = (const bf16_t*)(ws + OFF_UM);
    const int* SP = (const int*)(ws + OFF_MSP);
    const bf16_t* PO = (const bf16_t*)p.out; const float* PM = (const float*)((const char*)p.out + 52 * MiB); const float* PL = PM + 400000;
    bf16_t* ob = (bf16_t*)(ws + OFF_OB);
    for (int it = bid; it < 1024; it += nb) {
        const int tile = it >> 3, h = it & 7, b = tile >> 1, tb = tile & 1, nkeys = (tb + 1) * 128;
        attn_stage(p, b, h, nkeys, smem, tid);
        __syncthreads();
        const int qt = tile * 128 + w * 16 + fr;
        float m, l; f32x4 o[4];
        attn_core<true>(smem, um + (size_t)qt * UMC + h * 64, qt, b * 256, nkeys, fr, fq, m, l, o);
        int pos[3]; float pm[3]; float M = m;
#pragma unroll
        for (int s = 0; s < 3; ++s) { pos[s] = SP[(qt * 8 + h) * 3 + s]; pm[s] = (pos[s] >= 0) ? PM[pos[s]] : -3.0e38f; M = fmaxf(M, pm[s]); }
        const float so = __expf(m - M);
        float den = l * so;
#pragma unroll
        for (int dt = 0; dt < 4; ++dt) o[dt] = o[dt] * so;
#pragma unroll
        for (int s = 0; s < 3; ++s) {
            if (pos[s] >= 0) {
                const float e = __expf(pm[s] - M);
                den += PL[pos[s]] * e;
#pragma unroll
                for (int dt = 0; dt < 4; ++dt) {
                    const u32x2 pv = *(const u32x2*)(PO + (size_t)pos[s] * 64 + dt * 16 + fq * 4);
                    o[dt].x += e * __uint_as_float(pv.x << 16); o[dt].y += e * __uint_as_float(pv.x & 0xffff0000u);
                    o[dt].z += e * __uint_as_float(pv.y << 16); o[dt].w += e * __uint_as_float(pv.y & 0xffff0000u);
                }
            }
        }
        const float inv = 1.f / den;
#pragma unroll
        for (int dt = 0; dt < 4; ++dt) *(u32x2*)(ob + (size_t)qt * 512 + h * 64 + dt * 16 + fq * 4) = pack4(o[dt] * inv);
        __syncthreads();
    }
}


__device__ __forceinline__ void phase_kvx(const P& p, int bid0, int nb0, char* smem) {
    char* ws = p.ws;
    bf16_t* KX = (bf16_t*)(ws + OFF_KVX); bf16_t* VXT = KX + 256 * 512;
    for (int it = bid0; it < 8; it += nb0) {
        f32x4 acc[2][8];
#pragma unroll
        for (int m = 0; m < 2; ++m)
#pragma unroll
            for (int n = 0; n < 8; ++n) acc[m][n] = (f32x4){0.f, 0.f, 0.f, 0.f};
        gemm_r32(acc, (const bf16_t*)(ws + OFF_MEMN), D, 0, (const bf16_t*)(ws + OFF_WKV), D, it * 128, D, smem);
        const int tid = otid(), lane = tid & 63, w = tid >> 6, fr = lane & 15, fq = lane >> 4;
#pragma unroll
        for (int m = 0; m < 2; ++m) {
            const int row = w * 32 + m * 16 + fr;
#pragma unroll
            for (int n = 0; n < 8; ++n) {
                const f32x4 v = acc[m][n];
                if (it < 4) *(u32x2*)(KX + (size_t)row * 512 + it * 128 + n * 16 + fq * 4) = pack4(v);
                else {
                    const int col = (it - 4) * 128 + n * 16 + fq * 4;
                    VXT[(size_t)(col + 0) * 256 + row] = (bf16_t)f2bf(v.x); VXT[(size_t)(col + 1) * 256 + row] = (bf16_t)f2bf(v.y);
                    VXT[(size_t)(col + 2) * 256 + row] = (bf16_t)f2bf(v.z); VXT[(size_t)(col + 3) * 256 + row] = (bf16_t)f2bf(v.w);
                }
            }
        }
    }
}

__device__ __forceinline__ void phase_qx_xattn(const P& p, int bid, int nb, char* smem) {
    char* ws = p.ws;
    const bf16_t* KX = (const bf16_t*)(ws + OFF_KVX); const bf16_t* VXT = KX + 256 * 512;
    bf16_t* ox = (bf16_t*)(ws + OFF_OB);
    for (int it = bid; it < 256; it += nb) {
        const int pm = it >> 2, h = it & 3;
        bf16x8 qf[2][4];
        {
            f32x4 acc[2][8];
#pragma unroll
            for (int m = 0; m < 2; ++m)
#pragma unroll
                for (int n = 0; n < 8; ++n) acc[m][n] = (f32x4){0.f, 0.f, 0.f, 0.f};
            gemm_r32(acc, (const bf16_t*)(ws + OFF_XN), D, pm * 256, (const bf16_t*)(ws + OFF_WQ), D, h * 128, D, smem);
            const float sc = 0.08838834764831845f;
#pragma unroll
            for (int m = 0; m < 2; ++m)
#pragma unroll
                for (int s2 = 0; s2 < 4; ++s2) qf[m][s2] = pack8(acc[m][2 * s2] * sc, acc[m][2 * s2 + 1] * sc);
        }
        const int tid = otid(), lane = tid & 63, w = tid >> 6, fr = lane & 15, fq = lane >> 4;
        for (int idx = tid; idx < 4096; idx += NT) { const int key = idx >> 4, ch = idx & 15; *(u32x4*)(smem + key * 272 + ch * 16) = *(const u32x4*)(KX + (size_t)key * 512 + h * 128 + ch * 8); }
        __syncthreads();
        bf16x8 pf[2][8]; float inv[2];
#pragma unroll
        for (int m = 0; m < 2; ++m) {
            f32x4 sc[16]; float mx = -3.0e38f;
#pragma unroll
            for (int kt = 0; kt < 16; ++kt) {
                f32x4 a = {0.f, 0.f, 0.f, 0.f};
#pragma unroll
                for (int s2 = 0; s2 < 4; ++s2) a = MFMA16(ldperm(smem + (kt * 16 + fr) * 272, s2, fq), qf[m][s2], a);
                sc[kt] = a; mx = fmaxf(fmaxf(mx, fmaxf(a.x, a.y)), fmaxf(a.z, a.w));
            }
            mx = fmaxf(mx, __shfl_xor(mx, 16)); mx = fmaxf(mx, __shfl_xor(mx, 32));
            float ls = 0.f;
#pragma unroll
            for (int kt = 0; kt < 16; ++kt) { sc[kt].x = __expf(sc[kt].x - mx); sc[kt].y = __expf(sc[kt].y - mx); sc[kt].z = __expf(sc[kt].z - mx); sc[kt].w = __expf(sc[kt].w - mx); ls += (sc[kt].x + sc[kt].y) + (sc[kt].z + sc[kt].w); }
            ls += __shfl_xor(ls, 16); ls += __shfl_xor(ls, 32);
            inv[m] = 1.f / ls;
#pragma unroll
            for (int s2 = 0; s2 < 8; ++s2) { pf[m][s2] = pack8(sc[2 * s2], sc[2 * s2 + 1]); asm volatile("" : "+v"(pf[m][s2])); }
            asm volatile("" ::: "memory");
        }
        __syncthreads();
        for (int idx = tid; idx < 4096; idx += NT) { const int d = idx >> 5, ch = idx & 31; *(u32x4*)(smem + d * 528 + ch * 16) = *(const u32x4*)(VXT + (size_t)(h * 128 + d) * 256 + ch * 8); }
        __syncthreads();
#pragma unroll
        for (int m = 0; m < 2; ++m) {
            const int row = pm * 256 + w * 32 + m * 16 + fr;
#pragma unroll
            for (int dt = 0; dt < 8; ++dt) {
                f32x4 o = {0.f, 0.f, 0.f, 0.f};
#pragma unroll
                for (int s2 = 0; s2 < 8; ++s2) o = MFMA16(ldperm(smem + (dt * 16 + fr) * 528, s2, fq), pf[m][s2], o);
                *(u32x2*)(ox + (size_t)row * 512 + h * 128 + dt * 16 + fq * 4) = pack4(o * inv[m]);
                asm volatile("" ::: "memory");
            }
        }
        __syncthreads();
    }
}

struct EpiMergeA {
    static constexpr bool PERM = true;
    char* ws;
    __device__ __forceinline__ void operator()(const f32x4 (&acc)[2][2][4][2], const pg8::Unit& u, int wr, int wc, int fr, int fq) const {
        const bf16_t* ug = (const bf16_t*)(ws + OFF_UG); bf16_t* mg = (bf16_t*)(ws + OFF_MRG);
        const int row0 = u.pm * 256 + wr * 64 + fr, col0 = u.pn * 256 + wc * 32 + 8 * fq;
#pragma unroll
        for (int ai = 0; ai < 2; ++ai)
#pragma unroll
            for (int m = 0; m < 4; ++m) {
                const size_t row = row0 + ai * 128 + m * 16;
#pragma unroll
                for (int bj = 0; bj < 2; ++bj) {
                    const int col = col0 + bj * 128;
                    float g[8]; unpack8(*(const u32x4*)(ug + row * GCOLS + col), g);
                    const f32x4 a = acc[ai][bj][m][0], b = acc[ai][bj][m][1];
                    u32x4 w; w.x = cvt_pk(g[0] * a.x, g[1] * a.y); w.y = cvt_pk(g[2] * a.z, g[3] * a.w); w.z = cvt_pk(g[4] * b.x, g[5] * b.y); w.w = cvt_pk(g[6] * b.z, g[7] * b.w);
                    *(u32x4*)(mg + row * D + col) = w;
                }
            }
    }
};
struct EpiMergeB {
    static constexpr bool PERM = true;
    char* ws;
    __device__ __forceinline__ void operator()(const f32x4 (&acc)[2][2][4][2], const pg8::Unit& u, int wr, int wc, int fr, int fq) const {
        const bf16_t* ug = (const bf16_t*)(ws + OFF_UG); bf16_t* mg = (bf16_t*)(ws + OFF_MRG);
        const int row0 = u.pm * 256 + wr * 64 + fr, col0 = u.pn * 256 + wc * 32 + 8 * fq;
#pragma unroll
        for (int ai = 0; ai < 2; ++ai)
#pragma unroll
            for (int m = 0; m < 4; ++m) {
                const size_t row = row0 + ai * 128 + m * 16;
#pragma unroll
                for (int bj = 0; bj < 2; ++bj) {
                    const int col = col0 + bj * 128;
                    float g[8], t[8]; unpack8(*(const u32x4*)(ug + row * GCOLS + 1024 + col), g); unpack8(*(const u32x4*)(mg + row * D + col), t);
                    const f32x4 a = acc[ai][bj][m][0], b = acc[ai][bj][m][1];
                    u32x4 w; w.x = cvt_pk(t[0] + g[0] * a.x, t[1] + g[1] * a.y); w.y = cvt_pk(t[2] + g[2] * a.z, t[3] + g[3] * a.w);
                    w.z = cvt_pk(t[4] + g[4] * b.x, t[5] + g[5] * b.y); w.w = cvt_pk(t[6] + g[6] * b.z, t[7] + g[7] * b.w);
                    *(u32x4*)(mg + row * D + col) = w;
                }
            }
    }
};
__device__ __forceinline__ void phase_merge(const P& p, int bid, int nb, char* smem) {
    pg8::StaticOrder S; S.init(T, D, nb, bid);
    EpiMergeA EA{p.ws}; EpiMergeB EB{p.ws};
    pg8::gemm_phase<EpiMergeA, pg8::StaticOrder, true>((LAS unsigned char*)smem, (const bf16_t*)(p.ws + OFF_OA), (const bf16_t*)(p.ws + OFF_WORW), 512, S, EA);
    pg8::gemm_phase<EpiMergeB, pg8::StaticOrder, true>((LAS unsigned char*)smem, (const bf16_t*)(p.ws + OFF_OB), (const bf16_t*)(p.ws + OFF_WOMB), 512, S, EB);
}
struct EpiResid {
    static constexpr bool PERM = false;
    const float* res; float* out;
    __device__ __forceinline__ void operator()(const f32x4 (&acc)[2][2][4][2], const pg8::Unit& u, int wr, int wc, int fr, int fq) const {
        const int row0 = u.pm * 256 + wr * 64 + fr, col0 = u.pn * 256 + wc * 32 + 4 * fq;
#pragma unroll
        for (int ai = 0; ai < 2; ++ai)
#pragma unroll
            for (int m = 0; m < 4; ++m) {
                const size_t off = (size_t)(row0 + ai * 128 + m * 16) * D + col0;
#pragma unroll
                for (int bj = 0; bj < 2; ++bj)
#pragma unroll
                    for (int n = 0; n < 2; ++n) { const f32x4 r = *(const f32x4*)(res + off + bj * 128 + n * 16); *(f32x4*)(out + off + bj * 128 + n * 16) = r + acc[ai][bj][m][n]; }
            }
    }
};
__device__ __forceinline__ void phase_resid_gemm(const bf16_t* A, int K, const bf16_t* Bt, const float* res, float* dst, int bid, int nb, char* smem) {
    pg8::StaticOrder S; S.init(T, D, nb, bid);
    EpiResid E{res, dst};
    pg8::gemm_phase<EpiResid, pg8::StaticOrder, true>((LAS unsigned char*)smem, A, Bt, K, S, E);
}
__device__ __forceinline__ void phase_norm(const float* src, const float* g, bf16_t* dst, int bid, int nb) {
    const int lane = otid() & 63, wid = otid() >> 6;
    for (int it = bid; it < T / 8; it += nb) { const int row = it * 8 + wid; rms_row_bf16(src + (size_t)row * D, g, dst + (size_t)row * D, lane); }
}
__device__ __forceinline__ void phase_expconv(const P& p, int bid, int nb, char* smem) {
    float* scr = (float*)smem;
    bf16_t* gu = (bf16_t*)(p.ws + OFF_EXPGU); bf16_t* dn = (bf16_t*)(p.ws + OFF_EXPD);
    for (int it = bid; it < 3 * 32 * 64; it += nb) {
        const int which = it / 2048, r = it % 2048, e = r >> 6, tile = r & 63;
        if (which == 0) transpose_tile(p.w_exp_gate + (size_t)e * D * DEXP, D, DEXP, gu + (size_t)e * D * D, 32, 0, tile, scr);
        else if (which == 1) transpose_tile(p.w_exp_up + (size_t)e * D * DEXP, D, DEXP, gu + (size_t)e * D * D, 32, 16, tile, scr);
        else transpose_tile(p.w_exp_down + (size_t)e * DEXP * D, DEXP, D, dn + (size_t)e * D * DEXP, 16, 0, tile, scr);
    }
}

__device__ __forceinline__ void phase_router(const P& p, int bid, int nb, char* smem) {
    const int tid = otid(), lane = tid & 63, wid = tid >> 6;
    char* ws = p.ws;
    int* hist = (int*)smem;
    if (tid < 32) hist[tid] = 0;
    __syncthreads();
    const float* x2 = p.out;
    const float* rt = (const float*)(ws + OFF_ROUT);
    bf16_t* xn = (bf16_t*)(ws + OFF_XN);
    int* toke = (int*)(ws + OFF_CTL + CTL_TOKE); float* tokg = (float*)(ws + OFF_CTL + CTL_TOKG);
    int* rowtok = (int*)(ws + OFF_CTL + CTL_ROWTOK);
    for (int i = bid * NT + tid; i < CAP; i += nb * NT) rowtok[i] = 0;
    for (int it = bid; it < T / 32; it += nb) {
        const int rbase = it * 32 + wid * 4;
        f32x4 hv[4][4];
#pragma unroll
        for (int rr = 0; rr < 4; ++rr) {
            const f32x4* xr = (const f32x4*)(x2 + (size_t)(rbase + rr) * D) + lane; const f32x4* gr = (const f32x4*)p.norm_ffn + lane;
            float s = 0.f;
#pragma unroll
            for (int j = 0; j < 4; ++j) { hv[rr][j] = xr[64 * j]; s += hv[rr][j].x * hv[rr][j].x + hv[rr][j].y * hv[rr][j].y + hv[rr][j].z * hv[rr][j].z + hv[rr][j].w * hv[rr][j].w; }
            const float rstd = rsqrtf(wave_sum(s) * (1.f / 1024.f) + 1e-6f);
            u32x2* o8 = (u32x2*)(xn + (size_t)(rbase + rr) * D) + lane;
#pragma unroll
            for (int j = 0; j < 4; ++j) { const f32x4 gg = gr[64 * j]; hv[rr][j] = hv[rr][j] * rstd * gg; o8[64 * j] = pack4(hv[rr][j]); }
        }
        float mine[4] = {0.f, 0.f, 0.f, 0.f};
#pragma unroll 4
        for (int o = 0; o < 36; ++o) {
            const f32x4* wr_ = (const f32x4*)(rt + o * 1024) + lane;
            f32x4 w[4];
#pragma unroll
            for (int j = 0; j < 4; ++j) w[j] = wr_[64 * j];
#pragma unroll
            for (int rr = 0; rr < 4; ++rr) {
                float s = 0.f;
#pragma unroll
                for (int j = 0; j < 4; ++j) s += hv[rr][j].x * w[j].x + hv[rr][j].y * w[j].y + hv[rr][j].z * w[j].z + hv[rr][j].w * w[j].w;
                s = wave_sum(s);
                if (lane == o) mine[rr] = s;
            }
            asm volatile("" ::: "memory");
        }
#pragma unroll
        for (int rr = 0; rr < 4; ++rr) {
            const float g0 = __shfl(mine[rr], 32), g1 = __shfl(mine[rr], 33), g2 = __shfl(mine[rr], 34), g3 = __shfl(mine[rr], 35);
            int gs = 0; float gm = g0;
            if (g1 > gm) { gm = g1; gs = 1; }
            if (g2 > gm) { gm = g2; gs = 2; }
            if (g3 > gm) { gm = g3; gs = 3; }
            const float gp = 1.f / (__expf(g0 - gm) + __expf(g1 - gm) + __expf(g2 - gm) + __expf(g3 - gm));
            float e[8];
#pragma unroll
            for (int i = 0; i < 8; ++i) e[i] = __shfl(mine[rr], gs * 8 + i);
            int i1 = 0; float v1 = e[0];
#pragma unroll
            for (int i = 1; i < 8; ++i) if (e[i] > v1) { v1 = e[i]; i1 = i; }
            int i2 = -1; float v2 = -3.0e38f;
#pragma unroll
            for (int i = 0; i < 8; ++i) if (i != i1 && e[i] > v2) { v2 = e[i]; i2 = i; }
            const float e2 = __expf(v2 - v1), den = 1.f / (1.f + e2);
            if (lane == 0) {
                const int tok = rbase + rr;
                toke[tok * 2] = gs * 8 + i1; toke[tok * 2 + 1] = gs * 8 + i2;
                tokg[tok * 2] = gp * den; tokg[tok * 2 + 1] = gp * e2 * den;
                atomicAdd(&hist[gs * 8 + i1], 1); atomicAdd(&hist[gs * 8 + i2], 1);
            }
        }
    }
    __syncthreads();
    if (tid < 32 && hist[tid]) atomicAdd((int*)(ws + OFF_CTL + CTL_CNT) + tid, hist[tid]);
}
__device__ __forceinline__ void phase_dispatch(const P& p, int bid, int nb, char* smem) {
    const int tid = otid();
    char* ws = p.ws;
    int* pstart = (int*)smem;
    const int* counts = (const int*)(ws + OFF_CTL + CTL_CNT);
    int* cursor = (int*)(ws + OFF_CTL + CTL_CNT) + 32;
    if (tid == 0) { int a = 0; for (int e = 0; e < 32; ++e) { pstart[e] = a; a += (counts[e] + MBLK - 1) / MBLK * MBLK; } pstart[32] = a; }
    __syncthreads();
    const int* toke = (const int*)(ws + OFF_CTL + CTL_TOKE);
    int* toks = (int*)(ws + OFF_CTL + CTL_TOKS); int* rowtok = (int*)(ws + OFF_CTL + CTL_ROWTOK);
    for (int i = bid * NT + tid; i < T * 2; i += nb * NT) {
        const int e = toke[i];
        const int pos = pstart[e] + atomicAdd(&cursor[e], 1);
        rowtok[pos] = i >> 1; toks[i] = pos;
    }
    if (bid == 0) {
        int* blke = (int*)(ws + OFF_CTL + CTL_BLKE);
        for (int b = tid; b < NBLK; b += NT) {
            const int r = b * MBLK; int e = -1;
            if (r < pstart[32]) { e = 0; while (pstart[e + 1] <= r) ++e; }
            blke[b] = e;
        }
        if (tid == 0) blke[NBLK] = pstart[32] / MBLK;
    }
}
struct MoeOrder {
    const int* blke; const int* rowtok; int nunits, G, c; bool gather; int brows;
    __device__ bool next(int i, pg8::Unit& u) const {
        const int L = i * G + c; if (L >= nunits) return false;
        u.pm = L >> 2; u.pn = L & 3; u.e = blke[u.pm]; return true;
    }
    __device__ __forceinline__ unsigned rowA(const pg8::Unit& u, int r) const { return gather ? (unsigned)rowtok[u.pm * MBLK + r] : (unsigned)(u.pm * MBLK + r); }
    __device__ __forceinline__ unsigned rowB(const pg8::Unit& u, int r) const { return (unsigned)(u.e * brows + u.pn * 256 + r); }
};
struct EpiHid {
    static constexpr bool PERM = false;
    bf16_t* hid;
    __device__ __forceinline__ void operator()(const f32x4 (&acc)[2][2][4][2], const pg8::Unit& u, int wr, int wc, int fr, int fq) const {
        const int row0 = u.pm * 256 + wr * 64 + fr, col0 = u.pn * 128 + wc * 16 + 4 * fq;
#pragma unroll
        for (int ai = 0; ai < 2; ++ai)
#pragma unroll
            for (int m = 0; m < 4; ++m) {
                bf16_t* rowp = hid + (size_t)(row0 + ai * 128 + m * 16) * DEXP + col0;
#pragma unroll
                for (int bj = 0; bj < 2; ++bj) {
                    const f32x4 g = acc[ai][bj][m][0], uu = acc[ai][bj][m][1];
                    f32x4 hval; hval.x = g.x * sigm(g.x) * uu.x; hval.y = g.y * sigm(g.y) * uu.y; hval.z = g.z * sigm(g.z) * uu.z; hval.w = g.w * sigm(g.w) * uu.w;
                    *(u32x2*)(rowp + bj * 64) = pack4(hval);
                }
            }
    }
};
struct EpiY {
    static constexpr bool PERM = true;
    bf16_t* ym;
    __device__ __forceinline__ void operator()(const f32x4 (&acc)[2][2][4][2], const pg8::Unit& u, int wr, int wc, int fr, int fq) const {
        const int row0 = u.pm * 256 + wr * 64 + fr, col0 = u.pn * 256 + wc * 32 + 8 * fq;
#pragma unroll
        for (int ai = 0; ai < 2; ++ai)
#pragma unroll
            for (int m = 0; m < 4; ++m) {
                bf16_t* rowp = ym + (size_t)(row0 + ai * 128 + m * 16) * D + col0;
#pragma unroll
                for (int bj = 0; bj < 2; ++bj) {
                    const f32x4 v0 = acc[ai][bj][m][0], v1 = acc[ai][bj][m][1];
                    u32x4 w; w.x = cvt_pk(v0.x, v0.y); w.y = cvt_pk(v0.z, v0.w); w.z = cvt_pk(v1.x, v1.y); w.w = cvt_pk(v1.z, v1.w);
                    *(u32x4*)(rowp + bj * 128) = w;
                }
            }
    }
};
__device__ __forceinline__ void phase_exp1(const P& p, int bid, int nb, char* smem) {
    char* ws = p.ws;
    const int* blke = (const int*)(ws + OFF_CTL + CTL_BLKE);
    MoeOrder S{blke, (const int*)(ws + OFF_CTL + CTL_ROWTOK), blke[NBLK] * 4, nb, bid, true, 1024};
    EpiHid E{(bf16_t*)(ws + OFF_MRG)};
    pg8::gemm_phase<EpiHid, MoeOrder, true>((LAS unsigned char*)smem, (const bf16_t*)(ws + OFF_XN), (const bf16_t*)(ws + OFF_EXPGU), D, S, E);
}
__device__ __forceinline__ void phase_exp2(const P& p, int bid, int nb, char* smem) {
    char* ws = p.ws;
    const int* blke = (const int*)(ws + OFF_CTL + CTL_BLKE);
    MoeOrder S{blke, nullptr, blke[NBLK] * 4, nb, bid, false, 1024};
    EpiY E{(bf16_t*)(ws + OFF_YMOE)};
    pg8::gemm_phase<EpiY, MoeOrder, true>((LAS unsigned char*)smem, (const bf16_t*)(ws + OFF_MRG), (const bf16_t*)(ws + OFF_EXPD), DEXP, S, E);
}
__device__ __forceinline__ void phase_final(const P& p, int bid, int nb) {
    const int lane = otid() & 63, wid = otid() >> 6;
    char* ws = p.ws;
    const int* toks = (const int*)(ws + OFF_CTL + CTL_TOKS); const float* tokg = (const float*)(ws + OFF_CTL + CTL_TOKG);
    const bf16_t* ym = (const bf16_t*)(ws + OFF_YMOE);
    for (int it = bid; it < T / 8; it += nb) {
        const int row = it * 8 + wid;
        const int s1 = toks[row * 2], s2 = toks[row * 2 + 1]; const float g1 = tokg[row * 2], g2 = tokg[row * 2 + 1];
        f32x4* xr = (f32x4*)(p.out + (size_t)row * D) + lane; const f32x4* gr = (const f32x4*)p.norm_final + lane;
        const u32x2* y1 = (const u32x2*)(ym + (size_t)s1 * D) + lane; const u32x2* y2 = (const u32x2*)(ym + (size_t)s2 * D) + lane;
        f32x4 v[4]; float s = 0.f;
#pragma unroll
        for (int j = 0; j < 4; ++j) {
            v[j] = xr[64 * j] + g1 * unpack4(y1[64 * j]) + g2 * unpack4(y2[64 * j]);
            s += v[j].x * v[j].x + v[j].y * v[j].y + v[j].z * v[j].z + v[j].w * v[j].w;
        }
        const float rstd = rsqrtf(wave_sum(s) * (1.f / 1024.f) + 1e-6f);
#pragma unroll
        for (int j = 0; j < 4; ++j) xr[64 * j] = v[j] * rstd * gr[64 * j];
    }
}

template <int PH>
__device__ __forceinline__ void run_phase(const P& p, int bid, int nb, char* smem) {
    char* ws = p.ws;
    if (PH == 0) phase0(p, bid, nb, smem);
    else if (PH == 1) phase1(p, bid, nb, smem);
    else if (PH == 2) { phase_kmean(p, bid, nb, smem); phase_rw_chunk(p, bid, nb, smem); }
    else if (PH == 3) {
        if (bid < 32) { if ((otid() >> 6) == 0) rw_scan(p, bid); }
        else { moba_select(p, bid - 32, nb - 32, smem); phase_kvx(p, bid - 32, nb - 32, smem); }
    }
    else if (PH == 4) { phase_rw_out(p, bid, nb); moba_fill(p, bid, nb, smem); __syncthreads(); phase_vtrans(p, bid, nb, smem); }
    else if (PH == 5) moba_partial(p, bid, nb, smem);
    else if (PH == 6) moba_own(p, bid, nb, smem);
    else if (PH == 7) phase_merge(p, bid, nb, smem);
    else if (PH == 8) phase_resid_gemm((const bf16_t*)(ws + OFF_MRG), D, (const bf16_t*)(ws + OFF_WOUT), p.x, p.out, bid, nb, smem);
    else if (PH == 9) { phase_norm(p.out, p.norm_xattn, (bf16_t*)(ws + OFF_XN), bid, nb); phase_expconv(p, bid, nb, smem); }
    else if (PH == 10) phase_qx_xattn(p, bid, nb, smem);
    else if (PH == 11) phase_resid_gemm((const bf16_t*)(ws + OFF_OB), 512, (const bf16_t*)(ws + OFF_WOX), p.out, p.out, bid, nb, smem);
    else if (PH == 12) phase_router(p, bid, nb, smem);
    else if (PH == 13) phase_dispatch(p, bid, nb, smem);
    else if (PH == 14) phase_exp1(p, bid, nb, smem);
    else if (PH == 15) phase_exp2(p, bid, nb, smem);
    else if (PH == 16) phase_final(p, bid, nb);
}

#define XB_TMO      128
#define XB_XCNT(j)  (256  + 64 * (j))
#define XB_XSUB(j)  (1280 + 64 * (j))
#define XB_XGEN(j)  (2304 + 64 * (j))
#define XB_TOP      3328
#define XB_TOPGEN   3392
#define XCD_BAR_WORDS 3456
#define XB_SPIN_CAP (1u << 18)
__device__ __forceinline__ unsigned xb_ld(unsigned* p)              { return __hip_atomic_load(p, __ATOMIC_RELAXED, __HIP_MEMORY_SCOPE_AGENT); }
__device__ __forceinline__ unsigned xb_add(unsigned* p, unsigned v) { return __hip_atomic_fetch_add(p, v, __ATOMIC_RELAXED, __HIP_MEMORY_SCOPE_AGENT); }
__device__ __forceinline__ unsigned xb_xcc_id() { return (unsigned)__builtin_amdgcn_s_getreg((3 << 11) | 20) & 0xFu; }
#define XB_SPIN(cond, bar) do { unsigned _sp = 0; while (cond) { __builtin_amdgcn_s_sleep(1); \
    if ((++_sp & 255u) == 0u) { if (xb_ld(&(bar)[XB_TMO])) break; if (_sp > XB_SPIN_CAP) { atomicAdd(&(bar)[XB_TMO], 1u); break; } } } } while (0)
struct XcdBarrier { unsigned* bar; unsigned x; volatile LAS unsigned* st; };
__device__ __forceinline__ XcdBarrier xcd_barrier_post(unsigned* bar, volatile LAS unsigned* st) {
    XcdBarrier b; b.bar = bar; b.x = xb_xcc_id(); b.st = st;
    if (threadIdx.x == 0) (void)xb_add(&bar[XB_XCNT(b.x)], 1u);
    return b;
}
__device__ __forceinline__ void xcd_barrier_complete(unsigned* bar, unsigned x, unsigned& nloc, unsigned& nx) {
    const unsigned G = gridDim.x * gridDim.y * gridDim.z;
    unsigned sum, cnt, mine, sp = 0u;
    for (;;) {
        sum = 0u; cnt = 0u; mine = 0u;
#pragma unroll
        for (unsigned j = 0; j < 16; ++j) { const unsigned c = xb_ld(&bar[XB_XCNT(j)]); sum += c; cnt += (c > 0u) ? 1u : 0u; mine = (j == x) ? c : mine; }
        if (sum == G) break;
        __builtin_amdgcn_s_sleep(1);
        if ((++sp & 255u) == 0u) { if (xb_ld(&bar[XB_TMO])) break; if (sp > XB_SPIN_CAP) { atomicAdd(&bar[XB_TMO], 1u); break; } }
    }
    nloc = mine > 0u ? mine : 1u; nx = cnt > 0u ? cnt : 1u;
}
__device__ __forceinline__ void xcd_barrier(const XcdBarrier& b) {
    asm volatile("s_waitcnt vmcnt(0)" ::: "memory");
    __syncthreads();
    if (threadIdx.x == 0) {
        unsigned* bar = b.bar;
        __builtin_amdgcn_s_waitcnt(0);
        unsigned nloc = b.st[0], nx = b.st[1];
        if (nloc == 0u) { xcd_barrier_complete(bar, b.x, nloc, nx); b.st[0] = nloc; b.st[1] = nx; }
        const unsigned old = xb_add(&bar[XB_XSUB(b.x)], 1u);
        const unsigned gen = old / nloc;
        if (old + 1u == (gen + 1u) * nloc) {
            __builtin_amdgcn_fence(__ATOMIC_RELEASE, "agent");
            asm volatile("s_waitcnt vmcnt(0)" ::: "memory");
            const unsigned og = xb_add(&bar[XB_TOP], 1u);
            const unsigned tg = og / nx;
            if (og + 1u == (tg + 1u) * nx) xb_add(&bar[XB_TOPGEN], 1u);
            else XB_SPIN(xb_ld(&bar[XB_TOPGEN]) == tg, bar);
            __builtin_amdgcn_fence(__ATOMIC_ACQUIRE, "agent");
            xb_add(&bar[XB_XGEN(b.x)], 1u);
            asm volatile("s_waitcnt vmcnt(0)" ::: "memory");
        } else {
            XB_SPIN(xb_ld(&bar[XB_XGEN(b.x)]) == gen, bar);
            __builtin_amdgcn_fence(__ATOMIC_ACQUIRE, "agent");
            asm volatile("s_waitcnt vmcnt(0)" ::: "memory");
        }
    }
    __syncthreads();
}
constexpr int L_BARST = 150016;
constexpr int LDS_BYTES = 150528;
static_assert(2 * RW_LDS <= L_BARST && pg8::STAGE_BYTES <= L_BARST && A_TST + 2052 <= L_BARST, "lds");

__global__ void __launch_bounds__(NT, 2) mega_kernel(P p) {
    extern __shared__ __attribute__((aligned(16))) char smem[];
    const int bid = blockIdx.x, nb = gridDim.x;
    volatile LAS unsigned* bst = (volatile LAS unsigned*)(LAS char*)(smem + L_BARST);
    if (threadIdx.x < 2) bst[threadIdx.x] = 0u;
    __syncthreads();
    const XcdBarrier xb = xcd_barrier_post((unsigned*)(p.ws + OFF_CTL + CTL_BAR), bst);
#define GSYNC() xcd_barrier(xb)
    run_phase<0>(p, bid, nb, smem); GSYNC();
    run_phase<1>(p, bid, nb, smem); GSYNC();
    run_phase<2>(p, bid, nb, smem); GSYNC();
    run_phase<3>(p, bid, nb, smem); GSYNC();
    run_phase<4>(p, bid, nb, smem); GSYNC();
    run_phase<5>(p, bid, nb, smem); GSYNC();
    run_phase<6>(p, bid, nb, smem); GSYNC();
    run_phase<7>(p, bid, nb, smem); GSYNC();
    run_phase<8>(p, bid, nb, smem); GSYNC();
    run_phase<9>(p, bid, nb, smem); GSYNC();
    run_phase<10>(p, bid, nb, smem); GSYNC();
    run_phase<11>(p, bid, nb, smem); GSYNC();
    run_phase<12>(p, bid, nb, smem); GSYNC();
    run_phase<13>(p, bid, nb, smem); GSYNC();
    run_phase<14>(p, bid, nb, smem); GSYNC();
    run_phase<15>(p, bid, nb, smem); GSYNC();
    run_phase<16>(p, bid, nb, smem);
}

extern "C" void kernel_launch(void* const* d_in, const int* in_sizes, int n_in, void* d_out, int out_size, void* d_ws, size_t ws_size, hipStream_t stream) {
    if (n_in != 31 || ws_size < WS_NEED || out_size != T * D) { fprintf(stderr, "kernel_launch: unexpected n_in %d / ws_size %zu / out_size %d\n", n_in, ws_size, out_size); return; }
    static int grid_blocks = 0;
    if (!grid_blocks) {
        int dev = 0, cus = 0, per_cu = 0;
        (void)hipGetDevice(&dev);
        (void)hipDeviceGetAttribute(&cus, hipDeviceAttributeMultiprocessorCount, dev);
        if (hipFuncSetAttribute((const void*)mega_kernel, hipFuncAttributeMaxDynamicSharedMemorySize, LDS_BYTES) != hipSuccess) fprintf(stderr, "kernel_launch: hipFuncSetAttribute failed\n");
        (void)hipOccupancyMaxActiveBlocksPerMultiprocessor(&per_cu, (const void*)mega_kernel, NT, LDS_BYTES);
        if (per_cu < 1) { fprintf(stderr, "kernel_launch: occupancy query returned %d\n", per_cu); per_cu = 1; }
        grid_blocks = cus;
        if (grid_blocks % 8) grid_blocks -= grid_blocks % 8;
        fprintf(stderr, "kernel_launch: cus %d per_cu %d grid %d\n", cus, per_cu, grid_blocks);
    }
    P p{};
    const float** f = (const float**)&p;
    for (int i = 0; i < 31; ++i) f[i] = (const float*)d_in[i];
    p.out = (float*)d_out; p.ws = (char*)d_ws;
    if (hipMemsetAsync((char*)d_ws + OFF_CTL + CTL_BAR, 0, XCD_BAR_WORDS * 4, stream) != hipSuccess) fprintf(stderr, "kernel_launch: memset failed\n");
    void* args[] = {&p};
    hipError_t e = hipLaunchCooperativeKernel((const void*)mega_kernel, dim3(grid_blocks), dim3(NT), args, LDS_BYTES, stream);
    if (e != hipSuccess) fprintf(stderr, "cooperative launch failed: %s (grid %d)\n", hipGetErrorString(e), grid_blocks);
}
```

```cpp
#include <hip/hip_runtime.h>
#include <cstdio>
#include <cstdint>

typedef unsigned short bf16_t;
typedef short bf16x8 __attribute__((ext_vector_type(8)));
typedef float f32x4 __attribute__((ext_vector_type(4)));
typedef float f32x2 __attribute__((ext_vector_type(2)));
typedef unsigned u32x4 __attribute__((ext_vector_type(4)));
typedef unsigned u32x2 __attribute__((ext_vector_type(2)));
typedef __bf16 bf16x2_t __attribute__((ext_vector_type(2)));
#define LAS __attribute__((address_space(3)))
#define MFMA16(a, b, c) __builtin_amdgcn_mfma_f32_16x16x32_bf16((a), (b), (c), 0, 0, 0)

constexpr int NT = 512;
constexpr int T = 16384, D = 1024, NMEM = 256;
constexpr int UMC = 1536;
constexpr int RW = 512, RCOLS = 1792, MW = 512, MCOLS = 1536, GCOLS = 2048, INCOLS = 5376;
constexpr int NEXP = 32, DEXP = 512, MBLK = 256, NBLK = 160, CAP = NBLK * MBLK;
constexpr size_t MiB = 1u << 20;
constexpr size_t OFF_CTL = 0;
constexpr size_t OFF_WIN = 1 * MiB;
constexpr size_t OFF_WORW = OFF_WIN + (size_t)INCOLS * D * 2;
constexpr size_t OFF_WOMB = OFF_WORW + 1 * MiB;
constexpr size_t OFF_WOUT = OFF_WOMB + 1 * MiB;
constexpr size_t OFF_WQ = OFF_WOUT + 2 * MiB;
constexpr size_t OFF_WKV = OFF_WQ + 1 * MiB;
constexpr size_t OFF_WOX = OFF_WKV + 2 * MiB;
constexpr size_t OFF_MEMN = OFF_WOX + 1 * MiB;
constexpr size_t OFF_KVX = OFF_MEMN + MiB / 2;
constexpr size_t OFF_ROUT = OFF_KVX + MiB / 2;
constexpr size_t OFF_LORA_D = OFF_ROUT + 160 * 1024;
constexpr size_t OFF_LORA_I = OFF_LORA_D + 64 * 1024;
constexpr size_t OFF_LORA_G = OFF_LORA_I + 64 * 1024;
constexpr size_t OFF_XN = 21 * MiB;
constexpr size_t OFF_BON = 21 * MiB;
constexpr size_t OFF_RH = 37 * MiB;
constexpr size_t OFF_UG = 53 * MiB;
constexpr size_t OFF_UR = 117 * MiB;
constexpr size_t OFF_UM = 173 * MiB;
constexpr size_t OFF_OA = 221 * MiB;
constexpr size_t OFF_OB = 237 * MiB;
constexpr size_t OFF_MRG = 253 * MiB;
constexpr size_t OFF_MF = 253 * MiB;
constexpr size_t OFF_SF = 269 * MiB;
constexpr size_t OFF_VT = 253 * MiB;
constexpr size_t OFF_EXPGU = 117 * MiB;
constexpr size_t OFF_EXPD = 181 * MiB;
constexpr size_t OFF_YMOE = 21 * MiB;
constexpr size_t OFF_MSEL = 285 * MiB;
constexpr size_t OFF_MQL = OFF_MSEL + MiB / 2;
constexpr size_t OFF_MSP = OFF_MQL + 3 * MiB / 2;
constexpr size_t WS_NEED = 293 * MiB;
static_assert(OFF_LORA_G + 128 * 1024 <= OFF_XN, "ws map");
constexpr size_t CTL_CNT = 0;
constexpr size_t CTL_BLKE = 4096;
constexpr size_t CTL_MCNT = 8192, CTL_MCUR = 10240, CTL_MLST = 12288, CTL_MTST = 14592;
constexpr size_t CTL_TOKE = 192 * 1024;
constexpr size_t CTL_TOKG = 320 * 1024;
constexpr size_t CTL_TOKS = 448 * 1024;
constexpr size_t CTL_ROWTOK = 576 * 1024;
constexpr size_t CTL_BAR = 752 * 1024;
constexpr size_t CTL_KMB = 768 * 1024;

struct P {
    const float *x, *mem, *rel_bias, *mem_norm, *norm_mix, *w_in, *tshift_mu, *decay_w0, *decay_up, *iclr_a0, *iclr_up, *gate_up,
        *k_k, *k_a, *r_k, *ln_x_w, *ln_x_b, *w_o_rwkv, *w_o_moba, *w_out, *norm_xattn, *w_q_x, *w_kv_x, *w_o_x, *norm_ffn,
        *w_router_group, *w_router_expert, *w_exp_gate, *w_exp_up, *w_exp_down, *norm_final;
    float* out;
    char* ws;
};

__device__ __forceinline__ int otid() { int t = threadIdx.x; asm volatile("" : "+v"(t)); return t; }
__device__ __forceinline__ float bf2f(bf16_t b) { return __uint_as_float((unsigned)b << 16); }
__device__ __forceinline__ unsigned f2bf(float f) { unsigned u = __float_as_uint(f); return (u + 0x7fffu + ((u >> 16) & 1u)) >> 16; }
__device__ __forceinline__ unsigned cvt_pk(float lo, float hi) { const f32x2 v = {lo, hi}; return __builtin_bit_cast(unsigned, __builtin_convertvector(v, bf16x2_t)); }
__device__ __forceinline__ unsigned pk2(float lo, float hi) { return cvt_pk(lo, hi); }
__device__ __forceinline__ u32x2 pack4(f32x4 v) { u32x2 o; o.x = cvt_pk(v.x, v.y); o.y = cvt_pk(v.z, v.w); return o; }
__device__ __forceinline__ bf16x8 pack8(f32x4 a, f32x4 b) { u32x4 o; o.x = cvt_pk(a.x, a.y); o.y = cvt_pk(a.z, a.w); o.z = cvt_pk(b.x, b.y); o.w = cvt_pk(b.z, b.w); return __builtin_bit_cast(bf16x8, o); }
__device__ __forceinline__ bf16x8 ldperm(const char* rowbase, int ks, int fq) {
    const u32x2 a = *(const u32x2*)(rowbase + (32 * ks + fq * 4) * 2), b = *(const u32x2*)(rowbase + (32 * ks + 16 + fq * 4) * 2);
    u32x4 o; o.x = a.x; o.y = a.y; o.z = b.x; o.w = b.y; return __builtin_bit_cast(bf16x8, o);
}
__device__ __forceinline__ float wave_sum(float v) {
#pragma unroll
    for (int o = 32; o >= 1; o >>= 1) v += __shfl_xor(v, o);
    return v;
}
__device__ __forceinline__ float sigm(float x) { return __builtin_amdgcn_rcpf(1.f + __expf(-x)); }
__device__ __forceinline__ void unpack8(u32x4 w, float* f) {
    f[0] = __uint_as_float(w.x << 16); f[1] = __uint_as_float(w.x & 0xffff0000u);
    f[2] = __uint_as_float(w.y << 16); f[3] = __uint_as_float(w.y & 0xffff0000u);
    f[4] = __uint_as_float(w.z << 16); f[5] = __uint_as_float(w.z & 0xffff0000u);
    f[6] = __uint_as_float(w.w << 16); f[7] = __uint_as_float(w.w & 0xffff0000u);
}
__device__ __forceinline__ f32x4 unpack4(u32x2 w) { f32x4 r; r.x = __uint_as_float(w.x << 16); r.y = __uint_as_float(w.x & 0xffff0000u); r.z = __uint_as_float(w.y << 16); r.w = __uint_as_float(w.y & 0xffff0000u); return r; }

namespace pg8 {
constexpr int BM = 256, BK = 64, HALF = 128, HTB = HALF * BK * 2  , STAGE_BYTES = 8 * HTB, NXCD = 8, WGM = 8;
__device__ __forceinline__ int lds_byte(int r, int c) { const int st = (r >> 4) * 2 + (c >> 5), rr = r & 15, cc = c & 31, ob = rr * 64 + cc * 2; return st * 1024 + (ob ^ (((ob >> 9) & 1) << 5)); }
__device__ __forceinline__ void stage_rc(int b, int& R, int& C) { const int st = b / 1024, sb = b % 1024, swz = sb ^ (((sb >> 9) & 1) << 5); R = (st >> 1) * 16 + swz / 64; C = (st & 1) * 32 + (swz % 64) / 2; }
__device__ __forceinline__ int perm32(int rho) { const int n = rho >> 4, i = rho & 15; return 8 * (i >> 2) + 4 * n + (i & 3); }
struct Unit { int pm, pn, e; };

struct StaticOrder {
    int nM, nN, nwg, G, c;
    __device__ void init(int M, int N, int G_, int c_) { nM = M / BM; nN = N / BM; nwg = nM * nN; G = G_; c = c_; }
    __device__ bool next(int i, Unit& u) const {
        const long L = (long)i * G + c; if (L >= nwg) return false;
        int wgid = (int)L; { const int q = nwg / NXCD, r = nwg % NXCD, xcd = wgid % NXCD, off = wgid / NXCD; wgid = (xcd < r ? xcd * (q + 1) : r * (q + 1) + (xcd - r) * q) + off; }
        const int nig = WGM * nN, gid = wgid / nig, fm = gid * WGM, gsz = (nM - fm) < WGM ? (nM - fm) : WGM;
        u.pm = fm + ((wgid % nig) % gsz); u.pn = (wgid % nig) / gsz; u.e = 0; return true;
    }
    __device__ __forceinline__ unsigned rowA(const Unit& u, int r) const { return (unsigned)(u.pm * BM + r); }
    __device__ __forceinline__ unsigned rowB(const Unit& u, int r) const { return (unsigned)(u.pn * BM + r); }
};

template <class Epi, class Sched, bool ALIGN_EPI>
__device__ __forceinline__ void gemm_phase(LAS unsigned char* lds, const bf16_t* Ab, const bf16_t* Bb, const int K, const Sched& S, const Epi& E) {
    const int tid = otid(), wid = __builtin_amdgcn_readfirstlane(tid >> 6), lane = tid & 63, wr = wid >> 2, wc = wid & 3, fr = lane & 15, fq = lane >> 4;
    const int nt = K / BK;
    int sR[2], sC[2], sRb[2];
#pragma unroll
    for (int i = 0; i < 2; ++i) { int R, C; stage_rc(tid * 16 + i * 8192, R, C); sR[i] = R; sC[i] = C; sRb[i] = Epi::PERM ? ((R & ~31) + perm32(R & 31)) : R; }
    const unsigned kstep = (unsigned)(BK * 2);
    const unsigned ldsw = (unsigned)wid * 1024u;
    const int aoff = lds_byte(wr * 64 + fr, fq * 8), boff = lds_byte(wc * 32 + fr, fq * 8);
#define PG8_SA(b, h) (((b) * 2 + (h)) * HTB)
#define PG8_SB(b, h) ((4 + (b) * 2 + (h)) * HTB)
#define PG8_STAGE(bufoff, gbase, offs, kb) do { _Pragma("unroll") for (int _i = 0; _i < 2; ++_i) \
        __builtin_amdgcn_global_load_lds((const unsigned*)((const char*)(gbase) + (size_t)((offs)[_i] + (kb))), (LAS unsigned*)(lds + (bufoff) + ldsw + _i * 8192), 16, 0, 0); } while (0)
#define PG8_LDA(dst, b, h) do { _Pragma("unroll") for (int m = 0; m < 4; ++m) _Pragma("unroll") for (int k = 0; k < 2; ++k) dst[m][k] = *(const LAS bf16x8*)(lds + PG8_SA(b, h) + aoff + m * 2048 + k * 1024); } while (0)
#define PG8_LDB(dst, b, h) do { _Pragma("unroll") for (int n = 0; n < 2; ++n) _Pragma("unroll") for (int k = 0; k < 2; ++k) dst[n][k] = *(const LAS bf16x8*)(lds + PG8_SB(b, h) + boff + n * 2048 + k * 1024); } while (0)
#define PG8_MMA(ai, bj, At, Bt) do { __builtin_amdgcn_s_setprio(1); _Pragma("unroll") for (int m = 0; m < 4; ++m) _Pragma("unroll") for (int n = 0; n < 2; ++n) _Pragma("unroll") for (int k = 0; k < 2; ++k) \
        acc[ai][bj][m][n] = __builtin_amdgcn_mfma_f32_16x16x32_bf16(Bt[n][k], At[m][k], acc[ai][bj][m][n], 0, 0, 0); __builtin_amdgcn_s_setprio(0); } while (0)
#define PG8_WAIT_V(n) asm volatile("s_waitcnt vmcnt(" #n ")" ::: "memory")
#define PG8_WAIT_L(n) asm volatile("s_waitcnt lgkmcnt(" #n ")" ::: "memory")
#define PG8_BAR __builtin_amdgcn_s_barrier()
#define PG8_SCHED __builtin_amdgcn_sched_barrier(0)
#define PG8_OFFS(u, AO, BO) do { _Pragma("unroll") for (int _h = 0; _h < 2; ++_h) _Pragma("unroll") for (int _i = 0; _i < 2; ++_i) { \
        AO[_h][_i] = (S.rowA(u, _h * HALF + sR[_i]) * (unsigned)K + (unsigned)sC[_i]) * 2u; BO[_h][_i] = (S.rowB(u, _h * HALF + sRb[_i]) * (unsigned)K + (unsigned)sC[_i]) * 2u; } } while (0)
    Unit cur, nxt; int ui = 0;
    if (!S.next(0, cur)) return;
    f32x4 acc[2][2][4][2];
#pragma unroll
    for (int a = 0; a < 2; ++a)
#pragma unroll
        for (int b = 0; b < 2; ++b)
#pragma unroll
            for (int m = 0; m < 4; ++m)
#pragma unroll
                for (int n = 0; n < 2; ++n) acc[a][b][m][n] = (f32x4){0.f, 0.f, 0.f, 0.f};
    bf16x8 At[4][2], B0[2][2], B1[2][2];
    unsigned ao[2][2], bo[2][2], nao[2][2], nbo[2][2];
    PG8_OFFS(cur, ao, bo);
    PG8_STAGE(PG8_SB(0, 0), Bb, bo[0], 0u); PG8_STAGE(PG8_SB(0, 1), Bb, bo[1], 0u); PG8_STAGE(PG8_SA(0, 0), Ab, ao[0], 0u); PG8_STAGE(PG8_SA(0, 1), Ab, ao[1], 0u);
    if (wr == 1) PG8_BAR;
    PG8_WAIT_V(2); PG8_BAR;
    PG8_STAGE(PG8_SB(1, 0), Bb, bo[0], kstep); PG8_STAGE(PG8_SA(1, 0), Ab, ao[0], kstep); PG8_STAGE(PG8_SB(1, 1), Bb, bo[1], kstep);
    PG8_WAIT_V(6); PG8_BAR;
    for (;;) {
        const bool has_next = S.next(ui + 1, nxt);
        if (has_next) { PG8_OFFS(nxt, nao, nbo); }
        else {
#pragma unroll
            for (int h = 0; h < 2; ++h)
#pragma unroll
                for (int i = 0; i < 2; ++i) { nao[h][i] = ao[h][i]; nbo[h][i] = bo[h][i]; }
        }
        for (int t = 0; t < nt; t += 2) {
            const bool last = (t == nt - 2);
            const unsigned k1 = (unsigned)(t + 1) * kstep, k2 = last ? 0u : (unsigned)(t + 2) * kstep, k3 = k2 + kstep;
            unsigned a2[2][2], b2[2][2];
#pragma unroll
            for (int h = 0; h < 2; ++h)
#pragma unroll
                for (int i = 0; i < 2; ++i) { a2[h][i] = last ? nao[h][i] : ao[h][i]; b2[h][i] = last ? nbo[h][i] : bo[h][i]; }
            PG8_LDB(B0, 0, 0); PG8_LDB(B1, 0, 1); PG8_SCHED; PG8_LDA(At, 0, 0); PG8_STAGE(PG8_SA(1, 1), Ab, ao[1], k1);
            PG8_WAIT_V(8); PG8_WAIT_L(0); PG8_BAR; PG8_MMA(0, 0, At, B0); PG8_MMA(0, 1, At, B1); PG8_BAR; PG8_SCHED;
            PG8_LDA(At, 0, 1); PG8_STAGE(PG8_SB(0, 0), Bb, b2[0], k2); PG8_STAGE(PG8_SB(0, 1), Bb, b2[1], k2); PG8_STAGE(PG8_SA(0, 0), Ab, a2[0], k2);
            PG8_WAIT_V(8); PG8_WAIT_L(0); PG8_BAR; PG8_MMA(1, 0, At, B0); PG8_MMA(1, 1, At, B1); PG8_BAR; PG8_SCHED;
            PG8_LDB(B0, 1, 0); PG8_LDB(B1, 1, 1); PG8_SCHED; PG8_LDA(At, 1, 0); PG8_STAGE(PG8_SA(0, 1), Ab, a2[1], k2);
            PG8_WAIT_V(8); PG8_WAIT_L(0); PG8_BAR; PG8_MMA(0, 0, At, B0); PG8_MMA(0, 1, At, B1); PG8_BAR; PG8_SCHED;
            PG8_LDA(At, 1, 1); PG8_STAGE(PG8_SB(1, 0), Bb, b2[0], k3); PG8_STAGE(PG8_SB(1, 1), Bb, b2[1], k3); PG8_STAGE(PG8_SA(1, 0), Ab, a2[0], k3);
            PG8_WAIT_V(8); PG8_WAIT_L(0); PG8_BAR; PG8_MMA(1, 0, At, B0); PG8_MMA(1, 1, At, B1); PG8_BAR; PG8_SCHED;
        }
        if constexpr (ALIGN_EPI) { if (wr == 0) PG8_BAR; }
        E(acc, cur, wr, wc, fr, fq);
        if (!has_next) break;
#pragma unroll
        for (int a = 0; a < 2; ++a)
#pragma unroll
            for (int b = 0; b < 2; ++b)
#pragma unroll
                for (int m = 0; m < 4; ++m)
#pragma unroll
                    for (int n = 0; n < 2; ++n) acc[a][b][m][n] = (f32x4){0.f, 0.f, 0.f, 0.f};
        cur = nxt; ++ui;
#pragma unroll
        for (int h = 0; h < 2; ++h)
#pragma unroll
            for (int i = 0; i < 2; ++i) { ao[h][i] = nao[h][i]; bo[h][i] = nbo[h][i]; }
        if constexpr (ALIGN_EPI) { if (wr == 1) PG8_BAR; }
    }
    PG8_WAIT_V(0);
    if constexpr (!ALIGN_EPI) { if (wr == 0) PG8_BAR; }
    PG8_BAR;
#undef PG8_SA
#undef PG8_SB
#undef PG8_STAGE
#undef PG8_LDA
#undef PG8_LDB
#undef PG8_MMA
#undef PG8_WAIT_V
#undef PG8_WAIT_L
#undef PG8_BAR
#undef PG8_SCHED
#undef PG8_OFFS
}
}

__device__ __forceinline__ void gemm_r32(f32x4 (&acc)[2][8], const bf16_t* A, int lda, int brow, const bf16_t* Bt, int ldb, int bcol, int K, char* smem) {
    const int tid = otid(), lane = tid & 63, wid = tid >> 6, fr = lane & 15, fq = lane >> 4;
    const int r0 = tid >> 3, lch = (tid & 7) ^ ((tid >> 4) & 7);
    const bf16_t* pa[4]; const bf16_t* pb[2];
#pragma unroll
    for (int i = 0; i < 4; ++i) pa[i] = A + (long)(brow + r0 + 64 * i) * lda + lch * 8;
#pragma unroll
    for (int i = 0; i < 2; ++i) pb[i] = Bt + (long)(bcol + r0 + 64 * i) * ldb + lch * 8;
    const int nk = K / 64;
#pragma unroll
    for (int i = 0; i < 4; ++i) __builtin_amdgcn_global_load_lds((const unsigned*)pa[i], (unsigned*)(smem + tid * 16 + i * 8192), 16, 0, 0);
#pragma unroll
    for (int i = 0; i < 2; ++i) __builtin_amdgcn_global_load_lds((const unsigned*)pb[i], (unsigned*)(smem + 32768 + tid * 16 + i * 8192), 16, 0, 0);
    const int sw = fr >> 1;
    for (int kt = 0; kt < nk; ++kt) {
        asm volatile("s_waitcnt vmcnt(0)" ::: "memory");
        __syncthreads();
        char* cur = smem + (kt & 1) * 49152;
        if (kt + 1 < nk) {
            char* nx = smem + ((kt + 1) & 1) * 49152;
#pragma unroll
            for (int i = 0; i < 4; ++i) __builtin_amdgcn_global_load_lds((const unsigned*)(pa[i] + (kt + 1) * 64), (unsigned*)(nx + tid * 16 + i * 8192), 16, 0, 0);
#pragma unroll
            for (int i = 0; i < 2; ++i) __builtin_amdgcn_global_load_lds((const unsigned*)(pb[i] + (kt + 1) * 64), (unsigned*)(nx + 32768 + tid * 16 + i * 8192), 16, 0, 0);
        }
#pragma unroll
        for (int ks = 0; ks < 2; ++ks) {
            const int pc = ((ks * 4 + fq) ^ sw) * 16;
            bf16x8 At[2], Bf[8];
#pragma unroll
            for (int m = 0; m < 2; ++m) At[m] = *(const bf16x8*)(cur + (wid * 32 + m * 16 + fr) * 128 + pc);
#pragma unroll
            for (int n = 0; n < 8; ++n) Bf[n] = *(const bf16x8*)(cur + 32768 + (n * 16 + fr) * 128 + pc);
#pragma unroll
            for (int m = 0; m < 2; ++m)
#pragma unroll
                for (int n = 0; n < 8; ++n) acc[m][n] = MFMA16(Bf[n], At[m], acc[m][n]);
        }
    }
    __syncthreads();
}

__device__ __forceinline__ void transpose_tile(const float* W, int K, int N, bf16_t* Wt, int rs, int roff, int tile, float* scr  ) {
    const int tid = otid();
    const int nnb = N / 128, kb = tile / nnb, nb = tile % nnb, k0 = kb * 64, n0 = nb * 128;
#pragma unroll 4
    for (int i = 0; i < 16; ++i) { const int k = i * 4 + (tid >> 7), n = tid & 127; scr[k * 129 + n] = W[(size_t)(k0 + k) * N + n0 + n]; }
    __syncthreads();
#pragma unroll
    for (int i = 0; i < 2; ++i) {
        const int c = tid + i * 512, n = c >> 3, kc = c & 7;
        const float* s = scr + (kc * 8) * 129 + n;
        u32x4 o; o.x = pk2(s[0], s[129]); o.y = pk2(s[2 * 129], s[3 * 129]); o.z = pk2(s[4 * 129], s[5 * 129]); o.w = pk2(s[6 * 129], s[7 * 129]);
        const int nn = n0 + n, drow = (nn >> 4) * rs + (nn & 15) + roff;
        *(u32x4*)(Wt + (size_t)drow * K + k0 + kc * 8) = o;
    }
    __syncthreads();
}
__device__ __forceinline__ void rms_row_bf16(const float* xrow, const float* g, bf16_t* orow, int lane) {
    const f32x4* xr = (const f32x4*)xrow + lane; const f32x4* gr = (const f32x4*)g + lane;
    f32x4 v[4]; float s = 0.f;
#pragma unroll
    for (int j = 0; j < 4; ++j) { v[j] = xr[64 * j]; s += v[j].x * v[j].x + v[j].y * v[j].y + v[j].z * v[j].z + v[j].w * v[j].w; }
    const float rstd = rsqrtf(wave_sum(s) * (1.f / 1024.f) + 1e-6f);
    u32x2* o8 = (u32x2*)orow + lane;
#pragma unroll
    for (int j = 0; j < 4; ++j) { const f32x4 gg = gr[64 * j]; u32x2 o; o.x = pk2(v[j].x * rstd * gg.x, v[j].y * rstd * gg.y); o.y = pk2(v[j].z * rstd * gg.z, v[j].w * rstd * gg.w); o8[64 * j] = o; }
}
constexpr int P0_T_IN = 16 * 42, P0_T_A = 64, P0_T_B = 128, P0_T_L = 4 + 4 + 8;
constexpr int P0_TR = P0_T_IN + 4 * P0_T_A + 2 * P0_T_B + P0_T_L;
constexpr int P0_ROUT = 72, P0_NORM = T / 8, P0_MEM = NMEM / 8;
constexpr int P0_ITEMS = P0_TR + P0_ROUT + P0_NORM + P0_MEM + 1;
__device__ __forceinline__ void phase0(const P& p, int bid, int nb, char* smem) {
    const int tid = otid(), lane = tid & 63, wid = tid >> 6;
    char* ws = p.ws;
    for (int it = bid; it < P0_ITEMS; it += nb) {
        int r = it;
        if (r < P0_TR) {
            float* scr = (float*)smem;
            if (r < P0_T_IN) { transpose_tile(p.w_in, D, INCOLS, (bf16_t*)(ws + OFF_WIN), 16, 0, r, scr); continue; } r -= P0_T_IN;
            if (r < P0_T_A) { transpose_tile(p.w_o_rwkv, RW, D, (bf16_t*)(ws + OFF_WORW), 16, 0, r, scr); continue; } r -= P0_T_A;
            if (r < P0_T_A) { transpose_tile(p.w_o_moba, MW, D, (bf16_t*)(ws + OFF_WOMB), 16, 0, r, scr); continue; } r -= P0_T_A;
            if (r < P0_T_B) { transpose_tile(p.w_out, D, D, (bf16_t*)(ws + OFF_WOUT), 16, 0, r, scr); continue; } r -= P0_T_B;
            if (r < P0_T_A) { transpose_tile(p.w_q_x, D, 512, (bf16_t*)(ws + OFF_WQ), 16, 0, r, scr); continue; } r -= P0_T_A;
            if (r < P0_T_B) { transpose_tile(p.w_kv_x, D, D, (bf16_t*)(ws + OFF_WKV), 16, 0, r, scr); continue; } r -= P0_T_B;
            if (r < P0_T_A) { transpose_tile(p.w_o_x, 512, D, (bf16_t*)(ws + OFF_WOX), 16, 0, r, scr); continue; } r -= P0_T_A;
            if (r < 4) { transpose_tile(p.decay_up, 64, 512, (bf16_t*)(ws + OFF_LORA_D), 16, 0, r, scr); continue; } r -= 4;
            if (r < 4) { transpose_tile(p.iclr_up, 64, 512, (bf16_t*)(ws + OFF_LORA_I), 16, 0, r, scr); continue; } r -= 4;
            transpose_tile(p.gate_up, 128, 512, (bf16_t*)(ws + OFF_LORA_G), 16, 0, r, scr); continue;
        }
        r -= P0_TR;
        if (r < P0_ROUT) {
            const int e = r * 512 + tid, o = e >> 10, k = e & 1023;
            float* rt = (float*)(ws + OFF_ROUT);
            rt[e] = (o < 32) ? p.w_router_expert[k * 32 + o] : p.w_router_group[k * 4 + (o - 32)];
            continue;
        }
        r -= P0_ROUT;
        if (r < P0_NORM) { const int row = r * 8 + wid; rms_row_bf16(p.x + (size_t)row * D, p.norm_mix, (bf16_t*)(ws + OFF_XN) + (size_t)row * D, lane); continue; }
        r -= P0_NORM;
        if (r < P0_MEM) { const int row = r * 8 + wid; rms_row_bf16(p.mem + (size_t)row * D, p.mem_norm, (bf16_t*)(ws + OFF_MEMN) + (size_t)row * D, lane); continue; }
        if (tid < 64) ((int*)(ws + OFF_CTL + CTL_CNT))[tid] = 0;
        for (int i = tid; i < 1024; i += NT) ((int*)(ws + OFF_CTL + CTL_MCNT))[i] = 0;
    }
}

struct EpiU {
    static constexpr bool PERM = true;
    char* ws;
    __device__ __forceinline__ void operator()(const f32x4 (&acc)[2][2][4][2], const pg8::Unit& u, int wr, int wc, int fr, int fq) const {
        const int colt = u.pn * 256;
        bf16_t* dst; int ld, cb; bool sg = false;
        if (colt < RCOLS) { dst = (bf16_t*)(ws + OFF_UR); ld = RCOLS; cb = colt; }
        else if (colt < RCOLS + MCOLS) { dst = (bf16_t*)(ws + OFF_UM); ld = UMC; cb = colt - RCOLS; }
        else { dst = (bf16_t*)(ws + OFF_UG); ld = GCOLS; cb = colt - RCOLS - MCOLS; sg = true; }
        const int row0 = u.pm * 256 + wr * 64 + fr, col0 = cb + wc * 32 + 8 * fq;
#pragma unroll
        for (int ai = 0; ai < 2; ++ai)
#pragma unroll
            for (int m = 0; m < 4; ++m) {
                bf16_t* rowp = dst + (size_t)(row0 + ai * 128 + m * 16) * ld + col0;
#pragma unroll
                for (int bj = 0; bj < 2; ++bj) {
                    f32x4 v0 = acc[ai][bj][m][0], v1 = acc[ai][bj][m][1];
                    if (sg) { v0.x = sigm(v0.x); v0.y = sigm(v0.y); v0.z = sigm(v0.z); v0.w = sigm(v0.w); v1.x = sigm(v1.x); v1.y = sigm(v1.y); v1.z = sigm(v1.z); v1.w = sigm(v1.w); }
                    u32x4 w; w.x = cvt_pk(v0.x, v0.y); w.y = cvt_pk(v0.z, v0.w); w.z = cvt_pk(v1.x, v1.y); w.w = cvt_pk(v1.z, v1.w);
                    *(u32x4*)(rowp + bj * 128) = w;
                }
            }
    }
};
__device__ __forceinline__ void phase1(const P& p, int bid, int nb, char* smem) {
    pg8::StaticOrder S; S.init(T, INCOLS, nb, bid);
    EpiU E{p.ws};
    pg8::gemm_phase<EpiU, pg8::StaticOrder, true>((LAS unsigned char*)smem, (const bf16_t*)(p.ws + OFF_XN), (const bf16_t*)(p.ws + OFF_WIN), D, S, E);
}

__device__ __forceinline__ void phase_kmean(const P& p, int bid, int nb, char* smem) {
    const int tid = otid();
    const bf16_t* um = (const bf16_t*)(p.ws + OFF_UM);
    bf16_t* kmb = (bf16_t*)(p.ws + OFF_CTL + CTL_KMB);
    float* red = (float*)smem;
    for (int it = bid; it < 64 * 8; it += nb) {
        const int blk = it >> 3, h = it & 7, q = tid >> 6, d = tid & 63;
        float s = 0.f;
        for (int k = 0; k < 32; ++k) s += bf2f(um[(size_t)(blk * 256 + q * 32 + k) * UMC + 512 + h * 64 + d]);
        red[tid] = s;
        __syncthreads();
        if (tid < 64) { float a = 0.f;
#pragma unroll
            for (int j = 0; j < 8; ++j) a += red[tid + 64 * j];
            kmb[(blk * 8 + h) * 64 + tid] = (bf16_t)f2bf(a * (1.f / 256.f)); }
        __syncthreads();
    }
}
__device__ __forceinline__ void phase_vtrans(const P& p, int bid, int nb, char* smem) {
    const int tid = otid();
    const bf16_t* um = (const bf16_t*)(p.ws + OFF_UM); bf16_t* vt = (bf16_t*)(p.ws + OFF_VT);
    for (int it = bid; it < 256 * 4; it += nb) {
        const int tt = it >> 2, cq = it & 3, t0 = tt * 64, c0 = cq * 128;
#pragma unroll
        for (int i = 0; i < 2; ++i) { const int c = tid + i * 512, r = c >> 4, ch = c & 15; *(u32x4*)(smem + r * 272 + ch * 16) = *(const u32x4*)(um + (size_t)(t0 + r) * UMC + 1024 + c0 + ch * 8); }
        __syncthreads();
#pragma unroll
        for (int i = 0; i < 2; ++i) {
            const int c = tid + i * 512, col = c >> 3, tc = c & 7;
            unsigned short e[8];
#pragma unroll
            for (int j = 0; j < 8; ++j) e[j] = *(const unsigned short*)(smem + (tc * 8 + j) * 272 + col * 2);
            u32x4 o; o.x = e[0] | ((unsigned)e[1] << 16); o.y = e[2] | ((unsigned)e[3] << 16); o.z = e[4] | ((unsigned)e[5] << 16); o.w = e[6] | ((unsigned)e[7] << 16);
            *(u32x4*)(vt + (size_t)(c0 + col) * T + t0 + tc * 8) = o;
        }
        __syncthreads();
    }
}

constexpr int SLOT = 9216, ROWB = 144, LIN_ROWB = 528;
constexpr int L_WL = 0 * SLOT, L_AL = 1 * SLOT, L_LIN = 2 * SLOT, L_AT = 2 * SLOT, L_BT = 3 * SLOT, L_KT = 4 * SLOT, L_RT = 5 * SLOT, L_VT = 6 * SLOT, L_ATT = 7 * SLOT;
constexpr int L_AAB = L_AT, L_AKV = L_BT, L_BBT = L_WL, L_KBT = L_AL;
constexpr int L_WTOT = 8 * SLOT, L_WC = L_WTOT + 1024, L_PAR = L_WC + 256, RW_LDS = L_PAR + 2048;

typedef float f32x2 __attribute__((ext_vector_type(2)));
template <int TT> struct SolveRow {
    static __device__ __forceinline__ void run(f32x2 (&x)[32], const char* Lb, const u32x4 (&lcur)[8]) {
        u32x4 lnext[8];
        constexpr int NCN = (TT + 1 < 64) ? (TT / 8 + 1) : 0;
#pragma unroll
        for (int c8 = 0; c8 < 8; ++c8) if (c8 < NCN) lnext[c8] = *(const u32x4*)(Lb + (TT + 1) * 144 + c8 * 16); else lnext[c8] = (u32x4){0u, 0u, 0u, 0u};
        f32x2 a0 = {0.f, 0.f}, a1 = {0.f, 0.f}, a2 = {0.f, 0.f}, a3 = {0.f, 0.f};
#pragma unroll
        for (int c8 = 0; c8 <= (TT - 1) / 8; ++c8) {
            const u32x4 lv = lcur[c8];
            f32x2 l0, l1, l2, l3;
            l0.x = __uint_as_float(lv.x << 16); l0.y = __uint_as_float(lv.x & 0xffff0000u);
            l1.x = __uint_as_float(lv.y << 16); l1.y = __uint_as_float(lv.y & 0xffff0000u);
            l2.x = __uint_as_float(lv.z << 16); l2.y = __uint_as_float(lv.z & 0xffff0000u);
            l3.x = __uint_as_float(lv.w << 16); l3.y = __uint_as_float(lv.w & 0xffff0000u);
            a0 = l0 * x[c8 * 4 + 0] + a0; a1 = l1 * x[c8 * 4 + 1] + a1; a2 = l2 * x[c8 * 4 + 2] + a2; a3 = l3 * x[c8 * 4 + 3] + a3;
        }
        a0 = (a0 + a1) + (a2 + a3);
        const float r = a0.x + a0.y;
        if (TT & 1) x[TT / 2].y += r; else x[TT / 2].x += r;
        asm volatile("" : "+v"(x[TT / 2]) :: "memory");
        SolveRow<TT + 1>::run(x, Lb, lnext);
    }
};
template <> struct SolveRow<64> { static __device__ __forceinline__ void run(f32x2 (&)[32], const char*, const u32x4 (&)[8]) {} };

__device__ __forceinline__ void load_shift16(const bf16_t* ur, int row, int col, const float* mu, float* out) {
    const u32x4* cp = (const u32x4*)(ur + (size_t)row * RCOLS + col);
    const u32x4 c0 = cp[0], c1 = cp[1];
    u32x4 p0 = {0u, 0u, 0u, 0u}, p1 = {0u, 0u, 0u, 0u};
    if (row > 0) { const u32x4* pp = (const u32x4*)(ur + (size_t)(row - 1) * RCOLS + col); p0 = pp[0]; p1 = pp[1]; }
    float cf[16], pf[16];
    unpack8(c0, cf); unpack8(c1, cf + 8); unpack8(p0, pf); unpack8(p1, pf + 8);
#pragma unroll
    for (int e = 0; e < 16; ++e) out[e] = cf[e] + mu[col + e] * (pf[e] - cf[e]);
}

__device__ __forceinline__ void phase_rw_chunk(const P& p, int bid, int nb, char* smem0) {
    char* ws = p.ws;
    const bf16_t* ur = (const bf16_t*)(ws + OFF_UR);
    bf16_t* G = (bf16_t*)(ws + OFF_OA); bf16_t* BON = (bf16_t*)(ws + OFF_BON); bf16_t* RH = (bf16_t*)(ws + OFF_RH);
    float* YL = p.out; f32x4* NF = (f32x4*)(p.out + (size_t)T * 512);
    u32x4* MF = (u32x4*)(ws + OFF_MF);
    int hpar = -1;
    for (int itb = bid * 2; itb < 2048; itb += nb * 2) {
        const int tid5 = otid();
        const int half = __builtin_amdgcn_readfirstlane(tid5 >> 8), tid = tid5 & 255;
        char* smem = smem0 + half * RW_LDS;
        float* wtot = (float*)(smem + L_WTOT); float* WCs = (float*)(smem + L_WC);
        const int it = itb + half, c = it >> 3, h = it & 7;
        const int lane = tid & 63, w = __builtin_amdgcn_readfirstlane(tid >> 6), fr = lane & 15, fq = lane >> 4;
        if (h != hpar) {
            float* par = (float*)(smem + L_PAR);
            if (tid < 64) {
                const int hj = h * 64 + tid;
                par[tid] = p.decay_w0[hj]; par[64 + tid] = p.iclr_a0[hj]; par[128 + tid] = p.k_k[hj]; par[192 + tid] = p.k_a[hj]; par[256 + tid] = p.r_k[hj];
                par[320 + tid] = p.tshift_mu[hj]; par[384 + tid] = p.tshift_mu[512 + hj]; par[448 + tid] = p.tshift_mu[1024 + hj];
            }
            hpar = h;
        }
        u32x4 rawc[3][2], rawp[3][2];
        {
            const int row = c * 64 + (tid >> 2), hj0 = h * 64 + (tid & 3) * 16;
#pragma unroll
            for (int q3 = 0; q3 < 3; ++q3) {
                const u32x4* cp = (const u32x4*)(ur + (size_t)row * RCOLS + q3 * 512 + hj0);
                rawc[q3][0] = cp[0]; rawc[q3][1] = cp[1];
                rawp[q3][0] = (u32x4){0u, 0u, 0u, 0u}; rawp[q3][1] = rawp[q3][0];
                if (row > 0) { const u32x4* pp = (const u32x4*)(ur + (size_t)(row - 1) * RCOLS + q3 * 512 + hj0); rawp[q3][0] = pp[0]; rawp[q3][1] = pp[1]; }
            }
        }
        {
            const int cc = tid & 31, col = 1536 + cc * 8, t0 = tid >> 5;
            u32x4 cur[8], prv[8];
#pragma unroll
            for (int i = 0; i < 8; ++i) {
                const int row = c * 64 + t0 + 8 * i;
                cur[i] = *(const u32x4*)(ur + (size_t)row * RCOLS + col);
                prv[i] = (u32x4){0u, 0u, 0u, 0u};
                if (row > 0) prv[i] = *(const u32x4*)(ur + (size_t)(row - 1) * RCOLS + col);
            }
            const f32x4 mu0 = *(const f32x4*)(p.tshift_mu + col), mu1 = *(const f32x4*)(p.tshift_mu + col + 4);
            const float mu[8] = {mu0.x, mu0.y, mu0.z, mu0.w, mu1.x, mu1.y, mu1.z, mu1.w};
#pragma unroll
            for (int i = 0; i < 8; ++i) {
                float cf[8], pf[8], xs[8];
                unpack8(cur[i], cf); unpack8(prv[i], pf);
#pragma unroll
                for (int e = 0; e < 8; ++e) {
                    const float x = cf[e] + mu[e] * (pf[e] - cf[e]);
                    xs[e] = (cc < 8) ? (1.f - 2.f * __builtin_amdgcn_rcpf(1.f + __expf(2.f * x))) : ((cc < 16) ? x : sigm(x));
                }
                u32x4 o; o.x = cvt_pk(xs[0], xs[1]); o.y = cvt_pk(xs[2], xs[3]); o.z = cvt_pk(xs[4], xs[5]); o.w = cvt_pk(xs[6], xs[7]);
                *(u32x4*)(smem + L_LIN + (t0 + 8 * i) * LIN_ROWB + cc * 16) = o;
            }
        }
        __syncthreads();
        {
            const char* lrow = smem + L_LIN + (w * 16 + fr) * LIN_ROWB;
            const bf16_t* dT = (const bf16_t*)(ws + OFF_LORA_D) + (size_t)(h * 64) * 64;
            const bf16_t* iT = (const bf16_t*)(ws + OFF_LORA_I) + (size_t)(h * 64) * 64;
            const bf16_t* gT = (const bf16_t*)(ws + OFF_LORA_G) + (size_t)(h * 64) * 128;
            bf16x8 lb[8];
#pragma unroll
            for (int ks = 0; ks < 8; ++ks) lb[ks] = *(const bf16x8*)(lrow + (ks * 32 + fq * 8) * 2);
#pragma unroll
            for (int jt = 0; jt < 4; ++jt) {
                f32x4 aw = {0.f, 0.f, 0.f, 0.f}, aa = aw, ag = aw;
#pragma unroll
                for (int ks = 0; ks < 2; ++ks) {
                    aw = MFMA16(*(const bf16x8*)(dT + (jt * 16 + fr) * 64 + ks * 32 + fq * 8), lb[ks], aw);
                    aa = MFMA16(*(const bf16x8*)(iT + (jt * 16 + fr) * 64 + ks * 32 + fq * 8), lb[2 + ks], aa);
                }
#pragma unroll
                for (int ks = 0; ks < 4; ++ks) ag = MFMA16(*(const bf16x8*)(gT + (jt * 16 + fr) * 128 + ks * 32 + fq * 8), lb[4 + ks], ag);
                *(u32x2*)(smem + L_WL + (w * 16 + fr) * ROWB + (jt * 16 + fq * 4) * 2) = pack4(aw);
                *(u32x2*)(smem + L_AL + (w * 16 + fr) * ROWB + (jt * 16 + fq * 4) * 2) = pack4(aa);
                *(u32x2*)(G + (size_t)(c * 64 + w * 16 + fr) * 512 + h * 64 + jt * 16 + fq * 4) = pack4(ag);
            }
        }
        __syncthreads();
        {
            const int t = tid >> 2, jq = tid & 3, j0 = jq * 16, hj0 = h * 64 + j0, row = c * 64 + t;
            const float* par = (const float*)(smem + L_PAR) + j0;
            float ai[16], kk[16], k2[16], rr[16];
            {
                float al[16];
                const u32x4* ap = (const u32x4*)(smem + L_AL + t * ROWB + j0 * 2);
                unpack8(ap[0], al); unpack8(ap[1], al + 8);
#pragma unroll
                for (int e = 0; e < 16; ++e) ai[e] = sigm(par[64 + e] + al[e]);
            }
            float ss = 0.f, rk = 0.f;
            {
                float cf[16], pf[16];
                unpack8(rawc[1][0], cf); unpack8(rawc[1][1], cf + 8); unpack8(rawp[1][0], pf); unpack8(rawp[1][1], pf + 8);
#pragma unroll
                for (int e = 0; e < 16; ++e) { const float k = cf[e] + par[384 + e] * (pf[e] - cf[e]); kk[e] = k * par[128 + e]; ss += kk[e] * kk[e]; k2[e] = k * (1.f + (ai[e] - 1.f) * par[192 + e]); }
            }
            ss += __shfl_xor(ss, 1); ss += __shfl_xor(ss, 2);
            const float inv = rsqrtf(ss + 1e-12f);
            {
                float cf[16], pf[16];
                unpack8(rawc[0][0], cf); unpack8(rawc[0][1], cf + 8); unpack8(rawp[0][0], pf); unpack8(rawp[0][1], pf + 8);
#pragma unroll
                for (int e = 0; e < 16; ++e) { rr[e] = cf[e] + par[320 + e] * (pf[e] - cf[e]); rk += rr[e] * k2[e] * par[256 + e]; }
            }
            rk += __shfl_xor(rk, 1); rk += __shfl_xor(rk, 2);
            {
                float cf[16], pf[16], v[16];
                unpack8(rawc[2][0], cf); unpack8(rawc[2][1], cf + 8); unpack8(rawp[2][0], pf); unpack8(rawp[2][1], pf + 8);
#pragma unroll
                for (int e = 0; e < 16; ++e) { v[e] = cf[e] + par[448 + e] * (pf[e] - cf[e]); *(bf16_t*)(smem + L_VT + (j0 + e) * ROWB + t * 2) = (bf16_t)f2bf(v[e]); }
#pragma unroll
                for (int hh = 0; hh < 2; ++hh) {
                    u32x4 o; o.x = cvt_pk(rk * v[hh * 8], rk * v[hh * 8 + 1]); o.y = cvt_pk(rk * v[hh * 8 + 2], rk * v[hh * 8 + 3]); o.z = cvt_pk(rk * v[hh * 8 + 4], rk * v[hh * 8 + 5]); o.w = cvt_pk(rk * v[hh * 8 + 6], rk * v[hh * 8 + 7]);
                    *(u32x4*)(BON + (size_t)row * 512 + hj0 + hh * 8) = o;
                }
            }
            float lw[16], cum[16];
            {
                float wl[16];
                const u32x4* wp = (const u32x4*)(smem + L_WL + t * ROWB + j0 * 2);
                unpack8(wp[0], wl); unpack8(wp[1], wl + 8);
#pragma unroll
                for (int e = 0; e < 16; ++e) { const float wv = par[e] + wl[e]; lw[e] = -0.6065306597126334f * sigm(wv); }
            }
#pragma unroll
            for (int e = 0; e < 16; ++e) {
                float x = lw[e];
#pragma unroll
                for (int d = 4; d < 64; d <<= 1) { const float y = __shfl_up(x, d); if (lane >= d) x += y; }
                cum[e] = x;
            }
            if ((lane >> 2) == 15) {
#pragma unroll
                for (int e = 0; e < 16; ++e) wtot[w * 64 + j0 + e] = cum[e];
            }
            __syncthreads();
#pragma unroll
            for (int hh = 0; hh < 2; ++hh) {
                float at[8], bt[8], kt[8], rt[8];
#pragma unroll
                for (int e8 = 0; e8 < 8; ++e8) {
                    const int e = hh * 8 + e8;
                    const float t0 = wtot[j0 + e], t1 = wtot[64 + j0 + e], t2 = wtot[128 + j0 + e], t3 = wtot[192 + j0 + e];
                    const float cm = cum[e] + ((w > 0 ? t0 : 0.f) + (w > 1 ? t1 : 0.f) + (w > 2 ? t2 : 0.f));
                    const float tt = (t0 + t1) + (t2 + t3);
                    if (t == 63) WCs[j0 + e] = __expf(tt);
                    const float kn = kk[e] * inv;
                    const float E = __expf(cm), Ei = __expf(-cm), Ex = __expf(cm - lw[e]), Ec = __expf(tt - cm);
                    const float b = kn * ai[e];
                    at[e8] = -kn * Ex; bt[e8] = b * Ei; kt[e8] = k2[e] * Ei; rt[e8] = rr[e] * E;
                    *(bf16_t*)(smem + L_BBT + (j0 + e) * ROWB + t * 2) = (bf16_t)f2bf(b * Ec);
                    *(bf16_t*)(smem + L_KBT + (j0 + e) * ROWB + t * 2) = (bf16_t)f2bf(k2[e] * Ec);
                    *(bf16_t*)(smem + L_ATT + (j0 + e) * ROWB + t * 2) = (bf16_t)f2bf(at[e8]);
                }
                u32x4 o;
                o.x = cvt_pk(at[0], at[1]); o.y = cvt_pk(at[2], at[3]); o.z = cvt_pk(at[4], at[5]); o.w = cvt_pk(at[6], at[7]);
                *(u32x4*)(smem + L_AT + t * ROWB + (j0 + hh * 8) * 2) = o;
                o.x = cvt_pk(bt[0], bt[1]); o.y = cvt_pk(bt[2], bt[3]); o.z = cvt_pk(bt[4], bt[5]); o.w = cvt_pk(bt[6], bt[7]);
                *(u32x4*)(smem + L_BT + t * ROWB + (j0 + hh * 8) * 2) = o;
                o.x = cvt_pk(kt[0], kt[1]); o.y = cvt_pk(kt[2], kt[3]); o.z = cvt_pk(kt[4], kt[5]); o.w = cvt_pk(kt[6], kt[7]);
                *(u32x4*)(smem + L_KT + t * ROWB + (j0 + hh * 8) * 2) = o;
                o.x = cvt_pk(rt[0], rt[1]); o.y = cvt_pk(rt[2], rt[3]); o.z = cvt_pk(rt[4], rt[5]); o.w = cvt_pk(rt[6], rt[7]);
                *(u32x4*)(smem + L_RT + t * ROWB + (j0 + hh * 8) * 2) = o;
            }
        }
        __syncthreads();
        bf16x8 frb[2], frk[2];
        {
            const int tid2 = otid() & 255, lane = tid2 & 63, fr = lane & 15, fq = lane >> 4;
            bf16x8 xa[2], xr[2];
#pragma unroll
            for (int ks = 0; ks < 2; ++ks) {
                xa[ks] = *(const bf16x8*)(smem + L_AT + (w * 16 + fr) * ROWB + (ks * 32 + fq * 8) * 2);
                xr[ks] = *(const bf16x8*)(smem + L_RT + (w * 16 + fr) * ROWB + (ks * 32 + fq * 8) * 2);
            }
            f32x4 aab[4], aak[4], arb[4], ark[4];
            const int tq = w * 16 + fr;
#pragma unroll
            for (int n = 0; n < 4; ++n) {
                f32x4 dab = {0.f, 0.f, 0.f, 0.f}, dak = dab, drb = dab, drk = dab;
                if (n <= w) {
#pragma unroll
                    for (int ks = 0; ks < 2; ++ks) {
                        const bf16x8 yb = *(const bf16x8*)(smem + L_BT + (n * 16 + fr) * ROWB + (ks * 32 + fq * 8) * 2);
                        const bf16x8 yk = *(const bf16x8*)(smem + L_KT + (n * 16 + fr) * ROWB + (ks * 32 + fq * 8) * 2);
                        dab = MFMA16(yb, xa[ks], dab); dak = MFMA16(yk, xa[ks], dak); drb = MFMA16(yb, xr[ks], drb); drk = MFMA16(yk, xr[ks], drk);
                    }
#pragma unroll
                    for (int jj = 0; jj < 4; ++jj) {
                        const int sq = n * 16 + fq * 4 + jj;
                        if (!(sq < tq)) { dab[jj] = 0.f; dak[jj] = 0.f; }
                        if (!(sq <= tq)) { drb[jj] = 0.f; drk[jj] = 0.f; }
                    }
                }
                aab[n] = dab; aak[n] = dak; arb[n] = drb; ark[n] = drk;
            }
            __syncthreads();
#pragma unroll
            for (int n = 0; n < 4; ++n) *(u32x2*)(smem + L_AAB + (w * 16 + fr) * ROWB + (n * 16 + fq * 4) * 2) = pack4(aab[n]);
            bf16x8 fak[2];
#pragma unroll
            for (int ks = 0; ks < 2; ++ks) { fak[ks] = pack8(aak[2 * ks], aak[2 * ks + 1]); frb[ks] = pack8(arb[2 * ks], arb[2 * ks + 1]); frk[ks] = pack8(ark[2 * ks], ark[2 * ks + 1]); }
#pragma unroll
            for (int vt = 0; vt < 4; ++vt) {
                f32x4 acc = {0.f, 0.f, 0.f, 0.f};
#pragma unroll
                for (int ks = 0; ks < 2; ++ks) acc = MFMA16(fak[ks], ldperm(smem + L_VT + (vt * 16 + fr) * ROWB, ks, fq), acc);
                *(u32x2*)(smem + L_AKV + (vt * 16 + fr) * ROWB + (w * 16 + fq * 4) * 2) = pack4(acc);
            }
        }
        __syncthreads();
        if (w < 2) {
            char* rowp = smem + (w == 0 ? L_ATT : L_AKV) + (otid() & 63) * ROWB;
            f32x2 x[32];
#pragma unroll
            for (int c8 = 0; c8 < 8; ++c8) {
                const u32x4 xv = *(const u32x4*)(rowp + c8 * 16);
                x[c8 * 4 + 0].x = __uint_as_float(xv.x << 16); x[c8 * 4 + 0].y = __uint_as_float(xv.x & 0xffff0000u);
                x[c8 * 4 + 1].x = __uint_as_float(xv.y << 16); x[c8 * 4 + 1].y = __uint_as_float(xv.y & 0xffff0000u);
                x[c8 * 4 + 2].x = __uint_as_float(xv.z << 16); x[c8 * 4 + 2].y = __uint_as_float(xv.z & 0xffff0000u);
                x[c8 * 4 + 3].x = __uint_as_float(xv.w << 16); x[c8 * 4 + 3].y = __uint_as_float(xv.w & 0xffff0000u);
            }
            u32x4 l1[8];
#pragma unroll
            for (int c8 = 0; c8 < 8; ++c8) l1[c8] = (u32x4){0u, 0u, 0u, 0u};
            l1[0] = *(const u32x4*)(smem + L_AAB + 144);
            SolveRow<1>::run(x, smem + L_AAB, l1);
#pragma unroll
            for (int c8 = 0; c8 < 8; ++c8) {
                u32x4 o; o.x = cvt_pk(x[c8 * 4].x, x[c8 * 4].y); o.y = cvt_pk(x[c8 * 4 + 1].x, x[c8 * 4 + 1].y); o.z = cvt_pk(x[c8 * 4 + 2].x, x[c8 * 4 + 2].y); o.w = cvt_pk(x[c8 * 4 + 3].x, x[c8 * 4 + 3].y);
                *(u32x4*)(rowp + c8 * 16) = o;
            }
        }
        __syncthreads();
        {
            const int tid4 = otid() & 255, lane = tid4 & 63, fr = lane & 15, fq = lane >> 4;
            const int trow = c * 64 + w * 16 + fr;
#pragma unroll
            for (int kt = 0; kt < 4; ++kt) {
                f32x4 acc = {0.f, 0.f, 0.f, 0.f};
#pragma unroll
                for (int ks = 0; ks < 2; ++ks) acc = MFMA16(ldperm(smem + L_ATT + (kt * 16 + fr) * ROWB, ks, fq), frb[ks], acc);
                const u32x2 rr = *(const u32x2*)(smem + L_RT + (w * 16 + fr) * ROWB + (kt * 16 + fq * 4) * 2);
                acc.x += __uint_as_float(rr.x << 16); acc.y += __uint_as_float(rr.x & 0xffff0000u); acc.z += __uint_as_float(rr.y << 16); acc.w += __uint_as_float(rr.y & 0xffff0000u);
                *(u32x2*)(RH + (size_t)trow * 512 + h * 64 + kt * 16 + fq * 4) = pack4(acc);
            }
#pragma unroll
            for (int vt = 0; vt < 4; ++vt) {
                f32x4 acc = {0.f, 0.f, 0.f, 0.f};
#pragma unroll
                for (int ks = 0; ks < 2; ++ks) {
                    acc = MFMA16(ldperm(smem + L_AKV + (vt * 16 + fr) * ROWB, ks, fq), frb[ks], acc);
                    acc = MFMA16(ldperm(smem + L_VT + (vt * 16 + fr) * ROWB, ks, fq), frk[ks], acc);
                }
                *(f32x4*)(YL + (size_t)trow * 512 + h * 64 + vt * 16 + fq * 4) = acc;
            }
            bf16x8 xb[2], xk[2];
#pragma unroll
            for (int ks = 0; ks < 2; ++ks) {
                xb[ks] = *(const bf16x8*)(smem + L_BBT + (w * 16 + fr) * ROWB + (ks * 32 + fq * 8) * 2);
                xk[ks] = *(const bf16x8*)(smem + L_KBT + (w * 16 + fr) * ROWB + (ks * 32 + fq * 8) * 2);
            }
            f32x4 mt[4];
            const float wc = WCs[w * 16 + fr];
#pragma unroll
            for (int n = 0; n < 4; ++n) {
                f32x4 acc = {0.f, 0.f, 0.f, 0.f};
#pragma unroll
                for (int ks = 0; ks < 2; ++ks) acc = MFMA16(*(const bf16x8*)(smem + L_ATT + (n * 16 + fr) * ROWB + (ks * 32 + fq * 8) * 2), xb[ks], acc);
#pragma unroll
                for (int jj = 0; jj < 4; ++jj) if (n * 16 + fq * 4 + jj == w * 16 + fr) acc[jj] += wc;
                mt[n] = acc;
            }
#pragma unroll
            for (int ks = 0; ks < 2; ++ks) MF[((size_t)((c * 8 + h) * 4 + w) * 2 + ks) * 64 + lane] = __builtin_bit_cast(u32x4, pack8(mt[2 * ks], mt[2 * ks + 1]));
#pragma unroll
            for (int vs = 0; vs < 4; ++vs) {
                f32x4 acc = {0.f, 0.f, 0.f, 0.f};
#pragma unroll
                for (int ks = 0; ks < 2; ++ks) {
                    acc = MFMA16(xb[ks], *(const bf16x8*)(smem + L_AKV + (vs * 16 + fr) * ROWB + (ks * 32 + fq * 8) * 2), acc);
                    acc = MFMA16(xk[ks], *(const bf16x8*)(smem + L_VT + (vs * 16 + fr) * ROWB + (ks * 32 + fq * 8) * 2), acc);
                }
                NF[((size_t)((c * 8 + h) * 4 + w) * 4 + vs) * 64 + lane] = acc;
            }
        }
        __syncthreads();
    }
}

__device__ __forceinline__ void rw_scan(const P& p, int chain) {
    const int lane = otid() & 63, h = chain >> 2, vs = chain & 3;
    const u32x4* MF = (const u32x4*)(p.ws + OFF_MF); const f32x4* NF = (const f32x4*)(p.out + (size_t)T * 512);
    u32x4* SF = (u32x4*)(p.ws + OFF_SF);
    u32x4 st0 = {0u, 0u, 0u, 0u}, st1 = st0;
    u32x4 m[8]; f32x4 n[4];
    u32x4 m2[8]; f32x4 n2[4];
#pragma unroll
    for (int i = 0; i < 8; ++i) { m[i] = MF[((size_t)(h * 4 + (i >> 1)) * 2 + (i & 1)) * 64 + lane]; m2[i] = MF[((size_t)((8 + h) * 4 + (i >> 1)) * 2 + (i & 1)) * 64 + lane]; }
#pragma unroll
    for (int i = 0; i < 4; ++i) { n[i] = NF[((size_t)(h * 4 + i) * 4 + vs) * 64 + lane]; n2[i] = NF[((size_t)((8 + h) * 4 + i) * 4 + vs) * 64 + lane]; }
    for (int c = 0; c < 256; ++c) {
        SF[((size_t)((c * 8 + h) * 4 + vs) * 2 + 0) * 64 + lane] = st0;
        SF[((size_t)((c * 8 + h) * 4 + vs) * 2 + 1) * 64 + lane] = st1;
        if (c == 255) break;
        u32x4 m3[8]; f32x4 n3[4];
        const int cn = (c + 2 < 255) ? c + 2 : 254;
#pragma unroll
        for (int i = 0; i < 8; ++i) m3[i] = MF[((size_t)((cn * 8 + h) * 4 + (i >> 1)) * 2 + (i & 1)) * 64 + lane];
#pragma unroll
        for (int i = 0; i < 4; ++i) n3[i] = NF[((size_t)((cn * 8 + h) * 4 + i) * 4 + vs) * 64 + lane];
        f32x4 acc[4];
#pragma unroll
        for (int i = 0; i < 4; ++i) {
            acc[i] = MFMA16(__builtin_bit_cast(bf16x8, m[2 * i]), __builtin_bit_cast(bf16x8, st0), n[i]);
            acc[i] = MFMA16(__builtin_bit_cast(bf16x8, m[2 * i + 1]), __builtin_bit_cast(bf16x8, st1), acc[i]);
        }
        st0 = __builtin_bit_cast(u32x4, pack8(acc[0], acc[1])); st1 = __builtin_bit_cast(u32x4, pack8(acc[2], acc[3]));
#pragma unroll
        for (int i = 0; i < 8; ++i) { m[i] = m2[i]; m2[i] = m3[i]; }
#pragma unroll
        for (int i = 0; i < 4; ++i) { n[i] = n2[i]; n2[i] = n3[i]; }
    }
}

__device__ __forceinline__ void phase_rw_out(const P& p, int bid, int nb) {
    const int tid = otid(), lane = tid & 63, w8 = tid >> 6, w = w8 & 3, fr = lane & 15, fq = lane >> 4;
    char* ws = p.ws;
    bf16_t* OA = (bf16_t*)(ws + OFF_OA); const bf16_t* BON = (const bf16_t*)(ws + OFF_BON); const bf16_t* RH = (const bf16_t*)(ws + OFF_RH);
    const float* YL = p.out; const u32x4* SF = (const u32x4*)(ws + OFF_SF);
    for (int itb = bid * 2; itb < 2048; itb += nb * 2) {
        const int it = itb + (w8 >> 2), c = it >> 3, h = it & 7, trow = c * 64 + w * 16 + fr;
        const char* rrow = (const char*)(RH + (size_t)trow * 512 + h * 64);
        bf16x8 rf[2]; rf[0] = ldperm(rrow, 0, fq); rf[1] = ldperm(rrow, 1, fq);
        f32x4 acc[4];
#pragma unroll
        for (int vs = 0; vs < 4; ++vs) {
            acc[vs] = *(const f32x4*)(YL + (size_t)trow * 512 + h * 64 + vs * 16 + fq * 4);
#pragma unroll
            for (int ks = 0; ks < 2; ++ks) acc[vs] = MFMA16(__builtin_bit_cast(bf16x8, SF[((size_t)((c * 8 + h) * 4 + vs) * 2 + ks) * 64 + lane]), rf[ks], acc[vs]);
        }
        float s = 0.f;
#pragma unroll
        for (int vs = 0; vs < 4; ++vs) s += (acc[vs].x + acc[vs].y) + (acc[vs].z + acc[vs].w);
        s += __shfl_xor(s, 16); s += __shfl_xor(s, 32);
        const float mean = s * (1.f / 64.f);
        float q = 0.f;
#pragma unroll
        for (int vs = 0; vs < 4; ++vs) { acc[vs] = acc[vs] - mean; q += (acc[vs].x * acc[vs].x + acc[vs].y * acc[vs].y) + (acc[vs].z * acc[vs].z + acc[vs].w * acc[vs].w); }
        q += __shfl_xor(q, 16); q += __shfl_xor(q, 32);
        const float rstd = rsqrtf(q * (1.f / 64.f) + 64e-5f);
#pragma unroll
        for (int vs = 0; vs < 4; ++vs) {
            const int hv = h * 64 + vs * 16 + fq * 4;
            const f32x4 lw = *(const f32x4*)(p.ln_x_w + hv), lb = *(const f32x4*)(p.ln_x_b + hv);
            const u32x2 bo = *(const u32x2*)(BON + (size_t)trow * 512 + hv), gg = *(const u32x2*)(OA + (size_t)trow * 512 + hv);
            f32x4 o = acc[vs] * rstd * lw + lb;
            o.x = (o.x + __uint_as_float(bo.x << 16)) * __uint_as_float(gg.x << 16);
            o.y = (o.y + __uint_as_float(bo.x & 0xffff0000u)) * __uint_as_float(gg.x & 0xffff0000u);
            o.z = (o.z + __uint_as_float(bo.y << 16)) * __uint_as_float(gg.y << 16);
            o.w = (o.w + __uint_as_float(bo.y & 0xffff0000u)) * __uint_as_float(gg.y & 0xffff0000u);
            *(u32x2*)(OA + (size_t)trow * 512 + hv) = pack4(o);
        }
    }
}


constexpr int A_LK = 0, A_LV = 36864, A_BIAS = 70656, A_TST = 70784;
constexpr int MAXTILES = 6656;

__device__ __forceinline__ void moba_select(const P& p, int bid0, int nb0, char* smem) {
    const int tid = otid(), lane = tid & 63, w = tid >> 6, fr = lane & 15, fq = lane >> 4;
    char* ws = p.ws;
    const bf16_t* um = (const bf16_t*)(ws + OFF_UM); const bf16_t* kmb = (const bf16_t*)(ws + OFF_CTL + CTL_KMB);
    unsigned* SEL = (unsigned*)(ws + OFF_MSEL);
    int* hist = (int*)smem;
    for (int i = tid; i < 512; i += NT) hist[i] = 0;
    __syncthreads();
    for (int it = bid0; it < 1024; it += nb0) {
        const int tile = it >> 3, h = it & 7, qb = tile >> 1, t = tile * 128 + w * 16 + fr;
        bf16x8 qf[2];
#pragma unroll
        for (int ks = 0; ks < 2; ++ks) qf[ks] = *(const bf16x8*)(um + (size_t)t * UMC + h * 64 + ks * 32 + fq * 8);
        float sc[4][4];
#pragma unroll
        for (int nt = 0; nt < 4; ++nt) {
            f32x4 acc = {0.f, 0.f, 0.f, 0.f};
            if (nt * 16 < qb) {
#pragma unroll
                for (int ks = 0; ks < 2; ++ks) acc = MFMA16(*(const bf16x8*)(kmb + (size_t)((nt * 16 + fr) * 8 + h) * 64 + ks * 32 + fq * 8), qf[ks], acc);
            }
#pragma unroll
            for (int j = 0; j < 4; ++j) sc[nt][j] = (nt * 16 + fq * 4 + j < qb) ? acc[j] : -3.0e38f;
        }
        unsigned selw = 0u;
#pragma unroll
        for (int s = 0; s < 3; ++s) {
            float bv = -3.0e38f; int bi = 255;
#pragma unroll
            for (int nt = 0; nt < 4; ++nt)
#pragma unroll
                for (int j = 0; j < 4; ++j) if (sc[nt][j] > bv) { bv = sc[nt][j]; bi = nt * 16 + fq * 4 + j; }
#pragma unroll
            for (int o = 16; o <= 32; o <<= 1) {
                const float v2 = __shfl_xor(bv, o); const int i2 = __shfl_xor(bi, o);
                if (v2 > bv || (v2 == bv && i2 < bi)) { bv = v2; bi = i2; }
            }
            if (!(bv > -1.0e38f)) bi = 255;
            selw |= (unsigned)bi << (8 * s);
#pragma unroll
            for (int nt = 0; nt < 4; ++nt)
#pragma unroll
                for (int j = 0; j < 4; ++j) if (nt * 16 + fq * 4 + j == bi) sc[nt][j] = -3.0e38f;
            if (fq == 0 && bi != 255) atomicAdd(&hist[h * 64 + bi], 1);
        }
        if (fq == 0) SEL[t * 8 + h] = selw | 0xff000000u;
    }
    __syncthreads();
    int* gcnt = (int*)(ws + OFF_CTL + CTL_MCNT);
    for (int i = tid; i < 512; i += NT) if (hist[i]) atomicAdd(&gcnt[i], hist[i]);
}

__device__ __forceinline__ void moba_fill(const P& p, int bid, int nb, char* smem) {
    const int tid = otid();
    char* ws = p.ws;
    const int* gcnt = (const int*)(ws + OFF_CTL + CTL_MCNT); int* gcur = (int*)(ws + OFF_CTL + CTL_MCUR);
    int* lst = (int*)smem;
    int* tst = lst + 520;
    int* lh = tst + 520;
    int* lc = lh + 512;
    for (int i = tid; i < 512; i += NT) lc[i] = gcnt[i];
    __syncthreads();
    if (tid == 0) {
        int a = 0, b = 0;
        for (int i = 0; i < 512; ++i) { const int c = lc[i]; lst[i] = a; tst[i] = b; a += c; b += (c + 127) >> 7; }
        lst[512] = a; tst[512] = b;
    }
    __syncthreads();
    for (int i = tid; i < 512; i += NT) { lh[i] = 0; lc[i] = 0; }
    __syncthreads();
    if (bid == 0) {
        int* glst = (int*)(ws + OFF_CTL + CTL_MLST); int* gtst = (int*)(ws + OFF_CTL + CTL_MTST);
        for (int i = tid; i < 513; i += NT) { glst[i] = lst[i]; gtst[i] = tst[i]; }
    }
    const unsigned* SEL = (const unsigned*)(ws + OFF_MSEL);
    int* QL = (int*)(ws + OFF_MQL); int* SP = (int*)(ws + OFF_MSP);
    const int per = (T * 8 + nb - 1) / nb, i0 = bid * per, i1 = min(T * 8, i0 + per);
    for (int i = i0 + tid; i < i1; i += NT) {
        const unsigned sw = SEL[i]; const int h = i & 7;
#pragma unroll
        for (int s = 0; s < 3; ++s) { const int j = (sw >> (8 * s)) & 255; if (j != 255) atomicAdd(&lh[h * 64 + j], 1); }
    }
    __syncthreads();
    for (int i = tid; i < 512; i += NT) { const int c = lh[i]; lh[i] = c ? atomicAdd(&gcur[i], c) : 0; }
    __syncthreads();
    for (int i = i0 + tid; i < i1; i += NT) {
        const unsigned sw = SEL[i]; const int h = i & 7;
#pragma unroll
        for (int s = 0; s < 3; ++s) {
            const int j = (sw >> (8 * s)) & 255; int pos = -1;
            if (j != 255) { const int li = h * 64 + j; pos = lst[li] + lh[li] + atomicAdd(&lc[li], 1); QL[pos] = i >> 3; }
            SP[i * 3 + s] = pos;
        }
    }
}

__device__ __forceinline__ int t5b(int n) {
    const int v = (int)(__float_as_uint((float)(n * n)) >> 23) - 119;
    return n < 16 ? n : (v > 31 ? 31 : v);
}

__device__ __forceinline__ void attn_stage(const P& p, int j, int h, int nkeys, char* smem, int tid) {
    const bf16_t* um = (const bf16_t*)(p.ws + OFF_UM); const bf16_t* vt = (const bf16_t*)(p.ws + OFF_VT);
    for (int idx = tid; idx < nkeys * 8; idx += NT) {
        const int key = idx >> 3, ch = idx & 7;
        *(u32x4*)(smem + A_LK + key * 144 + ch * 16) = *(const u32x4*)(um + (size_t)(j * 256 + key) * UMC + 512 + h * 64 + ch * 8);
    }
    const int cpr = nkeys >> 3;
    for (int idx = tid; idx < 64 * cpr; idx += NT) {
        const int d = idx / cpr, ch = idx - d * cpr;
        *(u32x4*)(smem + A_LV + d * 528 + ch * 16) = *(const u32x4*)(vt + (size_t)(h * 64 + d) * T + j * 256 + ch * 8);
    }
    if (tid < 32) ((float*)(smem + A_BIAS))[tid] = p.rel_bias[tid * 8 + h];
}
template <bool CAUSAL>
__device__ __forceinline__ void attn_core(const char* smem, const bf16_t* qrow, int qt, int kbase, int nkeys, int fr, int fq, float& m_out, float& l_out, f32x4 (&o)[4]) {
    bf16x8 qf[2];
#pragma unroll
    for (int ks = 0; ks < 2; ++ks) qf[ks] = *(const bf16x8*)(qrow + ks * 32 + fq * 8);
    const float* lb = (const float*)(smem + A_BIAS);
    const int nkt = nkeys >> 4;
    f32x4 sc[16];
    float mx = -3.0e38f;
#pragma unroll
    for (int kt = 0; kt < 16; ++kt) {
        f32x4 acc = {0.f, 0.f, 0.f, 0.f};
        if (kt < nkt) {
#pragma unroll
            for (int ks = 0; ks < 2; ++ks) acc = MFMA16(*(const bf16x8*)(smem + A_LK + (kt * 16 + fr) * 144 + (ks * 32 + fq * 8) * 2), qf[ks], acc);
#pragma unroll
            for (int jj = 0; jj < 4; ++jj) {
                const int rel = qt - (kbase + kt * 16 + fq * 4 + jj);
                float l = acc[jj] * 0.125f + lb[t5b(rel < 0 ? 0 : rel)];
                if (CAUSAL && rel < 0) l = -3.0e38f;
                acc[jj] = l; mx = fmaxf(mx, l);
            }
        } else { acc = (f32x4){-3.0e38f, -3.0e38f, -3.0e38f, -3.0e38f}; }
        sc[kt] = acc;
    }
    mx = fmaxf(mx, __shfl_xor(mx, 16)); mx = fmaxf(mx, __shfl_xor(mx, 32));
    float ls = 0.f;
#pragma unroll
    for (int kt = 0; kt < 16; ++kt)
#pragma unroll
        for (int jj = 0; jj < 4; ++jj) { const float e = (sc[kt][jj] > -1.0e38f) ? __expf(sc[kt][jj] - mx) : 0.f; sc[kt][jj] = e; ls += e; }
    ls += __shfl_xor(ls, 16); ls += __shfl_xor(ls, 32);
#pragma unroll
    for (int dt = 0; dt < 4; ++dt) o[dt] = (f32x4){0.f, 0.f, 0.f, 0.f};
#pragma unroll
    for (int s = 0; s < 8; ++s) {
        if (s * 2 < nkt) {
            const bf16x8 pf = pack8(sc[2 * s], sc[2 * s + 1]);
#pragma unroll
            for (int dt = 0; dt < 4; ++dt) o[dt] = MFMA16(ldperm(smem + A_LV + (dt * 16 + fr) * 528, s, fq), pf, o[dt]);
        }
    }
    m_out = mx; l_out = ls;
}

__device__ __forceinline__ void moba_partial(const P& p, int bid, int nb, char* smem) {
    const int tid = otid(), lane = tid & 63, w = tid >> 6, fr = lane & 15, fq = lane >> 4;
    char* ws = p.ws;
    const bf16_t* um = (const bf16_t*)(ws + OFF_UM);
    const int* glst = (const int*)(ws + OFF_CTL + CTL_MLST); const int* gtst = (const int*)(ws + OFF_CTL + CTL_MTST);
    const int* QL = (const int*)(ws + OFF_MQL);
    bf16_t* PO = (bf16_t*)p.out; float* PM = (float*)((char*)p.out + 52 * MiB); float* PL = PM + 400000;
    int* tst = (int*)(smem + A_TST);
    for (int i = tid; i < 513; i += NT) tst[i] = gtst[i];
    __syncthreads();
    const int ntiles = tst[512];
    for (int it = bid; it < ntiles; it += nb) {
        int lo = 0, hi = 512;
        while (hi - lo > 1) { const int mid = (lo + hi) >> 1; if (tst[mid] <= it) lo = mid; else hi = mid; }
        const int li = lo, h = li >> 6, j = li & 63, r = it - tst[li];
        const int l0 = glst[li], l1 = glst[li + 1], base = l0 + r * 128;
        attn_stage(p, j, h, 256, smem, tid);
        __syncthreads();
        const int idx = w * 16 + fr; const bool valid = base + idx < l1;
        const int pos = valid ? base + idx : base;
        const int qt = QL[pos];
        float m, l; f32x4 o[4];
        attn_core<false>(smem, um + (size_t)qt * UMC + h * 64, qt, j * 256, 256, fr, fq, m, l, o);
        if (valid) {
#pragma unroll
            for (int dt = 0; dt < 4; ++dt) *(u32x2*)(PO + (size_t)pos * 64 + dt * 16 + fq * 4) = pack4(o[dt]);
            if (fq == 0) { PM[pos] = m; PL[pos] = l; }
        }
        __syncthreads();
    }
}

__device__ __forceinline__ void moba_own(const P& p, int bid, int nb, char* smem) {
    const int tid = otid(), lane = tid & 63, w = tid >> 6, fr = lane & 15, fq = lane >> 4;
    char* ws = p.ws;
    const bf16_t* um = (const bf16_t*)(ws + OFF_UM);
    const int* SP = (const int*)(ws + OFF_MSP);
    const bf16_t* PO = (const bf16_t*)p.out; const float* PM = (const float*)((const char*)p.out + 52 * MiB); const float* PL = PM + 400000;
    bf16_t* ob = (bf16_t*)(ws + OFF_OB);
    for (int it = bid; it < 1024; it += nb) {
        const int tile = it >> 3, h = it & 7, b = tile >> 1, tb = tile & 1, nkeys = (tb + 1) * 128;
        attn_stage(p, b, h, nkeys, smem, tid);
        __syncthreads();
        const int qt = tile * 128 + w * 16 + fr;
        float m, l; f32x4 o[4];
        attn_core<true>(smem, um + (size_t)qt * UMC + h * 64, qt, b * 256, nkeys, fr, fq, m, l, o);
        int pos[3]; float pm[3]; float M = m;
#pragma unroll
        for (int s = 0; s < 3; ++s) { pos[s] = SP[(qt * 8 + h) * 3 + s]; pm[s] = (pos[s] >= 0) ? PM[pos[s]] : -3.0e38f; M = fmaxf(M, pm[s]); }
        const float so = __expf(m - M);
        float den = l * so;
#pragma unroll
        for (int dt = 0; dt < 4; ++dt) o[dt] = o[dt] * so;
#pragma unroll
        for (int s = 0; s < 3; ++s) {
            if (pos[s] >= 0) {
                const float e = __expf(pm[s] - M);
                den += PL[pos[s]] * e;
#pragma unroll
                for (int dt = 0; dt < 4; ++dt) {
                    const u32x2 pv = *(const u32x2*)(PO + (size_t)pos[s] * 64 + dt * 16 + fq * 4);
                    o[dt].x += e * __uint_as_float(pv.x << 16); o[dt].y += e * __uint_as_float(pv.x & 0xffff0000u);
                    o[dt].z += e * __uint_as_float(pv.y << 16); o[dt].w += e * __uint_as_float(pv.y & 0xffff0000u);
                }
            }
        }
        const float inv = 1.f / den;
#pragma unroll
        for (int dt = 0; dt < 4; ++dt) *(u32x2*)(ob + (size_t)qt * 512 + h * 64 + dt * 16 + fq * 4) = pack4(o[dt] * inv);
        __syncthreads();
    }
}


__device__ __forceinline__ void phase_kvx(const P& p, int bid0, int nb0, char* smem) {
    char* ws = p.ws;
    bf16_t* KX = (bf16_t*)(ws + OFF_KVX); bf16_t* VXT = KX + 256 * 512;
    for (int it = bid0; it < 8; it += nb0) {
        f32x4 acc[2][8];
#pragma unroll
        for (int m = 0; m < 2; ++m)
#pragma unroll
            for (int n = 0; n < 8; ++n) acc[m][n] = (f32x4){0.f, 0.f, 0.f, 0.f};
        gemm_r32(acc, (const bf16_t*)(ws + OFF_MEMN), D, 0, (const bf16_t*)(ws + OFF_WKV), D, it * 128, D, smem);
        const int tid = otid(), lane = tid & 63, w = tid >> 6, fr = lane & 15, fq = lane >> 4;
#pragma unroll
        for (int m = 0; m < 2; ++m) {
            const int row = w * 32 + m * 16 + fr;
#pragma unroll
            for (int n = 0; n < 8; ++n) {
                const f32x4 v = acc[m][n];
                if (it < 4) *(u32x2*)(KX + (size_t)row * 512 + it * 128 + n * 16 + fq * 4) = pack4(v);
                else {
                    const int col = (it - 4) * 128 + n * 16 + fq * 4;
                    VXT[(size_t)(col + 0) * 256 + row] = (bf16_t)f2bf(v.x); VXT[(size_t)(col + 1) * 256 + row] = (bf16_t)f2bf(v.y);
                    VXT[(size_t)(col + 2) * 256 + row] = (bf16_t)f2bf(v.z); VXT[(size_t)(col + 3) * 256 + row] = (bf16_t)f2bf(v.w);
                }
            }
        }
    }
}

__device__ __forceinline__ void phase_qx_xattn(const P& p, int bid, int nb, char* smem) {
    char* ws = p.ws;
    const bf16_t* KX = (const bf16_t*)(ws + OFF_KVX); const bf16_t* VXT = KX + 256 * 512;
    bf16_t* ox = (bf16_t*)(ws + OFF_OB);
    for (int it = bid; it < 256; it += nb) {
        const int pm = it >> 2, h = it & 3;
        bf16x8 qf[2][4];
        {
            f32x4 acc[2][8];
#pragma unroll
            for (int m = 0; m < 2; ++m)
#pragma unroll
                for (int n = 0; n < 8; ++n) acc[m][n] = (f32x4){0.f, 0.f, 0.f, 0.f};
            gemm_r32(acc, (const bf16_t*)(ws + OFF_XN), D, pm * 256, (const bf16_t*)(ws + OFF_WQ), D, h * 128, D, smem);
            const float sc = 0.08838834764831845f;
#pragma unroll
            for (int m = 0; m < 2; ++m)
#pragma unroll
                for (int s2 = 0; s2 < 4; ++s2) qf[m][s2] = pack8(acc[m][2 * s2] * sc, acc[m][2 * s2 + 1] * sc);
        }
        const int tid = otid(), lane = tid & 63, w = tid >> 6, fr = lane & 15, fq = lane >> 4;
        for (int idx = tid; idx < 4096; idx += NT) { const int key = idx >> 4, ch = idx & 15; *(u32x4*)(smem + key * 272 + ch * 16) = *(const u32x4*)(KX + (size_t)key * 512 + h * 128 + ch * 8); }
        __syncthreads();
        bf16x8 pf[2][8]; float inv[2];
#pragma unroll
        for (int m = 0; m < 2; ++m) {
            f32x4 sc[16]; float mx = -3.0e38f;
#pragma unroll
            for (int kt = 0; kt < 16; ++kt) {
                f32x4 a = {0.f, 0.f, 0.f, 0.f};
#pragma unroll
                for (int s2 = 0; s2 < 4; ++s2) a = MFMA16(ldperm(smem + (kt * 16 + fr) * 272, s2, fq), qf[m][s2], a);
                sc[kt] = a; mx = fmaxf(fmaxf(mx, fmaxf(a.x, a.y)), fmaxf(a.z, a.w));
            }
            mx = fmaxf(mx, __shfl_xor(mx, 16)); mx = fmaxf(mx, __shfl_xor(mx, 32));
            float ls = 0.f;
#pragma unroll
            for (int kt = 0; kt < 16; ++kt) { sc[kt].x = __expf(sc[kt].x - mx); sc[kt].y = __expf(sc[kt].y - mx); sc[kt].z = __expf(sc[kt].z - mx); sc[kt].w = __expf(sc[kt].w - mx); ls += (sc[kt].x + sc[kt].y) + (sc[kt].z + sc[kt].w); }
            ls += __shfl_xor(ls, 16); ls += __shfl_xor(ls, 32);
            inv[m] = 1.f / ls;
#pragma unroll
            for (int s2 = 0; s2 < 8; ++s2) { pf[m][s2] = pack8(sc[2 * s2], sc[2 * s2 + 1]); asm volatile("" : "+v"(pf[m][s2])); }
            asm volatile("" ::: "memory");
        }
        __syncthreads();
        for (int idx = tid; idx < 4096; idx += NT) { const int d = idx >> 5, ch = idx & 31; *(u32x4*)(smem + d * 528 + ch * 16) = *(const u32x4*)(VXT + (size_t)(h * 128 + d) * 256 + ch * 8); }
        __syncthreads();
#pragma unroll
        for (int m = 0; m < 2; ++m) {
            const int row = pm * 256 + w * 32 + m * 16 + fr;
#pragma unroll
            for (int dt = 0; dt < 8; ++dt) {
                f32x4 o = {0.f, 0.f, 0.f, 0.f};
#pragma unroll
                for (int s2 = 0; s2 < 8; ++s2) o = MFMA16(ldperm(smem + (dt * 16 + fr) * 528, s2, fq), pf[m][s2], o);
                *(u32x2*)(ox + (size_t)row * 512 + h * 128 + dt * 16 + fq * 4) = pack4(o * inv[m]);
                asm volatile("" ::: "memory");
            }
        }
        __syncthreads();
    }
}

struct EpiMergeA {
    static constexpr bool PERM = true;
    char* ws;
    __device__ __forceinline__ void operator()(const f32x4 (&acc)[2][2][4][2], const pg8::Unit& u, int wr, int wc, int fr, int fq) const {
        const bf16_t* ug = (const bf16_t*)(ws + OFF_UG); bf16_t* mg = (bf16_t*)(ws + OFF_MRG);
        const int row0 = u.pm * 256 + wr * 64 + fr, col0 = u.pn * 256 + wc * 32 + 8 * fq;
#pragma unroll
        for (int ai = 0; ai < 2; ++ai)
#pragma unroll
            for (int m = 0; m < 4; ++m) {
                const size_t row = row0 + ai * 128 + m * 16;
#pragma unroll
                for (int bj = 0; bj < 2; ++bj) {
                    const int col = col0 + bj * 128;
                    float g[8]; unpack8(*(const u32x4*)(ug + row * GCOLS + col), g);
                    const f32x4 a = acc[ai][bj][m][0], b = acc[ai][bj][m][1];
                    u32x4 w; w.x = cvt_pk(g[0] * a.x, g[1] * a.y); w.y = cvt_pk(g[2] * a.z, g[3] * a.w); w.z = cvt_pk(g[4] * b.x, g[5] * b.y); w.w = cvt_pk(g[6] * b.z, g[7] * b.w);
                    *(u32x4*)(mg + row * D + col) = w;
                }
            }
    }
};
struct EpiMergeB {
    static constexpr bool PERM = true;
    char* ws;
    __device__ __forceinline__ void operator()(const f32x4 (&acc)[2][2][4][2], const pg8::Unit& u, int wr, int wc, int fr, int fq) const {
        const bf16_t* ug = (const bf16_t*)(ws + OFF_UG); bf16_t* mg = (bf16_t*)(ws + OFF_MRG);
        const int row0 = u.pm * 256 + wr * 64 + fr, col0 = u.pn * 256 + wc * 32 + 8 * fq;
#pragma unroll
        for (int ai = 0; ai < 2; ++ai)
#pragma unroll
            for (int m = 0; m < 4; ++m) {
                const size_t row = row0 + ai * 128 + m * 16;
#pragma unroll
                for (int bj = 0; bj < 2; ++bj) {
                    const int col = col0 + bj * 128;
                    float g[8], t[8]; unpack8(*(const u32x4*)(ug + row * GCOLS + 1024 + col), g); unpack8(*(const u32x4*)(mg + row * D + col), t);
                    const f32x4 a = acc[ai][bj][m][0], b = acc[ai][bj][m][1];
                    u32x4 w; w.x = cvt_pk(t[0] + g[0] * a.x, t[1] + g[1] * a.y); w.y = cvt_pk(t[2] + g[2] * a.z, t[3] + g[3] * a.w);
                    w.z = cvt_pk(t[4] + g[4] * b.x, t[5] + g[5] * b.y); w.w = cvt_pk(t[6] + g[6] * b.z, t[7] + g[7] * b.w);
                    *(u32x4*)(mg + row * D + col) = w;
                }
            }
    }
};
__device__ __forceinline__ void phase_merge(const P& p, int bid, int nb, char* smem) {
    pg8::StaticOrder S; S.init(T, D, nb, bid);
    EpiMergeA EA{p.ws}; EpiMergeB EB{p.ws};
    pg8::gemm_phase<EpiMergeA, pg8::StaticOrder, true>((LAS unsigned char*)smem, (const bf16_t*)(p.ws + OFF_OA), (const bf16_t*)(p.ws + OFF_WORW), 512, S, EA);
    pg8::gemm_phase<EpiMergeB, pg8::StaticOrder, true>((LAS unsigned char*)smem, (const bf16_t*)(p.ws + OFF_OB), (const bf16_t*)(p.ws + OFF_WOMB), 512, S, EB);
}
struct EpiResid {
    static constexpr bool PERM = false;
    const float* res; float* out;
    __device__ __forceinline__ void operator()(const f32x4 (&acc)[2][2][4][2], const pg8::Unit& u, int wr, int wc, int fr, int fq) const {
        const int row0 = u.pm * 256 + wr * 64 + fr, col0 = u.pn * 256 + wc * 32 + 4 * fq;
#pragma unroll
        for (int ai = 0; ai < 2; ++ai)
#pragma unroll
            for (int m = 0; m < 4; ++m) {
                const size_t off = (size_t)(row0 + ai * 128 + m * 16) * D + col0;
#pragma unroll
                for (int bj = 0; bj < 2; ++bj)
#pragma unroll
                    for (int n = 0; n < 2; ++n) { const f32x4 r = *(const f32x4*)(res + off + bj * 128 + n * 16); *(f32x4*)(out + off + bj * 128 + n * 16) = r + acc[ai][bj][m][n]; }
            }
    }
};
__device__ __forceinline__ void phase_resid_gemm(const bf16_t* A, int K, const bf16_t* Bt, const float* res, float* dst, int bid, int nb, char* smem) {
    pg8::StaticOrder S; S.init(T, D, nb, bid);
    EpiResid E{res, dst};
    pg8::gemm_phase<EpiResid, pg8::StaticOrder, true>((LAS unsigned char*)smem, A, Bt, K, S, E);
}
__device__ __forceinline__ void phase_norm(const float* src, const float* g, bf16_t* dst, int bid, int nb) {
    const int lane = otid() & 63, wid = otid() >> 6;
    for (int it = bid; it < T / 8; it += nb) { const int row = it * 8 + wid; rms_row_bf16(src + (size_t)row * D, g, dst + (size_t)row * D, lane); }
}
__device__ __forceinline__ void phase_expconv(const P& p, int bid, int nb, char* smem) {
    float* scr = (float*)smem;
    bf16_t* gu = (bf16_t*)(p.ws + OFF_EXPGU); bf16_t* dn = (bf16_t*)(p.ws + OFF_EXPD);
    for (int it = bid; it < 3 * 32 * 64; it += nb) {
        const int which = it / 2048, r = it % 2048, e = r >> 6, tile = r & 63;
        if (which == 0) transpose_tile(p.w_exp_gate + (size_t)e * D * DEXP, D, DEXP, gu + (size_t)e * D * D, 32, 0, tile, scr);
        else if (which == 1) transpose_tile(p.w_exp_up + (size_t)e * D * DEXP, D, DEXP, gu + (size_t)e * D * D, 32, 16, tile, scr);
        else transpose_tile(p.w_exp_down + (size_t)e * DEXP * D, DEXP, D, dn + (size_t)e * D * DEXP, 16, 0, tile, scr);
    }
}

__device__ __forceinline__ void phase_router(const P& p, int bid, int nb, char* smem) {
    const int tid = otid(), lane = tid & 63, wid = tid >> 6;
    char* ws = p.ws;
    int* hist = (int*)smem;
    if (tid < 32) hist[tid] = 0;
    __syncthreads();
    const float* x2 = p.out;
    const float* rt = (const float*)(ws + OFF_ROUT);
    bf16_t* xn = (bf16_t*)(ws + OFF_XN);
    int* toke = (int*)(ws + OFF_CTL + CTL_TOKE); float* tokg = (float*)(ws + OFF_CTL + CTL_TOKG);
    int* rowtok = (int*)(ws + OFF_CTL + CTL_ROWTOK);
    for (int i = bid * NT + tid; i < CAP; i += nb * NT) rowtok[i] = 0;
    for (int it = bid; it < T / 32; it += nb) {
        const int rbase = it * 32 + wid * 4;
        f32x4 hv[4][4];
#pragma unroll
        for (int rr = 0; rr < 4; ++rr) {
            const f32x4* xr = (const f32x4*)(x2 + (size_t)(rbase + rr) * D) + lane; const f32x4* gr = (const f32x4*)p.norm_ffn + lane;
            float s = 0.f;
#pragma unroll
            for (int j = 0; j < 4; ++j) { hv[rr][j] = xr[64 * j]; s += hv[rr][j].x * hv[rr][j].x + hv[rr][j].y * hv[rr][j].y + hv[rr][j].z * hv[rr][j].z + hv[rr][j].w * hv[rr][j].w; }
            const float rstd = rsqrtf(wave_sum(s) * (1.f / 1024.f) + 1e-6f);
            u32x2* o8 = (u32x2*)(xn + (size_t)(rbase + rr) * D) + lane;
#pragma unroll
            for (int j = 0; j < 4; ++j) { const f32x4 gg = gr[64 * j]; hv[rr][j] = hv[rr][j] * rstd * gg; o8[64 * j] = pack4(hv[rr][j]); }
        }
        float mine[4] = {0.f, 0.f, 0.f, 0.f};
#pragma unroll 4
        for (int o = 0; o < 36; ++o) {
            const f32x4* wr_ = (const f32x4*)(rt + o * 1024) + lane;
            f32x4 w[4];
#pragma unroll
            for (int j = 0; j < 4; ++j) w[j] = wr_[64 * j];
#pragma unroll
            for (int rr = 0; rr < 4; ++rr) {
                float s = 0.f;
#pragma unroll
                for (int j = 0; j < 4; ++j) s += hv[rr][j].x * w[j].x + hv[rr][j].y * w[j].y + hv[rr][j].z * w[j].z + hv[rr][j].w * w[j].w;
                s = wave_sum(s);
                if (lane == o) mine[rr] = s;
            }
            asm volatile("" ::: "memory");
        }
#pragma unroll
        for (int rr = 0; rr < 4; ++rr) {
            const float g0 = __shfl(mine[rr], 32), g1 = __shfl(mine[rr], 33), g2 = __shfl(mine[rr], 34), g3 = __shfl(mine[rr], 35);
            int gs = 0; float gm = g0;
            if (g1 > gm) { gm = g1; gs = 1; }
            if (g2 > gm) { gm = g2; gs = 2; }
            if (g3 > gm) { gm = g3; gs = 3; }
            const float gp = 1.f / (__expf(g0 - gm) + __expf(g1 - gm) + __expf(g2 - gm) + __expf(g3 - gm));
            float e[8];
#pragma unroll
            for (int i = 0; i < 8; ++i) e[i] = __shfl(mine[rr], gs * 8 + i);
            int i1 = 0; float v1 = e[0];
#pragma unroll
            for (int i = 1; i < 8; ++i) if (e[i] > v1) { v1 = e[i]; i1 = i; }
            int i2 = -1; float v2 = -3.0e38f;
#pragma unroll
            for (int i = 0; i < 8; ++i) if (i != i1 && e[i] > v2) { v2 = e[i]; i2 = i; }
            const float e2 = __expf(v2 - v1), den = 1.f / (1.f + e2);
            if (lane == 0) {
                const int tok = rbase + rr;
                toke[tok * 2] = gs * 8 + i1; toke[tok * 2 + 1] = gs * 8 + i2;
                tokg[tok * 2] = gp * den; tokg[tok * 2 + 1] = gp * e2 * den;
                atomicAdd(&hist[gs * 8 + i1], 1); atomicAdd(&hist[gs * 8 + i2], 1);
            }
        }
    }
    __syncthreads();
    if (tid < 32 && hist[tid]) atomicAdd((int*)(ws + OFF_CTL + CTL_CNT) + tid, hist[tid]);
}
__device__ __forceinline__ void phase_dispatch(const P& p, int bid, int nb, char* smem) {
    const int tid = otid();
    char* ws = p.ws;
    int* pstart = (int*)smem;
    const int* counts = (const int*)(ws + OFF_CTL + CTL_CNT);
    int* cursor = (int*)(ws + OFF_CTL + CTL_CNT) + 32;
    if (tid == 0) { int a = 0; for (int e = 0; e < 32; ++e) { pstart[e] = a; a += (counts[e] + MBLK - 1) / MBLK * MBLK; } pstart[32] = a; }
    __syncthreads();
    const int* toke = (const int*)(ws + OFF_CTL + CTL_TOKE);
    int* toks = (int*)(ws + OFF_CTL + CTL_TOKS); int* rowtok = (int*)(ws + OFF_CTL + CTL_ROWTOK);
    for (int i = bid * NT + tid; i < T * 2; i += nb * NT) {
        const int e = toke[i];
        const int pos = pstart[e] + atomicAdd(&cursor[e], 1);
        rowtok[pos] = i >> 1; toks[i] = pos;
    }
    if (bid == 0) {
        int* blke = (int*)(ws + OFF_CTL + CTL_BLKE);
        for (int b = tid; b < NBLK; b += NT) {
            const int r = b * MBLK; int e = -1;
            if (r < pstart[32]) { e = 0; while (pstart[e + 1] <= r) ++e; }
            blke[b] = e;
        }
        if (tid == 0) blke[NBLK] = pstart[32] / MBLK;
    }
}
struct MoeOrder {
    const int* blke; const int* rowtok; int nunits, G, c; bool gather; int brows;
    __device__ bool next(int i, pg8::Unit& u) const {
        const int L = i * G + c; if (L >= nunits) return false;
        u.pm = L >> 2; u.pn = L & 3; u.e = blke[u.pm]; return true;
    }
    __device__ __forceinline__ unsigned rowA(const pg8::Unit& u, int r) const { return gather ? (unsigned)rowtok[u.pm * MBLK + r] : (unsigned)(u.pm * MBLK + r); }
    __device__ __forceinline__ unsigned rowB(const pg8::Unit& u, int r) const { return (unsigned)(u.e * brows + u.pn * 256 + r); }
};
struct EpiHid {
    static constexpr bool PERM = false;
    bf16_t* hid;
    __device__ __forceinline__ void operator()(const f32x4 (&acc)[2][2][4][2], const pg8::Unit& u, int wr, int wc, int fr, int fq) const {
        const int row0 = u.pm * 256 + wr * 64 + fr, col0 = u.pn * 128 + wc * 16 + 4 * fq;
#pragma unroll
        for (int ai = 0; ai < 2; ++ai)
#pragma unroll
            for (int m = 0; m < 4; ++m) {
                bf16_t* rowp = hid + (size_t)(row0 + ai * 128 + m * 16) * DEXP + col0;
#pragma unroll
                for (int bj = 0; bj < 2; ++bj) {
                    const f32x4 g = acc[ai][bj][m][0], uu = acc[ai][bj][m][1];
                    f32x4 hval; hval.x = g.x * sigm(g.x) * uu.x; hval.y = g.y * sigm(g.y) * uu.y; hval.z = g.z * sigm(g.z) * uu.z; hval.w = g.w * sigm(g.w) * uu.w;
                    *(u32x2*)(rowp + bj * 64) = pack4(hval);
                }
            }
    }
};
struct EpiY {
    static constexpr bool PERM = true;
    bf16_t* ym;
    __device__ __forceinline__ void operator()(const f32x4 (&acc)[2][2][4][2], const pg8::Unit& u, int wr, int wc, int fr, int fq) const {
        const int row0 = u.pm * 256 + wr * 64 + fr, col0 = u.pn * 256 + wc * 32 + 8 * fq;
#pragma unroll
        for (int ai = 0; ai < 2; ++ai)
#pragma unroll
            for (int m = 0; m < 4; ++m) {
                bf16_t* rowp = ym + (size_t)(row0 + ai * 128 + m * 16) * D + col0;
#pragma unroll
                for (int bj = 0; bj < 2; ++bj) {
                    const f32x4 v0 = acc[ai][bj][m][0], v1 = acc[ai][bj][m][1];
                    u32x4 w; w.x = cvt_pk(v0.x, v0.y); w.y = cvt_pk(v0.z, v0.w); w.z = cvt_pk(v1.x, v1.y); w.w = cvt_pk(v1.z, v1.w);
                    *(u32x4*)(rowp + bj * 128) = w;
                }
            }
    }
};
__device__ __forceinline__ void phase_exp1(const P& p, int bid, int nb, char* smem) {
    char* ws = p.ws;
    const int* blke = (const int*)(ws + OFF_CTL + CTL_BLKE);
    MoeOrder S{blke, (const int*)(ws + OFF_CTL + CTL_ROWTOK), blke[NBLK] * 4, nb, bid, true, 1024};
    EpiHid E{(bf16_t*)(ws + OFF_MRG)};
    pg8::gemm_phase<EpiHid, MoeOrder, true>((LAS unsigned char*)smem, (const bf16_t*)(ws + OFF_XN), (const bf16_t*)(ws + OFF_EXPGU), D, S, E);
}
__device__ __forceinline__ void phase_exp2(const P& p, int bid, int nb, char* smem) {
    char* ws = p.ws;
    const int* blke = (const int*)(ws + OFF_CTL + CTL_BLKE);
    MoeOrder S{blke, nullptr, blke[NBLK] * 4, nb, bid, false, 1024};
    EpiY E{(bf16_t*)(ws + OFF_YMOE)};
    pg8::gemm_phase<EpiY, MoeOrder, true>((LAS unsigned char*)smem, (const bf16_t*)(ws + OFF_MRG), (const bf16_t*)(ws + OFF_EXPD), DEXP, S, E);
}
__device__ __forceinline__ void phase_final(const P& p, int bid, int nb) {
    const int lane = otid() & 63, wid = otid() >> 6;
    char* ws = p.ws;
    const int* toks = (const int*)(ws + OFF_CTL + CTL_TOKS); const float* tokg = (const float*)(ws + OFF_CTL + CTL_TOKG);
    const bf16_t* ym = (const bf16_t*)(ws + OFF_YMOE);
    for (int it = bid; it < T / 8; it += nb) {
        const int row = it * 8 + wid;
        const int s1 = toks[row * 2], s2 = toks[row * 2 + 1]; const float g1 = tokg[row * 2], g2 = tokg[row * 2 + 1];
        f32x4* xr = (f32x4*)(p.out + (size_t)row * D) + lane; const f32x4* gr = (const f32x4*)p.norm_final + lane;
        const u32x2* y1 = (const u32x2*)(ym + (size_t)s1 * D) + lane; const u32x2* y2 = (const u32x2*)(ym + (size_t)s2 * D) + lane;
        f32x4 v[4]; float s = 0.f;
#pragma unroll
        for (int j = 0; j < 4; ++j) {
            v[j] = xr[64 * j] + g1 * unpack4(y1[64 * j]) + g2 * unpack4(y2[64 * j]);
            s += v[j].x * v[j].x + v[j].y * v[j].y + v[j].z * v[j].z + v[j].w * v[j].w;
        }
        const float rstd = rsqrtf(wave_sum(s) * (1.f / 1024.f) + 1e-6f);
#pragma unroll
        for (int j = 0; j < 4; ++j) xr[64 * j] = v[j] * rstd * gr[64 * j];
    }
}

template <int PH>
__device__ __forceinline__ void run_phase(const P& p, int bid, int nb, char* smem) {
    char* ws = p.ws;
    if (PH == 0) phase0(p, bid, nb, smem);
    else if (PH == 1) phase1(p, bid, nb, smem);
    else if (PH == 2) { phase_kmean(p, bid, nb, smem); phase_rw_chunk(p, bid, nb, smem); }
    else if (PH == 3) {
        if (bid < 32) { if ((otid() >> 6) == 0) rw_scan(p, bid); }
        else { moba_select(p, bid - 32, nb - 32, smem); phase_kvx(p, bid - 32, nb - 32, smem); }
    }
    else if (PH == 4) { phase_rw_out(p, bid, nb); moba_fill(p, bid, nb, smem); __syncthreads(); phase_vtrans(p, bid, nb, smem); }
    else if (PH == 5) moba_partial(p, bid, nb, smem);
    else if (PH == 6) moba_own(p, bid, nb, smem);
    else if (PH == 7) phase_merge(p, bid, nb, smem);
    else if (PH == 8) phase_resid_gemm((const bf16_t*)(ws + OFF_MRG), D, (const bf16_t*)(ws + OFF_WOUT), p.x, p.out, bid, nb, smem);
    else if (PH == 9) { phase_norm(p.out, p.norm_xattn, (bf16_t*)(ws + OFF_XN), bid, nb); phase_expconv(p, bid, nb, smem); }
    else if (PH == 10) phase_qx_xattn(p, bid, nb, smem);
    else if (PH == 11) phase_resid_gemm((const bf16_t*)(ws + OFF_OB), 512, (const bf16_t*)(ws + OFF_WOX), p.out, p.out, bid, nb, smem);
    else if (PH == 12) phase_router(p, bid, nb, smem);
    else if (PH == 13) phase_dispatch(p, bid, nb, smem);
    else if (PH == 14) phase_exp1(p, bid, nb, smem);
    else if (PH == 15) phase_exp2(p, bid, nb, smem);
    else if (PH == 16) phase_final(p, bid, nb);
}

#define XB_TMO      128
#define XB_XCNT(j)  (256  + 64 * (j))
#define XB_XSUB(j)  (1280 + 64 * (j))
#define XB_XGEN(j)  (2304 + 64 * (j))
#define XB_TOP      3328
#define XB_TOPGEN   3392
#define XCD_BAR_WORDS 3456
#define XB_SPIN_CAP (1u << 18)
__device__ __forceinline__ unsigned xb_ld(unsigned* p)              { return __hip_atomic_load(p, __ATOMIC_RELAXED, __HIP_MEMORY_SCOPE_AGENT); }
__device__ __forceinline__ unsigned xb_add(unsigned* p, unsigned v) { return __hip_atomic_fetch_add(p, v, __ATOMIC_RELAXED, __HIP_MEMORY_SCOPE_AGENT); }
__device__ __forceinline__ unsigned xb_xcc_id() { return (unsigned)__builtin_amdgcn_s_getreg((3 << 11) | 20) & 0xFu; }
#define XB_SPIN(cond, bar) do { unsigned _sp = 0; while (cond) { __builtin_amdgcn_s_sleep(1); \
    if ((++_sp & 255u) == 0u) { if (xb_ld(&(bar)[XB_TMO])) break; if (_sp > XB_SPIN_CAP) { atomicAdd(&(bar)[XB_TMO], 1u); break; } } } } while (0)
struct XcdBarrier { unsigned* bar; unsigned x; volatile LAS unsigned* st; };
__device__ __forceinline__ XcdBarrier xcd_barrier_post(unsigned* bar, volatile LAS unsigned* st) {
    XcdBarrier b; b.bar = bar; b.x = xb_xcc_id(); b.st = st;
    if (threadIdx.x == 0) (void)xb_add(&bar[XB_XCNT(b.x)], 1u);
    return b;
}
__device__ __forceinline__ void xcd_barrier_complete(unsigned* bar, unsigned x, unsigned& nloc, unsigned& nx) {
    const unsigned G = gridDim.x * gridDim.y * gridDim.z;
    unsigned sum, cnt, mine, sp = 0u;
    for (;;) {
        sum = 0u; cnt = 0u; mine = 0u;
#pragma unroll
        for (unsigned j = 0; j < 16; ++j) { const unsigned c = xb_ld(&bar[XB_XCNT(j)]); sum += c; cnt += (c > 0u) ? 1u : 0u; mine = (j == x) ? c : mine; }
        if (sum == G) break;
        __builtin_amdgcn_s_sleep(1);
        if ((++sp & 255u) == 0u) { if (xb_ld(&bar[XB_TMO])) break; if (sp > XB_SPIN_CAP) { atomicAdd(&bar[XB_TMO], 1u); break; } }
    }
    nloc = mine > 0u ? mine : 1u; nx = cnt > 0u ? cnt : 1u;
}
__device__ __forceinline__ void xcd_barrier(const XcdBarrier& b) {
    asm volatile("s_waitcnt vmcnt(0)" ::: "memory");
    __syncthreads();
    if (threadIdx.x == 0) {
        unsigned* bar = b.bar;
        __builtin_amdgcn_s_waitcnt(0);
        unsigned nloc = b.st[0], nx = b.st[1];
        if (nloc == 0u) { xcd_barrier_complete(bar, b.x, nloc, nx); b.st[0] = nloc; b.st[1] = nx; }
        const unsigned old = xb_add(&bar[XB_XSUB(b.x)], 1u);
        const unsigned gen = old / nloc;
        if (old + 1u == (gen + 1u) * nloc) {
            __builtin_amdgcn_fence(__ATOMIC_RELEASE, "agent");
            asm volatile("s_waitcnt vmcnt(0)" ::: "memory");
            const unsigned og = xb_add(&bar[XB_TOP], 1u);
            const unsigned tg = og / nx;
            if (og + 1u == (tg + 1u) * nx) xb_add(&bar[XB_TOPGEN], 1u);
            else XB_SPIN(xb_ld(&bar[XB_TOPGEN]) == tg, bar);
            __builtin_amdgcn_fence(__ATOMIC_ACQUIRE, "agent");
            xb_add(&bar[XB_XGEN(b.x)], 1u);
            asm volatile("s_waitcnt vmcnt(0)" ::: "memory");
        } else {
            XB_SPIN(xb_ld(&bar[XB_XGEN(b.x)]) == gen, bar);
            __builtin_amdgcn_fence(__ATOMIC_ACQUIRE, "agent");
            asm volatile("s_waitcnt vmcnt(0)" ::: "memory");
        }
    }
    __syncthreads();
}
constexpr int L_BARST = 154112;
constexpr int LDS_BYTES = 154368;
static_assert(2 * RW_LDS <= L_BARST && pg8::STAGE_BYTES <= L_BARST && A_TST + 2052 <= L_BARST, "lds");

__global__ void __launch_bounds__(NT, 2) mega_kernel(P p) {
    extern __shared__ __attribute__((aligned(16))) char smem[];
    const int bid = blockIdx.x, nb = gridDim.x;
    volatile LAS unsigned* bst = (volatile LAS unsigned*)(LAS char*)(smem + L_BARST);
    if (threadIdx.x < 2) bst[threadIdx.x] = 0u;
    __syncthreads();
    const XcdBarrier xb = xcd_barrier_post((unsigned*)(p.ws + OFF_CTL + CTL_BAR), bst);
#define GSYNC() xcd_barrier(xb)
    run_phase<0>(p, bid, nb, smem); GSYNC();
    run_phase<1>(p, bid, nb, smem); GSYNC();
    run_phase<2>(p, bid, nb, smem); GSYNC();
    run_phase<3>(p, bid, nb, smem); GSYNC();
    run_phase<4>(p, bid, nb, smem); GSYNC();
    run_phase<5>(p, bid, nb, smem); GSYNC();
    run_phase<6>(p, bid, nb, smem); GSYNC();
    run_phase<7>(p, bid, nb, smem); GSYNC();
    run_phase<8>(p, bid, nb, smem); GSYNC();
    run_phase<9>(p, bid, nb, smem); GSYNC();
    run_phase<10>(p, bid, nb, smem); GSYNC();
    run_phase<11>(p, bid, nb, smem); GSYNC();
    run_phase<12>(p, bid, nb, smem); GSYNC();
    run_phase<13>(p, bid, nb, smem); GSYNC();
    run_phase<14>(p, bid, nb, smem); GSYNC();
    run_phase<15>(p, bid, nb, smem); GSYNC();
    run_phase<16>(p, bid, nb, smem);
}

extern "C" void kernel_launch(void* const* d_in, const int* in_sizes, int n_in, void* d_out, int out_size, void* d_ws, size_t ws_size, hipStream_t stream) {
    if (n_in != 31 || ws_size < WS_NEED || out_size != T * D) { fprintf(stderr, "kernel_launch: unexpected n_in %d / ws_size %zu / out_size %d\n", n_in, ws_size, out_size); return; }
    static int grid_blocks = 0;
    if (!grid_blocks) {
        int dev = 0, cus = 0, per_cu = 0;
        (void)hipGetDevice(&dev);
        (void)hipDeviceGetAttribute(&cus, hipDeviceAttributeMultiprocessorCount, dev);
        if (hipFuncSetAttribute((const void*)mega_kernel, hipFuncAttributeMaxDynamicSharedMemorySize, LDS_BYTES) != hipSuccess) fprintf(stderr, "kernel_launch: hipFuncSetAttribute failed\n");
        (void)hipOccupancyMaxActiveBlocksPerMultiprocessor(&per_cu, (const void*)mega_kernel, NT, LDS_BYTES);
        if (per_cu < 1) { fprintf(stderr, "kernel_launch: occupancy query returned %d\n", per_cu); per_cu = 1; }
        grid_blocks = cus;
        if (grid_blocks % 8) grid_blocks -= grid_blocks % 8;
        fprintf(stderr, "kernel_launch: cus %d per_cu %d grid %d\n", cus, per_cu, grid_blocks);
    }
    P p{};
    const float** f = (const float**)&p;
    for (int i = 0; i < 31; ++i) f[i] = (const float*)d_in[i];
    p.out = (float*)d_out; p.ws = (char*)d_ws;
    if (hipMemsetAsync((char*)d_ws + OFF_CTL + CTL_BAR, 0, XCD_BAR_WORDS * 4, stream) != hipSuccess) fprintf(stderr, "kernel_launch: memset failed\n");
    void* args[] = {&p};
    hipError_t e = hipLaunchCooperativeKernel((const void*)mega_kernel, dim3(grid_blocks), dim3(NT), args, LDS_BYTES, stream);
    if (e != hipSuccess) fprintf(stderr, "cooperative launch failed: %s (grid %d)\n", hipGetErrorString(e), grid_blocks);
}
```

```cpp
#include <hip/hip_runtime.h>
#include <cstdio>
#include <cstdint>

typedef unsigned short bf16_t;
typedef short bf16x8 __attribute__((ext_vector_type(8)));
typedef float f32x4 __attribute__((ext_vector_type(4)));
typedef float f32x2 __attribute__((ext_vector_type(2)));
typedef unsigned u32x4 __attribute__((ext_vector_type(4)));
typedef unsigned u32x2 __attribute__((ext_vector_type(2)));
typedef __bf16 bf16x2_t __attribute__((ext_vector_type(2)));
#define LAS __attribute__((address_space(3)))
#define MFMA16(a, b, c) __builtin_amdgcn_mfma_f32_16x16x32_bf16((a), (b), (c), 0, 0, 0)

constexpr int NT = 512;
constexpr int T = 16384, D = 1024, NMEM = 256;
constexpr int UMC = 1536;
constexpr int RW = 512, RCOLS = 1792, MW = 512, MCOLS = 1536, GCOLS = 2048, INCOLS = 5376;
constexpr int NEXP = 32, DEXP = 512, MBLK = 256, NBLK = 160, CAP = NBLK * MBLK;
constexpr size_t MiB = 1u << 20;
constexpr size_t OFF_CTL = 0;
constexpr size_t OFF_WIN = 1 * MiB;
constexpr size_t OFF_WORW = OFF_WIN + (size_t)INCOLS * D * 2;
constexpr size_t OFF_WOMB = OFF_WORW + 1 * MiB;
constexpr size_t OFF_WOUT = OFF_WOMB + 1 * MiB;
constexpr size_t OFF_WQ = OFF_WOUT + 2 * MiB;
constexpr size_t OFF_WKV = OFF_WQ + 1 * MiB;
constexpr size_t OFF_WOX = OFF_WKV + 2 * MiB;
constexpr size_t OFF_MEMN = OFF_WOX + 1 * MiB;
constexpr size_t OFF_KVX = OFF_MEMN + MiB / 2;
constexpr size_t OFF_ROUT = OFF_KVX + MiB / 2;
constexpr size_t OFF_LORA_D = OFF_ROUT + 160 * 1024;
constexpr size_t OFF_LORA_I = OFF_LORA_D + 64 * 1024;
constexpr size_t OFF_LORA_G = OFF_LORA_I + 64 * 1024;
constexpr size_t OFF_XN = 21 * MiB;
constexpr size_t OFF_BON = 21 * MiB;
constexpr size_t OFF_RH = 37 * MiB;
constexpr size_t OFF_UG = 53 * MiB;
constexpr size_t OFF_UR = 117 * MiB;
constexpr size_t OFF_UM = 173 * MiB;
constexpr size_t OFF_OA = 221 * MiB;
constexpr size_t OFF_OB = 237 * MiB;
constexpr size_t OFF_MRG = 253 * MiB;
constexpr size_t OFF_MF = 253 * MiB;
constexpr size_t OFF_SF = 269 * MiB;
constexpr size_t OFF_VT = 253 * MiB;
constexpr size_t OFF_EXPD = 117 * MiB;
constexpr size_t OFF_EXPGU = 149 * MiB;
constexpr size_t OFF_YMOE = 21 * MiB;
constexpr size_t OFF_MSEL = 285 * MiB;
constexpr size_t OFF_MQL = OFF_MSEL + MiB / 2;
constexpr size_t OFF_MSP = OFF_MQL + 3 * MiB / 2;
constexpr size_t WS_NEED = 293 * MiB;
static_assert(OFF_LORA_G + 128 * 1024 <= OFF_XN, "ws map");
constexpr size_t CTL_CNT = 0;
constexpr size_t CTL_BLKE = 4096;
constexpr size_t CTL_MCNT = 8192, CTL_MCUR = 10240, CTL_MLST = 12288, CTL_MTST = 14592, CTL_MCST = 16896;
constexpr size_t CTL_TOKE = 192 * 1024;
constexpr size_t CTL_TOKG = 320 * 1024;
constexpr size_t CTL_TOKS = 448 * 1024;
constexpr size_t CTL_ROWTOK = 576 * 1024;
constexpr size_t CTL_BAR = 752 * 1024;
constexpr size_t CTL_KMB = 768 * 1024;

struct P {
    const float *x, *mem, *rel_bias, *mem_norm, *norm_mix, *w_in, *tshift_mu, *decay_w0, *decay_up, *iclr_a0, *iclr_up, *gate_up,
        *k_k, *k_a, *r_k, *ln_x_w, *ln_x_b, *w_o_rwkv, *w_o_moba, *w_out, *norm_xattn, *w_q_x, *w_kv_x, *w_o_x, *norm_ffn,
        *w_router_group, *w_router_expert, *w_exp_gate, *w_exp_up, *w_exp_down, *norm_final;
    float* out;
    char* ws;
};

__device__ __forceinline__ int otid() { int t = threadIdx.x; asm volatile("" : "+v"(t)); return t; }
__device__ __forceinline__ float bf2f(bf16_t b) { return __uint_as_float((unsigned)b << 16); }
__device__ __forceinline__ unsigned f2bf(float f) { unsigned u = __float_as_uint(f); return (u + 0x7fffu + ((u >> 16) & 1u)) >> 16; }
__device__ __forceinline__ unsigned cvt_pk(float lo, float hi) { const f32x2 v = {lo, hi}; return __builtin_bit_cast(unsigned, __builtin_convertvector(v, bf16x2_t)); }
__device__ __forceinline__ unsigned pk2(float lo, float hi) { return cvt_pk(lo, hi); }
__device__ __forceinline__ u32x2 pack4(f32x4 v) { u32x2 o; o.x = cvt_pk(v.x, v.y); o.y = cvt_pk(v.z, v.w); return o; }
__device__ __forceinline__ bf16x8 pack8(f32x4 a, f32x4 b) { u32x4 o; o.x = cvt_pk(a.x, a.y); o.y = cvt_pk(a.z, a.w); o.z = cvt_pk(b.x, b.y); o.w = cvt_pk(b.z, b.w); return __builtin_bit_cast(bf16x8, o); }
__device__ __forceinline__ bf16x8 ldperm(const char* rowbase, int ks, int fq) {
    const u32x2 a = *(const u32x2*)(rowbase + (32 * ks + fq * 4) * 2), b = *(const u32x2*)(rowbase + (32 * ks + 16 + fq * 4) * 2);
    u32x4 o; o.x = a.x; o.y = a.y; o.z = b.x; o.w = b.y; return __builtin_bit_cast(bf16x8, o);
}
__device__ __forceinline__ float wave_sum(float v) {
#pragma unroll
    for (int o = 32; o >= 1; o >>= 1) v += __shfl_xor(v, o);
    return v;
}
__device__ __forceinline__ float sigm(float x) { return __builtin_amdgcn_rcpf(1.f + __expf(-x)); }
__device__ __forceinline__ void unpack8(u32x4 w, float* f) {
    f[0] = __uint_as_float(w.x << 16); f[1] = __uint_as_float(w.x & 0xffff0000u);
    f[2] = __uint_as_float(w.y << 16); f[3] = __uint_as_float(w.y & 0xffff0000u);
    f[4] = __uint_as_float(w.z << 16); f[5] = __uint_as_float(w.z & 0xffff0000u);
    f[6] = __uint_as_float(w.w << 16); f[7] = __uint_as_float(w.w & 0xffff0000u);
}
__device__ __forceinline__ f32x4 unpack4(u32x2 w) { f32x4 r; r.x = __uint_as_float(w.x << 16); r.y = __uint_as_float(w.x & 0xffff0000u); r.z = __uint_as_float(w.y << 16); r.w = __uint_as_float(w.y & 0xffff0000u); return r; }

namespace pg8 {
constexpr int BM = 256, BK = 64, HALF = 128, HTB = HALF * BK * 2  , STAGE_BYTES = 8 * HTB, NXCD = 8, WGM = 8;
__device__ __forceinline__ int lds_byte(int r, int c) { const int st = (r >> 4) * 2 + (c >> 5), rr = r & 15, cc = c & 31, ob = rr * 64 + cc * 2; return st * 1024 + (ob ^ (((ob >> 9) & 1) << 5)); }
__device__ __forceinline__ void stage_rc(int b, int& R, int& C) { const int st = b / 1024, sb = b % 1024, swz = sb ^ (((sb >> 9) & 1) << 5); R = (st >> 1) * 16 + swz / 64; C = (st & 1) * 32 + (swz % 64) / 2; }
__device__ __forceinline__ int perm32(int rho) { const int n = rho >> 4, i = rho & 15; return 8 * (i >> 2) + 4 * n + (i & 3); }
struct Unit { int pm, pn, e; };

struct StaticOrder {
    int nM, nN, nwg, G, c;
    __device__ void init(int M, int N, int G_, int c_) { nM = M / BM; nN = N / BM; nwg = nM * nN; G = G_; c = c_; }
    __device__ bool next(int i, Unit& u) const {
        const long L = (long)i * G + c; if (L >= nwg) return false;
        int wgid = (int)L; { const int q = nwg / NXCD, r = nwg % NXCD, xcd = wgid % NXCD, off = wgid / NXCD; wgid = (xcd < r ? xcd * (q + 1) : r * (q + 1) + (xcd - r) * q) + off; }
        const int nig = WGM * nN, gid = wgid / nig, fm = gid * WGM, gsz = (nM - fm) < WGM ? (nM - fm) : WGM;
        u.pm = fm + ((wgid % nig) % gsz); u.pn = (wgid % nig) / gsz; u.e = 0; return true;
    }
    __device__ __forceinline__ unsigned rowA(const Unit& u, int r) const { return (unsigned)(u.pm * BM + r); }
    __device__ __forceinline__ unsigned rowB(const Unit& u, int r) const { return (unsigned)(u.pn * BM + r); }
};

template <class Epi, class Sched, bool ALIGN_EPI>
__device__ __forceinline__ void gemm_phase(LAS unsigned char* lds, const bf16_t* Ab, const bf16_t* Bb, const int K, const Sched& S, const Epi& E) {
    const int tid = otid(), wid = __builtin_amdgcn_readfirstlane(tid >> 6), lane = tid & 63, wr = wid >> 2, wc = wid & 3, fr = lane & 15, fq = lane >> 4;
    const int nt = K / BK;
    int sR[2], sC[2], sRb[2];
#pragma unroll
    for (int i = 0; i < 2; ++i) { int R, C; stage_rc(tid * 16 + i * 8192, R, C); sR[i] = R; sC[i] = C; sRb[i] = Epi::PERM ? ((R & ~31) + perm32(R & 31)) : R; }
    const unsigned kstep = (unsigned)(BK * 2);
    const unsigned ldsw = (unsigned)wid * 1024u;
    const int aoff = lds_byte(wr * 64 + fr, fq * 8), boff = lds_byte(wc * 32 + fr, fq * 8);
#define PG8_SA(b, h) (((b) * 2 + (h)) * HTB)
#define PG8_SB(b, h) ((4 + (b) * 2 + (h)) * HTB)
#define PG8_STAGE(bufoff, gbase, offs, kb) do { _Pragma("unroll") for (int _i = 0; _i < 2; ++_i) \
        __builtin_amdgcn_global_load_lds((const unsigned*)((const char*)(gbase) + (size_t)((offs)[_i] + (kb))), (LAS unsigned*)(lds + (bufoff) + ldsw + _i * 8192), 16, 0, 0); } while (0)
#define PG8_LDA(dst, b, h) do { _Pragma("unroll") for (int m = 0; m < 4; ++m) _Pragma("unroll") for (int k = 0; k < 2; ++k) dst[m][k] = *(const LAS bf16x8*)(lds + PG8_SA(b, h) + aoff + m * 2048 + k * 1024); } while (0)
#define PG8_LDB(dst, b, h) do { _Pragma("unroll") for (int n = 0; n < 2; ++n) _Pragma("unroll") for (int k = 0; k < 2; ++k) dst[n][k] = *(const LAS bf16x8*)(lds + PG8_SB(b, h) + boff + n * 2048 + k * 1024); } while (0)
#define PG8_MMA(ai, bj, At, Bt) do { __builtin_amdgcn_s_setprio(1); _Pragma("unroll") for (int m = 0; m < 4; ++m) _Pragma("unroll") for (int n = 0; n < 2; ++n) _Pragma("unroll") for (int k = 0; k < 2; ++k) \
        acc[ai][bj][m][n] = __builtin_amdgcn_mfma_f32_16x16x32_bf16(Bt[n][k], At[m][k], acc[ai][bj][m][n], 0, 0, 0); __builtin_amdgcn_s_setprio(0); } while (0)
#define PG8_WAIT_V(n) asm volatile("s_waitcnt vmcnt(" #n ")" ::: "memory")
#define PG8_WAIT_L(n) asm volatile("s_waitcnt lgkmcnt(" #n ")" ::: "memory")
#define PG8_BAR __builtin_amdgcn_s_barrier()
#define PG8_SCHED __builtin_amdgcn_sched_barrier(0)
#define PG8_OFFS(u, AO, BO) do { _Pragma("unroll") for (int _h = 0; _h < 2; ++_h) _Pragma("unroll") for (int _i = 0; _i < 2; ++_i) { \
        AO[_h][_i] = (S.rowA(u, _h * HALF + sR[_i]) * (unsigned)K + (unsigned)sC[_i]) * 2u; BO[_h][_i] = (S.rowB(u, _h * HALF + sRb[_i]) * (unsigned)K + (unsigned)sC[_i]) * 2u; } } while (0)
    Unit cur, nxt; int ui = 0;
    if (!S.next(0, cur)) return;
    f32x4 acc[2][2][4][2];
#pragma unroll
    for (int a = 0; a < 2; ++a)
#pragma unroll
        for (int b = 0; b < 2; ++b)
#pragma unroll
            for (int m = 0; m < 4; ++m)
#pragma unroll
                for (int n = 0; n < 2; ++n) acc[a][b][m][n] = (f32x4){0.f, 0.f, 0.f, 0.f};
    bf16x8 At[4][2], B0[2][2], B1[2][2];
    unsigned ao[2][2], bo[2][2], nao[2][2], nbo[2][2];
    PG8_OFFS(cur, ao, bo);
    PG8_STAGE(PG8_SB(0, 0), Bb, bo[0], 0u); PG8_STAGE(PG8_SB(0, 1), Bb, bo[1], 0u); PG8_STAGE(PG8_SA(0, 0), Ab, ao[0], 0u); PG8_STAGE(PG8_SA(0, 1), Ab, ao[1], 0u);
    if (wr == 1) PG8_BAR;
    PG8_WAIT_V(2); PG8_BAR;
    PG8_STAGE(PG8_SB(1, 0), Bb, bo[0], kstep); PG8_STAGE(PG8_SA(1, 0), Ab, ao[0], kstep); PG8_STAGE(PG8_SB(1, 1), Bb, bo[1], kstep);
    PG8_WAIT_V(6); PG8_BAR;
    for (;;) {
        const bool has_next = S.next(ui + 1, nxt);
        if (has_next) { PG8_OFFS(nxt, nao, nbo); }
        else {
#pragma unroll
            for (int h = 0; h < 2; ++h)
#pragma unroll
                for (int i = 0; i < 2; ++i) { nao[h][i] = ao[h][i]; nbo[h][i] = bo[h][i]; }
        }
        for (int t = 0; t < nt; t += 2) {
            const bool last = (t == nt - 2);
            const unsigned k1 = (unsigned)(t + 1) * kstep, k2 = last ? 0u : (unsigned)(t + 2) * kstep, k3 = k2 + kstep;
            unsigned a2[2][2], b2[2][2];
#pragma unroll
            for (int h = 0; h < 2; ++h)
#pragma unroll
                for (int i = 0; i < 2; ++i) { a2[h][i] = last ? nao[h][i] : ao[h][i]; b2[h][i] = last ? nbo[h][i] : bo[h][i]; }
            PG8_LDB(B0, 0, 0); PG8_LDB(B1, 0, 1); PG8_SCHED; PG8_LDA(At, 0, 0); PG8_STAGE(PG8_SA(1, 1), Ab, ao[1], k1);
            PG8_WAIT_V(8); PG8_WAIT_L(0); PG8_BAR; PG8_MMA(0, 0, At, B0); PG8_MMA(0, 1, At, B1); PG8_BAR; PG8_SCHED;
            PG8_LDA(At, 0, 1); PG8_STAGE(PG8_SB(0, 0), Bb, b2[0], k2); PG8_STAGE(PG8_SB(0, 1), Bb, b2[1], k2); PG8_STAGE(PG8_SA(0, 0), Ab, a2[0], k2);
            PG8_WAIT_V(8); PG8_WAIT_L(0); PG8_BAR; PG8_MMA(1, 0, At, B0); PG8_MMA(1, 1, At, B1); PG8_BAR; PG8_SCHED;
            PG8_LDB(B0, 1, 0); PG8_LDB(B1, 1, 1); PG8_SCHED; PG8_LDA(At, 1, 0); PG8_STAGE(PG8_SA(0, 1), Ab, a2[1], k2);
            PG8_WAIT_V(8); PG8_WAIT_L(0); PG8_BAR; PG8_MMA(0, 0, At, B0); PG8_MMA(0, 1, At, B1); PG8_BAR; PG8_SCHED;
            PG8_LDA(At, 1, 1); PG8_STAGE(PG8_SB(1, 0), Bb, b2[0], k3); PG8_STAGE(PG8_SB(1, 1), Bb, b2[1], k3); PG8_STAGE(PG8_SA(1, 0), Ab, a2[0], k3);
            PG8_WAIT_V(8); PG8_WAIT_L(0); PG8_BAR; PG8_MMA(1, 0, At, B0); PG8_MMA(1, 1, At, B1); PG8_BAR; PG8_SCHED;
        }
        if constexpr (ALIGN_EPI) { if (wr == 0) PG8_BAR; }
        E(acc, cur, wr, wc, fr, fq);
        if (!has_next) break;
#pragma unroll
        for (int a = 0; a < 2; ++a)
#pragma unroll
            for (int b = 0; b < 2; ++b)
#pragma unroll
                for (int m = 0; m < 4; ++m)
#pragma unroll
                    for (int n = 0; n < 2; ++n) acc[a][b][m][n] = (f32x4){0.f, 0.f, 0.f, 0.f};
        cur = nxt; ++ui;
#pragma unroll
        for (int h = 0; h < 2; ++h)
#pragma unroll
            for (int i = 0; i < 2; ++i) { ao[h][i] = nao[h][i]; bo[h][i] = nbo[h][i]; }
        if constexpr (ALIGN_EPI) { if (wr == 1) PG8_BAR; }
    }
    PG8_WAIT_V(0);
    if constexpr (!ALIGN_EPI) { if (wr == 0) PG8_BAR; }
    PG8_BAR;
#undef PG8_SA
#undef PG8_SB
#undef PG8_STAGE
#undef PG8_LDA
#undef PG8_LDB
#undef PG8_MMA
#undef PG8_WAIT_V
#undef PG8_WAIT_L
#undef PG8_BAR
#undef PG8_SCHED
#undef PG8_OFFS
}
}

__device__ __forceinline__ void gemm_r32(f32x4 (&acc)[2][8], const bf16_t* A, int lda, int brow, const bf16_t* Bt, int ldb, int bcol, int K, char* smem) {
    const int tid = otid(), lane = tid & 63, wid = tid >> 6, fr = lane & 15, fq = lane >> 4;
    const int r0 = tid >> 3, lch = (tid & 7) ^ ((tid >> 4) & 7);
    const bf16_t* pa[4]; const bf16_t* pb[2];
#pragma unroll
    for (int i = 0; i < 4; ++i) pa[i] = A + (long)(brow + r0 + 64 * i) * lda + lch * 8;
#pragma unroll
    for (int i = 0; i < 2; ++i) pb[i] = Bt + (long)(bcol + r0 + 64 * i) * ldb + lch * 8;
    const int nk = K / 64;
#pragma unroll
    for (int i = 0; i < 4; ++i) __builtin_amdgcn_global_load_lds((const unsigned*)pa[i], (unsigned*)(smem + tid * 16 + i * 8192), 16, 0, 0);
#pragma unroll
    for (int i = 0; i < 2; ++i) __builtin_amdgcn_global_load_lds((const unsigned*)pb[i], (unsigned*)(smem + 32768 + tid * 16 + i * 8192), 16, 0, 0);
    const int sw = fr >> 1;
    for (int kt = 0; kt < nk; ++kt) {
        asm volatile("s_waitcnt vmcnt(0)" ::: "memory");
        __syncthreads();
        char* cur = smem + (kt & 1) * 49152;
        if (kt + 1 < nk) {
            char* nx = smem + ((kt + 1) & 1) * 49152;
#pragma unroll
            for (int i = 0; i < 4; ++i) __builtin_amdgcn_global_load_lds((const unsigned*)(pa[i] + (kt + 1) * 64), (unsigned*)(nx + tid * 16 + i * 8192), 16, 0, 0);
#pragma unroll
            for (int i = 0; i < 2; ++i) __builtin_amdgcn_global_load_lds((const unsigned*)(pb[i] + (kt + 1) * 64), (unsigned*)(nx + 32768 + tid * 16 + i * 8192), 16, 0, 0);
        }
#pragma unroll
        for (int ks = 0; ks < 2; ++ks) {
            const int pc = ((ks * 4 + fq) ^ sw) * 16;
            bf16x8 At[2], Bf[8];
#pragma unroll
            for (int m = 0; m < 2; ++m) At[m] = *(const bf16x8*)(cur + (wid * 32 + m * 16 + fr) * 128 + pc);
#pragma unroll
            for (int n = 0; n < 8; ++n) Bf[n] = *(const bf16x8*)(cur + 32768 + (n * 16 + fr) * 128 + pc);
#pragma unroll
            for (int m = 0; m < 2; ++m)
#pragma unroll
                for (int n = 0; n < 8; ++n) acc[m][n] = MFMA16(Bf[n], At[m], acc[m][n]);
        }
    }
    __syncthreads();
}

__device__ __forceinline__ void transpose_tile(const float* W, int K, int N, bf16_t* Wt, int rs, int roff, int tile, float* scr  ) {
    const int tid = otid();
    const int nnb = N / 128, kb = tile / nnb, nb = tile % nnb, k0 = kb * 64, n0 = nb * 128;
#pragma unroll 4
    for (int i = 0; i < 16; ++i) { const int k = i * 4 + (tid >> 7), n = tid & 127; scr[k * 129 + n] = W[(size_t)(k0 + k) * N + n0 + n]; }
    __syncthreads();
#pragma unroll
    for (int i = 0; i < 2; ++i) {
        const int c = tid + i * 512, n = c >> 3, kc = c & 7;
        const float* s = scr + (kc * 8) * 129 + n;
        u32x4 o; o.x = pk2(s[0], s[129]); o.y = pk2(s[2 * 129], s[3 * 129]); o.z = pk2(s[4 * 129], s[5 * 129]); o.w = pk2(s[6 * 129], s[7 * 129]);
        const int nn = n0 + n, drow = (nn >> 4) * rs + (nn & 15) + roff;
        *(u32x4*)(Wt + (size_t)drow * K + k0 + kc * 8) = o;
    }
    __syncthreads();
}
__device__ __forceinline__ void rms_row_bf16(const float* xrow, const float* g, bf16_t* orow, int lane) {
    const f32x4* xr = (const f32x4*)xrow + lane; const f32x4* gr = (const f32x4*)g + lane;
    f32x4 v[4]; float s = 0.f;
#pragma unroll
    for (int j = 0; j < 4; ++j) { v[j] = xr[64 * j]; s += v[j].x * v[j].x + v[j].y * v[j].y + v[j].z * v[j].z + v[j].w * v[j].w; }
    const float rstd = rsqrtf(wave_sum(s) * (1.f / 1024.f) + 1e-6f);
    u32x2* o8 = (u32x2*)orow + lane;
#pragma unroll
    for (int j = 0; j < 4; ++j) { const f32x4 gg = gr[64 * j]; u32x2 o; o.x = pk2(v[j].x * rstd * gg.x, v[j].y * rstd * gg.y); o.y = pk2(v[j].z * rstd * gg.z, v[j].w * rstd * gg.w); o8[64 * j] = o; }
}
constexpr int P0_T_IN = 16 * 42, P0_T_A = 64, P0_T_B = 128, P0_T_L = 4 + 4 + 8;
constexpr int P0_TR = P0_T_IN + 4 * P0_T_A + 2 * P0_T_B + P0_T_L;
constexpr int P0_ROUT = 72, P0_NORM = T / 8, P0_MEM = NMEM / 8;
constexpr int P0_ITEMS = P0_TR + P0_ROUT + P0_NORM + P0_MEM + 1;
__device__ __forceinline__ void phase0(const P& p, int bid, int nb, char* smem) {
    const int tid = otid(), lane = tid & 63, wid = tid >> 6;
    char* ws = p.ws;
    for (int it = bid; it < P0_ITEMS; it += nb) {
        int r = it;
        if (r < P0_TR) {
            float* scr = (float*)smem;
            if (r < P0_T_IN) { transpose_tile(p.w_in, D, INCOLS, (bf16_t*)(ws + OFF_WIN), 16, 0, r, scr); continue; } r -= P0_T_IN;
            if (r < P0_T_A) { transpose_tile(p.w_o_rwkv, RW, D, (bf16_t*)(ws + OFF_WORW), 16, 0, r, scr); continue; } r -= P0_T_A;
            if (r < P0_T_A) { transpose_tile(p.w_o_moba, MW, D, (bf16_t*)(ws + OFF_WOMB), 16, 0, r, scr); continue; } r -= P0_T_A;
            if (r < P0_T_B) { transpose_tile(p.w_out, D, D, (bf16_t*)(ws + OFF_WOUT), 16, 0, r, scr); continue; } r -= P0_T_B;
            if (r < P0_T_A) { transpose_tile(p.w_q_x, D, 512, (bf16_t*)(ws + OFF_WQ), 16, 0, r, scr); continue; } r -= P0_T_A;
            if (r < P0_T_B) { transpose_tile(p.w_kv_x, D, D, (bf16_t*)(ws + OFF_WKV), 16, 0, r, scr); continue; } r -= P0_T_B;
            if (r < P0_T_A) { transpose_tile(p.w_o_x, 512, D, (bf16_t*)(ws + OFF_WOX), 16, 0, r, scr); continue; } r -= P0_T_A;
            if (r < 4) { transpose_tile(p.decay_up, 64, 512, (bf16_t*)(ws + OFF_LORA_D), 16, 0, r, scr); continue; } r -= 4;
            if (r < 4) { transpose_tile(p.iclr_up, 64, 512, (bf16_t*)(ws + OFF_LORA_I), 16, 0, r, scr); continue; } r -= 4;
            transpose_tile(p.gate_up, 128, 512, (bf16_t*)(ws + OFF_LORA_G), 16, 0, r, scr); continue;
        }
        r -= P0_TR;
        if (r < P0_ROUT) {
            const int e = r * 512 + tid, o = e >> 10, k = e & 1023;
            float* rt = (float*)(ws + OFF_ROUT);
            rt[e] = (o < 32) ? p.w_router_expert[k * 32 + o] : p.w_router_group[k * 4 + (o - 32)];
            continue;
        }
        r -= P0_ROUT;
        if (r < P0_NORM) { const int row = r * 8 + wid; rms_row_bf16(p.x + (size_t)row * D, p.norm_mix, (bf16_t*)(ws + OFF_XN) + (size_t)row * D, lane); continue; }
        r -= P0_NORM;
        if (r < P0_MEM) { const int row = r * 8 + wid; rms_row_bf16(p.mem + (size_t)row * D, p.mem_norm, (bf16_t*)(ws + OFF_MEMN) + (size_t)row * D, lane); continue; }
        if (tid < 64) ((int*)(ws + OFF_CTL + CTL_CNT))[tid] = 0;
        for (int i = tid; i < 1024; i += NT) ((int*)(ws + OFF_CTL + CTL_MCNT))[i] = 0;
    }
}

struct EpiU {
    static constexpr bool PERM = true;
    char* ws;
    __device__ __forceinline__ void operator()(const f32x4 (&acc)[2][2][4][2], const pg8::Unit& u, int wr, int wc, int fr, int fq) const {
        const int colt = u.pn * 256;
        bf16_t* dst; int ld, cb; bool sg = false;
        if (colt < RCOLS) { dst = (bf16_t*)(ws + OFF_UR); ld = RCOLS; cb = colt; }
        else if (colt < RCOLS + MCOLS) { dst = (bf16_t*)(ws + OFF_UM); ld = UMC; cb = colt - RCOLS; }
        else { dst = (bf16_t*)(ws + OFF_UG); ld = GCOLS; cb = colt - RCOLS - MCOLS; sg = true; }
        const int row0 = u.pm * 256 + wr * 64 + fr, col0 = cb + wc * 32 + 8 * fq;
#pragma unroll
        for (int ai = 0; ai < 2; ++ai)
#pragma unroll
            for (int m = 0; m < 4; ++m) {
                bf16_t* rowp = dst + (size_t)(row0 + ai * 128 + m * 16) * ld + col0;
#pragma unroll
                for (int bj = 0; bj < 2; ++bj) {
                    f32x4 v0 = acc[ai][bj][m][0], v1 = acc[ai][bj][m][1];
                    if (sg) { v0.x = sigm(v0.x); v0.y = sigm(v0.y); v0.z = sigm(v0.z); v0.w = sigm(v0.w); v1.x = sigm(v1.x); v1.y = sigm(v1.y); v1.z = sigm(v1.z); v1.w = sigm(v1.w); }
                    u32x4 w; w.x = cvt_pk(v0.x, v0.y); w.y = cvt_pk(v0.z, v0.w); w.z = cvt_pk(v1.x, v1.y); w.w = cvt_pk(v1.z, v1.w);
                    *(u32x4*)(rowp + bj * 128) = w;
                }
            }
    }
};
__device__ __forceinline__ void phase1(const P& p, int bid, int nb, char* smem) {
    pg8::StaticOrder S; S.init(T, INCOLS, nb, bid);
    EpiU E{p.ws};
    pg8::gemm_phase<EpiU, pg8::StaticOrder, true>((LAS unsigned char*)smem, (const bf16_t*)(p.ws + OFF_XN), (const bf16_t*)(p.ws + OFF_WIN), D, S, E);
}

__device__ __forceinline__ void phase_kmean(const P& p, int bid, int nb, char* smem) {
    const int tid = otid();
    const bf16_t* um = (const bf16_t*)(p.ws + OFF_UM);
    bf16_t* kmb = (bf16_t*)(p.ws + OFF_CTL + CTL_KMB);
    float* red = (float*)smem;
    for (int it = bid; it < 64 * 8; it += nb) {
        const int blk = it >> 3, h = it & 7, q = tid >> 6, d = tid & 63;
        float s = 0.f;
        for (int k = 0; k < 32; ++k) s += bf2f(um[(size_t)(blk * 256 + q * 32 + k) * UMC + 512 + h * 64 + d]);
        red[tid] = s;
        __syncthreads();
        if (tid < 64) { float a = 0.f;
#pragma unroll
            for (int j = 0; j < 8; ++j) a += red[tid + 64 * j];
            kmb[(blk * 8 + h) * 64 + tid] = (bf16_t)f2bf(a * (1.f / 256.f)); }
        __syncthreads();
    }
}
__device__ __forceinline__ void phase_vtrans(const P& p, int bid, int nb, char* smem) {
    const int tid = otid();
    const bf16_t* um = (const bf16_t*)(p.ws + OFF_UM); bf16_t* vt = (bf16_t*)(p.ws + OFF_VT);
    for (int it = bid; it < 256 * 4; it += nb) {
        const int tt = it >> 2, cq = it & 3, t0 = tt * 64, c0 = cq * 128;
#pragma unroll
        for (int i = 0; i < 2; ++i) { const int c = tid + i * 512, r = c >> 4, ch = c & 15; *(u32x4*)(smem + r * 272 + ch * 16) = *(const u32x4*)(um + (size_t)(t0 + r) * UMC + 1024 + c0 + ch * 8); }
        __syncthreads();
#pragma unroll
        for (int i = 0; i < 2; ++i) {
            const int c = tid + i * 512, col = c >> 3, tc = c & 7;
            unsigned short e[8];
#pragma unroll
            for (int j = 0; j < 8; ++j) e[j] = *(const unsigned short*)(smem + (tc * 8 + j) * 272 + col * 2);
            u32x4 o; o.x = e[0] | ((unsigned)e[1] << 16); o.y = e[2] | ((unsigned)e[3] << 16); o.z = e[4] | ((unsigned)e[5] << 16); o.w = e[6] | ((unsigned)e[7] << 16);
            *(u32x4*)(vt + (size_t)(c0 + col) * T + t0 + tc * 8) = o;
        }
        __syncthreads();
    }
}

constexpr int SLOT = 9216, ROWB = 144, LIN_ROWB = 528;
constexpr int L_WL = 0 * SLOT, L_AL = 1 * SLOT, L_LIN = 2 * SLOT, L_AT = 2 * SLOT, L_BT = 3 * SLOT, L_KT = 4 * SLOT, L_RT = 5 * SLOT, L_VT = 6 * SLOT, L_ATT = 7 * SLOT;
constexpr int L_AAB = L_AT, L_AKV = L_BT, L_BBT = L_WL, L_KBT = L_AL, L_TD = L_KT;
constexpr int L_WTOT = 8 * SLOT, L_WC = L_WTOT + 1024, L_PAR = L_WC + 256, RW_LDS = L_PAR + 2048;

typedef float f32x2 __attribute__((ext_vector_type(2)));
template <int TT> struct SolveRow {
    static __device__ __forceinline__ void run(f32x2 (&x)[32], const char* Lb, const u32x4 (&lcur)[8]) {
        u32x4 lnext[8];
        constexpr int NCN = (TT + 1 < 64) ? (TT / 8 + 1) : 0;
#pragma unroll
        for (int c8 = 0; c8 < 8; ++c8) if (c8 < NCN) lnext[c8] = *(const u32x4*)(Lb + (TT + 1) * 144 + c8 * 16); else lnext[c8] = (u32x4){0u, 0u, 0u, 0u};
        f32x2 a0 = {0.f, 0.f}, a1 = {0.f, 0.f}, a2 = {0.f, 0.f}, a3 = {0.f, 0.f};
#pragma unroll
        for (int c8 = 0; c8 <= (TT - 1) / 8; ++c8) {
            const u32x4 lv = lcur[c8];
            f32x2 l0, l1, l2, l3;
            l0.x = __uint_as_float(lv.x << 16); l0.y = __uint_as_float(lv.x & 0xffff0000u);
            l1.x = __uint_as_float(lv.y << 16); l1.y = __uint_as_float(lv.y & 0xffff0000u);
            l2.x = __uint_as_float(lv.z << 16); l2.y = __uint_as_float(lv.z & 0xffff0000u);
            l3.x = __uint_as_float(lv.w << 16); l3.y = __uint_as_float(lv.w & 0xffff0000u);
            a0 = l0 * x[c8 * 4 + 0] + a0; a1 = l1 * x[c8 * 4 + 1] + a1; a2 = l2 * x[c8 * 4 + 2] + a2; a3 = l3 * x[c8 * 4 + 3] + a3;
        }
        a0 = (a0 + a1) + (a2 + a3);
        const float r = a0.x + a0.y;
        if (TT & 1) x[TT / 2].y += r; else x[TT / 2].x += r;
        asm volatile("" : "+v"(x[TT / 2]) :: "memory");
        SolveRow<TT + 1>::run(x, Lb, lnext);
    }
};
template <> struct SolveRow<64> { static __device__ __forceinline__ void run(f32x2 (&)[32], const char*, const u32x4 (&)[8]) {} };

__device__ __forceinline__ void load_shift16(const bf16_t* ur, int row, int col, const float* mu, float* out) {
    const u32x4* cp = (const u32x4*)(ur + (size_t)row * RCOLS + col);
    const u32x4 c0 = cp[0], c1 = cp[1];
    u32x4 p0 = {0u, 0u, 0u, 0u}, p1 = {0u, 0u, 0u, 0u};
    if (row > 0) { const u32x4* pp = (const u32x4*)(ur + (size_t)(row - 1) * RCOLS + col); p0 = pp[0]; p1 = pp[1]; }
    float cf[16], pf[16];
    unpack8(c0, cf); unpack8(c1, cf + 8); unpack8(p0, pf); unpack8(p1, pf + 8);
#pragma unroll
    for (int e = 0; e < 16; ++e) out[e] = cf[e] + mu[col + e] * (pf[e] - cf[e]);
}

__device__ __forceinline__ void phase_rw_chunk(const P& p, int bid, int nb, char* smem0) {
    char* ws = p.ws;
    const bf16_t* ur = (const bf16_t*)(ws + OFF_UR);
    bf16_t* G = (bf16_t*)(ws + OFF_OA); bf16_t* BON = (bf16_t*)(ws + OFF_BON); bf16_t* RH = (bf16_t*)(ws + OFF_RH);
    float* YL = p.out; f32x4* NF = (f32x4*)(p.out + (size_t)T * 512);
    u32x4* MF = (u32x4*)(ws + OFF_MF);
    int hpar = -1;
    for (int itb = bid * 2; itb < 2048; itb += nb * 2) {
        const int tid5 = otid();
        const int half = __builtin_amdgcn_readfirstlane(tid5 >> 8), tid = tid5 & 255;
        char* smem = smem0 + half * RW_LDS;
        float* wtot = (float*)(smem + L_WTOT); float* WCs = (float*)(smem + L_WC);
        const int it = itb + half, c = it >> 3, h = it & 7;
        const int lane = tid & 63, w = __builtin_amdgcn_readfirstlane(tid >> 6), fr = lane & 15, fq = lane >> 4;
        if (h != hpar) {
            float* par = (float*)(smem + L_PAR);
            if (tid < 64) {
                const int hj = h * 64 + tid;
                par[tid] = p.decay_w0[hj]; par[64 + tid] = p.iclr_a0[hj]; par[128 + tid] = p.k_k[hj]; par[192 + tid] = p.k_a[hj]; par[256 + tid] = p.r_k[hj];
                par[320 + tid] = p.tshift_mu[hj]; par[384 + tid] = p.tshift_mu[512 + hj]; par[448 + tid] = p.tshift_mu[1024 + hj];
            }
            hpar = h;
        }
        u32x4 rawc[3][2], rawp[3][2];
        {
            const int row = c * 64 + (tid >> 2), hj0 = h * 64 + (tid & 3) * 16;
#pragma unroll
            for (int q3 = 0; q3 < 3; ++q3) {
                const u32x4* cp = (const u32x4*)(ur + (size_t)row * RCOLS + q3 * 512 + hj0);
                rawc[q3][0] = cp[0]; rawc[q3][1] = cp[1];
                rawp[q3][0] = (u32x4){0u, 0u, 0u, 0u}; rawp[q3][1] = rawp[q3][0];
                if (row > 0) { const u32x4* pp = (const u32x4*)(ur + (size_t)(row - 1) * RCOLS + q3 * 512 + hj0); rawp[q3][0] = pp[0]; rawp[q3][1] = pp[1]; }
            }
        }
        {
            const int cc = tid & 31, col = 1536 + cc * 8, t0 = tid >> 5;
            u32x4 cur[8], prv[8];
#pragma unroll
            for (int i = 0; i < 8; ++i) {
                const int row = c * 64 + t0 + 8 * i;
                cur[i] = *(const u32x4*)(ur + (size_t)row * RCOLS + col);
                prv[i] = (u32x4){0u, 0u, 0u, 0u};
                if (row > 0) prv[i] = *(const u32x4*)(ur + (size_t)(row - 1) * RCOLS + col);
            }
            const f32x4 mu0 = *(const f32x4*)(p.tshift_mu + col), mu1 = *(const f32x4*)(p.tshift_mu + col + 4);
            const float mu[8] = {mu0.x, mu0.y, mu0.z, mu0.w, mu1.x, mu1.y, mu1.z, mu1.w};
#pragma unroll
            for (int i = 0; i < 8; ++i) {
                float cf[8], pf[8], xs[8];
                unpack8(cur[i], cf); unpack8(prv[i], pf);
#pragma unroll
                for (int e = 0; e < 8; ++e) {
                    const float x = cf[e] + mu[e] * (pf[e] - cf[e]);
                    xs[e] = (cc < 8) ? (1.f - 2.f * __builtin_amdgcn_rcpf(1.f + __expf(2.f * x))) : ((cc < 16) ? x : sigm(x));
                }
                u32x4 o; o.x = cvt_pk(xs[0], xs[1]); o.y = cvt_pk(xs[2], xs[3]); o.z = cvt_pk(xs[4], xs[5]); o.w = cvt_pk(xs[6], xs[7]);
                *(u32x4*)(smem + L_LIN + (t0 + 8 * i) * LIN_ROWB + cc * 16) = o;
            }
        }
        __syncthreads();
        {
            const char* lrow = smem + L_LIN + (w * 16 + fr) * LIN_ROWB;
            const bf16_t* dT = (const bf16_t*)(ws + OFF_LORA_D) + (size_t)(h * 64) * 64;
            const bf16_t* iT = (const bf16_t*)(ws + OFF_LORA_I) + (size_t)(h * 64) * 64;
            const bf16_t* gT = (const bf16_t*)(ws + OFF_LORA_G) + (size_t)(h * 64) * 128;
            bf16x8 lb[8];
#pragma unroll
            for (int ks = 0; ks < 8; ++ks) lb[ks] = *(const bf16x8*)(lrow + (ks * 32 + fq * 8) * 2);
#pragma unroll
            for (int jt = 0; jt < 4; ++jt) {
                f32x4 aw = {0.f, 0.f, 0.f, 0.f}, aa = aw, ag = aw;
#pragma unroll
                for (int ks = 0; ks < 2; ++ks) {
                    aw = MFMA16(*(const bf16x8*)(dT + (jt * 16 + fr) * 64 + ks * 32 + fq * 8), lb[ks], aw);
                    aa = MFMA16(*(const bf16x8*)(iT + (jt * 16 + fr) * 64 + ks * 32 + fq * 8), lb[2 + ks], aa);
                }
#pragma unroll
                for (int ks = 0; ks < 4; ++ks) ag = MFMA16(*(const bf16x8*)(gT + (jt * 16 + fr) * 128 + ks * 32 + fq * 8), lb[4 + ks], ag);
                *(u32x2*)(smem + L_WL + (w * 16 + fr) * ROWB + (jt * 16 + fq * 4) * 2) = pack4(aw);
                *(u32x2*)(smem + L_AL + (w * 16 + fr) * ROWB + (jt * 16 + fq * 4) * 2) = pack4(aa);
                *(u32x2*)(G + (size_t)(c * 64 + w * 16 + fr) * 512 + h * 64 + jt * 16 + fq * 4) = pack4(ag);
            }
        }
        __syncthreads();
        {
            const int t = tid >> 2, jq = tid & 3, j0 = jq * 16, hj0 = h * 64 + j0, row = c * 64 + t;
            const float* par = (const float*)(smem + L_PAR) + j0;
            float ai[16], kk[16], k2[16], rr[16];
            {
                float al[16];
                const u32x4* ap = (const u32x4*)(smem + L_AL + t * ROWB + j0 * 2);
                unpack8(ap[0], al); unpack8(ap[1], al + 8);
#pragma unroll
                for (int e = 0; e < 16; ++e) ai[e] = sigm(par[64 + e] + al[e]);
            }
            float ss = 0.f, rk = 0.f;
            {
                float cf[16], pf[16];
                unpack8(rawc[1][0], cf); unpack8(rawc[1][1], cf + 8); unpack8(rawp[1][0], pf); unpack8(rawp[1][1], pf + 8);
#pragma unroll
                for (int e = 0; e < 16; ++e) { const float k = cf[e] + par[384 + e] * (pf[e] - cf[e]); kk[e] = k * par[128 + e]; ss += kk[e] * kk[e]; k2[e] = k * (1.f + (ai[e] - 1.f) * par[192 + e]); }
            }
            ss += __shfl_xor(ss, 1); ss += __shfl_xor(ss, 2);
            const float inv = rsqrtf(ss + 1e-12f);
            {
                float cf[16], pf[16];
                unpack8(rawc[0][0], cf); unpack8(rawc[0][1], cf + 8); unpack8(rawp[0][0], pf); unpack8(rawp[0][1], pf + 8);
#pragma unroll
                for (int e = 0; e < 16; ++e) { rr[e] = cf[e] + par[320 + e] * (pf[e] - cf[e]); rk += rr[e] * k2[e] * par[256 + e]; }
            }
            rk += __shfl_xor(rk, 1); rk += __shfl_xor(rk, 2);
            {
                float cf[16], pf[16], v[16];
                unpack8(rawc[2][0], cf); unpack8(rawc[2][1], cf + 8); unpack8(rawp[2][0], pf); unpack8(rawp[2][1], pf + 8);
#pragma unroll
                for (int e = 0; e < 16; ++e) { v[e] = cf[e] + par[448 + e] * (pf[e] - cf[e]); *(bf16_t*)(smem + L_VT + (j0 + e) * ROWB + t * 2) = (bf16_t)f2bf(v[e]); }
#pragma unroll
                for (int hh = 0; hh < 2; ++hh) {
                    u32x4 o; o.x = cvt_pk(rk * v[hh * 8], rk * v[hh * 8 + 1]); o.y = cvt_pk(rk * v[hh * 8 + 2], rk * v[hh * 8 + 3]); o.z = cvt_pk(rk * v[hh * 8 + 4], rk * v[hh * 8 + 5]); o.w = cvt_pk(rk * v[hh * 8 + 6], rk * v[hh * 8 + 7]);
                    *(u32x4*)(BON + (size_t)row * 512 + hj0 + hh * 8) = o;
                }
            }
            float lw[16], cum[16];
            {
                float wl[16];
                const u32x4* wp = (const u32x4*)(smem + L_WL + t * ROWB + j0 * 2);
                unpack8(wp[0], wl); unpack8(wp[1], wl + 8);
#pragma unroll
                for (int e = 0; e < 16; ++e) { const float wv = par[e] + wl[e]; lw[e] = -0.6065306597126334f * sigm(wv); }
            }
#pragma unroll
            for (int e = 0; e < 16; ++e) {
                float x = lw[e];
#pragma unroll
                for (int d = 4; d < 64; d <<= 1) { const float y = __shfl_up(x, d); if (lane >= d) x += y; }
                cum[e] = x;
            }
            if ((lane >> 2) == 15) {
#pragma unroll
                for (int e = 0; e < 16; ++e) wtot[w * 64 + j0 + e] = cum[e];
            }
            __syncthreads();
#pragma unroll
            for (int hh = 0; hh < 2; ++hh) {
                float at[8], bt[8], kt[8], rt[8];
#pragma unroll
                for (int e8 = 0; e8 < 8; ++e8) {
                    const int e = hh * 8 + e8;
                    const float t0 = wtot[j0 + e], t1 = wtot[64 + j0 + e], t2 = wtot[128 + j0 + e], t3 = wtot[192 + j0 + e];
                    const float cm = cum[e] + ((w > 0 ? t0 : 0.f) + (w > 1 ? t1 : 0.f) + (w > 2 ? t2 : 0.f));
                    const float tt = (t0 + t1) + (t2 + t3);
                    if (t == 63) WCs[j0 + e] = __expf(tt);
                    const float kn = kk[e] * inv;
                    const float E = __expf(cm), Ei = __expf(-cm), Ex = __expf(cm - lw[e]), Ec = __expf(tt - cm);
                    const float b = kn * ai[e];
                    at[e8] = -kn * Ex; bt[e8] = b * Ei; kt[e8] = k2[e] * Ei; rt[e8] = rr[e] * E;
                    *(bf16_t*)(smem + L_BBT + (j0 + e) * ROWB + t * 2) = (bf16_t)f2bf(b * Ec);
                    *(bf16_t*)(smem + L_KBT + (j0 + e) * ROWB + t * 2) = (bf16_t)f2bf(k2[e] * Ec);
                    *(bf16_t*)(smem + L_ATT + (j0 + e) * ROWB + t * 2) = (bf16_t)f2bf(at[e8]);
                }
                u32x4 o;
                o.x = cvt_pk(at[0], at[1]); o.y = cvt_pk(at[2], at[3]); o.z = cvt_pk(at[4], at[5]); o.w = cvt_pk(at[6], at[7]);
                *(u32x4*)(smem + L_AT + t * ROWB + (j0 + hh * 8) * 2) = o;
                o.x = cvt_pk(bt[0], bt[1]); o.y = cvt_pk(bt[2], bt[3]); o.z = cvt_pk(bt[4], bt[5]); o.w = cvt_pk(bt[6], bt[7]);
                *(u32x4*)(smem + L_BT + t * ROWB + (j0 + hh * 8) * 2) = o;
                o.x = cvt_pk(kt[0], kt[1]); o.y = cvt_pk(kt[2], kt[3]); o.z = cvt_pk(kt[4], kt[5]); o.w = cvt_pk(kt[6], kt[7]);
                *(u32x4*)(smem + L_KT + t * ROWB + (j0 + hh * 8) * 2) = o;
                o.x = cvt_pk(rt[0], rt[1]); o.y = cvt_pk(rt[2], rt[3]); o.z = cvt_pk(rt[4], rt[5]); o.w = cvt_pk(rt[6], rt[7]);
                *(u32x4*)(smem + L_RT + t * ROWB + (j0 + hh * 8) * 2) = o;
            }
        }
        __syncthreads();
        bf16x8 frb[2], frk[2];
        {
            const int tid2 = otid() & 255, lane = tid2 & 63, fr = lane & 15, fq = lane >> 4;
            bf16x8 xa[2], xr[2];
#pragma unroll
            for (int ks = 0; ks < 2; ++ks) {
                xa[ks] = *(const bf16x8*)(smem + L_AT + (w * 16 + fr) * ROWB + (ks * 32 + fq * 8) * 2);
                xr[ks] = *(const bf16x8*)(smem + L_RT + (w * 16 + fr) * ROWB + (ks * 32 + fq * 8) * 2);
            }
            f32x4 aab[4], aak[4], arb[4], ark[4];
            const int tq = w * 16 + fr;
#pragma unroll
            for (int n = 0; n < 4; ++n) {
                f32x4 dab = {0.f, 0.f, 0.f, 0.f}, dak = dab, drb = dab, drk = dab;
                if (n <= w) {
#pragma unroll
                    for (int ks = 0; ks < 2; ++ks) {
                        const bf16x8 yb = *(const bf16x8*)(smem + L_BT + (n * 16 + fr) * ROWB + (ks * 32 + fq * 8) * 2);
                        const bf16x8 yk = *(const bf16x8*)(smem + L_KT + (n * 16 + fr) * ROWB + (ks * 32 + fq * 8) * 2);
                        dab = MFMA16(yb, xa[ks], dab); dak = MFMA16(yk, xa[ks], dak); drb = MFMA16(yb, xr[ks], drb); drk = MFMA16(yk, xr[ks], drk);
                    }
#pragma unroll
                    for (int jj = 0; jj < 4; ++jj) {
                        const int sq = n * 16 + fq * 4 + jj;
                        if (!(sq < tq)) { dab[jj] = 0.f; dak[jj] = 0.f; }
                        if (!(sq <= tq)) { drb[jj] = 0.f; drk[jj] = 0.f; }
                    }
                }
                aab[n] = dab; aak[n] = dak; arb[n] = drb; ark[n] = drk;
            }
            __syncthreads();
#pragma unroll
            for (int n = 0; n < 4; ++n) *(u32x2*)(smem + L_AAB + (w * 16 + fr) * ROWB + (n * 16 + fq * 4) * 2) = pack4(aab[n]);
            *(u32x4*)(smem + L_TD + (w * 16 + (lane >> 2)) * ROWB + (lane & 3) * 32) = (u32x4){0u, 0u, 0u, 0u};
            *(u32x4*)(smem + L_TD + (w * 16 + (lane >> 2)) * ROWB + (lane & 3) * 32 + 16) = (u32x4){0u, 0u, 0u, 0u};
            asm volatile("s_waitcnt lgkmcnt(0)" ::: "memory"); __builtin_amdgcn_wave_barrier();
            {
                const int cc = lane & 15;
                float Tc[16];
#pragma unroll
                for (int r = 0; r < 16; ++r) {
                    float lf[16];
                    const u32x4* lp = (const u32x4*)(smem + L_AAB + (w * 16 + r) * ROWB + w * 32);
                    unpack8(lp[0], lf); unpack8(lp[1], lf + 8);
                    float a = (r == cc) ? 1.f : 0.f;
#pragma unroll
                    for (int s2 = 0; s2 < 16; ++s2) if (s2 < r) a += lf[s2] * Tc[s2];
                    Tc[r] = a;
                }
                if (lane < 16) {
#pragma unroll
                    for (int r = 0; r < 16; ++r) *(bf16_t*)(smem + L_TD + (w * 16 + r) * ROWB + (w * 16 + cc) * 2) = (bf16_t)f2bf(Tc[r]);
                }
            }
            bf16x8 fak[2];
#pragma unroll
            for (int ks = 0; ks < 2; ++ks) { fak[ks] = pack8(aak[2 * ks], aak[2 * ks + 1]); frb[ks] = pack8(arb[2 * ks], arb[2 * ks + 1]); frk[ks] = pack8(ark[2 * ks], ark[2 * ks + 1]); }
#pragma unroll
            for (int vt = 0; vt < 4; ++vt) {
                f32x4 acc = {0.f, 0.f, 0.f, 0.f};
#pragma unroll
                for (int ks = 0; ks < 2; ++ks) acc = MFMA16(fak[ks], ldperm(smem + L_VT + (vt * 16 + fr) * ROWB, ks, fq), acc);
                *(u32x2*)(smem + L_AKV + (vt * 16 + fr) * ROWB + (w * 16 + fq * 4) * 2) = pack4(acc);
            }
        }
        __syncthreads();
        {
            const int tid3 = otid() & 255, lane = tid3 & 63, fr = lane & 15, fq = lane >> 4;
            char* xb = smem + (w < 2 ? L_ATT : L_AKV) + (w & 1) * 32 * ROWB;
#pragma unroll
            for (int i = 0; i < 4; ++i) {
                bf16x8 la[2];
#pragma unroll
                for (int ks = 0; ks < 2; ++ks) {
                    u32x4 v = *(const u32x4*)(smem + L_AAB + (16 * i + fr) * ROWB + (ks * 32 + fq * 8) * 2);
                    if (2 * ks + (fq >> 1) >= i) v = (u32x4){0u, 0u, 0u, 0u};
                    la[ks] = __builtin_bit_cast(bf16x8, v);
                }
                const bf16x8 ta = *(const bf16x8*)(smem + L_TD + (16 * i + fr) * ROWB + ((i >> 1) * 32 + fq * 8) * 2);
#pragma unroll
                for (int nt = 0; nt < 2; ++nt) {
                    char* rowp = xb + (nt * 16 + fr) * ROWB;
                    f32x4 y = unpack4(*(const u32x2*)(rowp + (16 * i + fq * 4) * 2));
                    if (i >= 1) y = MFMA16(la[0], *(const bf16x8*)(rowp + (fq * 8) * 2), y);
                    if (i == 3) y = MFMA16(la[1], *(const bf16x8*)(rowp + (32 + fq * 8) * 2), y);
                    *(u32x2*)(rowp + (16 * i + fq * 4) * 2) = pack4(y);
                }
                asm volatile("s_waitcnt lgkmcnt(0)" ::: "memory"); __builtin_amdgcn_wave_barrier();
#pragma unroll
                for (int nt = 0; nt < 2; ++nt) {
                    char* rowp = xb + (nt * 16 + fr) * ROWB;
                    const f32x4 x = MFMA16(ta, *(const bf16x8*)(rowp + ((i >> 1) * 32 + fq * 8) * 2), ((f32x4){0.f, 0.f, 0.f, 0.f}));
                    asm volatile("s_waitcnt lgkmcnt(0)" ::: "memory");
                    *(u32x2*)(rowp + (16 * i + fq * 4) * 2) = pack4(x);
                }
                asm volatile("s_waitcnt lgkmcnt(0)" ::: "memory"); __builtin_amdgcn_wave_barrier();
            }
        }
        __syncthreads();
        {
            const int tid4 = otid() & 255, lane = tid4 & 63, fr = lane & 15, fq = lane >> 4;
            const int trow = c * 64 + w * 16 + fr;
#pragma unroll
            for (int kt = 0; kt < 4; ++kt) {
                f32x4 acc = {0.f, 0.f, 0.f, 0.f};
#pragma unroll
                for (int ks = 0; ks < 2; ++ks) acc = MFMA16(ldperm(smem + L_ATT + (kt * 16 + fr) * ROWB, ks, fq), frb[ks], acc);
                const u32x2 rr = *(const u32x2*)(smem + L_RT + (w * 16 + fr) * ROWB + (kt * 16 + fq * 4) * 2);
                acc.x += __uint_as_float(rr.x << 16); acc.y += __uint_as_float(rr.x & 0xffff0000u); acc.z += __uint_as_float(rr.y << 16); acc.w += __uint_as_float(rr.y & 0xffff0000u);
                *(u32x2*)(RH + (size_t)trow * 512 + h * 64 + kt * 16 + fq * 4) = pack4(acc);
            }
#pragma unroll
            for (int vt = 0; vt < 4; ++vt) {
                f32x4 acc = {0.f, 0.f, 0.f, 0.f};
#pragma unroll
                for (int ks = 0; ks < 2; ++ks) {
                    acc = MFMA16(ldperm(smem + L_AKV + (vt * 16 + fr) * ROWB, ks, fq), frb[ks], acc);
                    acc = MFMA16(ldperm(smem + L_VT + (vt * 16 + fr) * ROWB, ks, fq), frk[ks], acc);
                }
                *(f32x4*)(YL + (size_t)trow * 512 + h * 64 + vt * 16 + fq * 4) = acc;
            }
            bf16x8 xb[2], xk[2];
#pragma unroll
            for (int ks = 0; ks < 2; ++ks) {
                xb[ks] = *(const bf16x8*)(smem + L_BBT + (w * 16 + fr) * ROWB + (ks * 32 + fq * 8) * 2);
                xk[ks] = *(const bf16x8*)(smem + L_KBT + (w * 16 + fr) * ROWB + (ks * 32 + fq * 8) * 2);
            }
            f32x4 mt[4];
            const float wc = WCs[w * 16 + fr];
#pragma unroll
            for (int n = 0; n < 4; ++n) {
                f32x4 acc = {0.f, 0.f, 0.f, 0.f};
#pragma unroll
                for (int ks = 0; ks < 2; ++ks) acc = MFMA16(*(const bf16x8*)(smem + L_ATT + (n * 16 + fr) * ROWB + (ks * 32 + fq * 8) * 2), xb[ks], acc);
#pragma unroll
                for (int jj = 0; jj < 4; ++jj) if (n * 16 + fq * 4 + jj == w * 16 + fr) acc[jj] += wc;
                mt[n] = acc;
            }
#pragma unroll
            for (int ks = 0; ks < 2; ++ks) MF[((size_t)((c * 8 + h) * 4 + w) * 2 + ks) * 64 + lane] = __builtin_bit_cast(u32x4, pack8(mt[2 * ks], mt[2 * ks + 1]));
#pragma unroll
            for (int vs = 0; vs < 4; ++vs) {
                f32x4 acc = {0.f, 0.f, 0.f, 0.f};
#pragma unroll
                for (int ks = 0; ks < 2; ++ks) {
                    acc = MFMA16(xb[ks], *(const bf16x8*)(smem + L_AKV + (vs * 16 + fr) * ROWB + (ks * 32 + fq * 8) * 2), acc);
                    acc = MFMA16(xk[ks], *(const bf16x8*)(smem + L_VT + (vs * 16 + fr) * ROWB + (ks * 32 + fq * 8) * 2), acc);
                }
                NF[((size_t)((c * 8 + h) * 4 + w) * 4 + vs) * 64 + lane] = acc;
            }
        }
        __syncthreads();
    }
}

constexpr int SC_D = 8, SC_R = SC_D + 2, SC_SLOT = 12288;
__device__ __forceinline__ void rw_scan(const P& p, int chain, char* smem) {
    const int tid = otid(), lane = tid & 63, w = __builtin_amdgcn_readfirstlane(tid >> 6), h = chain >> 2, vs = chain & 3;
    const char* MF = (const char*)(p.ws + OFF_MF); const char* NF = (const char*)(p.out + (size_t)T * 512);
    u32x4* SF = (u32x4*)(p.ws + OFF_SF);
    const int q0 = (w >= 1 && w <= 5) ? 2 * (w - 1) : (w == 6 ? 10 : 11), npc = (w >= 1 && w <= 5) ? 2 : 1;
    auto issue = [&](int c) {
        char* slot = smem + (c % SC_R) * SC_SLOT;
#pragma unroll
        for (int j = 0; j < 2; ++j) {
            if (j < npc) {
                const int q = q0 + j;
                const char* src = (q < 8) ? MF + ((size_t)((c * 8 + h) * 8 + q) * 64 + lane) * 16
                                          : NF + ((size_t)(((c * 8 + h) * 4 + (q - 8)) * 4 + vs) * 64 + lane) * 16;
                __builtin_amdgcn_global_load_lds((const unsigned*)src, (unsigned*)(slot + q * 1024 + lane * 16), 16, 0, 0);
            }
        }
    };
    if (w != 0) {
#pragma unroll 1
        for (int c = 0; c < SC_D; ++c) issue(c);
    }
    u32x4 st0 = {0u, 0u, 0u, 0u}, st1 = st0;
    for (int c = 0; c < 255; ++c) {
        if (w != 0) {
            if (c + SC_D < 255) issue(c + SC_D);
            else { issue(254); }
            if (npc == 2) asm volatile("s_waitcnt vmcnt(16)" ::: "memory"); else asm volatile("s_waitcnt vmcnt(8)" ::: "memory");
        }
        __builtin_amdgcn_s_barrier();
        if (w == 0) {
            SF[((size_t)((c * 8 + h) * 4 + vs) * 2 + 0) * 64 + lane] = st0;
            SF[((size_t)((c * 8 + h) * 4 + vs) * 2 + 1) * 64 + lane] = st1;
            const char* slot = smem + (c % SC_R) * SC_SLOT;
            f32x4 acc[4];
#pragma unroll
            for (int i = 0; i < 4; ++i) {
                acc[i] = *(const f32x4*)(slot + (8 + i) * 1024 + lane * 16);
                acc[i] = MFMA16(*(const bf16x8*)(slot + (2 * i) * 1024 + lane * 16), __builtin_bit_cast(bf16x8, st0), acc[i]);
                acc[i] = MFMA16(*(const bf16x8*)(slot + (2 * i + 1) * 1024 + lane * 16), __builtin_bit_cast(bf16x8, st1), acc[i]);
            }
            st0 = __builtin_bit_cast(u32x4, pack8(acc[0], acc[1])); st1 = __builtin_bit_cast(u32x4, pack8(acc[2], acc[3]));
        }
    }
    if (w == 0) {
        SF[((size_t)((255 * 8 + h) * 4 + vs) * 2 + 0) * 64 + lane] = st0;
        SF[((size_t)((255 * 8 + h) * 4 + vs) * 2 + 1) * 64 + lane] = st1;
    }
    asm volatile("s_waitcnt vmcnt(0)" ::: "memory");
    __builtin_amdgcn_s_barrier();
}

__device__ __forceinline__ void phase_rw_out(const P& p, int bid, int nb) {
    const int tid = otid(), lane = tid & 63, w8 = tid >> 6, w = w8 & 3, fr = lane & 15, fq = lane >> 4;
    char* ws = p.ws;
    bf16_t* OA = (bf16_t*)(ws + OFF_OA); const bf16_t* BON = (const bf16_t*)(ws + OFF_BON); const bf16_t* RH = (const bf16_t*)(ws + OFF_RH);
    const float* YL = p.out; const u32x4* SF = (const u32x4*)(ws + OFF_SF);
    for (int itb = bid * 2; itb < 2048; itb += nb * 2) {
        const int it = itb + (w8 >> 2), c = it >> 3, h = it & 7, trow = c * 64 + w * 16 + fr;
        const char* rrow = (const char*)(RH + (size_t)trow * 512 + h * 64);
        bf16x8 rf[2]; rf[0] = ldperm(rrow, 0, fq); rf[1] = ldperm(rrow, 1, fq);
        f32x4 acc[4];
#pragma unroll
        for (int vs = 0; vs < 4; ++vs) {
            acc[vs] = *(const f32x4*)(YL + (size_t)trow * 512 + h * 64 + vs * 16 + fq * 4);
#pragma unroll
            for (int ks = 0; ks < 2; ++ks) acc[vs] = MFMA16(__builtin_bit_cast(bf16x8, SF[((size_t)((c * 8 + h) * 4 + vs) * 2 + ks) * 64 + lane]), rf[ks], acc[vs]);
        }
        float s = 0.f;
#pragma unroll
        for (int vs = 0; vs < 4; ++vs) s += (acc[vs].x + acc[vs].y) + (acc[vs].z + acc[vs].w);
        s += __shfl_xor(s, 16); s += __shfl_xor(s, 32);
        const float mean = s * (1.f / 64.f);
        float q = 0.f;
#pragma unroll
        for (int vs = 0; vs < 4; ++vs) { acc[vs] = acc[vs] - mean; q += (acc[vs].x * acc[vs].x + acc[vs].y * acc[vs].y) + (acc[vs].z * acc[vs].z + acc[vs].w * acc[vs].w); }
        q += __shfl_xor(q, 16); q += __shfl_xor(q, 32);
        const float rstd = rsqrtf(q * (1.f / 64.f) + 64e-5f);
#pragma unroll
        for (int vs = 0; vs < 4; ++vs) {
            const int hv = h * 64 + vs * 16 + fq * 4;
            const f32x4 lw = *(const f32x4*)(p.ln_x_w + hv), lb = *(const f32x4*)(p.ln_x_b + hv);
            const u32x2 bo = *(const u32x2*)(BON + (size_t)trow * 512 + hv), gg = *(const u32x2*)(OA + (size_t)trow * 512 + hv);
            f32x4 o = acc[vs] * rstd * lw + lb;
            o.x = (o.x + __uint_as_float(bo.x << 16)) * __uint_as_float(gg.x << 16);
            o.y = (o.y + __uint_as_float(bo.x & 0xffff0000u)) * __uint_as_float(gg.x & 0xffff0000u);
            o.z = (o.z + __uint_as_float(bo.y << 16)) * __uint_as_float(gg.y << 16);
            o.w = (o.w + __uint_as_float(bo.y & 0xffff0000u)) * __uint_as_float(gg.y & 0xffff0000u);
            *(u32x2*)(OA + (size_t)trow * 512 + hv) = pack4(o);
        }
    }
}


constexpr int A_LK = 0, A_LV = 36864, A_BIAS = 70656, A_TST = 70784, A_TAB = 72848, NTAB = 2912, A_LST = 84496, A_CST = 86560;
constexpr int MAXTILES = 6656;

__device__ __forceinline__ void moba_select(const P& p, int bid0, int nb0, char* smem) {
    const int tid = otid(), lane = tid & 63, w = tid >> 6, fr = lane & 15, fq = lane >> 4;
    char* ws = p.ws;
    const bf16_t* um = (const bf16_t*)(ws + OFF_UM); const bf16_t* kmb = (const bf16_t*)(ws + OFF_CTL + CTL_KMB);
    unsigned* SEL = (unsigned*)(ws + OFF_MSEL);
    int* hist = (int*)smem;
    for (int i = tid; i < 512; i += NT) hist[i] = 0;
    __syncthreads();
    for (int it = bid0; it < 1024; it += nb0) {
        const int tile = it >> 3, h = it & 7, qb = tile >> 1, t = tile * 128 + w * 16 + fr;
        bf16x8 qf[2];
#pragma unroll
        for (int ks = 0; ks < 2; ++ks) qf[ks] = *(const bf16x8*)(um + (size_t)t * UMC + h * 64 + ks * 32 + fq * 8);
        float sc[4][4];
#pragma unroll
        for (int nt = 0; nt < 4; ++nt) {
            f32x4 acc = {0.f, 0.f, 0.f, 0.f};
            if (nt * 16 < qb) {
#pragma unroll
                for (int ks = 0; ks < 2; ++ks) acc = MFMA16(*(const bf16x8*)(kmb + (size_t)((nt * 16 + fr) * 8 + h) * 64 + ks * 32 + fq * 8), qf[ks], acc);
            }
#pragma unroll
            for (int j = 0; j < 4; ++j) sc[nt][j] = (nt * 16 + fq * 4 + j < qb) ? acc[j] : -3.0e38f;
        }
        unsigned selw = 0u;
#pragma unroll
        for (int s = 0; s < 3; ++s) {
            float bv = -3.0e38f; int bi = 255;
#pragma unroll
            for (int nt = 0; nt < 4; ++nt)
#pragma unroll
                for (int j = 0; j < 4; ++j) if (sc[nt][j] > bv) { bv = sc[nt][j]; bi = nt * 16 + fq * 4 + j; }
#pragma unroll
            for (int o = 16; o <= 32; o <<= 1) {
                const float v2 = __shfl_xor(bv, o); const int i2 = __shfl_xor(bi, o);
                if (v2 > bv || (v2 == bv && i2 < bi)) { bv = v2; bi = i2; }
            }
            if (!(bv > -1.0e38f)) bi = 255;
            selw |= (unsigned)bi << (8 * s);
#pragma unroll
            for (int nt = 0; nt < 4; ++nt)
#pragma unroll
                for (int j = 0; j < 4; ++j) if (nt * 16 + fq * 4 + j == bi) sc[nt][j] = -3.0e38f;
            if (fq == 0 && bi != 255) atomicAdd(&hist[h * 64 + bi], 1);
        }
        if (fq == 0) SEL[t * 8 + h] = selw | 0xff000000u;
    }
    __syncthreads();
    int* gcnt = (int*)(ws + OFF_CTL + CTL_MCNT);
    for (int i = tid; i < 512; i += NT) if (hist[i]) atomicAdd(&gcnt[i], hist[i]);
}

__device__ __forceinline__ void moba_fill(const P& p, int bid, int nb, char* smem) {
    const int tid = otid();
    char* ws = p.ws;
    const int* gcnt = (const int*)(ws + OFF_CTL + CTL_MCNT); int* gcur = (int*)(ws + OFF_CTL + CTL_MCUR);
    int* lst = (int*)smem;
    int* tst = lst + 520;
    int* cst = tst + 520;
    int* lh = cst + 520;
    int* lc = lh + 512;
    for (int i = tid; i < 512; i += NT) lc[i] = gcnt[i];
    __syncthreads();
    if (tid == 0) {
        int a = 0, b = 0, cc = 0;
        for (int i = 0; i < 512; ++i) { const int c = lc[i]; lst[i] = a; tst[i] = b; cst[i] = cc; a += c; const int nt_ = (c + 127) >> 7; b += nt_; cc += 2 * nt_ + (nt_ ? 3 : 0); }
        lst[512] = a; tst[512] = b; cst[512] = cc;
    }
    __syncthreads();
    for (int i = tid; i < 512; i += NT) { lh[i] = 0; lc[i] = 0; }
    __syncthreads();
    if (bid == 0) {
        int* glst = (int*)(ws + OFF_CTL + CTL_MLST); int* gtst = (int*)(ws + OFF_CTL + CTL_MTST);
        int* gcst = (int*)(ws + OFF_CTL + CTL_MCST);
        for (int i = tid; i < 513; i += NT) { glst[i] = lst[i]; gtst[i] = tst[i]; gcst[i] = cst[i]; }
    }
    const unsigned* SEL = (const unsigned*)(ws + OFF_MSEL);
    int* QL = (int*)(ws + OFF_MQL); int* SP = (int*)(ws + OFF_MSP);
    const int per = (T * 8 + nb - 1) / nb, i0 = bid * per, i1 = min(T * 8, i0 + per);
    for (int i = i0 + tid; i < i1; i += NT) {
        const unsigned sw = SEL[i]; const int h = i & 7;
#pragma unroll
        for (int s = 0; s < 3; ++s) { const int j = (sw >> (8 * s)) & 255; if (j != 255) atomicAdd(&lh[h * 64 + j], 1); }
    }
    __syncthreads();
    for (int i = tid; i < 512; i += NT) { const int c = lh[i]; lh[i] = c ? atomicAdd(&gcur[i], c) : 0; }
    __syncthreads();
    for (int i = i0 + tid; i < i1; i += NT) {
        const unsigned sw = SEL[i]; const int h = i & 7;
#pragma unroll
        for (int s = 0; s < 3; ++s) {
            const int j = (sw >> (8 * s)) & 255; int pos = -1;
            if (j != 255) { const int li = h * 64 + j; pos = lst[li] + lh[li] + atomicAdd(&lc[li], 1); QL[pos] = i >> 3; }
            SP[i * 3 + s] = pos;
        }
    }
}

__device__ __forceinline__ int t5b(int n) {
    const int v = (int)(__float_as_uint((float)(n * n)) >> 23) - 119;
    return n < 16 ? n : (v > 31 ? 31 : v);
}

__device__ __forceinline__ void attn_stage(const P& p, int j, int h, int nkeys, char* smem, int tid) {
    const bf16_t* um = (const bf16_t*)(p.ws + OFF_UM); const bf16_t* vt = (const bf16_t*)(p.ws + OFF_VT);
    for (int idx = tid; idx < nkeys * 8; idx += NT) {
        const int key = idx >> 3, ch = idx & 7;
        *(u32x4*)(smem + A_LK + key * 144 + ch * 16) = *(const u32x4*)(um + (size_t)(j * 256 + key) * UMC + 512 + h * 64 + ch * 8);
    }
    const int cpr = nkeys >> 3;
    for (int idx = tid; idx < 64 * cpr; idx += NT) {
        const int d = idx / cpr, ch = idx - d * cpr;
        *(u32x4*)(smem + A_LV + d * 528 + ch * 16) = *(const u32x4*)(vt + (size_t)(h * 64 + d) * T + j * 256 + ch * 8);
    }
    for (int i = tid; i < NTAB; i += NT) ((float*)(smem + A_TAB))[i] = p.rel_bias[t5b(i) * 8 + h];
}
__device__ __forceinline__ void attn_stage_load(const P& p, int j, int h, int tid, u32x4 (&rk)[4], u32x4 (&rv)[4]) {
    const bf16_t* um = (const bf16_t*)(p.ws + OFF_UM); const bf16_t* vt = (const bf16_t*)(p.ws + OFF_VT);
#pragma unroll
    for (int i = 0; i < 4; ++i) {
        const int idx = tid + i * NT, key = idx >> 3, ch = idx & 7, d = idx >> 5, c2 = idx & 31;
        rk[i] = *(const u32x4*)(um + (size_t)(j * 256 + key) * UMC + 512 + h * 64 + ch * 8);
        rv[i] = *(const u32x4*)(vt + (size_t)(h * 64 + d) * T + j * 256 + c2 * 8);
    }
}
__device__ __forceinline__ void attn_stage_store(const P& p, int h, int tid, char* smem, const u32x4 (&rk)[4], const u32x4 (&rv)[4]) {
#pragma unroll
    for (int i = 0; i < 4; ++i) {
        const int idx = tid + i * NT, key = idx >> 3, ch = idx & 7, d = idx >> 5, c2 = idx & 31;
        *(u32x4*)(smem + A_LK + key * 144 + ch * 16) = rk[i];
        *(u32x4*)(smem + A_LV + d * 528 + c2 * 16) = rv[i];
    }
    for (int i = tid; i < NTAB; i += NT) ((float*)(smem + A_TAB))[i] = p.rel_bias[t5b(i) * 8 + h];
}
template <bool CAUSAL>
__device__ __forceinline__ void attn_core_q(const char* smem, const bf16x8 (&qf)[2], int qt, int kbase, int nkeys, int fr, int fq, float& m_out, float& l_out, f32x4 (&o)[4]) {
    const float* tb = (const float*)(smem + A_TAB);
    const int nkt = nkeys >> 4;
    f32x4 sc[16];
    float mx = -3.0e38f;
    const bool far = !CAUSAL && __all(qt - (kbase + 255) >= 2897);
    const float cfar = tb[NTAB - 1];
#pragma unroll
    for (int kt = 0; kt < 16; ++kt) {
        f32x4 acc = {0.f, 0.f, 0.f, 0.f};
        if (kt < nkt) {
#pragma unroll
            for (int ks = 0; ks < 2; ++ks) acc = MFMA16(*(const bf16x8*)(smem + A_LK + (kt * 16 + fr) * 144 + (ks * 32 + fq * 8) * 2), qf[ks], acc);
            if (far) {
#pragma unroll
                for (int jj = 0; jj < 4; ++jj) { const float l = acc[jj] * 0.125f + cfar; acc[jj] = l; mx = fmaxf(mx, l); }
            } else {
#pragma unroll
                for (int jj = 0; jj < 4; ++jj) {
                    const int rel = qt - (kbase + kt * 16 + fq * 4 + jj);
                    float l = acc[jj] * 0.125f + tb[min(max(rel, 0), NTAB - 1)];
                    if (CAUSAL && rel < 0) l = -3.0e38f;
                    acc[jj] = l; mx = fmaxf(mx, l);
                }
            }
        } else { acc = (f32x4){-3.0e38f, -3.0e38f, -3.0e38f, -3.0e38f}; }
        sc[kt] = acc;
    }
    mx = fmaxf(mx, __shfl_xor(mx, 16)); mx = fmaxf(mx, __shfl_xor(mx, 32));
    float ls = 0.f;
#pragma unroll
    for (int kt = 0; kt < 16; ++kt)
#pragma unroll
        for (int jj = 0; jj < 4; ++jj) { const float e = (sc[kt][jj] > -1.0e38f) ? __expf(sc[kt][jj] - mx) : 0.f; sc[kt][jj] = e; ls += e; }
    ls += __shfl_xor(ls, 16); ls += __shfl_xor(ls, 32);
#pragma unroll
    for (int dt = 0; dt < 4; ++dt) o[dt] = (f32x4){0.f, 0.f, 0.f, 0.f};
#pragma unroll
    for (int s = 0; s < 8; ++s) {
        if (s * 2 < nkt) {
            const bf16x8 pf = pack8(sc[2 * s], sc[2 * s + 1]);
#pragma unroll
            for (int dt = 0; dt < 4; ++dt) o[dt] = MFMA16(ldperm(smem + A_LV + (dt * 16 + fr) * 528, s, fq), pf, o[dt]);
        }
    }
    m_out = mx; l_out = ls;
}

template <bool CAUSAL>
__device__ __forceinline__ void attn_core(const char* smem, const bf16_t* qrow, int qt, int kbase, int nkeys, int fr, int fq, float& m_out, float& l_out, f32x4 (&o)[4]) {
    bf16x8 qf[2];
#pragma unroll
    for (int ks = 0; ks < 2; ++ks) qf[ks] = *(const bf16x8*)(qrow + ks * 32 + fq * 8);
    attn_core_q<CAUSAL>(smem, qf, qt, kbase, nkeys, fr, fq, m_out, l_out, o);
}

__device__ __forceinline__ void moba_partial(const P& p, int bid, int nb, char* smem) {
    const int tid = otid(), lane = tid & 63, w = tid >> 6, fr = lane & 15, fq = lane >> 4;
    char* ws = p.ws;
    const bf16_t* um = (const bf16_t*)(ws + OFF_UM);
    const int* glst = (const int*)(ws + OFF_CTL + CTL_MLST); const int* gtst = (const int*)(ws + OFF_CTL + CTL_MTST);
    const int* QL = (const int*)(ws + OFF_MQL);
    bf16_t* PO = (bf16_t*)p.out; float* PM = (float*)((char*)p.out + 52 * MiB); float* PL = PM + 400000;
    int* tst = (int*)(smem + A_TST); int* lst = (int*)(smem + A_LST);
    for (int i = tid; i < 513; i += NT) { tst[i] = gtst[i]; lst[i] = glst[i]; }
    __syncthreads();
    const int* gcst = (const int*)(ws + OFF_CTL + CTL_MCST);
    int* cst = (int*)(smem + A_CST);
    for (int i = tid; i < 513; i += NT) cst[i] = gcst[i];
    __syncthreads();
    auto first_tile = [&](int cpos) {
        int lo = 0, hi = 512;
        while (hi - lo > 1) { const int mid = (lo + hi) >> 1; if (cst[mid] <= cpos) lo = mid; else hi = mid; }
        const int ntl = tst[lo + 1] - tst[lo];
        int k = (cpos - cst[lo] - 3 + 1) >> 1; if (k < 0) k = 0;
        return (k >= ntl) ? tst[lo + 1] : tst[lo] + k;
    };
    const int Ctot = cst[512];
    const int it0 = first_tile((int)((long)Ctot * bid / nb)), it1 = (bid + 1 == nb) ? tst[512] : first_tile((int)((long)Ctot * (bid + 1) / nb));
    auto tile_pos = [&](int it, int& li, int& pos, bool& valid) {
        int lo = 0, hi = 512;
        while (hi - lo > 1) { const int mid = (lo + hi) >> 1; if (tst[mid] <= it) lo = mid; else hi = mid; }
        li = lo;
        const int base = lst[lo] + (it - tst[lo]) * 128, idx = w * 16 + fr;
        valid = base + idx < lst[lo + 1];
        pos = valid ? base + idx : base;
    };
    int liA = 0, posA = 0, liB = 0, posB = 0, qtA = 0, qtB = 0; bool vA = false, vB = false;
    bf16x8 qfA[2];
    if (it0 < it1) {
        tile_pos(it0, liA, posA, vA); qtA = QL[posA];
        if (it0 + 1 < it1) { tile_pos(it0 + 1, liB, posB, vB); qtB = QL[posB]; }
#pragma unroll
        for (int ks = 0; ks < 2; ++ks) qfA[ks] = *(const bf16x8*)(um + (size_t)qtA * UMC + (liA >> 6) * 64 + ks * 32 + fq * 8);
    }
    int lprev = -1, lpre = -1;
    u32x4 rk[4], rv[4];
    for (int it = it0; it < it1; ++it) {
        const int h = liA >> 6, j = liA & 63;
        if (liA != lprev) {
            if (lpre != liA) attn_stage_load(p, j, h, tid, rk, rv);
            __syncthreads();
            attn_stage_store(p, h, tid, smem, rk, rv);
            __syncthreads();
            lprev = liA;
        }
        if (it + 1 < it1 && liB != liA) { attn_stage_load(p, liB & 63, liB >> 6, tid, rk, rv); lpre = liB; }
        bf16x8 qfB[2]; int liC = 0, posC = 0, qtC = 0; bool vC = false;
        if (it + 1 < it1) {
#pragma unroll
            for (int ks = 0; ks < 2; ++ks) qfB[ks] = *(const bf16x8*)(um + (size_t)qtB * UMC + (liB >> 6) * 64 + ks * 32 + fq * 8);
        } else { qfB[0] = qfA[0]; qfB[1] = qfA[1]; }
        if (it + 2 < it1) { tile_pos(it + 2, liC, posC, vC); qtC = QL[posC]; }
        float m, l; f32x4 o[4];
        attn_core_q<false>(smem, qfA, qtA, j * 256, 256, fr, fq, m, l, o);
        if (vA) {
#pragma unroll
            for (int dt = 0; dt < 4; ++dt) *(u32x2*)(PO + (size_t)posA * 64 + dt * 16 + fq * 4) = pack4(o[dt]);
            if (fq == 0) { PM[posA] = m; PL[posA] = l; }
        }
        liA = liB; posA = posB; vA = vB; qtA = qtB; qfA[0] = qfB[0]; qfA[1] = qfB[1];
        liB = liC; posB = posC; vB = vC; qtB = qtC;
    }
}

__device__ __forceinline__ void moba_own(const P& p, int bid, int nb, char* smem) {
    const int tid = otid(), lane = tid & 63, w = tid >> 6, fr = lane & 15, fq = lane >> 4;
    char* ws = p.ws;
    const bf16_t* um = (const bf16_t*)(ws + OFF_UM);
    const int* SP = (const int*)(ws + OFF_MSP);
    const bf16_t* PO = (const bf16_t*)p.out; const float* PM = (const float*)((const char*)p.out + 52 * MiB); const float* PL = PM + 400000;
    bf16_t* ob = (bf16_t*)(ws + OFF_OB);
    for (int it = bid; it < 1024; it += nb) {
        const int tile = it >> 3, h = it & 7, b = tile >> 1, tb = tile & 1, nkeys = (tb + 1) * 128;
        attn_stage(p, b, h, nkeys, smem, tid);
        __syncthreads();
        const int qt = tile * 128 + w * 16 + fr;
        float m, l; f32x4 o[4];
        attn_core<true>(smem, um + (size_t)qt * UMC + h * 64, qt, b * 256, nkeys, fr, fq, m, l, o);
        int pos[3]; float pm[3]; float M = m;
#pragma unroll
        for (int s = 0; s < 3; ++s) { pos[s] = SP[(qt * 8 + h) * 3 + s]; pm[s] = (pos[s] >= 0) ? PM[pos[s]] : -3.0e38f; M = fmaxf(M, pm[s]); }
        const float so = __expf(m - M);
        float den = l * so;
#pragma unroll
        for (int dt = 0; dt < 4; ++dt) o[dt] = o[dt] * so;
#pragma unroll
        for (int s = 0; s < 3; ++s) {
            if (pos[s] >= 0) {
                const float e = __expf(pm[s] - M);
                den += PL[pos[s]] * e;
#pragma unroll
                for (int dt = 0; dt < 4; ++dt) {
                    const u32x2 pv = *(const u32x2*)(PO + (size_t)pos[s] * 64 + dt * 16 + fq * 4);
                    o[dt].x += e * __uint_as_float(pv.x << 16); o[dt].y += e * __uint_as_float(pv.x & 0xffff0000u);
                    o[dt].z += e * __uint_as_float(pv.y << 16); o[dt].w += e * __uint_as_float(pv.y & 0xffff0000u);
                }
            }
        }
        const float inv = 1.f / den;
#pragma unroll
        for (int dt = 0; dt < 4; ++dt) *(u32x2*)(ob + (size_t)qt * 512 + h * 64 + dt * 16 + fq * 4) = pack4(o[dt] * inv);
        __syncthreads();
    }
}


__device__ __forceinline__ void phase_kvx(const P& p, int bid0, int nb0, char* smem) {
    char* ws = p.ws;
    bf16_t* KX = (bf16_t*)(ws + OFF_KVX); bf16_t* VXT = KX + 256 * 512;
    for (int it = bid0; it < 8; it += nb0) {
        f32x4 acc[2][8];
#pragma unroll
        for (int m = 0; m < 2; ++m)
#pragma unroll
            for (int n = 0; n < 8; ++n) acc[m][n] = (f32x4){0.f, 0.f, 0.f, 0.f};
        gemm_r32(acc, (const bf16_t*)(ws + OFF_MEMN), D, 0, (const bf16_t*)(ws + OFF_WKV), D, it * 128, D, smem);
        const int tid = otid(), lane = tid & 63, w = tid >> 6, fr = lane & 15, fq = lane >> 4;
#pragma unroll
        for (int m = 0; m < 2; ++m) {
            const int row = w * 32 + m * 16 + fr;
#pragma unroll
            for (int n = 0; n < 8; ++n) {
                const f32x4 v = acc[m][n];
                if (it < 4) *(u32x2*)(KX + (size_t)row * 512 + it * 128 + n * 16 + fq * 4) = pack4(v);
                else {
                    const int col = (it - 4) * 128 + n * 16 + fq * 4;
                    VXT[(size_t)(col + 0) * 256 + row] = (bf16_t)f2bf(v.x); VXT[(size_t)(col + 1) * 256 + row] = (bf16_t)f2bf(v.y);
                    VXT[(size_t)(col + 2) * 256 + row] = (bf16_t)f2bf(v.z); VXT[(size_t)(col + 3) * 256 + row] = (bf16_t)f2bf(v.w);
                }
            }
        }
    }
}

__device__ __forceinline__ void phase_qx_xattn(const P& p, int bid, int nb, char* smem) {
    char* ws = p.ws;
    const bf16_t* KX = (const bf16_t*)(ws + OFF_KVX); const bf16_t* VXT = KX + 256 * 512;
    bf16_t* ox = (bf16_t*)(ws + OFF_OB);
    for (int it = bid; it < 256; it += nb) {
        const int pm = it >> 2, h = it & 3;
        bf16x8 qf[2][4];
        {
            f32x4 acc[2][8];
#pragma unroll
            for (int m = 0; m < 2; ++m)
#pragma unroll
                for (int n = 0; n < 8; ++n) acc[m][n] = (f32x4){0.f, 0.f, 0.f, 0.f};
            gemm_r32(acc, (const bf16_t*)(ws + OFF_XN), D, pm * 256, (const bf16_t*)(ws + OFF_WQ), D, h * 128, D, smem);
            const float sc = 0.08838834764831845f;
#pragma unroll
            for (int m = 0; m < 2; ++m)
#pragma unroll
                for (int s2 = 0; s2 < 4; ++s2) qf[m][s2] = pack8(acc[m][2 * s2] * sc, acc[m][2 * s2 + 1] * sc);
        }
        const int tid = otid(), lane = tid & 63, w = tid >> 6, fr = lane & 15, fq = lane >> 4;
        for (int idx = tid; idx < 4096; idx += NT) { const int key = idx >> 4, ch = idx & 15; *(u32x4*)(smem + key * 272 + ch * 16) = *(const u32x4*)(KX + (size_t)key * 512 + h * 128 + ch * 8); }
        __syncthreads();
        bf16x8 pf[2][8]; float inv[2];
#pragma unroll
        for (int m = 0; m < 2; ++m) {
            f32x4 sc[16]; float mx = -3.0e38f;
#pragma unroll
            for (int kt = 0; kt < 16; ++kt) {
                f32x4 a = {0.f, 0.f, 0.f, 0.f};
#pragma unroll
                for (int s2 = 0; s2 < 4; ++s2) a = MFMA16(ldperm(smem + (kt * 16 + fr) * 272, s2, fq), qf[m][s2], a);
                sc[kt] = a; mx = fmaxf(fmaxf(mx, fmaxf(a.x, a.y)), fmaxf(a.z, a.w));
            }
            mx = fmaxf(mx, __shfl_xor(mx, 16)); mx = fmaxf(mx, __shfl_xor(mx, 32));
            float ls = 0.f;
#pragma unroll
            for (int kt = 0; kt < 16; ++kt) { sc[kt].x = __expf(sc[kt].x - mx); sc[kt].y = __expf(sc[kt].y - mx); sc[kt].z = __expf(sc[kt].z - mx); sc[kt].w = __expf(sc[kt].w - mx); ls += (sc[kt].x + sc[kt].y) + (sc[kt].z + sc[kt].w); }
            ls += __shfl_xor(ls, 16); ls += __shfl_xor(ls, 32);
            inv[m] = 1.f / ls;
#pragma unroll
            for (int s2 = 0; s2 < 8; ++s2) { pf[m][s2] = pack8(sc[2 * s2], sc[2 * s2 + 1]); asm volatile("" : "+v"(pf[m][s2])); }
            asm volatile("" ::: "memory");
        }
        __syncthreads();
        for (int idx = tid; idx < 4096; idx += NT) { const int d = idx >> 5, ch = idx & 31; *(u32x4*)(smem + d * 528 + ch * 16) = *(const u32x4*)(VXT + (size_t)(h * 128 + d) * 256 + ch * 8); }
        __syncthreads();
#pragma unroll
        for (int m = 0; m < 2; ++m) {
            const int row = pm * 256 + w * 32 + m * 16 + fr;
#pragma unroll
            for (int dt = 0; dt < 8; ++dt) {
                f32x4 o = {0.f, 0.f, 0.f, 0.f};
#pragma unroll
                for (int s2 = 0; s2 < 8; ++s2) o = MFMA16(ldperm(smem + (dt * 16 + fr) * 528, s2, fq), pf[m][s2], o);
                *(u32x2*)(ox + (size_t)row * 512 + h * 128 + dt * 16 + fq * 4) = pack4(o * inv[m]);
                asm volatile("" ::: "memory");
            }
        }
        __syncthreads();
    }
}

struct EpiMergeA {
    static constexpr bool PERM = true;
    char* ws;
    __device__ __forceinline__ void operator()(const f32x4 (&acc)[2][2][4][2], const pg8::Unit& u, int wr, int wc, int fr, int fq) const {
        const bf16_t* ug = (const bf16_t*)(ws + OFF_UG); bf16_t* mg = (bf16_t*)(ws + OFF_MRG);
        const int row0 = u.pm * 256 + wr * 64 + fr, col0 = u.pn * 256 + wc * 32 + 8 * fq;
#pragma unroll
        for (int ai = 0; ai < 2; ++ai)
#pragma unroll
            for (int m = 0; m < 4; ++m) {
                const size_t row = row0 + ai * 128 + m * 16;
#pragma unroll
                for (int bj = 0; bj < 2; ++bj) {
                    const int col = col0 + bj * 128;
                    float g[8]; unpack8(*(const u32x4*)(ug + row * GCOLS + col), g);
                    const f32x4 a = acc[ai][bj][m][0], b = acc[ai][bj][m][1];
                    u32x4 w; w.x = cvt_pk(g[0] * a.x, g[1] * a.y); w.y = cvt_pk(g[2] * a.z, g[3] * a.w); w.z = cvt_pk(g[4] * b.x, g[5] * b.y); w.w = cvt_pk(g[6] * b.z, g[7] * b.w);
                    *(u32x4*)(mg + row * D + col) = w;
                }
            }
    }
};
struct EpiMergeB {
    static constexpr bool PERM = true;
    char* ws;
    __device__ __forceinline__ void operator()(const f32x4 (&acc)[2][2][4][2], const pg8::Unit& u, int wr, int wc, int fr, int fq) const {
        const bf16_t* ug = (const bf16_t*)(ws + OFF_UG); bf16_t* mg = (bf16_t*)(ws + OFF_MRG);
        const int row0 = u.pm * 256 + wr * 64 + fr, col0 = u.pn * 256 + wc * 32 + 8 * fq;
#pragma unroll
        for (int ai = 0; ai < 2; ++ai)
#pragma unroll
            for (int m = 0; m < 4; ++m) {
                const size_t row = row0 + ai * 128 + m * 16;
#pragma unroll
                for (int bj = 0; bj < 2; ++bj) {
                    const int col = col0 + bj * 128;
                    float g[8], t[8]; unpack8(*(const u32x4*)(ug + row * GCOLS + 1024 + col), g); unpack8(*(const u32x4*)(mg + row * D + col), t);
                    const f32x4 a = acc[ai][bj][m][0], b = acc[ai][bj][m][1];
                    u32x4 w; w.x = cvt_pk(t[0] + g[0] * a.x, t[1] + g[1] * a.y); w.y = cvt_pk(t[2] + g[2] * a.z, t[3] + g[3] * a.w);
                    w.z = cvt_pk(t[4] + g[4] * b.x, t[5] + g[5] * b.y); w.w = cvt_pk(t[6] + g[6] * b.z, t[7] + g[7] * b.w);
                    *(u32x4*)(mg + row * D + col) = w;
                }
            }
    }
};
__device__ __forceinline__ void phase_merge(const P& p, int bid, int nb, char* smem) {
    pg8::StaticOrder S; S.init(T, D, nb, bid);
    EpiMergeA EA{p.ws}; EpiMergeB EB{p.ws};
    pg8::gemm_phase<EpiMergeA, pg8::StaticOrder, true>((LAS unsigned char*)smem, (const bf16_t*)(p.ws + OFF_OA), (const bf16_t*)(p.ws + OFF_WORW), 512, S, EA);
    pg8::gemm_phase<EpiMergeB, pg8::StaticOrder, true>((LAS unsigned char*)smem, (const bf16_t*)(p.ws + OFF_OB), (const bf16_t*)(p.ws + OFF_WOMB), 512, S, EB);
}
struct EpiResid {
    static constexpr bool PERM = false;
    const float* res; float* out;
    __device__ __forceinline__ void operator()(const f32x4 (&acc)[2][2][4][2], const pg8::Unit& u, int wr, int wc, int fr, int fq) const {
        const int row0 = u.pm * 256 + wr * 64 + fr, col0 = u.pn * 256 + wc * 32 + 4 * fq;
#pragma unroll
        for (int ai = 0; ai < 2; ++ai)
#pragma unroll
            for (int m = 0; m < 4; ++m) {
                const size_t off = (size_t)(row0 + ai * 128 + m * 16) * D + col0;
#pragma unroll
                for (int bj = 0; bj < 2; ++bj)
#pragma unroll
                    for (int n = 0; n < 2; ++n) { const f32x4 r = *(const f32x4*)(res + off + bj * 128 + n * 16); *(f32x4*)(out + off + bj * 128 + n * 16) = r + acc[ai][bj][m][n]; }
            }
    }
};
__device__ __forceinline__ void phase_resid_gemm(const bf16_t* A, int K, const bf16_t* Bt, const float* res, float* dst, int bid, int nb, char* smem) {
    pg8::StaticOrder S; S.init(T, D, nb, bid);
    EpiResid E{res, dst};
    pg8::gemm_phase<EpiResid, pg8::StaticOrder, true>((LAS unsigned char*)smem, A, Bt, K, S, E);
}
__device__ __forceinline__ void phase_norm(const float* src, const float* g, bf16_t* dst, int bid, int nb) {
    const int lane = otid() & 63, wid = otid() >> 6;
    for (int it = bid; it < T / 8; it += nb) { const int row = it * 8 + wid; rms_row_bf16(src + (size_t)row * D, g, dst + (size_t)row * D, lane); }
}
template <int PART>
__device__ __forceinline__ void phase_expconv(const P& p, int bid, int nb, char* smem) {
    float* scr = (float*)smem;
    bf16_t* gu = (bf16_t*)(p.ws + OFF_EXPGU); bf16_t* dn = (bf16_t*)(p.ws + OFF_EXPD);
    constexpr int NITEMS = PART == 0 ? (32 * 64 + 12 * 128) : (20 * 128);
    for (int it = bid; it < NITEMS; it += nb) {
        if (PART == 0 && it < 2048) { const int e = it >> 6, tile = it & 63; transpose_tile(p.w_exp_down + (size_t)e * DEXP * D, DEXP, D, dn + (size_t)e * D * DEXP, 16, 0, tile, scr); continue; }
        const int r = PART == 0 ? it - 2048 : it + 12 * 128, e = r >> 7, which = (r >> 6) & 1, tile = r & 63;
        if (which == 0) transpose_tile(p.w_exp_gate + (size_t)e * D * DEXP, D, DEXP, gu + (size_t)e * D * D, 32, 0, tile, scr);
        else transpose_tile(p.w_exp_up + (size_t)e * D * DEXP, D, DEXP, gu + (size_t)e * D * D, 32, 16, tile, scr);
    }
}

__device__ __forceinline__ void phase_router(const P& p, int bid, int nb, char* smem) {
    const int tid = otid(), lane = tid & 63, wid = tid >> 6;
    char* ws = p.ws;
    int* hist = (int*)smem;
    if (tid < 32) hist[tid] = 0;
    __syncthreads();
    const float* x2 = p.out;
    bf16_t* xn = (bf16_t*)(ws + OFF_XN);
    int* toke = (int*)(ws + OFF_CTL + CTL_TOKE); float* tokg = (float*)(ws + OFF_CTL + CTL_TOKG);
    int* rowtok = (int*)(ws + OFF_CTL + CTL_ROWTOK);
    for (int i = bid * NT + tid; i < CAP; i += nb * NT) rowtok[i] = 0;
    float* rt = (float*)(smem + 256);
    { const f32x4* src = (const f32x4*)(ws + OFF_ROUT); f32x4* dst = (f32x4*)rt; for (int i = tid; i < 36 * 256; i += NT) dst[i] = src[i]; }
    __syncthreads();
    for (int it = bid; it < T / 32; it += nb) {
        const int rbase = it * 32 + wid * 4;
        f32x4 hv[4][4];
#pragma unroll
        for (int rr = 0; rr < 4; ++rr) {
            const f32x4* xr = (const f32x4*)(x2 + (size_t)(rbase + rr) * D) + lane; const f32x4* gr = (const f32x4*)p.norm_ffn + lane;
            float s = 0.f;
#pragma unroll
            for (int j = 0; j < 4; ++j) { hv[rr][j] = xr[64 * j]; s += hv[rr][j].x * hv[rr][j].x + hv[rr][j].y * hv[rr][j].y + hv[rr][j].z * hv[rr][j].z + hv[rr][j].w * hv[rr][j].w; }
            const float rstd = rsqrtf(wave_sum(s) * (1.f / 1024.f) + 1e-6f);
            u32x2* o8 = (u32x2*)(xn + (size_t)(rbase + rr) * D) + lane;
#pragma unroll
            for (int j = 0; j < 4; ++j) { const f32x4 gg = gr[64 * j]; hv[rr][j] = hv[rr][j] * rstd * gg; o8[64 * j] = pack4(hv[rr][j]); }
        }
        float mine[4] = {0.f, 0.f, 0.f, 0.f};
#pragma unroll 2
        for (int o = 0; o < 36; ++o) {
            const f32x4* wr_ = (const f32x4*)(rt + o * 1024) + lane;
            f32x4 w[4];
#pragma unroll
            for (int j = 0; j < 4; ++j) w[j] = wr_[64 * j];
#pragma unroll
            for (int rr = 0; rr < 4; ++rr) {
                float s = 0.f;
#pragma unroll
                for (int j = 0; j < 4; ++j) s += hv[rr][j].x * w[j].x + hv[rr][j].y * w[j].y + hv[rr][j].z * w[j].z + hv[rr][j].w * w[j].w;
                s = wave_sum(s);
                if (lane == o) mine[rr] = s;
            }
        }
#pragma unroll
        for (int rr = 0; rr < 4; ++rr) {
            const float g0 = __shfl(mine[rr], 32), g1 = __shfl(mine[rr], 33), g2 = __shfl(mine[rr], 34), g3 = __shfl(mine[rr], 35);
            int gs = 0; float gm = g0;
            if (g1 > gm) { gm = g1; gs = 1; }
            if (g2 > gm) { gm = g2; gs = 2; }
            if (g3 > gm) { gm = g3; gs = 3; }
            const float gp = 1.f / (__expf(g0 - gm) + __expf(g1 - gm) + __expf(g2 - gm) + __expf(g3 - gm));
            float e[8];
#pragma unroll
            for (int i = 0; i < 8; ++i) e[i] = __shfl(mine[rr], gs * 8 + i);
            int i1 = 0; float v1 = e[0];
#pragma unroll
            for (int i = 1; i < 8; ++i) if (e[i] > v1) { v1 = e[i]; i1 = i; }
            int i2 = -1; float v2 = -3.0e38f;
#pragma unroll
            for (int i = 0; i < 8; ++i) if (i != i1 && e[i] > v2) { v2 = e[i]; i2 = i; }
            const float e2 = __expf(v2 - v1), den = 1.f / (1.f + e2);
            if (lane == 0) {
                const int tok = rbase + rr;
                toke[tok * 2] = gs * 8 + i1; toke[tok * 2 + 1] = gs * 8 + i2;
                tokg[tok * 2] = gp * den; tokg[tok * 2 + 1] = gp * e2 * den;
                atomicAdd(&hist[gs * 8 + i1], 1); atomicAdd(&hist[gs * 8 + i2], 1);
            }
        }
    }
    __syncthreads();
    if (tid < 32 && hist[tid]) atomicAdd((int*)(ws + OFF_CTL + CTL_CNT) + tid, hist[tid]);
}
__device__ __forceinline__ void phase_dispatch(const P& p, int bid, int nb, char* smem) {
    const int tid = otid();
    char* ws = p.ws;
    int* pstart = (int*)smem;
    int* lh = pstart + 64;
    int* lc = lh + 32;
    int* cn = lc + 32;
    const int* counts = (const int*)(ws + OFF_CTL + CTL_CNT);
    int* cursor = (int*)(ws + OFF_CTL + CTL_CNT) + 32;
    if (tid < 32) { cn[tid] = counts[tid]; lh[tid] = 0; lc[tid] = 0; }
    __syncthreads();
    if (tid == 0) { int a = 0; for (int e = 0; e < 32; ++e) { pstart[e] = a; a += (cn[e] + MBLK - 1) / MBLK * MBLK; } pstart[32] = a; }
    __syncthreads();
    const int* toke = (const int*)(ws + OFF_CTL + CTL_TOKE);
    int* toks = (int*)(ws + OFF_CTL + CTL_TOKS); int* rowtok = (int*)(ws + OFF_CTL + CTL_ROWTOK);
    const int per = (T * 2 + nb - 1) / nb, i0 = bid * per, i1 = min(T * 2, i0 + per);
    for (int i = i0 + tid; i < i1; i += NT) atomicAdd(&lh[toke[i]], 1);
    __syncthreads();
    if (tid < 32) { const int c = lh[tid]; lh[tid] = c ? atomicAdd(&cursor[tid], c) : 0; }
    __syncthreads();
    for (int i = i0 + tid; i < i1; i += NT) {
        const int e = toke[i];
        const int pos = pstart[e] + lh[e] + atomicAdd(&lc[e], 1);
        rowtok[pos] = i >> 1; toks[i] = pos;
    }
    if (bid == 0) {
        int* blke = (int*)(ws + OFF_CTL + CTL_BLKE);
        for (int b = tid; b < NBLK; b += NT) {
            const int r = b * MBLK; int e = -1;
            if (r < pstart[32]) { e = 0; while (pstart[e + 1] <= r) ++e; }
            blke[b] = e;
        }
        if (tid == 0) blke[NBLK] = pstart[32] / MBLK;
    }
}
struct MoeOrder {
    const int* blke; const int* rowtok; int nunits, G, c; bool gather; int brows;
    __device__ bool next(int i, pg8::Unit& u) const {
        const int L = i * G + c; if (L >= nunits) return false;
        u.pm = L >> 2; u.pn = L & 3; u.e = blke[u.pm]; return true;
    }
    __device__ __forceinline__ unsigned rowA(const pg8::Unit& u, int r) const { return gather ? (unsigned)rowtok[u.pm * MBLK + r] : (unsigned)(u.pm * MBLK + r); }
    __device__ __forceinline__ unsigned rowB(const pg8::Unit& u, int r) const { return (unsigned)(u.e * brows + u.pn * 256 + r); }
};
struct EpiHid {
    static constexpr bool PERM = false;
    bf16_t* hid;
    __device__ __forceinline__ void operator()(const f32x4 (&acc)[2][2][4][2], const pg8::Unit& u, int wr, int wc, int fr, int fq) const {
        const int row0 = u.pm * 256 + wr * 64 + fr, col0 = u.pn * 128 + wc * 16 + 4 * fq;
#pragma unroll
        for (int ai = 0; ai < 2; ++ai)
#pragma unroll
            for (int m = 0; m < 4; ++m) {
                bf16_t* rowp = hid + (size_t)(row0 + ai * 128 + m * 16) * DEXP + col0;
#pragma unroll
                for (int bj = 0; bj < 2; ++bj) {
                    const f32x4 g = acc[ai][bj][m][0], uu = acc[ai][bj][m][1];
                    f32x4 hval; hval.x = g.x * sigm(g.x) * uu.x; hval.y = g.y * sigm(g.y) * uu.y; hval.z = g.z * sigm(g.z) * uu.z; hval.w = g.w * sigm(g.w) * uu.w;
                    *(u32x2*)(rowp + bj * 64) = pack4(hval);
                }
            }
    }
};
struct EpiY {
    static constexpr bool PERM = true;
    bf16_t* ym;
    __device__ __forceinline__ void operator()(const f32x4 (&acc)[2][2][4][2], const pg8::Unit& u, int wr, int wc, int fr, int fq) const {
        const int row0 = u.pm * 256 + wr * 64 + fr, col0 = u.pn * 256 + wc * 32 + 8 * fq;
#pragma unroll
        for (int ai = 0; ai < 2; ++ai)
#pragma unroll
            for (int m = 0; m < 4; ++m) {
                bf16_t* rowp = ym + (size_t)(row0 + ai * 128 + m * 16) * D + col0;
#pragma unroll
                for (int bj = 0; bj < 2; ++bj) {
                    const f32x4 v0 = acc[ai][bj][m][0], v1 = acc[ai][bj][m][1];
                    u32x4 w; w.x = cvt_pk(v0.x, v0.y); w.y = cvt_pk(v0.z, v0.w); w.z = cvt_pk(v1.x, v1.y); w.w = cvt_pk(v1.z, v1.w);
                    *(u32x4*)(rowp + bj * 128) = w;
                }
            }
    }
};
__device__ __forceinline__ void phase_exp1(const P& p, int bid, int nb, char* smem) {
    char* ws = p.ws;
    const int* blke = (const int*)(ws + OFF_CTL + CTL_BLKE);
    MoeOrder S{blke, (const int*)(ws + OFF_CTL + CTL_ROWTOK), blke[NBLK] * 4, nb, bid, true, 1024};
    EpiHid E{(bf16_t*)(ws + OFF_MRG)};
    pg8::gemm_phase<EpiHid, MoeOrder, true>((LAS unsigned char*)smem, (const bf16_t*)(ws + OFF_XN), (const bf16_t*)(ws + OFF_EXPGU), D, S, E);
}
__device__ __forceinline__ void phase_exp2(const P& p, int bid, int nb, char* smem) {
    char* ws = p.ws;
    const int* blke = (const int*)(ws + OFF_CTL + CTL_BLKE);
    MoeOrder S{blke, nullptr, blke[NBLK] * 4, nb, bid, false, 1024};
    EpiY E{(bf16_t*)(ws + OFF_YMOE)};
    pg8::gemm_phase<EpiY, MoeOrder, true>((LAS unsigned char*)smem, (const bf16_t*)(ws + OFF_MRG), (const bf16_t*)(ws + OFF_EXPD), DEXP, S, E);
}
__device__ __forceinline__ void phase_final(const P& p, int bid, int nb) {
    const int lane = otid() & 63, wid = otid() >> 6;
    char* ws = p.ws;
    const int* toks = (const int*)(ws + OFF_CTL + CTL_TOKS); const float* tokg = (const float*)(ws + OFF_CTL + CTL_TOKG);
    const bf16_t* ym = (const bf16_t*)(ws + OFF_YMOE);
    for (int it = bid; it < T / 8; it += nb) {
        const int row = it * 8 + wid;
        const int s1 = toks[row * 2], s2 = toks[row * 2 + 1]; const float g1 = tokg[row * 2], g2 = tokg[row * 2 + 1];
        f32x4* xr = (f32x4*)(p.out + (size_t)row * D) + lane; const f32x4* gr = (const f32x4*)p.norm_final + lane;
        const u32x2* y1 = (const u32x2*)(ym + (size_t)s1 * D) + lane; const u32x2* y2 = (const u32x2*)(ym + (size_t)s2 * D) + lane;
        f32x4 v[4]; float s = 0.f;
#pragma unroll
        for (int j = 0; j < 4; ++j) {
            v[j] = xr[64 * j] + g1 * unpack4(y1[64 * j]) + g2 * unpack4(y2[64 * j]);
            s += v[j].x * v[j].x + v[j].y * v[j].y + v[j].z * v[j].z + v[j].w * v[j].w;
        }
        const float rstd = rsqrtf(wave_sum(s) * (1.f / 1024.f) + 1e-6f);
#pragma unroll
        for (int j = 0; j < 4; ++j) xr[64 * j] = v[j] * rstd * gr[64 * j];
    }
}

template <int PH>
__device__ __forceinline__ void run_phase(const P& p, int bid, int nb, char* smem) {
    char* ws = p.ws;
    if (PH == 0) phase0(p, bid, nb, smem);
    else if (PH == 1) phase1(p, bid, nb, smem);
    else if (PH == 2) { phase_kmean(p, bid, nb, smem); phase_rw_chunk(p, bid, nb, smem); }
    else if (PH == 3) {
        if (bid < 32) rw_scan(p, bid, smem);
        else { moba_select(p, bid - 32, nb - 32, smem); phase_kvx(p, bid - 32, nb - 32, smem); phase_expconv<0>(p, bid - 32, nb - 32, smem); }
    }
    else if (PH == 4) { phase_rw_out(p, bid, nb); moba_fill(p, bid, nb, smem); __syncthreads(); phase_vtrans(p, bid, nb, smem); }
    else if (PH == 5) moba_partial(p, bid, nb, smem);
    else if (PH == 6) moba_own(p, bid, nb, smem);
    else if (PH == 7) phase_merge(p, bid, nb, smem);
    else if (PH == 8) phase_resid_gemm((const bf16_t*)(ws + OFF_MRG), D, (const bf16_t*)(ws + OFF_WOUT), p.x, p.out, bid, nb, smem);
    else if (PH == 9) { phase_norm(p.out, p.norm_xattn, (bf16_t*)(ws + OFF_XN), bid, nb); phase_expconv<1>(p, bid, nb, smem); }
    else if (PH == 10) phase_qx_xattn(p, bid, nb, smem);
    else if (PH == 11) phase_resid_gemm((const bf16_t*)(ws + OFF_OB), 512, (const bf16_t*)(ws + OFF_WOX), p.out, p.out, bid, nb, smem);
    else if (PH == 12) phase_router(p, bid, nb, smem);
    else if (PH == 13) phase_dispatch(p, bid, nb, smem);
    else if (PH == 14) phase_exp1(p, bid, nb, smem);
    else if (PH == 15) phase_exp2(p, bid, nb, smem);
    else if (PH == 16) phase_final(p, bid, nb);
}

#define XB_TMO      128
#define XB_XCNT(j)  (256  + 64 * (j))
#define XB_XSUB(j)  (1280 + 64 * (j))
#define XB_XGEN(j)  (2304 + 64 * (j))
#define XB_TOP      3328
#define XB_TOPGEN   3392
#define XCD_BAR_WORDS 3456
#define XB_SPIN_CAP (1u << 18)
__device__ __forceinline__ unsigned xb_ld(unsigned* p)              { return __hip_atomic_load(p, __ATOMIC_RELAXED, __HIP_MEMORY_SCOPE_AGENT); }
__device__ __forceinline__ unsigned xb_add(unsigned* p, unsigned v) { return __hip_atomic_fetch_add(p, v, __ATOMIC_RELAXED, __HIP_MEMORY_SCOPE_AGENT); }
__device__ __forceinline__ unsigned xb_xcc_id() { return (unsigned)__builtin_amdgcn_s_getreg((3 << 11) | 20) & 0xFu; }
#define XB_SPIN(cond, bar) do { unsigned _sp = 0; while (cond) { __builtin_amdgcn_s_sleep(1); \
    if ((++_sp & 255u) == 0u) { if (xb_ld(&(bar)[XB_TMO])) break; if (_sp > XB_SPIN_CAP) { atomicAdd(&(bar)[XB_TMO], 1u); break; } } } } while (0)
struct XcdBarrier { unsigned* bar; unsigned x; volatile LAS unsigned* st; };
__device__ __forceinline__ XcdBarrier xcd_barrier_post(unsigned* bar, volatile LAS unsigned* st) {
    XcdBarrier b; b.bar = bar; b.x = xb_xcc_id(); b.st = st;
    if (threadIdx.x == 0) (void)xb_add(&bar[XB_XCNT(b.x)], 1u);
    return b;
}
__device__ __forceinline__ void xcd_barrier_complete(unsigned* bar, unsigned x, unsigned& nloc, unsigned& nx) {
    const unsigned G = gridDim.x * gridDim.y * gridDim.z;
    unsigned sum, cnt, mine, sp = 0u;
    for (;;) {
        sum = 0u; cnt = 0u; mine = 0u;
#pragma unroll
        for (unsigned j = 0; j < 16; ++j) { const unsigned c = xb_ld(&bar[XB_XCNT(j)]); sum += c; cnt += (c > 0u) ? 1u : 0u; mine = (j == x) ? c : mine; }
        if (sum == G) break;
        __builtin_amdgcn_s_sleep(1);
        if ((++sp & 255u) == 0u) { if (xb_ld(&bar[XB_TMO])) break; if (sp > XB_SPIN_CAP) { atomicAdd(&bar[XB_TMO], 1u); break; } }
    }
    nloc = mine > 0u ? mine : 1u; nx = cnt > 0u ? cnt : 1u;
}
__device__ __forceinline__ void xcd_barrier(const XcdBarrier& b) {
    asm volatile("s_waitcnt vmcnt(0)" ::: "memory");
    __syncthreads();
    if (threadIdx.x == 0) {
        unsigned* bar = b.bar;
        __builtin_amdgcn_s_waitcnt(0);
        unsigned nloc = b.st[0], nx = b.st[1];
        if (nloc == 0u) { xcd_barrier_complete(bar, b.x, nloc, nx); b.st[0] = nloc; b.st[1] = nx; }
        const unsigned old = xb_add(&bar[XB_XSUB(b.x)], 1u);
        const unsigned gen = old / nloc;
        if (old + 1u == (gen + 1u) * nloc) {
            __builtin_amdgcn_fence(__ATOMIC_RELEASE, "agent");
            asm volatile("s_waitcnt vmcnt(0)" ::: "memory");
            const unsigned og = xb_add(&bar[XB_TOP], 1u);
            const unsigned tg = og / nx;
            if (og + 1u == (tg + 1u) * nx) xb_add(&bar[XB_TOPGEN], 1u);
            else XB_SPIN(xb_ld(&bar[XB_TOPGEN]) == tg, bar);
            __builtin_amdgcn_fence(__ATOMIC_ACQUIRE, "agent");
            xb_add(&bar[XB_XGEN(b.x)], 1u);
            asm volatile("s_waitcnt vmcnt(0)" ::: "memory");
        } else {
            XB_SPIN(xb_ld(&bar[XB_XGEN(b.x)]) == gen, bar);
            __builtin_amdgcn_fence(__ATOMIC_ACQUIRE, "agent");
            asm volatile("s_waitcnt vmcnt(0)" ::: "memory");
        }
    }
    __syncthreads();
}
constexpr int L_BARST = 154112;
constexpr int LDS_BYTES = 154368;
static_assert(2 * RW_LDS <= L_BARST && pg8::STAGE_BYTES <= L_BARST && A_TST + 2052 <= L_BARST, "lds");

__global__ void __launch_bounds__(NT, 2) mega_kernel(P p) {
    extern __shared__ __attribute__((aligned(16))) char smem[];
    const int bid = blockIdx.x, nb = gridDim.x;
    volatile LAS unsigned* bst = (volatile LAS unsigned*)(LAS char*)(smem + L_BARST);
    if (threadIdx.x < 2) bst[threadIdx.x] = 0u;
    __syncthreads();
    const XcdBarrier xb = xcd_barrier_post((unsigned*)(p.ws + OFF_CTL + CTL_BAR), bst);
#define GSYNC() xcd_barrier(xb)
    run_phase<0>(p, bid, nb, smem); GSYNC();
    run_phase<1>(p, bid, nb, smem); GSYNC();
    run_phase<2>(p, bid, nb, smem); GSYNC();
    run_phase<3>(p, bid, nb, smem); GSYNC();
    run_phase<4>(p, bid, nb, smem); GSYNC();
    run_phase<5>(p, bid, nb, smem); GSYNC();
    run_phase<6>(p, bid, nb, smem); GSYNC();
    run_phase<7>(p, bid, nb, smem); GSYNC();
    run_phase<8>(p, bid, nb, smem); GSYNC();
    run_phase<9>(p, bid, nb, smem); GSYNC();
    run_phase<10>(p, bid, nb, smem); GSYNC();
    run_phase<11>(p, bid, nb, smem); GSYNC();
    run_phase<12>(p, bid, nb, smem); GSYNC();
    run_phase<13>(p, bid, nb, smem); GSYNC();
    run_phase<14>(p, bid, nb, smem); GSYNC();
    run_phase<15>(p, bid, nb, smem); GSYNC();
    run_phase<16>(p, bid, nb, smem);
}

extern "C" void kernel_launch(void* const* d_in, const int* in_sizes, int n_in, void* d_out, int out_size, void* d_ws, size_t ws_size, hipStream_t stream) {
    if (n_in != 31 || ws_size < WS_NEED || out_size != T * D) { fprintf(stderr, "kernel_launch: unexpected n_in %d / ws_size %zu / out_size %d\n", n_in, ws_size, out_size); return; }
    static int grid_blocks = 0;
    if (!grid_blocks) {
        int dev = 0, cus = 0, per_cu = 0;
        (void)hipGetDevice(&dev);
        (void)hipDeviceGetAttribute(&cus, hipDeviceAttributeMultiprocessorCount, dev);
        if (hipFuncSetAttribute((const void*)mega_kernel, hipFuncAttributeMaxDynamicSharedMemorySize, LDS_BYTES) != hipSuccess) fprintf(stderr, "kernel_launch: hipFuncSetAttribute failed\n");
        (void)hipOccupancyMaxActiveBlocksPerMultiprocessor(&per_cu, (const void*)mega_kernel, NT, LDS_BYTES);
        if (per_cu < 1) { fprintf(stderr, "kernel_launch: occupancy query returned %d\n", per_cu); per_cu = 1; }
        grid_blocks = cus;
        if (grid_blocks % 8) grid_blocks -= grid_blocks % 8;
        fprintf(stderr, "kernel_launch: cus %d per_cu %d grid %d\n", cus, per_cu, grid_blocks);
    }
    P p{};
    const float** f = (const float**)&p;
    for (int i = 0; i < 31; ++i) f[i] = (const float*)d_in[i];
    p.out = (float*)d_out; p.ws = (char*)d_ws;
    if (hipMemsetAsync((char*)d_ws + OFF_CTL + CTL_BAR, 0, XCD_BAR_WORDS * 4, stream) != hipSuccess) fprintf(stderr, "kernel_launch: memset failed\n");
    void* args[] = {&p};
    hipError_t e = hipLaunchCooperativeKernel((const void*)mega_kernel, dim3(grid_blocks), dim3(NT), args, LDS_BYTES, stream);
    if (e != hipSuccess) fprintf(stderr, "cooperative launch failed: %s (grid %d)\n", hipGetErrorString(e), grid_blocks);
}
```

```cpp
#include <hip/hip_runtime.h>
#include <cstdio>
#include <cstdint>

typedef unsigned short bf16_t;
typedef short bf16x8 __attribute__((ext_vector_type(8)));
typedef float f32x4 __attribute__((ext_vector_type(4)));
typedef float f32x2 __attribute__((ext_vector_type(2)));
typedef unsigned u32x4 __attribute__((ext_vector_type(4)));
typedef unsigned u32x2 __attribute__((ext_vector_type(2)));
typedef __bf16 bf16x2_t __attribute__((ext_vector_type(2)));
#define LAS __attribute__((address_space(3)))
#define MFMA16(a, b, c) __builtin_amdgcn_mfma_f32_16x16x32_bf16((a), (b), (c), 0, 0, 0)

constexpr int NT = 512;
constexpr int T = 16384, D = 1024, NMEM = 256;
constexpr int UMC = 1536;
constexpr int RW = 512, RCOLS = 1792, MW = 512, MCOLS = 1536, GCOLS = 2048, INCOLS = 5376;
constexpr int NEXP = 32, DEXP = 512, MBLK = 256, NBLK = 160, CAP = NBLK * MBLK;
constexpr size_t MiB = 1u << 20;
constexpr size_t OFF_CTL = 0;
constexpr size_t OFF_WIN = 1 * MiB;
constexpr size_t OFF_WORW = OFF_WIN + (size_t)INCOLS * D * 2;
constexpr size_t OFF_WOMB = OFF_WORW + 1 * MiB;
constexpr size_t OFF_WOUT = OFF_WOMB + 1 * MiB;
constexpr size_t OFF_WQ = OFF_WOUT + 2 * MiB;
constexpr size_t OFF_WKV = OFF_WQ + 1 * MiB;
constexpr size_t OFF_WOX = OFF_WKV + 2 * MiB;
constexpr size_t OFF_MEMN = OFF_WOX + 1 * MiB;
constexpr size_t OFF_KVX = OFF_MEMN + MiB / 2;
constexpr size_t OFF_ROUT = OFF_KVX + MiB / 2;
constexpr size_t OFF_LORA_D = OFF_ROUT + 160 * 1024;
constexpr size_t OFF_LORA_I = OFF_LORA_D + 64 * 1024;
constexpr size_t OFF_LORA_G = OFF_LORA_I + 64 * 1024;
constexpr size_t OFF_XN = 21 * MiB;
constexpr size_t OFF_BON = 21 * MiB;
constexpr size_t OFF_RH = 37 * MiB;
constexpr size_t OFF_UG = 53 * MiB;
constexpr size_t OFF_UR = 117 * MiB;
constexpr size_t OFF_UM = 173 * MiB;
constexpr size_t OFF_OA = 221 * MiB;
constexpr size_t OFF_OB = 237 * MiB;
constexpr size_t OFF_MRG = 253 * MiB;
constexpr size_t OFF_MF = 253 * MiB;
constexpr size_t OFF_SF = 269 * MiB;
constexpr size_t OFF_VT = 253 * MiB;
constexpr size_t OFF_EXPD = 117 * MiB;
constexpr size_t OFF_EXPGU = 149 * MiB;
constexpr size_t OFF_YMOE = 21 * MiB;
constexpr size_t OFF_MSEL = 285 * MiB;
constexpr size_t OFF_MQL = OFF_MSEL + MiB / 2;
constexpr size_t OFF_MSP = OFF_MQL + 3 * MiB / 2;
constexpr size_t WS_NEED = 293 * MiB;
static_assert(OFF_LORA_G + 128 * 1024 <= OFF_XN, "ws map");
constexpr size_t CTL_CNT = 0;
constexpr size_t CTL_BLKE = 4096;
constexpr size_t CTL_MCNT = 8192, CTL_MCUR = 10240, CTL_MLST = 12288, CTL_MTST = 14592, CTL_MCST = 16896;
constexpr size_t CTL_TOKE = 192 * 1024;
constexpr size_t CTL_TOKG = 320 * 1024;
constexpr size_t CTL_TOKS = 448 * 1024;
constexpr size_t CTL_ROWTOK = 576 * 1024;
constexpr size_t CTL_BAR = 752 * 1024;
constexpr size_t CTL_KMB = 768 * 1024;

struct P {
    const float *x, *mem, *rel_bias, *mem_norm, *norm_mix, *w_in, *tshift_mu, *decay_w0, *decay_up, *iclr_a0, *iclr_up, *gate_up,
        *k_k, *k_a, *r_k, *ln_x_w, *ln_x_b, *w_o_rwkv, *w_o_moba, *w_out, *norm_xattn, *w_q_x, *w_kv_x, *w_o_x, *norm_ffn,
        *w_router_group, *w_router_expert, *w_exp_gate, *w_exp_up, *w_exp_down, *norm_final;
    float* out;
    char* ws;
};

__device__ __forceinline__ int otid() { int t = threadIdx.x; asm volatile("" : "+v"(t)); return t; }
__device__ __forceinline__ float bf2f(bf16_t b) { return __uint_as_float((unsigned)b << 16); }
__device__ __forceinline__ unsigned f2bf(float f) { unsigned u = __float_as_uint(f); return (u + 0x7fffu + ((u >> 16) & 1u)) >> 16; }
__device__ __forceinline__ unsigned cvt_pk(float lo, float hi) { const f32x2 v = {lo, hi}; return __builtin_bit_cast(unsigned, __builtin_convertvector(v, bf16x2_t)); }
__device__ __forceinline__ unsigned pk2(float lo, float hi) { return cvt_pk(lo, hi); }
__device__ __forceinline__ u32x2 pack4(f32x4 v) { u32x2 o; o.x = cvt_pk(v.x, v.y); o.y = cvt_pk(v.z, v.w); return o; }
__device__ __forceinline__ bf16x8 pack8(f32x4 a, f32x4 b) { u32x4 o; o.x = cvt_pk(a.x, a.y); o.y = cvt_pk(a.z, a.w); o.z = cvt_pk(b.x, b.y); o.w = cvt_pk(b.z, b.w); return __builtin_bit_cast(bf16x8, o); }
__device__ __forceinline__ bf16x8 ldperm(const char* rowbase, int ks, int fq) {
    const u32x2 a = *(const u32x2*)(rowbase + (32 * ks + fq * 4) * 2), b = *(const u32x2*)(rowbase + (32 * ks + 16 + fq * 4) * 2);
    u32x4 o; o.x = a.x; o.y = a.y; o.z = b.x; o.w = b.y; return __builtin_bit_cast(bf16x8, o);
}
__device__ __forceinline__ float wave_sum(float v) {
#pragma unroll
    for (int o = 32; o >= 1; o >>= 1) v += __shfl_xor(v, o);
    return v;
}
__device__ __forceinline__ float sigm(float x) { return __builtin_amdgcn_rcpf(1.f + __expf(-x)); }
__device__ __forceinline__ void unpack8(u32x4 w, float* f) {
    f[0] = __uint_as_float(w.x << 16); f[1] = __uint_as_float(w.x & 0xffff0000u);
    f[2] = __uint_as_float(w.y << 16); f[3] = __uint_as_float(w.y & 0xffff0000u);
    f[4] = __uint_as_float(w.z << 16); f[5] = __uint_as_float(w.z & 0xffff0000u);
    f[6] = __uint_as_float(w.w << 16); f[7] = __uint_as_float(w.w & 0xffff0000u);
}
__device__ __forceinline__ f32x4 unpack4(u32x2 w) { f32x4 r; r.x = __uint_as_float(w.x << 16); r.y = __uint_as_float(w.x & 0xffff0000u); r.z = __uint_as_float(w.y << 16); r.w = __uint_as_float(w.y & 0xffff0000u); return r; }

namespace pg8 {
constexpr int BM = 256, BK = 64, HALF = 128, HTB = HALF * BK * 2  , STAGE_BYTES = 8 * HTB, NXCD = 8, WGM = 8;
__device__ __forceinline__ int lds_byte(int r, int c) { const int st = (r >> 4) * 2 + (c >> 5), rr = r & 15, cc = c & 31, ob = rr * 64 + cc * 2; return st * 1024 + (ob ^ (((ob >> 9) & 1) << 5)); }
__device__ __forceinline__ void stage_rc(int b, int& R, int& C) { const int st = b / 1024, sb = b % 1024, swz = sb ^ (((sb >> 9) & 1) << 5); R = (st >> 1) * 16 + swz / 64; C = (st & 1) * 32 + (swz % 64) / 2; }
__device__ __forceinline__ int perm32(int rho) { const int n = rho >> 4, i = rho & 15; return 8 * (i >> 2) + 4 * n + (i & 3); }
struct Unit { int pm, pn, e; };

struct StaticOrder {
    int nM, nN, nwg, G, c;
    __device__ void init(int M, int N, int G_, int c_) { nM = M / BM; nN = N / BM; nwg = nM * nN; G = G_; c = c_; }
    __device__ bool next(int i, Unit& u) const {
        const long L = (long)i * G + c; if (L >= nwg) return false;
        int wgid = (int)L; { const int q = nwg / NXCD, r = nwg % NXCD, xcd = wgid % NXCD, off = wgid / NXCD; wgid = (xcd < r ? xcd * (q + 1) : r * (q + 1) + (xcd - r) * q) + off; }
        const int nig = WGM * nN, gid = wgid / nig, fm = gid * WGM, gsz = (nM - fm) < WGM ? (nM - fm) : WGM;
        u.pm = fm + ((wgid % nig) % gsz); u.pn = (wgid % nig) / gsz; u.e = 0; return true;
    }
    __device__ __forceinline__ unsigned rowA(const Unit& u, int r) const { return (unsigned)(u.pm * BM + r); }
    __device__ __forceinline__ unsigned rowB(const Unit& u, int r) const { return (unsigned)(u.pn * BM + r); }
};

template <class Epi, class Sched, bool ALIGN_EPI>
__device__ __forceinline__ void gemm_phase(LAS unsigned char* lds, const bf16_t* Ab, const bf16_t* Bb, const int K, const Sched& S, const Epi& E) {
    const int tid = otid(), wid = __builtin_amdgcn_readfirstlane(tid >> 6), lane = tid & 63, wr = wid >> 2, wc = wid & 3, fr = lane & 15, fq = lane >> 4;
    const int nt = K / BK;
    int sR[2], sC[2], sRb[2];
#pragma unroll
    for (int i = 0; i < 2; ++i) { int R, C; stage_rc(tid * 16 + i * 8192, R, C); sR[i] = R; sC[i] = C; sRb[i] = Epi::PERM ? ((R & ~31) + perm32(R & 31)) : R; }
    const unsigned kstep = (unsigned)(BK * 2);
    const unsigned ldsw = (unsigned)wid * 1024u;
    const int aoff = lds_byte(wr * 64 + fr, fq * 8), boff = lds_byte(wc * 32 + fr, fq * 8);
#define PG8_SA(b, h) (((b) * 2 + (h)) * HTB)
#define PG8_SB(b, h) ((4 + (b) * 2 + (h)) * HTB)
#define PG8_STAGE(bufoff, gbase, offs, kb) do { _Pragma("unroll") for (int _i = 0; _i < 2; ++_i) \
        __builtin_amdgcn_global_load_lds((const unsigned*)((const char*)(gbase) + (size_t)((offs)[_i] + (kb))), (LAS unsigned*)(lds + (bufoff) + ldsw + _i * 8192), 16, 0, 0); } while (0)
#define PG8_LDA(dst, b, h) do { _Pragma("unroll") for (int m = 0; m < 4; ++m) _Pragma("unroll") for (int k = 0; k < 2; ++k) dst[m][k] = *(const LAS bf16x8*)(lds + PG8_SA(b, h) + aoff + m * 2048 + k * 1024); } while (0)
#define PG8_LDB(dst, b, h) do { _Pragma("unroll") for (int n = 0; n < 2; ++n) _Pragma("unroll") for (int k = 0; k < 2; ++k) dst[n][k] = *(const LAS bf16x8*)(lds + PG8_SB(b, h) + boff + n * 2048 + k * 1024); } while (0)
#define PG8_MMA(ai, bj, At, Bt) do { __builtin_amdgcn_s_setprio(1); _Pragma("unroll") for (int m = 0; m < 4; ++m) _Pragma("unroll") for (int n = 0; n < 2; ++n) _Pragma("unroll") for (int k = 0; k < 2; ++k) \
        acc[ai][bj][m][n] = __builtin_amdgcn_mfma_f32_16x16x32_bf16(Bt[n][k], At[m][k], acc[ai][bj][m][n], 0, 0, 0); __builtin_amdgcn_s_setprio(0); } while (0)
#define PG8_WAIT_V(n) asm volatile("s_waitcnt vmcnt(" #n ")" ::: "memory")
#define PG8_WAIT_L(n) asm volatile("s_waitcnt lgkmcnt(" #n ")" ::: "memory")
#define PG8_BAR __builtin_amdgcn_s_barrier()
#define PG8_SCHED __builtin_amdgcn_sched_barrier(0)
#define PG8_OFFS(u, AO, BO) do { _Pragma("unroll") for (int _h = 0; _h < 2; ++_h) _Pragma("unroll") for (int _i = 0; _i < 2; ++_i) { \
        AO[_h][_i] = (S.rowA(u, _h * HALF + sR[_i]) * (unsigned)K + (unsigned)sC[_i]) * 2u; BO[_h][_i] = (S.rowB(u, _h * HALF + sRb[_i]) * (unsigned)K + (unsigned)sC[_i]) * 2u; } } while (0)
    Unit cur, nxt; int ui = 0;
    if (!S.next(0, cur)) return;
    f32x4 acc[2][2][4][2];
#pragma unroll
    for (int a = 0; a < 2; ++a)
#pragma unroll
        for (int b = 0; b < 2; ++b)
#pragma unroll
            for (int m = 0; m < 4; ++m)
#pragma unroll
                for (int n = 0; n < 2; ++n) acc[a][b][m][n] = (f32x4){0.f, 0.f, 0.f, 0.f};
    bf16x8 At[4][2], B0[2][2], B1[2][2];
    unsigned ao[2][2], bo[2][2], nao[2][2], nbo[2][2];
    PG8_OFFS(cur, ao, bo);
    PG8_STAGE(PG8_SB(0, 0), Bb, bo[0], 0u); PG8_STAGE(PG8_SB(0, 1), Bb, bo[1], 0u); PG8_STAGE(PG8_SA(0, 0), Ab, ao[0], 0u); PG8_STAGE(PG8_SA(0, 1), Ab, ao[1], 0u);
    if (wr == 1) PG8_BAR;
    PG8_WAIT_V(2); PG8_BAR;
    PG8_STAGE(PG8_SB(1, 0), Bb, bo[0], kstep); PG8_STAGE(PG8_SA(1, 0), Ab, ao[0], kstep); PG8_STAGE(PG8_SB(1, 1), Bb, bo[1], kstep);
    PG8_WAIT_V(6); PG8_BAR;
    for (;;) {
        const bool has_next = S.next(ui + 1, nxt);
        if (has_next) { PG8_OFFS(nxt, nao, nbo); }
        else {
#pragma unroll
            for (int h = 0; h < 2; ++h)
#pragma unroll
                for (int i = 0; i < 2; ++i) { nao[h][i] = ao[h][i]; nbo[h][i] = bo[h][i]; }
        }
        for (int t = 0; t < nt; t += 2) {
            const bool last = (t == nt - 2);
            const unsigned k1 = (unsigned)(t + 1) * kstep, k2 = last ? 0u : (unsigned)(t + 2) * kstep, k3 = k2 + kstep;
            unsigned a2[2][2], b2[2][2];
#pragma unroll
            for (int h = 0; h < 2; ++h)
#pragma unroll
                for (int i = 0; i < 2; ++i) { a2[h][i] = last ? nao[h][i] : ao[h][i]; b2[h][i] = last ? nbo[h][i] : bo[h][i]; }
            PG8_LDB(B0, 0, 0); PG8_LDB(B1, 0, 1); PG8_SCHED; PG8_LDA(At, 0, 0); PG8_STAGE(PG8_SA(1, 1), Ab, ao[1], k1);
            PG8_WAIT_V(8); PG8_WAIT_L(0); PG8_BAR; PG8_MMA(0, 0, At, B0); PG8_MMA(0, 1, At, B1); PG8_BAR; PG8_SCHED;
            PG8_LDA(At, 0, 1); PG8_STAGE(PG8_SB(0, 0), Bb, b2[0], k2); PG8_STAGE(PG8_SB(0, 1), Bb, b2[1], k2); PG8_STAGE(PG8_SA(0, 0), Ab, a2[0], k2);
            PG8_WAIT_V(8); PG8_WAIT_L(0); PG8_BAR; PG8_MMA(1, 0, At, B0); PG8_MMA(1, 1, At, B1); PG8_BAR; PG8_SCHED;
            PG8_LDB(B0, 1, 0); PG8_LDB(B1, 1, 1); PG8_SCHED; PG8_LDA(At, 1, 0); PG8_STAGE(PG8_SA(0, 1), Ab, a2[1], k2);
            PG8_WAIT_V(8); PG8_WAIT_L(0); PG8_BAR; PG8_MMA(0, 0, At, B0); PG8_MMA(0, 1, At, B1); PG8_BAR; PG8_SCHED;
            PG8_LDA(At, 1, 1); PG8_STAGE(PG8_SB(1, 0), Bb, b2[0], k3); PG8_STAGE(PG8_SB(1, 1), Bb, b2[1], k3); PG8_STAGE(PG8_SA(1, 0), Ab, a2[0], k3);
            PG8_WAIT_V(8); PG8_WAIT_L(0); PG8_BAR; PG8_MMA(1, 0, At, B0); PG8_MMA(1, 1, At, B1); PG8_BAR; PG8_SCHED;
        }
        if constexpr (ALIGN_EPI) { if (wr == 0) PG8_BAR; }
        E(acc, cur, wr, wc, fr, fq);
        if (!has_next) break;
#pragma unroll
        for (int a = 0; a < 2; ++a)
#pragma unroll
            for (int b = 0; b < 2; ++b)
#pragma unroll
                for (int m = 0; m < 4; ++m)
#pragma unroll
                    for (int n = 0; n < 2; ++n) acc[a][b][m][n] = (f32x4){0.f, 0.f, 0.f, 0.f};
        cur = nxt; ++ui;
#pragma unroll
        for (int h = 0; h < 2; ++h)
#pragma unroll
            for (int i = 0; i < 2; ++i) { ao[h][i] = nao[h][i]; bo[h][i] = nbo[h][i]; }
        if constexpr (ALIGN_EPI) { if (wr == 1) PG8_BAR; }
    }
    PG8_WAIT_V(0);
    if constexpr (!ALIGN_EPI) { if (wr == 0) PG8_BAR; }
    PG8_BAR;
#undef PG8_SA
#undef PG8_SB
#undef PG8_STAGE
#undef PG8_LDA
#undef PG8_LDB
#undef PG8_MMA
#undef PG8_WAIT_V
#undef PG8_WAIT_L
#undef PG8_BAR
#undef PG8_SCHED
#undef PG8_OFFS
}
}

__device__ __forceinline__ void gemm_r32(f32x4 (&acc)[2][8], const bf16_t* A, int lda, int brow, const bf16_t* Bt, int ldb, int bcol, int K, char* smem) {
    const int tid = otid(), lane = tid & 63, wid = tid >> 6, fr = lane & 15, fq = lane >> 4;
    const int r0 = tid >> 3, lch = (tid & 7) ^ ((tid >> 4) & 7);
    const bf16_t* pa[4]; const bf16_t* pb[2];
#pragma unroll
    for (int i = 0; i < 4; ++i) pa[i] = A + (long)(brow + r0 + 64 * i) * lda + lch * 8;
#pragma unroll
    for (int i = 0; i < 2; ++i) pb[i] = Bt + (long)(bcol + r0 + 64 * i) * ldb + lch * 8;
    const int nk = K / 64;
#pragma unroll
    for (int i = 0; i < 4; ++i) __builtin_amdgcn_global_load_lds((const unsigned*)pa[i], (unsigned*)(smem + tid * 16 + i * 8192), 16, 0, 0);
#pragma unroll
    for (int i = 0; i < 2; ++i) __builtin_amdgcn_global_load_lds((const unsigned*)pb[i], (unsigned*)(smem + 32768 + tid * 16 + i * 8192), 16, 0, 0);
    const int sw = fr >> 1;
    for (int kt = 0; kt < nk; ++kt) {
        asm volatile("s_waitcnt vmcnt(0)" ::: "memory");
        __syncthreads();
        char* cur = smem + (kt & 1) * 49152;
        if (kt + 1 < nk) {
            char* nx = smem + ((kt + 1) & 1) * 49152;
#pragma unroll
            for (int i = 0; i < 4; ++i) __builtin_amdgcn_global_load_lds((const unsigned*)(pa[i] + (kt + 1) * 64), (unsigned*)(nx + tid * 16 + i * 8192), 16, 0, 0);
#pragma unroll
            for (int i = 0; i < 2; ++i) __builtin_amdgcn_global_load_lds((const unsigned*)(pb[i] + (kt + 1) * 64), (unsigned*)(nx + 32768 + tid * 16 + i * 8192), 16, 0, 0);
        }
#pragma unroll
        for (int ks = 0; ks < 2; ++ks) {
            const int pc = ((ks * 4 + fq) ^ sw) * 16;
            bf16x8 At[2], Bf[8];
#pragma unroll
            for (int m = 0; m < 2; ++m) At[m] = *(const bf16x8*)(cur + (wid * 32 + m * 16 + fr) * 128 + pc);
#pragma unroll
            for (int n = 0; n < 8; ++n) Bf[n] = *(const bf16x8*)(cur + 32768 + (n * 16 + fr) * 128 + pc);
#pragma unroll
            for (int m = 0; m < 2; ++m)
#pragma unroll
                for (int n = 0; n < 8; ++n) acc[m][n] = MFMA16(Bf[n], At[m], acc[m][n]);
        }
    }
    __syncthreads();
}

__device__ __forceinline__ void transpose_tile(const float* W, int K, int N, bf16_t* Wt, int rs, int roff, int tile, float* scr  ) {
    const int tid = otid();
    const int nnb = N / 128, kb = tile / nnb, nb = tile % nnb, k0 = kb * 64, n0 = nb * 128;
#pragma unroll 4
    for (int i = 0; i < 16; ++i) { const int k = i * 4 + (tid >> 7), n = tid & 127; scr[k * 129 + n] = W[(size_t)(k0 + k) * N + n0 + n]; }
    __syncthreads();
#pragma unroll
    for (int i = 0; i < 2; ++i) {
        const int c = tid + i * 512, n = c >> 3, kc = c & 7;
        const float* s = scr + (kc * 8) * 129 + n;
        u32x4 o; o.x = pk2(s[0], s[129]); o.y = pk2(s[2 * 129], s[3 * 129]); o.z = pk2(s[4 * 129], s[5 * 129]); o.w = pk2(s[6 * 129], s[7 * 129]);
        const int nn = n0 + n, drow = (nn >> 4) * rs + (nn & 15) + roff;
        *(u32x4*)(Wt + (size_t)drow * K + k0 + kc * 8) = o;
    }
    __syncthreads();
}
__device__ __forceinline__ void rms_row_bf16(const float* xrow, const float* g, bf16_t* orow, int lane) {
    const f32x4* xr = (const f32x4*)xrow + lane; const f32x4* gr = (const f32x4*)g + lane;
    f32x4 v[4]; float s = 0.f;
#pragma unroll
    for (int j = 0; j < 4; ++j) { v[j] = xr[64 * j]; s += v[j].x * v[j].x + v[j].y * v[j].y + v[j].z * v[j].z + v[j].w * v[j].w; }
    const float rstd = rsqrtf(wave_sum(s) * (1.f / 1024.f) + 1e-6f);
    u32x2* o8 = (u32x2*)orow + lane;
#pragma unroll
    for (int j = 0; j < 4; ++j) { const f32x4 gg = gr[64 * j]; u32x2 o; o.x = pk2(v[j].x * rstd * gg.x, v[j].y * rstd * gg.y); o.y = pk2(v[j].z * rstd * gg.z, v[j].w * rstd * gg.w); o8[64 * j] = o; }
}
constexpr int P0_T_IN = 16 * 42, P0_T_A = 64, P0_T_B = 128, P0_T_L = 4 + 4 + 8;
constexpr int P0_TR = P0_T_IN + 4 * P0_T_A + 2 * P0_T_B + P0_T_L;
constexpr int P0_ROUT = 72, P0_NORM = T / 8, P0_MEM = NMEM / 8;
constexpr int P0_ITEMS = P0_TR + P0_ROUT + P0_NORM + P0_MEM + 1;
__device__ __forceinline__ void phase0(const P& p, int bid, int nb, char* smem) {
    const int tid = otid(), lane = tid & 63, wid = tid >> 6;
    char* ws = p.ws;
    for (int it = bid; it < P0_ITEMS; it += nb) {
        int r = it;
        if (r < P0_TR) {
            float* scr = (float*)smem;
            if (r < P0_T_IN) { transpose_tile(p.w_in, D, INCOLS, (bf16_t*)(ws + OFF_WIN), 16, 0, r, scr); continue; } r -= P0_T_IN;
            if (r < P0_T_A) { transpose_tile(p.w_o_rwkv, RW, D, (bf16_t*)(ws + OFF_WORW), 16, 0, r, scr); continue; } r -= P0_T_A;
            if (r < P0_T_A) { transpose_tile(p.w_o_moba, MW, D, (bf16_t*)(ws + OFF_WOMB), 16, 0, r, scr); continue; } r -= P0_T_A;
            if (r < P0_T_B) { transpose_tile(p.w_out, D, D, (bf16_t*)(ws + OFF_WOUT), 16, 0, r, scr); continue; } r -= P0_T_B;
            if (r < P0_T_A) { transpose_tile(p.w_q_x, D, 512, (bf16_t*)(ws + OFF_WQ), 16, 0, r, scr); continue; } r -= P0_T_A;
            if (r < P0_T_B) { transpose_tile(p.w_kv_x, D, D, (bf16_t*)(ws + OFF_WKV), 16, 0, r, scr); continue; } r -= P0_T_B;
            if (r < P0_T_A) { transpose_tile(p.w_o_x, 512, D, (bf16_t*)(ws + OFF_WOX), 16, 0, r, scr); continue; } r -= P0_T_A;
            if (r < 4) { transpose_tile(p.decay_up, 64, 512, (bf16_t*)(ws + OFF_LORA_D), 16, 0, r, scr); continue; } r -= 4;
            if (r < 4) { transpose_tile(p.iclr_up, 64, 512, (bf16_t*)(ws + OFF_LORA_I), 16, 0, r, scr); continue; } r -= 4;
            transpose_tile(p.gate_up, 128, 512, (bf16_t*)(ws + OFF_LORA_G), 16, 0, r, scr); continue;
        }
        r -= P0_TR;
        if (r < P0_ROUT) {
            const int e = r * 512 + tid, o = e >> 10, k = e & 1023;
            float* rt = (float*)(ws + OFF_ROUT);
            rt[e] = (o < 32) ? p.w_router_expert[k * 32 + o] : p.w_router_group[k * 4 + (o - 32)];
            continue;
        }
        r -= P0_ROUT;
        if (r < P0_NORM) { const int row = r * 8 + wid; rms_row_bf16(p.x + (size_t)row * D, p.norm_mix, (bf16_t*)(ws + OFF_XN) + (size_t)row * D, lane); continue; }
        r -= P0_NORM;
        if (r < P0_MEM) { const int row = r * 8 + wid; rms_row_bf16(p.mem + (size_t)row * D, p.mem_norm, (bf16_t*)(ws + OFF_MEMN) + (size_t)row * D, lane); continue; }
        if (tid < 64) ((int*)(ws + OFF_CTL + CTL_CNT))[tid] = 0;
        for (int i = tid; i < 1024; i += NT) ((int*)(ws + OFF_CTL + CTL_MCNT))[i] = 0;
    }
}

struct EpiU {
    static constexpr bool PERM = true;
    char* ws;
    __device__ __forceinline__ void operator()(const f32x4 (&acc)[2][2][4][2], const pg8::Unit& u, int wr, int wc, int fr, int fq) const {
        const int colt = u.pn * 256;
        bf16_t* dst; int ld, cb; bool sg = false;
        if (colt < RCOLS) { dst = (bf16_t*)(ws + OFF_UR); ld = RCOLS; cb = colt; }
        else if (colt < RCOLS + MCOLS) { dst = (bf16_t*)(ws + OFF_UM); ld = UMC; cb = colt - RCOLS; }
        else { dst = (bf16_t*)(ws + OFF_UG); ld = GCOLS; cb = colt - RCOLS - MCOLS; sg = true; }
        const int row0 = u.pm * 256 + wr * 64 + fr, col0 = cb + wc * 32 + 8 * fq;
#pragma unroll
        for (int ai = 0; ai < 2; ++ai)
#pragma unroll
            for (int m = 0; m < 4; ++m) {
                bf16_t* rowp = dst + (size_t)(row0 + ai * 128 + m * 16) * ld + col0;
#pragma unroll
                for (int bj = 0; bj < 2; ++bj) {
                    f32x4 v0 = acc[ai][bj][m][0], v1 = acc[ai][bj][m][1];
                    if (sg) { v0.x = sigm(v0.x); v0.y = sigm(v0.y); v0.z = sigm(v0.z); v0.w = sigm(v0.w); v1.x = sigm(v1.x); v1.y = sigm(v1.y); v1.z = sigm(v1.z); v1.w = sigm(v1.w); }
                    u32x4 w; w.x = cvt_pk(v0.x, v0.y); w.y = cvt_pk(v0.z, v0.w); w.z = cvt_pk(v1.x, v1.y); w.w = cvt_pk(v1.z, v1.w);
                    *(u32x4*)(rowp + bj * 128) = w;
                }
            }
    }
};
__device__ __forceinline__ void phase1(const P& p, int bid, int nb, char* smem) {
    pg8::StaticOrder S; S.init(T, INCOLS, nb, bid);
    EpiU E{p.ws};
    pg8::gemm_phase<EpiU, pg8::StaticOrder, true>((LAS unsigned char*)smem, (const bf16_t*)(p.ws + OFF_XN), (const bf16_t*)(p.ws + OFF_WIN), D, S, E);
}

__device__ __forceinline__ void phase_kmean(const P& p, int bid, int nb, char* smem) {
    const int tid = otid();
    const bf16_t* um = (const bf16_t*)(p.ws + OFF_UM);
    bf16_t* kmb = (bf16_t*)(p.ws + OFF_CTL + CTL_KMB);
    float* red = (float*)smem;
    for (int it = bid; it < 64 * 8; it += nb) {
        const int blk = it >> 3, h = it & 7, q = tid >> 6, d = tid & 63;
        float s = 0.f;
        for (int k = 0; k < 32; ++k) s += bf2f(um[(size_t)(blk * 256 + q * 32 + k) * UMC + 512 + h * 64 + d]);
        red[tid] = s;
        __syncthreads();
        if (tid < 64) { float a = 0.f;
#pragma unroll
            for (int j = 0; j < 8; ++j) a += red[tid + 64 * j];
            kmb[(blk * 8 + h) * 64 + tid] = (bf16_t)f2bf(a * (1.f / 256.f)); }
        __syncthreads();
    }
}
__device__ __forceinline__ void phase_vtrans(const P& p, int bid, int nb, char* smem) {
    const int tid = otid();
    const bf16_t* um = (const bf16_t*)(p.ws + OFF_UM); bf16_t* vt = (bf16_t*)(p.ws + OFF_VT);
    for (int it = bid; it < 256 * 4; it += nb) {
        const int tt = it >> 2, cq = it & 3, t0 = tt * 64, c0 = cq * 128;
#pragma unroll
        for (int i = 0; i < 2; ++i) { const int c = tid + i * 512, r = c >> 4, ch = c & 15; *(u32x4*)(smem + r * 272 + ch * 16) = *(const u32x4*)(um + (size_t)(t0 + r) * UMC + 1024 + c0 + ch * 8); }
        __syncthreads();
#pragma unroll
        for (int i = 0; i < 2; ++i) {
            const int c = tid + i * 512, col = c >> 3, tc = c & 7;
            unsigned short e[8];
#pragma unroll
            for (int j = 0; j < 8; ++j) e[j] = *(const unsigned short*)(smem + (tc * 8 + j) * 272 + col * 2);
            u32x4 o; o.x = e[0] | ((unsigned)e[1] << 16); o.y = e[2] | ((unsigned)e[3] << 16); o.z = e[4] | ((unsigned)e[5] << 16); o.w = e[6] | ((unsigned)e[7] << 16);
            *(u32x4*)(vt + (size_t)(c0 + col) * T + t0 + tc * 8) = o;
        }
        __syncthreads();
    }
}

constexpr int SLOT = 9216, ROWB = 144, LIN_ROWB = 528;
constexpr int L_WL = 0 * SLOT, L_AL = 1 * SLOT, L_LIN = 2 * SLOT, L_AT = 2 * SLOT, L_BT = 3 * SLOT, L_KT = 4 * SLOT, L_RT = 5 * SLOT, L_VT = 6 * SLOT, L_ATT = 7 * SLOT;
constexpr int L_AAB = L_AT, L_AKV = L_BT, L_BBT = L_WL, L_KBT = L_AL, L_TD = L_KT;
constexpr int L_WTOT = 8 * SLOT, L_WC = L_WTOT + 1024, L_PAR = L_WC + 256, RW_LDS = L_PAR + 2048;

typedef float f32x2 __attribute__((ext_vector_type(2)));
template <int TT> struct SolveRow {
    static __device__ __forceinline__ void run(f32x2 (&x)[32], const char* Lb, const u32x4 (&lcur)[8]) {
        u32x4 lnext[8];
        constexpr int NCN = (TT + 1 < 64) ? (TT / 8 + 1) : 0;
#pragma unroll
        for (int c8 = 0; c8 < 8; ++c8) if (c8 < NCN) lnext[c8] = *(const u32x4*)(Lb + (TT + 1) * 144 + c8 * 16); else lnext[c8] = (u32x4){0u, 0u, 0u, 0u};
        f32x2 a0 = {0.f, 0.f}, a1 = {0.f, 0.f}, a2 = {0.f, 0.f}, a3 = {0.f, 0.f};
#pragma unroll
        for (int c8 = 0; c8 <= (TT - 1) / 8; ++c8) {
            const u32x4 lv = lcur[c8];
            f32x2 l0, l1, l2, l3;
            l0.x = __uint_as_float(lv.x << 16); l0.y = __uint_as_float(lv.x & 0xffff0000u);
            l1.x = __uint_as_float(lv.y << 16); l1.y = __uint_as_float(lv.y & 0xffff0000u);
            l2.x = __uint_as_float(lv.z << 16); l2.y = __uint_as_float(lv.z & 0xffff0000u);
            l3.x = __uint_as_float(lv.w << 16); l3.y = __uint_as_float(lv.w & 0xffff0000u);
            a0 = l0 * x[c8 * 4 + 0] + a0; a1 = l1 * x[c8 * 4 + 1] + a1; a2 = l2 * x[c8 * 4 + 2] + a2; a3 = l3 * x[c8 * 4 + 3] + a3;
        }
        a0 = (a0 + a1) + (a2 + a3);
        const float r = a0.x + a0.y;
        if (TT & 1) x[TT / 2].y += r; else x[TT / 2].x += r;
        asm volatile("" : "+v"(x[TT / 2]) :: "memory");
        SolveRow<TT + 1>::run(x, Lb, lnext);
    }
};
template <> struct SolveRow<64> { static __device__ __forceinline__ void run(f32x2 (&)[32], const char*, const u32x4 (&)[8]) {} };

__device__ __forceinline__ void load_shift16(const bf16_t* ur, int row, int col, const float* mu, float* out) {
    const u32x4* cp = (const u32x4*)(ur + (size_t)row * RCOLS + col);
    const u32x4 c0 = cp[0], c1 = cp[1];
    u32x4 p0 = {0u, 0u, 0u, 0u}, p1 = {0u, 0u, 0u, 0u};
    if (row > 0) { const u32x4* pp = (const u32x4*)(ur + (size_t)(row - 1) * RCOLS + col); p0 = pp[0]; p1 = pp[1]; }
    float cf[16], pf[16];
    unpack8(c0, cf); unpack8(c1, cf + 8); unpack8(p0, pf); unpack8(p1, pf + 8);
#pragma unroll
    for (int e = 0; e < 16; ++e) out[e] = cf[e] + mu[col + e] * (pf[e] - cf[e]);
}

__device__ __forceinline__ void phase_rw_chunk(const P& p, int bid, int nb, char* smem0) {
    char* ws = p.ws;
    const bf16_t* ur = (const bf16_t*)(ws + OFF_UR);
    bf16_t* G = (bf16_t*)(ws + OFF_OA); bf16_t* BON = (bf16_t*)(ws + OFF_BON); bf16_t* RH = (bf16_t*)(ws + OFF_RH);
    float* YL = p.out; f32x4* NF = (f32x4*)(p.out + (size_t)T * 512);
    u32x4* MF = (u32x4*)(ws + OFF_MF);
    int hpar = -1;
    for (int itb = bid * 2; itb < 2048; itb += nb * 2) {
        const int tid5 = otid();
        const int half = __builtin_amdgcn_readfirstlane(tid5 >> 8), tid = tid5 & 255;
        char* smem = smem0 + half * RW_LDS;
        float* wtot = (float*)(smem + L_WTOT); float* WCs = (float*)(smem + L_WC);
        const int pr = itb >> 1, c = (pr % nb) + nb * (pr / (4 * nb)), h = ((pr / nb) & 3) * 2 + half;
        const int lane = tid & 63, w = __builtin_amdgcn_readfirstlane(tid >> 6), fr = lane & 15, fq = lane >> 4;
        if (h != hpar) {
            float* par = (float*)(smem + L_PAR);
            if (tid < 64) {
                const int hj = h * 64 + tid;
                par[tid] = p.decay_w0[hj]; par[64 + tid] = p.iclr_a0[hj]; par[128 + tid] = p.k_k[hj]; par[192 + tid] = p.k_a[hj]; par[256 + tid] = p.r_k[hj];
                par[320 + tid] = p.tshift_mu[hj]; par[384 + tid] = p.tshift_mu[512 + hj]; par[448 + tid] = p.tshift_mu[1024 + hj];
            }
            hpar = h;
        }
        u32x4 rawc[3][2], rawp[3][2];
        {
            const int row = c * 64 + (tid >> 2), hj0 = h * 64 + (tid & 3) * 16;
#pragma unroll
            for (int q3 = 0; q3 < 3; ++q3) {
                const u32x4* cp = (const u32x4*)(ur + (size_t)row * RCOLS + q3 * 512 + hj0);
                rawc[q3][0] = cp[0]; rawc[q3][1] = cp[1];
                rawp[q3][0] = (u32x4){0u, 0u, 0u, 0u}; rawp[q3][1] = rawp[q3][0];
                if (row > 0) { const u32x4* pp = (const u32x4*)(ur + (size_t)(row - 1) * RCOLS + q3 * 512 + hj0); rawp[q3][0] = pp[0]; rawp[q3][1] = pp[1]; }
            }
        }
        {
            const int cc = tid & 31, col = 1536 + cc * 8, t0 = tid >> 5;
            u32x4 cur[8], prv[8];
#pragma unroll
            for (int i = 0; i < 8; ++i) {
                const int row = c * 64 + t0 + 8 * i;
                cur[i] = *(const u32x4*)(ur + (size_t)row * RCOLS + col);
                prv[i] = (u32x4){0u, 0u, 0u, 0u};
                if (row > 0) prv[i] = *(const u32x4*)(ur + (size_t)(row - 1) * RCOLS + col);
            }
            const float nsc = cc < 8 ? 2.f : 1.f, na = cc < 8 ? 2.f : 1.f, nbb = cc < 8 ? -1.f : 0.f;
            const f32x4 mu0 = *(const f32x4*)(p.tshift_mu + col), mu1 = *(const f32x4*)(p.tshift_mu + col + 4);
            const float mu[8] = {mu0.x, mu0.y, mu0.z, mu0.w, mu1.x, mu1.y, mu1.z, mu1.w};
#pragma unroll
            for (int i = 0; i < 8; ++i) {
                float cf[8], pf[8], xs[8];
                unpack8(cur[i], cf); unpack8(prv[i], pf);
#pragma unroll
                for (int e = 0; e < 8; ++e) {
                    const float x = cf[e] + mu[e] * (pf[e] - cf[e]);
                    const float y = sigm(nsc * x);
                    xs[e] = (cc >= 8 && cc < 16) ? x : na * y + nbb;
                }
                u32x4 o; o.x = cvt_pk(xs[0], xs[1]); o.y = cvt_pk(xs[2], xs[3]); o.z = cvt_pk(xs[4], xs[5]); o.w = cvt_pk(xs[6], xs[7]);
                *(u32x4*)(smem + L_LIN + (t0 + 8 * i) * LIN_ROWB + cc * 16) = o;
            }
        }
        __syncthreads();
        {
            const bf16_t* dT = (const bf16_t*)(ws + OFF_LORA_D) + (size_t)(h * 64 + w * 16 + fr) * 64 + fq * 8;
            const bf16_t* iT = (const bf16_t*)(ws + OFF_LORA_I) + (size_t)(h * 64 + w * 16 + fr) * 64 + fq * 8;
            const bf16_t* gT = (const bf16_t*)(ws + OFF_LORA_G) + (size_t)(h * 64 + w * 16 + fr) * 128 + fq * 8;
            bf16x8 wd[2], wi[2], wg[4];
#pragma unroll
            for (int ks = 0; ks < 2; ++ks) { wd[ks] = *(const bf16x8*)(dT + ks * 32); wi[ks] = *(const bf16x8*)(iT + ks * 32); }
#pragma unroll
            for (int ks = 0; ks < 4; ++ks) wg[ks] = *(const bf16x8*)(gT + ks * 32);
#pragma unroll
            for (int tt = 0; tt < 4; ++tt) {
                const char* lrow = smem + L_LIN + (tt * 16 + fr) * LIN_ROWB + fq * 16;
                f32x4 aw = {0.f, 0.f, 0.f, 0.f}, aa = aw, ag = aw;
#pragma unroll
                for (int ks = 0; ks < 2; ++ks) {
                    aw = MFMA16(wd[ks], *(const bf16x8*)(lrow + ks * 64), aw);
                    aa = MFMA16(wi[ks], *(const bf16x8*)(lrow + 128 + ks * 64), aa);
                }
#pragma unroll
                for (int ks = 0; ks < 4; ++ks) ag = MFMA16(wg[ks], *(const bf16x8*)(lrow + 256 + ks * 64), ag);
                *(u32x2*)(smem + L_WL + (tt * 16 + fr) * ROWB + (w * 16 + fq * 4) * 2) = pack4(aw);
                *(u32x2*)(smem + L_AL + (tt * 16 + fr) * ROWB + (w * 16 + fq * 4) * 2) = pack4(aa);
                *(u32x2*)(G + (size_t)(c * 64 + tt * 16 + fr) * 512 + h * 64 + w * 16 + fq * 4) = pack4(ag);
            }
        }
        __syncthreads();
        {
            const int t = tid >> 2, jq = tid & 3, j0 = jq * 16, hj0 = h * 64 + j0, row = c * 64 + t;
            const float* par = (const float*)(smem + L_PAR) + j0;
            float ai[16], kk[16], k2[16], rr[16];
            {
                float al[16];
                const u32x4* ap = (const u32x4*)(smem + L_AL + t * ROWB + j0 * 2);
                unpack8(ap[0], al); unpack8(ap[1], al + 8);
#pragma unroll
                for (int e = 0; e < 16; ++e) ai[e] = sigm(par[64 + e] + al[e]);
            }
            float ss = 0.f, rk = 0.f;
            {
                float cf[16], pf[16];
                unpack8(rawc[1][0], cf); unpack8(rawc[1][1], cf + 8); unpack8(rawp[1][0], pf); unpack8(rawp[1][1], pf + 8);
#pragma unroll
                for (int e = 0; e < 16; ++e) { const float k = cf[e] + par[384 + e] * (pf[e] - cf[e]); kk[e] = k * par[128 + e]; ss += kk[e] * kk[e]; k2[e] = k * (1.f + (ai[e] - 1.f) * par[192 + e]); }
            }
            ss += __shfl_xor(ss, 1); ss += __shfl_xor(ss, 2);
            const float inv = rsqrtf(ss + 1e-12f);
            {
                float cf[16], pf[16];
                unpack8(rawc[0][0], cf); unpack8(rawc[0][1], cf + 8); unpack8(rawp[0][0], pf); unpack8(rawp[0][1], pf + 8);
#pragma unroll
                for (int e = 0; e < 16; ++e) { rr[e] = cf[e] + par[320 + e] * (pf[e] - cf[e]); rk += rr[e] * k2[e] * par[256 + e]; }
            }
            rk += __shfl_xor(rk, 1); rk += __shfl_xor(rk, 2);
            {
                float cf[16], pf[16], v[16];
                unpack8(rawc[2][0], cf); unpack8(rawc[2][1], cf + 8); unpack8(rawp[2][0], pf); unpack8(rawp[2][1], pf + 8);
#pragma unroll
                for (int e = 0; e < 16; ++e) { v[e] = cf[e] + par[448 + e] * (pf[e] - cf[e]); *(bf16_t*)(smem + L_VT + (j0 + e) * ROWB + t * 2) = (bf16_t)f2bf(v[e]); }
#pragma unroll
                for (int hh = 0; hh < 2; ++hh) {
                    u32x4 o; o.x = cvt_pk(rk * v[hh * 8], rk * v[hh * 8 + 1]); o.y = cvt_pk(rk * v[hh * 8 + 2], rk * v[hh * 8 + 3]); o.z = cvt_pk(rk * v[hh * 8 + 4], rk * v[hh * 8 + 5]); o.w = cvt_pk(rk * v[hh * 8 + 6], rk * v[hh * 8 + 7]);
                    *(u32x4*)(BON + (size_t)row * 512 + hj0 + hh * 8) = o;
                }
            }
            float lw[16], cum[16];
            {
                float wl[16];
                const u32x4* wp = (const u32x4*)(smem + L_WL + t * ROWB + j0 * 2);
                unpack8(wp[0], wl); unpack8(wp[1], wl + 8);
#pragma unroll
                for (int e = 0; e < 16; ++e) { const float wv = par[e] + wl[e]; lw[e] = -0.6065306597126334f * sigm(wv); }
            }
#pragma unroll
            for (int e = 0; e < 16; ++e) {
                float x = lw[e];
#pragma unroll
                for (int d = 4; d < 64; d <<= 1) { const float y = __shfl_up(x, d); if (lane >= d) x += y; }
                cum[e] = x;
            }
            if ((lane >> 2) == 15) {
#pragma unroll
                for (int e = 0; e < 16; ++e) wtot[w * 64 + j0 + e] = cum[e];
            }
            __syncthreads();
#pragma unroll
            for (int hh = 0; hh < 2; ++hh) {
                float at[8], bt[8], kt[8], rt[8];
#pragma unroll
                for (int e8 = 0; e8 < 8; ++e8) {
                    const int e = hh * 8 + e8;
                    const float t0 = wtot[j0 + e], t1 = wtot[64 + j0 + e], t2 = wtot[128 + j0 + e], t3 = wtot[192 + j0 + e];
                    const float cm = cum[e] + ((w > 0 ? t0 : 0.f) + (w > 1 ? t1 : 0.f) + (w > 2 ? t2 : 0.f));
                    const float tt = (t0 + t1) + (t2 + t3);
                    if (t == 63) WCs[j0 + e] = __expf(tt);
                    const float kn = kk[e] * inv;
                    const float E = __expf(cm), Ei = __expf(-cm), Ex = __expf(cm - lw[e]), Ec = __expf(tt - cm);
                    const float b = kn * ai[e];
                    at[e8] = -kn * Ex; bt[e8] = b * Ei; kt[e8] = k2[e] * Ei; rt[e8] = rr[e] * E;
                    *(bf16_t*)(smem + L_BBT + (j0 + e) * ROWB + t * 2) = (bf16_t)f2bf(b * Ec);
                    *(bf16_t*)(smem + L_KBT + (j0 + e) * ROWB + t * 2) = (bf16_t)f2bf(k2[e] * Ec);
                    *(bf16_t*)(smem + L_ATT + (j0 + e) * ROWB + t * 2) = (bf16_t)f2bf(at[e8]);
                }
                u32x4 o;
                o.x = cvt_pk(at[0], at[1]); o.y = cvt_pk(at[2], at[3]); o.z = cvt_pk(at[4], at[5]); o.w = cvt_pk(at[6], at[7]);
                *(u32x4*)(smem + L_AT + t * ROWB + (j0 + hh * 8) * 2) = o;
                o.x = cvt_pk(bt[0], bt[1]); o.y = cvt_pk(bt[2], bt[3]); o.z = cvt_pk(bt[4], bt[5]); o.w = cvt_pk(bt[6], bt[7]);
                *(u32x4*)(smem + L_BT + t * ROWB + (j0 + hh * 8) * 2) = o;
                o.x = cvt_pk(kt[0], kt[1]); o.y = cvt_pk(kt[2], kt[3]); o.z = cvt_pk(kt[4], kt[5]); o.w = cvt_pk(kt[6], kt[7]);
                *(u32x4*)(smem + L_KT + t * ROWB + (j0 + hh * 8) * 2) = o;
                o.x = cvt_pk(rt[0], rt[1]); o.y = cvt_pk(rt[2], rt[3]); o.z = cvt_pk(rt[4], rt[5]); o.w = cvt_pk(rt[6], rt[7]);
                *(u32x4*)(smem + L_RT + t * ROWB + (j0 + hh * 8) * 2) = o;
            }
        }
        __syncthreads();
        bf16x8 frb[2], frk[2];
        {
            const int tid2 = otid() & 255, lane = tid2 & 63, fr = lane & 15, fq = lane >> 4;
            bf16x8 xa[2], xr[2];
#pragma unroll
            for (int ks = 0; ks < 2; ++ks) {
                xa[ks] = *(const bf16x8*)(smem + L_AT + (w * 16 + fr) * ROWB + (ks * 32 + fq * 8) * 2);
                xr[ks] = *(const bf16x8*)(smem + L_RT + (w * 16 + fr) * ROWB + (ks * 32 + fq * 8) * 2);
            }
            f32x4 aab[4], aak[4], arb[4], ark[4];
            const int tq = w * 16 + fr;
#pragma unroll
            for (int n = 0; n < 4; ++n) {
                f32x4 dab = {0.f, 0.f, 0.f, 0.f}, dak = dab, drb = dab, drk = dab;
                if (n <= w) {
#pragma unroll
                    for (int ks = 0; ks < 2; ++ks) {
                        const bf16x8 yb = *(const bf16x8*)(smem + L_BT + (n * 16 + fr) * ROWB + (ks * 32 + fq * 8) * 2);
                        const bf16x8 yk = *(const bf16x8*)(smem + L_KT + (n * 16 + fr) * ROWB + (ks * 32 + fq * 8) * 2);
                        dab = MFMA16(yb, xa[ks], dab); dak = MFMA16(yk, xa[ks], dak); drb = MFMA16(yb, xr[ks], drb); drk = MFMA16(yk, xr[ks], drk);
                    }
#pragma unroll
                    for (int jj = 0; jj < 4; ++jj) {
                        const int sq = n * 16 + fq * 4 + jj;
                        if (!(sq < tq)) { dab[jj] = 0.f; dak[jj] = 0.f; }
                        if (!(sq <= tq)) { drb[jj] = 0.f; drk[jj] = 0.f; }
                    }
                }
                aab[n] = dab; aak[n] = dak; arb[n] = drb; ark[n] = drk;
            }
            __syncthreads();
#pragma unroll
            for (int n = 0; n < 4; ++n) *(u32x2*)(smem + L_AAB + (w * 16 + fr) * ROWB + (n * 16 + fq * 4) * 2) = pack4(aab[n]);
            *(u32x4*)(smem + L_TD + (w * 16 + (lane >> 2)) * ROWB + (lane & 3) * 32) = (u32x4){0u, 0u, 0u, 0u};
            *(u32x4*)(smem + L_TD + (w * 16 + (lane >> 2)) * ROWB + (lane & 3) * 32 + 16) = (u32x4){0u, 0u, 0u, 0u};
            asm volatile("s_waitcnt lgkmcnt(0)" ::: "memory"); __builtin_amdgcn_wave_barrier();
            {
                const int cc = lane & 15;
                float Tc[16];
#pragma unroll
                for (int r = 0; r < 16; ++r) {
                    float lf[16];
                    const u32x4* lp = (const u32x4*)(smem + L_AAB + (w * 16 + r) * ROWB + w * 32);
                    unpack8(lp[0], lf); unpack8(lp[1], lf + 8);
                    float a = (r == cc) ? 1.f : 0.f;
#pragma unroll
                    for (int s2 = 0; s2 < 16; ++s2) if (s2 < r) a += lf[s2] * Tc[s2];
                    Tc[r] = a;
                }
                if (lane < 16) {
#pragma unroll
                    for (int r = 0; r < 16; ++r) *(bf16_t*)(smem + L_TD + (w * 16 + r) * ROWB + (w * 16 + cc) * 2) = (bf16_t)f2bf(Tc[r]);
                }
            }
            bf16x8 fak[2];
#pragma unroll
            for (int ks = 0; ks < 2; ++ks) { fak[ks] = pack8(aak[2 * ks], aak[2 * ks + 1]); frb[ks] = pack8(arb[2 * ks], arb[2 * ks + 1]); frk[ks] = pack8(ark[2 * ks], ark[2 * ks + 1]); }
#pragma unroll
            for (int vt = 0; vt < 4; ++vt) {
                f32x4 acc = {0.f, 0.f, 0.f, 0.f};
#pragma unroll
                for (int ks = 0; ks < 2; ++ks) acc = MFMA16(fak[ks], ldperm(smem + L_VT + (vt * 16 + fr) * ROWB, ks, fq), acc);
                *(u32x2*)(smem + L_AKV + (vt * 16 + fr) * ROWB + (w * 16 + fq * 4) * 2) = pack4(acc);
            }
        }
        __syncthreads();
        {
            const int tid3 = otid() & 255, lane = tid3 & 63, fr = lane & 15, fq = lane >> 4;
            char* xb = smem + (w < 2 ? L_ATT : L_AKV) + (w & 1) * 32 * ROWB;
#pragma unroll
            for (int i = 0; i < 4; ++i) {
                bf16x8 la[2];
#pragma unroll
                for (int ks = 0; ks < 2; ++ks) {
                    u32x4 v = *(const u32x4*)(smem + L_AAB + (16 * i + fr) * ROWB + (ks * 32 + fq * 8) * 2);
                    if (2 * ks + (fq >> 1) >= i) v = (u32x4){0u, 0u, 0u, 0u};
                    la[ks] = __builtin_bit_cast(bf16x8, v);
                }
                const bf16x8 ta = *(const bf16x8*)(smem + L_TD + (16 * i + fr) * ROWB + ((i >> 1) * 32 + fq * 8) * 2);
#pragma unroll
                for (int nt = 0; nt < 2; ++nt) {
                    char* rowp = xb + (nt * 16 + fr) * ROWB;
                    f32x4 y = unpack4(*(const u32x2*)(rowp + (16 * i + fq * 4) * 2));
                    if (i >= 1) y = MFMA16(la[0], *(const bf16x8*)(rowp + (fq * 8) * 2), y);
                    if (i == 3) y = MFMA16(la[1], *(const bf16x8*)(rowp + (32 + fq * 8) * 2), y);
                    *(u32x2*)(rowp + (16 * i + fq * 4) * 2) = pack4(y);
                }
                asm volatile("s_waitcnt lgkmcnt(0)" ::: "memory"); __builtin_amdgcn_wave_barrier();
#pragma unroll
                for (int nt = 0; nt < 2; ++nt) {
                    char* rowp = xb + (nt * 16 + fr) * ROWB;
                    const f32x4 x = MFMA16(ta, *(const bf16x8*)(rowp + ((i >> 1) * 32 + fq * 8) * 2), ((f32x4){0.f, 0.f, 0.f, 0.f}));
                    asm volatile("s_waitcnt lgkmcnt(0)" ::: "memory");
                    *(u32x2*)(rowp + (16 * i + fq * 4) * 2) = pack4(x);
                }
                asm volatile("s_waitcnt lgkmcnt(0)" ::: "memory"); __builtin_amdgcn_wave_barrier();
            }
        }
        __syncthreads();
        {
            const int tid4 = otid() & 255, lane = tid4 & 63, fr = lane & 15, fq = lane >> 4;
            const int trow = c * 64 + w * 16 + fr;
#pragma unroll
            for (int kt = 0; kt < 4; ++kt) {
                f32x4 acc = {0.f, 0.f, 0.f, 0.f};
#pragma unroll
                for (int ks = 0; ks < 2; ++ks) acc = MFMA16(ldperm(smem + L_ATT + (kt * 16 + fr) * ROWB, ks, fq), frb[ks], acc);
                const u32x2 rr = *(const u32x2*)(smem + L_RT + (w * 16 + fr) * ROWB + (kt * 16 + fq * 4) * 2);
                acc.x += __uint_as_float(rr.x << 16); acc.y += __uint_as_float(rr.x & 0xffff0000u); acc.z += __uint_as_float(rr.y << 16); acc.w += __uint_as_float(rr.y & 0xffff0000u);
                *(u32x2*)(RH + (size_t)trow * 512 + h * 64 + kt * 16 + fq * 4) = pack4(acc);
            }
#pragma unroll
            for (int vt = 0; vt < 4; ++vt) {
                f32x4 acc = {0.f, 0.f, 0.f, 0.f};
#pragma unroll
                for (int ks = 0; ks < 2; ++ks) {
                    acc = MFMA16(ldperm(smem + L_AKV + (vt * 16 + fr) * ROWB, ks, fq), frb[ks], acc);
                    acc = MFMA16(ldperm(smem + L_VT + (vt * 16 + fr) * ROWB, ks, fq), frk[ks], acc);
                }
                *(f32x4*)(YL + (size_t)trow * 512 + h * 64 + vt * 16 + fq * 4) = acc;
            }
            bf16x8 xb[2], xk[2];
#pragma unroll
            for (int ks = 0; ks < 2; ++ks) {
                xb[ks] = *(const bf16x8*)(smem + L_BBT + (w * 16 + fr) * ROWB + (ks * 32 + fq * 8) * 2);
                xk[ks] = *(const bf16x8*)(smem + L_KBT + (w * 16 + fr) * ROWB + (ks * 32 + fq * 8) * 2);
            }
            f32x4 mt[4];
            const float wc = WCs[w * 16 + fr];
#pragma unroll
            for (int n = 0; n < 4; ++n) {
                f32x4 acc = {0.f, 0.f, 0.f, 0.f};
#pragma unroll
                for (int ks = 0; ks < 2; ++ks) acc = MFMA16(*(const bf16x8*)(smem + L_ATT + (n * 16 + fr) * ROWB + (ks * 32 + fq * 8) * 2), xb[ks], acc);
#pragma unroll
                for (int jj = 0; jj < 4; ++jj) if (n * 16 + fq * 4 + jj == w * 16 + fr) acc[jj] += wc;
                mt[n] = acc;
            }
#pragma unroll
            for (int ks = 0; ks < 2; ++ks) MF[((size_t)((c * 8 + h) * 4 + w) * 2 + ks) * 64 + lane] = __builtin_bit_cast(u32x4, pack8(mt[2 * ks], mt[2 * ks + 1]));
#pragma unroll
            for (int vs = 0; vs < 4; ++vs) {
                f32x4 acc = {0.f, 0.f, 0.f, 0.f};
#pragma unroll
                for (int ks = 0; ks < 2; ++ks) {
                    acc = MFMA16(xb[ks], *(const bf16x8*)(smem + L_AKV + (vs * 16 + fr) * ROWB + (ks * 32 + fq * 8) * 2), acc);
                    acc = MFMA16(xk[ks], *(const bf16x8*)(smem + L_VT + (vs * 16 + fr) * ROWB + (ks * 32 + fq * 8) * 2), acc);
                }
                NF[((size_t)((c * 8 + h) * 4 + w) * 4 + vs) * 64 + lane] = acc;
            }
        }
        __syncthreads();
    }
}

constexpr int SC_D = 8, SC_R = SC_D + 2, SC_SLOT = 12288;
__device__ __forceinline__ void rw_scan(const P& p, int chain, char* smem) {
    const int tid = otid(), lane = tid & 63, w = __builtin_amdgcn_readfirstlane(tid >> 6), h = chain >> 2, vs = chain & 3;
    const char* MF = (const char*)(p.ws + OFF_MF); const char* NF = (const char*)(p.out + (size_t)T * 512);
    u32x4* SF = (u32x4*)(p.ws + OFF_SF);
    const int q0 = (w >= 1 && w <= 5) ? 2 * (w - 1) : (w == 6 ? 10 : 11), npc = (w >= 1 && w <= 5) ? 2 : 1;
    auto issue = [&](int c) {
        char* slot = smem + (c % SC_R) * SC_SLOT;
#pragma unroll
        for (int j = 0; j < 2; ++j) {
            if (j < npc) {
                const int q = q0 + j;
                const char* src = (q < 8) ? MF + ((size_t)((c * 8 + h) * 8 + q) * 64 + lane) * 16
                                          : NF + ((size_t)(((c * 8 + h) * 4 + (q - 8)) * 4 + vs) * 64 + lane) * 16;
                __builtin_amdgcn_global_load_lds((const unsigned*)src, (unsigned*)(slot + q * 1024 + lane * 16), 16, 0, 0);
            }
        }
    };
    if (w != 0) {
#pragma unroll 1
        for (int c = 0; c < SC_D; ++c) issue(c);
    }
    u32x4 st0 = {0u, 0u, 0u, 0u}, st1 = st0;
    for (int c = 0; c < 255; ++c) {
        if (w != 0) {
            if (c + SC_D < 255) issue(c + SC_D);
            else { issue(254); }
            if (npc == 2) asm volatile("s_waitcnt vmcnt(16)" ::: "memory"); else asm volatile("s_waitcnt vmcnt(8)" ::: "memory");
        }
        __builtin_amdgcn_s_barrier();
        if (w == 0) {
            SF[((size_t)((c * 8 + h) * 4 + vs) * 2 + 0) * 64 + lane] = st0;
            SF[((size_t)((c * 8 + h) * 4 + vs) * 2 + 1) * 64 + lane] = st1;
            const char* slot = smem + (c % SC_R) * SC_SLOT;
            f32x4 acc[4];
#pragma unroll
            for (int i = 0; i < 4; ++i) {
                acc[i] = *(const f32x4*)(slot + (8 + i) * 1024 + lane * 16);
                acc[i] = MFMA16(*(const bf16x8*)(slot + (2 * i) * 1024 + lane * 16), __builtin_bit_cast(bf16x8, st0), acc[i]);
                acc[i] = MFMA16(*(const bf16x8*)(slot + (2 * i + 1) * 1024 + lane * 16), __builtin_bit_cast(bf16x8, st1), acc[i]);
            }
            st0 = __builtin_bit_cast(u32x4, pack8(acc[0], acc[1])); st1 = __builtin_bit_cast(u32x4, pack8(acc[2], acc[3]));
        }
    }
    if (w == 0) {
        SF[((size_t)((255 * 8 + h) * 4 + vs) * 2 + 0) * 64 + lane] = st0;
        SF[((size_t)((255 * 8 + h) * 4 + vs) * 2 + 1) * 64 + lane] = st1;
    }
    asm volatile("s_waitcnt vmcnt(0)" ::: "memory");
    __builtin_amdgcn_s_barrier();
}

__device__ __forceinline__ void phase_rw_out(const P& p, int bid, int nb) {
    const int tid = otid(), lane = tid & 63, w8 = tid >> 6, w = w8 & 3, fr = lane & 15, fq = lane >> 4;
    char* ws = p.ws;
    bf16_t* OA = (bf16_t*)(ws + OFF_OA); const bf16_t* BON = (const bf16_t*)(ws + OFF_BON); const bf16_t* RH = (const bf16_t*)(ws + OFF_RH);
    const float* YL = p.out; const u32x4* SF = (const u32x4*)(ws + OFF_SF);
    for (int itb = bid * 2; itb < 2048; itb += nb * 2) {
        const int it = itb + (w8 >> 2), c = it >> 3, h = it & 7, trow = c * 64 + w * 16 + fr;
        const char* rrow = (const char*)(RH + (size_t)trow * 512 + h * 64);
        bf16x8 rf[2]; rf[0] = ldperm(rrow, 0, fq); rf[1] = ldperm(rrow, 1, fq);
        f32x4 acc[4];
#pragma unroll
        for (int vs = 0; vs < 4; ++vs) {
            acc[vs] = *(const f32x4*)(YL + (size_t)trow * 512 + h * 64 + vs * 16 + fq * 4);
#pragma unroll
            for (int ks = 0; ks < 2; ++ks) acc[vs] = MFMA16(__builtin_bit_cast(bf16x8, SF[((size_t)((c * 8 + h) * 4 + vs) * 2 + ks) * 64 + lane]), rf[ks], acc[vs]);
        }
        float s = 0.f;
#pragma unroll
        for (int vs = 0; vs < 4; ++vs) s += (acc[vs].x + acc[vs].y) + (acc[vs].z + acc[vs].w);
        s += __shfl_xor(s, 16); s += __shfl_xor(s, 32);
        const float mean = s * (1.f / 64.f);
        float q = 0.f;
#pragma unroll
        for (int vs = 0; vs < 4; ++vs) { acc[vs] = acc[vs] - mean; q += (acc[vs].x * acc[vs].x + acc[vs].y * acc[vs].y) + (acc[vs].z * acc[vs].z + acc[vs].w * acc[vs].w); }
        q += __shfl_xor(q, 16); q += __shfl_xor(q, 32);
        const float rstd = rsqrtf(q * (1.f / 64.f) + 64e-5f);
#pragma unroll
        for (int vs = 0; vs < 4; ++vs) {
            const int hv = h * 64 + vs * 16 + fq * 4;
            const f32x4 lw = *(const f32x4*)(p.ln_x_w + hv), lb = *(const f32x4*)(p.ln_x_b + hv);
            const u32x2 bo = *(const u32x2*)(BON + (size_t)trow * 512 + hv), gg = *(const u32x2*)(OA + (size_t)trow * 512 + hv);
            f32x4 o = acc[vs] * rstd * lw + lb;
            o.x = (o.x + __uint_as_float(bo.x << 16)) * __uint_as_float(gg.x << 16);
            o.y = (o.y + __uint_as_float(bo.x & 0xffff0000u)) * __uint_as_float(gg.x & 0xffff0000u);
            o.z = (o.z + __uint_as_float(bo.y << 16)) * __uint_as_float(gg.y << 16);
            o.w = (o.w + __uint_as_float(bo.y & 0xffff0000u)) * __uint_as_float(gg.y & 0xffff0000u);
            *(u32x2*)(OA + (size_t)trow * 512 + hv) = pack4(o);
        }
    }
}


constexpr int A_LK = 0, A_LV = 36864, A_BIAS = 70656, A_TST = 70784, A_TAB = 72848, NTAB = 2912, A_LST = 84496, A_CST = 86560;
constexpr int MAXTILES = 6656;

__device__ __forceinline__ void moba_select(const P& p, int bid0, int nb0, char* smem) {
    const int tid = otid(), lane = tid & 63, w = tid >> 6, fr = lane & 15, fq = lane >> 4;
    char* ws = p.ws;
    const bf16_t* um = (const bf16_t*)(ws + OFF_UM); const bf16_t* kmb = (const bf16_t*)(ws + OFF_CTL + CTL_KMB);
    unsigned* SEL = (unsigned*)(ws + OFF_MSEL);
    int* hist = (int*)smem;
    for (int i = tid; i < 512; i += NT) hist[i] = 0;
    __syncthreads();
    for (int it = bid0; it < 1024; it += nb0) {
        const int tile = it >> 3, h = it & 7, qb = tile >> 1, t = tile * 128 + w * 16 + fr;
        bf16x8 qf[2];
#pragma unroll
        for (int ks = 0; ks < 2; ++ks) qf[ks] = *(const bf16x8*)(um + (size_t)t * UMC + h * 64 + ks * 32 + fq * 8);
        float sc[4][4];
#pragma unroll
        for (int nt = 0; nt < 4; ++nt) {
            f32x4 acc = {0.f, 0.f, 0.f, 0.f};
            if (nt * 16 < qb) {
#pragma unroll
                for (int ks = 0; ks < 2; ++ks) acc = MFMA16(*(const bf16x8*)(kmb + (size_t)((nt * 16 + fr) * 8 + h) * 64 + ks * 32 + fq * 8), qf[ks], acc);
            }
#pragma unroll
            for (int j = 0; j < 4; ++j) sc[nt][j] = (nt * 16 + fq * 4 + j < qb) ? acc[j] : -3.0e38f;
        }
        unsigned selw = 0u;
#pragma unroll
        for (int s = 0; s < 3; ++s) {
            float bv = -3.0e38f; int bi = 255;
#pragma unroll
            for (int nt = 0; nt < 4; ++nt)
#pragma unroll
                for (int j = 0; j < 4; ++j) if (sc[nt][j] > bv) { bv = sc[nt][j]; bi = nt * 16 + fq * 4 + j; }
#pragma unroll
            for (int o = 16; o <= 32; o <<= 1) {
                const float v2 = __shfl_xor(bv, o); const int i2 = __shfl_xor(bi, o);
                if (v2 > bv || (v2 == bv && i2 < bi)) { bv = v2; bi = i2; }
            }
            if (!(bv > -1.0e38f)) bi = 255;
            selw |= (unsigned)bi << (8 * s);
#pragma unroll
            for (int nt = 0; nt < 4; ++nt)
#pragma unroll
                for (int j = 0; j < 4; ++j) if (nt * 16 + fq * 4 + j == bi) sc[nt][j] = -3.0e38f;
            if (fq == 0 && bi != 255) atomicAdd(&hist[h * 64 + bi], 1);
        }
        if (fq == 0) SEL[t * 8 + h] = selw | 0xff000000u;
    }
    __syncthreads();
    int* gcnt = (int*)(ws + OFF_CTL + CTL_MCNT);
    for (int i = tid; i < 512; i += NT) if (hist[i]) atomicAdd(&gcnt[i], hist[i]);
}

__device__ __forceinline__ void moba_fill(const P& p, int bid, int nb, char* smem) {
    const int tid = otid();
    char* ws = p.ws;
    const int* gcnt = (const int*)(ws + OFF_CTL + CTL_MCNT); int* gcur = (int*)(ws + OFF_CTL + CTL_MCUR);
    int* lst = (int*)smem;
    int* tst = lst + 520;
    int* cst = tst + 520;
    int* lh = cst + 520;
    int* lc = lh + 512;
    for (int i = tid; i < 512; i += NT) lc[i] = gcnt[i];
    __syncthreads();
    if (tid == 0) {
        int a = 0, b = 0, cc = 0;
        for (int i = 0; i < 512; ++i) { const int c = lc[i]; lst[i] = a; tst[i] = b; cst[i] = cc; a += c; const int nt_ = (c + 127) >> 7; b += nt_; cc += 2 * nt_ + (nt_ ? 2 : 0); }
        lst[512] = a; tst[512] = b; cst[512] = cc;
    }
    __syncthreads();
    for (int i = tid; i < 512; i += NT) { lh[i] = 0; lc[i] = 0; }
    __syncthreads();
    if (bid == 0) {
        int* glst = (int*)(ws + OFF_CTL + CTL_MLST); int* gtst = (int*)(ws + OFF_CTL + CTL_MTST);
        int* gcst = (int*)(ws + OFF_CTL + CTL_MCST);
        for (int i = tid; i < 513; i += NT) { glst[i] = lst[i]; gtst[i] = tst[i]; gcst[i] = cst[i]; }
    }
    const unsigned* SEL = (const unsigned*)(ws + OFF_MSEL);
    int* QL = (int*)(ws + OFF_MQL); int* SP = (int*)(ws + OFF_MSP);
    const int per = (T * 8 + nb - 1) / nb, i0 = bid * per, i1 = min(T * 8, i0 + per);
    for (int i = i0 + tid; i < i1; i += NT) {
        const unsigned sw = SEL[i]; const int h = i & 7;
#pragma unroll
        for (int s = 0; s < 3; ++s) { const int j = (sw >> (8 * s)) & 255; if (j != 255) atomicAdd(&lh[h * 64 + j], 1); }
    }
    __syncthreads();
    for (int i = tid; i < 512; i += NT) { const int c = lh[i]; lh[i] = c ? atomicAdd(&gcur[i], c) : 0; }
    __syncthreads();
    for (int i = i0 + tid; i < i1; i += NT) {
        const unsigned sw = SEL[i]; const int h = i & 7;
#pragma unroll
        for (int s = 0; s < 3; ++s) {
            const int j = (sw >> (8 * s)) & 255; int pos = -1;
            if (j != 255) { const int li = h * 64 + j; pos = lst[li] + lh[li] + atomicAdd(&lc[li], 1); QL[pos] = i >> 3; }
            SP[i * 3 + s] = pos;
        }
    }
}

__device__ __forceinline__ int t5b(int n) {
    const int v = (int)(__float_as_uint((float)(n * n)) >> 23) - 119;
    return n < 16 ? n : (v > 31 ? 31 : v);
}

__device__ __forceinline__ void attn_stage(const P& p, int j, int h, int nkeys, char* smem, int tid) {
    const bf16_t* um = (const bf16_t*)(p.ws + OFF_UM); const bf16_t* vt = (const bf16_t*)(p.ws + OFF_VT);
    for (int idx = tid; idx < nkeys * 8; idx += NT) {
        const int key = idx >> 3, ch = idx & 7;
        *(u32x4*)(smem + A_LK + key * 144 + ch * 16) = *(const u32x4*)(um + (size_t)(j * 256 + key) * UMC + 512 + h * 64 + ch * 8);
    }
    const int cpr = nkeys >> 3;
    for (int idx = tid; idx < 64 * cpr; idx += NT) {
        const int d = idx / cpr, ch = idx - d * cpr;
        *(u32x4*)(smem + A_LV + d * 528 + ch * 16) = *(const u32x4*)(vt + (size_t)(h * 64 + d) * T + j * 256 + ch * 8);
    }
    for (int i = tid; i < NTAB; i += NT) ((float*)(smem + A_TAB))[i] = p.rel_bias[t5b(i) * 8 + h];
}
__device__ __forceinline__ void attn_stage_load(const P& p, int j, int h, int tid, u32x4 (&rk)[4], u32x4 (&rv)[4]) {
    const bf16_t* um = (const bf16_t*)(p.ws + OFF_UM); const bf16_t* vt = (const bf16_t*)(p.ws + OFF_VT);
#pragma unroll
    for (int i = 0; i < 4; ++i) {
        const int idx = tid + i * NT, key = idx >> 3, ch = idx & 7, d = idx >> 5, c2 = idx & 31;
        rk[i] = *(const u32x4*)(um + (size_t)(j * 256 + key) * UMC + 512 + h * 64 + ch * 8);
        rv[i] = *(const u32x4*)(vt + (size_t)(h * 64 + d) * T + j * 256 + c2 * 8);
    }
}
__device__ __forceinline__ void attn_stage_store(const P& p, int h, int tid, char* smem, const u32x4 (&rk)[4], const u32x4 (&rv)[4]) {
#pragma unroll
    for (int i = 0; i < 4; ++i) {
        const int idx = tid + i * NT, key = idx >> 3, ch = idx & 7, d = idx >> 5, c2 = idx & 31;
        *(u32x4*)(smem + A_LK + key * 144 + ch * 16) = rk[i];
        *(u32x4*)(smem + A_LV + d * 528 + c2 * 16) = rv[i];
    }
    for (int i = tid; i < NTAB; i += NT) ((float*)(smem + A_TAB))[i] = p.rel_bias[t5b(i) * 8 + h];
}
template <bool CAUSAL>
__device__ __forceinline__ void attn_core_q(const char* smem, const bf16x8 (&qf)[2], int qt, int kbase, int nkeys, int fr, int fq, float& m_out, float& l_out, f32x4 (&o)[4]) {
    const float* tb = (const float*)(smem + A_TAB);
    const int nkt = nkeys >> 4;
    f32x4 sc[16];
    float mx = -3.0e38f;
    const bool far = !CAUSAL && __all(qt - (kbase + 255) >= 2897);
    const float cfar = tb[NTAB - 1];
#pragma unroll
    for (int kt = 0; kt < 16; ++kt) {
        f32x4 acc = {0.f, 0.f, 0.f, 0.f};
        if (kt < nkt) {
#pragma unroll
            for (int ks = 0; ks < 2; ++ks) acc = MFMA16(*(const bf16x8*)(smem + A_LK + (kt * 16 + fr) * 144 + (ks * 32 + fq * 8) * 2), qf[ks], acc);
            if (far) {
#pragma unroll
                for (int jj = 0; jj < 4; ++jj) { const float l = acc[jj] * 0.125f + cfar; acc[jj] = l; mx = fmaxf(mx, l); }
            } else {
#pragma unroll
                for (int jj = 0; jj < 4; ++jj) {
                    const int rel = qt - (kbase + kt * 16 + fq * 4 + jj);
                    float l = acc[jj] * 0.125f + tb[min(max(rel, 0), NTAB - 1)];
                    if (CAUSAL && rel < 0) l = -3.0e38f;
                    acc[jj] = l; mx = fmaxf(mx, l);
                }
            }
        } else { acc = (f32x4){-3.0e38f, -3.0e38f, -3.0e38f, -3.0e38f}; }
        sc[kt] = acc;
    }
    mx = fmaxf(mx, __shfl_xor(mx, 16)); mx = fmaxf(mx, __shfl_xor(mx, 32));
    float ls = 0.f;
#pragma unroll
    for (int kt = 0; kt < 16; ++kt)
#pragma unroll
        for (int jj = 0; jj < 4; ++jj) { const float e = (!CAUSAL || sc[kt][jj] > -1.0e38f) ? __expf(sc[kt][jj] - mx) : 0.f; sc[kt][jj] = e; ls += e; }
    ls += __shfl_xor(ls, 16); ls += __shfl_xor(ls, 32);
#pragma unroll
    for (int dt = 0; dt < 4; ++dt) o[dt] = (f32x4){0.f, 0.f, 0.f, 0.f};
#pragma unroll
    for (int s = 0; s < 8; ++s) {
        if (s * 2 < nkt) {
            const bf16x8 pf = pack8(sc[2 * s], sc[2 * s + 1]);
#pragma unroll
            for (int dt = 0; dt < 4; ++dt) o[dt] = MFMA16(ldperm(smem + A_LV + (dt * 16 + fr) * 528, s, fq), pf, o[dt]);
        }
    }
    m_out = mx; l_out = ls;
}

template <bool CAUSAL>
__device__ __forceinline__ void attn_core(const char* smem, const bf16_t* qrow, int qt, int kbase, int nkeys, int fr, int fq, float& m_out, float& l_out, f32x4 (&o)[4]) {
    bf16x8 qf[2];
#pragma unroll
    for (int ks = 0; ks < 2; ++ks) qf[ks] = *(const bf16x8*)(qrow + ks * 32 + fq * 8);
    attn_core_q<CAUSAL>(smem, qf, qt, kbase, nkeys, fr, fq, m_out, l_out, o);
}

__device__ __forceinline__ void moba_partial(const P& p, int bid, int nb, char* smem) {
    const int tid = otid(), lane = tid & 63, w = tid >> 6, fr = lane & 15, fq = lane >> 4;
    char* ws = p.ws;
    const bf16_t* um = (const bf16_t*)(ws + OFF_UM);
    const int* glst = (const int*)(ws + OFF_CTL + CTL_MLST); const int* gtst = (const int*)(ws + OFF_CTL + CTL_MTST);
    const int* QL = (const int*)(ws + OFF_MQL);
    bf16_t* PO = (bf16_t*)p.out; float* PM = (float*)((char*)p.out + 52 * MiB); float* PL = PM + 400000;
    int* tst = (int*)(smem + A_TST); int* lst = (int*)(smem + A_LST);
    for (int i = tid; i < 513; i += NT) { tst[i] = gtst[i]; lst[i] = glst[i]; }
    __syncthreads();
    const int* gcst = (const int*)(ws + OFF_CTL + CTL_MCST);
    int* cst = (int*)(smem + A_CST);
    for (int i = tid; i < 513; i += NT) cst[i] = gcst[i];
    __syncthreads();
    auto first_tile = [&](int cpos) {
        int lo = 0, hi = 512;
        while (hi - lo > 1) { const int mid = (lo + hi) >> 1; if (cst[mid] <= cpos) lo = mid; else hi = mid; }
        const int ntl = tst[lo + 1] - tst[lo];
        int k = (cpos - cst[lo] - 2 + 1) >> 1; if (k < 0) k = 0;
        return (k >= ntl) ? tst[lo + 1] : tst[lo] + k;
    };
    const int Ctot = cst[512];
    const int it0 = first_tile((int)((long)Ctot * bid / nb)), it1 = (bid + 1 == nb) ? tst[512] : first_tile((int)((long)Ctot * (bid + 1) / nb));
    int lq = 0;
    auto tile_pos = [&](int it, int& li, int& pos, bool& valid) {
        int lo = lq;
        while (lo < 511 && tst[lo + 1] <= it) ++lo;
        lq = lo; li = lo;
        const int base = lst[lo] + (it - tst[lo]) * 128, idx = w * 16 + fr;
        valid = base + idx < lst[lo + 1];
        pos = valid ? base + idx : base;
    };
    { int lo = 0, hi = 512; while (hi - lo > 1) { const int mid = (lo + hi) >> 1; if (tst[mid] <= it0) lo = mid; else hi = mid; } lq = lo; }
    int liA = 0, posA = 0, liB = 0, posB = 0, qtA = 0, qtB = 0; bool vA = false, vB = false;
    bf16x8 qfA[2];
    if (it0 < it1) {
        tile_pos(it0, liA, posA, vA); qtA = QL[posA];
        if (it0 + 1 < it1) { tile_pos(it0 + 1, liB, posB, vB); qtB = QL[posB]; }
#pragma unroll
        for (int ks = 0; ks < 2; ++ks) qfA[ks] = *(const bf16x8*)(um + (size_t)qtA * UMC + (liA >> 6) * 64 + ks * 32 + fq * 8);
    }
    int lprev = -1, lpre = -1;
    u32x4 rk[4], rv[4];
    for (int it = it0; it < it1; ++it) {
        const int h = liA >> 6, j = liA & 63;
        if (liA != lprev) {
            if (lpre != liA) attn_stage_load(p, j, h, tid, rk, rv);
            __syncthreads();
            attn_stage_store(p, h, tid, smem, rk, rv);
            __syncthreads();
            lprev = liA;
        }
        if (it + 1 < it1 && liB != liA) { attn_stage_load(p, liB & 63, liB >> 6, tid, rk, rv); lpre = liB; }
        bf16x8 qfB[2]; int liC = 0, posC = 0, qtC = 0; bool vC = false;
        if (it + 1 < it1) {
#pragma unroll
            for (int ks = 0; ks < 2; ++ks) qfB[ks] = *(const bf16x8*)(um + (size_t)qtB * UMC + (liB >> 6) * 64 + ks * 32 + fq * 8);
        } else { qfB[0] = qfA[0]; qfB[1] = qfA[1]; }
        if (it + 2 < it1) { tile_pos(it + 2, liC, posC, vC); qtC = QL[posC]; }
        float m, l; f32x4 o[4];
        attn_core_q<false>(smem, qfA, qtA, j * 256, 256, fr, fq, m, l, o);
        if (vA) {
#pragma unroll
            for (int dt = 0; dt < 4; ++dt) *(u32x2*)(PO + (size_t)posA * 64 + dt * 16 + fq * 4) = pack4(o[dt]);
            if (fq == 0) { PM[posA] = m; PL[posA] = l; }
        }
        liA = liB; posA = posB; vA = vB; qtA = qtB; qfA[0] = qfB[0]; qfA[1] = qfB[1];
        liB = liC; posB = posC; vB = vC; qtB = qtC;
    }
}

__device__ __forceinline__ void moba_own(const P& p, int bid, int nb, char* smem) {
    const int tid = otid(), lane = tid & 63, w = tid >> 6, fr = lane & 15, fq = lane >> 4;
    char* ws = p.ws;
    const bf16_t* um = (const bf16_t*)(ws + OFF_UM);
    const int* SP = (const int*)(ws + OFF_MSP);
    const bf16_t* PO = (const bf16_t*)p.out; const float* PM = (const float*)((const char*)p.out + 52 * MiB); const float* PL = PM + 400000;
    bf16_t* ob = (bf16_t*)(ws + OFF_OB);
    for (int it = bid; it < 1024; it += nb) {
        const int tile = it >> 3, h = it & 7, b = tile >> 1, tb = tile & 1, nkeys = (tb + 1) * 128;
        attn_stage(p, b, h, nkeys, smem, tid);
        __syncthreads();
        const int qt = tile * 128 + w * 16 + fr;
        float m, l; f32x4 o[4];
        attn_core<true>(smem, um + (size_t)qt * UMC + h * 64, qt, b * 256, nkeys, fr, fq, m, l, o);
        int pos[3]; float pm[3]; float M = m;
#pragma unroll
        for (int s = 0; s < 3; ++s) { pos[s] = SP[(qt * 8 + h) * 3 + s]; pm[s] = (pos[s] >= 0) ? PM[pos[s]] : -3.0e38f; M = fmaxf(M, pm[s]); }
        const float so = __expf(m - M);
        float den = l * so;
#pragma unroll
        for (int dt = 0; dt < 4; ++dt) o[dt] = o[dt] * so;
#pragma unroll
        for (int s = 0; s < 3; ++s) {
            if (pos[s] >= 0) {
                const float e = __expf(pm[s] - M);
                den += PL[pos[s]] * e;
#pragma unroll
                for (int dt = 0; dt < 4; ++dt) {
                    const u32x2 pv = *(const u32x2*)(PO + (size_t)pos[s] * 64 + dt * 16 + fq * 4);
                    o[dt].x += e * __uint_as_float(pv.x << 16); o[dt].y += e * __uint_as_float(pv.x & 0xffff0000u);
                    o[dt].z += e * __uint_as_float(pv.y << 16); o[dt].w += e * __uint_as_float(pv.y & 0xffff0000u);
                }
            }
        }
        const float inv = 1.f / den;
#pragma unroll
        for (int dt = 0; dt < 4; ++dt) *(u32x2*)(ob + (size_t)qt * 512 + h * 64 + dt * 16 + fq * 4) = pack4(o[dt] * inv);
        __syncthreads();
    }
}


__device__ __forceinline__ void phase_kvx(const P& p, int bid0, int nb0, char* smem) {
    char* ws = p.ws;
    bf16_t* KX = (bf16_t*)(ws + OFF_KVX); bf16_t* VXT = KX + 256 * 512;
    for (int it = bid0; it < 8; it += nb0) {
        f32x4 acc[2][8];
#pragma unroll
        for (int m = 0; m < 2; ++m)
#pragma unroll
            for (int n = 0; n < 8; ++n) acc[m][n] = (f32x4){0.f, 0.f, 0.f, 0.f};
        gemm_r32(acc, (const bf16_t*)(ws + OFF_MEMN), D, 0, (const bf16_t*)(ws + OFF_WKV), D, it * 128, D, smem);
        const int tid = otid(), lane = tid & 63, w = tid >> 6, fr = lane & 15, fq = lane >> 4;
#pragma unroll
        for (int m = 0; m < 2; ++m) {
            const int row = w * 32 + m * 16 + fr;
#pragma unroll
            for (int n = 0; n < 8; ++n) {
                const f32x4 v = acc[m][n];
                if (it < 4) *(u32x2*)(KX + (size_t)row * 512 + it * 128 + n * 16 + fq * 4) = pack4(v);
                else {
                    const int col = (it - 4) * 128 + n * 16 + fq * 4;
                    VXT[(size_t)(col + 0) * 256 + row] = (bf16_t)f2bf(v.x); VXT[(size_t)(col + 1) * 256 + row] = (bf16_t)f2bf(v.y);
                    VXT[(size_t)(col + 2) * 256 + row] = (bf16_t)f2bf(v.z); VXT[(size_t)(col + 3) * 256 + row] = (bf16_t)f2bf(v.w);
                }
            }
        }
    }
}

__device__ __forceinline__ void phase_qx_xattn(const P& p, int bid, int nb, char* smem) {
    char* ws = p.ws;
    const bf16_t* KX = (const bf16_t*)(ws + OFF_KVX); const bf16_t* VXT = KX + 256 * 512;
    bf16_t* ox = (bf16_t*)(ws + OFF_OB);
    for (int it = bid; it < 256; it += nb) {
        const int pm = it >> 2, h = it & 3;
        bf16x8 qf[2][4];
        {
            f32x4 acc[2][8];
#pragma unroll
            for (int m = 0; m < 2; ++m)
#pragma unroll
                for (int n = 0; n < 8; ++n) acc[m][n] = (f32x4){0.f, 0.f, 0.f, 0.f};
            gemm_r32(acc, (const bf16_t*)(ws + OFF_XN), D, pm * 256, (const bf16_t*)(ws + OFF_WQ), D, h * 128, D, smem);
            const float sc = 0.08838834764831845f;
#pragma unroll
            for (int m = 0; m < 2; ++m)
#pragma unroll
                for (int s2 = 0; s2 < 4; ++s2) qf[m][s2] = pack8(acc[m][2 * s2] * sc, acc[m][2 * s2 + 1] * sc);
        }
        const int tid = otid(), lane = tid & 63, w = tid >> 6, fr = lane & 15, fq = lane >> 4;
        for (int idx = tid; idx < 4096; idx += NT) { const int key = idx >> 4, ch = idx & 15; *(u32x4*)(smem + key * 272 + ch * 16) = *(const u32x4*)(KX + (size_t)key * 512 + h * 128 + ch * 8); }
        __syncthreads();
        bf16x8 pf[2][8]; float inv[2];
#pragma unroll
        for (int m = 0; m < 2; ++m) {
            f32x4 sc[16]; float mx = -3.0e38f;
#pragma unroll
            for (int kt = 0; kt < 16; ++kt) {
                f32x4 a = {0.f, 0.f, 0.f, 0.f};
#pragma unroll
                for (int s2 = 0; s2 < 4; ++s2) a = MFMA16(ldperm(smem + (kt * 16 + fr) * 272, s2, fq), qf[m][s2], a);
                sc[kt] = a; mx = fmaxf(fmaxf(mx, fmaxf(a.x, a.y)), fmaxf(a.z, a.w));
            }
            mx = fmaxf(mx, __shfl_xor(mx, 16)); mx = fmaxf(mx, __shfl_xor(mx, 32));
            float ls = 0.f;
#pragma unroll
            for (int kt = 0; kt < 16; ++kt) { sc[kt].x = __expf(sc[kt].x - mx); sc[kt].y = __expf(sc[kt].y - mx); sc[kt].z = __expf(sc[kt].z - mx); sc[kt].w = __expf(sc[kt].w - mx); ls += (sc[kt].x + sc[kt].y) + (sc[kt].z + sc[kt].w); }
            ls += __shfl_xor(ls, 16); ls += __shfl_xor(ls, 32);
            inv[m] = 1.f / ls;
#pragma unroll
            for (int s2 = 0; s2 < 8; ++s2) { pf[m][s2] = pack8(sc[2 * s2], sc[2 * s2 + 1]); asm volatile("" : "+v"(pf[m][s2])); }
            asm volatile("" ::: "memory");
        }
        __syncthreads();
        for (int idx = tid; idx < 4096; idx += NT) { const int d = idx >> 5, ch = idx & 31; *(u32x4*)(smem + d * 528 + ch * 16) = *(const u32x4*)(VXT + (size_t)(h * 128 + d) * 256 + ch * 8); }
        __syncthreads();
#pragma unroll
        for (int m = 0; m < 2; ++m) {
            const int row = pm * 256 + w * 32 + m * 16 + fr;
#pragma unroll
            for (int dt = 0; dt < 8; ++dt) {
                f32x4 o = {0.f, 0.f, 0.f, 0.f};
#pragma unroll
                for (int s2 = 0; s2 < 8; ++s2) o = MFMA16(ldperm(smem + (dt * 16 + fr) * 528, s2, fq), pf[m][s2], o);
                *(u32x2*)(ox + (size_t)row * 512 + h * 128 + dt * 16 + fq * 4) = pack4(o * inv[m]);
                asm volatile("" ::: "memory");
            }
        }
        __syncthreads();
    }
}

struct EpiMergeA {
    static constexpr bool PERM = true;
    char* ws;
    __device__ __forceinline__ void operator()(const f32x4 (&acc)[2][2][4][2], const pg8::Unit& u, int wr, int wc, int fr, int fq) const {
        const bf16_t* ug = (const bf16_t*)(ws + OFF_UG); bf16_t* mg = (bf16_t*)(ws + OFF_MRG);
        const int row0 = u.pm * 256 + wr * 64 + fr, col0 = u.pn * 256 + wc * 32 + 8 * fq;
#pragma unroll
        for (int ai = 0; ai < 2; ++ai)
#pragma unroll
            for (int m = 0; m < 4; ++m) {
                const size_t row = row0 + ai * 128 + m * 16;
#pragma unroll
                for (int bj = 0; bj < 2; ++bj) {
                    const int col = col0 + bj * 128;
                    float g[8]; unpack8(*(const u32x4*)(ug + row * GCOLS + col), g);
                    const f32x4 a = acc[ai][bj][m][0], b = acc[ai][bj][m][1];
                    u32x4 w; w.x = cvt_pk(g[0] * a.x, g[1] * a.y); w.y = cvt_pk(g[2] * a.z, g[3] * a.w); w.z = cvt_pk(g[4] * b.x, g[5] * b.y); w.w = cvt_pk(g[6] * b.z, g[7] * b.w);
                    *(u32x4*)(mg + row * D + col) = w;
                }
            }
    }
};
struct EpiMergeB {
    static constexpr bool PERM = true;
    char* ws;
    __device__ __forceinline__ void operator()(const f32x4 (&acc)[2][2][4][2], const pg8::Unit& u, int wr, int wc, int fr, int fq) const {
        const bf16_t* ug = (const bf16_t*)(ws + OFF_UG); bf16_t* mg = (bf16_t*)(ws + OFF_MRG);
        const int row0 = u.pm * 256 + wr * 64 + fr, col0 = u.pn * 256 + wc * 32 + 8 * fq;
#pragma unroll
        for (int ai = 0; ai < 2; ++ai)
#pragma unroll
            for (int m = 0; m < 4; ++m) {
                const size_t row = row0 + ai * 128 + m * 16;
#pragma unroll
                for (int bj = 0; bj < 2; ++bj) {
                    const int col = col0 + bj * 128;
                    float g[8], t[8]; unpack8(*(const u32x4*)(ug + row * GCOLS + 1024 + col), g); unpack8(*(const u32x4*)(mg + row * D + col), t);
                    const f32x4 a = acc[ai][bj][m][0], b = acc[ai][bj][m][1];
                    u32x4 w; w.x = cvt_pk(t[0] + g[0] * a.x, t[1] + g[1] * a.y); w.y = cvt_pk(t[2] + g[2] * a.z, t[3] + g[3] * a.w);
                    w.z = cvt_pk(t[4] + g[4] * b.x, t[5] + g[5] * b.y); w.w = cvt_pk(t[6] + g[6] * b.z, t[7] + g[7] * b.w);
                    *(u32x4*)(mg + row * D + col) = w;
                }
            }
    }
};
__device__ __forceinline__ void phase_merge(const P& p, int bid, int nb, char* smem) {
    pg8::StaticOrder S; S.init(T, D, nb, bid);
    EpiMergeA EA{p.ws}; EpiMergeB EB{p.ws};
    pg8::gemm_phase<EpiMergeA, pg8::StaticOrder, true>((LAS unsigned char*)smem, (const bf16_t*)(p.ws + OFF_OA), (const bf16_t*)(p.ws + OFF_WORW), 512, S, EA);
    pg8::gemm_phase<EpiMergeB, pg8::StaticOrder, true>((LAS unsigned char*)smem, (const bf16_t*)(p.ws + OFF_OB), (const bf16_t*)(p.ws + OFF_WOMB), 512, S, EB);
}
struct EpiResid {
    static constexpr bool PERM = false;
    const float* res; float* out;
    __device__ __forceinline__ void operator()(const f32x4 (&acc)[2][2][4][2], const pg8::Unit& u, int wr, int wc, int fr, int fq) const {
        const int row0 = u.pm * 256 + wr * 64 + fr, col0 = u.pn * 256 + wc * 32 + 4 * fq;
#pragma unroll
        for (int ai = 0; ai < 2; ++ai)
#pragma unroll
            for (int m = 0; m < 4; ++m) {
                const size_t off = (size_t)(row0 + ai * 128 + m * 16) * D + col0;
#pragma unroll
                for (int bj = 0; bj < 2; ++bj)
#pragma unroll
                    for (int n = 0; n < 2; ++n) { const f32x4 r = *(const f32x4*)(res + off + bj * 128 + n * 16); *(f32x4*)(out + off + bj * 128 + n * 16) = r + acc[ai][bj][m][n]; }
            }
    }
};
__device__ __forceinline__ void phase_resid_gemm(const bf16_t* A, int K, const bf16_t* Bt, const float* res, float* dst, int bid, int nb, char* smem) {
    pg8::StaticOrder S; S.init(T, D, nb, bid);
    EpiResid E{res, dst};
    pg8::gemm_phase<EpiResid, pg8::StaticOrder, true>((LAS unsigned char*)smem, A, Bt, K, S, E);
}
__device__ __forceinline__ void phase_norm(const float* src, const float* g, bf16_t* dst, int bid, int nb) {
    const int lane = otid() & 63, wid = otid() >> 6;
    for (int it = bid; it < T / 8; it += nb) { const int row = it * 8 + wid; rms_row_bf16(src + (size_t)row * D, g, dst + (size_t)row * D, lane); }
}
template <int PART>
__device__ __forceinline__ void phase_expconv(const P& p, int bid, int nb, char* smem) {
    float* scr = (float*)smem;
    bf16_t* gu = (bf16_t*)(p.ws + OFF_EXPGU); bf16_t* dn = (bf16_t*)(p.ws + OFF_EXPD);
    constexpr int NITEMS = PART == 0 ? (32 * 64 + 12 * 128) : (20 * 128);
    for (int it = bid; it < NITEMS; it += nb) {
        if (PART == 0 && it < 2048) { const int e = it >> 6, tile = it & 63; transpose_tile(p.w_exp_down + (size_t)e * DEXP * D, DEXP, D, dn + (size_t)e * D * DEXP, 16, 0, tile, scr); continue; }
        const int r = PART == 0 ? it - 2048 : it + 12 * 128, e = r >> 7, which = (r >> 6) & 1, tile = r & 63;
        if (which == 0) transpose_tile(p.w_exp_gate + (size_t)e * D * DEXP, D, DEXP, gu + (size_t)e * D * D, 32, 0, tile, scr);
        else transpose_tile(p.w_exp_up + (size_t)e * D * DEXP, D, DEXP, gu + (size_t)e * D * D, 32, 16, tile, scr);
    }
}

__device__ __forceinline__ void phase_router(const P& p, int bid, int nb, char* smem) {
    const int tid = otid(), lane = tid & 63, wid = tid >> 6;
    char* ws = p.ws;
    int* hist = (int*)smem;
    if (tid < 32) hist[tid] = 0;
    __syncthreads();
    const float* x2 = p.out;
    bf16_t* xn = (bf16_t*)(ws + OFF_XN);
    int* toke = (int*)(ws + OFF_CTL + CTL_TOKE); float* tokg = (float*)(ws + OFF_CTL + CTL_TOKG);
    int* rowtok = (int*)(ws + OFF_CTL + CTL_ROWTOK);
    for (int i = bid * NT + tid; i < CAP; i += nb * NT) rowtok[i] = 0;
    float* rt = (float*)(smem + 256);
    { const f32x4* src = (const f32x4*)(ws + OFF_ROUT); f32x4* dst = (f32x4*)rt; for (int i = tid; i < 36 * 256; i += NT) dst[i] = src[i]; }
    __syncthreads();
    for (int it = bid; it < T / 32; it += nb) {
        const int tidr = otid(), lane = tidr & 63, wid = tidr >> 6;
        const int rbase = it * 32 + wid * 4;
        f32x4 hv[4][4];
#pragma unroll
        for (int rr = 0; rr < 4; ++rr) {
            const f32x4* xr = (const f32x4*)(x2 + (size_t)(rbase + rr) * D) + lane; const f32x4* gr = (const f32x4*)p.norm_ffn + lane;
            float s = 0.f;
#pragma unroll
            for (int j = 0; j < 4; ++j) { hv[rr][j] = xr[64 * j]; s += hv[rr][j].x * hv[rr][j].x + hv[rr][j].y * hv[rr][j].y + hv[rr][j].z * hv[rr][j].z + hv[rr][j].w * hv[rr][j].w; }
            const float rstd = rsqrtf(wave_sum(s) * (1.f / 1024.f) + 1e-6f);
            u32x2* o8 = (u32x2*)(xn + (size_t)(rbase + rr) * D) + lane;
#pragma unroll
            for (int j = 0; j < 4; ++j) { const f32x4 gg = gr[64 * j]; hv[rr][j] = hv[rr][j] * rstd * gg; o8[64 * j] = pack4(hv[rr][j]); }
        }
#pragma unroll
        for (int rp = 0; rp < 2; ++rp) {
            float ve[2][32], vg[2][4];
#pragma unroll
            for (int o = 0; o < 36; ++o) {
                const f32x4* wr_ = (const f32x4*)(rt + o * 1024) + lane;
                f32x4 w[4];
#pragma unroll
                for (int j = 0; j < 4; ++j) w[j] = wr_[64 * j];
#pragma unroll
                for (int r2 = 0; r2 < 2; ++r2) {
                    const int rr = rp * 2 + r2;
                    float sacc = 0.f;
#pragma unroll
                    for (int j = 0; j < 4; ++j) sacc += hv[rr][j].x * w[j].x + hv[rr][j].y * w[j].y + hv[rr][j].z * w[j].z + hv[rr][j].w * w[j].w;
                    if (o < 32) ve[r2][o] = sacc; else vg[r2][o - 32] = sacc;
                }
                if (o & 1) asm volatile("" ::: "memory");
            }
#pragma unroll
            for (int r2 = 0; r2 < 2; ++r2) {
#define RT_LEVEL(D, NH) { const bool hi = (lane & (D)) != 0; _Pragma("unroll") for (int i = 0; i < (NH); ++i) { \
                    const float keep = hi ? ve[r2][2 * i + 1] : ve[r2][2 * i], send = hi ? ve[r2][2 * i] : ve[r2][2 * i + 1]; ve[r2][i] = keep + __shfl_xor(send, (D)); } }
                RT_LEVEL(32, 16) RT_LEVEL(16, 8) RT_LEVEL(8, 4) RT_LEVEL(4, 2) RT_LEVEL(2, 1)
#undef RT_LEVEL
                ve[r2][0] += __shfl_xor(ve[r2][0], 1);
                {
                    const bool h5 = (lane & 32) != 0, h4 = (lane & 16) != 0;
                    const float k0 = h5 ? vg[r2][1] : vg[r2][0], s0 = h5 ? vg[r2][0] : vg[r2][1], k1 = h5 ? vg[r2][3] : vg[r2][2], s1 = h5 ? vg[r2][2] : vg[r2][3];
                    const float a0 = k0 + __shfl_xor(s0, 32), a1 = k1 + __shfl_xor(s1, 32);
                    float gsum = (h4 ? a1 : a0) + __shfl_xor(h4 ? a0 : a1, 16);
                    gsum += __shfl_xor(gsum, 8); gsum += __shfl_xor(gsum, 4); gsum += __shfl_xor(gsum, 2); gsum += __shfl_xor(gsum, 1);
                    vg[r2][0] = gsum;
                }
            }
#pragma unroll
            for (int r2 = 0; r2 < 2; ++r2) {
                const int rr = rp * 2 + r2;
                const float g0 = __shfl(vg[r2][0], 0), g1 = __shfl(vg[r2][0], 32), g2 = __shfl(vg[r2][0], 16), g3 = __shfl(vg[r2][0], 48);
                int gs = 0; float gm = g0;
                if (g1 > gm) { gm = g1; gs = 1; }
                if (g2 > gm) { gm = g2; gs = 2; }
                if (g3 > gm) { gm = g3; gs = 3; }
                const float gp = 1.f / (__expf(g0 - gm) + __expf(g1 - gm) + __expf(g2 - gm) + __expf(g3 - gm));
                float e[8];
#pragma unroll
                for (int i = 0; i < 8; ++i) {
                    const int o = gs * 8 + i;
                    const int src = ((o & 1) << 5) | (((o >> 1) & 1) << 4) | (((o >> 2) & 1) << 3) | (((o >> 3) & 1) << 2) | (((o >> 4) & 1) << 1);
                    e[i] = __shfl(ve[r2][0], src);
                }
                int i1 = 0; float v1 = e[0];
#pragma unroll
                for (int i = 1; i < 8; ++i) if (e[i] > v1) { v1 = e[i]; i1 = i; }
                int i2 = -1; float v2 = -3.0e38f;
#pragma unroll
                for (int i = 0; i < 8; ++i) if (i != i1 && e[i] > v2) { v2 = e[i]; i2 = i; }
                const float e2 = __expf(v2 - v1), den = 1.f / (1.f + e2);
                if (lane == 0) {
                    const int tok = rbase + rr;
                    toke[tok * 2] = gs * 8 + i1; toke[tok * 2 + 1] = gs * 8 + i2;
                    tokg[tok * 2] = gp * den; tokg[tok * 2 + 1] = gp * e2 * den;
                    atomicAdd(&hist[gs * 8 + i1], 1); atomicAdd(&hist[gs * 8 + i2], 1);
                }
            }
        }
    }
    __syncthreads();
    { const int t2 = otid(); const int* h2 = (const int*)smem; if (t2 < 32 && h2[t2]) atomicAdd((int*)(p.ws + OFF_CTL + CTL_CNT) + t2, h2[t2]); }
}
__device__ __forceinline__ void phase_dispatch(const P& p, int bid, int nb, char* smem) {
    const int tid = otid();
    char* ws = p.ws;
    int* pstart = (int*)smem;
    int* lh = pstart + 64;
    int* lc = lh + 32;
    int* cn = lc + 32;
    const int* counts = (const int*)(ws + OFF_CTL + CTL_CNT);
    int* cursor = (int*)(ws + OFF_CTL + CTL_CNT) + 32;
    if (tid < 32) { cn[tid] = counts[tid]; lh[tid] = 0; lc[tid] = 0; }
    __syncthreads();
    if (tid == 0) { int a = 0; for (int e = 0; e < 32; ++e) { pstart[e] = a; a += (cn[e] + MBLK - 1) / MBLK * MBLK; } pstart[32] = a; }
    __syncthreads();
    const int* toke = (const int*)(ws + OFF_CTL + CTL_TOKE);
    int* toks = (int*)(ws + OFF_CTL + CTL_TOKS); int* rowtok = (int*)(ws + OFF_CTL + CTL_ROWTOK);
    const int per = (T * 2 + nb - 1) / nb, i0 = bid * per, i1 = min(T * 2, i0 + per);
    for (int i = i0 + tid; i < i1; i += NT) atomicAdd(&lh[toke[i]], 1);
    __syncthreads();
    if (tid < 32) { const int c = lh[tid]; lh[tid] = c ? atomicAdd(&cursor[tid], c) : 0; }
    __syncthreads();
    for (int i = i0 + tid; i < i1; i += NT) {
        const int e = toke[i];
        const int pos = pstart[e] + lh[e] + atomicAdd(&lc[e], 1);
        rowtok[pos] = i >> 1; toks[i] = pos;
    }
    if (bid == 0) {
        int* blke = (int*)(ws + OFF_CTL + CTL_BLKE);
        for (int b = tid; b < NBLK; b += NT) {
            const int r = b * MBLK; int e = -1;
            if (r < pstart[32]) { e = 0; while (pstart[e + 1] <= r) ++e; }
            blke[b] = e;
        }
        if (tid == 0) blke[NBLK] = pstart[32] / MBLK;
    }
}
struct MoeOrder {
    const int* blke; const int* rowtok; int nunits, G, c; bool gather; int brows;
    __device__ bool next(int i, pg8::Unit& u) const {
        const int L = i * G + c; if (L >= nunits) return false;
        u.pm = L >> 2; u.pn = L & 3; u.e = blke[u.pm]; return true;
    }
    __device__ __forceinline__ unsigned rowA(const pg8::Unit& u, int r) const { return gather ? (unsigned)rowtok[u.pm * MBLK + r] : (unsigned)(u.pm * MBLK + r); }
    __device__ __forceinline__ unsigned rowB(const pg8::Unit& u, int r) const { return (unsigned)(u.e * brows + u.pn * 256 + r); }
};
struct EpiHid {
    static constexpr bool PERM = false;
    bf16_t* hid;
    __device__ __forceinline__ void operator()(const f32x4 (&acc)[2][2][4][2], const pg8::Unit& u, int wr, int wc, int fr, int fq) const {
        const int row0 = u.pm * 256 + wr * 64 + fr, col0 = u.pn * 128 + wc * 16 + 4 * fq;
#pragma unroll
        for (int ai = 0; ai < 2; ++ai)
#pragma unroll
            for (int m = 0; m < 4; ++m) {
                bf16_t* rowp = hid + (size_t)(row0 + ai * 128 + m * 16) * DEXP + col0;
#pragma unroll
                for (int bj = 0; bj < 2; ++bj) {
                    const f32x4 g = acc[ai][bj][m][0], uu = acc[ai][bj][m][1];
                    f32x4 hval; hval.x = g.x * sigm(g.x) * uu.x; hval.y = g.y * sigm(g.y) * uu.y; hval.z = g.z * sigm(g.z) * uu.z; hval.w = g.w * sigm(g.w) * uu.w;
                    *(u32x2*)(rowp + bj * 64) = pack4(hval);
                }
            }
    }
};
struct EpiY {
    static constexpr bool PERM = true;
    bf16_t* ym;
    __device__ __forceinline__ void operator()(const f32x4 (&acc)[2][2][4][2], const pg8::Unit& u, int wr, int wc, int fr, int fq) const {
        const int row0 = u.pm * 256 + wr * 64 + fr, col0 = u.pn * 256 + wc * 32 + 8 * fq;
#pragma unroll
        for (int ai = 0; ai < 2; ++ai)
#pragma unroll
            for (int m = 0; m < 4; ++m) {
                bf16_t* rowp = ym + (size_t)(row0 + ai * 128 + m * 16) * D + col0;
#pragma unroll
                for (int bj = 0; bj < 2; ++bj) {
                    const f32x4 v0 = acc[ai][bj][m][0], v1 = acc[ai][bj][m][1];
                    u32x4 w; w.x = cvt_pk(v0.x, v0.y); w.y = cvt_pk(v0.z, v0.w); w.z = cvt_pk(v1.x, v1.y); w.w = cvt_pk(v1.z, v1.w);
                    *(u32x4*)(rowp + bj * 128) = w;
                }
            }
    }
};
__device__ __forceinline__ void phase_exp1(const P& p, int bid, int nb, char* smem) {
    char* ws = p.ws;
    const int* blke = (const int*)(ws + OFF_CTL + CTL_BLKE);
    MoeOrder S{blke, (const int*)(ws + OFF_CTL + CTL_ROWTOK), blke[NBLK] * 4, nb, bid, true, 1024};
    EpiHid E{(bf16_t*)(ws + OFF_MRG)};
    pg8::gemm_phase<EpiHid, MoeOrder, true>((LAS unsigned char*)smem, (const bf16_t*)(ws + OFF_XN), (const bf16_t*)(ws + OFF_EXPGU), D, S, E);
}
__device__ __forceinline__ void phase_exp2(const P& p, int bid, int nb, char* smem) {
    char* ws = p.ws;
    const int* blke = (const int*)(ws + OFF_CTL + CTL_BLKE);
    MoeOrder S{blke, nullptr, blke[NBLK] * 4, nb, bid, false, 1024};
    EpiY E{(bf16_t*)(ws + OFF_YMOE)};
    pg8::gemm_phase<EpiY, MoeOrder, true>((LAS unsigned char*)smem, (const bf16_t*)(ws + OFF_MRG), (const bf16_t*)(ws + OFF_EXPD), DEXP, S, E);
}
__device__ __forceinline__ void phase_final(const P& p, int bid, int nb) {
    const int lane = otid() & 63, wid = otid() >> 6;
    char* ws = p.ws;
    const int* toks = (const int*)(ws + OFF_CTL + CTL_TOKS); const float* tokg = (const float*)(ws + OFF_CTL + CTL_TOKG);
    const bf16_t* ym = (const bf16_t*)(ws + OFF_YMOE);
    for (int it = bid; it < T / 8; it += nb) {
        const int row = it * 8 + wid;
        const int s1 = toks[row * 2], s2 = toks[row * 2 + 1]; const float g1 = tokg[row * 2], g2 = tokg[row * 2 + 1];
        f32x4* xr = (f32x4*)(p.out + (size_t)row * D) + lane; const f32x4* gr = (const f32x4*)p.norm_final + lane;
        const u32x2* y1 = (const u32x2*)(ym + (size_t)s1 * D) + lane; const u32x2* y2 = (const u32x2*)(ym + (size_t)s2 * D) + lane;
        f32x4 v[4]; float s = 0.f;
#pragma unroll
        for (int j = 0; j < 4; ++j) {
            v[j] = xr[64 * j] + g1 * unpack4(y1[64 * j]) + g2 * unpack4(y2[64 * j]);
            s += v[j].x * v[j].x + v[j].y * v[j].y + v[j].z * v[j].z + v[j].w * v[j].w;
        }
        const float rstd = rsqrtf(wave_sum(s) * (1.f / 1024.f) + 1e-6f);
#pragma unroll
        for (int j = 0; j < 4; ++j) xr[64 * j] = v[j] * rstd * gr[64 * j];
    }
}

template <int PH>
__device__ __forceinline__ void run_phase(const P& p, int bid, int nb, char* smem) {
    char* ws = p.ws;
    if (PH == 0) phase0(p, bid, nb, smem);
    else if (PH == 1) phase1(p, bid, nb, smem);
    else if (PH == 2) { phase_kmean(p, bid, nb, smem); phase_rw_chunk(p, bid, nb, smem); }
    else if (PH == 3) {
        if (bid < 32) rw_scan(p, bid, smem);
        else { moba_select(p, bid - 32, nb - 32, smem); phase_kvx(p, bid - 32, nb - 32, smem); phase_expconv<0>(p, bid - 32, nb - 32, smem); }
    }
    else if (PH == 4) { phase_rw_out(p, bid, nb); moba_fill(p, bid, nb, smem); __syncthreads(); phase_vtrans(p, bid, nb, smem); }
    else if (PH == 5) moba_partial(p, bid, nb, smem);
    else if (PH == 6) moba_own(p, bid, nb, smem);
    else if (PH == 7) phase_merge(p, bid, nb, smem);
    else if (PH == 8) phase_resid_gemm((const bf16_t*)(ws + OFF_MRG), D, (const bf16_t*)(ws + OFF_WOUT), p.x, p.out, bid, nb, smem);
    else if (PH == 9) { phase_norm(p.out, p.norm_xattn, (bf16_t*)(ws + OFF_XN), bid, nb); phase_expconv<1>(p, bid, nb, smem); }
    else if (PH == 10) phase_qx_xattn(p, bid, nb, smem);
    else if (PH == 11) phase_resid_gemm((const bf16_t*)(ws + OFF_OB), 512, (const bf16_t*)(ws + OFF_WOX), p.out, p.out, bid, nb, smem);
    else if (PH == 12) phase_router(p, bid, nb, smem);
    else if (PH == 13) phase_dispatch(p, bid, nb, smem);
    else if (PH == 14) phase_exp1(p, bid, nb, smem);
    else if (PH == 15) phase_exp2(p, bid, nb, smem);
    else if (PH == 16) phase_final(p, bid, nb);
}

#define XB_TMO      128
#define XB_XCNT(j)  (256  + 64 * (j))
#define XB_XSUB(j)  (1280 + 64 * (j))
#define XB_XGEN(j)  (2304 + 64 * (j))
#define XB_TOP      3328
#define XB_TOPGEN   3392
#define XCD_BAR_WORDS 3456
#define XB_SPIN_CAP (1u << 18)
__device__ __forceinline__ unsigned xb_ld(unsigned* p)              { return __hip_atomic_load(p, __ATOMIC_RELAXED, __HIP_MEMORY_SCOPE_AGENT); }
__device__ __forceinline__ unsigned xb_add(unsigned* p, unsigned v) { return __hip_atomic_fetch_add(p, v, __ATOMIC_RELAXED, __HIP_MEMORY_SCOPE_AGENT); }
__device__ __forceinline__ unsigned xb_xcc_id() { return (unsigned)__builtin_amdgcn_s_getreg((3 << 11) | 20) & 0xFu; }
#define XB_SPIN(cond, bar) do { unsigned _sp = 0; while (cond) { __builtin_amdgcn_s_sleep(1); \
    if ((++_sp & 255u) == 0u) { if (xb_ld(&(bar)[XB_TMO])) break; if (_sp > XB_SPIN_CAP) { atomicAdd(&(bar)[XB_TMO], 1u); break; } } } } while (0)
struct XcdBarrier { unsigned* bar; unsigned x; volatile LAS unsigned* st; };
__device__ __forceinline__ XcdBarrier xcd_barrier_post(unsigned* bar, volatile LAS unsigned* st) {
    XcdBarrier b; b.bar = bar; b.x = xb_xcc_id(); b.st = st;
    if (threadIdx.x == 0) (void)xb_add(&bar[XB_XCNT(b.x)], 1u);
    return b;
}
__device__ __forceinline__ void xcd_barrier_complete(unsigned* bar, unsigned x, unsigned& nloc, unsigned& nx) {
    const unsigned G = gridDim.x * gridDim.y * gridDim.z;
    unsigned sum, cnt, mine, sp = 0u;
    for (;;) {
        sum = 0u; cnt = 0u; mine = 0u;
#pragma unroll
        for (unsigned j = 0; j < 16; ++j) { const unsigned c = xb_ld(&bar[XB_XCNT(j)]); sum += c; cnt += (c > 0u) ? 1u : 0u; mine = (j == x) ? c : mine; }
        if (sum == G) break;
        __builtin_amdgcn_s_sleep(1);
        if ((++sp & 255u) == 0u) { if (xb_ld(&bar[XB_TMO])) break; if (sp > XB_SPIN_CAP) { atomicAdd(&bar[XB_TMO], 1u); break; } }
    }
    nloc = mine > 0u ? mine : 1u; nx = cnt > 0u ? cnt : 1u;
}
__device__ __forceinline__ void xcd_barrier(const XcdBarrier& b) {
    asm volatile("s_waitcnt vmcnt(0)" ::: "memory");
    __syncthreads();
    if (threadIdx.x == 0) {
        unsigned* bar = b.bar;
        __builtin_amdgcn_s_waitcnt(0);
        unsigned nloc = b.st[0], nx = b.st[1];
        if (nloc == 0u) { xcd_barrier_complete(bar, b.x, nloc, nx); b.st[0] = nloc; b.st[1] = nx; }
        const unsigned old = xb_add(&bar[XB_XSUB(b.x)], 1u);
        const unsigned gen = old / nloc;
        if (old + 1u == (gen + 1u) * nloc) {
            __builtin_amdgcn_fence(__ATOMIC_RELEASE, "agent");
            asm volatile("s_waitcnt vmcnt(0)" ::: "memory");
            const unsigned og = xb_add(&bar[XB_TOP], 1u);
            const unsigned tg = og / nx;
            if (og + 1u == (tg + 1u) * nx) xb_add(&bar[XB_TOPGEN], 1u);
            else XB_SPIN(xb_ld(&bar[XB_TOPGEN]) == tg, bar);
            __builtin_amdgcn_fence(__ATOMIC_ACQUIRE, "agent");
            xb_add(&bar[XB_XGEN(b.x)], 1u);
            asm volatile("s_waitcnt vmcnt(0)" ::: "memory");
        } else {
            XB_SPIN(xb_ld(&bar[XB_XGEN(b.x)]) == gen, bar);
            __builtin_amdgcn_fence(__ATOMIC_ACQUIRE, "agent");
            asm volatile("s_waitcnt vmcnt(0)" ::: "memory");
        }
    }
    __syncthreads();
}
constexpr int L_BARST = 154112;
constexpr int LDS_BYTES = 154368;
static_assert(2 * RW_LDS <= L_BARST && pg8::STAGE_BYTES <= L_BARST && A_TST + 2052 <= L_BARST, "lds");

__global__ void __launch_bounds__(NT, 2) mega_kernel(P p) {
    extern __shared__ __attribute__((aligned(16))) char smem[];
    const int bid = blockIdx.x, nb = gridDim.x;
    volatile LAS unsigned* bst = (volatile LAS unsigned*)(LAS char*)(smem + L_BARST);
    if (threadIdx.x < 2) bst[threadIdx.x] = 0u;
    __syncthreads();
    const XcdBarrier xb = xcd_barrier_post((unsigned*)(p.ws + OFF_CTL + CTL_BAR), bst);
#define GSYNC() xcd_barrier(xb)
    run_phase<0>(p, bid, nb, smem); GSYNC();
    run_phase<1>(p, bid, nb, smem); GSYNC();
    run_phase<2>(p, bid, nb, smem); GSYNC();
    run_phase<3>(p, bid, nb, smem); GSYNC();
    run_phase<4>(p, bid, nb, smem); GSYNC();
    run_phase<5>(p, bid, nb, smem); GSYNC();
    run_phase<6>(p, bid, nb, smem); GSYNC();
    run_phase<7>(p, bid, nb, smem); GSYNC();
    run_phase<8>(p, bid, nb, smem); GSYNC();
    run_phase<9>(p, bid, nb, smem); GSYNC();
    run_phase<10>(p, bid, nb, smem); GSYNC();
    run_phase<11>(p, bid, nb, smem); GSYNC();
    run_phase<12>(p, bid, nb, smem); GSYNC();
    run_phase<13>(p, bid, nb, smem); GSYNC();
    run_phase<14>(p, bid, nb, smem); GSYNC();
    run_phase<15>(p, bid, nb, smem); GSYNC();
    run_phase<16>(p, bid, nb, smem);
}

extern "C" void kernel_launch(void* const* d_in, const int* in_sizes, int n_in, void* d_out, int out_size, void* d_ws, size_t ws_size, hipStream_t stream) {
    if (n_in != 31 || ws_size < WS_NEED || out_size != T * D) { fprintf(stderr, "kernel_launch: unexpected n_in %d / ws_size %zu / out_size %d\n", n_in, ws_size, out_size); return; }
    static int grid_blocks = 0;
    if (!grid_blocks) {
        int dev = 0, cus = 0, per_cu = 0;
        (void)hipGetDevice(&dev);
        (void)hipDeviceGetAttribute(&cus, hipDeviceAttributeMultiprocessorCount, dev);
        if (hipFuncSetAttribute((const void*)mega_kernel, hipFuncAttributeMaxDynamicSharedMemorySize, LDS_BYTES) != hipSuccess) fprintf(stderr, "kernel_launch: hipFuncSetAttribute failed\n");
        (void)hipOccupancyMaxActiveBlocksPerMultiprocessor(&per_cu, (const void*)mega_kernel, NT, LDS_BYTES);
        if (per_cu < 1) { fprintf(stderr, "kernel_launch: occupancy query returned %d\n", per_cu); per_cu = 1; }
        grid_blocks = cus;
        if (grid_blocks % 8) grid_blocks -= grid_blocks % 8;
        fprintf(stderr, "kernel_launch: cus %d per_cu %d grid %d\n", cus, per_cu, grid_blocks);
    }
    P p{};
    const float** f = (const float**)&p;
    for (int i = 0; i < 31; ++i) f[i] = (const float*)d_in[i];
    p.out = (float*)d_out; p.ws = (char*)d_ws;
    if (hipMemsetAsync((char*)d_ws + OFF_CTL + CTL_BAR, 0, XCD_BAR_WORDS * 4, stream) != hipSuccess) fprintf(stderr, "kernel_launch: memset failed\n");
    void* args[] = {&p};
    hipError_t e = hipLaunchCooperativeKernel((const void*)mega_kernel, dim3(grid_blocks), dim3(NT), args, LDS_BYTES, stream);
    if (e != hipSuccess) fprintf(stderr, "cooperative launch failed: %s (grid %d)\n", hipGetErrorString(e), grid_blocks);
}
```

```cpp
#include <hip/hip_runtime.h>
#include <cstdio>
#include <cstdint>

typedef unsigned short bf16_t;
typedef short bf16x8 __attribute__((ext_vector_type(8)));
typedef float f32x4 __attribute__((ext_vector_type(4)));
typedef float f32x2 __attribute__((ext_vector_type(2)));
typedef unsigned u32x4 __attribute__((ext_vector_type(4)));
typedef unsigned u32x2 __attribute__((ext_vector_type(2)));
typedef __bf16 bf16x2_t __attribute__((ext_vector_type(2)));
#define LAS __attribute__((address_space(3)))
#define MFMA16(a, b, c) __builtin_amdgcn_mfma_f32_16x16x32_bf16((a), (b), (c), 0, 0, 0)

constexpr int NT = 512;
constexpr int T = 16384, D = 1024, NMEM = 256;
constexpr int UMC = 1536;
constexpr int RW = 512, RCOLS = 1792, MW = 512, MCOLS = 1536, GCOLS = 2048, INCOLS = 5376;
constexpr int NEXP = 32, DEXP = 512, MBLK = 256, NBLK = 160, CAP = NBLK * MBLK;
constexpr size_t MiB = 1u << 20;
constexpr size_t OFF_CTL = 0;
constexpr size_t OFF_WIN = 1 * MiB;
constexpr size_t OFF_WORW = OFF_WIN + (size_t)INCOLS * D * 2;
constexpr size_t OFF_WOMB = OFF_WORW + 1 * MiB;
constexpr size_t OFF_WOUT = OFF_WOMB + 1 * MiB;
constexpr size_t OFF_WQ = OFF_WOUT + 2 * MiB;
constexpr size_t OFF_WKV = OFF_WQ + 1 * MiB;
constexpr size_t OFF_WOX = OFF_WKV + 2 * MiB;
constexpr size_t OFF_MEMN = OFF_WOX + 1 * MiB;
constexpr size_t OFF_KVX = OFF_MEMN + MiB / 2;
constexpr size_t OFF_ROUT = OFF_KVX + MiB / 2;
constexpr size_t OFF_LORA_D = OFF_ROUT + 160 * 1024;
constexpr size_t OFF_LORA_I = OFF_LORA_D + 64 * 1024;
constexpr size_t OFF_LORA_G = OFF_LORA_I + 64 * 1024;
constexpr size_t OFF_XN = 21 * MiB;
constexpr size_t OFF_BON = 21 * MiB;
constexpr size_t OFF_RH = 37 * MiB;
constexpr size_t OFF_UG = 53 * MiB;
constexpr size_t OFF_UR = 117 * MiB;
constexpr size_t OFF_UM = 173 * MiB;
constexpr size_t OFF_OA = 221 * MiB;
constexpr size_t OFF_OB = 237 * MiB;
constexpr size_t OFF_MRG = 253 * MiB;
constexpr size_t OFF_MF = 253 * MiB;
constexpr size_t OFF_SF = 269 * MiB;
constexpr size_t OFF_VT = 253 * MiB;
constexpr size_t OFF_EXPD = 117 * MiB;
constexpr size_t OFF_EXPGU = 149 * MiB;
constexpr size_t OFF_YMOE = 21 * MiB;
constexpr size_t OFF_MSEL = 285 * MiB;
constexpr size_t OFF_MQL = OFF_MSEL + MiB / 2;
constexpr size_t OFF_MSP = OFF_MQL + 3 * MiB / 2;
constexpr size_t WS_NEED = 293 * MiB;
static_assert(OFF_LORA_G + 128 * 1024 <= OFF_XN, "ws map");
constexpr size_t CTL_CNT = 0;
constexpr size_t CTL_BLKE = 4096;
constexpr size_t CTL_MCNT = 8192, CTL_MCUR = 10240, CTL_MLST = 12288, CTL_MTST = 14592, CTL_MCST = 16896;
constexpr size_t CTL_TOKE = 192 * 1024;
constexpr size_t CTL_TOKG = 320 * 1024;
constexpr size_t CTL_TOKS = 448 * 1024;
constexpr size_t CTL_ROWTOK = 576 * 1024;
constexpr size_t CTL_BAR = 752 * 1024;
constexpr size_t CTL_KMS = 832 * 1024;

struct P {
    const float *x, *mem, *rel_bias, *mem_norm, *norm_mix, *w_in, *tshift_mu, *decay_w0, *decay_up, *iclr_a0, *iclr_up, *gate_up,
        *k_k, *k_a, *r_k, *ln_x_w, *ln_x_b, *w_o_rwkv, *w_o_moba, *w_out, *norm_xattn, *w_q_x, *w_kv_x, *w_o_x, *norm_ffn,
        *w_router_group, *w_router_expert, *w_exp_gate, *w_exp_up, *w_exp_down, *norm_final;
    float* out;
    char* ws;
};

__device__ __forceinline__ int otid() { int t = threadIdx.x; asm volatile("" : "+v"(t)); return t; }
__device__ __forceinline__ float bf2f(bf16_t b) { return __uint_as_float((unsigned)b << 16); }
__device__ __forceinline__ unsigned f2bf(float f) { unsigned u = __float_as_uint(f); return (u + 0x7fffu + ((u >> 16) & 1u)) >> 16; }
__device__ __forceinline__ unsigned cvt_pk(float lo, float hi) { const f32x2 v = {lo, hi}; return __builtin_bit_cast(unsigned, __builtin_convertvector(v, bf16x2_t)); }
__device__ __forceinline__ unsigned pk2(float lo, float hi) { return cvt_pk(lo, hi); }
__device__ __forceinline__ u32x2 pack4(f32x4 v) { u32x2 o; o.x = cvt_pk(v.x, v.y); o.y = cvt_pk(v.z, v.w); return o; }
__device__ __forceinline__ bf16x8 pack8(f32x4 a, f32x4 b) { u32x4 o; o.x = cvt_pk(a.x, a.y); o.y = cvt_pk(a.z, a.w); o.z = cvt_pk(b.x, b.y); o.w = cvt_pk(b.z, b.w); return __builtin_bit_cast(bf16x8, o); }
__device__ __forceinline__ bf16x8 ldperm(const char* rowbase, int ks, int fq) {
    const u32x2 a = *(const u32x2*)(rowbase + (32 * ks + fq * 4) * 2), b = *(const u32x2*)(rowbase + (32 * ks + 16 + fq * 4) * 2);
    u32x4 o; o.x = a.x; o.y = a.y; o.z = b.x; o.w = b.y; return __builtin_bit_cast(bf16x8, o);
}
__device__ __forceinline__ float wave_sum(float v) {
#pragma unroll
    for (int o = 32; o >= 1; o >>= 1) v += __shfl_xor(v, o);
    return v;
}
__device__ __forceinline__ float sigm(float x) { return __builtin_amdgcn_rcpf(1.f + __expf(-x)); }
__device__ __forceinline__ void unpack8(u32x4 w, float* f) {
    f[0] = __uint_as_float(w.x << 16); f[1] = __uint_as_float(w.x & 0xffff0000u);
    f[2] = __uint_as_float(w.y << 16); f[3] = __uint_as_float(w.y & 0xffff0000u);
    f[4] = __uint_as_float(w.z << 16); f[5] = __uint_as_float(w.z & 0xffff0000u);
    f[6] = __uint_as_float(w.w << 16); f[7] = __uint_as_float(w.w & 0xffff0000u);
}
__device__ __forceinline__ f32x4 unpack4(u32x2 w) { f32x4 r; r.x = __uint_as_float(w.x << 16); r.y = __uint_as_float(w.x & 0xffff0000u); r.z = __uint_as_float(w.y << 16); r.w = __uint_as_float(w.y & 0xffff0000u); return r; }

namespace pg8 {
constexpr int BM = 256, BK = 64, HALF = 128, HTB = HALF * BK * 2  , STAGE_BYTES = 8 * HTB, NXCD = 8, WGM = 8;
__device__ __forceinline__ int lds_byte(int r, int c) { const int st = (r >> 4) * 2 + (c >> 5), rr = r & 15, cc = c & 31, ob = rr * 64 + cc * 2; return st * 1024 + (ob ^ (((ob >> 9) & 1) << 5)); }
__device__ __forceinline__ void stage_rc(int b, int& R, int& C) { const int st = b / 1024, sb = b % 1024, swz = sb ^ (((sb >> 9) & 1) << 5); R = (st >> 1) * 16 + swz / 64; C = (st & 1) * 32 + (swz % 64) / 2; }
__device__ __forceinline__ int perm32(int rho) { const int n = rho >> 4, i = rho & 15; return 8 * (i >> 2) + 4 * n + (i & 3); }
struct Unit { int pm, pn, e; };

struct StaticOrder {
    int nM, nN, nwg, G, c;
    __device__ void init(int M, int N, int G_, int c_) { nM = M / BM; nN = N / BM; nwg = nM * nN; G = G_; c = c_; }
    __device__ bool next(int i, Unit& u) const {
        const long L = (long)i * G + c; if (L >= nwg) return false;
        int wgid = (int)L; { const int q = nwg / NXCD, r = nwg % NXCD, xcd = wgid % NXCD, off = wgid / NXCD; wgid = (xcd < r ? xcd * (q + 1) : r * (q + 1) + (xcd - r) * q) + off; }
        const int nig = WGM * nN, gid = wgid / nig, fm = gid * WGM, gsz = (nM - fm) < WGM ? (nM - fm) : WGM;
        u.pm = fm + ((wgid % nig) % gsz); u.pn = (wgid % nig) / gsz; u.e = 0; return true;
    }
    __device__ __forceinline__ unsigned rowA(const Unit& u, int r) const { return (unsigned)(u.pm * BM + r); }
    __device__ __forceinline__ unsigned rowB(const Unit& u, int r) const { return (unsigned)(u.pn * BM + r); }
};

template <class Epi, class Sched, bool ALIGN_EPI>
__device__ __forceinline__ void gemm_phase(LAS unsigned char* lds, const bf16_t* Ab, const bf16_t* Bb, const int K, const Sched& S, const Epi& E) {
    const int tid = otid(), wid = __builtin_amdgcn_readfirstlane(tid >> 6), lane = tid & 63, wr = wid >> 2, wc = wid & 3, fr = lane & 15, fq = lane >> 4;
    const int nt = K / BK;
    int sR[2], sC[2], sRb[2];
#pragma unroll
    for (int i = 0; i < 2; ++i) { int R, C; stage_rc(tid * 16 + i * 8192, R, C); sR[i] = R; sC[i] = C; sRb[i] = Epi::PERM ? ((R & ~31) + perm32(R & 31)) : R; }
    const unsigned kstep = (unsigned)(BK * 2);
    const unsigned ldsw = (unsigned)wid * 1024u;
    const int aoff = lds_byte(wr * 64 + fr, fq * 8), boff = lds_byte(wc * 32 + fr, fq * 8);
#define PG8_SA(b, h) (((b) * 2 + (h)) * HTB)
#define PG8_SB(b, h) ((4 + (b) * 2 + (h)) * HTB)
#define PG8_STAGE(bufoff, gbase, offs, kb) do { _Pragma("unroll") for (int _i = 0; _i < 2; ++_i) \
        __builtin_amdgcn_global_load_lds((const unsigned*)((const char*)(gbase) + (size_t)((offs)[_i] + (kb))), (LAS unsigned*)(lds + (bufoff) + ldsw + _i * 8192), 16, 0, 0); } while (0)
#define PG8_LDA(dst, b, h) do { _Pragma("unroll") for (int m = 0; m < 4; ++m) _Pragma("unroll") for (int k = 0; k < 2; ++k) dst[m][k] = *(const LAS bf16x8*)(lds + PG8_SA(b, h) + aoff + m * 2048 + k * 1024); } while (0)
#define PG8_LDB(dst, b, h) do { _Pragma("unroll") for (int n = 0; n < 2; ++n) _Pragma("unroll") for (int k = 0; k < 2; ++k) dst[n][k] = *(const LAS bf16x8*)(lds + PG8_SB(b, h) + boff + n * 2048 + k * 1024); } while (0)
#define PG8_MMA(ai, bj, At, Bt) do { __builtin_amdgcn_s_setprio(1); _Pragma("unroll") for (int m = 0; m < 4; ++m) _Pragma("unroll") for (int n = 0; n < 2; ++n) _Pragma("unroll") for (int k = 0; k < 2; ++k) \
        acc[ai][bj][m][n] = __builtin_amdgcn_mfma_f32_16x16x32_bf16(Bt[n][k], At[m][k], acc[ai][bj][m][n], 0, 0, 0); __builtin_amdgcn_s_setprio(0); } while (0)
#define PG8_WAIT_V(n) asm volatile("s_waitcnt vmcnt(" #n ")" ::: "memory")
#define PG8_WAIT_L(n) asm volatile("s_waitcnt lgkmcnt(" #n ")" ::: "memory")
#define PG8_BAR __builtin_amdgcn_s_barrier()
#define PG8_SCHED __builtin_amdgcn_sched_barrier(0)
#define PG8_OFFS(u, AO, BO) do { _Pragma("unroll") for (int _h = 0; _h < 2; ++_h) _Pragma("unroll") for (int _i = 0; _i < 2; ++_i) { \
        AO[_h][_i] = (S.rowA(u, _h * HALF + sR[_i]) * (unsigned)K + (unsigned)sC[_i]) * 2u; BO[_h][_i] = (S.rowB(u, _h * HALF + sRb[_i]) * (unsigned)K + (unsigned)sC[_i]) * 2u; } } while (0)
    Unit cur, nxt; int ui = 0;
    if (!S.next(0, cur)) return;
    f32x4 acc[2][2][4][2];
#pragma unroll
    for (int a = 0; a < 2; ++a)
#pragma unroll
        for (int b = 0; b < 2; ++b)
#pragma unroll
            for (int m = 0; m < 4; ++m)
#pragma unroll
                for (int n = 0; n < 2; ++n) acc[a][b][m][n] = (f32x4){0.f, 0.f, 0.f, 0.f};
    bf16x8 At[4][2], B0[2][2], B1[2][2];
    unsigned ao[2][2], bo[2][2], nao[2][2], nbo[2][2];
    PG8_OFFS(cur, ao, bo);
    PG8_STAGE(PG8_SB(0, 0), Bb, bo[0], 0u); PG8_STAGE(PG8_SB(0, 1), Bb, bo[1], 0u); PG8_STAGE(PG8_SA(0, 0), Ab, ao[0], 0u); PG8_STAGE(PG8_SA(0, 1), Ab, ao[1], 0u);
    if (wr == 1) PG8_BAR;
    PG8_WAIT_V(2); PG8_BAR;
    PG8_STAGE(PG8_SB(1, 0), Bb, bo[0], kstep); PG8_STAGE(PG8_SA(1, 0), Ab, ao[0], kstep); PG8_STAGE(PG8_SB(1, 1), Bb, bo[1], kstep);
    PG8_WAIT_V(6); PG8_BAR;
    for (;;) {
        const bool has_next = S.next(ui + 1, nxt);
        if (has_next) { PG8_OFFS(nxt, nao, nbo); }
        else {
#pragma unroll
            for (int h = 0; h < 2; ++h)
#pragma unroll
                for (int i = 0; i < 2; ++i) { nao[h][i] = ao[h][i]; nbo[h][i] = bo[h][i]; }
        }
        for (int t = 0; t < nt; t += 2) {
            const bool last = (t == nt - 2);
            const unsigned k1 = (unsigned)(t + 1) * kstep, k2 = last ? 0u : (unsigned)(t + 2) * kstep, k3 = k2 + kstep;
            unsigned a2[2][2], b2[2][2];
#pragma unroll
            for (int h = 0; h < 2; ++h)
#pragma unroll
                for (int i = 0; i < 2; ++i) { a2[h][i] = last ? nao[h][i] : ao[h][i]; b2[h][i] = last ? nbo[h][i] : bo[h][i]; }
            PG8_LDB(B0, 0, 0); PG8_LDB(B1, 0, 1); PG8_SCHED; PG8_LDA(At, 0, 0); PG8_STAGE(PG8_SA(1, 1), Ab, ao[1], k1);
            PG8_WAIT_V(8); PG8_WAIT_L(0); PG8_BAR; PG8_MMA(0, 0, At, B0); PG8_MMA(0, 1, At, B1); PG8_BAR; PG8_SCHED;
            PG8_LDA(At, 0, 1); PG8_STAGE(PG8_SB(0, 0), Bb, b2[0], k2); PG8_STAGE(PG8_SB(0, 1), Bb, b2[1], k2); PG8_STAGE(PG8_SA(0, 0), Ab, a2[0], k2);
            PG8_WAIT_V(8); PG8_WAIT_L(0); PG8_BAR; PG8_MMA(1, 0, At, B0); PG8_MMA(1, 1, At, B1); PG8_BAR; PG8_SCHED;
            PG8_LDB(B0, 1, 0); PG8_LDB(B1, 1, 1); PG8_SCHED; PG8_LDA(At, 1, 0); PG8_STAGE(PG8_SA(0, 1), Ab, a2[1], k2);
            PG8_WAIT_V(8); PG8_WAIT_L(0); PG8_BAR; PG8_MMA(0, 0, At, B0); PG8_MMA(0, 1, At, B1); PG8_BAR; PG8_SCHED;
            PG8_LDA(At, 1, 1); PG8_STAGE(PG8_SB(1, 0), Bb, b2[0], k3); PG8_STAGE(PG8_SB(1, 1), Bb, b2[1], k3); PG8_STAGE(PG8_SA(1, 0), Ab, a2[0], k3);
            PG8_WAIT_V(8); PG8_WAIT_L(0); PG8_BAR; PG8_MMA(1, 0, At, B0); PG8_MMA(1, 1, At, B1); PG8_BAR; PG8_SCHED;
        }
        if constexpr (ALIGN_EPI) { if (wr == 0) PG8_BAR; }
        E(acc, cur, wr, wc, fr, fq);
        if (!has_next) break;
#pragma unroll
        for (int a = 0; a < 2; ++a)
#pragma unroll
            for (int b = 0; b < 2; ++b)
#pragma unroll
                for (int m = 0; m < 4; ++m)
#pragma unroll
                    for (int n = 0; n < 2; ++n) acc[a][b][m][n] = (f32x4){0.f, 0.f, 0.f, 0.f};
        cur = nxt; ++ui;
#pragma unroll
        for (int h = 0; h < 2; ++h)
#pragma unroll
            for (int i = 0; i < 2; ++i) { ao[h][i] = nao[h][i]; bo[h][i] = nbo[h][i]; }
        if constexpr (ALIGN_EPI) { if (wr == 1) PG8_BAR; }
    }
    PG8_WAIT_V(0);
    if constexpr (!ALIGN_EPI) { if (wr == 0) PG8_BAR; }
    PG8_BAR;
#undef PG8_SA
#undef PG8_SB
#undef PG8_STAGE
#undef PG8_LDA
#undef PG8_LDB
#undef PG8_MMA
#undef PG8_WAIT_V
#undef PG8_WAIT_L
#undef PG8_BAR
#undef PG8_SCHED
#undef PG8_OFFS
}
}

__device__ __forceinline__ void gemm_r32(f32x4 (&acc)[2][8], const bf16_t* A, int lda, int brow, const bf16_t* Bt, int ldb, int bcol, int K, char* smem) {
    const int tid = otid(), lane = tid & 63, wid = tid >> 6, fr = lane & 15, fq = lane >> 4;
    const int r0 = tid >> 3, lch = (tid & 7) ^ ((tid >> 4) & 7);
    const bf16_t* pa[4]; const bf16_t* pb[2];
#pragma unroll
    for (int i = 0; i < 4; ++i) pa[i] = A + (long)(brow + r0 + 64 * i) * lda + lch * 8;
#pragma unroll
    for (int i = 0; i < 2; ++i) pb[i] = Bt + (long)(bcol + r0 + 64 * i) * ldb + lch * 8;
    const int nk = K / 64;
#pragma unroll
    for (int i = 0; i < 4; ++i) __builtin_amdgcn_global_load_lds((const unsigned*)pa[i], (unsigned*)(smem + tid * 16 + i * 8192), 16, 0, 0);
#pragma unroll
    for (int i = 0; i < 2; ++i) __builtin_amdgcn_global_load_lds((const unsigned*)pb[i], (unsigned*)(smem + 32768 + tid * 16 + i * 8192), 16, 0, 0);
    const int sw = fr >> 1;
    for (int kt = 0; kt < nk; ++kt) {
        asm volatile("s_waitcnt vmcnt(0)" ::: "memory");
        __syncthreads();
        char* cur = smem + (kt & 1) * 49152;
        if (kt + 1 < nk) {
            char* nx = smem + ((kt + 1) & 1) * 49152;
#pragma unroll
            for (int i = 0; i < 4; ++i) __builtin_amdgcn_global_load_lds((const unsigned*)(pa[i] + (kt + 1) * 64), (unsigned*)(nx + tid * 16 + i * 8192), 16, 0, 0);
#pragma unroll
            for (int i = 0; i < 2; ++i) __builtin_amdgcn_global_load_lds((const unsigned*)(pb[i] + (kt + 1) * 64), (unsigned*)(nx + 32768 + tid * 16 + i * 8192), 16, 0, 0);
        }
#pragma unroll
        for (int ks = 0; ks < 2; ++ks) {
            const int pc = ((ks * 4 + fq) ^ sw) * 16;
            bf16x8 At[2], Bf[8];
#pragma unroll
            for (int m = 0; m < 2; ++m) At[m] = *(const bf16x8*)(cur + (wid * 32 + m * 16 + fr) * 128 + pc);
#pragma unroll
            for (int n = 0; n < 8; ++n) Bf[n] = *(const bf16x8*)(cur + 32768 + (n * 16 + fr) * 128 + pc);
#pragma unroll
            for (int m = 0; m < 2; ++m)
#pragma unroll
                for (int n = 0; n < 8; ++n) acc[m][n] = MFMA16(Bf[n], At[m], acc[m][n]);
        }
    }
    __syncthreads();
}

__device__ __forceinline__ void transpose_tile(const float* W, int K, int N, bf16_t* Wt, int rs, int roff, int tile, float* scr  ) {
    const int tid = otid();
    const int nnb = N / 128, kb = tile / nnb, nb = tile % nnb, k0 = kb * 64, n0 = nb * 128;
#pragma unroll 4
    for (int i = 0; i < 16; ++i) { const int k = i * 4 + (tid >> 7), n = tid & 127; scr[k * 129 + n] = W[(size_t)(k0 + k) * N + n0 + n]; }
    __syncthreads();
#pragma unroll
    for (int i = 0; i < 2; ++i) {
        const int c = tid + i * 512, n = c >> 3, kc = c & 7;
        const float* s = scr + (kc * 8) * 129 + n;
        u32x4 o; o.x = pk2(s[0], s[129]); o.y = pk2(s[2 * 129], s[3 * 129]); o.z = pk2(s[4 * 129], s[5 * 129]); o.w = pk2(s[6 * 129], s[7 * 129]);
        const int nn = n0 + n, drow = (nn >> 4) * rs + (nn & 15) + roff;
        *(u32x4*)(Wt + (size_t)drow * K + k0 + kc * 8) = o;
    }
    __syncthreads();
}
__device__ __forceinline__ void rms_row_bf16(const float* xrow, const float* g, bf16_t* orow, int lane) {
    const f32x4* xr = (const f32x4*)xrow + lane; const f32x4* gr = (const f32x4*)g + lane;
    f32x4 v[4]; float s = 0.f;
#pragma unroll
    for (int j = 0; j < 4; ++j) { v[j] = xr[64 * j]; s += v[j].x * v[j].x + v[j].y * v[j].y + v[j].z * v[j].z + v[j].w * v[j].w; }
    const float rstd = rsqrtf(wave_sum(s) * (1.f / 1024.f) + 1e-6f);
    u32x2* o8 = (u32x2*)orow + lane;
#pragma unroll
    for (int j = 0; j < 4; ++j) { const f32x4 gg = gr[64 * j]; u32x2 o; o.x = pk2(v[j].x * rstd * gg.x, v[j].y * rstd * gg.y); o.y = pk2(v[j].z * rstd * gg.z, v[j].w * rstd * gg.w); o8[64 * j] = o; }
}
constexpr int P0_T_IN = 16 * 42, P0_T_A = 64, P0_T_B = 128, P0_T_L = 4 + 4 + 8;
constexpr int P0_TR = P0_T_IN + 4 * P0_T_A + 2 * P0_T_B + P0_T_L;
constexpr int P0_ROUT = 72, P0_NORM = T / 8, P0_MEM = NMEM / 8;
constexpr int P0_ITEMS = P0_TR + P0_ROUT + P0_NORM + P0_MEM + 1;
__device__ __forceinline__ void phase0(const P& p, int bid, int nb, char* smem) {
    const int tid = otid(), lane = tid & 63, wid = tid >> 6;
    char* ws = p.ws;
    for (int i = bid * NT + tid; i < 64 * 512; i += nb * NT) ((float*)(ws + OFF_CTL + CTL_KMS))[i] = 0.f;
    for (int it = bid; it < P0_ITEMS; it += nb) {
        int r = it;
        if (r < P0_TR) {
            float* scr = (float*)smem;
            if (r < P0_T_IN) { transpose_tile(p.w_in, D, INCOLS, (bf16_t*)(ws + OFF_WIN), 16, 0, r, scr); continue; } r -= P0_T_IN;
            if (r < P0_T_A) { transpose_tile(p.w_o_rwkv, RW, D, (bf16_t*)(ws + OFF_WORW), 16, 0, r, scr); continue; } r -= P0_T_A;
            if (r < P0_T_A) { transpose_tile(p.w_o_moba, MW, D, (bf16_t*)(ws + OFF_WOMB), 16, 0, r, scr); continue; } r -= P0_T_A;
            if (r < P0_T_B) { transpose_tile(p.w_out, D, D, (bf16_t*)(ws + OFF_WOUT), 16, 0, r, scr); continue; } r -= P0_T_B;
            if (r < P0_T_A) { transpose_tile(p.w_q_x, D, 512, (bf16_t*)(ws + OFF_WQ), 16, 0, r, scr); continue; } r -= P0_T_A;
            if (r < P0_T_B) { transpose_tile(p.w_kv_x, D, D, (bf16_t*)(ws + OFF_WKV), 16, 0, r, scr); continue; } r -= P0_T_B;
            if (r < P0_T_A) { transpose_tile(p.w_o_x, 512, D, (bf16_t*)(ws + OFF_WOX), 16, 0, r, scr); continue; } r -= P0_T_A;
            if (r < 4) { transpose_tile(p.decay_up, 64, 512, (bf16_t*)(ws + OFF_LORA_D), 16, 0, r, scr); continue; } r -= 4;
            if (r < 4) { transpose_tile(p.iclr_up, 64, 512, (bf16_t*)(ws + OFF_LORA_I), 16, 0, r, scr); continue; } r -= 4;
            transpose_tile(p.gate_up, 128, 512, (bf16_t*)(ws + OFF_LORA_G), 16, 0, r, scr); continue;
        }
        r -= P0_TR;
        if (r < P0_ROUT) {
            const int e = r * 512 + tid, o = e >> 10, k = e & 1023;
            float* rt = (float*)(ws + OFF_ROUT);
            rt[e] = (o < 32) ? p.w_router_expert[k * 32 + o] : p.w_router_group[k * 4 + (o - 32)];
            continue;
        }
        r -= P0_ROUT;
        if (r < P0_NORM) { const int row = r * 8 + wid; rms_row_bf16(p.x + (size_t)row * D, p.norm_mix, (bf16_t*)(ws + OFF_XN) + (size_t)row * D, lane); continue; }
        r -= P0_NORM;
        if (r < P0_MEM) { const int row = r * 8 + wid; rms_row_bf16(p.mem + (size_t)row * D, p.mem_norm, (bf16_t*)(ws + OFF_MEMN) + (size_t)row * D, lane); continue; }
        if (tid < 64) ((int*)(ws + OFF_CTL + CTL_CNT))[tid] = 0;
        for (int i = tid; i < 1024; i += NT) ((int*)(ws + OFF_CTL + CTL_MCNT))[i] = 0;
    }
}

struct EpiU {
    static constexpr bool PERM = true;
    char* ws;
    __device__ __forceinline__ void operator()(const f32x4 (&acc)[2][2][4][2], const pg8::Unit& u, int wr, int wc, int fr, int fq) const {
        const int colt = u.pn * 256;
        bf16_t* dst; int ld, cb; bool sg = false;
        if (colt < RCOLS) { dst = (bf16_t*)(ws + OFF_UR); ld = RCOLS; cb = colt; }
        else if (colt < RCOLS + MCOLS) { dst = (bf16_t*)(ws + OFF_UM); ld = UMC; cb = colt - RCOLS; }
        else { dst = (bf16_t*)(ws + OFF_UG); ld = GCOLS; cb = colt - RCOLS - MCOLS; sg = true; }
        const int row0 = u.pm * 256 + wr * 64 + fr, col0 = cb + wc * 32 + 8 * fq;
#pragma unroll
        for (int ai = 0; ai < 2; ++ai)
#pragma unroll
            for (int m = 0; m < 4; ++m) {
                bf16_t* rowp = dst + (size_t)(row0 + ai * 128 + m * 16) * ld + col0;
#pragma unroll
                for (int bj = 0; bj < 2; ++bj) {
                    f32x4 v0 = acc[ai][bj][m][0], v1 = acc[ai][bj][m][1];
                    if (sg) { v0.x = sigm(v0.x); v0.y = sigm(v0.y); v0.z = sigm(v0.z); v0.w = sigm(v0.w); v1.x = sigm(v1.x); v1.y = sigm(v1.y); v1.z = sigm(v1.z); v1.w = sigm(v1.w); }
                    u32x4 w; w.x = cvt_pk(v0.x, v0.y); w.y = cvt_pk(v0.z, v0.w); w.z = cvt_pk(v1.x, v1.y); w.w = cvt_pk(v1.z, v1.w);
                    *(u32x4*)(rowp + bj * 128) = w;
                }
            }
        if (colt >= RCOLS + 512 && colt < RCOLS + 1024) {
            float* kms = (float*)(ws + OFF_CTL + CTL_KMS) + (size_t)u.pm * 512 + (colt - RCOLS - 512) + wc * 32 + 8 * fq;
#pragma unroll
            for (int bj = 0; bj < 2; ++bj)
#pragma unroll
                for (int n = 0; n < 2; ++n) {
                    f32x4 sv = {0.f, 0.f, 0.f, 0.f};
#pragma unroll
                    for (int ai = 0; ai < 2; ++ai)
#pragma unroll
                        for (int m = 0; m < 4; ++m) sv = sv + acc[ai][bj][m][n];
#pragma unroll
                    for (int o = 1; o < 16; o <<= 1) { sv.x += __shfl_xor(sv.x, o); sv.y += __shfl_xor(sv.y, o); sv.z += __shfl_xor(sv.z, o); sv.w += __shfl_xor(sv.w, o); }
                    if (fr == 0) { float* d = kms + bj * 128 + 4 * n; atomicAdd(d, sv.x); atomicAdd(d + 1, sv.y); atomicAdd(d + 2, sv.z); atomicAdd(d + 3, sv.w); }
                }
        }
    }
};
__device__ __forceinline__ void phase1(const P& p, int bid, int nb, char* smem) {
    pg8::StaticOrder S; S.init(T, INCOLS, nb, bid);
    EpiU E{p.ws};
    pg8::gemm_phase<EpiU, pg8::StaticOrder, true>((LAS unsigned char*)smem, (const bf16_t*)(p.ws + OFF_XN), (const bf16_t*)(p.ws + OFF_WIN), D, S, E);
}

__device__ __forceinline__ void phase_vtrans(const P& p, int bid, int nb, char* smem) {
    const int tid = otid();
    const bf16_t* um = (const bf16_t*)(p.ws + OFF_UM); bf16_t* vt = (bf16_t*)(p.ws + OFF_VT);
    for (int it = bid; it < 256 * 4; it += nb) {
        const int tt = it >> 2, cq = it & 3, t0 = tt * 64, c0 = cq * 128;
#pragma unroll
        for (int i = 0; i < 2; ++i) { const int c = tid + i * 512, r = c >> 4, ch = c & 15; *(u32x4*)(smem + r * 272 + ch * 16) = *(const u32x4*)(um + (size_t)(t0 + r) * UMC + 1024 + c0 + ch * 8); }
        __syncthreads();
#pragma unroll
        for (int i = 0; i < 2; ++i) {
            const int c = tid + i * 512, col = c >> 3, tc = c & 7;
            unsigned short e[8];
#pragma unroll
            for (int j = 0; j < 8; ++j) e[j] = *(const unsigned short*)(smem + (tc * 8 + j) * 272 + col * 2);
            u32x4 o; o.x = e[0] | ((unsigned)e[1] << 16); o.y = e[2] | ((unsigned)e[3] << 16); o.z = e[4] | ((unsigned)e[5] << 16); o.w = e[6] | ((unsigned)e[7] << 16);
            *(u32x4*)(vt + (size_t)(c0 + col) * T + t0 + tc * 8) = o;
        }
        __syncthreads();
    }
}

constexpr int SLOT = 9216, ROWB = 144, LIN_ROWB = 528;
constexpr int L_WL = 0 * SLOT, L_AL = 1 * SLOT, L_LIN = 2 * SLOT, L_AT = 2 * SLOT, L_BT = 3 * SLOT, L_KT = 4 * SLOT, L_RT = 5 * SLOT, L_VT = 6 * SLOT, L_ATT = 7 * SLOT;
constexpr int L_AAB = L_AT, L_AKV = L_BT, L_BBT = L_WL, L_KBT = L_AL, L_TD = L_KT;
constexpr int L_WTOT = 8 * SLOT, L_WC = L_WTOT + 1024, L_PAR = L_WC + 256, RW_LDS = L_PAR + 2048;

typedef float f32x2 __attribute__((ext_vector_type(2)));
template <int TT> struct SolveRow {
    static __device__ __forceinline__ void run(f32x2 (&x)[32], const char* Lb, const u32x4 (&lcur)[8]) {
        u32x4 lnext[8];
        constexpr int NCN = (TT + 1 < 64) ? (TT / 8 + 1) : 0;
#pragma unroll
        for (int c8 = 0; c8 < 8; ++c8) if (c8 < NCN) lnext[c8] = *(const u32x4*)(Lb + (TT + 1) * 144 + c8 * 16); else lnext[c8] = (u32x4){0u, 0u, 0u, 0u};
        f32x2 a0 = {0.f, 0.f}, a1 = {0.f, 0.f}, a2 = {0.f, 0.f}, a3 = {0.f, 0.f};
#pragma unroll
        for (int c8 = 0; c8 <= (TT - 1) / 8; ++c8) {
            const u32x4 lv = lcur[c8];
            f32x2 l0, l1, l2, l3;
            l0.x = __uint_as_float(lv.x << 16); l0.y = __uint_as_float(lv.x & 0xffff0000u);
            l1.x = __uint_as_float(lv.y << 16); l1.y = __uint_as_float(lv.y & 0xffff0000u);
            l2.x = __uint_as_float(lv.z << 16); l2.y = __uint_as_float(lv.z & 0xffff0000u);
            l3.x = __uint_as_float(lv.w << 16); l3.y = __uint_as_float(lv.w & 0xffff0000u);
            a0 = l0 * x[c8 * 4 + 0] + a0; a1 = l1 * x[c8 * 4 + 1] + a1; a2 = l2 * x[c8 * 4 + 2] + a2; a3 = l3 * x[c8 * 4 + 3] + a3;
        }
        a0 = (a0 + a1) + (a2 + a3);
        const float r = a0.x + a0.y;
        if (TT & 1) x[TT / 2].y += r; else x[TT / 2].x += r;
        asm volatile("" : "+v"(x[TT / 2]) :: "memory");
        SolveRow<TT + 1>::run(x, Lb, lnext);
    }
};
template <> struct SolveRow<64> { static __device__ __forceinline__ void run(f32x2 (&)[32], const char*, const u32x4 (&)[8]) {} };

__device__ __forceinline__ void load_shift16(const bf16_t* ur, int row, int col, const float* mu, float* out) {
    const u32x4* cp = (const u32x4*)(ur + (size_t)row * RCOLS + col);
    const u32x4 c0 = cp[0], c1 = cp[1];
    u32x4 p0 = {0u, 0u, 0u, 0u}, p1 = {0u, 0u, 0u, 0u};
    if (row > 0) { const u32x4* pp = (const u32x4*)(ur + (size_t)(row - 1) * RCOLS + col); p0 = pp[0]; p1 = pp[1]; }
    float cf[16], pf[16];
    unpack8(c0, cf); unpack8(c1, cf + 8); unpack8(p0, pf); unpack8(p1, pf + 8);
#pragma unroll
    for (int e = 0; e < 16; ++e) out[e] = cf[e] + mu[col + e] * (pf[e] - cf[e]);
}

__device__ __forceinline__ void phase_rw_chunk(const P& p, int bid, int nb, char* smem0) {
    char* ws = p.ws;
    const bf16_t* ur = (const bf16_t*)(ws + OFF_UR);
    bf16_t* G = (bf16_t*)(ws + OFF_OA); bf16_t* BON = (bf16_t*)(ws + OFF_BON); bf16_t* RH = (bf16_t*)(ws + OFF_RH);
    float* YL = p.out; f32x4* NF = (f32x4*)(p.out + (size_t)T * 512);
    u32x4* MF = (u32x4*)(ws + OFF_MF);
    int hpar = -1;
    for (int itb = bid * 2; itb < 2048; itb += nb * 2) {
        const int tid5 = otid();
        const int half = __builtin_amdgcn_readfirstlane(tid5 >> 8), tid = tid5 & 255;
        char* smem = smem0 + half * RW_LDS;
        float* wtot = (float*)(smem + L_WTOT); float* WCs = (float*)(smem + L_WC);
        int c, h;
        if ((1024 % nb) == 0 && nb <= 256) { const int pr = itb >> 1; c = (pr % nb) + nb * (pr / (4 * nb)); h = ((pr / nb) & 3) * 2 + half; }
        else { const int it = itb + half; c = it >> 3; h = it & 7; }
        const int lane = tid & 63, w = __builtin_amdgcn_readfirstlane(tid >> 6), fr = lane & 15, fq = lane >> 4;
        if (h != hpar) {
            float* par = (float*)(smem + L_PAR);
            if (tid < 64) {
                const int hj = h * 64 + tid;
                par[tid] = p.decay_w0[hj]; par[64 + tid] = p.iclr_a0[hj]; par[128 + tid] = p.k_k[hj]; par[192 + tid] = p.k_a[hj]; par[256 + tid] = p.r_k[hj];
                par[320 + tid] = p.tshift_mu[hj]; par[384 + tid] = p.tshift_mu[512 + hj]; par[448 + tid] = p.tshift_mu[1024 + hj];
            }
            hpar = h;
        }
        u32x4 rawc[3][2], rawp[3][2];
        {
            const int row = c * 64 + (tid >> 2), hj0 = h * 64 + (tid & 3) * 16;
#pragma unroll
            for (int q3 = 0; q3 < 3; ++q3) {
                const u32x4* cp = (const u32x4*)(ur + (size_t)row * RCOLS + q3 * 512 + hj0);
                rawc[q3][0] = cp[0]; rawc[q3][1] = cp[1];
                rawp[q3][0] = (u32x4){0u, 0u, 0u, 0u}; rawp[q3][1] = rawp[q3][0];
                if (row > 0) { const u32x4* pp = (const u32x4*)(ur + (size_t)(row - 1) * RCOLS + q3 * 512 + hj0); rawp[q3][0] = pp[0]; rawp[q3][1] = pp[1]; }
            }
        }
        {
            const int cc = tid & 31, col = 1536 + cc * 8, t0 = tid >> 5;
            u32x4 cur[8], prv[8];
#pragma unroll
            for (int i = 0; i < 8; ++i) {
                const int row = c * 64 + t0 + 8 * i;
                cur[i] = *(const u32x4*)(ur + (size_t)row * RCOLS + col);
                prv[i] = (u32x4){0u, 0u, 0u, 0u};
                if (row > 0) prv[i] = *(const u32x4*)(ur + (size_t)(row - 1) * RCOLS + col);
            }
            const float nsc = cc < 8 ? 2.f : 1.f, na = cc < 8 ? 2.f : 1.f, nbb = cc < 8 ? -1.f : 0.f;
            const f32x4 mu0 = *(const f32x4*)(p.tshift_mu + col), mu1 = *(const f32x4*)(p.tshift_mu + col + 4);
            const float mu[8] = {mu0.x, mu0.y, mu0.z, mu0.w, mu1.x, mu1.y, mu1.z, mu1.w};
#pragma unroll
            for (int i = 0; i < 8; ++i) {
                float cf[8], pf[8], xs[8];
                unpack8(cur[i], cf); unpack8(prv[i], pf);
#pragma unroll
                for (int e = 0; e < 8; ++e) {
                    const float x = cf[e] + mu[e] * (pf[e] - cf[e]);
                    const float y = sigm(nsc * x);
                    xs[e] = (cc >= 8 && cc < 16) ? x : na * y + nbb;
                }
                u32x4 o; o.x = cvt_pk(xs[0], xs[1]); o.y = cvt_pk(xs[2], xs[3]); o.z = cvt_pk(xs[4], xs[5]); o.w = cvt_pk(xs[6], xs[7]);
                *(u32x4*)(smem + L_LIN + (t0 + 8 * i) * LIN_ROWB + cc * 16) = o;
            }
        }
        __syncthreads();
        {
            const bf16_t* dT = (const bf16_t*)(ws + OFF_LORA_D) + (size_t)(h * 64 + w * 16 + fr) * 64 + fq * 8;
            const bf16_t* iT = (const bf16_t*)(ws + OFF_LORA_I) + (size_t)(h * 64 + w * 16 + fr) * 64 + fq * 8;
            const bf16_t* gT = (const bf16_t*)(ws + OFF_LORA_G) + (size_t)(h * 64 + w * 16 + fr) * 128 + fq * 8;
            bf16x8 wd[2], wi[2], wg[4];
#pragma unroll
            for (int ks = 0; ks < 2; ++ks) { wd[ks] = *(const bf16x8*)(dT + ks * 32); wi[ks] = *(const bf16x8*)(iT + ks * 32); }
#pragma unroll
            for (int ks = 0; ks < 4; ++ks) wg[ks] = *(const bf16x8*)(gT + ks * 32);
#pragma unroll
            for (int tt = 0; tt < 4; ++tt) {
                const char* lrow = smem + L_LIN + (tt * 16 + fr) * LIN_ROWB + fq * 16;
                f32x4 aw = {0.f, 0.f, 0.f, 0.f}, aa = aw, ag = aw;
#pragma unroll
                for (int ks = 0; ks < 2; ++ks) {
                    aw = MFMA16(wd[ks], *(const bf16x8*)(lrow + ks * 64), aw);
                    aa = MFMA16(wi[ks], *(const bf16x8*)(lrow + 128 + ks * 64), aa);
                }
#pragma unroll
                for (int ks = 0; ks < 4; ++ks) ag = MFMA16(wg[ks], *(const bf16x8*)(lrow + 256 + ks * 64), ag);
                *(u32x2*)(smem + L_WL + (tt * 16 + fr) * ROWB + (w * 16 + fq * 4) * 2) = pack4(aw);
                *(u32x2*)(smem + L_AL + (tt * 16 + fr) * ROWB + (w * 16 + fq * 4) * 2) = pack4(aa);
                *(u32x2*)(G + (size_t)(c * 64 + tt * 16 + fr) * 512 + h * 64 + w * 16 + fq * 4) = pack4(ag);
            }
        }
        __syncthreads();
        {
            const int t = tid >> 2, jq = tid & 3, j0 = jq * 16, hj0 = h * 64 + j0, row = c * 64 + t;
            const float* par = (const float*)(smem + L_PAR) + j0;
            float ai[16], kk[16], k2[16], rr[16];
            {
                float al[16];
                const u32x4* ap = (const u32x4*)(smem + L_AL + t * ROWB + j0 * 2);
                unpack8(ap[0], al); unpack8(ap[1], al + 8);
#pragma unroll
                for (int e = 0; e < 16; ++e) ai[e] = sigm(par[64 + e] + al[e]);
            }
            float ss = 0.f, rk = 0.f;
            {
                float cf[16], pf[16];
                unpack8(rawc[1][0], cf); unpack8(rawc[1][1], cf + 8); unpack8(rawp[1][0], pf); unpack8(rawp[1][1], pf + 8);
#pragma unroll
                for (int e = 0; e < 16; ++e) { const float k = cf[e] + par[384 + e] * (pf[e] - cf[e]); kk[e] = k * par[128 + e]; ss += kk[e] * kk[e]; k2[e] = k * (1.f + (ai[e] - 1.f) * par[192 + e]); }
            }
            ss += __shfl_xor(ss, 1); ss += __shfl_xor(ss, 2);
            const float inv = rsqrtf(ss + 1e-12f);
            {
                float cf[16], pf[16];
                unpack8(rawc[0][0], cf); unpack8(rawc[0][1], cf + 8); unpack8(rawp[0][0], pf); unpack8(rawp[0][1], pf + 8);
#pragma unroll
                for (int e = 0; e < 16; ++e) { rr[e] = cf[e] + par[320 + e] * (pf[e] - cf[e]); rk += rr[e] * k2[e] * par[256 + e]; }
            }
            rk += __shfl_xor(rk, 1); rk += __shfl_xor(rk, 2);
            {
                float cf[16], pf[16], v[16];
                unpack8(rawc[2][0], cf); unpack8(rawc[2][1], cf + 8); unpack8(rawp[2][0], pf); unpack8(rawp[2][1], pf + 8);
#pragma unroll
                for (int e = 0; e < 16; ++e) { v[e] = cf[e] + par[448 + e] * (pf[e] - cf[e]); *(bf16_t*)(smem + L_VT + (j0 + e) * ROWB + t * 2) = (bf16_t)f2bf(v[e]); }
#pragma unroll
                for (int hh = 0; hh < 2; ++hh) {
                    u32x4 o; o.x = cvt_pk(rk * v[hh * 8], rk * v[hh * 8 + 1]); o.y = cvt_pk(rk * v[hh * 8 + 2], rk * v[hh * 8 + 3]); o.z = cvt_pk(rk * v[hh * 8 + 4], rk * v[hh * 8 + 5]); o.w = cvt_pk(rk * v[hh * 8 + 6], rk * v[hh * 8 + 7]);
                    *(u32x4*)(BON + (size_t)row * 512 + hj0 + hh * 8) = o;
                }
            }
            float lw[16], cum[16];
            {
                float wl[16];
                const u32x4* wp = (const u32x4*)(smem + L_WL + t * ROWB + j0 * 2);
                unpack8(wp[0], wl); unpack8(wp[1], wl + 8);
#pragma unroll
                for (int e = 0; e < 16; ++e) { const float wv = par[e] + wl[e]; lw[e] = -0.6065306597126334f * sigm(wv); }
            }
#pragma unroll
            for (int e = 0; e < 16; ++e) {
                float x = lw[e];
#pragma unroll
                for (int d = 4; d < 64; d <<= 1) { const float y = __shfl_up(x, d); if (lane >= d) x += y; }
                cum[e] = x;
            }
            if ((lane >> 2) == 15) {
#pragma unroll
                for (int e = 0; e < 16; ++e) wtot[w * 64 + j0 + e] = cum[e];
            }
            __syncthreads();
#pragma unroll
            for (int hh = 0; hh < 2; ++hh) {
                float at[8], bt[8], kt[8], rt[8];
#pragma unroll
                for (int e8 = 0; e8 < 8; ++e8) {
                    const int e = hh * 8 + e8;
                    const float t0 = wtot[j0 + e], t1 = wtot[64 + j0 + e], t2 = wtot[128 + j0 + e], t3 = wtot[192 + j0 + e];
                    const float cm = cum[e] + ((w > 0 ? t0 : 0.f) + (w > 1 ? t1 : 0.f) + (w > 2 ? t2 : 0.f));
                    const float tt = (t0 + t1) + (t2 + t3);
                    if (t == 63) WCs[j0 + e] = __expf(tt);
                    const float kn = kk[e] * inv;
                    const float E = __expf(cm), Ei = __expf(-cm), Ex = __expf(cm - lw[e]), Ec = __expf(tt - cm);
                    const float b = kn * ai[e];
                    at[e8] = -kn * Ex; bt[e8] = b * Ei; kt[e8] = k2[e] * Ei; rt[e8] = rr[e] * E;
                    *(bf16_t*)(smem + L_BBT + (j0 + e) * ROWB + t * 2) = (bf16_t)f2bf(b * Ec);
                    *(bf16_t*)(smem + L_KBT + (j0 + e) * ROWB + t * 2) = (bf16_t)f2bf(k2[e] * Ec);
                    *(bf16_t*)(smem + L_ATT + (j0 + e) * ROWB + t * 2) = (bf16_t)f2bf(at[e8]);
                }
                u32x4 o;
                o.x = cvt_pk(at[0], at[1]); o.y = cvt_pk(at[2], at[3]); o.z = cvt_pk(at[4], at[5]); o.w = cvt_pk(at[6], at[7]);
                *(u32x4*)(smem + L_AT + t * ROWB + (j0 + hh * 8) * 2) = o;
                o.x = cvt_pk(bt[0], bt[1]); o.y = cvt_pk(bt[2], bt[3]); o.z = cvt_pk(bt[4], bt[5]); o.w = cvt_pk(bt[6], bt[7]);
                *(u32x4*)(smem + L_BT + t * ROWB + (j0 + hh * 8) * 2) = o;
                o.x = cvt_pk(kt[0], kt[1]); o.y = cvt_pk(kt[2], kt[3]); o.z = cvt_pk(kt[4], kt[5]); o.w = cvt_pk(kt[6], kt[7]);
                *(u32x4*)(smem + L_KT + t * ROWB + (j0 + hh * 8) * 2) = o;
                o.x = cvt_pk(rt[0], rt[1]); o.y = cvt_pk(rt[2], rt[3]); o.z = cvt_pk(rt[4], rt[5]); o.w = cvt_pk(rt[6], rt[7]);
                *(u32x4*)(smem + L_RT + t * ROWB + (j0 + hh * 8) * 2) = o;
            }
        }
        __syncthreads();
        bf16x8 frb[2], frk[2];
        {
            const int tid2 = otid() & 255, lane = tid2 & 63, fr = lane & 15, fq = lane >> 4;
            bf16x8 xa[2], xr[2];
#pragma unroll
            for (int ks = 0; ks < 2; ++ks) {
                xa[ks] = *(const bf16x8*)(smem + L_AT + (w * 16 + fr) * ROWB + (ks * 32 + fq * 8) * 2);
                xr[ks] = *(const bf16x8*)(smem + L_RT + (w * 16 + fr) * ROWB + (ks * 32 + fq * 8) * 2);
            }
            f32x4 aab[4], aak[4], arb[4], ark[4];
            const int tq = w * 16 + fr;
#pragma unroll
            for (int n = 0; n < 4; ++n) {
                f32x4 dab = {0.f, 0.f, 0.f, 0.f}, dak = dab, drb = dab, drk = dab;
                if (n <= w) {
#pragma unroll
                    for (int ks = 0; ks < 2; ++ks) {
                        const bf16x8 yb = *(const bf16x8*)(smem + L_BT + (n * 16 + fr) * ROWB + (ks * 32 + fq * 8) * 2);
                        const bf16x8 yk = *(const bf16x8*)(smem + L_KT + (n * 16 + fr) * ROWB + (ks * 32 + fq * 8) * 2);
                        dab = MFMA16(yb, xa[ks], dab); dak = MFMA16(yk, xa[ks], dak); drb = MFMA16(yb, xr[ks], drb); drk = MFMA16(yk, xr[ks], drk);
                    }
#pragma unroll
                    for (int jj = 0; jj < 4; ++jj) {
                        const int sq = n * 16 + fq * 4 + jj;
                        if (!(sq < tq)) { dab[jj] = 0.f; dak[jj] = 0.f; }
                        if (!(sq <= tq)) { drb[jj] = 0.f; drk[jj] = 0.f; }
                    }
                }
                aab[n] = dab; aak[n] = dak; arb[n] = drb; ark[n] = drk;
            }
            __syncthreads();
#pragma unroll
            for (int n = 0; n < 4; ++n) *(u32x2*)(smem + L_AAB + (w * 16 + fr) * ROWB + (n * 16 + fq * 4) * 2) = pack4(aab[n]);
            *(u32x4*)(smem + L_TD + (w * 16 + (lane >> 2)) * ROWB + (lane & 3) * 32) = (u32x4){0u, 0u, 0u, 0u};
            *(u32x4*)(smem + L_TD + (w * 16 + (lane >> 2)) * ROWB + (lane & 3) * 32 + 16) = (u32x4){0u, 0u, 0u, 0u};
            asm volatile("s_waitcnt lgkmcnt(0)" ::: "memory"); __builtin_amdgcn_wave_barrier();
            {
                const int cc = lane & 15;
                float Tc[16];
#pragma unroll
                for (int r = 0; r < 16; ++r) {
                    float lf[16];
                    const u32x4* lp = (const u32x4*)(smem + L_AAB + (w * 16 + r) * ROWB + w * 32);
                    unpack8(lp[0], lf); unpack8(lp[1], lf + 8);
                    float a = (r == cc) ? 1.f : 0.f;
#pragma unroll
                    for (int s2 = 0; s2 < 16; ++s2) if (s2 < r) a += lf[s2] * Tc[s2];
                    Tc[r] = a;
                }
                if (lane < 16) {
#pragma unroll
                    for (int r = 0; r < 16; ++r) *(bf16_t*)(smem + L_TD + (w * 16 + r) * ROWB + (w * 16 + cc) * 2) = (bf16_t)f2bf(Tc[r]);
                }
            }
            bf16x8 fak[2];
#pragma unroll
            for (int ks = 0; ks < 2; ++ks) { fak[ks] = pack8(aak[2 * ks], aak[2 * ks + 1]); frb[ks] = pack8(arb[2 * ks], arb[2 * ks + 1]); frk[ks] = pack8(ark[2 * ks], ark[2 * ks + 1]); }
#pragma unroll
            for (int vt = 0; vt < 4; ++vt) {
                f32x4 acc = {0.f, 0.f, 0.f, 0.f};
#pragma unroll
                for (int ks = 0; ks < 2; ++ks) acc = MFMA16(fak[ks], ldperm(smem + L_VT + (vt * 16 + fr) * ROWB, ks, fq), acc);
                *(u32x2*)(smem + L_AKV + (vt * 16 + fr) * ROWB + (w * 16 + fq * 4) * 2) = pack4(acc);
            }
        }
        __syncthreads();
        {
            const int tid3 = otid() & 255, lane = tid3 & 63, fr = lane & 15, fq = lane >> 4;
            char* xb = smem + (w < 2 ? L_ATT : L_AKV) + (w & 1) * 32 * ROWB;
#pragma unroll
            for (int i = 0; i < 4; ++i) {
                bf16x8 la[2];
#pragma unroll
                for (int ks = 0; ks < 2; ++ks) {
                    u32x4 v = *(const u32x4*)(smem + L_AAB + (16 * i + fr) * ROWB + (ks * 32 + fq * 8) * 2);
                    if (2 * ks + (fq >> 1) >= i) v = (u32x4){0u, 0u, 0u, 0u};
                    la[ks] = __builtin_bit_cast(bf16x8, v);
                }
                const bf16x8 ta = *(const bf16x8*)(smem + L_TD + (16 * i + fr) * ROWB + ((i >> 1) * 32 + fq * 8) * 2);
#pragma unroll
                for (int nt = 0; nt < 2; ++nt) {
                    char* rowp = xb + (nt * 16 + fr) * ROWB;
                    f32x4 y = unpack4(*(const u32x2*)(rowp + (16 * i + fq * 4) * 2));
                    if (i >= 1) y = MFMA16(la[0], *(const bf16x8*)(rowp + (fq * 8) * 2), y);
                    if (i == 3) y = MFMA16(la[1], *(const bf16x8*)(rowp + (32 + fq * 8) * 2), y);
                    *(u32x2*)(rowp + (16 * i + fq * 4) * 2) = pack4(y);
                }
                asm volatile("s_waitcnt lgkmcnt(0)" ::: "memory"); __builtin_amdgcn_wave_barrier();
#pragma unroll
                for (int nt = 0; nt < 2; ++nt) {
                    char* rowp = xb + (nt * 16 + fr) * ROWB;
                    const f32x4 x = MFMA16(ta, *(const bf16x8*)(rowp + ((i >> 1) * 32 + fq * 8) * 2), ((f32x4){0.f, 0.f, 0.f, 0.f}));
                    asm volatile("s_waitcnt lgkmcnt(0)" ::: "memory");
                    *(u32x2*)(rowp + (16 * i + fq * 4) * 2) = pack4(x);
                }
                asm volatile("s_waitcnt lgkmcnt(0)" ::: "memory"); __builtin_amdgcn_wave_barrier();
            }
        }
        __syncthreads();
        {
            const int tid4 = otid() & 255, lane = tid4 & 63, fr = lane & 15, fq = lane >> 4;
            const int trow = c * 64 + w * 16 + fr;
#pragma unroll
            for (int kt = 0; kt < 4; ++kt) {
                f32x4 acc = {0.f, 0.f, 0.f, 0.f};
#pragma unroll
                for (int ks = 0; ks < 2; ++ks) acc = MFMA16(ldperm(smem + L_ATT + (kt * 16 + fr) * ROWB, ks, fq), frb[ks], acc);
                const u32x2 rr = *(const u32x2*)(smem + L_RT + (w * 16 + fr) * ROWB + (kt * 16 + fq * 4) * 2);
                acc.x += __uint_as_float(rr.x << 16); acc.y += __uint_as_float(rr.x & 0xffff0000u); acc.z += __uint_as_float(rr.y << 16); acc.w += __uint_as_float(rr.y & 0xffff0000u);
                *(u32x2*)(RH + (size_t)trow * 512 + h * 64 + kt * 16 + fq * 4) = pack4(acc);
            }
#pragma unroll
            for (int vt = 0; vt < 4; ++vt) {
                f32x4 acc = {0.f, 0.f, 0.f, 0.f};
#pragma unroll
                for (int ks = 0; ks < 2; ++ks) {
                    acc = MFMA16(ldperm(smem + L_AKV + (vt * 16 + fr) * ROWB, ks, fq), frb[ks], acc);
                    acc = MFMA16(ldperm(smem + L_VT + (vt * 16 + fr) * ROWB, ks, fq), frk[ks], acc);
                }
                *(f32x4*)(YL + (size_t)trow * 512 + h * 64 + vt * 16 + fq * 4) = acc;
            }
            bf16x8 xb[2], xk[2];
#pragma unroll
            for (int ks = 0; ks < 2; ++ks) {
                xb[ks] = *(const bf16x8*)(smem + L_BBT + (w * 16 + fr) * ROWB + (ks * 32 + fq * 8) * 2);
                xk[ks] = *(const bf16x8*)(smem + L_KBT + (w * 16 + fr) * ROWB + (ks * 32 + fq * 8) * 2);
            }
            f32x4 mt[4];
            const float wc = WCs[w * 16 + fr];
#pragma unroll
            for (int n = 0; n < 4; ++n) {
                f32x4 acc = {0.f, 0.f, 0.f, 0.f};
#pragma unroll
                for (int ks = 0; ks < 2; ++ks) acc = MFMA16(*(const bf16x8*)(smem + L_ATT + (n * 16 + fr) * ROWB + (ks * 32 + fq * 8) * 2), xb[ks], acc);
#pragma unroll
                for (int jj = 0; jj < 4; ++jj) if (n * 16 + fq * 4 + jj == w * 16 + fr) acc[jj] += wc;
                mt[n] = acc;
            }
#pragma unroll
            for (int ks = 0; ks < 2; ++ks) MF[((size_t)((c * 8 + h) * 4 + w) * 2 + ks) * 64 + lane] = __builtin_bit_cast(u32x4, pack8(mt[2 * ks], mt[2 * ks + 1]));
#pragma unroll
            for (int vs = 0; vs < 4; ++vs) {
                f32x4 acc = {0.f, 0.f, 0.f, 0.f};
#pragma unroll
                for (int ks = 0; ks < 2; ++ks) {
                    acc = MFMA16(xb[ks], *(const bf16x8*)(smem + L_AKV + (vs * 16 + fr) * ROWB + (ks * 32 + fq * 8) * 2), acc);
                    acc = MFMA16(xk[ks], *(const bf16x8*)(smem + L_VT + (vs * 16 + fr) * ROWB + (ks * 32 + fq * 8) * 2), acc);
                }
                NF[((size_t)((c * 8 + h) * 4 + w) * 4 + vs) * 64 + lane] = acc;
            }
        }
        __syncthreads();
    }
}

constexpr int SC_D = 8, SC_R = SC_D + 2, SC_SLOT = 12288;
__device__ __forceinline__ void rw_scan(const P& p, int chain, char* smem) {
    const int tid = otid(), lane = tid & 63, w = __builtin_amdgcn_readfirstlane(tid >> 6), h = chain >> 2, vs = chain & 3;
    const char* MF = (const char*)(p.ws + OFF_MF); const char* NF = (const char*)(p.out + (size_t)T * 512);
    u32x4* SF = (u32x4*)(p.ws + OFF_SF);
    const int q0 = (w >= 1 && w <= 5) ? 2 * (w - 1) : (w == 6 ? 10 : 11), npc = (w >= 1 && w <= 5) ? 2 : 1;
    auto issue = [&](int c) {
        char* slot = smem + (c % SC_R) * SC_SLOT;
#pragma unroll
        for (int j = 0; j < 2; ++j) {
            if (j < npc) {
                const int q = q0 + j;
                const char* src = (q < 8) ? MF + ((size_t)((c * 8 + h) * 8 + q) * 64 + lane) * 16
                                          : NF + ((size_t)(((c * 8 + h) * 4 + (q - 8)) * 4 + vs) * 64 + lane) * 16;
                __builtin_amdgcn_global_load_lds((const unsigned*)src, (unsigned*)(slot + q * 1024 + lane * 16), 16, 0, 0);
            }
        }
    };
    if (w != 0) {
#pragma unroll 1
        for (int c = 0; c < SC_D; ++c) issue(c);
    }
    u32x4 st0 = {0u, 0u, 0u, 0u}, st1 = st0;
    for (int c = 0; c < 255; ++c) {
        if (w != 0) {
            if (c + SC_D < 255) issue(c + SC_D);
            else { issue(254); }
            if (npc == 2) asm volatile("s_waitcnt vmcnt(16)" ::: "memory"); else asm volatile("s_waitcnt vmcnt(8)" ::: "memory");
        }
        __builtin_amdgcn_s_barrier();
        if (w == 0) {
            SF[((size_t)((c * 8 + h) * 4 + vs) * 2 + 0) * 64 + lane] = st0;
            SF[((size_t)((c * 8 + h) * 4 + vs) * 2 + 1) * 64 + lane] = st1;
            const char* slot = smem + (c % SC_R) * SC_SLOT;
            f32x4 acc[4];
#pragma unroll
            for (int i = 0; i < 4; ++i) {
                acc[i] = *(const f32x4*)(slot + (8 + i) * 1024 + lane * 16);
                acc[i] = MFMA16(*(const bf16x8*)(slot + (2 * i) * 1024 + lane * 16), __builtin_bit_cast(bf16x8, st0), acc[i]);
                acc[i] = MFMA16(*(const bf16x8*)(slot + (2 * i + 1) * 1024 + lane * 16), __builtin_bit_cast(bf16x8, st1), acc[i]);
            }
            st0 = __builtin_bit_cast(u32x4, pack8(acc[0], acc[1])); st1 = __builtin_bit_cast(u32x4, pack8(acc[2], acc[3]));
        }
    }
    if (w == 0) {
        SF[((size_t)((255 * 8 + h) * 4 + vs) * 2 + 0) * 64 + lane] = st0;
        SF[((size_t)((255 * 8 + h) * 4 + vs) * 2 + 1) * 64 + lane] = st1;
    }
    asm volatile("s_waitcnt vmcnt(0)" ::: "memory");
    __builtin_amdgcn_s_barrier();
}

__device__ __forceinline__ void phase_rw_out(const P& p, int bid, int nb) {
    const int tid = otid(), lane = tid & 63, w8 = tid >> 6, w = w8 & 3, fr = lane & 15, fq = lane >> 4;
    char* ws = p.ws;
    bf16_t* OA = (bf16_t*)(ws + OFF_OA); const bf16_t* BON = (const bf16_t*)(ws + OFF_BON); const bf16_t* RH = (const bf16_t*)(ws + OFF_RH);
    const float* YL = p.out; const u32x4* SF = (const u32x4*)(ws + OFF_SF);
    for (int itb = bid * 2; itb < 2048; itb += nb * 2) {
        const int it = itb + (w8 >> 2), c = it >> 3, h = it & 7, trow = c * 64 + w * 16 + fr;
        const char* rrow = (const char*)(RH + (size_t)trow * 512 + h * 64);
        bf16x8 rf[2]; rf[0] = ldperm(rrow, 0, fq); rf[1] = ldperm(rrow, 1, fq);
        f32x4 acc[4];
#pragma unroll
        for (int vs = 0; vs < 4; ++vs) {
            acc[vs] = *(const f32x4*)(YL + (size_t)trow * 512 + h * 64 + vs * 16 + fq * 4);
#pragma unroll
            for (int ks = 0; ks < 2; ++ks) acc[vs] = MFMA16(__builtin_bit_cast(bf16x8, SF[((size_t)((c * 8 + h) * 4 + vs) * 2 + ks) * 64 + lane]), rf[ks], acc[vs]);
        }
        float s = 0.f;
#pragma unroll
        for (int vs = 0; vs < 4; ++vs) s += (acc[vs].x + acc[vs].y) + (acc[vs].z + acc[vs].w);
        s += __shfl_xor(s, 16); s += __shfl_xor(s, 32);
        const float mean = s * (1.f / 64.f);
        float q = 0.f;
#pragma unroll
        for (int vs = 0; vs < 4; ++vs) { acc[vs] = acc[vs] - mean; q += (acc[vs].x * acc[vs].x + acc[vs].y * acc[vs].y) + (acc[vs].z * acc[vs].z + acc[vs].w * acc[vs].w); }
        q += __shfl_xor(q, 16); q += __shfl_xor(q, 32);
        const float rstd = rsqrtf(q * (1.f / 64.f) + 64e-5f);
#pragma unroll
        for (int vs = 0; vs < 4; ++vs) {
            const int hv = h * 64 + vs * 16 + fq * 4;
            const f32x4 lw = *(const f32x4*)(p.ln_x_w + hv), lb = *(const f32x4*)(p.ln_x_b + hv);
            const u32x2 bo = *(const u32x2*)(BON + (size_t)trow * 512 + hv), gg = *(const u32x2*)(OA + (size_t)trow * 512 + hv);
            f32x4 o = acc[vs] * rstd * lw + lb;
            o.x = (o.x + __uint_as_float(bo.x << 16)) * __uint_as_float(gg.x << 16);
            o.y = (o.y + __uint_as_float(bo.x & 0xffff0000u)) * __uint_as_float(gg.x & 0xffff0000u);
            o.z = (o.z + __uint_as_float(bo.y << 16)) * __uint_as_float(gg.y << 16);
            o.w = (o.w + __uint_as_float(bo.y & 0xffff0000u)) * __uint_as_float(gg.y & 0xffff0000u);
            *(u32x2*)(OA + (size_t)trow * 512 + hv) = pack4(o);
        }
    }
}


constexpr int A_LK = 0, A_LV = 36864, A_BIAS = 70656, A_TST = 70784, A_TAB = 72848, NTAB = 2912, A_LST = 84496, A_CST = 86560;
constexpr int MAXTILES = 6656;

__device__ __forceinline__ void moba_select(const P& p, int bid0, int nb0, char* smem) {
    const int tid = otid(), lane = tid & 63, w = tid >> 6, fr = lane & 15, fq = lane >> 4;
    char* ws = p.ws;
    const bf16_t* um = (const bf16_t*)(ws + OFF_UM); const float* kms = (const float*)(ws + OFF_CTL + CTL_KMS);
    unsigned* SEL = (unsigned*)(ws + OFF_MSEL);
    int* hist = (int*)smem;
    for (int i = tid; i < 512; i += NT) hist[i] = 0;
    __syncthreads();
    for (int it = bid0; it < 1024; it += nb0) {
        const int tile = it >> 3, h = it & 7, qb = tile >> 1, t = tile * 128 + w * 16 + fr;
        bf16x8 qf[2];
#pragma unroll
        for (int ks = 0; ks < 2; ++ks) qf[ks] = *(const bf16x8*)(um + (size_t)t * UMC + h * 64 + ks * 32 + fq * 8);
        float sc[4][4];
#pragma unroll
        for (int nt = 0; nt < 4; ++nt) {
            f32x4 acc = {0.f, 0.f, 0.f, 0.f};
            if (nt * 16 < qb) {
#pragma unroll
                for (int ks = 0; ks < 2; ++ks) {
                    const f32x4* kp = (const f32x4*)(kms + (size_t)(nt * 16 + fr) * 512 + h * 64 + ks * 32 + fq * 8);
                    acc = MFMA16(pack8(kp[0] * (1.f / 256.f), kp[1] * (1.f / 256.f)), qf[ks], acc);
                }
            }
#pragma unroll
            for (int j = 0; j < 4; ++j) sc[nt][j] = (nt * 16 + fq * 4 + j < qb) ? acc[j] : -3.0e38f;
        }
        unsigned selw = 0u;
#pragma unroll
        for (int s = 0; s < 3; ++s) {
            float bv = -3.0e38f; int bi = 255;
#pragma unroll
            for (int nt = 0; nt < 4; ++nt)
#pragma unroll
                for (int j = 0; j < 4; ++j) if (sc[nt][j] > bv) { bv = sc[nt][j]; bi = nt * 16 + fq * 4 + j; }
#pragma unroll
            for (int o = 16; o <= 32; o <<= 1) {
                const float v2 = __shfl_xor(bv, o); const int i2 = __shfl_xor(bi, o);
                if (v2 > bv || (v2 == bv && i2 < bi)) { bv = v2; bi = i2; }
            }
            if (!(bv > -1.0e38f)) bi = 255;
            selw |= (unsigned)bi << (8 * s);
#pragma unroll
            for (int nt = 0; nt < 4; ++nt)
#pragma unroll
                for (int j = 0; j < 4; ++j) if (nt * 16 + fq * 4 + j == bi) sc[nt][j] = -3.0e38f;
            if (fq == 0 && bi != 255) atomicAdd(&hist[h * 64 + bi], 1);
        }
        if (fq == 0) SEL[t * 8 + h] = selw | 0xff000000u;
    }
    __syncthreads();
    int* gcnt = (int*)(ws + OFF_CTL + CTL_MCNT);
    for (int i = tid; i < 512; i += NT) if (hist[i]) atomicAdd(&gcnt[i], hist[i]);
}

__device__ __forceinline__ void moba_fill(const P& p, int bid, int nb, char* smem) {
    const int tid = otid();
    char* ws = p.ws;
    const int* gcnt = (const int*)(ws + OFF_CTL + CTL_MCNT); int* gcur = (int*)(ws + OFF_CTL + CTL_MCUR);
    int* lst = (int*)smem;
    int* tst = lst + 520;
    int* cst = tst + 520;
    int* lh = cst + 520;
    int* lc = lh + 512;
    for (int i = tid; i < 512; i += NT) lc[i] = gcnt[i];
    __syncthreads();
    if (tid == 0) {
        int a = 0, b = 0, cc = 0;
        for (int i = 0; i < 512; ++i) { const int c = lc[i]; lst[i] = a; tst[i] = b; cst[i] = cc; a += c; const int nt_ = (c + 127) >> 7; b += nt_; cc += 2 * nt_ + (nt_ ? 2 : 0); }
        lst[512] = a; tst[512] = b; cst[512] = cc;
    }
    __syncthreads();
    for (int i = tid; i < 512; i += NT) { lh[i] = 0; lc[i] = 0; }
    __syncthreads();
    if (bid == 0) {
        int* glst = (int*)(ws + OFF_CTL + CTL_MLST); int* gtst = (int*)(ws + OFF_CTL + CTL_MTST);
        int* gcst = (int*)(ws + OFF_CTL + CTL_MCST);
        for (int i = tid; i < 513; i += NT) { glst[i] = lst[i]; gtst[i] = tst[i]; gcst[i] = cst[i]; }
    }
    const unsigned* SEL = (const unsigned*)(ws + OFF_MSEL);
    int* QL = (int*)(ws + OFF_MQL); int* SP = (int*)(ws + OFF_MSP);
    const int per = (T * 8 + nb - 1) / nb, i0 = bid * per, i1 = min(T * 8, i0 + per);
    for (int i = i0 + tid; i < i1; i += NT) {
        const unsigned sw = SEL[i]; const int h = i & 7;
#pragma unroll
        for (int s = 0; s < 3; ++s) { const int j = (sw >> (8 * s)) & 255; if (j != 255) atomicAdd(&lh[h * 64 + j], 1); }
    }
    __syncthreads();
    for (int i = tid; i < 512; i += NT) { const int c = lh[i]; lh[i] = c ? atomicAdd(&gcur[i], c) : 0; }
    __syncthreads();
    for (int i = i0 + tid; i < i1; i += NT) {
        const unsigned sw = SEL[i]; const int h = i & 7;
#pragma unroll
        for (int s = 0; s < 3; ++s) {
            const int j = (sw >> (8 * s)) & 255; int pos = -1;
            if (j != 255) { const int li = h * 64 + j; pos = lst[li] + lh[li] + atomicAdd(&lc[li], 1); QL[pos] = i >> 3; }
            SP[i * 3 + s] = pos;
        }
    }
}

__device__ __forceinline__ int t5b(int n) {
    const int v = (int)(__float_as_uint((float)(n * n)) >> 23) - 119;
    return n < 16 ? n : (v > 31 ? 31 : v);
}

__device__ __forceinline__ void attn_stage(const P& p, int j, int h, int nkeys, char* smem, int tid) {
    const bf16_t* um = (const bf16_t*)(p.ws + OFF_UM); const bf16_t* vt = (const bf16_t*)(p.ws + OFF_VT);
    for (int idx = tid; idx < nkeys * 8; idx += NT) {
        const int key = idx >> 3, ch = idx & 7;
        *(u32x4*)(smem + A_LK + key * 144 + ch * 16) = *(const u32x4*)(um + (size_t)(j * 256 + key) * UMC + 512 + h * 64 + ch * 8);
    }
    const int cpr = nkeys >> 3;
    for (int idx = tid; idx < 64 * cpr; idx += NT) {
        const int d = idx / cpr, ch = idx - d * cpr;
        *(u32x4*)(smem + A_LV + d * 528 + ch * 16) = *(const u32x4*)(vt + (size_t)(h * 64 + d) * T + j * 256 + ch * 8);
    }
    for (int i = tid; i < NTAB; i += NT) ((float*)(smem + A_TAB))[i] = p.rel_bias[t5b(i) * 8 + h];
}
__device__ __forceinline__ void attn_stage_load(const P& p, int j, int h, int tid, u32x4 (&rk)[4], u32x4 (&rv)[4]) {
    const bf16_t* um = (const bf16_t*)(p.ws + OFF_UM); const bf16_t* vt = (const bf16_t*)(p.ws + OFF_VT);
#pragma unroll
    for (int i = 0; i < 4; ++i) {
        const int idx = tid + i * NT, key = idx >> 3, ch = idx & 7, d = idx >> 5, c2 = idx & 31;
        rk[i] = *(const u32x4*)(um + (size_t)(j * 256 + key) * UMC + 512 + h * 64 + ch * 8);
        rv[i] = *(const u32x4*)(vt + (size_t)(h * 64 + d) * T + j * 256 + c2 * 8);
    }
}
__device__ __forceinline__ void attn_stage_store(const P& p, int h, int tid, char* smem, const u32x4 (&rk)[4], const u32x4 (&rv)[4]) {
#pragma unroll
    for (int i = 0; i < 4; ++i) {
        const int idx = tid + i * NT, key = idx >> 3, ch = idx & 7, d = idx >> 5, c2 = idx & 31;
        *(u32x4*)(smem + A_LK + key * 144 + ch * 16) = rk[i];
        *(u32x4*)(smem + A_LV + d * 528 + c2 * 16) = rv[i];
    }
    for (int i = tid; i < NTAB; i += NT) ((float*)(smem + A_TAB))[i] = p.rel_bias[t5b(i) * 8 + h];
}
template <bool CAUSAL>
__device__ __forceinline__ void attn_core_q(const char* smem, const bf16x8 (&qf)[2], int qt, int kbase, int nkeys, int fr, int fq, float& m_out, float& l_out, f32x4 (&o)[4]) {
    const float* tb = (const float*)(smem + A_TAB);
    const int nkt = nkeys >> 4;
    f32x4 sc[16];
    float mx = -3.0e38f;
    const bool far = !CAUSAL && __all(qt - (kbase + 255) >= 2897);
    const float cfar = tb[NTAB - 1];
#pragma unroll
    for (int kt = 0; kt < 16; ++kt) {
        f32x4 acc = {0.f, 0.f, 0.f, 0.f};
        if (kt < nkt) {
#pragma unroll
            for (int ks = 0; ks < 2; ++ks) acc = MFMA16(*(const bf16x8*)(smem + A_LK + (kt * 16 + fr) * 144 + (ks * 32 + fq * 8) * 2), qf[ks], acc);
            if (far) {
#pragma unroll
                for (int jj = 0; jj < 4; ++jj) { const float l = acc[jj] * 0.125f + cfar; acc[jj] = l; mx = fmaxf(mx, l); }
            } else {
#pragma unroll
                for (int jj = 0; jj < 4; ++jj) {
                    const int rel = qt - (kbase + kt * 16 + fq * 4 + jj);
                    float l = acc[jj] * 0.125f + tb[min(max(rel, 0), NTAB - 1)];
                    if (CAUSAL && rel < 0) l = -3.0e38f;
                    acc[jj] = l; mx = fmaxf(mx, l);
                }
            }
        } else { acc = (f32x4){-3.0e38f, -3.0e38f, -3.0e38f, -3.0e38f}; }
        sc[kt] = acc;
    }
    mx = fmaxf(mx, __shfl_xor(mx, 16)); mx = fmaxf(mx, __shfl_xor(mx, 32));
    float ls = 0.f;
#pragma unroll
    for (int kt = 0; kt < 16; ++kt)
#pragma unroll
        for (int jj = 0; jj < 4; ++jj) { const float e = (!CAUSAL || sc[kt][jj] > -1.0e38f) ? __expf(sc[kt][jj] - mx) : 0.f; sc[kt][jj] = e; ls += e; }
    ls += __shfl_xor(ls, 16); ls += __shfl_xor(ls, 32);
#pragma unroll
    for (int dt = 0; dt < 4; ++dt) o[dt] = (f32x4){0.f, 0.f, 0.f, 0.f};
#pragma unroll
    for (int s = 0; s < 8; ++s) {
        if (s * 2 < nkt) {
            const bf16x8 pf = pack8(sc[2 * s], sc[2 * s + 1]);
#pragma unroll
            for (int dt = 0; dt < 4; ++dt) o[dt] = MFMA16(ldperm(smem + A_LV + (dt * 16 + fr) * 528, s, fq), pf, o[dt]);
        }
    }
    m_out = mx; l_out = ls;
}

template <bool CAUSAL>
__device__ __forceinline__ void attn_core(const char* smem, const bf16_t* qrow, int qt, int kbase, int nkeys, int fr, int fq, float& m_out, float& l_out, f32x4 (&o)[4]) {
    bf16x8 qf[2];
#pragma unroll
    for (int ks = 0; ks < 2; ++ks) qf[ks] = *(const bf16x8*)(qrow + ks * 32 + fq * 8);
    attn_core_q<CAUSAL>(smem, qf, qt, kbase, nkeys, fr, fq, m_out, l_out, o);
}

__device__ __forceinline__ void moba_partial(const P& p, int bid, int nb, char* smem) {
    const int tid = otid(), lane = tid & 63, w = tid >> 6, fr = lane & 15, fq = lane >> 4;
    char* ws = p.ws;
    const bf16_t* um = (const bf16_t*)(ws + OFF_UM);
    const int* glst = (const int*)(ws + OFF_CTL + CTL_MLST); const int* gtst = (const int*)(ws + OFF_CTL + CTL_MTST);
    const int* QL = (const int*)(ws + OFF_MQL);
    bf16_t* PO = (bf16_t*)p.out; float* PM = (float*)((char*)p.out + 52 * MiB); float* PL = PM + 400000;
    int* tst = (int*)(smem + A_TST); int* lst = (int*)(smem + A_LST);
    for (int i = tid; i < 513; i += NT) { tst[i] = gtst[i]; lst[i] = glst[i]; }
    __syncthreads();
    const int* gcst = (const int*)(ws + OFF_CTL + CTL_MCST);
    int* cst = (int*)(smem + A_CST);
    for (int i = tid; i < 513; i += NT) cst[i] = gcst[i];
    __syncthreads();
    auto first_tile = [&](int cpos) {
        int lo = 0, hi = 512;
        while (hi - lo > 1) { const int mid = (lo + hi) >> 1; if (cst[mid] <= cpos) lo = mid; else hi = mid; }
        const int ntl = tst[lo + 1] - tst[lo];
        int k = (cpos - cst[lo] - 2 + 1) >> 1; if (k < 0) k = 0;
        return (k >= ntl) ? tst[lo + 1] : tst[lo] + k;
    };
    const int Ctot = cst[512];
    const int it0 = first_tile((int)((long)Ctot * bid / nb)), it1 = (bid + 1 == nb) ? tst[512] : first_tile((int)((long)Ctot * (bid + 1) / nb));
    int lq = 0;
    auto tile_pos = [&](int it, int& li, int& pos, bool& valid) {
        int lo = lq;
        while (lo < 511 && tst[lo + 1] <= it) ++lo;
        lq = lo; li = lo;
        const int base = lst[lo] + (it - tst[lo]) * 128, idx = w * 16 + fr;
        valid = base + idx < lst[lo + 1];
        pos = valid ? base + idx : base;
    };
    { int lo = 0, hi = 512; while (hi - lo > 1) { const int mid = (lo + hi) >> 1; if (tst[mid] <= it0) lo = mid; else hi = mid; } lq = lo; }
    int liA = 0, posA = 0, liB = 0, posB = 0, qtA = 0, qtB = 0; bool vA = false, vB = false;
    bf16x8 qfA[2];
    if (it0 < it1) {
        tile_pos(it0, liA, posA, vA); qtA = QL[posA];
        if (it0 + 1 < it1) { tile_pos(it0 + 1, liB, posB, vB); qtB = QL[posB]; }
#pragma unroll
        for (int ks = 0; ks < 2; ++ks) qfA[ks] = *(const bf16x8*)(um + (size_t)qtA * UMC + (liA >> 6) * 64 + ks * 32 + fq * 8);
    }
    int lprev = -1, lpre = -1;
    u32x4 rk[4], rv[4];
    for (int it = it0; it < it1; ++it) {
        const int h = liA >> 6, j = liA & 63;
        if (liA != lprev) {
            if (lpre != liA) attn_stage_load(p, j, h, tid, rk, rv);
            __syncthreads();
            attn_stage_store(p, h, tid, smem, rk, rv);
            __syncthreads();
            lprev = liA;
        }
        if (it + 1 < it1 && liB != liA) { attn_stage_load(p, liB & 63, liB >> 6, tid, rk, rv); lpre = liB; }
        bf16x8 qfB[2]; int liC = 0, posC = 0, qtC = 0; bool vC = false;
        if (it + 1 < it1) {
#pragma unroll
            for (int ks = 0; ks < 2; ++ks) qfB[ks] = *(const bf16x8*)(um + (size_t)qtB * UMC + (liB >> 6) * 64 + ks * 32 + fq * 8);
        } else { qfB[0] = qfA[0]; qfB[1] = qfA[1]; }
        if (it + 2 < it1) { tile_pos(it + 2, liC, posC, vC); qtC = QL[posC]; }
        float m, l; f32x4 o[4];
        attn_core_q<false>(smem, qfA, qtA, j * 256, 256, fr, fq, m, l, o);
        if (vA) {
#pragma unroll
            for (int dt = 0; dt < 4; ++dt) *(u32x2*)(PO + (size_t)posA * 64 + dt * 16 + fq * 4) = pack4(o[dt]);
            if (fq == 0) { PM[posA] = m; PL[posA] = l; }
        }
        liA = liB; posA = posB; vA = vB; qtA = qtB; qfA[0] = qfB[0]; qfA[1] = qfB[1];
        liB = liC; posB = posC; vB = vC; qtB = qtC;
    }
}

__device__ __forceinline__ void moba_own(const P& p, int bid, int nb, char* smem) {
    const int tid = otid(), lane = tid & 63, w = tid >> 6, fr = lane & 15, fq = lane >> 4;
    char* ws = p.ws;
    const bf16_t* um = (const bf16_t*)(ws + OFF_UM);
    const int* SP = (const int*)(ws + OFF_MSP);
    const bf16_t* PO = (const bf16_t*)p.out; const float* PM = (const float*)((const char*)p.out + 52 * MiB); const float* PL = PM + 400000;
    bf16_t* ob = (bf16_t*)(ws + OFF_OB);
    u32x4 rk[4], rv[4];
    if (bid < 1024) attn_stage_load(p, (bid >> 3) >> 1, bid & 7, tid, rk, rv);
    for (int it = bid; it < 1024; it += nb) {
        const int tile = it >> 3, h = it & 7, b = tile >> 1, tb = tile & 1, nkeys = (tb + 1) * 128;
        __syncthreads();
        attn_stage_store(p, h, tid, smem, rk, rv);
        __syncthreads();
        if (it + nb < 1024) attn_stage_load(p, ((it + nb) >> 3) >> 1, (it + nb) & 7, tid, rk, rv);
        const int qt = tile * 128 + w * 16 + fr;
        int pos[3]; float pm[3], pl[3];
#pragma unroll
        for (int s = 0; s < 3; ++s) pos[s] = SP[(qt * 8 + h) * 3 + s];
#pragma unroll
        for (int s = 0; s < 3; ++s) { pm[s] = (pos[s] >= 0) ? PM[pos[s]] : -3.0e38f; pl[s] = (pos[s] >= 0) ? PL[pos[s]] : 0.f; }
        float m, l; f32x4 o[4];
        attn_core<true>(smem, um + (size_t)qt * UMC + h * 64, qt, b * 256, nkeys, fr, fq, m, l, o);
        float M = m;
#pragma unroll
        for (int s = 0; s < 3; ++s) M = fmaxf(M, pm[s]);
        const float so = __expf(m - M);
        float den = l * so;
#pragma unroll
        for (int dt = 0; dt < 4; ++dt) o[dt] = o[dt] * so;
#pragma unroll
        for (int s = 0; s < 3; ++s) {
            if (pos[s] >= 0) {
                const float e = __expf(pm[s] - M);
                den += pl[s] * e;
#pragma unroll
                for (int dt = 0; dt < 4; ++dt) o[dt] = o[dt] + e * unpack4(*(const u32x2*)(PO + (size_t)pos[s] * 64 + dt * 16 + fq * 4));
            }
        }
        const float inv = 1.f / den;
#pragma unroll
        for (int dt = 0; dt < 4; ++dt) *(u32x2*)(ob + (size_t)qt * 512 + h * 64 + dt * 16 + fq * 4) = pack4(o[dt] * inv);
    }
}

__device__ __forceinline__ void phase_kvx(const P& p, int bid0, int nb0, char* smem) {
    char* ws = p.ws;
    bf16_t* KX = (bf16_t*)(ws + OFF_KVX); bf16_t* VXT = KX + 256 * 512;
    for (int it = bid0; it < 8; it += nb0) {
        f32x4 acc[2][8];
#pragma unroll
        for (int m = 0; m < 2; ++m)
#pragma unroll
            for (int n = 0; n < 8; ++n) acc[m][n] = (f32x4){0.f, 0.f, 0.f, 0.f};
        gemm_r32(acc, (const bf16_t*)(ws + OFF_MEMN), D, 0, (const bf16_t*)(ws + OFF_WKV), D, it * 128, D, smem);
        const int tid = otid(), lane = tid & 63, w = tid >> 6, fr = lane & 15, fq = lane >> 4;
#pragma unroll
        for (int m = 0; m < 2; ++m) {
            const int row = w * 32 + m * 16 + fr;
#pragma unroll
            for (int n = 0; n < 8; ++n) {
                const f32x4 v = acc[m][n];
                if (it < 4) *(u32x2*)(KX + (size_t)row * 512 + it * 128 + n * 16 + fq * 4) = pack4(v);
                else {
                    const int col = (it - 4) * 128 + n * 16 + fq * 4;
                    VXT[(size_t)(col + 0) * 256 + row] = (bf16_t)f2bf(v.x); VXT[(size_t)(col + 1) * 256 + row] = (bf16_t)f2bf(v.y);
                    VXT[(size_t)(col + 2) * 256 + row] = (bf16_t)f2bf(v.z); VXT[(size_t)(col + 3) * 256 + row] = (bf16_t)f2bf(v.w);
                }
            }
        }
    }
}

__device__ __forceinline__ void phase_qx_xattn(const P& p, int bid, int nb, char* smem) {
    char* ws = p.ws;
    const bf16_t* KX = (const bf16_t*)(ws + OFF_KVX); const bf16_t* VXT = KX + 256 * 512;
    bf16_t* ox = (bf16_t*)(ws + OFF_OB);
    for (int it = bid; it < 256; it += nb) {
        const int pm = it >> 2, h = it & 3;
        bf16x8 qf[2][4];
        {
            f32x4 acc[2][8];
#pragma unroll
            for (int m = 0; m < 2; ++m)
#pragma unroll
                for (int n = 0; n < 8; ++n) acc[m][n] = (f32x4){0.f, 0.f, 0.f, 0.f};
            gemm_r32(acc, (const bf16_t*)(ws + OFF_XN), D, pm * 256, (const bf16_t*)(ws + OFF_WQ), D, h * 128, D, smem);
            const float sc = 0.08838834764831845f;
#pragma unroll
            for (int m = 0; m < 2; ++m)
#pragma unroll
                for (int s2 = 0; s2 < 4; ++s2) qf[m][s2] = pack8(acc[m][2 * s2] * sc, acc[m][2 * s2 + 1] * sc);
        }
        const int tid = otid(), lane = tid & 63, w = tid >> 6, fr = lane & 15, fq = lane >> 4;
        for (int idx = tid; idx < 4096; idx += NT) { const int key = idx >> 4, ch = idx & 15; *(u32x4*)(smem + key * 272 + ch * 16) = *(const u32x4*)(KX + (size_t)key * 512 + h * 128 + ch * 8); }
        __syncthreads();
        bf16x8 pf[2][8]; float inv[2];
#pragma unroll
        for (int m = 0; m < 2; ++m) {
            f32x4 sc[16]; float mx = -3.0e38f;
#pragma unroll
            for (int kt = 0; kt < 16; ++kt) {
                f32x4 a = {0.f, 0.f, 0.f, 0.f};
#pragma unroll
                for (int s2 = 0; s2 < 4; ++s2) a = MFMA16(ldperm(smem + (kt * 16 + fr) * 272, s2, fq), qf[m][s2], a);
                sc[kt] = a; mx = fmaxf(fmaxf(mx, fmaxf(a.x, a.y)), fmaxf(a.z, a.w));
            }
            mx = fmaxf(mx, __shfl_xor(mx, 16)); mx = fmaxf(mx, __shfl_xor(mx, 32));
            float ls = 0.f;
#pragma unroll
            for (int kt = 0; kt < 16; ++kt) { sc[kt].x = __expf(sc[kt].x - mx); sc[kt].y = __expf(sc[kt].y - mx); sc[kt].z = __expf(sc[kt].z - mx); sc[kt].w = __expf(sc[kt].w - mx); ls += (sc[kt].x + sc[kt].y) + (sc[kt].z + sc[kt].w); }
            ls += __shfl_xor(ls, 16); ls += __shfl_xor(ls, 32);
            inv[m] = 1.f / ls;
#pragma unroll
            for (int s2 = 0; s2 < 8; ++s2) { pf[m][s2] = pack8(sc[2 * s2], sc[2 * s2 + 1]); asm volatile("" : "+v"(pf[m][s2])); }
            asm volatile("" ::: "memory");
        }
        __syncthreads();
        for (int idx = tid; idx < 4096; idx += NT) { const int d = idx >> 5, ch = idx & 31; *(u32x4*)(smem + d * 528 + ch * 16) = *(const u32x4*)(VXT + (size_t)(h * 128 + d) * 256 + ch * 8); }
        __syncthreads();
#pragma unroll
        for (int m = 0; m < 2; ++m) {
            const int row = pm * 256 + w * 32 + m * 16 + fr;
#pragma unroll
            for (int dt = 0; dt < 8; ++dt) {
                f32x4 o = {0.f, 0.f, 0.f, 0.f};
#pragma unroll
                for (int s2 = 0; s2 < 8; ++s2) o = MFMA16(ldperm(smem + (dt * 16 + fr) * 528, s2, fq), pf[m][s2], o);
                *(u32x2*)(ox + (size_t)row * 512 + h * 128 + dt * 16 + fq * 4) = pack4(o * inv[m]);
                asm volatile("" ::: "memory");
            }
        }
        __syncthreads();
    }
}

struct EpiMergeA {
    static constexpr bool PERM = true;
    char* ws;
    __device__ __forceinline__ void operator()(const f32x4 (&acc)[2][2][4][2], const pg8::Unit& u, int wr, int wc, int fr, int fq) const {
        const bf16_t* ug = (const bf16_t*)(ws + OFF_UG); bf16_t* mg = (bf16_t*)(ws + OFF_MRG);
        const int row0 = u.pm * 256 + wr * 64 + fr, col0 = u.pn * 256 + wc * 32 + 8 * fq;
#pragma unroll
        for (int ai = 0; ai < 2; ++ai)
#pragma unroll
            for (int m = 0; m < 4; ++m) {
                const size_t row = row0 + ai * 128 + m * 16;
#pragma unroll
                for (int bj = 0; bj < 2; ++bj) {
                    const int col = col0 + bj * 128;
                    float g[8]; unpack8(*(const u32x4*)(ug + row * GCOLS + col), g);
                    const f32x4 a = acc[ai][bj][m][0], b = acc[ai][bj][m][1];
                    u32x4 w; w.x = cvt_pk(g[0] * a.x, g[1] * a.y); w.y = cvt_pk(g[2] * a.z, g[3] * a.w); w.z = cvt_pk(g[4] * b.x, g[5] * b.y); w.w = cvt_pk(g[6] * b.z, g[7] * b.w);
                    *(u32x4*)(mg + row * D + col) = w;
                }
            }
    }
};
struct EpiMergeB {
    static constexpr bool PERM = true;
    char* ws;
    __device__ __forceinline__ void operator()(const f32x4 (&acc)[2][2][4][2], const pg8::Unit& u, int wr, int wc, int fr, int fq) const {
        const bf16_t* ug = (const bf16_t*)(ws + OFF_UG); bf16_t* mg = (bf16_t*)(ws + OFF_MRG);
        const int row0 = u.pm * 256 + wr * 64 + fr, col0 = u.pn * 256 + wc * 32 + 8 * fq;
#pragma unroll
        for (int ai = 0; ai < 2; ++ai)
#pragma unroll
            for (int m = 0; m < 4; ++m) {
                const size_t row = row0 + ai * 128 + m * 16;
#pragma unroll
                for (int bj = 0; bj < 2; ++bj) {
                    const int col = col0 + bj * 128;
                    float g[8], t[8]; unpack8(*(const u32x4*)(ug + row * GCOLS + 1024 + col), g); unpack8(*(const u32x4*)(mg + row * D + col), t);
                    const f32x4 a = acc[ai][bj][m][0], b = acc[ai][bj][m][1];
                    u32x4 w; w.x = cvt_pk(t[0] + g[0] * a.x, t[1] + g[1] * a.y); w.y = cvt_pk(t[2] + g[2] * a.z, t[3] + g[3] * a.w);
                    w.z = cvt_pk(t[4] + g[4] * b.x, t[5] + g[5] * b.y); w.w = cvt_pk(t[6] + g[6] * b.z, t[7] + g[7] * b.w);
                    *(u32x4*)(mg + row * D + col) = w;
                }
            }
    }
};
__device__ __forceinline__ void phase_merge(const P& p, int bid, int nb, char* smem) {
    pg8::StaticOrder S; S.init(T, D, nb, bid);
    EpiMergeA EA{p.ws}; EpiMergeB EB{p.ws};
    pg8::gemm_phase<EpiMergeA, pg8::StaticOrder, true>((LAS unsigned char*)smem, (const bf16_t*)(p.ws + OFF_OA), (const bf16_t*)(p.ws + OFF_WORW), 512, S, EA);
    pg8::gemm_phase<EpiMergeB, pg8::StaticOrder, true>((LAS unsigned char*)smem, (const bf16_t*)(p.ws + OFF_OB), (const bf16_t*)(p.ws + OFF_WOMB), 512, S, EB);
}
struct EpiResid {
    static constexpr bool PERM = false;
    const float* res; float* out;
    __device__ __forceinline__ void operator()(const f32x4 (&acc)[2][2][4][2], const pg8::Unit& u, int wr, int wc, int fr, int fq) const {
        const int row0 = u.pm * 256 + wr * 64 + fr, col0 = u.pn * 256 + wc * 32 + 4 * fq;
#pragma unroll
        for (int ai = 0; ai < 2; ++ai)
#pragma unroll
            for (int m = 0; m < 4; ++m) {
                const size_t off = (size_t)(row0 + ai * 128 + m * 16) * D + col0;
#pragma unroll
                for (int bj = 0; bj < 2; ++bj)
#pragma unroll
                    for (int n = 0; n < 2; ++n) { const f32x4 r = *(const f32x4*)(res + off + bj * 128 + n * 16); *(f32x4*)(out + off + bj * 128 + n * 16) = r + acc[ai][bj][m][n]; }
            }
    }
};
__device__ __forceinline__ void phase_resid_gemm(const bf16_t* A, int K, const bf16_t* Bt, const float* res, float* dst, int bid, int nb, char* smem) {
    pg8::StaticOrder S; S.init(T, D, nb, bid);
    EpiResid E{res, dst};
    pg8::gemm_phase<EpiResid, pg8::StaticOrder, true>((LAS unsigned char*)smem, A, Bt, K, S, E);
}
__device__ __forceinline__ void phase_norm(const float* src, const float* g, bf16_t* dst, int bid, int nb) {
    const int lane = otid() & 63, wid = otid() >> 6;
    for (int it = bid; it < T / 8; it += nb) { const int row = it * 8 + wid; rms_row_bf16(src + (size_t)row * D, g, dst + (size_t)row * D, lane); }
}
template <int PART>
__device__ __forceinline__ void phase_expconv(const P& p, int bid, int nb, char* smem) {
    float* scr = (float*)smem;
    bf16_t* gu = (bf16_t*)(p.ws + OFF_EXPGU); bf16_t* dn = (bf16_t*)(p.ws + OFF_EXPD);
    constexpr int NITEMS = PART == 0 ? (32 * 64 + 12 * 128) : (20 * 128);
    for (int it = bid; it < NITEMS; it += nb) {
        if (PART == 0 && it < 2048) { const int e = it >> 6, tile = it & 63; transpose_tile(p.w_exp_down + (size_t)e * DEXP * D, DEXP, D, dn + (size_t)e * D * DEXP, 16, 0, tile, scr); continue; }
        const int r = PART == 0 ? it - 2048 : it + 12 * 128, e = r >> 7, which = (r >> 6) & 1, tile = r & 63;
        if (which == 0) transpose_tile(p.w_exp_gate + (size_t)e * D * DEXP, D, DEXP, gu + (size_t)e * D * D, 32, 0, tile, scr);
        else transpose_tile(p.w_exp_up + (size_t)e * D * DEXP, D, DEXP, gu + (size_t)e * D * D, 32, 16, tile, scr);
    }
}

__device__ __forceinline__ void phase_router(const P& p, int bid, int nb, char* smem) {
    const int tid = otid(), lane = tid & 63, wid = tid >> 6;
    char* ws = p.ws;
    int* hist = (int*)smem;
    if (tid < 32) hist[tid] = 0;
    __syncthreads();
    const float* x2 = p.out;
    bf16_t* xn = (bf16_t*)(ws + OFF_XN);
    int* toke = (int*)(ws + OFF_CTL + CTL_TOKE); float* tokg = (float*)(ws + OFF_CTL + CTL_TOKG);
    int* rowtok = (int*)(ws + OFF_CTL + CTL_ROWTOK);
    for (int i = bid * NT + tid; i < CAP; i += nb * NT) rowtok[i] = 0;
    float* rt = (float*)(smem + 256);
    { const f32x4* src = (const f32x4*)(ws + OFF_ROUT); f32x4* dst = (f32x4*)rt; for (int i = tid; i < 36 * 256; i += NT) dst[i] = src[i]; }
    __syncthreads();
    for (int it = bid; it < T / 32; it += nb) {
        const int tidr = otid(), lane = tidr & 63, wid = tidr >> 6;
        const int rbase = it * 32 + wid * 4;
#pragma unroll 1
        for (int rp = 0; rp < 2; ++rp) {
            f32x4 hv[2][4];
#pragma unroll
            for (int r2 = 0; r2 < 2; ++r2) {
                const f32x4* xr = (const f32x4*)(x2 + (size_t)(rbase + rp * 2 + r2) * D) + lane; const f32x4* gr = (const f32x4*)p.norm_ffn + lane;
                float s = 0.f;
#pragma unroll
                for (int j = 0; j < 4; ++j) { hv[r2][j] = xr[64 * j]; s += hv[r2][j].x * hv[r2][j].x + hv[r2][j].y * hv[r2][j].y + hv[r2][j].z * hv[r2][j].z + hv[r2][j].w * hv[r2][j].w; }
                const float rstd = rsqrtf(wave_sum(s) * (1.f / 1024.f) + 1e-6f);
                u32x2* o8 = (u32x2*)(xn + (size_t)(rbase + rp * 2 + r2) * D) + lane;
#pragma unroll
                for (int j = 0; j < 4; ++j) { const f32x4 gg = gr[64 * j]; hv[r2][j] = hv[r2][j] * rstd * gg; o8[64 * j] = pack4(hv[r2][j]); }
            }
            float ve[2][32], vg[2][4];
#pragma unroll
            for (int o = 0; o < 36; ++o) {
                const f32x4* wr_ = (const f32x4*)(rt + o * 1024) + lane;
                f32x4 w[4];
#pragma unroll
                for (int j = 0; j < 4; ++j) w[j] = wr_[64 * j];
#pragma unroll
                for (int r2 = 0; r2 < 2; ++r2) {
                    float sacc = 0.f;
#pragma unroll
                    for (int j = 0; j < 4; ++j) sacc += hv[r2][j].x * w[j].x + hv[r2][j].y * w[j].y + hv[r2][j].z * w[j].z + hv[r2][j].w * w[j].w;
                    if (o < 32) ve[r2][o] = sacc; else vg[r2][o - 32] = sacc;
                }
                if (o & 1) asm volatile("" ::: "memory");
            }
#pragma unroll
            for (int r2 = 0; r2 < 2; ++r2) {
#define RT_LEVEL(D, NH) { const bool hi = (lane & (D)) != 0; _Pragma("unroll") for (int i = 0; i < (NH); ++i) { \
                    const float keep = hi ? ve[r2][2 * i + 1] : ve[r2][2 * i], send = hi ? ve[r2][2 * i] : ve[r2][2 * i + 1]; ve[r2][i] = keep + __shfl_xor(send, (D)); } }
                RT_LEVEL(32, 16) RT_LEVEL(16, 8) RT_LEVEL(8, 4) RT_LEVEL(4, 2) RT_LEVEL(2, 1)
#undef RT_LEVEL
                ve[r2][0] += __shfl_xor(ve[r2][0], 1);
                {
                    const bool h5 = (lane & 32) != 0, h4 = (lane & 16) != 0;
                    const float k0 = h5 ? vg[r2][1] : vg[r2][0], s0 = h5 ? vg[r2][0] : vg[r2][1], k1 = h5 ? vg[r2][3] : vg[r2][2], s1 = h5 ? vg[r2][2] : vg[r2][3];
                    const float a0 = k0 + __shfl_xor(s0, 32), a1 = k1 + __shfl_xor(s1, 32);
                    float gsum = (h4 ? a1 : a0) + __shfl_xor(h4 ? a0 : a1, 16);
                    gsum += __shfl_xor(gsum, 8); gsum += __shfl_xor(gsum, 4); gsum += __shfl_xor(gsum, 2); gsum += __shfl_xor(gsum, 1);
                    vg[r2][0] = gsum;
                }
            }
#pragma unroll
            for (int r2 = 0; r2 < 2; ++r2) {
                const int rr = rp * 2 + r2;
                const float g0 = __shfl(vg[r2][0], 0), g1 = __shfl(vg[r2][0], 32), g2 = __shfl(vg[r2][0], 16), g3 = __shfl(vg[r2][0], 48);
                int gs = 0; float gm = g0;
                if (g1 > gm) { gm = g1; gs = 1; }
                if (g2 > gm) { gm = g2; gs = 2; }
                if (g3 > gm) { gm = g3; gs = 3; }
                const float gp = 1.f / (__expf(g0 - gm) + __expf(g1 - gm) + __expf(g2 - gm) + __expf(g3 - gm));
                float e[8];
#pragma unroll
                for (int i = 0; i < 8; ++i) {
                    const int o = gs * 8 + i;
                    const int src = ((o & 1) << 5) | (((o >> 1) & 1) << 4) | (((o >> 2) & 1) << 3) | (((o >> 3) & 1) << 2) | (((o >> 4) & 1) << 1);
                    e[i] = __shfl(ve[r2][0], src);
                }
                int i1 = 0; float v1 = e[0];
#pragma unroll
                for (int i = 1; i < 8; ++i) if (e[i] > v1) { v1 = e[i]; i1 = i; }
                int i2 = -1; float v2 = -3.0e38f;
#pragma unroll
                for (int i = 0; i < 8; ++i) if (i != i1 && e[i] > v2) { v2 = e[i]; i2 = i; }
                const float e2 = __expf(v2 - v1), den = 1.f / (1.f + e2);
                if (lane == 0) {
                    const int tok = rbase + rr;
                    toke[tok * 2] = gs * 8 + i1; toke[tok * 2 + 1] = gs * 8 + i2;
                    tokg[tok * 2] = gp * den; tokg[tok * 2 + 1] = gp * e2 * den;
                    atomicAdd(&hist[gs * 8 + i1], 1); atomicAdd(&hist[gs * 8 + i2], 1);
                }
            }
        }
    }
    __syncthreads();
    { const int t2 = otid(); const int* h2 = (const int*)smem; if (t2 < 32 && h2[t2]) atomicAdd((int*)(p.ws + OFF_CTL + CTL_CNT) + t2, h2[t2]); }
}
__device__ __forceinline__ void phase_dispatch(const P& p, int bid, int nb, char* smem) {
    const int tid = otid();
    char* ws = p.ws;
    int* pstart = (int*)smem;
    int* lh = pstart + 64;
    int* lc = lh + 32;
    int* cn = lc + 32;
    const int* counts = (const int*)(ws + OFF_CTL + CTL_CNT);
    int* cursor = (int*)(ws + OFF_CTL + CTL_CNT) + 32;
    if (tid < 32) { cn[tid] = counts[tid]; lh[tid] = 0; lc[tid] = 0; }
    __syncthreads();
    if (tid == 0) { int a = 0; for (int e = 0; e < 32; ++e) { pstart[e] = a; a += (cn[e] + MBLK - 1) / MBLK * MBLK; } pstart[32] = a; }
    __syncthreads();
    const int* toke = (const int*)(ws + OFF_CTL + CTL_TOKE);
    int* toks = (int*)(ws + OFF_CTL + CTL_TOKS); int* rowtok = (int*)(ws + OFF_CTL + CTL_ROWTOK);
    const int per = (T * 2 + nb - 1) / nb, i0 = bid * per, i1 = min(T * 2, i0 + per);
    for (int i = i0 + tid; i < i1; i += NT) atomicAdd(&lh[toke[i]], 1);
    __syncthreads();
    if (tid < 32) { const int c = lh[tid]; lh[tid] = c ? atomicAdd(&cursor[tid], c) : 0; }
    __syncthreads();
    for (int i = i0 + tid; i < i1; i += NT) {
        const int e = toke[i];
        const int pos = pstart[e] + lh[e] + atomicAdd(&lc[e], 1);
        rowtok[pos] = i >> 1; toks[i] = pos;
    }
    if (bid == 0) {
        int* blke = (int*)(ws + OFF_CTL + CTL_BLKE);
        for (int b = tid; b < NBLK; b += NT) {
            const int r = b * MBLK; int e = -1;
            if (r < pstart[32]) { e = 0; while (pstart[e + 1] <= r) ++e; }
            blke[b] = e;
        }
        if (tid == 0) blke[NBLK] = pstart[32] / MBLK;
    }
}
struct MoeOrder {
    const int* blke; const int* rowtok; int nunits, G, c; bool gather; int brows;
    __device__ bool next(int i, pg8::Unit& u) const {
        const int L = i * G + c; if (L >= nunits) return false;
        u.pm = L >> 2; u.pn = L & 3; u.e = blke[u.pm]; return true;
    }
    __device__ __forceinline__ unsigned rowA(const pg8::Unit& u, int r) const { return gather ? (unsigned)rowtok[u.pm * MBLK + r] : (unsigned)(u.pm * MBLK + r); }
    __device__ __forceinline__ unsigned rowB(const pg8::Unit& u, int r) const { return (unsigned)(u.e * brows + u.pn * 256 + r); }
};
struct EpiHid {
    static constexpr bool PERM = false;
    bf16_t* hid;
    __device__ __forceinline__ void operator()(const f32x4 (&acc)[2][2][4][2], const pg8::Unit& u, int wr, int wc, int fr, int fq) const {
        const int row0 = u.pm * 256 + wr * 64 + fr, col0 = u.pn * 128 + wc * 16 + 4 * fq;
#pragma unroll
        for (int ai = 0; ai < 2; ++ai)
#pragma unroll
            for (int m = 0; m < 4; ++m) {
                bf16_t* rowp = hid + (size_t)(row0 + ai * 128 + m * 16) * DEXP + col0;
#pragma unroll
                for (int bj = 0; bj < 2; ++bj) {
                    const f32x4 g = acc[ai][bj][m][0], uu = acc[ai][bj][m][1];
                    f32x4 hval; hval.x = g.x * sigm(g.x) * uu.x; hval.y = g.y * sigm(g.y) * uu.y; hval.z = g.z * sigm(g.z) * uu.z; hval.w = g.w * sigm(g.w) * uu.w;
                    *(u32x2*)(rowp + bj * 64) = pack4(hval);
                }
            }
    }
};
struct EpiY {
    static constexpr bool PERM = true;
    bf16_t* ym;
    __device__ __forceinline__ void operator()(const f32x4 (&acc)[2][2][4][2], const pg8::Unit& u, int wr, int wc, int fr, int fq) const {
        const int row0 = u.pm * 256 + wr * 64 + fr, col0 = u.pn * 256 + wc * 32 + 8 * fq;
#pragma unroll
        for (int ai = 0; ai < 2; ++ai)
#pragma unroll
            for (int m = 0; m < 4; ++m) {
                bf16_t* rowp = ym + (size_t)(row0 + ai * 128 + m * 16) * D + col0;
#pragma unroll
                for (int bj = 0; bj < 2; ++bj) {
                    const f32x4 v0 = acc[ai][bj][m][0], v1 = acc[ai][bj][m][1];
                    u32x4 w; w.x = cvt_pk(v0.x, v0.y); w.y = cvt_pk(v0.z, v0.w); w.z = cvt_pk(v1.x, v1.y); w.w = cvt_pk(v1.z, v1.w);
                    *(u32x4*)(rowp + bj * 128) = w;
                }
            }
    }
};
__device__ __forceinline__ void phase_exp1(const P& p, int bid, int nb, char* smem) {
    char* ws = p.ws;
    const int* blke = (const int*)(ws + OFF_CTL + CTL_BLKE);
    MoeOrder S{blke, (const int*)(ws + OFF_CTL + CTL_ROWTOK), blke[NBLK] * 4, nb, bid, true, 1024};
    EpiHid E{(bf16_t*)(ws + OFF_MRG)};
    pg8::gemm_phase<EpiHid, MoeOrder, true>((LAS unsigned char*)smem, (const bf16_t*)(ws + OFF_XN), (const bf16_t*)(ws + OFF_EXPGU), D, S, E);
}
__device__ __forceinline__ void phase_exp2(const P& p, int bid, int nb, char* smem) {
    char* ws = p.ws;
    const int* blke = (const int*)(ws + OFF_CTL + CTL_BLKE);
    MoeOrder S{blke, nullptr, blke[NBLK] * 4, nb, bid, false, 1024};
    EpiY E{(bf16_t*)(ws + OFF_YMOE)};
    pg8::gemm_phase<EpiY, MoeOrder, true>((LAS unsigned char*)smem, (const bf16_t*)(ws + OFF_MRG), (const bf16_t*)(ws + OFF_EXPD), DEXP, S, E);
}
__device__ __forceinline__ void phase_final(const P& p, int bid, int nb) {
    const int lane = otid() & 63, wid = otid() >> 6;
    char* ws = p.ws;
    const int* toks = (const int*)(ws + OFF_CTL + CTL_TOKS); const float* tokg = (const float*)(ws + OFF_CTL + CTL_TOKG);
    const bf16_t* ym = (const bf16_t*)(ws + OFF_YMOE);
    for (int it = bid; it < T / 8; it += nb) {
        const int row = it * 8 + wid;
        const int s1 = toks[row * 2], s2 = toks[row * 2 + 1]; const float g1 = tokg[row * 2], g2 = tokg[row * 2 + 1];
        f32x4* xr = (f32x4*)(p.out + (size_t)row * D) + lane; const f32x4* gr = (const f32x4*)p.norm_final + lane;
        const u32x2* y1 = (const u32x2*)(ym + (size_t)s1 * D) + lane; const u32x2* y2 = (const u32x2*)(ym + (size_t)s2 * D) + lane;
        f32x4 v[4]; float s = 0.f;
#pragma unroll
        for (int j = 0; j < 4; ++j) {
            v[j] = xr[64 * j] + g1 * unpack4(y1[64 * j]) + g2 * unpack4(y2[64 * j]);
            s += v[j].x * v[j].x + v[j].y * v[j].y + v[j].z * v[j].z + v[j].w * v[j].w;
        }
        const float rstd = rsqrtf(wave_sum(s) * (1.f / 1024.f) + 1e-6f);
#pragma unroll
        for (int j = 0; j < 4; ++j) xr[64 * j] = v[j] * rstd * gr[64 * j];
    }
}

template <int PH>
__device__ __forceinline__ void run_phase(const P& p, int bid, int nb, char* smem) {
    char* ws = p.ws;
    if (PH == 0) phase0(p, bid, nb, smem);
    else if (PH == 1) phase1(p, bid, nb, smem);
    else if (PH == 2) phase_rw_chunk(p, bid, nb, smem);
    else if (PH == 3) {
        if (bid < 32) rw_scan(p, bid, smem);
        else { moba_select(p, bid - 32, nb - 32, smem); phase_kvx(p, bid - 32, nb - 32, smem); phase_expconv<0>(p, bid - 32, nb - 32, smem); }
    }
    else if (PH == 4) { phase_rw_out(p, bid, nb); moba_fill(p, bid, nb, smem); __syncthreads(); phase_vtrans(p, bid, nb, smem); }
    else if (PH == 5) moba_partial(p, bid, nb, smem);
    else if (PH == 6) moba_own(p, bid, nb, smem);
    else if (PH == 7) phase_merge(p, bid, nb, smem);
    else if (PH == 8) phase_resid_gemm((const bf16_t*)(ws + OFF_MRG), D, (const bf16_t*)(ws + OFF_WOUT), p.x, p.out, bid, nb, smem);
    else if (PH == 9) { phase_norm(p.out, p.norm_xattn, (bf16_t*)(ws + OFF_XN), bid, nb); phase_expconv<1>(p, bid, nb, smem); }
    else if (PH == 10) phase_qx_xattn(p, bid, nb, smem);
    else if (PH == 11) phase_resid_gemm((const bf16_t*)(ws + OFF_OB), 512, (const bf16_t*)(ws + OFF_WOX), p.out, p.out, bid, nb, smem);
    else if (PH == 12) phase_router(p, bid, nb, smem);
    else if (PH == 13) phase_dispatch(p, bid, nb, smem);
    else if (PH == 14) phase_exp1(p, bid, nb, smem);
    else if (PH == 15) phase_exp2(p, bid, nb, smem);
    else if (PH == 16) phase_final(p, bid, nb);
}

#define XB_TMO      128
#define XB_XCNT(j)  (256  + 64 * (j))
#define XB_XSUB(j)  (1280 + 64 * (j))
#define XB_XGEN(j)  (2304 + 64 * (j))
#define XB_TOP      3328
#define XB_TOPGEN   3392
#define XCD_BAR_WORDS 3456
#define XB_SPIN_CAP (1u << 18)
__device__ __forceinline__ unsigned xb_ld(unsigned* p)              { return __hip_atomic_load(p, __ATOMIC_RELAXED, __HIP_MEMORY_SCOPE_AGENT); }
__device__ __forceinline__ unsigned xb_add(unsigned* p, unsigned v) { return __hip_atomic_fetch_add(p, v, __ATOMIC_RELAXED, __HIP_MEMORY_SCOPE_AGENT); }
__device__ __forceinline__ unsigned xb_xcc_id() { return (unsigned)__builtin_amdgcn_s_getreg((3 << 11) | 20) & 0xFu; }
#define XB_SPIN(cond, bar) do { unsigned _sp = 0; while (cond) { __builtin_amdgcn_s_sleep(1); \
    if ((++_sp & 255u) == 0u) { if (xb_ld(&(bar)[XB_TMO])) break; if (_sp > XB_SPIN_CAP) { atomicAdd(&(bar)[XB_TMO], 1u); break; } } } } while (0)
struct XcdBarrier { unsigned* bar; unsigned x; volatile LAS unsigned* st; };
__device__ __forceinline__ XcdBarrier xcd_barrier_post(unsigned* bar, volatile LAS unsigned* st) {
    XcdBarrier b; b.bar = bar; b.x = xb_xcc_id(); b.st = st;
    if (threadIdx.x == 0) (void)xb_add(&bar[XB_XCNT(b.x)], 1u);
    return b;
}
__device__ __forceinline__ void xcd_barrier_complete(unsigned* bar, unsigned x, unsigned& nloc, unsigned& nx) {
    const unsigned G = gridDim.x * gridDim.y * gridDim.z;
    unsigned sum, cnt, mine, sp = 0u;
    for (;;) {
        sum = 0u; cnt = 0u; mine = 0u;
#pragma unroll
        for (unsigned j = 0; j < 16; ++j) { const unsigned c = xb_ld(&bar[XB_XCNT(j)]); sum += c; cnt += (c > 0u) ? 1u : 0u; mine = (j == x) ? c : mine; }
        if (sum == G) break;
        __builtin_amdgcn_s_sleep(1);
        if ((++sp & 255u) == 0u) { if (xb_ld(&bar[XB_TMO])) break; if (sp > XB_SPIN_CAP) { atomicAdd(&bar[XB_TMO], 1u); break; } }
    }
    nloc = mine > 0u ? mine : 1u; nx = cnt > 0u ? cnt : 1u;
}
__device__ __forceinline__ void xcd_barrier(const XcdBarrier& b) {
    asm volatile("s_waitcnt vmcnt(0)" ::: "memory");
    __syncthreads();
    if (threadIdx.x == 0) {
        unsigned* bar = b.bar;
        __builtin_amdgcn_s_waitcnt(0);
        unsigned nloc = b.st[0], nx = b.st[1];
        if (nloc == 0u) { xcd_barrier_complete(bar, b.x, nloc, nx); b.st[0] = nloc; b.st[1] = nx; }
        const unsigned old = xb_add(&bar[XB_XSUB(b.x)], 1u);
        const unsigned gen = old / nloc;
        if (old + 1u == (gen + 1u) * nloc) {
            __builtin_amdgcn_fence(__ATOMIC_RELEASE, "agent");
            asm volatile("s_waitcnt vmcnt(0)" ::: "memory");
            const unsigned og = xb_add(&bar[XB_TOP], 1u);
            const unsigned tg = og / nx;
            if (og + 1u == (tg + 1u) * nx) xb_add(&bar[XB_TOPGEN], 1u);
            else XB_SPIN(xb_ld(&bar[XB_TOPGEN]) == tg, bar);
            __builtin_amdgcn_fence(__ATOMIC_ACQUIRE, "agent");
            xb_add(&bar[XB_XGEN(b.x)], 1u);
            asm volatile("s_waitcnt vmcnt(0)" ::: "memory");
        } else {
            XB_SPIN(xb_ld(&bar[XB_XGEN(b.x)]) == gen, bar);
            __builtin_amdgcn_fence(__ATOMIC_ACQUIRE, "agent");
            asm volatile("s_waitcnt vmcnt(0)" ::: "memory");
        }
    }
    __syncthreads();
}
constexpr int L_BARST = 154112;
constexpr int LDS_BYTES = 154368;
static_assert(2 * RW_LDS <= L_BARST && pg8::STAGE_BYTES <= L_BARST && A_TST + 2052 <= L_BARST, "lds");

__global__ void __launch_bounds__(NT, 2) mega_kernel(P p) {
    extern __shared__ __attribute__((aligned(16))) char smem[];
    const int bid = blockIdx.x, nb = gridDim.x;
    volatile LAS unsigned* bst = (volatile LAS unsigned*)(LAS char*)(smem + L_BARST);
    if (threadIdx.x < 2) bst[threadIdx.x] = 0u;
    __syncthreads();
    const XcdBarrier xb = xcd_barrier_post((unsigned*)(p.ws + OFF_CTL + CTL_BAR), bst);
#define GSYNC() xcd_barrier(xb)
    run_phase<0>(p, bid, nb, smem); GSYNC();
    run_phase<1>(p, bid, nb, smem); GSYNC();
    run_phase<2>(p, bid, nb, smem); GSYNC();
    run_phase<3>(p, bid, nb, smem); GSYNC();
    run_phase<4>(p, bid, nb, smem); GSYNC();
    run_phase<5>(p, bid, nb, smem); GSYNC();
    run_phase<6>(p, bid, nb, smem); GSYNC();
    run_phase<7>(p, bid, nb, smem); GSYNC();
    run_phase<8>(p, bid, nb, smem); GSYNC();
    run_phase<9>(p, bid, nb, smem); GSYNC();
    run_phase<10>(p, bid, nb, smem); GSYNC();
    run_phase<11>(p, bid, nb, smem); GSYNC();
    run_phase<12>(p, bid, nb, smem); GSYNC();
    run_phase<13>(p, bid, nb, smem); GSYNC();
    run_phase<14>(p, bid, nb, smem); GSYNC();
    run_phase<15>(p, bid, nb, smem); GSYNC();
    run_phase<16>(p, bid, nb, smem);
}

extern "C" void kernel_launch(void* const* d_in, const int* in_sizes, int n_in, void* d_out, int out_size, void* d_ws, size_t ws_size, hipStream_t stream) {
    if (n_in != 31 || ws_size < WS_NEED || out_size != T * D) { fprintf(stderr, "kernel_launch: unexpected n_in %d / ws_size %zu / out_size %d\n", n_in, ws_size, out_size); return; }
    static int grid_blocks = 0;
    if (!grid_blocks) {
        int dev = 0, cus = 0, per_cu = 0;
        (void)hipGetDevice(&dev);
        (void)hipDeviceGetAttribute(&cus, hipDeviceAttributeMultiprocessorCount, dev);
        if (hipFuncSetAttribute((const void*)mega_kernel, hipFuncAttributeMaxDynamicSharedMemorySize, LDS_BYTES) != hipSuccess) fprintf(stderr, "kernel_launch: hipFuncSetAttribute failed\n");
        (void)hipOccupancyMaxActiveBlocksPerMultiprocessor(&per_cu, (const void*)mega_kernel, NT, LDS_BYTES);
        if (per_cu < 1) { fprintf(stderr, "kernel_launch: occupancy query returned %d\n", per_cu); per_cu = 1; }
        grid_blocks = cus;
        if (grid_blocks % 8) grid_blocks -= grid_blocks % 8;
        fprintf(stderr, "kernel_launch: cus %d per_cu %d grid %d\n", cus, per_cu, grid_blocks);
    }
    P p{};
    const float** f = (const float**)&p;
    for (int i = 0; i < 31; ++i) f[i] = (const float*)d_in[i];
    p.out = (float*)d_out; p.ws = (char*)d_ws;
    if (hipMemsetAsync((char*)d_ws + OFF_CTL + CTL_BAR, 0, XCD_BAR_WORDS * 4, stream) != hipSuccess) fprintf(stderr, "kernel_launch: memset failed\n");
    void* args[] = {&p};
    hipError_t e = hipLaunchCooperativeKernel((const void*)mega_kernel, dim3(grid_blocks), dim3(NT), args, LDS_BYTES, stream);
    if (e != hipSuccess) fprintf(stderr, "cooperative launch failed: %s (grid %d)\n", hipGetErrorString(e), grid_blocks);
}
```

```cpp
#include <hip/hip_runtime.h>
#include <cstdio>
#include <cstdint>

typedef unsigned short bf16_t;
typedef short bf16x8 __attribute__((ext_vector_type(8)));
typedef float f32x4 __attribute__((ext_vector_type(4)));
typedef float f32x2 __attribute__((ext_vector_type(2)));
typedef unsigned u32x4 __attribute__((ext_vector_type(4)));
typedef unsigned u32x2 __attribute__((ext_vector_type(2)));
typedef __bf16 bf16x2_t __attribute__((ext_vector_type(2)));
#define LAS __attribute__((address_space(3)))
#define MFMA16(a, b, c) __builtin_amdgcn_mfma_f32_16x16x32_bf16((a), (b), (c), 0, 0, 0)

constexpr int NT = 512;
constexpr int T = 16384, D = 1024, NMEM = 256;
constexpr int UMC = 1536;
constexpr int RW = 512, RCOLS = 1792, MW = 512, MCOLS = 1536, GCOLS = 2048, INCOLS = 5376;
constexpr int NEXP = 32, DEXP = 512, MBLK = 256, NBLK = 160, CAP = NBLK * MBLK;
constexpr size_t MiB = 1u << 20;
constexpr size_t OFF_CTL = 0;
constexpr size_t OFF_WIN = 1 * MiB;
constexpr size_t OFF_WORW = OFF_WIN + (size_t)INCOLS * D * 2;
constexpr size_t OFF_WOMB = OFF_WORW + 1 * MiB;
constexpr size_t OFF_WOUT = OFF_WOMB + 1 * MiB;
constexpr size_t OFF_WQ = OFF_WOUT + 2 * MiB;
constexpr size_t OFF_WKV = OFF_WQ + 1 * MiB;
constexpr size_t OFF_WOX = OFF_WKV + 2 * MiB;
constexpr size_t OFF_MEMN = OFF_WOX + 1 * MiB;
constexpr size_t OFF_KVX = OFF_MEMN + MiB / 2;
constexpr size_t OFF_ROUT = OFF_KVX + MiB / 2;
constexpr size_t OFF_LORA_D = OFF_ROUT + 160 * 1024;
constexpr size_t OFF_LORA_I = OFF_LORA_D + 64 * 1024;
constexpr size_t OFF_LORA_G = OFF_LORA_I + 64 * 1024;
constexpr size_t OFF_XN = 21 * MiB;
constexpr size_t DOUT_BON = 32 * MiB;
constexpr size_t DOUT_RH = 48 * MiB;
constexpr size_t OFF_UG = 53 * MiB;
constexpr size_t OFF_UR = 117 * MiB;
constexpr size_t OFF_UM = 173 * MiB;
constexpr size_t OFF_OA = 221 * MiB;
constexpr size_t OFF_OB = 237 * MiB;
constexpr size_t OFF_MRG = 253 * MiB;
constexpr size_t OFF_MF = 253 * MiB;
constexpr size_t OFF_SF = 269 * MiB;
constexpr size_t OFF_VT = 253 * MiB;
constexpr size_t OFF_EXPD = 117 * MiB;
constexpr size_t OFF_EXPGU = 149 * MiB;
constexpr size_t OFF_YMOE = 21 * MiB;
constexpr size_t OFF_XB0 = 101 * MiB;
constexpr size_t OFF_XB1 = 213 * MiB;
constexpr size_t OFF_MSEL = 285 * MiB;
constexpr size_t OFF_MQL = OFF_MSEL + MiB / 2;
constexpr size_t OFF_MSP = OFF_MQL + 3 * MiB / 2;
constexpr size_t WS_NEED = 293 * MiB;
static_assert(OFF_LORA_G + 128 * 1024 <= OFF_XN, "ws map");
constexpr size_t CTL_CNT = 0;
constexpr size_t CTL_BLKE = 4096;
constexpr size_t CTL_MCNT = 8192, CTL_MCUR = 10240, CTL_MLST = 12288, CTL_MTST = 14592, CTL_MCST = 16896;
constexpr size_t CTL_TOKE = 192 * 1024;
constexpr size_t CTL_TOKG = 320 * 1024;
constexpr size_t CTL_TOKS = 448 * 1024;
constexpr size_t CTL_ROWTOK = 576 * 1024;
constexpr size_t CTL_BAR = 752 * 1024;
constexpr size_t CTL_KMS = 832 * 1024;

struct P {
    const float *x, *mem, *rel_bias, *mem_norm, *norm_mix, *w_in, *tshift_mu, *decay_w0, *decay_up, *iclr_a0, *iclr_up, *gate_up,
        *k_k, *k_a, *r_k, *ln_x_w, *ln_x_b, *w_o_rwkv, *w_o_moba, *w_out, *norm_xattn, *w_q_x, *w_kv_x, *w_o_x, *norm_ffn,
        *w_router_group, *w_router_expert, *w_exp_gate, *w_exp_up, *w_exp_down, *norm_final;
    float* out;
    char* ws;
};

__device__ __forceinline__ int otid() { int t = threadIdx.x; asm volatile("" : "+v"(t)); return t; }
__device__ __forceinline__ float bf2f(bf16_t b) { return __uint_as_float((unsigned)b << 16); }
__device__ __forceinline__ unsigned f2bf(float f) { unsigned u = __float_as_uint(f); return (u + 0x7fffu + ((u >> 16) & 1u)) >> 16; }
__device__ __forceinline__ unsigned cvt_pk(float lo, float hi) { const f32x2 v = {lo, hi}; return __builtin_bit_cast(unsigned, __builtin_convertvector(v, bf16x2_t)); }
__device__ __forceinline__ unsigned pk2(float lo, float hi) { return cvt_pk(lo, hi); }
__device__ __forceinline__ u32x2 pack4(f32x4 v) { u32x2 o; o.x = cvt_pk(v.x, v.y); o.y = cvt_pk(v.z, v.w); return o; }
__device__ __forceinline__ bf16x8 pack8(f32x4 a, f32x4 b) { u32x4 o; o.x = cvt_pk(a.x, a.y); o.y = cvt_pk(a.z, a.w); o.z = cvt_pk(b.x, b.y); o.w = cvt_pk(b.z, b.w); return __builtin_bit_cast(bf16x8, o); }
__device__ __forceinline__ bf16x8 ldperm(const char* rowbase, int ks, int fq) {
    const u32x2 a = *(const u32x2*)(rowbase + (32 * ks + fq * 4) * 2), b = *(const u32x2*)(rowbase + (32 * ks + 16 + fq * 4) * 2);
    u32x4 o; o.x = a.x; o.y = a.y; o.z = b.x; o.w = b.y; return __builtin_bit_cast(bf16x8, o);
}
__device__ __forceinline__ float wave_sum(float v) {
#pragma unroll
    for (int o = 32; o >= 1; o >>= 1) v += __shfl_xor(v, o);
    return v;
}
__device__ __forceinline__ float sigm(float x) { return __builtin_amdgcn_rcpf(1.f + __expf(-x)); }
__device__ __forceinline__ void unpack8(u32x4 w, float* f) {
    f[0] = __uint_as_float(w.x << 16); f[1] = __uint_as_float(w.x & 0xffff0000u);
    f[2] = __uint_as_float(w.y << 16); f[3] = __uint_as_float(w.y & 0xffff0000u);
    f[4] = __uint_as_float(w.z << 16); f[5] = __uint_as_float(w.z & 0xffff0000u);
    f[6] = __uint_as_float(w.w << 16); f[7] = __uint_as_float(w.w & 0xffff0000u);
}
__device__ __forceinline__ f32x4 unpack4(u32x2 w) { f32x4 r; r.x = __uint_as_float(w.x << 16); r.y = __uint_as_float(w.x & 0xffff0000u); r.z = __uint_as_float(w.y << 16); r.w = __uint_as_float(w.y & 0xffff0000u); return r; }

namespace pg8 {
constexpr int BM = 256, BK = 64, HALF = 128, HTB = HALF * BK * 2  , STAGE_BYTES = 8 * HTB, NXCD = 8, WGM = 8;
__device__ __forceinline__ int lds_byte(int r, int c) { const int st = (r >> 4) * 2 + (c >> 5), rr = r & 15, cc = c & 31, ob = rr * 64 + cc * 2; return st * 1024 + (ob ^ (((ob >> 9) & 1) << 5)); }
__device__ __forceinline__ void stage_rc(int b, int& R, int& C) { const int st = b / 1024, sb = b % 1024, swz = sb ^ (((sb >> 9) & 1) << 5); R = (st >> 1) * 16 + swz / 64; C = (st & 1) * 32 + (swz % 64) / 2; }
__device__ __forceinline__ int perm32(int rho) { const int n = rho >> 4, i = rho & 15; return 8 * (i >> 2) + 4 * n + (i & 3); }
struct Unit { int pm, pn, e; };

struct StaticOrder {
    int nM, nN, nwg, G, c;
    __device__ void init(int M, int N, int G_, int c_) { nM = M / BM; nN = N / BM; nwg = nM * nN; G = G_; c = c_; }
    __device__ bool next(int i, Unit& u) const {
        const long L = (long)i * G + c; if (L >= nwg) return false;
        int wgid = (int)L; { const int q = nwg / NXCD, r = nwg % NXCD, xcd = wgid % NXCD, off = wgid / NXCD; wgid = (xcd < r ? xcd * (q + 1) : r * (q + 1) + (xcd - r) * q) + off; }
        const int nig = WGM * nN, gid = wgid / nig, fm = gid * WGM, gsz = (nM - fm) < WGM ? (nM - fm) : WGM;
        u.pm = fm + ((wgid % nig) % gsz); u.pn = (wgid % nig) / gsz; u.e = 0; return true;
    }
    __device__ __forceinline__ unsigned rowA(const Unit& u, int r) const { return (unsigned)(u.pm * BM + r); }
    __device__ __forceinline__ unsigned rowB(const Unit& u, int r) const { return (unsigned)(u.pn * BM + r); }
};

template <class Epi, class Sched, bool ALIGN_EPI>
__device__ __forceinline__ void gemm_phase(LAS unsigned char* lds, const bf16_t* Ab, const bf16_t* Bb, const int K, const Sched& S, const Epi& E) {
    const int tid = otid(), wid = __builtin_amdgcn_readfirstlane(tid >> 6), lane = tid & 63, wr = wid >> 2, wc = wid & 3, fr = lane & 15, fq = lane >> 4;
    const int nt = K / BK;
    int sR[2], sC[2], sRb[2];
#pragma unroll
    for (int i = 0; i < 2; ++i) { int R, C; stage_rc(tid * 16 + i * 8192, R, C); sR[i] = R; sC[i] = C; sRb[i] = Epi::PERM ? ((R & ~31) + perm32(R & 31)) : R; }
    const unsigned kstep = (unsigned)(BK * 2);
    const unsigned ldsw = (unsigned)wid * 1024u;
    const int aoff = lds_byte(wr * 64 + fr, fq * 8), boff = lds_byte(wc * 32 + fr, fq * 8);
#define PG8_SA(b, h) (((b) * 2 + (h)) * HTB)
#define PG8_SB(b, h) ((4 + (b) * 2 + (h)) * HTB)
#define PG8_STAGE(bufoff, gbase, offs, kb) do { _Pragma("unroll") for (int _i = 0; _i < 2; ++_i) \
        __builtin_amdgcn_global_load_lds((const unsigned*)((const char*)(gbase) + (size_t)((offs)[_i] + (kb))), (LAS unsigned*)(lds + (bufoff) + ldsw + _i * 8192), 16, 0, 0); } while (0)
#define PG8_LDA(dst, b, h) do { _Pragma("unroll") for (int m = 0; m < 4; ++m) _Pragma("unroll") for (int k = 0; k < 2; ++k) dst[m][k] = *(const LAS bf16x8*)(lds + PG8_SA(b, h) + aoff + m * 2048 + k * 1024); } while (0)
#define PG8_LDB(dst, b, h) do { _Pragma("unroll") for (int n = 0; n < 2; ++n) _Pragma("unroll") for (int k = 0; k < 2; ++k) dst[n][k] = *(const LAS bf16x8*)(lds + PG8_SB(b, h) + boff + n * 2048 + k * 1024); } while (0)
#define PG8_MMA(ai, bj, At, Bt) do { __builtin_amdgcn_s_setprio(1); _Pragma("unroll") for (int m = 0; m < 4; ++m) _Pragma("unroll") for (int n = 0; n < 2; ++n) _Pragma("unroll") for (int k = 0; k < 2; ++k) \
        acc[ai][bj][m][n] = __builtin_amdgcn_mfma_f32_16x16x32_bf16(Bt[n][k], At[m][k], acc[ai][bj][m][n], 0, 0, 0); __builtin_amdgcn_s_setprio(0); } while (0)
#define PG8_WAIT_V(n) asm volatile("s_waitcnt vmcnt(" #n ")" ::: "memory")
#define PG8_WAIT_L(n) asm volatile("s_waitcnt lgkmcnt(" #n ")" ::: "memory")
#define PG8_BAR __builtin_amdgcn_s_barrier()
#define PG8_SCHED __builtin_amdgcn_sched_barrier(0)
#define PG8_OFFS(u, AO, BO) do { _Pragma("unroll") for (int _h = 0; _h < 2; ++_h) _Pragma("unroll") for (int _i = 0; _i < 2; ++_i) { \
        AO[_h][_i] = (S.rowA(u, _h * HALF + sR[_i]) * (unsigned)K + (unsigned)sC[_i]) * 2u; BO[_h][_i] = (S.rowB(u, _h * HALF + sRb[_i]) * (unsigned)K + (unsigned)sC[_i]) * 2u; } } while (0)
    Unit cur, nxt; int ui = 0;
    if (!S.next(0, cur)) return;
    f32x4 acc[2][2][4][2];
#pragma unroll
    for (int a = 0; a < 2; ++a)
#pragma unroll
        for (int b = 0; b < 2; ++b)
#pragma unroll
            for (int m = 0; m < 4; ++m)
#pragma unroll
                for (int n = 0; n < 2; ++n) acc[a][b][m][n] = (f32x4){0.f, 0.f, 0.f, 0.f};
    bf16x8 At[4][2], B0[2][2], B1[2][2];
    unsigned ao[2][2], bo[2][2], nao[2][2], nbo[2][2];
    PG8_OFFS(cur, ao, bo);
    PG8_STAGE(PG8_SB(0, 0), Bb, bo[0], 0u); PG8_STAGE(PG8_SB(0, 1), Bb, bo[1], 0u); PG8_STAGE(PG8_SA(0, 0), Ab, ao[0], 0u); PG8_STAGE(PG8_SA(0, 1), Ab, ao[1], 0u);
    if (wr == 1) PG8_BAR;
    PG8_WAIT_V(2); PG8_BAR;
    PG8_STAGE(PG8_SB(1, 0), Bb, bo[0], kstep); PG8_STAGE(PG8_SA(1, 0), Ab, ao[0], kstep); PG8_STAGE(PG8_SB(1, 1), Bb, bo[1], kstep);
    PG8_WAIT_V(6); PG8_BAR;
    for (;;) {
        const bool has_next = S.next(ui + 1, nxt);
        if (has_next) { PG8_OFFS(nxt, nao, nbo); }
        else {
#pragma unroll
            for (int h = 0; h < 2; ++h)
#pragma unroll
                for (int i = 0; i < 2; ++i) { nao[h][i] = ao[h][i]; nbo[h][i] = bo[h][i]; }
        }
        for (int t = 0; t < nt; t += 2) {
            const bool last = (t == nt - 2);
            const unsigned k1 = (unsigned)(t + 1) * kstep, k2 = last ? 0u : (unsigned)(t + 2) * kstep, k3 = k2 + kstep;
            unsigned a2[2][2], b2[2][2];
#pragma unroll
            for (int h = 0; h < 2; ++h)
#pragma unroll
                for (int i = 0; i < 2; ++i) { a2[h][i] = last ? nao[h][i] : ao[h][i]; b2[h][i] = last ? nbo[h][i] : bo[h][i]; }
            PG8_LDB(B0, 0, 0); PG8_LDB(B1, 0, 1); PG8_SCHED; PG8_LDA(At, 0, 0); PG8_STAGE(PG8_SA(1, 1), Ab, ao[1], k1);
            PG8_WAIT_V(8); PG8_WAIT_L(0); PG8_BAR; PG8_MMA(0, 0, At, B0); PG8_MMA(0, 1, At, B1); PG8_BAR; PG8_SCHED;
            PG8_LDA(At, 0, 1); PG8_STAGE(PG8_SB(0, 0), Bb, b2[0], k2); PG8_STAGE(PG8_SB(0, 1), Bb, b2[1], k2); PG8_STAGE(PG8_SA(0, 0), Ab, a2[0], k2);
            PG8_WAIT_V(8); PG8_WAIT_L(0); PG8_BAR; PG8_MMA(1, 0, At, B0); PG8_MMA(1, 1, At, B1); PG8_BAR; PG8_SCHED;
            PG8_LDB(B0, 1, 0); PG8_LDB(B1, 1, 1); PG8_SCHED; PG8_LDA(At, 1, 0); PG8_STAGE(PG8_SA(0, 1), Ab, a2[1], k2);
            PG8_WAIT_V(8); PG8_WAIT_L(0); PG8_BAR; PG8_MMA(0, 0, At, B0); PG8_MMA(0, 1, At, B1); PG8_BAR; PG8_SCHED;
            PG8_LDA(At, 1, 1); PG8_STAGE(PG8_SB(1, 0), Bb, b2[0], k3); PG8_STAGE(PG8_SB(1, 1), Bb, b2[1], k3); PG8_STAGE(PG8_SA(1, 0), Ab, a2[0], k3);
            PG8_WAIT_V(8); PG8_WAIT_L(0); PG8_BAR; PG8_MMA(1, 0, At, B0); PG8_MMA(1, 1, At, B1); PG8_BAR; PG8_SCHED;
        }
        if constexpr (ALIGN_EPI) { if (wr == 0) PG8_BAR; }
        E(acc, cur, wr, wc, fr, fq);
        if (!has_next) break;
#pragma unroll
        for (int a = 0; a < 2; ++a)
#pragma unroll
            for (int b = 0; b < 2; ++b)
#pragma unroll
                for (int m = 0; m < 4; ++m)
#pragma unroll
                    for (int n = 0; n < 2; ++n) acc[a][b][m][n] = (f32x4){0.f, 0.f, 0.f, 0.f};
        cur = nxt; ++ui;
#pragma unroll
        for (int h = 0; h < 2; ++h)
#pragma unroll
            for (int i = 0; i < 2; ++i) { ao[h][i] = nao[h][i]; bo[h][i] = nbo[h][i]; }
        if constexpr (ALIGN_EPI) { if (wr == 1) PG8_BAR; }
    }
    PG8_WAIT_V(0);
    if constexpr (!ALIGN_EPI) { if (wr == 0) PG8_BAR; }
    PG8_BAR;
#undef PG8_SA
#undef PG8_SB
#undef PG8_STAGE
#undef PG8_LDA
#undef PG8_LDB
#undef PG8_MMA
#undef PG8_WAIT_V
#undef PG8_WAIT_L
#undef PG8_BAR
#undef PG8_SCHED
#undef PG8_OFFS
}
}

__device__ __forceinline__ void gemm_r32(f32x4 (&acc)[2][8], const bf16_t* A, int lda, int brow, const bf16_t* Bt, int ldb, int bcol, int K, char* smem) {
    const int tid = otid(), lane = tid & 63, wid = tid >> 6, fr = lane & 15, fq = lane >> 4;
    const int r0 = tid >> 3, lch = (tid & 7) ^ ((tid >> 4) & 7);
    const bf16_t* pa[4]; const bf16_t* pb[2];
#pragma unroll
    for (int i = 0; i < 4; ++i) pa[i] = A + (long)(brow + r0 + 64 * i) * lda + lch * 8;
#pragma unroll
    for (int i = 0; i < 2; ++i) pb[i] = Bt + (long)(bcol + r0 + 64 * i) * ldb + lch * 8;
    const int nk = K / 64;
    auto stage = [&](int kt, int st) {
        char* nx = smem + st * 49152;
#pragma unroll
        for (int i = 0; i < 4; ++i) __builtin_amdgcn_global_load_lds((const unsigned*)(pa[i] + kt * 64), (unsigned*)(nx + tid * 16 + i * 8192), 16, 0, 0);
#pragma unroll
        for (int i = 0; i < 2; ++i) __builtin_amdgcn_global_load_lds((const unsigned*)(pb[i] + kt * 64), (unsigned*)(nx + 32768 + tid * 16 + i * 8192), 16, 0, 0);
    };
    stage(0, 0); stage(1, 1);
    const int sw = fr >> 1;
    int st = 0;
    for (int kt = 0; kt < nk; ++kt) {
        if (kt + 1 < nk) asm volatile("s_waitcnt vmcnt(6)" ::: "memory"); else asm volatile("s_waitcnt vmcnt(0)" ::: "memory");
        __builtin_amdgcn_s_barrier(); asm volatile("" ::: "memory");
        char* cur = smem + st * 49152;
        const int st2 = st == 0 ? 2 : st - 1;
        if (kt + 2 < nk) stage(kt + 2, st2);
#pragma unroll
        for (int ks = 0; ks < 2; ++ks) {
            const int pc = ((ks * 4 + fq) ^ sw) * 16;
            bf16x8 At[2], Bf[8];
#pragma unroll
            for (int m = 0; m < 2; ++m) At[m] = *(const bf16x8*)(cur + (wid * 32 + m * 16 + fr) * 128 + pc);
#pragma unroll
            for (int n = 0; n < 8; ++n) Bf[n] = *(const bf16x8*)(cur + 32768 + (n * 16 + fr) * 128 + pc);
#pragma unroll
            for (int m = 0; m < 2; ++m)
#pragma unroll
                for (int n = 0; n < 8; ++n) acc[m][n] = MFMA16(Bf[n], At[m], acc[m][n]);
        }
        st = st == 2 ? 0 : st + 1;
    }
    __syncthreads();
}

__device__ __forceinline__ void transpose_tile(const float* W, int K, int N, bf16_t* Wt, int rs, int roff, int tile, float* scr  ) {
    const int tid = otid();
    const int nnb = N / 128, kb = tile / nnb, nb = tile % nnb, k0 = kb * 64, n0 = nb * 128;
#pragma unroll 4
    for (int i = 0; i < 16; ++i) { const int k = i * 4 + (tid >> 7), n = tid & 127; scr[k * 129 + n] = W[(size_t)(k0 + k) * N + n0 + n]; }
    __syncthreads();
#pragma unroll
    for (int i = 0; i < 2; ++i) {
        const int c = tid + i * 512, n = c >> 3, kc = c & 7;
        const float* s = scr + (kc * 8) * 129 + n;
        u32x4 o; o.x = pk2(s[0], s[129]); o.y = pk2(s[2 * 129], s[3 * 129]); o.z = pk2(s[4 * 129], s[5 * 129]); o.w = pk2(s[6 * 129], s[7 * 129]);
        const int nn = n0 + n, drow = (nn >> 4) * rs + (nn & 15) + roff;
        *(u32x4*)(Wt + (size_t)drow * K + k0 + kc * 8) = o;
    }
    __syncthreads();
}
__device__ __forceinline__ void rms_row_bf16(const float* xrow, const f32x4 (&gr)[4], bf16_t* orow, int lane) {
    const f32x4* xr = (const f32x4*)xrow + lane;
    f32x4 v[4]; float s = 0.f;
#pragma unroll
    for (int j = 0; j < 4; ++j) { v[j] = xr[64 * j]; s += v[j].x * v[j].x + v[j].y * v[j].y + v[j].z * v[j].z + v[j].w * v[j].w; }
    const float rstd = rsqrtf(wave_sum(s) * (1.f / 1024.f) + 1e-6f);
    u32x2* o8 = (u32x2*)orow + lane;
#pragma unroll
    for (int j = 0; j < 4; ++j) { const f32x4 gg = gr[j]; u32x2 o; o.x = pk2(v[j].x * rstd * gg.x, v[j].y * rstd * gg.y); o.y = pk2(v[j].z * rstd * gg.z, v[j].w * rstd * gg.w); o8[64 * j] = o; }
}
__device__ __forceinline__ void load_gain(f32x4 (&gr)[4], const float* g, int lane) {
#pragma unroll
    for (int j = 0; j < 4; ++j) gr[j] = ((const f32x4*)g + lane)[64 * j];
}
constexpr int P0_T_IN = 16 * 42, P0_T_A = 64, P0_T_B = 128, P0_T_L = 4 + 4 + 8;
constexpr int P0_TR2 = 4 * P0_T_A + 2 * P0_T_B + P0_T_L;
constexpr int P0_ROUT = 72, P0_NORM = T / 8, P0_MEM = NMEM / 8;
constexpr int P0_ITEMS = P0_T_IN + P0_ROUT + P0_NORM + P0_MEM + 1;
__device__ __forceinline__ void p0_other_transposes(const P& p, int first, int stride, char* smem) {
    char* ws = p.ws; float* scr = (float*)smem;
    for (int it = first; it < P0_TR2; it += stride) {
        int r = it;
        if (r < P0_T_A) { transpose_tile(p.w_o_rwkv, RW, D, (bf16_t*)(ws + OFF_WORW), 16, 0, r, scr); continue; } r -= P0_T_A;
        if (r < P0_T_A) { transpose_tile(p.w_o_moba, MW, D, (bf16_t*)(ws + OFF_WOMB), 16, 0, r, scr); continue; } r -= P0_T_A;
        if (r < P0_T_B) { transpose_tile(p.w_out, D, D, (bf16_t*)(ws + OFF_WOUT), 16, 0, r, scr); continue; } r -= P0_T_B;
        if (r < P0_T_A) { transpose_tile(p.w_q_x, D, 512, (bf16_t*)(ws + OFF_WQ), 16, 0, r, scr); continue; } r -= P0_T_A;
        if (r < P0_T_B) { transpose_tile(p.w_kv_x, D, D, (bf16_t*)(ws + OFF_WKV), 16, 0, r, scr); continue; } r -= P0_T_B;
        if (r < P0_T_A) { transpose_tile(p.w_o_x, 512, D, (bf16_t*)(ws + OFF_WOX), 16, 0, r, scr); continue; } r -= P0_T_A;
        if (r < 4) { transpose_tile(p.decay_up, 64, 512, (bf16_t*)(ws + OFF_LORA_D), 16, 0, r, scr); continue; } r -= 4;
        if (r < 4) { transpose_tile(p.iclr_up, 64, 512, (bf16_t*)(ws + OFF_LORA_I), 16, 0, r, scr); continue; } r -= 4;
        transpose_tile(p.gate_up, 128, 512, (bf16_t*)(ws + OFF_LORA_G), 16, 0, r, scr);
    }
}
__device__ __forceinline__ void phase0(const P& p, int bid, int nb, char* smem) {
    const int tid = otid(), lane = tid & 63, wid = tid >> 6;
    char* ws = p.ws;
    for (int i = bid * NT + tid; i < 64 * 512; i += nb * NT) ((float*)(ws + OFF_CTL + CTL_KMS))[i] = 0.f;
    f32x4 gmix[4], gmem[4]; load_gain(gmix, p.norm_mix, lane); load_gain(gmem, p.mem_norm, lane);
    for (int it = bid; it < P0_ITEMS; it += nb) {
        int r = it;
        if (r < P0_T_IN) { transpose_tile(p.w_in, D, INCOLS, (bf16_t*)(ws + OFF_WIN), 16, 0, r, (float*)smem); continue; }
        r -= P0_T_IN;
        if (r < P0_ROUT) {
            const int e = r * 512 + tid, o = e >> 10, k = e & 1023;
            float* rt = (float*)(ws + OFF_ROUT);
            rt[e] = (o < 32) ? p.w_router_expert[k * 32 + o] : p.w_router_group[k * 4 + (o - 32)];
            continue;
        }
        r -= P0_ROUT;
        if (r < P0_NORM) { const int row = r * 8 + wid; rms_row_bf16(p.x + (size_t)row * D, gmix, (bf16_t*)(ws + OFF_XN) + (size_t)row * D, lane); continue; }
        r -= P0_NORM;
        if (r < P0_MEM) { const int row = r * 8 + wid; rms_row_bf16(p.mem + (size_t)row * D, gmem, (bf16_t*)(ws + OFF_MEMN) + (size_t)row * D, lane); continue; }
        if (tid < 80) ((int*)(ws + OFF_CTL + CTL_CNT))[tid] = 0;
        for (int i = tid; i < 1024; i += NT) ((int*)(ws + OFF_CTL + CTL_MCNT))[i] = 0;
    }
}

struct EpiU {
    static constexpr bool PERM = true;
    char* ws; int coff;
    __device__ __forceinline__ void operator()(const f32x4 (&acc)[2][2][4][2], const pg8::Unit& u, int wr, int wc, int fr, int fq) const {
        const int colt = u.pn * 256 + coff;
        bf16_t* dst; int ld, cb; bool sg = false;
        if (colt < RCOLS) { dst = (bf16_t*)(ws + OFF_UR); ld = RCOLS; cb = colt; }
        else if (colt < RCOLS + MCOLS) { dst = (bf16_t*)(ws + OFF_UM); ld = UMC; cb = colt - RCOLS; }
        else { dst = (bf16_t*)(ws + OFF_UG); ld = GCOLS; cb = colt - RCOLS - MCOLS; sg = true; }
        const int row0 = u.pm * 256 + wr * 64 + fr, col0 = cb + wc * 32 + 8 * fq;
#pragma unroll
        for (int ai = 0; ai < 2; ++ai)
#pragma unroll
            for (int m = 0; m < 4; ++m) {
                bf16_t* rowp = dst + (size_t)(row0 + ai * 128 + m * 16) * ld + col0;
#pragma unroll
                for (int bj = 0; bj < 2; ++bj) {
                    f32x4 v0 = acc[ai][bj][m][0], v1 = acc[ai][bj][m][1];
                    if (sg) { v0.x = sigm(v0.x); v0.y = sigm(v0.y); v0.z = sigm(v0.z); v0.w = sigm(v0.w); v1.x = sigm(v1.x); v1.y = sigm(v1.y); v1.z = sigm(v1.z); v1.w = sigm(v1.w); }
                    u32x4 w; w.x = cvt_pk(v0.x, v0.y); w.y = cvt_pk(v0.z, v0.w); w.z = cvt_pk(v1.x, v1.y); w.w = cvt_pk(v1.z, v1.w);
                    *(u32x4*)(rowp + bj * 128) = w;
                }
            }
        if (colt >= RCOLS + 512 && colt < RCOLS + 1024) {
            float* kms = (float*)(ws + OFF_CTL + CTL_KMS) + (size_t)u.pm * 512 + (colt - RCOLS - 512) + wc * 32 + 8 * fq;
#pragma unroll
            for (int bj = 0; bj < 2; ++bj)
#pragma unroll
                for (int n = 0; n < 2; ++n) {
                    f32x4 sv = {0.f, 0.f, 0.f, 0.f};
#pragma unroll
                    for (int ai = 0; ai < 2; ++ai)
#pragma unroll
                        for (int m = 0; m < 4; ++m) sv = sv + acc[ai][bj][m][n];
#pragma unroll
                    for (int o = 1; o < 16; o <<= 1) { sv.x += __shfl_xor(sv.x, o); sv.y += __shfl_xor(sv.y, o); sv.z += __shfl_xor(sv.z, o); sv.w += __shfl_xor(sv.w, o); }
                    if (fr == 0) { float* d = kms + bj * 128 + 4 * n; atomicAdd(d, sv.x); atomicAdd(d + 1, sv.y); atomicAdd(d + 2, sv.z); atomicAdd(d + 3, sv.w); }
                }
        }
    }
};
constexpr int P1_COLS = INCOLS - 256;
__device__ __forceinline__ void phase1_deferred(const P& p, int idx, int n, char* smem) {
    pg8::StaticOrder S; S.init(T, 256, n, idx);
    EpiU E{p.ws, P1_COLS};
    pg8::gemm_phase<EpiU, pg8::StaticOrder, true>((LAS unsigned char*)smem, (const bf16_t*)(p.ws + OFF_XN), (const bf16_t*)(p.ws + OFF_WIN) + (size_t)P1_COLS * D, D, S, E);
}
__device__ __forceinline__ void phase1(const P& p, int bid, int nb, char* smem) {
    pg8::StaticOrder S; S.init(T, P1_COLS, nb, bid);
    EpiU E{p.ws, 0};
    pg8::gemm_phase<EpiU, pg8::StaticOrder, true>((LAS unsigned char*)smem, (const bf16_t*)(p.ws + OFF_XN), (const bf16_t*)(p.ws + OFF_WIN), D, S, E);
    const int nwg = (T / 256) * (P1_COLS / 256), extra = nwg % nb;
    if (extra == 0) p0_other_transposes(p, bid, nb, smem);
    else if (bid >= extra) p0_other_transposes(p, bid - extra, nb - extra, smem);
}

__device__ __forceinline__ void phase_vtrans(const P& p, int bid, int nb, char* smem) {
    const int tid = otid();
    const bf16_t* um = (const bf16_t*)(p.ws + OFF_UM); bf16_t* vt = (bf16_t*)(p.ws + OFF_VT);
    for (int it = bid; it < 256 * 4; it += nb) {
        const int tt = it >> 2, cq = it & 3, t0 = tt * 64, c0 = cq * 128;
#pragma unroll
        for (int i = 0; i < 2; ++i) { const int c = tid + i * 512, r = c >> 4, ch = c & 15; *(u32x4*)(smem + r * 272 + ch * 16) = *(const u32x4*)(um + (size_t)(t0 + r) * UMC + 1024 + c0 + ch * 8); }
        __syncthreads();
#pragma unroll
        for (int i = 0; i < 2; ++i) {
            const int c = tid + i * 512, col = c >> 3, tc = c & 7;
            unsigned short e[8];
#pragma unroll
            for (int j = 0; j < 8; ++j) e[j] = *(const unsigned short*)(smem + (tc * 8 + j) * 272 + col * 2);
            u32x4 o; o.x = e[0] | ((unsigned)e[1] << 16); o.y = e[2] | ((unsigned)e[3] << 16); o.z = e[4] | ((unsigned)e[5] << 16); o.w = e[6] | ((unsigned)e[7] << 16);
            *(u32x4*)(vt + (size_t)(c0 + col) * T + t0 + tc * 8) = o;
        }
        __syncthreads();
    }
}

constexpr int SLOT = 9216, ROWB = 144, LIN_ROWB = 528;
constexpr int L_WL = 0 * SLOT, L_AL = 1 * SLOT, L_LIN = 2 * SLOT, L_AT = 2 * SLOT, L_BT = 3 * SLOT, L_KT = 4 * SLOT, L_RT = 5 * SLOT, L_VT = 6 * SLOT, L_ATT = 7 * SLOT;
constexpr int L_AAB = L_AT, L_AKV = L_BT, L_BBT = L_WL, L_KBT = L_AL, L_TD = L_KT;
constexpr int L_WTOT = 8 * SLOT, L_WC = L_WTOT + 1024, L_PAR = L_WC + 256, RW_LDS = L_PAR + 2048;

typedef float f32x2 __attribute__((ext_vector_type(2)));
template <int TT> struct SolveRow {
    static __device__ __forceinline__ void run(f32x2 (&x)[32], const char* Lb, const u32x4 (&lcur)[8]) {
        u32x4 lnext[8];
        constexpr int NCN = (TT + 1 < 64) ? (TT / 8 + 1) : 0;
#pragma unroll
        for (int c8 = 0; c8 < 8; ++c8) if (c8 < NCN) lnext[c8] = *(const u32x4*)(Lb + (TT + 1) * 144 + c8 * 16); else lnext[c8] = (u32x4){0u, 0u, 0u, 0u};
        f32x2 a0 = {0.f, 0.f}, a1 = {0.f, 0.f}, a2 = {0.f, 0.f}, a3 = {0.f, 0.f};
#pragma unroll
        for (int c8 = 0; c8 <= (TT - 1) / 8; ++c8) {
            const u32x4 lv = lcur[c8];
            f32x2 l0, l1, l2, l3;
            l0.x = __uint_as_float(lv.x << 16); l0.y = __uint_as_float(lv.x & 0xffff0000u);
            l1.x = __uint_as_float(lv.y << 16); l1.y = __uint_as_float(lv.y & 0xffff0000u);
            l2.x = __uint_as_float(lv.z << 16); l2.y = __uint_as_float(lv.z & 0xffff0000u);
            l3.x = __uint_as_float(lv.w << 16); l3.y = __uint_as_float(lv.w & 0xffff0000u);
            a0 = l0 * x[c8 * 4 + 0] + a0; a1 = l1 * x[c8 * 4 + 1] + a1; a2 = l2 * x[c8 * 4 + 2] + a2; a3 = l3 * x[c8 * 4 + 3] + a3;
        }
        a0 = (a0 + a1) + (a2 + a3);
        const float r = a0.x + a0.y;
        if (TT & 1) x[TT / 2].y += r; else x[TT / 2].x += r;
        asm volatile("" : "+v"(x[TT / 2]) :: "memory");
        SolveRow<TT + 1>::run(x, Lb, lnext);
    }
};
template <> struct SolveRow<64> { static __device__ __forceinline__ void run(f32x2 (&)[32], const char*, const u32x4 (&)[8]) {} };

__device__ __forceinline__ void load_shift16(const bf16_t* ur, int row, int col, const float* mu, float* out) {
    const u32x4* cp = (const u32x4*)(ur + (size_t)row * RCOLS + col);
    const u32x4 c0 = cp[0], c1 = cp[1];
    u32x4 p0 = {0u, 0u, 0u, 0u}, p1 = {0u, 0u, 0u, 0u};
    if (row > 0) { const u32x4* pp = (const u32x4*)(ur + (size_t)(row - 1) * RCOLS + col); p0 = pp[0]; p1 = pp[1]; }
    float cf[16], pf[16];
    unpack8(c0, cf); unpack8(c1, cf + 8); unpack8(p0, pf); unpack8(p1, pf + 8);
#pragma unroll
    for (int e = 0; e < 16; ++e) out[e] = cf[e] + mu[col + e] * (pf[e] - cf[e]);
}

__device__ __forceinline__ void phase_rw_chunk(const P& p, int bid, int nb, char* smem0) {
    char* ws = p.ws;
    const bf16_t* ur = (const bf16_t*)(ws + OFF_UR);
    bf16_t* G = (bf16_t*)(ws + OFF_OA); bf16_t* BON = (bf16_t*)((char*)p.out + DOUT_BON); bf16_t* RH = (bf16_t*)((char*)p.out + DOUT_RH);
    bf16_t* YL = (bf16_t*)p.out; u32x2* NF = (u32x2*)((char*)p.out + 16 * MiB);
    u32x4* MF = (u32x4*)(ws + OFF_MF);
    int hpar = -1;
    for (int itb = bid * 2; itb < 2048; itb += nb * 2) {
        const int tid5 = otid();
        const int half = __builtin_amdgcn_readfirstlane(tid5 >> 8), tid = tid5 & 255;
        char* smem = smem0 + half * RW_LDS;
        float* wtot = (float*)(smem + L_WTOT); float* WCs = (float*)(smem + L_WC);
        int c, h;
        if ((1024 % nb) == 0 && nb <= 256) { const int pr = itb >> 1; c = (pr % nb) + nb * (pr / (4 * nb)); h = ((pr / nb) & 3) * 2 + half; }
        else { const int it = itb + half; c = it >> 3; h = it & 7; }
        const int lane = tid & 63, w = __builtin_amdgcn_readfirstlane(tid >> 6), fr = lane & 15, fq = lane >> 4;
        if (h != hpar) {
            float* par = (float*)(smem + L_PAR);
            if (tid < 64) {
                const int hj = h * 64 + tid;
                par[tid] = p.decay_w0[hj]; par[64 + tid] = p.iclr_a0[hj]; par[128 + tid] = p.k_k[hj]; par[192 + tid] = p.k_a[hj]; par[256 + tid] = p.r_k[hj];
                par[320 + tid] = p.tshift_mu[hj]; par[384 + tid] = p.tshift_mu[512 + hj]; par[448 + tid] = p.tshift_mu[1024 + hj];
            }
            hpar = h;
        }
        u32x4 rawc[3][2], rawp[3][2];
        {
            const int row = c * 64 + (tid >> 2), hj0 = h * 64 + (tid & 3) * 16;
#pragma unroll
            for (int q3 = 0; q3 < 3; ++q3) {
                const u32x4* cp = (const u32x4*)(ur + (size_t)row * RCOLS + q3 * 512 + hj0);
                rawc[q3][0] = cp[0]; rawc[q3][1] = cp[1];
                rawp[q3][0] = (u32x4){0u, 0u, 0u, 0u}; rawp[q3][1] = rawp[q3][0];
                if (row > 0) { const u32x4* pp = (const u32x4*)(ur + (size_t)(row - 1) * RCOLS + q3 * 512 + hj0); rawp[q3][0] = pp[0]; rawp[q3][1] = pp[1]; }
            }
        }
        {
            const int cc = tid & 31, col = 1536 + cc * 8, t0 = tid >> 5;
            u32x4 cur[8], prv[8];
#pragma unroll
            for (int i = 0; i < 8; ++i) {
                const int row = c * 64 + t0 + 8 * i;
                cur[i] = *(const u32x4*)(ur + (size_t)row * RCOLS + col);
                prv[i] = (u32x4){0u, 0u, 0u, 0u};
                if (row > 0) prv[i] = *(const u32x4*)(ur + (size_t)(row - 1) * RCOLS + col);
            }
            const float nsc = cc < 8 ? 2.f : 1.f, na = cc < 8 ? 2.f : 1.f, nbb = cc < 8 ? -1.f : 0.f;
            const f32x4 mu0 = *(const f32x4*)(p.tshift_mu + col), mu1 = *(const f32x4*)(p.tshift_mu + col + 4);
            const float mu[8] = {mu0.x, mu0.y, mu0.z, mu0.w, mu1.x, mu1.y, mu1.z, mu1.w};
#pragma unroll
            for (int i = 0; i < 8; ++i) {
                float cf[8], pf[8], xs[8];
                unpack8(cur[i], cf); unpack8(prv[i], pf);
#pragma unroll
                for (int e = 0; e < 8; ++e) {
                    const float x = cf[e] + mu[e] * (pf[e] - cf[e]);
                    const float y = sigm(nsc * x);
                    xs[e] = (cc >= 8 && cc < 16) ? x : na * y + nbb;
                }
                u32x4 o; o.x = cvt_pk(xs[0], xs[1]); o.y = cvt_pk(xs[2], xs[3]); o.z = cvt_pk(xs[4], xs[5]); o.w = cvt_pk(xs[6], xs[7]);
                *(u32x4*)(smem + L_LIN + (t0 + 8 * i) * LIN_ROWB + cc * 16) = o;
            }
        }
        __syncthreads();
        {
            const bf16_t* dT = (const bf16_t*)(ws + OFF_LORA_D) + (size_t)(h * 64 + w * 16 + fr) * 64 + fq * 8;
            const bf16_t* iT = (const bf16_t*)(ws + OFF_LORA_I) + (size_t)(h * 64 + w * 16 + fr) * 64 + fq * 8;
            const bf16_t* gT = (const bf16_t*)(ws + OFF_LORA_G) + (size_t)(h * 64 + w * 16 + fr) * 128 + fq * 8;
            bf16x8 wd[2], wi[2], wg[4];
#pragma unroll
            for (int ks = 0; ks < 2; ++ks) { wd[ks] = *(const bf16x8*)(dT + ks * 32); wi[ks] = *(const bf16x8*)(iT + ks * 32); }
#pragma unroll
            for (int ks = 0; ks < 4; ++ks) wg[ks] = *(const bf16x8*)(gT + ks * 32);
#pragma unroll
            for (int tt = 0; tt < 4; ++tt) {
                const char* lrow = smem + L_LIN + (tt * 16 + fr) * LIN_ROWB + fq * 16;
                f32x4 aw = {0.f, 0.f, 0.f, 0.f}, aa = aw, ag = aw;
#pragma unroll
                for (int ks = 0; ks < 2; ++ks) {
                    aw = MFMA16(wd[ks], *(const bf16x8*)(lrow + ks * 64), aw);
                    aa = MFMA16(wi[ks], *(const bf16x8*)(lrow + 128 + ks * 64), aa);
                }
#pragma unroll
                for (int ks = 0; ks < 4; ++ks) ag = MFMA16(wg[ks], *(const bf16x8*)(lrow + 256 + ks * 64), ag);
                *(u32x2*)(smem + L_WL + (tt * 16 + fr) * ROWB + (w * 16 + fq * 4) * 2) = pack4(aw);
                *(u32x2*)(smem + L_AL + (tt * 16 + fr) * ROWB + (w * 16 + fq * 4) * 2) = pack4(aa);
                *(u32x2*)(G + (size_t)(c * 64 + tt * 16 + fr) * 512 + h * 64 + w * 16 + fq * 4) = pack4(ag);
            }
        }
        __syncthreads();
        {
            const int t = tid >> 2, jq = tid & 3, j0 = jq * 16, hj0 = h * 64 + j0, row = c * 64 + t;
            const float* par = (const float*)(smem + L_PAR) + j0;
            float ai[16], kk[16], k2[16], rr[16];
            {
                float al[16];
                const u32x4* ap = (const u32x4*)(smem + L_AL + t * ROWB + j0 * 2);
                unpack8(ap[0], al); unpack8(ap[1], al + 8);
#pragma unroll
                for (int e = 0; e < 16; ++e) ai[e] = sigm(par[64 + e] + al[e]);
            }
            float ss = 0.f, rk = 0.f;
            {
                float cf[16], pf[16];
                unpack8(rawc[1][0], cf); unpack8(rawc[1][1], cf + 8); unpack8(rawp[1][0], pf); unpack8(rawp[1][1], pf + 8);
#pragma unroll
                for (int e = 0; e < 16; ++e) { const float k = cf[e] + par[384 + e] * (pf[e] - cf[e]); kk[e] = k * par[128 + e]; ss += kk[e] * kk[e]; k2[e] = k * (1.f + (ai[e] - 1.f) * par[192 + e]); }
            }
            ss += __shfl_xor(ss, 1); ss += __shfl_xor(ss, 2);
            const float inv = rsqrtf(ss + 1e-12f);
            {
                float cf[16], pf[16];
                unpack8(rawc[0][0], cf); unpack8(rawc[0][1], cf + 8); unpack8(rawp[0][0], pf); unpack8(rawp[0][1], pf + 8);
#pragma unroll
                for (int e = 0; e < 16; ++e) { rr[e] = cf[e] + par[320 + e] * (pf[e] - cf[e]); rk += rr[e] * k2[e] * par[256 + e]; }
            }
            rk += __shfl_xor(rk, 1); rk += __shfl_xor(rk, 2);
            {
                float cf[16], pf[16], v[16];
                unpack8(rawc[2][0], cf); unpack8(rawc[2][1], cf + 8); unpack8(rawp[2][0], pf); unpack8(rawp[2][1], pf + 8);
#pragma unroll
                for (int e = 0; e < 16; ++e) { v[e] = cf[e] + par[448 + e] * (pf[e] - cf[e]); *(bf16_t*)(smem + L_VT + (j0 + e) * ROWB + t * 2) = (bf16_t)f2bf(v[e]); }
#pragma unroll
                for (int hh = 0; hh < 2; ++hh) {
                    u32x4 o; o.x = cvt_pk(rk * v[hh * 8], rk * v[hh * 8 + 1]); o.y = cvt_pk(rk * v[hh * 8 + 2], rk * v[hh * 8 + 3]); o.z = cvt_pk(rk * v[hh * 8 + 4], rk * v[hh * 8 + 5]); o.w = cvt_pk(rk * v[hh * 8 + 6], rk * v[hh * 8 + 7]);
                    *(u32x4*)(BON + (size_t)row * 512 + hj0 + hh * 8) = o;
                }
            }
            float lw[16], cum[16];
            {
                float wl[16];
                const u32x4* wp = (const u32x4*)(smem + L_WL + t * ROWB + j0 * 2);
                unpack8(wp[0], wl); unpack8(wp[1], wl + 8);
#pragma unroll
                for (int e = 0; e < 16; ++e) { const float wv = par[e] + wl[e]; lw[e] = -0.6065306597126334f * sigm(wv); }
            }
#pragma unroll
            for (int e = 0; e < 16; ++e) {
                float x = lw[e];
#pragma unroll
                for (int d = 4; d < 64; d <<= 1) { const float y = __shfl_up(x, d); if (lane >= d) x += y; }
                cum[e] = x;
            }
            if ((lane >> 2) == 15) {
#pragma unroll
                for (int e = 0; e < 16; ++e) wtot[w * 64 + j0 + e] = cum[e];
            }
            __syncthreads();
#pragma unroll
            for (int hh = 0; hh < 2; ++hh) {
                float at[8], bt[8], kt[8], rt[8];
#pragma unroll
                for (int e8 = 0; e8 < 8; ++e8) {
                    const int e = hh * 8 + e8;
                    const float t0 = wtot[j0 + e], t1 = wtot[64 + j0 + e], t2 = wtot[128 + j0 + e], t3 = wtot[192 + j0 + e];
                    const float cm = cum[e] + ((w > 0 ? t0 : 0.f) + (w > 1 ? t1 : 0.f) + (w > 2 ? t2 : 0.f));
                    const float tt = (t0 + t1) + (t2 + t3);
                    if (t == 63) WCs[j0 + e] = __expf(tt);
                    const float kn = kk[e] * inv;
                    const float E = __expf(cm), Ei = __expf(-cm), Ex = __expf(cm - lw[e]), Ec = __expf(tt - cm);
                    const float b = kn * ai[e];
                    at[e8] = -kn * Ex; bt[e8] = b * Ei; kt[e8] = k2[e] * Ei; rt[e8] = rr[e] * E;
                    *(bf16_t*)(smem + L_BBT + (j0 + e) * ROWB + t * 2) = (bf16_t)f2bf(b * Ec);
                    *(bf16_t*)(smem + L_KBT + (j0 + e) * ROWB + t * 2) = (bf16_t)f2bf(k2[e] * Ec);
                    *(bf16_t*)(smem + L_ATT + (j0 + e) * ROWB + t * 2) = (bf16_t)f2bf(at[e8]);
                }
                u32x4 o;
                o.x = cvt_pk(at[0], at[1]); o.y = cvt_pk(at[2], at[3]); o.z = cvt_pk(at[4], at[5]); o.w = cvt_pk(at[6], at[7]);
                *(u32x4*)(smem + L_AT + t * ROWB + (j0 + hh * 8) * 2) = o;
                o.x = cvt_pk(bt[0], bt[1]); o.y = cvt_pk(bt[2], bt[3]); o.z = cvt_pk(bt[4], bt[5]); o.w = cvt_pk(bt[6], bt[7]);
                *(u32x4*)(smem + L_BT + t * ROWB + (j0 + hh * 8) * 2) = o;
                o.x = cvt_pk(kt[0], kt[1]); o.y = cvt_pk(kt[2], kt[3]); o.z = cvt_pk(kt[4], kt[5]); o.w = cvt_pk(kt[6], kt[7]);
                *(u32x4*)(smem + L_KT + t * ROWB + (j0 + hh * 8) * 2) = o;
                o.x = cvt_pk(rt[0], rt[1]); o.y = cvt_pk(rt[2], rt[3]); o.z = cvt_pk(rt[4], rt[5]); o.w = cvt_pk(rt[6], rt[7]);
                *(u32x4*)(smem + L_RT + t * ROWB + (j0 + hh * 8) * 2) = o;
            }
        }
        __syncthreads();
        bf16x8 frb[2], frk[2];
        {
            const int tid2 = otid() & 255, lane = tid2 & 63, fr = lane & 15, fq = lane >> 4;
            bf16x8 xa[2], xr[2];
#pragma unroll
            for (int ks = 0; ks < 2; ++ks) {
                xa[ks] = *(const bf16x8*)(smem + L_AT + (w * 16 + fr) * ROWB + (ks * 32 + fq * 8) * 2);
                xr[ks] = *(const bf16x8*)(smem + L_RT + (w * 16 + fr) * ROWB + (ks * 32 + fq * 8) * 2);
            }
            f32x4 aab[4], aak[4], arb[4], ark[4];
            const int tq = w * 16 + fr;
#pragma unroll
            for (int n = 0; n < 4; ++n) {
                f32x4 dab = {0.f, 0.f, 0.f, 0.f}, dak = dab, drb = dab, drk = dab;
                if (n <= w) {
#pragma unroll
                    for (int ks = 0; ks < 2; ++ks) {
                        const bf16x8 yb = *(const bf16x8*)(smem + L_BT + (n * 16 + fr) * ROWB + (ks * 32 + fq * 8) * 2);
                        const bf16x8 yk = *(const bf16x8*)(smem + L_KT + (n * 16 + fr) * ROWB + (ks * 32 + fq * 8) * 2);
                        dab = MFMA16(yb, xa[ks], dab); dak = MFMA16(yk, xa[ks], dak); drb = MFMA16(yb, xr[ks], drb); drk = MFMA16(yk, xr[ks], drk);
                    }
#pragma unroll
                    for (int jj = 0; jj < 4; ++jj) {
                        const int sq = n * 16 + fq * 4 + jj;
                        if (!(sq < tq)) { dab[jj] = 0.f; dak[jj] = 0.f; }
                        if (!(sq <= tq)) { drb[jj] = 0.f; drk[jj] = 0.f; }
                    }
                }
                aab[n] = dab; aak[n] = dak; arb[n] = drb; ark[n] = drk;
            }
            __syncthreads();
#pragma unroll
            for (int n = 0; n < 4; ++n) *(u32x2*)(smem + L_AAB + (w * 16 + fr) * ROWB + (n * 16 + fq * 4) * 2) = pack4(aab[n]);
            *(u32x4*)(smem + L_TD + (w * 16 + (lane >> 2)) * ROWB + (lane & 3) * 32) = (u32x4){0u, 0u, 0u, 0u};
            *(u32x4*)(smem + L_TD + (w * 16 + (lane >> 2)) * ROWB + (lane & 3) * 32 + 16) = (u32x4){0u, 0u, 0u, 0u};
            asm volatile("s_waitcnt lgkmcnt(0)" ::: "memory"); __builtin_amdgcn_wave_barrier();
            {
                const int cc = lane & 15;
                float Tc[16];
#pragma unroll
                for (int r = 0; r < 16; ++r) {
                    float lf[16];
                    const u32x4* lp = (const u32x4*)(smem + L_AAB + (w * 16 + r) * ROWB + w * 32);
                    unpack8(lp[0], lf); unpack8(lp[1], lf + 8);
                    float a = (r == cc) ? 1.f : 0.f;
#pragma unroll
                    for (int s2 = 0; s2 < 16; ++s2) if (s2 < r) a += lf[s2] * Tc[s2];
                    Tc[r] = a;
                }
                if (lane < 16) {
#pragma unroll
                    for (int r = 0; r < 16; ++r) *(bf16_t*)(smem + L_TD + (w * 16 + r) * ROWB + (w * 16 + cc) * 2) = (bf16_t)f2bf(Tc[r]);
                }
            }
            bf16x8 fak[2];
#pragma unroll
            for (int ks = 0; ks < 2; ++ks) { fak[ks] = pack8(aak[2 * ks], aak[2 * ks + 1]); frb[ks] = pack8(arb[2 * ks], arb[2 * ks + 1]); frk[ks] = pack8(ark[2 * ks], ark[2 * ks + 1]); }
#pragma unroll
            for (int vt = 0; vt < 4; ++vt) {
                f32x4 acc = {0.f, 0.f, 0.f, 0.f};
#pragma unroll
                for (int ks = 0; ks < 2; ++ks) acc = MFMA16(fak[ks], ldperm(smem + L_VT + (vt * 16 + fr) * ROWB, ks, fq), acc);
                *(u32x2*)(smem + L_AKV + (vt * 16 + fr) * ROWB + (w * 16 + fq * 4) * 2) = pack4(acc);
            }
        }
        __syncthreads();
        {
            const int tid3 = otid() & 255, lane = tid3 & 63, fr = lane & 15, fq = lane >> 4;
            char* xb = smem + (w < 2 ? L_ATT : L_AKV) + (w & 1) * 32 * ROWB;
#pragma unroll
            for (int i = 0; i < 4; ++i) {
                bf16x8 la[2];
#pragma unroll
                for (int ks = 0; ks < 2; ++ks) {
                    u32x4 v = *(const u32x4*)(smem + L_AAB + (16 * i + fr) * ROWB + (ks * 32 + fq * 8) * 2);
                    if (2 * ks + (fq >> 1) >= i) v = (u32x4){0u, 0u, 0u, 0u};
                    la[ks] = __builtin_bit_cast(bf16x8, v);
                }
                const bf16x8 ta = *(const bf16x8*)(smem + L_TD + (16 * i + fr) * ROWB + ((i >> 1) * 32 + fq * 8) * 2);
#pragma unroll
                for (int nt = 0; nt < 2; ++nt) {
                    char* rowp = xb + (nt * 16 + fr) * ROWB;
                    f32x4 y = unpack4(*(const u32x2*)(rowp + (16 * i + fq * 4) * 2));
                    if (i >= 1) y = MFMA16(la[0], *(const bf16x8*)(rowp + (fq * 8) * 2), y);
                    if (i == 3) y = MFMA16(la[1], *(const bf16x8*)(rowp + (32 + fq * 8) * 2), y);
                    *(u32x2*)(rowp + (16 * i + fq * 4) * 2) = pack4(y);
                }
                asm volatile("s_waitcnt lgkmcnt(0)" ::: "memory"); __builtin_amdgcn_wave_barrier();
#pragma unroll
                for (int nt = 0; nt < 2; ++nt) {
                    char* rowp = xb + (nt * 16 + fr) * ROWB;
                    const f32x4 x = MFMA16(ta, *(const bf16x8*)(rowp + ((i >> 1) * 32 + fq * 8) * 2), ((f32x4){0.f, 0.f, 0.f, 0.f}));
                    asm volatile("s_waitcnt lgkmcnt(0)" ::: "memory");
                    *(u32x2*)(rowp + (16 * i + fq * 4) * 2) = pack4(x);
                }
                asm volatile("s_waitcnt lgkmcnt(0)" ::: "memory"); __builtin_amdgcn_wave_barrier();
            }
        }
        __syncthreads();
        {
            const int tid4 = otid() & 255, lane = tid4 & 63, fr = lane & 15, fq = lane >> 4;
            const int trow = c * 64 + w * 16 + fr;
#pragma unroll
            for (int kt = 0; kt < 4; ++kt) {
                f32x4 acc = {0.f, 0.f, 0.f, 0.f};
#pragma unroll
                for (int ks = 0; ks < 2; ++ks) acc = MFMA16(ldperm(smem + L_ATT + (kt * 16 + fr) * ROWB, ks, fq), frb[ks], acc);
                const u32x2 rr = *(const u32x2*)(smem + L_RT + (w * 16 + fr) * ROWB + (kt * 16 + fq * 4) * 2);
                acc.x += __uint_as_float(rr.x << 16); acc.y += __uint_as_float(rr.x & 0xffff0000u); acc.z += __uint_as_float(rr.y << 16); acc.w += __uint_as_float(rr.y & 0xffff0000u);
                *(u32x2*)(RH + (size_t)trow * 512 + h * 64 + kt * 16 + fq * 4) = pack4(acc);
            }
#pragma unroll
            for (int vt = 0; vt < 4; ++vt) {
                f32x4 acc = {0.f, 0.f, 0.f, 0.f};
#pragma unroll
                for (int ks = 0; ks < 2; ++ks) {
                    acc = MFMA16(ldperm(smem + L_AKV + (vt * 16 + fr) * ROWB, ks, fq), frb[ks], acc);
                    acc = MFMA16(ldperm(smem + L_VT + (vt * 16 + fr) * ROWB, ks, fq), frk[ks], acc);
                }
                *(u32x2*)(YL + (size_t)trow * 512 + h * 64 + vt * 16 + fq * 4) = pack4(acc);
            }
            bf16x8 xb[2], xk[2];
#pragma unroll
            for (int ks = 0; ks < 2; ++ks) {
                xb[ks] = *(const bf16x8*)(smem + L_BBT + (w * 16 + fr) * ROWB + (ks * 32 + fq * 8) * 2);
                xk[ks] = *(const bf16x8*)(smem + L_KBT + (w * 16 + fr) * ROWB + (ks * 32 + fq * 8) * 2);
            }
            f32x4 mt[4];
            const float wc = WCs[w * 16 + fr];
#pragma unroll
            for (int n = 0; n < 4; ++n) {
                f32x4 acc = {0.f, 0.f, 0.f, 0.f};
#pragma unroll
                for (int ks = 0; ks < 2; ++ks) acc = MFMA16(*(const bf16x8*)(smem + L_ATT + (n * 16 + fr) * ROWB + (ks * 32 + fq * 8) * 2), xb[ks], acc);
#pragma unroll
                for (int jj = 0; jj < 4; ++jj) if (n * 16 + fq * 4 + jj == w * 16 + fr) acc[jj] += wc;
                mt[n] = acc;
            }
#pragma unroll
            for (int ks = 0; ks < 2; ++ks) MF[((size_t)((c * 8 + h) * 4 + w) * 2 + ks) * 64 + lane] = __builtin_bit_cast(u32x4, pack8(mt[2 * ks], mt[2 * ks + 1]));
#pragma unroll
            for (int vs = 0; vs < 4; ++vs) {
                f32x4 acc = {0.f, 0.f, 0.f, 0.f};
#pragma unroll
                for (int ks = 0; ks < 2; ++ks) {
                    acc = MFMA16(xb[ks], *(const bf16x8*)(smem + L_AKV + (vs * 16 + fr) * ROWB + (ks * 32 + fq * 8) * 2), acc);
                    acc = MFMA16(xk[ks], *(const bf16x8*)(smem + L_VT + (vs * 16 + fr) * ROWB + (ks * 32 + fq * 8) * 2), acc);
                }
                NF[(((size_t)((c * 8 + h) * 2 + (w >> 1)) * 4 + vs) * 64 + lane) * 2 + (w & 1)] = pack4(acc);
            }
        }
        __syncthreads();
    }
}

constexpr int SC_D = 8, SC_R = 12, SC_SLOT = 10240;
__device__ __forceinline__ void rw_scan(const P& p, int chain, char* smem) {
    const int tid = otid(), lane = tid & 63, w = __builtin_amdgcn_readfirstlane(tid >> 6), h = chain >> 2, vs = chain & 3;
    const char* MF = (const char*)(p.ws + OFF_MF); const char* NF = (const char*)p.out + 16 * MiB;
    u32x4* SF = (u32x4*)(p.ws + OFF_SF);
    const int q0 = (w >= 1 && w <= 3) ? 2 * (w - 1) : (w + 2), npc = (w >= 1 && w <= 3) ? 2 : 1;
    auto issue = [&](int c) {
        char* slot = smem + (c % SC_R) * SC_SLOT;
#pragma unroll
        for (int j = 0; j < 2; ++j) {
            if (j < npc) {
                const int q = q0 + j;
                const char* src = (q < 8) ? MF + ((size_t)((c * 8 + h) * 8 + q) * 64 + lane) * 16
                                          : NF + ((size_t)(((c * 8 + h) * 2 + (q - 8)) * 4 + vs) * 64 + lane) * 16;
                __builtin_amdgcn_global_load_lds((const unsigned*)src, (unsigned*)(slot + q * 1024 + lane * 16), 16, 0, 0);
            }
        }
    };
    bf16x8 fa[8], fb[8]; u32x4 na0, na1, nb0, nb1;
    auto rd = [&](bf16x8 (&f)[8], u32x4& n0, u32x4& n1, int c) {
        const char* slot = smem + (c % SC_R) * SC_SLOT;
#pragma unroll
        for (int i = 0; i < 8; ++i) f[i] = *(const bf16x8*)(slot + i * 1024 + lane * 16);
        n0 = *(const u32x4*)(slot + 8 * 1024 + lane * 16); n1 = *(const u32x4*)(slot + 9 * 1024 + lane * 16);
    };
    u32x4 st0 = {0u, 0u, 0u, 0u}, st1 = st0;
    auto comp = [&](const bf16x8 (&f)[8], const u32x4& n01, const u32x4& n23, int c) {
        SF[((size_t)((c * 8 + h) * 4 + vs) * 2 + 0) * 64 + lane] = st0;
        SF[((size_t)((c * 8 + h) * 4 + vs) * 2 + 1) * 64 + lane] = st1;
        f32x4 acc[4];
        acc[0] = unpack4((u32x2){n01.x, n01.y}); acc[1] = unpack4((u32x2){n01.z, n01.w}); acc[2] = unpack4((u32x2){n23.x, n23.y}); acc[3] = unpack4((u32x2){n23.z, n23.w});
#pragma unroll
        for (int i = 0; i < 4; ++i) {
            acc[i] = MFMA16(f[2 * i], __builtin_bit_cast(bf16x8, st0), acc[i]);
            acc[i] = MFMA16(f[2 * i + 1], __builtin_bit_cast(bf16x8, st1), acc[i]);
        }
        st0 = __builtin_bit_cast(u32x4, pack8(acc[0], acc[1])); st1 = __builtin_bit_cast(u32x4, pack8(acc[2], acc[3]));
    };
    auto feed = [&](int c) {
        issue(c < 255 ? c : 254);
    };
    if (w != 0) {
#pragma unroll 1
        for (int c = 0; c < SC_D; ++c) issue(c);
        if (npc == 2) asm volatile("s_waitcnt vmcnt(14)" ::: "memory"); else asm volatile("s_waitcnt vmcnt(7)" ::: "memory");
    }
    __builtin_amdgcn_s_barrier();
    if (w == 0) rd(fa, na0, na1, 0);
#pragma unroll 1
    for (int c = 0; c < 255; c += 2) {
        if (w != 0) {
            feed(c + SC_D); feed(c + SC_D + 1);
            if (npc == 2) asm volatile("s_waitcnt vmcnt(14)" ::: "memory"); else asm volatile("s_waitcnt vmcnt(7)" ::: "memory");
        }
        __builtin_amdgcn_s_barrier();
        if (w == 0) {
            rd(fb, nb0, nb1, c + 1); comp(fa, na0, na1, c);
            rd(fa, na0, na1, c + 2);
            if (c + 1 < 255) comp(fb, nb0, nb1, c + 1);
        }
    }
    if (w == 0) {
        SF[((size_t)((255 * 8 + h) * 4 + vs) * 2 + 0) * 64 + lane] = st0;
        SF[((size_t)((255 * 8 + h) * 4 + vs) * 2 + 1) * 64 + lane] = st1;
    }
    asm volatile("s_waitcnt vmcnt(0)" ::: "memory");
    __builtin_amdgcn_s_barrier();
}

__device__ __forceinline__ void phase_rw_out(const P& p, int bid, int nb) {
    const int tid = otid(), lane = tid & 63, w8 = tid >> 6, w = w8 & 3, fr = lane & 15, fq = lane >> 4;
    char* ws = p.ws;
    bf16_t* OA = (bf16_t*)(ws + OFF_OA); const bf16_t* BON = (const bf16_t*)((const char*)p.out + DOUT_BON); const bf16_t* RH = (const bf16_t*)((const char*)p.out + DOUT_RH);
    const bf16_t* YL = (const bf16_t*)p.out; const u32x4* SF = (const u32x4*)(ws + OFF_SF);
    for (int itb = bid * 2; itb < 2048; itb += nb * 2) {
        const int it = itb + (w8 >> 2), c = it >> 3, h = it & 7, trow = c * 64 + w * 16 + fr;
        const char* rrow = (const char*)(RH + (size_t)trow * 512 + h * 64);
        bf16x8 rf[2]; rf[0] = ldperm(rrow, 0, fq); rf[1] = ldperm(rrow, 1, fq);
        f32x4 acc[4];
#pragma unroll
        for (int vs = 0; vs < 4; ++vs) {
            acc[vs] = unpack4(*(const u32x2*)(YL + (size_t)trow * 512 + h * 64 + vs * 16 + fq * 4));
#pragma unroll
            for (int ks = 0; ks < 2; ++ks) acc[vs] = MFMA16(__builtin_bit_cast(bf16x8, SF[((size_t)((c * 8 + h) * 4 + vs) * 2 + ks) * 64 + lane]), rf[ks], acc[vs]);
        }
        float s = 0.f;
#pragma unroll
        for (int vs = 0; vs < 4; ++vs) s += (acc[vs].x + acc[vs].y) + (acc[vs].z + acc[vs].w);
        s += __shfl_xor(s, 16); s += __shfl_xor(s, 32);
        const float mean = s * (1.f / 64.f);
        float q = 0.f;
#pragma unroll
        for (int vs = 0; vs < 4; ++vs) { acc[vs] = acc[vs] - mean; q += (acc[vs].x * acc[vs].x + acc[vs].y * acc[vs].y) + (acc[vs].z * acc[vs].z + acc[vs].w * acc[vs].w); }
        q += __shfl_xor(q, 16); q += __shfl_xor(q, 32);
        const float rstd = rsqrtf(q * (1.f / 64.f) + 64e-5f);
#pragma unroll
        for (int vs = 0; vs < 4; ++vs) {
            const int hv = h * 64 + vs * 16 + fq * 4;
            const f32x4 lw = *(const f32x4*)(p.ln_x_w + hv), lb = *(const f32x4*)(p.ln_x_b + hv);
            const u32x2 bo = *(const u32x2*)(BON + (size_t)trow * 512 + hv), gg = *(const u32x2*)(OA + (size_t)trow * 512 + hv);
            f32x4 o = acc[vs] * rstd * lw + lb;
            o.x = (o.x + __uint_as_float(bo.x << 16)) * __uint_as_float(gg.x << 16);
            o.y = (o.y + __uint_as_float(bo.x & 0xffff0000u)) * __uint_as_float(gg.x & 0xffff0000u);
            o.z = (o.z + __uint_as_float(bo.y << 16)) * __uint_as_float(gg.y << 16);
            o.w = (o.w + __uint_as_float(bo.y & 0xffff0000u)) * __uint_as_float(gg.y & 0xffff0000u);
            *(u32x2*)(OA + (size_t)trow * 512 + hv) = pack4(o);
        }
    }
}


constexpr int A_LK = 0, A_LV = 36864, A_BIAS = 70656, A_TST = 70784, A_TAB = 72848, NTAB = 2912, A_LST = 84496, A_CST = 86560;
constexpr int MAXTILES = 6656;

__device__ __forceinline__ void moba_select(const P& p, int bid0, int nb0, char* smem) {
    const int tid = otid(), lane = tid & 63, w = tid >> 6, fr = lane & 15, fq = lane >> 4;
    char* ws = p.ws;
    const bf16_t* um = (const bf16_t*)(ws + OFF_UM); const float* kms = (const float*)(ws + OFF_CTL + CTL_KMS);
    unsigned* SEL = (unsigned*)(ws + OFF_MSEL);
    int* hist = (int*)smem;
    for (int i = tid; i < 512; i += NT) hist[i] = 0;
    __syncthreads();
    for (int it = bid0; it < 1024; it += nb0) {
        const int tile = it >> 3, h = it & 7, qb = tile >> 1, t = tile * 128 + w * 16 + fr;
        bf16x8 qf[2];
#pragma unroll
        for (int ks = 0; ks < 2; ++ks) qf[ks] = *(const bf16x8*)(um + (size_t)t * UMC + h * 64 + ks * 32 + fq * 8);
        float sc[4][4];
#pragma unroll
        for (int nt = 0; nt < 4; ++nt) {
            f32x4 acc = {0.f, 0.f, 0.f, 0.f};
            if (nt * 16 < qb) {
#pragma unroll
                for (int ks = 0; ks < 2; ++ks) {
                    const f32x4* kp = (const f32x4*)(kms + (size_t)(nt * 16 + fr) * 512 + h * 64 + ks * 32 + fq * 8);
                    acc = MFMA16(pack8(kp[0] * (1.f / 256.f), kp[1] * (1.f / 256.f)), qf[ks], acc);
                }
            }
#pragma unroll
            for (int j = 0; j < 4; ++j) sc[nt][j] = (nt * 16 + fq * 4 + j < qb) ? acc[j] : -3.0e38f;
        }
        unsigned selw = 0u;
#pragma unroll
        for (int s = 0; s < 3; ++s) {
            float bv = -3.0e38f; int bi = 255;
#pragma unroll
            for (int nt = 0; nt < 4; ++nt)
#pragma unroll
                for (int j = 0; j < 4; ++j) if (sc[nt][j] > bv) { bv = sc[nt][j]; bi = nt * 16 + fq * 4 + j; }
#pragma unroll
            for (int o = 16; o <= 32; o <<= 1) {
                const float v2 = __shfl_xor(bv, o); const int i2 = __shfl_xor(bi, o);
                if (v2 > bv || (v2 == bv && i2 < bi)) { bv = v2; bi = i2; }
            }
            if (!(bv > -1.0e38f)) bi = 255;
            selw |= (unsigned)bi << (8 * s);
#pragma unroll
            for (int nt = 0; nt < 4; ++nt)
#pragma unroll
                for (int j = 0; j < 4; ++j) if (nt * 16 + fq * 4 + j == bi) sc[nt][j] = -3.0e38f;
            if (fq == 0 && bi != 255) atomicAdd(&hist[h * 64 + bi], 1);
        }
        if (fq == 0) SEL[t * 8 + h] = selw | 0xff000000u;
    }
    __syncthreads();
    int* gcnt = (int*)(ws + OFF_CTL + CTL_MCNT);
    for (int i = tid; i < 512; i += NT) if (hist[i]) atomicAdd(&gcnt[i], hist[i]);
}

__device__ __forceinline__ void moba_fill(const P& p, int bid, int nb, char* smem) {
    const int tid = otid();
    char* ws = p.ws;
    const int* gcnt = (const int*)(ws + OFF_CTL + CTL_MCNT); int* gcur = (int*)(ws + OFF_CTL + CTL_MCUR);
    int* lst = (int*)smem;
    int* tst = lst + 520;
    int* cst = tst + 520;
    int* lh = cst + 520;
    int* lc = lh + 512;
    {
        static_assert(NT == 512, "one list per thread");
        const int lane = tid & 63, w = tid >> 6;
        const int c = gcnt[tid], nt_ = (c + 127) >> 7, cc1 = 2 * nt_ + (nt_ ? 2 : 0);
        int a = c, b = nt_, cc = cc1;
#pragma unroll
        for (int o = 1; o < 64; o <<= 1) { const int ta = __shfl_up(a, o), tb = __shfl_up(b, o), tc = __shfl_up(cc, o); if (lane >= o) { a += ta; b += tb; cc += tc; } }
        if (lane == 63) { lc[w * 3] = a; lc[w * 3 + 1] = b; lc[w * 3 + 2] = cc; }
        __syncthreads();
        int oa = 0, ob = 0, oc = 0;
#pragma unroll
        for (int k = 0; k < 7; ++k) if (k < w) { oa += lc[k * 3]; ob += lc[k * 3 + 1]; oc += lc[k * 3 + 2]; }
        lst[tid] = oa + a - c; tst[tid] = ob + b - nt_; cst[tid] = oc + cc - cc1;
        if (tid == NT - 1) { lst[512] = oa + a; tst[512] = ob + b; cst[512] = oc + cc; }
    }
    __syncthreads();
    for (int i = tid; i < 512; i += NT) { lh[i] = 0; lc[i] = 0; }
    __syncthreads();
    if (bid == 0) {
        int* glst = (int*)(ws + OFF_CTL + CTL_MLST); int* gtst = (int*)(ws + OFF_CTL + CTL_MTST);
        int* gcst = (int*)(ws + OFF_CTL + CTL_MCST);
        for (int i = tid; i < 513; i += NT) { glst[i] = lst[i]; gtst[i] = tst[i]; gcst[i] = cst[i]; }
    }
    const unsigned* SEL = (const unsigned*)(ws + OFF_MSEL);
    int* QL = (int*)(ws + OFF_MQL); int* SP = (int*)(ws + OFF_MSP);
    const int per = (T * 8 + nb - 1) / nb, i0 = bid * per, i1 = min(T * 8, i0 + per);
    for (int i = i0 + tid; i < i1; i += NT) {
        const unsigned sw = SEL[i]; const int h = i & 7;
#pragma unroll
        for (int s = 0; s < 3; ++s) { const int j = (sw >> (8 * s)) & 255; if (j != 255) atomicAdd(&lh[h * 64 + j], 1); }
    }
    __syncthreads();
    for (int i = tid; i < 512; i += NT) { const int c = lh[i]; lh[i] = c ? atomicAdd(&gcur[i], c) : 0; }
    __syncthreads();
    for (int i = i0 + tid; i < i1; i += NT) {
        const unsigned sw = SEL[i]; const int h = i & 7;
#pragma unroll
        for (int s = 0; s < 3; ++s) {
            const int j = (sw >> (8 * s)) & 255; int pos = -1;
            if (j != 255) { const int li = h * 64 + j; pos = lst[li] + lh[li] + atomicAdd(&lc[li], 1); QL[pos] = i >> 3; }
            SP[i * 3 + s] = pos;
        }
    }
}

__device__ __forceinline__ int t5b(int n) {
    const int v = (int)(__float_as_uint((float)(n * n)) >> 23) - 119;
    return n < 16 ? n : (v > 31 ? 31 : v);
}

__device__ __forceinline__ void attn_stage(const P& p, int j, int h, int nkeys, char* smem, int tid) {
    const bf16_t* um = (const bf16_t*)(p.ws + OFF_UM); const bf16_t* vt = (const bf16_t*)(p.ws + OFF_VT);
    for (int idx = tid; idx < nkeys * 8; idx += NT) {
        const int key = idx >> 3, ch = idx & 7;
        *(u32x4*)(smem + A_LK + key * 144 + ch * 16) = *(const u32x4*)(um + (size_t)(j * 256 + key) * UMC + 512 + h * 64 + ch * 8);
    }
    const int cpr = nkeys >> 3;
    for (int idx = tid; idx < 64 * cpr; idx += NT) {
        const int d = idx / cpr, ch = idx - d * cpr;
        *(u32x4*)(smem + A_LV + d * 528 + ch * 16) = *(const u32x4*)(vt + (size_t)(h * 64 + d) * T + j * 256 + ch * 8);
    }
    for (int i = tid; i < NTAB; i += NT) ((float*)(smem + A_TAB))[i] = p.rel_bias[t5b(i) * 8 + h];
}
__device__ __forceinline__ void attn_stage_load(const P& p, int j, int h, int tid, u32x4 (&rk)[4], u32x4 (&rv)[4]) {
    const bf16_t* um = (const bf16_t*)(p.ws + OFF_UM); const bf16_t* vt = (const bf16_t*)(p.ws + OFF_VT);
#pragma unroll
    for (int i = 0; i < 4; ++i) {
        const int idx = tid + i * NT, key = idx >> 3, ch = idx & 7, d = idx >> 5, c2 = idx & 31;
        rk[i] = *(const u32x4*)(um + (size_t)(j * 256 + key) * UMC + 512 + h * 64 + ch * 8);
        rv[i] = *(const u32x4*)(vt + (size_t)(h * 64 + d) * T + j * 256 + c2 * 8);
    }
}
__device__ __forceinline__ void attn_stage_store(const P& p, int h, int tid, char* smem, const u32x4 (&rk)[4], const u32x4 (&rv)[4]) {
#pragma unroll
    for (int i = 0; i < 4; ++i) {
        const int idx = tid + i * NT, key = idx >> 3, ch = idx & 7, d = idx >> 5, c2 = idx & 31;
        *(u32x4*)(smem + A_LK + key * 144 + ch * 16) = rk[i];
        *(u32x4*)(smem + A_LV + d * 528 + c2 * 16) = rv[i];
    }
    for (int i = tid; i < NTAB; i += NT) ((float*)(smem + A_TAB))[i] = p.rel_bias[t5b(i) * 8 + h];
}
template <bool CAUSAL>
__device__ __forceinline__ void attn_core_q(const char* smem, const bf16x8 (&qf)[2], int qt, int kbase, int nkeys, int fr, int fq, float& m_out, float& l_out, f32x4 (&o)[4]) {
    const float* tb = (const float*)(smem + A_TAB);
    const int nkt = nkeys >> 4;
    f32x4 sc[16];
    float mx = -3.0e38f;
    const bool far = !CAUSAL && __all(qt - (kbase + 255) >= 2897);
    const float cfar = tb[NTAB - 1];
#pragma unroll
    for (int kt = 0; kt < 16; ++kt) {
        f32x4 acc = {0.f, 0.f, 0.f, 0.f};
        if (kt < nkt) {
#pragma unroll
            for (int ks = 0; ks < 2; ++ks) acc = MFMA16(*(const bf16x8*)(smem + A_LK + (kt * 16 + fr) * 144 + (ks * 32 + fq * 8) * 2), qf[ks], acc);
            if (far) {
#pragma unroll
                for (int jj = 0; jj < 4; ++jj) { const float l = acc[jj] * 0.125f + cfar; acc[jj] = l; mx = fmaxf(mx, l); }
            } else {
#pragma unroll
                for (int jj = 0; jj < 4; ++jj) {
                    const int rel = qt - (kbase + kt * 16 + fq * 4 + jj);
                    float l = acc[jj] * 0.125f + tb[min(max(rel, 0), NTAB - 1)];
                    if (CAUSAL && rel < 0) l = -3.0e38f;
                    acc[jj] = l; mx = fmaxf(mx, l);
                }
            }
        } else { acc = (f32x4){-3.0e38f, -3.0e38f, -3.0e38f, -3.0e38f}; }
        sc[kt] = acc;
    }
    mx = fmaxf(mx, __shfl_xor(mx, 16)); mx = fmaxf(mx, __shfl_xor(mx, 32));
    float ls = 0.f;
#pragma unroll
    for (int kt = 0; kt < 16; ++kt)
#pragma unroll
        for (int jj = 0; jj < 4; ++jj) { const float e = (!CAUSAL || sc[kt][jj] > -1.0e38f) ? __expf(sc[kt][jj] - mx) : 0.f; sc[kt][jj] = e; ls += e; }
    ls += __shfl_xor(ls, 16); ls += __shfl_xor(ls, 32);
#pragma unroll
    for (int dt = 0; dt < 4; ++dt) o[dt] = (f32x4){0.f, 0.f, 0.f, 0.f};
#pragma unroll
    for (int s = 0; s < 8; ++s) {
        if (s * 2 < nkt) {
            const bf16x8 pf = pack8(sc[2 * s], sc[2 * s + 1]);
#pragma unroll
            for (int dt = 0; dt < 4; ++dt) o[dt] = MFMA16(ldperm(smem + A_LV + (dt * 16 + fr) * 528, s, fq), pf, o[dt]);
        }
    }
    m_out = mx; l_out = ls;
}

template <bool CAUSAL>
__device__ __forceinline__ void attn_core_q_pipe(const char* smem, const bf16x8 (&qf)[2], int qt, int kbase, int nkeys, int fr, int fq, float& m_out, float& l_out, f32x4 (&o)[4]) {
    const float* tb = (const float*)(smem + A_TAB);
    const int nkt = nkeys >> 4;
    f32x4 sc[16];
    float mx = -3.0e38f;
    const bool far = !CAUSAL && __all(qt - (kbase + 255) >= 2897);
    const float cfar = tb[NTAB - 1];
    const char* kp = smem + A_LK + fr * 144 + fq * 16;
    bf16x8 kf[2][2];
    kf[0][0] = *(const bf16x8*)(kp); kf[0][1] = *(const bf16x8*)(kp + 64);
    if (far) {
#pragma unroll
        for (int kt = 0; kt < 16; ++kt) {
            if (kt + 1 < 16) { kf[(kt + 1) & 1][0] = *(const bf16x8*)(kp + (kt + 1) * 2304); kf[(kt + 1) & 1][1] = *(const bf16x8*)(kp + (kt + 1) * 2304 + 64); }
            __builtin_amdgcn_sched_barrier(0);
            f32x4 acc = {0.f, 0.f, 0.f, 0.f};
            acc = MFMA16(kf[kt & 1][0], qf[0], acc); acc = MFMA16(kf[kt & 1][1], qf[1], acc);
#pragma unroll
            for (int jj = 0; jj < 4; ++jj) { const float l = acc[jj] * 0.125f + cfar; acc[jj] = l; mx = fmaxf(mx, l); }
            sc[kt] = acc;
        }
    } else {
        float bb[2][4];
#pragma unroll
        for (int jj = 0; jj < 4; ++jj) bb[0][jj] = tb[min(max(qt - (kbase + fq * 4 + jj), 0), NTAB - 1)];
#pragma unroll
        for (int kt = 0; kt < 16; ++kt) {
            if (kt + 1 < 16) {
                kf[(kt + 1) & 1][0] = *(const bf16x8*)(kp + (kt + 1) * 2304); kf[(kt + 1) & 1][1] = *(const bf16x8*)(kp + (kt + 1) * 2304 + 64);
#pragma unroll
                for (int jj = 0; jj < 4; ++jj) bb[(kt + 1) & 1][jj] = tb[min(max(qt - (kbase + (kt + 1) * 16 + fq * 4 + jj), 0), NTAB - 1)];
            }
            __builtin_amdgcn_sched_barrier(0);
            f32x4 acc = {0.f, 0.f, 0.f, 0.f};
            if (kt < nkt) {
                acc = MFMA16(kf[kt & 1][0], qf[0], acc); acc = MFMA16(kf[kt & 1][1], qf[1], acc);
#pragma unroll
                for (int jj = 0; jj < 4; ++jj) {
                    const int rel = qt - (kbase + kt * 16 + fq * 4 + jj);
                    float l = acc[jj] * 0.125f + bb[kt & 1][jj];
                    if (CAUSAL && rel < 0) l = -3.0e38f;
                    acc[jj] = l; mx = fmaxf(mx, l);
                }
            } else { acc = (f32x4){-3.0e38f, -3.0e38f, -3.0e38f, -3.0e38f}; }
            sc[kt] = acc;
        }
    }
    mx = fmaxf(mx, __shfl_xor(mx, 16)); mx = fmaxf(mx, __shfl_xor(mx, 32));
    float ls = 0.f;
    bf16x8 vf[2][4];
#pragma unroll
    for (int dt = 0; dt < 4; ++dt) vf[0][dt] = ldperm(smem + A_LV + (dt * 16 + fr) * 528, 0, fq);
#pragma unroll
    for (int kt = 0; kt < 16; ++kt)
#pragma unroll
        for (int jj = 0; jj < 4; ++jj) { const float e = (!CAUSAL || sc[kt][jj] > -1.0e38f) ? __expf(sc[kt][jj] - mx) : 0.f; sc[kt][jj] = e; ls += e; }
    ls += __shfl_xor(ls, 16); ls += __shfl_xor(ls, 32);
#pragma unroll
    for (int dt = 0; dt < 4; ++dt) o[dt] = (f32x4){0.f, 0.f, 0.f, 0.f};
#pragma unroll
    for (int s = 0; s < 8; ++s) {
        if (s + 1 < 8) {
#pragma unroll
            for (int dt = 0; dt < 4; ++dt) vf[(s + 1) & 1][dt] = ldperm(smem + A_LV + (dt * 16 + fr) * 528, s + 1, fq);
        }
        __builtin_amdgcn_sched_barrier(0);
        if (s * 2 < nkt) {
            const bf16x8 pf = pack8(sc[2 * s], sc[2 * s + 1]);
#pragma unroll
            for (int dt = 0; dt < 4; ++dt) o[dt] = MFMA16(vf[s & 1][dt], pf, o[dt]);
        }
    }
    m_out = mx; l_out = ls;
}

template <bool CAUSAL>
__device__ __forceinline__ void attn_core(const char* smem, const bf16_t* qrow, int qt, int kbase, int nkeys, int fr, int fq, float& m_out, float& l_out, f32x4 (&o)[4]) {
    bf16x8 qf[2];
#pragma unroll
    for (int ks = 0; ks < 2; ++ks) qf[ks] = *(const bf16x8*)(qrow + ks * 32 + fq * 8);
    attn_core_q<CAUSAL>(smem, qf, qt, kbase, nkeys, fr, fq, m_out, l_out, o);
}

__device__ __forceinline__ void moba_partial(const P& p, int bid, int nb, char* smem) {
    const int tid = otid(), lane = tid & 63, w = tid >> 6, fr = lane & 15, fq = lane >> 4;
    char* ws = p.ws;
    const bf16_t* um = (const bf16_t*)(ws + OFF_UM);
    const int* glst = (const int*)(ws + OFF_CTL + CTL_MLST); const int* gtst = (const int*)(ws + OFF_CTL + CTL_MTST);
    const int* QL = (const int*)(ws + OFF_MQL);
    bf16_t* PO = (bf16_t*)p.out; float* PM = (float*)((char*)p.out + 52 * MiB); float* PL = PM + 400000;
    int* tst = (int*)(smem + A_TST); int* lst = (int*)(smem + A_LST);
    for (int i = tid; i < 513; i += NT) { tst[i] = gtst[i]; lst[i] = glst[i]; }
    __syncthreads();
    const int* gcst = (const int*)(ws + OFF_CTL + CTL_MCST);
    int* cst = (int*)(smem + A_CST);
    for (int i = tid; i < 513; i += NT) cst[i] = gcst[i];
    __syncthreads();
    auto first_tile = [&](int cpos) {
        int lo = 0, hi = 512;
        while (hi - lo > 1) { const int mid = (lo + hi) >> 1; if (cst[mid] <= cpos) lo = mid; else hi = mid; }
        const int ntl = tst[lo + 1] - tst[lo];
        int k = (cpos - cst[lo] - 2 + 1) >> 1; if (k < 0) k = 0;
        return (k >= ntl) ? tst[lo + 1] : tst[lo] + k;
    };
    const int Ctot = cst[512];
    const int it0 = first_tile((int)((long)Ctot * bid / nb)), it1 = (bid + 1 == nb) ? tst[512] : first_tile((int)((long)Ctot * (bid + 1) / nb));
    int lq = 0;
    auto tile_pos = [&](int it, int& li, int& pos, bool& valid) {
        int lo = lq;
        while (lo < 511 && tst[lo + 1] <= it) ++lo;
        lq = lo; li = lo;
        const int base = lst[lo] + (it - tst[lo]) * 128, idx = w * 16 + fr;
        valid = base + idx < lst[lo + 1];
        pos = valid ? base + idx : base;
    };
    { int lo = 0, hi = 512; while (hi - lo > 1) { const int mid = (lo + hi) >> 1; if (tst[mid] <= it0) lo = mid; else hi = mid; } lq = lo; }
    int liA = 0, posA = 0, liB = 0, posB = 0, qtA = 0, qtB = 0; bool vA = false, vB = false;
    bf16x8 qfA[2];
    if (it0 < it1) {
        tile_pos(it0, liA, posA, vA); qtA = QL[posA];
        if (it0 + 1 < it1) { tile_pos(it0 + 1, liB, posB, vB); qtB = QL[posB]; }
#pragma unroll
        for (int ks = 0; ks < 2; ++ks) qfA[ks] = *(const bf16x8*)(um + (size_t)qtA * UMC + (liA >> 6) * 64 + ks * 32 + fq * 8);
    }
    int lprev = -1, lpre = -1;
    u32x4 rk[4], rv[4];
    for (int it = it0; it < it1; ++it) {
        const int h = liA >> 6, j = liA & 63;
        if (liA != lprev) {
            if (lpre != liA) attn_stage_load(p, j, h, tid, rk, rv);
            __syncthreads();
            attn_stage_store(p, h, tid, smem, rk, rv);
            __syncthreads();
            lprev = liA;
        }
        if (it + 1 < it1 && liB != liA) { attn_stage_load(p, liB & 63, liB >> 6, tid, rk, rv); lpre = liB; }
        bf16x8 qfB[2]; int liC = 0, posC = 0, qtC = 0; bool vC = false;
        if (it + 1 < it1) {
#pragma unroll
            for (int ks = 0; ks < 2; ++ks) qfB[ks] = *(const bf16x8*)(um + (size_t)qtB * UMC + (liB >> 6) * 64 + ks * 32 + fq * 8);
        } else { qfB[0] = qfA[0]; qfB[1] = qfA[1]; }
        if (it + 2 < it1) { tile_pos(it + 2, liC, posC, vC); qtC = QL[posC]; }
        float m, l; f32x4 o[4];
        attn_core_q_pipe<false>(smem, qfA, qtA, j * 256, 256, fr, fq, m, l, o);
        if (vA) {
#pragma unroll
            for (int dt = 0; dt < 4; ++dt) *(u32x2*)(PO + (size_t)posA * 64 + dt * 16 + fq * 4) = pack4(o[dt]);
            if (fq == 0) { PM[posA] = m; PL[posA] = l; }
        }
        liA = liB; posA = posB; vA = vB; qtA = qtB; qfA[0] = qfB[0]; qfA[1] = qfB[1];
        liB = liC; posB = posC; vB = vC; qtB = qtC;
    }
}

__device__ __forceinline__ void moba_own(const P& p, int bid, int nb, char* smem) {
    const int tid = otid(), lane = tid & 63, w = tid >> 6, fr = lane & 15, fq = lane >> 4;
    char* ws = p.ws;
    const bf16_t* um = (const bf16_t*)(ws + OFF_UM);
    const int* SP = (const int*)(ws + OFF_MSP);
    const bf16_t* PO = (const bf16_t*)p.out; const float* PM = (const float*)((const char*)p.out + 52 * MiB); const float* PL = PM + 400000;
    bf16_t* ob = (bf16_t*)(ws + OFF_OB);
    u32x4 rk[4], rv[4];
    if (bid < 1024) attn_stage_load(p, (bid >> 3) >> 1, bid & 7, tid, rk, rv);
    for (int it = bid; it < 1024; it += nb) {
        const int tile = it >> 3, h = it & 7, b = tile >> 1, tb = tile & 1, nkeys = (tb + 1) * 128;
        __syncthreads();
        attn_stage_store(p, h, tid, smem, rk, rv);
        __syncthreads();
        if (it + nb < 1024) attn_stage_load(p, ((it + nb) >> 3) >> 1, (it + nb) & 7, tid, rk, rv);
        const int qt = tile * 128 + w * 16 + fr;
        int pos[3]; float pm[3], pl[3];
#pragma unroll
        for (int s = 0; s < 3; ++s) pos[s] = SP[(qt * 8 + h) * 3 + s];
#pragma unroll
        for (int s = 0; s < 3; ++s) { pm[s] = (pos[s] >= 0) ? PM[pos[s]] : -3.0e38f; pl[s] = (pos[s] >= 0) ? PL[pos[s]] : 0.f; }
        float m, l; f32x4 o[4];
        attn_core<true>(smem, um + (size_t)qt * UMC + h * 64, qt, b * 256, nkeys, fr, fq, m, l, o);
        float M = m;
#pragma unroll
        for (int s = 0; s < 3; ++s) M = fmaxf(M, pm[s]);
        const float so = __expf(m - M);
        float den = l * so;
#pragma unroll
        for (int dt = 0; dt < 4; ++dt) o[dt] = o[dt] * so;
#pragma unroll
        for (int s = 0; s < 3; ++s) {
            if (pos[s] >= 0) {
                const float e = __expf(pm[s] - M);
                den += pl[s] * e;
#pragma unroll
                for (int dt = 0; dt < 4; ++dt) o[dt] = o[dt] + e * unpack4(*(const u32x2*)(PO + (size_t)pos[s] * 64 + dt * 16 + fq * 4));
            }
        }
        const float inv = 1.f / den;
#pragma unroll
        for (int dt = 0; dt < 4; ++dt) *(u32x2*)(ob + (size_t)qt * 512 + h * 64 + dt * 16 + fq * 4) = pack4(o[dt] * inv);
    }
}

__device__ __forceinline__ void phase_kvx(const P& p, int bid0, int nb0, char* smem) {
    char* ws = p.ws;
    bf16_t* KX = (bf16_t*)(ws + OFF_KVX); bf16_t* VXT = KX + 256 * 512;
    for (int it = bid0; it < 8; it += nb0) {
        f32x4 acc[2][8];
#pragma unroll
        for (int m = 0; m < 2; ++m)
#pragma unroll
            for (int n = 0; n < 8; ++n) acc[m][n] = (f32x4){0.f, 0.f, 0.f, 0.f};
        gemm_r32(acc, (const bf16_t*)(ws + OFF_MEMN), D, 0, (const bf16_t*)(ws + OFF_WKV), D, it * 128, D, smem);
        const int tid = otid(), lane = tid & 63, w = tid >> 6, fr = lane & 15, fq = lane >> 4;
#pragma unroll
        for (int m = 0; m < 2; ++m) {
            const int row = w * 32 + m * 16 + fr;
#pragma unroll
            for (int n = 0; n < 8; ++n) {
                const f32x4 v = acc[m][n];
                if (it < 4) *(u32x2*)(KX + (size_t)row * 512 + it * 128 + n * 16 + fq * 4) = pack4(v);
                else {
                    const int col = (it - 4) * 128 + n * 16 + fq * 4;
                    VXT[(size_t)(col + 0) * 256 + row] = (bf16_t)f2bf(v.x); VXT[(size_t)(col + 1) * 256 + row] = (bf16_t)f2bf(v.y);
                    VXT[(size_t)(col + 2) * 256 + row] = (bf16_t)f2bf(v.z); VXT[(size_t)(col + 3) * 256 + row] = (bf16_t)f2bf(v.w);
                }
            }
        }
    }
}

__device__ __forceinline__ void phase_qx_xattn(const P& p, int bid, int nb, char* smem) {
    char* ws = p.ws;
    const bf16_t* KX = (const bf16_t*)(ws + OFF_KVX); const bf16_t* VXT = KX + 256 * 512;
    bf16_t* ox = (bf16_t*)(ws + OFF_OB);
    for (int it = bid; it < 256; it += nb) {
        const int pm = it >> 2, h = it & 3;
        bf16x8 qf[2][4];
        {
            f32x4 acc[2][8];
#pragma unroll
            for (int m = 0; m < 2; ++m)
#pragma unroll
                for (int n = 0; n < 8; ++n) acc[m][n] = (f32x4){0.f, 0.f, 0.f, 0.f};
            gemm_r32(acc, (const bf16_t*)(ws + OFF_XN), D, pm * 256, (const bf16_t*)(ws + OFF_WQ), D, h * 128, D, smem);
            const float sc = 0.08838834764831845f;
#pragma unroll
            for (int m = 0; m < 2; ++m)
#pragma unroll
                for (int s2 = 0; s2 < 4; ++s2) qf[m][s2] = pack8(acc[m][2 * s2] * sc, acc[m][2 * s2 + 1] * sc);
        }
        const int tid = otid(), lane = tid & 63, w = tid >> 6, fr = lane & 15, fq = lane >> 4;
        for (int idx = tid; idx < 4096; idx += NT) { const int key = idx >> 4, ch = idx & 15; *(u32x4*)(smem + key * 272 + ch * 16) = *(const u32x4*)(KX + (size_t)key * 512 + h * 128 + ch * 8); }
        __syncthreads();
        bf16x8 pf[2][8]; float inv[2];
#pragma unroll
        for (int m = 0; m < 2; ++m) {
            f32x4 sc[16]; float mx = -3.0e38f;
            bf16x8 kq[2][4];
#pragma unroll
            for (int s2 = 0; s2 < 4; ++s2) kq[0][s2] = ldperm(smem + fr * 272, s2, fq);
#pragma unroll
            for (int kt = 0; kt < 16; ++kt) {
                if (kt + 1 < 16) {
#pragma unroll
                    for (int s2 = 0; s2 < 4; ++s2) kq[(kt + 1) & 1][s2] = ldperm(smem + ((kt + 1) * 16 + fr) * 272, s2, fq);
                }
                __builtin_amdgcn_sched_barrier(0);
                f32x4 a = {0.f, 0.f, 0.f, 0.f};
#pragma unroll
                for (int s2 = 0; s2 < 4; ++s2) a = MFMA16(kq[kt & 1][s2], qf[m][s2], a);
                sc[kt] = a; mx = fmaxf(fmaxf(mx, fmaxf(a.x, a.y)), fmaxf(a.z, a.w));
            }
            mx = fmaxf(mx, __shfl_xor(mx, 16)); mx = fmaxf(mx, __shfl_xor(mx, 32));
            float ls = 0.f;
#pragma unroll
            for (int kt = 0; kt < 16; ++kt) { sc[kt].x = __expf(sc[kt].x - mx); sc[kt].y = __expf(sc[kt].y - mx); sc[kt].z = __expf(sc[kt].z - mx); sc[kt].w = __expf(sc[kt].w - mx); ls += (sc[kt].x + sc[kt].y) + (sc[kt].z + sc[kt].w); }
            ls += __shfl_xor(ls, 16); ls += __shfl_xor(ls, 32);
            inv[m] = 1.f / ls;
#pragma unroll
            for (int s2 = 0; s2 < 8; ++s2) { pf[m][s2] = pack8(sc[2 * s2], sc[2 * s2 + 1]); asm volatile("" : "+v"(pf[m][s2])); }
            asm volatile("" ::: "memory");
        }
        __syncthreads();
        for (int idx = tid; idx < 4096; idx += NT) { const int d = idx >> 5, ch = idx & 31; *(u32x4*)(smem + d * 528 + ch * 16) = *(const u32x4*)(VXT + (size_t)(h * 128 + d) * 256 + ch * 8); }
        __syncthreads();
        {
            bf16x8 vq[2][8];
#pragma unroll
            for (int s2 = 0; s2 < 8; ++s2) vq[0][s2] = ldperm(smem + fr * 528, s2, fq);
#pragma unroll
            for (int dt = 0; dt < 8; ++dt) {
                if (dt + 1 < 8) {
#pragma unroll
                    for (int s2 = 0; s2 < 8; ++s2) vq[(dt + 1) & 1][s2] = ldperm(smem + ((dt + 1) * 16 + fr) * 528, s2, fq);
                }
                __builtin_amdgcn_sched_barrier(0);
#pragma unroll
                for (int m = 0; m < 2; ++m) {
                    const int row = pm * 256 + w * 32 + m * 16 + fr;
                    f32x4 o = {0.f, 0.f, 0.f, 0.f};
#pragma unroll
                    for (int s2 = 0; s2 < 8; ++s2) o = MFMA16(vq[dt & 1][s2], pf[m][s2], o);
                    *(u32x2*)(ox + (size_t)row * 512 + h * 128 + dt * 16 + fq * 4) = pack4(o * inv[m]);
                }
                asm volatile("" ::: "memory");
            }
        }
        __syncthreads();
    }
}

struct EpiMergeA {
    static constexpr bool PERM = true;
    char* ws;
    __device__ __forceinline__ void operator()(const f32x4 (&acc)[2][2][4][2], const pg8::Unit& u, int wr, int wc, int fr, int fq) const {
        const bf16_t* ug = (const bf16_t*)(ws + OFF_UG); bf16_t* mg = (bf16_t*)(ws + OFF_MRG);
        const int row0 = u.pm * 256 + wr * 64 + fr, col0 = u.pn * 256 + wc * 32 + 8 * fq;
#pragma unroll
        for (int ai = 0; ai < 2; ++ai)
#pragma unroll
            for (int m = 0; m < 4; ++m) {
                const size_t row = row0 + ai * 128 + m * 16;
#pragma unroll
                for (int bj = 0; bj < 2; ++bj) {
                    const int col = col0 + bj * 128;
                    float g[8]; unpack8(*(const u32x4*)(ug + row * GCOLS + col), g);
                    const f32x4 a = acc[ai][bj][m][0], b = acc[ai][bj][m][1];
                    u32x4 w; w.x = cvt_pk(g[0] * a.x, g[1] * a.y); w.y = cvt_pk(g[2] * a.z, g[3] * a.w); w.z = cvt_pk(g[4] * b.x, g[5] * b.y); w.w = cvt_pk(g[6] * b.z, g[7] * b.w);
                    *(u32x4*)(mg + row * D + col) = w;
                }
            }
    }
};
struct EpiMergeB {
    static constexpr bool PERM = true;
    char* ws;
    __device__ __forceinline__ void operator()(const f32x4 (&acc)[2][2][4][2], const pg8::Unit& u, int wr, int wc, int fr, int fq) const {
        const bf16_t* ug = (const bf16_t*)(ws + OFF_UG); bf16_t* mg = (bf16_t*)(ws + OFF_MRG);
        const int row0 = u.pm * 256 + wr * 64 + fr, col0 = u.pn * 256 + wc * 32 + 8 * fq;
#pragma unroll
        for (int ai = 0; ai < 2; ++ai)
#pragma unroll
            for (int m = 0; m < 4; ++m) {
                const size_t row = row0 + ai * 128 + m * 16;
#pragma unroll
                for (int bj = 0; bj < 2; ++bj) {
                    const int col = col0 + bj * 128;
                    float g[8], t[8]; unpack8(*(const u32x4*)(ug + row * GCOLS + 1024 + col), g); unpack8(*(const u32x4*)(mg + row * D + col), t);
                    const f32x4 a = acc[ai][bj][m][0], b = acc[ai][bj][m][1];
                    u32x4 w; w.x = cvt_pk(t[0] + g[0] * a.x, t[1] + g[1] * a.y); w.y = cvt_pk(t[2] + g[2] * a.z, t[3] + g[3] * a.w);
                    w.z = cvt_pk(t[4] + g[4] * b.x, t[5] + g[5] * b.y); w.w = cvt_pk(t[6] + g[6] * b.z, t[7] + g[7] * b.w);
                    *(u32x4*)(mg + row * D + col) = w;
                }
            }
    }
};
__device__ __forceinline__ void phase_merge(const P& p, int bid, int nb, char* smem) {
    pg8::StaticOrder S; S.init(T, D, nb, bid);
    EpiMergeA EA{p.ws}; EpiMergeB EB{p.ws};
    pg8::gemm_phase<EpiMergeA, pg8::StaticOrder, true>((LAS unsigned char*)smem, (const bf16_t*)(p.ws + OFF_OA), (const bf16_t*)(p.ws + OFF_WORW), 512, S, EA);
    pg8::gemm_phase<EpiMergeB, pg8::StaticOrder, true>((LAS unsigned char*)smem, (const bf16_t*)(p.ws + OFF_OB), (const bf16_t*)(p.ws + OFF_WOMB), 512, S, EB);
}
__device__ __forceinline__ bf16_t* xb_row(char* ws, int row) { return (bf16_t*)(ws + (row < 8192 ? OFF_XB0 : OFF_XB1 - (size_t)8192 * D * 2)) + (size_t)row * D; }
struct EpiResidX {
    static constexpr bool PERM = true;
    const float* res; char* ws;
    __device__ __forceinline__ void operator()(const f32x4 (&acc)[2][2][4][2], const pg8::Unit& u, int wr, int wc, int fr, int fq) const {
        const int row0 = u.pm * 256 + wr * 64 + fr, col0 = u.pn * 256 + wc * 32 + 8 * fq;
#pragma unroll
        for (int ai = 0; ai < 2; ++ai)
#pragma unroll
            for (int m = 0; m < 4; ++m) {
                const int row = row0 + ai * 128 + m * 16;
                const float* rp = res + (size_t)row * D + col0; bf16_t* op = xb_row(ws, row) + col0;
                f32x4 r[2][2];
#pragma unroll
                for (int bj = 0; bj < 2; ++bj)
#pragma unroll
                    for (int n = 0; n < 2; ++n) r[bj][n] = *(const f32x4*)(rp + bj * 128 + n * 4);
#pragma unroll
                for (int bj = 0; bj < 2; ++bj) {
                    const u32x2 lo = pack4(r[bj][0] + acc[ai][bj][m][0]), hi = pack4(r[bj][1] + acc[ai][bj][m][1]);
                    *(u32x4*)(op + bj * 128) = (u32x4){lo.x, lo.y, hi.x, hi.y};
                }
            }
    }
};
struct EpiResidB {
    static constexpr bool PERM = true;
    char* ws;
    __device__ __forceinline__ void operator()(const f32x4 (&acc)[2][2][4][2], const pg8::Unit& u, int wr, int wc, int fr, int fq) const {
        const int row0 = u.pm * 256 + wr * 64 + fr, col0 = u.pn * 256 + wc * 32 + 8 * fq;
#pragma unroll
        for (int ai = 0; ai < 2; ++ai)
#pragma unroll
            for (int m = 0; m < 4; ++m) {
                bf16_t* op = xb_row(ws, row0 + ai * 128 + m * 16) + col0;
                u32x4 r[2];
#pragma unroll
                for (int bj = 0; bj < 2; ++bj) r[bj] = *(const u32x4*)(op + bj * 128);
#pragma unroll
                for (int bj = 0; bj < 2; ++bj) {
                    const u32x2 lo = pack4(unpack4((u32x2){r[bj].x, r[bj].y}) + acc[ai][bj][m][0]), hi = pack4(unpack4((u32x2){r[bj].z, r[bj].w}) + acc[ai][bj][m][1]);
                    *(u32x4*)(op + bj * 128) = (u32x4){lo.x, lo.y, hi.x, hi.y};
                }
            }
    }
};
struct EpiResid {
    static constexpr bool PERM = false;
    const float* res; float* out;
    __device__ __forceinline__ void operator()(const f32x4 (&acc)[2][2][4][2], const pg8::Unit& u, int wr, int wc, int fr, int fq) const {
        const int row0 = u.pm * 256 + wr * 64 + fr, col0 = u.pn * 256 + wc * 32 + 4 * fq;
#pragma unroll
        for (int ai = 0; ai < 2; ++ai)
#pragma unroll
            for (int m = 0; m < 4; ++m) {
                const size_t off = (size_t)(row0 + ai * 128 + m * 16) * D + col0;
#pragma unroll
                for (int bj = 0; bj < 2; ++bj)
#pragma unroll
                    for (int n = 0; n < 2; ++n) { const f32x4 r = *(const f32x4*)(res + off + bj * 128 + n * 16); *(f32x4*)(out + off + bj * 128 + n * 16) = r + acc[ai][bj][m][n]; }
            }
    }
};
__device__ __forceinline__ void phase_resid_gemm_x(const bf16_t* A, int K, const bf16_t* Bt, const float* res, char* ws, int bid, int nb, char* smem) {
    pg8::StaticOrder S; S.init(T, D, nb, bid);
    EpiResidX E{res, ws};
    pg8::gemm_phase<EpiResidX, pg8::StaticOrder, true>((LAS unsigned char*)smem, A, Bt, K, S, E);
}
__device__ __forceinline__ void phase_resid_gemm_b(const bf16_t* A, int K, const bf16_t* Bt, char* ws, int bid, int nb, char* smem) {
    pg8::StaticOrder S; S.init(T, D, nb, bid);
    EpiResidB E{ws};
    pg8::gemm_phase<EpiResidB, pg8::StaticOrder, true>((LAS unsigned char*)smem, A, Bt, K, S, E);
}
__device__ __forceinline__ void phase_norm(char* ws, const float* g, bf16_t* dst, int bid, int nb) {
    const int lane = otid() & 63, wid = otid() >> 6;
    f32x4 gr[4]; load_gain(gr, g, lane);
    for (int it = bid; it < T / 8; it += nb) {
        const int row = it * 8 + wid;
        const u32x2* xr = (const u32x2*)xb_row(ws, row) + lane;
        f32x4 v[4]; float s = 0.f;
#pragma unroll
        for (int j = 0; j < 4; ++j) { v[j] = unpack4(xr[64 * j]); s += v[j].x * v[j].x + v[j].y * v[j].y + v[j].z * v[j].z + v[j].w * v[j].w; }
        const float rstd = rsqrtf(wave_sum(s) * (1.f / 1024.f) + 1e-6f);
        u32x2* o8 = (u32x2*)(dst + (size_t)row * D) + lane;
#pragma unroll
        for (int j = 0; j < 4; ++j) { const f32x4 gg = gr[j]; u32x2 o; o.x = pk2(v[j].x * rstd * gg.x, v[j].y * rstd * gg.y); o.y = pk2(v[j].z * rstd * gg.z, v[j].w * rstd * gg.w); o8[64 * j] = o; }
    }
}
struct ConvT { const float* W; bf16_t* Wt; int K, N, rs, roff, tile; };
constexpr int CONV_B = 32 * 64 + 12 * 128, CONV_N = 32 * 64 + 32 * 128;
__device__ __forceinline__ bool conv_item(const P& p, int it, int hi, ConvT& c) {
    if (it >= hi) return false;
    bf16_t* gu = (bf16_t*)(p.ws + OFF_EXPGU); bf16_t* dn = (bf16_t*)(p.ws + OFF_EXPD);
    if (it < 2048) { const int e = it >> 6; c.W = p.w_exp_down + (size_t)e * DEXP * D; c.Wt = dn + (size_t)e * D * DEXP; c.K = DEXP; c.N = D; c.rs = 16; c.roff = 0; c.tile = it & 63; return true; }
    const int r = it - 2048, e = r >> 7, which = (r >> 6) & 1;
    c.W = (which ? p.w_exp_up : p.w_exp_gate) + (size_t)e * D * DEXP; c.Wt = gu + (size_t)e * D * D; c.K = D; c.N = DEXP; c.rs = 0; c.roff = which * 128; c.tile = r & 63;
    return true;
}
__device__ __forceinline__ void conv_two(const ConvT& c0, const ConvT& c1, const bool h1, char* smem, const int tid) {
    float v0[16], v1[16];
    {
        const int nnb = c0.N / 128, k0 = (c0.tile / nnb) * 64, n0 = (c0.tile % nnb) * 128;
#pragma unroll
        for (int i = 0; i < 16; ++i) v0[i] = c0.W[(size_t)(k0 + i * 4 + (tid >> 7)) * c0.N + n0 + (tid & 127)];
    }
    {
        const int nnb = c1.N / 128, k0 = (c1.tile / nnb) * 64, n0 = (c1.tile % nnb) * 128;
#pragma unroll
        for (int i = 0; i < 16; ++i) v1[i] = c1.W[(size_t)(k0 + i * 4 + (tid >> 7)) * c1.N + n0 + (tid & 127)];
    }
    float* s0 = (float*)smem; float* s1 = s0 + 64 * 129 + 64;
#pragma unroll
    for (int i = 0; i < 16; ++i) { const int k = i * 4 + (tid >> 7), n = tid & 127; s0[k * 129 + n] = v0[i]; s1[k * 129 + n] = v1[i]; }
    __syncthreads();
#pragma unroll
    for (int q = 0; q < 2; ++q) {
        const ConvT& c = q ? c1 : c0; const float* sc = q ? s1 : s0;
        if (q == 1 && !h1) break;
        const int nnb = c.N / 128, k0 = (c.tile / nnb) * 64, n0 = (c.tile % nnb) * 128;
#pragma unroll
        for (int i = 0; i < 2; ++i) {
            const int cc = tid + i * 512, n = cc >> 3, kc = cc & 7;
            const float* s = sc + (kc * 8) * 129 + n;
            u32x4 o; o.x = pk2(s[0], s[129]); o.y = pk2(s[2 * 129], s[3 * 129]); o.z = pk2(s[4 * 129], s[5 * 129]); o.w = pk2(s[6 * 129], s[7 * 129]);
            const int nn = n0 + n, drow = c.rs ? (nn >> 4) * c.rs + (nn & 15) + c.roff : (nn >> 7) * 256 + c.roff + (nn & 127);
            *(u32x4*)(c.Wt + (size_t)drow * c.K + k0 + kc * 8) = o;
        }
    }
}
__device__ __forceinline__ void phase_expconv(const P& p, int bid, int nb, char* smem, int lo, int hi) {
    const int tid = otid();
    for (int it = lo + bid; ; it += 2 * nb) {
        ConvT c0, c1;
        const bool h0 = conv_item(p, it, hi, c0), h1 = conv_item(p, it + nb, hi, c1);
        if (!h0) break;
        if (!h1) c1 = c0;
        conv_two(c0, c1, h1, smem, tid);
        __syncthreads();
    }
}
constexpr int L_CONVBC = 67584;
__device__ __forceinline__ void phase_expconv_dyn(const P& p, char* smem, int lo, int hi, int* ctr) {
    const int tid = otid();
    volatile LAS int* bc = (volatile LAS int*)(LAS char*)(smem + L_CONVBC);
    if (tid == 0) bc[0] = atomicAdd(ctr, 1);
    __syncthreads();
    int g = __builtin_amdgcn_readfirstlane(bc[0]);
    for (;;) {
        const int it = lo + 2 * g;
        if (it >= hi) break;
        int gn = 0;
        if (tid == 0) gn = atomicAdd(ctr, 1);
        ConvT c0, c1;
        conv_item(p, it, hi, c0); const bool h1 = conv_item(p, it + 1, hi, c1);
        if (!h1) c1 = c0;
        conv_two(c0, c1, h1, smem, tid);
        if (tid == 0) bc[0] = gn;
        __builtin_amdgcn_s_sleep(32);
        __syncthreads();
        g = __builtin_amdgcn_readfirstlane(bc[0]);
    }
}

__device__ __forceinline__ void phase_router(const P& p, int bid, int nb, char* smem) {
    const int tid = otid(), lane = tid & 63, wid = tid >> 6;
    char* ws = p.ws;
    int* hist = (int*)smem;
    if (tid < 32) hist[tid] = 0;
    __syncthreads();
    bf16_t* xn = (bf16_t*)(ws + OFF_XN);
    int* toke = (int*)(ws + OFF_CTL + CTL_TOKE); float* tokg = (float*)(ws + OFF_CTL + CTL_TOKG);
    int* rowtok = (int*)(ws + OFF_CTL + CTL_ROWTOK);
    for (int i = bid * NT + tid; i < CAP; i += nb * NT) rowtok[i] = 0;
    float* rt = (float*)(smem + 256);
    {
        const char* src = (const char*)(ws + OFF_ROUT);
#pragma unroll
        for (int i = 0; i < 18; ++i) __builtin_amdgcn_global_load_lds((const unsigned*)(src + (size_t)(i * NT + tid) * 16), (unsigned*)((char*)rt + (size_t)(i * NT + tid) * 16), 16, 0, 0);
    }
    f32x4 gnorm[4];
#pragma unroll
    for (int j = 0; j < 4; ++j) gnorm[j] = ((const f32x4*)p.norm_ffn + lane)[64 * j];
    asm volatile("s_waitcnt vmcnt(0)" ::: "memory");
    __syncthreads();
    for (int it = bid; it < T / 32; it += nb) {
        const int tidr = otid(), lane = tidr & 63, wid = tidr >> 6;
        const int rbase = it * 32 + wid * 4;
#pragma unroll 1
        for (int rp = 0; rp < 2; ++rp) {
            f32x4 hv[2][4];
#pragma unroll
            for (int r2 = 0; r2 < 2; ++r2) {
                const u32x2* xr = (const u32x2*)xb_row(ws, rbase + rp * 2 + r2) + lane;
                float s = 0.f;
#pragma unroll
                for (int j = 0; j < 4; ++j) { hv[r2][j] = unpack4(xr[64 * j]); s += hv[r2][j].x * hv[r2][j].x + hv[r2][j].y * hv[r2][j].y + hv[r2][j].z * hv[r2][j].z + hv[r2][j].w * hv[r2][j].w; }
                const float rstd = rsqrtf(wave_sum(s) * (1.f / 1024.f) + 1e-6f);
                u32x2* o8 = (u32x2*)(xn + (size_t)(rbase + rp * 2 + r2) * D) + lane;
#pragma unroll
                for (int j = 0; j < 4; ++j) { hv[r2][j] = hv[r2][j] * rstd * gnorm[j]; o8[64 * j] = pack4(hv[r2][j]); }
            }
            float ve[2][32], vg[2][4];
            f32x4 wq[2][4];
#pragma unroll
            for (int j = 0; j < 4; ++j) wq[0][j] = ((const f32x4*)rt + lane)[64 * j];
#pragma unroll
            for (int o = 0; o < 36; ++o) {
                if (o + 1 < 36) {
                    const f32x4* wr_ = (const f32x4*)(rt + (o + 1) * 1024) + lane;
#pragma unroll
                    for (int j = 0; j < 4; ++j) wq[(o + 1) & 1][j] = wr_[64 * j];
                }
                const f32x4 (&w)[4] = wq[o & 1];
#pragma unroll
                for (int r2 = 0; r2 < 2; ++r2) {
                    f32x2 a2 = {0.f, 0.f};
#pragma unroll
                    for (int j = 0; j < 4; ++j) { a2 = (f32x2){hv[r2][j].x, hv[r2][j].y} * (f32x2){w[j].x, w[j].y} + a2; a2 = (f32x2){hv[r2][j].z, hv[r2][j].w} * (f32x2){w[j].z, w[j].w} + a2; }
                    const float sacc = a2.x + a2.y;
                    if (o < 32) ve[r2][o] = sacc; else vg[r2][o - 32] = sacc;
                }
                asm volatile("" ::: "memory");
            }
#pragma unroll
            for (int r2 = 0; r2 < 2; ++r2) {
#define RT_LEVEL(D, NH) { const bool hi = (lane & (D)) != 0; _Pragma("unroll") for (int i = 0; i < (NH); ++i) { \
                    const float keep = hi ? ve[r2][2 * i + 1] : ve[r2][2 * i], send = hi ? ve[r2][2 * i] : ve[r2][2 * i + 1]; ve[r2][i] = keep + __shfl_xor(send, (D)); } }
                RT_LEVEL(32, 16) RT_LEVEL(16, 8) RT_LEVEL(8, 4) RT_LEVEL(4, 2) RT_LEVEL(2, 1)
#undef RT_LEVEL
                ve[r2][0] += __shfl_xor(ve[r2][0], 1);
                {
                    const bool h5 = (lane & 32) != 0, h4 = (lane & 16) != 0;
                    const float k0 = h5 ? vg[r2][1] : vg[r2][0], s0 = h5 ? vg[r2][0] : vg[r2][1], k1 = h5 ? vg[r2][3] : vg[r2][2], s1 = h5 ? vg[r2][2] : vg[r2][3];
                    const float a0 = k0 + __shfl_xor(s0, 32), a1 = k1 + __shfl_xor(s1, 32);
                    float gsum = (h4 ? a1 : a0) + __shfl_xor(h4 ? a0 : a1, 16);
                    gsum += __shfl_xor(gsum, 8); gsum += __shfl_xor(gsum, 4); gsum += __shfl_xor(gsum, 2); gsum += __shfl_xor(gsum, 1);
                    vg[r2][0] = gsum;
                }
            }
#pragma unroll
            for (int r2 = 0; r2 < 2; ++r2) {
                const int rr = rp * 2 + r2;
                const float g0 = __shfl(vg[r2][0], 0), g1 = __shfl(vg[r2][0], 32), g2 = __shfl(vg[r2][0], 16), g3 = __shfl(vg[r2][0], 48);
                int gs = 0; float gm = g0;
                if (g1 > gm) { gm = g1; gs = 1; }
                if (g2 > gm) { gm = g2; gs = 2; }
                if (g3 > gm) { gm = g3; gs = 3; }
                const float gp = 1.f / (__expf(g0 - gm) + __expf(g1 - gm) + __expf(g2 - gm) + __expf(g3 - gm));
                float e[8];
#pragma unroll
                for (int i = 0; i < 8; ++i) {
                    const int o = gs * 8 + i;
                    const int src = ((o & 1) << 5) | (((o >> 1) & 1) << 4) | (((o >> 2) & 1) << 3) | (((o >> 3) & 1) << 2) | (((o >> 4) & 1) << 1);
                    e[i] = __shfl(ve[r2][0], src);
                }
                int i1 = 0; float v1 = e[0];
#pragma unroll
                for (int i = 1; i < 8; ++i) if (e[i] > v1) { v1 = e[i]; i1 = i; }
                int i2 = -1; float v2 = -3.0e38f;
#pragma unroll
                for (int i = 0; i < 8; ++i) if (i != i1 && e[i] > v2) { v2 = e[i]; i2 = i; }
                const float e2 = __expf(v2 - v1), den = 1.f / (1.f + e2);
                if (lane == 0) {
                    const int tok = rbase + rr;
                    toke[tok * 2] = gs * 8 + i1; toke[tok * 2 + 1] = gs * 8 + i2;
                    tokg[tok * 2] = gp * den; tokg[tok * 2 + 1] = gp * e2 * den;
                    atomicAdd(&hist[gs * 8 + i1], 1); atomicAdd(&hist[gs * 8 + i2], 1);
                }
            }
        }
    }
    __syncthreads();
    { const int t2 = otid(); const int* h2 = (const int*)smem; if (t2 < 32 && h2[t2]) atomicAdd((int*)(p.ws + OFF_CTL + CTL_CNT) + t2, h2[t2]); }
}
__device__ __forceinline__ void phase_dispatch(const P& p, int bid, int nb, char* smem) {
    const int tid = otid();
    char* ws = p.ws;
    int* pstart = (int*)smem;
    int* lh = pstart + 64;
    int* lc = lh + 32;
    int* cn = lc + 32;
    const int* counts = (const int*)(ws + OFF_CTL + CTL_CNT);
    int* cursor = (int*)(ws + OFF_CTL + CTL_CNT) + 32;
    if (tid < 32) { cn[tid] = counts[tid]; lh[tid] = 0; lc[tid] = 0; }
    __syncthreads();
    if (tid == 0) { int a = 0; for (int e = 0; e < 32; ++e) { pstart[e] = a; a += (cn[e] + MBLK - 1) / MBLK * MBLK; } pstart[32] = a; }
    __syncthreads();
    const int* toke = (const int*)(ws + OFF_CTL + CTL_TOKE);
    int* toks = (int*)(ws + OFF_CTL + CTL_TOKS); int* rowtok = (int*)(ws + OFF_CTL + CTL_ROWTOK);
    const int per = (T * 2 + nb - 1) / nb, i0 = bid * per, i1 = min(T * 2, i0 + per);
    for (int i = i0 + tid; i < i1; i += NT) atomicAdd(&lh[toke[i]], 1);
    __syncthreads();
    if (tid < 32) { const int c = lh[tid]; lh[tid] = c ? atomicAdd(&cursor[tid], c) : 0; }
    __syncthreads();
    for (int i = i0 + tid; i < i1; i += NT) {
        const int e = toke[i];
        const int pos = pstart[e] + lh[e] + atomicAdd(&lc[e], 1);
        rowtok[pos] = i >> 1; toks[i] = pos;
    }
    if (bid == 0) {
        int* blke = (int*)(ws + OFF_CTL + CTL_BLKE);
        for (int b = tid; b < NBLK; b += NT) {
            const int r = b * MBLK; int e = -1;
            if (r < pstart[32]) { e = 0; while (pstart[e + 1] <= r) ++e; }
            blke[b] = e;
        }
        if (tid == 0) blke[NBLK] = pstart[32] / MBLK;
    }
}
struct MoeOrder {
    const int* blke; const int* rowtok; int nunits, G, c; bool gather; int brows;
    __device__ bool next(int i, pg8::Unit& u) const {
        const int L = i * G + c; if (L >= nunits) return false;
        u.pm = L >> 2; u.pn = L & 3; u.e = blke[u.pm]; return true;
    }
    __device__ __forceinline__ unsigned rowA(const pg8::Unit& u, int r) const { return gather ? (unsigned)rowtok[u.pm * MBLK + r] : (unsigned)(u.pm * MBLK + r); }
    __device__ __forceinline__ unsigned rowB(const pg8::Unit& u, int r) const { return (unsigned)(u.e * brows + u.pn * 256 + r); }
};
struct EpiHid {
    static constexpr bool PERM = true;
    bf16_t* hid;
    __device__ __forceinline__ void operator()(const f32x4 (&acc)[2][2][4][2], const pg8::Unit& u, int wr, int wc, int fr, int fq) const {
        const int row0 = u.pm * 256 + wr * 64 + fr, col0 = u.pn * 128 + wc * 32 + 8 * fq;
#pragma unroll
        for (int ai = 0; ai < 2; ++ai)
#pragma unroll
            for (int m = 0; m < 4; ++m) {
                bf16_t* rowp = hid + (size_t)(row0 + ai * 128 + m * 16) * DEXP + col0;
                u32x2 hw[2];
#pragma unroll
                for (int n = 0; n < 2; ++n) {
                    const f32x4 g = acc[ai][0][m][n], uu = acc[ai][1][m][n];
                    f32x4 hval; hval.x = g.x * sigm(g.x) * uu.x; hval.y = g.y * sigm(g.y) * uu.y; hval.z = g.z * sigm(g.z) * uu.z; hval.w = g.w * sigm(g.w) * uu.w;
                    hw[n] = pack4(hval);
                }
                *(u32x4*)rowp = (u32x4){hw[0].x, hw[0].y, hw[1].x, hw[1].y};
            }
    }
};
struct EpiY {
    static constexpr bool PERM = true;
    bf16_t* ym;
    __device__ __forceinline__ void operator()(const f32x4 (&acc)[2][2][4][2], const pg8::Unit& u, int wr, int wc, int fr, int fq) const {
        const int row0 = u.pm * 256 + wr * 64 + fr, col0 = u.pn * 256 + wc * 32 + 8 * fq;
#pragma unroll
        for (int ai = 0; ai < 2; ++ai)
#pragma unroll
            for (int m = 0; m < 4; ++m) {
                bf16_t* rowp = ym + (size_t)(row0 + ai * 128 + m * 16) * D + col0;
#pragma unroll
                for (int bj = 0; bj < 2; ++bj) {
                    const f32x4 v0 = acc[ai][bj][m][0], v1 = acc[ai][bj][m][1];
                    u32x4 w; w.x = cvt_pk(v0.x, v0.y); w.y = cvt_pk(v0.z, v0.w); w.z = cvt_pk(v1.x, v1.y); w.w = cvt_pk(v1.z, v1.w);
                    *(u32x4*)(rowp + bj * 128) = w;
                }
            }
    }
};
__device__ __forceinline__ void phase_exp1(const P& p, int bid, int nb, char* smem) {
    char* ws = p.ws;
    const int* blke = (const int*)(ws + OFF_CTL + CTL_BLKE);
    MoeOrder S{blke, (const int*)(ws + OFF_CTL + CTL_ROWTOK), blke[NBLK] * 4, nb, bid, true, 1024};
    EpiHid E{(bf16_t*)(ws + OFF_MRG)};
    pg8::gemm_phase<EpiHid, MoeOrder, true>((LAS unsigned char*)smem, (const bf16_t*)(ws + OFF_XN), (const bf16_t*)(ws + OFF_EXPGU), D, S, E);
}
__device__ __forceinline__ void phase_exp2(const P& p, int bid, int nb, char* smem) {
    char* ws = p.ws;
    const int* blke = (const int*)(ws + OFF_CTL + CTL_BLKE);
    MoeOrder S{blke, nullptr, blke[NBLK] * 4, nb, bid, false, 1024};
    EpiY E{(bf16_t*)(ws + OFF_YMOE)};
    pg8::gemm_phase<EpiY, MoeOrder, true>((LAS unsigned char*)smem, (const bf16_t*)(ws + OFF_MRG), (const bf16_t*)(ws + OFF_EXPD), DEXP, S, E);
}
__device__ __forceinline__ void phase_final(const P& p, int bid, int nb) {
    const int lane = otid() & 63, wid = otid() >> 6;
    char* ws = p.ws;
    const int* toks = (const int*)(ws + OFF_CTL + CTL_TOKS); const float* tokg = (const float*)(ws + OFF_CTL + CTL_TOKG);
    const bf16_t* ym = (const bf16_t*)(ws + OFF_YMOE);
    f32x4 gfin[4]; load_gain(gfin, p.norm_final, lane);
    for (int it = bid; it < T / 8; it += nb) {
        const int row = it * 8 + wid;
        const int s1 = toks[row * 2], s2 = toks[row * 2 + 1]; const float g1 = tokg[row * 2], g2 = tokg[row * 2 + 1];
        f32x4* xo = (f32x4*)(p.out + (size_t)row * D) + lane; const u32x2* xr = (const u32x2*)xb_row(ws, row) + lane;
        const u32x2* y1 = (const u32x2*)(ym + (size_t)s1 * D) + lane; const u32x2* y2 = (const u32x2*)(ym + (size_t)s2 * D) + lane;
        f32x4 v[4]; float s = 0.f;
#pragma unroll
        for (int j = 0; j < 4; ++j) {
            v[j] = unpack4(xr[64 * j]) + g1 * unpack4(y1[64 * j]) + g2 * unpack4(y2[64 * j]);
            s += v[j].x * v[j].x + v[j].y * v[j].y + v[j].z * v[j].z + v[j].w * v[j].w;
        }
        const float rstd = rsqrtf(wave_sum(s) * (1.f / 1024.f) + 1e-6f);
#pragma unroll
        for (int j = 0; j < 4; ++j) xo[64 * j] = v[j] * rstd * gfin[j];
    }
}

template <int PH>
__device__ __forceinline__ void run_phase(const P& p, int bid, int nb, char* smem) {
    char* ws = p.ws;
    if (PH == 0) phase0(p, bid, nb, smem);
    else if (PH == 1) phase1(p, bid, nb, smem);
    else if (PH == 2) phase_rw_chunk(p, bid, nb, smem);
    else if (PH == 3) {
        if (bid < 32) rw_scan(p, bid, smem);
        else {
            if (bid < 40) phase_kvx(p, bid - 32, 8, smem);
            else {
                const int nd = (nb - 40) < 64 ? (nb - 40) : 64;
                if (bid - 40 < nd) { phase1_deferred(p, bid - 40, nd, smem); __syncthreads(); }
                moba_select(p, bid - 40, nb - 40, smem);
            }
            __syncthreads();
            phase_expconv_dyn(p, smem, 0, CONV_B, (int*)(ws + OFF_CTL + CTL_CNT) + 64);
        }
    }
    else if (PH == 4) { phase_rw_out(p, bid, nb); moba_fill(p, bid, nb, smem); __syncthreads(); phase_vtrans(p, bid, nb, smem); }
    else if (PH == 5) moba_partial(p, bid, nb, smem);
    else if (PH == 6) moba_own(p, bid, nb, smem);
    else if (PH == 7) phase_merge(p, bid, nb, smem);
    else if (PH == 8) {
        if ((bid >> 3) & 1) { phase_expconv(p, bid, nb, smem, CONV_B, CONV_N); __syncthreads(); }
        phase_resid_gemm_x((const bf16_t*)(ws + OFF_MRG), D, (const bf16_t*)(ws + OFF_WOUT), p.x, ws, bid, nb, smem);
        if (!((bid >> 3) & 1)) { __syncthreads(); phase_expconv(p, bid, nb, smem, CONV_B, CONV_N); }
    }
    else if (PH == 9) phase_norm(ws, p.norm_xattn, (bf16_t*)(ws + OFF_XN), bid, nb);
    else if (PH == 10) phase_qx_xattn(p, bid, nb, smem);
    else if (PH == 11) phase_resid_gemm_b((const bf16_t*)(ws + OFF_OB), 512, (const bf16_t*)(ws + OFF_WOX), ws, bid, nb, smem);
    else if (PH == 12) phase_router(p, bid, nb, smem);
    else if (PH == 13) phase_dispatch(p, bid, nb, smem);
    else if (PH == 14) phase_exp1(p, bid, nb, smem);
    else if (PH == 15) phase_exp2(p, bid, nb, smem);
    else if (PH == 16) phase_final(p, bid, nb);
}

#define XB_TMO      128
#define XB_XCNT(j)  (256  + 64 * (j))
#define XB_XSUB(j)  (1280 + 64 * (j))
#define XB_XGEN(j)  (2304 + 64 * (j))
#define XB_TOP      3328
#define XB_TOPGEN   3392
#define XCD_BAR_WORDS 3456
#define XB_SPIN_CAP (1u << 18)
__device__ __forceinline__ unsigned xb_ld(unsigned* p)              { return __hip_atomic_load(p, __ATOMIC_RELAXED, __HIP_MEMORY_SCOPE_AGENT); }
__device__ __forceinline__ unsigned xb_add(unsigned* p, unsigned v) { return __hip_atomic_fetch_add(p, v, __ATOMIC_RELAXED, __HIP_MEMORY_SCOPE_AGENT); }
__device__ __forceinline__ unsigned xb_xcc_id() { return (unsigned)__builtin_amdgcn_s_getreg((3 << 11) | 20) & 0xFu; }
#define XB_SPIN(cond, bar) do { unsigned _sp = 0; while (cond) { __builtin_amdgcn_s_sleep(1); \
    if ((++_sp & 255u) == 0u) { if (xb_ld(&(bar)[XB_TMO])) break; if (_sp > XB_SPIN_CAP) { atomicAdd(&(bar)[XB_TMO], 1u); break; } } } } while (0)
struct XcdBarrier { unsigned* bar; unsigned x; volatile LAS unsigned* st; };
__device__ __forceinline__ XcdBarrier xcd_barrier_post(unsigned* bar, volatile LAS unsigned* st) {
    XcdBarrier b; b.bar = bar; b.x = xb_xcc_id(); b.st = st;
    if (threadIdx.x == 0) (void)xb_add(&bar[XB_XCNT(b.x)], 1u);
    return b;
}
__device__ __forceinline__ void xcd_barrier_complete(unsigned* bar, unsigned x, unsigned& nloc, unsigned& nx) {
    const unsigned G = gridDim.x * gridDim.y * gridDim.z;
    unsigned sum, cnt, mine, sp = 0u;
    for (;;) {
        sum = 0u; cnt = 0u; mine = 0u;
#pragma unroll
        for (unsigned j = 0; j < 16; ++j) { const unsigned c = xb_ld(&bar[XB_XCNT(j)]); sum += c; cnt += (c > 0u) ? 1u : 0u; mine = (j == x) ? c : mine; }
        if (sum == G) break;
        __builtin_amdgcn_s_sleep(1);
        if ((++sp & 255u) == 0u) { if (xb_ld(&bar[XB_TMO])) break; if (sp > XB_SPIN_CAP) { atomicAdd(&bar[XB_TMO], 1u); break; } }
    }
    nloc = mine > 0u ? mine : 1u; nx = cnt > 0u ? cnt : 1u;
}
__device__ __forceinline__ void xcd_barrier(const XcdBarrier& b) {
    asm volatile("s_waitcnt vmcnt(0)" ::: "memory");
    __syncthreads();
    if (threadIdx.x == 0) {
        unsigned* bar = b.bar;
        __builtin_amdgcn_s_waitcnt(0);
        unsigned nloc = b.st[0], nx = b.st[1];
        if (nloc == 0u) { xcd_barrier_complete(bar, b.x, nloc, nx); b.st[0] = nloc; b.st[1] = nx; }
        const unsigned old = xb_add(&bar[XB_XSUB(b.x)], 1u);
        const unsigned gen = old / nloc;
        if (old + 1u == (gen + 1u) * nloc) {
            __builtin_amdgcn_fence(__ATOMIC_RELEASE, "agent");
            asm volatile("s_waitcnt vmcnt(0)" ::: "memory");
            const unsigned og = xb_add(&bar[XB_TOP], 1u);
            const unsigned tg = og / nx;
            if (og + 1u == (tg + 1u) * nx) xb_add(&bar[XB_TOPGEN], 1u);
            else XB_SPIN(xb_ld(&bar[XB_TOPGEN]) == tg, bar);
            __builtin_amdgcn_fence(__ATOMIC_ACQUIRE, "agent");
            xb_add(&bar[XB_XGEN(b.x)], 1u);
            asm volatile("s_waitcnt vmcnt(0)" ::: "memory");
        } else {
            XB_SPIN(xb_ld(&bar[XB_XGEN(b.x)]) == gen, bar);
            __builtin_amdgcn_fence(__ATOMIC_ACQUIRE, "agent");
            asm volatile("s_waitcnt vmcnt(0)" ::: "memory");
        }
    }
    __syncthreads();
}
constexpr int L_BARST = 154112;
constexpr int LDS_BYTES = 154368;
static_assert(2 * RW_LDS <= L_BARST && pg8::STAGE_BYTES <= L_BARST && A_TST + 2052 <= L_BARST, "lds");

__global__ void __launch_bounds__(NT, 2) mega_kernel(P p) {
    extern __shared__ __attribute__((aligned(16))) char smem[];
    const int bid = blockIdx.x, nb = gridDim.x;
    volatile LAS unsigned* bst = (volatile LAS unsigned*)(LAS char*)(smem + L_BARST);
    if (threadIdx.x < 2) bst[threadIdx.x] = 0u;
    __syncthreads();
    const XcdBarrier xb = xcd_barrier_post((unsigned*)(p.ws + OFF_CTL + CTL_BAR), bst);
#define GSYNC() xcd_barrier(xb)
    run_phase<0>(p, bid, nb, smem); GSYNC();
    run_phase<1>(p, bid, nb, smem); GSYNC();
    run_phase<2>(p, bid, nb, smem); GSYNC();
    run_phase<3>(p, bid, nb, smem); GSYNC();
    run_phase<4>(p, bid, nb, smem); GSYNC();
    run_phase<5>(p, bid, nb, smem); GSYNC();
    run_phase<6>(p, bid, nb, smem); GSYNC();
    run_phase<7>(p, bid, nb, smem); GSYNC();
    run_phase<8>(p, bid, nb, smem); GSYNC();
    run_phase<9>(p, bid, nb, smem); GSYNC();
    run_phase<10>(p, bid, nb, smem); GSYNC();
    run_phase<11>(p, bid, nb, smem); GSYNC();
    run_phase<12>(p, bid, nb, smem); GSYNC();
    run_phase<13>(p, bid, nb, smem); GSYNC();
    run_phase<14>(p, bid, nb, smem); GSYNC();
    run_phase<15>(p, bid, nb, smem); GSYNC();
    run_phase<16>(p, bid, nb, smem);
}

extern "C" void kernel_launch(void* const* d_in, const int* in_sizes, int n_in, void* d_out, int out_size, void* d_ws, size_t ws_size, hipStream_t stream) {
    if (n_in != 31 || ws_size < WS_NEED || out_size != T * D) { fprintf(stderr, "kernel_launch: unexpected n_in %d / ws_size %zu / out_size %d\n", n_in, ws_size, out_size); return; }
    static int grid_blocks = 0;
    if (!grid_blocks) {
        int dev = 0, cus = 0, per_cu = 0;
        (void)hipGetDevice(&dev);
        (void)hipDeviceGetAttribute(&cus, hipDeviceAttributeMultiprocessorCount, dev);
        if (hipFuncSetAttribute((const void*)mega_kernel, hipFuncAttributeMaxDynamicSharedMemorySize, LDS_BYTES) != hipSuccess) fprintf(stderr, "kernel_launch: hipFuncSetAttribute failed\n");
        (void)hipOccupancyMaxActiveBlocksPerMultiprocessor(&per_cu, (const void*)mega_kernel, NT, LDS_BYTES);
        if (per_cu < 1) { fprintf(stderr, "kernel_launch: occupancy query returned %d\n", per_cu); per_cu = 1; }
        grid_blocks = cus;
        if (grid_blocks % 8) grid_blocks -= grid_blocks % 8;
        fprintf(stderr, "kernel_launch: cus %d per_cu %d grid %d\n", cus, per_cu, grid_blocks);
    }
    P p{};
    const float** f = (const float**)&p;
    for (int i = 0; i < 31; ++i) f[i] = (const float*)d_in[i];
    p.out = (float*)d_out; p.ws = (char*)d_ws;
    if (hipMemsetAsync((char*)d_ws + OFF_CTL + CTL_BAR, 0, XCD_BAR_WORDS * 4, stream) != hipSuccess) fprintf(stderr, "kernel_launch: memset failed\n");
    void* args[] = {&p};
    hipError_t e = hipLaunchCooperativeKernel((const void*)mega_kernel, dim3(grid_blocks), dim3(NT), args, LDS_BYTES, stream);
    if (e != hipSuccess) fprintf(stderr, "cooperative launch failed: %s (grid %d)\n", hipGetErrorString(e), grid_blocks);
}
```
